# Optimizing an MI355X kernel written in HIP

```python
import math
import jax
import jax.numpy as jnp
from jax import lax
import numpy as np

D_MODEL = 1024
BATCH = 1
SEQ = 16384
DEPTH = 2

N_META = 16
LEAD = 128
N_PAD = LEAD - N_META
M_HEADS = 4
M_HEAD_DIM = D_MODEL // M_HEADS
M_INNER = M_HEADS * M_HEAD_DIM
CONV_W = 4
CHUNK = 64
F_BIAS_LO = 3.0
F_BIAS_HI = 6.0
A_HEADS = 8
A_HEAD_DIM = D_MODEL // (2 * A_HEADS)
A_VDIM = 2 * A_HEAD_DIM
A_INNER = A_HEADS * A_VDIM
Q_BLOCK = 128
N_EXPERTS = 16
N_GROUPS = 4
EXPERTS_PER_GROUP = N_EXPERTS // N_GROUPS
TOP_K = 2
D_EXPERT = D_MODEL
DN_ALPHA = (2 * DEPTH) ** 0.25
DN_BETA = (8 * DEPTH) ** -0.25
LN_EPS = 1e-5
NEG = -1e30
SPLITS = (M_INNER, M_INNER, M_HEADS, M_HEADS, A_INNER, A_INNER, A_INNER, D_MODEL, D_MODEL)
D_IN = 7176

kernel_name = 'hybrid_mlstm_diffattn_groupmoe_block'


def layer_norm(x, g, b):
    xf = x.astype(jnp.float32)
    mu = jnp.mean(xf, axis=-1, keepdims=True)
    var = jnp.mean(jnp.square(xf - mu), axis=-1, keepdims=True)
    y = (xf - mu) * lax.rsqrt(var + LN_EPS) * g.astype(jnp.float32) + b.astype(jnp.float32)
    return y.astype(x.dtype)


def causal_conv(x, w, b):
    y = lax.conv_general_dilated(
        x, w[:, None, :].astype(x.dtype), window_strides=(1,),
        padding=[(CONV_W - 1, 0)], dimension_numbers=('NWC', 'WIO', 'NWC'),
        feature_group_count=x.shape[-1])
    return y + b.astype(x.dtype)


def to_chunks(t):
    bsz, length = t.shape[:2]
    t = t.reshape((bsz, length // CHUNK, CHUNK) + t.shape[2:])
    return jnp.swapaxes(jnp.moveaxis(t, 1, 0), 2, 3)


def mlstm_chunk_step(carry, inp):
    c_state, n_state, m_state = carry
    q, k, v, logi, logf = inp
    causal = jnp.tril(jnp.ones((CHUNK, CHUNK), dtype=bool))
    b = jnp.cumsum(logf, axis=-1)
    g = b[..., -1]
    d_mat = jnp.where(causal, b[..., :, None] - b[..., None, :] + logi[..., None, :], NEG)
    inter = b + m_state[..., None]
    m_t = jnp.maximum(inter, jnp.max(d_mat, axis=-1))
    w_intra = jnp.einsum('bhtd,bhsd->bhts', q, k) * jnp.exp(d_mat - m_t[..., None])
    scale_inter = jnp.exp(inter - m_t)
    num = (jnp.einsum('bhts,bhsv->bhtv', w_intra, v)
           + scale_inter[..., None] * jnp.einsum('bhtd,bhdv->bhtv', q, c_state))
    den = jnp.sum(w_intra, axis=-1) + scale_inter * jnp.einsum('bhtd,bhd->bht', q, n_state)
    h = num / jnp.maximum(jnp.abs(den), jnp.exp(-m_t))[..., None]
    a = g[..., None] - b + logi
    m_new = jnp.maximum(g + m_state, jnp.max(a, axis=-1))
    w_state = jnp.exp(a - m_new[..., None])
    decay = jnp.exp(g + m_state - m_new)
    c_new = decay[..., None, None] * c_state + jnp.einsum('bhs,bhsd,bhsv->bhdv', w_state, k, v)
    n_new = decay[..., None] * n_state + jnp.einsum('bhs,bhsd->bhd', w_state, k)
    return (c_new, n_new, m_new), h


def mlstm_branch(xm, o_pre, i_pre, f_pre, valid, conv_w, conv_b, wq, wk, wv, b_i, b_f, norm_g):
    bsz, length, _ = xm.shape
    f32 = jnp.float32
    xm = xm * valid[None, :, None].astype(xm.dtype)
    xc = jax.nn.silu(causal_conv(xm, conv_w, conv_b))
    xch = xc.reshape(bsz, length, M_HEADS, M_HEAD_DIM)
    xmh = xm.reshape(bsz, length, M_HEADS, M_HEAD_DIM)
    q = jnp.einsum('blhd,hde->blhe', xch, wq).astype(f32)
    k = (jnp.einsum('blhd,hde->blhe', xch, wk) * (M_HEAD_DIM ** -0.5)).astype(f32)
    v = jnp.einsum('blhd,hde->blhe', xmh, wv).astype(f32)
    vmask = valid[None, :, None]
    logi = jnp.where(vmask, i_pre.astype(f32) + b_i.astype(f32), NEG)
    logf = jnp.where(vmask, jax.nn.log_sigmoid(f_pre.astype(f32) + b_f.astype(f32)), 0.0)
    init = (jnp.zeros((bsz, M_HEADS, M_HEAD_DIM, M_HEAD_DIM), f32),
            jnp.zeros((bsz, M_HEADS, M_HEAD_DIM), f32),
            jnp.zeros((bsz, M_HEADS), f32))
    xs = (to_chunks(q), to_chunks(k), to_chunks(v), to_chunks(logi), to_chunks(logf))
    _, h = lax.scan(mlstm_chunk_step, init, xs)
    h = jnp.moveaxis(jnp.swapaxes(h, 2, 3), 0, 1).reshape(bsz, length, M_HEADS, M_HEAD_DIM)
    h = jax.nn.sigmoid(o_pre.astype(f32)).reshape(bsz, length, M_HEADS, M_HEAD_DIM) * h
    mu = jnp.mean(h, axis=-1, keepdims=True)
    var = jnp.mean(jnp.square(h - mu), axis=-1, keepdims=True)
    h = ((h - mu) * lax.rsqrt(var + LN_EPS)).reshape(bsz, length, M_INNER) * norm_g.astype(f32)
    return h.astype(xm.dtype)


def diff_attn_branch(q, k, v, valid, lq1, lk1, lq2, lk2, norm_g, lam_init):
    bsz, length, _ = q.shape
    f32 = jnp.float32
    q = q.reshape(bsz, length, A_HEADS, 2, A_HEAD_DIM) * (A_HEAD_DIM ** -0.5)
    k = k.reshape(bsz, length, A_HEADS, 2, A_HEAD_DIM)
    v = v.reshape(bsz, length, A_HEADS, A_VDIM)
    k1 = k[..., 0, :]
    k2 = k[..., 1, :]
    lam = (jnp.exp(jnp.sum(lq1.astype(f32) * lk1.astype(f32)))
           - jnp.exp(jnp.sum(lq2.astype(f32) * lk2.astype(f32))) + lam_init)
    n_blocks = length // Q_BLOCK
    qb = jnp.moveaxis(q.reshape(bsz, n_blocks, Q_BLOCK, A_HEADS, 2, A_HEAD_DIM), 1, 0)
    starts = jnp.arange(n_blocks) * Q_BLOCK
    kpos = jnp.arange(length)

    def block(args):
        qblk, start = args
        qpos = start + jnp.arange(Q_BLOCK)
        mask = (kpos[None, :] <= qpos[:, None]) & valid[None, :]
        s1 = jnp.einsum('bqhd,bkhd->bhqk', qblk[..., 0, :], k1).astype(f32)
        s2 = jnp.einsum('bqhd,bkhd->bhqk', qblk[..., 1, :], k2).astype(f32)
        a1 = jax.nn.softmax(jnp.where(mask, s1, NEG), axis=-1)
        a2 = jax.nn.softmax(jnp.where(mask, s2, NEG), axis=-1)
        attn = a1 - lam * a2
        return jnp.einsum('bhqk,bkhv->bqhv', attn.astype(v.dtype), v)

    o = lax.map(block, (qb, starts))
    o = jnp.moveaxis(o, 0, 1).reshape(bsz, length, A_HEADS, A_VDIM).astype(f32)
    o = o * lax.rsqrt(jnp.mean(jnp.square(o), axis=-1, keepdims=True) + LN_EPS)
    o = o * norm_g.astype(f32) * (1.0 - lam_init)
    return o.reshape(bsz, length, A_INNER).astype(v.dtype)


def group_moe(x, w_router, router_bias, w_gate, w_up, w_down):
    bsz, length, dm = x.shape
    f32 = jnp.float32
    xt = x.reshape(-1, dm)
    probs = jax.nn.softmax((xt @ w_router).astype(f32), axis=-1)
    sel = probs + router_bias.astype(f32)
    group_score = jnp.max(sel.reshape(-1, N_GROUPS, EXPERTS_PER_GROUP), axis=-1)
    top_group = jnp.argmax(group_score, axis=-1)
    in_group = (jnp.arange(N_EXPERTS) // EXPERTS_PER_GROUP)[None, :] == top_group[:, None]
    _, idx = lax.top_k(jnp.where(in_group, sel, NEG), TOP_K)
    w = jnp.take_along_axis(probs, idx, axis=-1)
    w = w / jnp.sum(w, axis=-1, keepdims=True)
    combine = jnp.einsum('tk,tke->te', w, jax.nn.one_hot(idx, N_EXPERTS, dtype=f32))
    y = jnp.zeros((xt.shape[0], dm), f32)
    for e in range(N_EXPERTS):
        h = jax.nn.silu(xt @ w_gate[e]) * (xt @ w_up[e])
        y = y + combine[:, e:e + 1] * (h @ w_down[e]).astype(f32)
    return y.astype(x.dtype).reshape(bsz, length, dm)


def setup_inputs(seed: int = 0) -> dict:
    key = jax.random.key(seed)
    ks = jax.random.split(key, 32)
    f32 = jnp.float32

    def nrm(k, shape, scale):
        return jax.random.normal(k, shape, f32) * scale

    return {
        'x': nrm(ks[0], (BATCH, SEQ, D_MODEL), 1.0),
        'meta_tokens': nrm(ks[1], (N_META, D_MODEL), 1.0),
        'ln_in_g': 1.0 + nrm(ks[2], (D_MODEL,), 0.02),
        'ln_in_b': nrm(ks[3], (D_MODEL,), 0.02),
        'w_in': nrm(ks[4], (DEPTH, D_MODEL, D_IN), D_MODEL ** -0.5),
        'conv_w': nrm(ks[5], (DEPTH, CONV_W, M_INNER), CONV_W ** -0.5),
        'conv_b': nrm(ks[6], (DEPTH, M_INNER), 0.02),
        'wq_m': nrm(ks[7], (DEPTH, M_HEADS, M_HEAD_DIM, M_HEAD_DIM), M_HEAD_DIM ** -0.5),
        'wk_m': nrm(ks[8], (DEPTH, M_HEADS, M_HEAD_DIM, M_HEAD_DIM), M_HEAD_DIM ** -0.5),
        'wv_m': nrm(ks[9], (DEPTH, M_HEADS, M_HEAD_DIM, M_HEAD_DIM), M_HEAD_DIM ** -0.5),
        'b_i': nrm(ks[10], (DEPTH, M_HEADS), 0.1),
        'b_f': jnp.linspace(F_BIAS_LO, F_BIAS_HI, M_HEADS, dtype=f32)[None, :] + nrm(ks[11], (DEPTH, M_HEADS), 0.1),
        'm_norm_g': 1.0 + nrm(ks[12], (DEPTH, M_INNER), 0.02),
        'lam_q1': nrm(ks[13], (DEPTH, A_HEAD_DIM), 0.1),
        'lam_k1': nrm(ks[14], (DEPTH, A_HEAD_DIM), 0.1),
        'lam_q2': nrm(ks[15], (DEPTH, A_HEAD_DIM), 0.1),
        'lam_k2': nrm(ks[16], (DEPTH, A_HEAD_DIM), 0.1),
        'a_norm_g': 1.0 + nrm(ks[17], (DEPTH, A_VDIM), 0.02),
        'w_branch_m': nrm(ks[18], (DEPTH, M_INNER, D_MODEL), M_INNER ** -0.5),
        'w_branch_a': nrm(ks[19], (DEPTH, A_INNER, D_MODEL), A_INNER ** -0.5),
        'w_out': nrm(ks[20], (DEPTH, D_MODEL, D_MODEL), D_MODEL ** -0.5 * DN_BETA),
        'ln1_g': 1.0 + nrm(ks[21], (DEPTH, D_MODEL), 0.02),
        'ln1_b': nrm(ks[22], (DEPTH, D_MODEL), 0.02),
        'ln2_g': 1.0 + nrm(ks[23], (DEPTH, D_MODEL), 0.02),
        'ln2_b': nrm(ks[24], (DEPTH, D_MODEL), 0.02),
        'w_router': nrm(ks[25], (D_MODEL, N_EXPERTS), D_MODEL ** -0.5),
        'router_bias': nrm(ks[26], (N_EXPERTS,), 0.01),
        'w_gate_e': nrm(ks[27], (DEPTH, N_EXPERTS, D_MODEL, D_EXPERT), D_MODEL ** -0.5),
        'w_up_e': nrm(ks[28], (DEPTH, N_EXPERTS, D_MODEL, D_EXPERT), D_MODEL ** -0.5),
        'w_down_e': nrm(ks[29], (DEPTH, N_EXPERTS, D_EXPERT, D_MODEL), D_EXPERT ** -0.5 * DN_BETA),
    }


def reference(x, meta_tokens, ln_in_g, ln_in_b, w_in, conv_w, conv_b, wq_m, wk_m, wv_m,
              b_i, b_f, m_norm_g, lam_q1, lam_k1, lam_q2, lam_k2, a_norm_g,
              w_branch_m, w_branch_a, w_out, ln1_g, ln1_b, ln2_g, ln2_b,
              w_router, router_bias, w_gate_e, w_up_e, w_down_e):
    bsz, seq, dm = x.shape
    length = seq + LEAD
    pad = jnp.zeros((bsz, N_PAD, dm), x.dtype)
    meta = jnp.broadcast_to(meta_tokens[None].astype(x.dtype), (bsz, N_META, dm))
    h = jnp.concatenate([pad, meta, x], axis=1)
    valid = jnp.arange(length) >= N_PAD
    h = layer_norm(h, ln_in_g, ln_in_b)
    split_points = [int(s) for s in np.cumsum(SPLITS)[:-1]]
    for l in range(DEPTH):
        proj = h @ w_in[l]
        xm, o_pre, i_pre, f_pre, qa, ka, va, ga, gb = jnp.split(proj, split_points, axis=-1)
        y_m = mlstm_branch(xm, o_pre, i_pre, f_pre, valid, conv_w[l], conv_b[l],
                           wq_m[l], wk_m[l], wv_m[l], b_i[l], b_f[l], m_norm_g[l])
        lam_init = 0.8 - 0.6 * math.exp(-0.3 * l)
        y_a = diff_attn_branch(qa, ka, va, valid, lam_q1[l], lam_k1[l], lam_q2[l], lam_k2[l],
                               a_norm_g[l], lam_init)
        merged = jax.nn.sigmoid(ga) * (y_m @ w_branch_m[l]) + jax.nn.sigmoid(gb) * (y_a @ w_branch_a[l])
        h = layer_norm(DN_ALPHA * h + merged @ w_out[l], ln1_g[l], ln1_b[l])
        ffn = group_moe(h, w_router, router_bias, w_gate_e[l], w_up_e[l], w_down_e[l])
        h = layer_norm(DN_ALPHA * h + ffn, ln2_g[l], ln2_b[l])
    return h[:, LEAD:]
```

```cpp
#include <hip/hip_runtime.h>
#include <cstdio>
#include <cstdint>

constexpr int D = 1024;
constexpr int SEQ = 16384;
constexpr int NMETA = 16;
constexpr int P = 16640;
constexpr int VALID0 = 240;
constexpr int DEPTH = 2;
constexpr int DIN = 7176;
constexpr int NSC = 65;
constexpr int NEXP = 16;
constexpr float LN_EPS = 1e-5f;
constexpr float DN_ALPHA = 1.4142135623730951f;
constexpr float NEGBIG = -1e30f;
constexpr int NT = 512;
constexpr int NW = 8;

typedef unsigned short bf16_t;
typedef short bf16x8 __attribute__((ext_vector_type(8)));
typedef float f32x4 __attribute__((ext_vector_type(4)));
typedef unsigned u32x4 __attribute__((ext_vector_type(4)));
typedef unsigned u32x2 __attribute__((ext_vector_type(2)));

constexpr size_t MiB = 1u << 20;
constexpr size_t RB = (size_t)P * D * 2;
constexpr size_t WS_CTL = 0;
constexpr size_t CTL_BYTES = 1 * MiB;
constexpr size_t WS_TAB = 1 * MiB;
constexpr size_t TAB_GLI = WS_TAB;
constexpr size_t TAB_GLF = TAB_GLI + 4 * P * 4;
constexpr size_t TAB_B   = TAB_GLF + 4 * P * 4;
constexpr size_t TAB_E   = TAB_B + 4 * P * 4;
constexpr size_t TAB_PM  = TAB_E + 4 * P * 4;
constexpr size_t TAB_W   = TAB_PM + 4 * P * 4;
constexpr size_t TAB_SCG = TAB_W + 4 * P * 4;
constexpr size_t TAB_SCM = TAB_SCG + 4096;
constexpr size_t TAB_MT  = TAB_SCM + 4096;
constexpr size_t TAB_NT  = TAB_MT + 4096;
constexpr size_t TAB_TOPK = TAB_NT + (size_t)NSC * 4 * 256 * 4;
constexpr size_t TAB_ELIST = TAB_TOPK + (size_t)P * 32;
constexpr size_t TAB_END = TAB_ELIST + (size_t)NEXP * P * 4;
static_assert(TAB_END <= 8 * MiB, "tables");
constexpr size_t WS_W = 8 * MiB;
constexpr size_t W_IN_T = WS_W;
constexpr size_t W_Q_T = W_IN_T + (size_t)7168 * 1024 * 2;
constexpr size_t W_K_T = W_Q_T + 4 * 65536 * 2;
constexpr size_t W_V_T = W_K_T + 4 * 65536 * 2;
constexpr size_t W_BM_T = W_V_T + 4 * 65536 * 2;
constexpr size_t W_BA_T = W_BM_T + (size_t)D * D * 2;
constexpr size_t W_OUT_T = W_BA_T + (size_t)D * D * 2;
constexpr size_t W_G_T = W_OUT_T + (size_t)D * D * 2;
constexpr size_t W_U_T = W_G_T + (size_t)NEXP * D * D * 2;
constexpr size_t W_D_T = W_U_T + (size_t)NEXP * D * D * 2;
constexpr size_t W_END = W_D_T + (size_t)NEXP * D * D * 2;
static_assert(W_END <= 128 * MiB, "weights");
constexpr size_t WS_SLOT = 128 * MiB;
constexpr size_t SLOT(int i) { return WS_SLOT + (size_t)i * RB; }
constexpr size_t WS_END = WS_SLOT + 11 * RB;
constexpr size_t B_H = SLOT(0);
constexpr size_t B_XM = SLOT(1), B_YM = SLOT(1);
constexpr size_t B_OP = SLOT(2), B_MRGB = SLOT(2);
constexpr size_t B_QA = SLOT(3), B_QM = SLOT(3);
constexpr size_t B_KA = SLOT(4), B_XC = SLOT(4), B_CT = SLOT(4);
constexpr size_t B_VAT = SLOT(5), B_KM = SLOT(5), B_H1 = SLOT(5);
constexpr size_t B_GA = SLOT(6);
constexpr size_t B_GB = SLOT(7);
constexpr size_t B_YA = SLOT(8);
constexpr size_t B_KMT = SLOT(9), B_MRG = SLOT(9);
constexpr size_t B_VMT = SLOT(10);
constexpr size_t B_Z = SLOT(3);
constexpr size_t B_HID = SLOT(6);
constexpr size_t B_YB = SLOT(1);
constexpr int HID_ROWS_MAX = (int)(3 * RB / (D * 2));
constexpr int CW_CNT = 64;

struct Params {
    const float* in[30];
    float* out;
    unsigned char* ws;
};
enum { I_X = 0, I_META, I_LNG, I_LNB, I_WIN, I_CONVW, I_CONVB, I_WQM, I_WKM, I_WVM, I_BI, I_BF, I_MNG, I_LQ1, I_LK1, I_LQ2, I_LK2, I_ANG,
       I_WBM, I_WBA, I_WOUT, I_LN1G, I_LN1B, I_LN2G, I_LN2B, I_WR, I_RB, I_WG, I_WU, I_WD };

__device__ __forceinline__ float bf2f(unsigned v) { return __uint_as_float(v << 16); }
__device__ __forceinline__ unsigned f2bf(float f) { unsigned u = __float_as_uint(f); return (u + 0x7fffu + ((u >> 16) & 1u)) >> 16; }
__device__ __forceinline__ unsigned pk2(float lo, float hi) { return f2bf(lo) | (f2bf(hi) << 16); }
__device__ __forceinline__ float wave_sum(float v) {
#pragma unroll
    for (int o = 1; o < 64; o <<= 1) v += __shfl_xor(v, o);
    return v;
}
__device__ __forceinline__ float sigmoidf_(float x) { return 1.f / (1.f + __expf(-x)); }
__device__ __forceinline__ float siluf_(float x) { return x / (1.f + __expf(-x)); }
__device__ __forceinline__ float logsigmoidf_(float x) { return x >= 0.f ? -log1pf(__expf(-x)) : x - log1pf(__expf(x)); }
__device__ __forceinline__ f32x4 mfma16(bf16x8 a, bf16x8 b, f32x4 c) { return __builtin_amdgcn_mfma_f32_16x16x32_bf16(a, b, c, 0, 0, 0); }
__device__ __forceinline__ bf16x8 ld8(const bf16_t* p) { return *(const bf16x8*)p; }

__device__ __forceinline__ void transpose_item(const float* W, int K, size_t ldsrc, int k0, int n_src0, bf16_t* WT, int dst_row0, float* scr, int lane) {
#pragma unroll 8
    for (int i = 0; i < 32; ++i) { const int kk = 2 * i + (lane >> 5); scr[kk * 33 + (lane & 31)] = W[(size_t)(k0 + kk) * ldsrc + n_src0 + (lane & 31)]; }
    __builtin_amdgcn_wave_barrier();
    asm volatile("s_waitcnt lgkmcnt(0)" ::: "memory");
    const int c = lane & 7;
#pragma unroll
    for (int j = 0; j < 4; ++j) { const int n = (lane >> 3) + 8 * j; const float* s = scr + (8 * c) * 33 + n;
        u32x4 o; o.x = pk2(s[0 * 33], s[1 * 33]); o.y = pk2(s[2 * 33], s[3 * 33]); o.z = pk2(s[4 * 33], s[5 * 33]); o.w = pk2(s[6 * 33], s[7 * 33]);
        *(u32x4*)(WT + (size_t)(dst_row0 + n) * K + k0 + 8 * c) = o; }
    asm volatile("s_waitcnt lgkmcnt(0)" ::: "memory");
    __builtin_amdgcn_wave_barrier();
}
__device__ void convert_weights(const Params& p, int l, char* lds, int gw, int ngw, int wid, int lane) {
    float* scr = (float*)lds + wid * (64 * 33);
    unsigned char* ws = p.ws;
    constexpr int I_IN = 16 * 224, I_QKV = 3 * 4 * 4 * 8, I_SQ = 16 * 32, I_EXP = 3 * 16 * 512;
    constexpr int TOTAL = I_IN + I_QKV + 3 * I_SQ + I_EXP;
    for (int it = gw; it < TOTAL; it += ngw) {
        int r = it;
        if (r < I_IN) { const int kb = r / 224, nb = r % 224, r0 = nb * 32, nsrc = r0 < 2048 ? r0 : r0 + 8;
            transpose_item(p.in[I_WIN] + (size_t)l * D * DIN, D, DIN, kb * 64, nsrc, (bf16_t*)(ws + W_IN_T), r0, scr, lane); continue; }
        r -= I_IN;
        if (r < I_QKV) { const int w = r / 128, rr = r % 128, h = rr / 32, t = rr % 32, kb = t / 8, nb = t % 8;
            const float* src = p.in[w == 0 ? I_WQM : (w == 1 ? I_WKM : I_WVM)] + ((size_t)l * 4 + h) * 65536;
            bf16_t* dst = (bf16_t*)(ws + (w == 0 ? W_Q_T : (w == 1 ? W_K_T : W_V_T))) + (size_t)h * 65536;
            transpose_item(src, 256, 256, kb * 64, nb * 32, dst, nb * 32, scr, lane); continue; }
        r -= I_QKV;
        if (r < 3 * I_SQ) { const int w = r / I_SQ, t = r % I_SQ, kb = t / 32, nb = t % 32;
            const float* src = p.in[w == 0 ? I_WBM : (w == 1 ? I_WBA : I_WOUT)] + (size_t)l * D * D;
            bf16_t* dst = (bf16_t*)(ws + (w == 0 ? W_BM_T : (w == 1 ? W_BA_T : W_OUT_T)));
            transpose_item(src, D, D, kb * 64, nb * 32, dst, nb * 32, scr, lane); continue; }
        r -= 3 * I_SQ;
        { const int w = r / (16 * 512), rr = r % (16 * 512), e = rr / 512, t = rr % 512, kb = t / 32, nb = t % 32;
            const float* src = p.in[w == 0 ? I_WG : (w == 1 ? I_WU : I_WD)] + ((size_t)l * NEXP + e) * D * D;
            bf16_t* dst = (bf16_t*)(ws + (w == 0 ? W_G_T : (w == 1 ? W_U_T : W_D_T))) + (size_t)e * D * D;
            transpose_item(src, D, D, kb * 64, nb * 32, dst, nb * 32, scr, lane); }
    }
}

__device__ __forceinline__ void ln_normalize(f32x4 (&v)[4], const float* g, const float* b, int lane) {
    float s = 0.f;
#pragma unroll
    for (int j = 0; j < 4; ++j) s += (v[j].x + v[j].y) + (v[j].z + v[j].w);
    const float mean = wave_sum(s) * (1.f / D);
    float s2 = 0.f;
#pragma unroll
    for (int j = 0; j < 4; ++j) { v[j] = v[j] - mean; s2 += (v[j].x * v[j].x + v[j].y * v[j].y) + (v[j].z * v[j].z + v[j].w * v[j].w); }
    const float rstd = rsqrtf(wave_sum(s2) * (1.f / D) + LN_EPS);
#pragma unroll
    for (int j = 0; j < 4; ++j) { const f32x4 gg = *(const f32x4*)(g + 4 * lane + 256 * j), bb = *(const f32x4*)(b + 4 * lane + 256 * j); v[j] = v[j] * rstd * gg + bb; }
}
__device__ __forceinline__ void store_row_bf16(bf16_t* row, const f32x4 (&v)[4], int lane) {
#pragma unroll
    for (int j = 0; j < 4; ++j) { u32x2 o; o.x = pk2(v[j].x, v[j].y); o.y = pk2(v[j].z, v[j].w); *(u32x2*)(row + 4 * lane + 256 * j) = o; }
}
__device__ __forceinline__ void store_row_zero(bf16_t* row, int lane) {
#pragma unroll
    for (int j = 0; j < 4; ++j) { u32x2 o; o.x = 0u; o.y = 0u; *(u32x2*)(row + 4 * lane + 256 * j) = o; }
}
__device__ __forceinline__ void load_gate_w(const Params& p, int l, float* g8) {
    const float* w = p.in[I_WIN] + (size_t)l * D * DIN + 2048;
    for (int i = threadIdx.x; i < D * 8; i += NT) { const int k = i >> 3, c = i & 7; g8[i] = w[(size_t)k * DIN + c]; }
    __syncthreads();
}
__device__ __forceinline__ void gates_row(const Params& p, int l, const float* g8, const f32x4 (&v)[4], int prow, int lane) {
    float acc[8];
#pragma unroll
    for (int c = 0; c < 8; ++c) acc[c] = 0.f;
#pragma unroll
    for (int j = 0; j < 4; ++j)
#pragma unroll
        for (int i = 0; i < 4; ++i) { const int k = 4 * lane + 256 * j + i; const float x = v[j][i];
            const f32x4 w0 = *(const f32x4*)(g8 + k * 8), w1 = *(const f32x4*)(g8 + k * 8 + 4);
            acc[0] += x * w0.x; acc[1] += x * w0.y; acc[2] += x * w0.z; acc[3] += x * w0.w; acc[4] += x * w1.x; acc[5] += x * w1.y; acc[6] += x * w1.z; acc[7] += x * w1.w; }
#pragma unroll
    for (int c = 0; c < 8; ++c) acc[c] = wave_sum(acc[c]);
    if (lane < 4) {
        float* gli = (float*)(p.ws + TAB_GLI); float* glf = (float*)(p.ws + TAB_GLF);
        const float bi = p.in[I_BI][l * 4 + lane], bfv = p.in[I_BF][l * 4 + lane];
        float ai = acc[0], af = acc[4];
        if (lane == 1) { ai = acc[1]; af = acc[5]; } else if (lane == 2) { ai = acc[2]; af = acc[6]; } else if (lane == 3) { ai = acc[3]; af = acc[7]; }
        gli[(size_t)lane * P + prow] = ai + bi;
        glf[(size_t)lane * P + prow] = logsigmoidf_(af + bfv);
    }
}
__device__ __forceinline__ void gates_row_pad(const Params& p, int prow, int lane) {
    if (lane < 4) { ((float*)(p.ws + TAB_GLI))[(size_t)lane * P + prow] = NEGBIG; ((float*)(p.ws + TAB_GLF))[(size_t)lane * P + prow] = 0.f; }
}

__device__ void phase_prologue(const Params& p, char* lds, int bid, int nb) {
    const int tid = threadIdx.x, wid = tid >> 6, lane = tid & 63, gw = bid * NW + wid, ngw = nb * NW;
    convert_weights(p, 0, lds, gw, ngw, wid, lane);
    __syncthreads();
    float* g8 = (float*)lds;
    load_gate_w(p, 0, g8);
    bf16_t* H = (bf16_t*)(p.ws + B_H);
    for (int r = gw; r < P; r += ngw) {
        if (r < VALID0) { store_row_zero(H + (size_t)r * D, lane); gates_row_pad(p, r, lane); continue; }
        const float* src = r < 256 ? p.in[I_META] + (size_t)(r - VALID0) * D : p.in[I_X] + (size_t)(r - 256) * D;
        f32x4 v[4];
#pragma unroll
        for (int j = 0; j < 4; ++j) v[j] = *(const f32x4*)(src + 4 * lane + 256 * j);
        ln_normalize(v, p.in[I_LNG], p.in[I_LNB], lane);
        store_row_bf16(H + (size_t)r * D, v, lane);
        gates_row(p, 0, g8, v, r, lane);
    }
}

struct RowsPlain { const bf16_t* base; size_t ld; __device__ __forceinline__ const bf16_t* row(int m) const { return base + (size_t)m * ld; } };
template <class AR, class BR, class Epi>
__device__ __forceinline__ void sgemm_unit(const AR& ar, const BR& br, int K, int m0, int n0, const Epi& epi) {
    const int tid = threadIdx.x, wid = tid >> 6, lane = tid & 63, c = lane & 15, g = lane >> 4, wr = wid >> 2, wc = wid & 3;
    const int mw = m0 + 64 * wr, nw = n0 + 64 * wc;
    const bf16_t* ap[4]; const bf16_t* bp[4];
#pragma unroll
    for (int i = 0; i < 4; ++i) { ap[i] = ar.row(mw + 16 * i + c) + 8 * g; bp[i] = br.row(nw + 16 * i + c) + 8 * g; }
    f32x4 acc[4][4];
#pragma unroll
    for (int i = 0; i < 4; ++i)
#pragma unroll
        for (int j = 0; j < 4; ++j) acc[i][j] = (f32x4){0.f, 0.f, 0.f, 0.f};
    for (int k0 = 0; k0 < K; k0 += 32) {
        bf16x8 a[4], b[4];
#pragma unroll
        for (int i = 0; i < 4; ++i) { a[i] = ld8(ap[i] + k0); b[i] = ld8(bp[i] + k0); }
#pragma unroll
        for (int i = 0; i < 4; ++i)
#pragma unroll
            for (int j = 0; j < 4; ++j) acc[i][j] = mfma16(b[j], a[i], acc[i][j]);
    }
#pragma unroll
    for (int i = 0; i < 4; ++i)
#pragma unroll
        for (int j = 0; j < 4; ++j) epi(mw + 16 * i + c, nw + 16 * j + 4 * g, acc[i][j]);
}
__device__ __forceinline__ void store4_bf16(bf16_t* dst, f32x4 v) { u32x2 o; o.x = pk2(v.x, v.y); o.y = pk2(v.z, v.w); *(u32x2*)dst = o; }

struct EpiProj { unsigned char* ws;
    __device__ __forceinline__ void operator()(int m, int n, f32x4 v) const {
        const int seg = n >> 10, cc = n & 1023;
        const size_t off = seg == 0 ? B_XM : seg == 1 ? B_OP : seg == 2 ? B_QA : seg == 3 ? B_KA : seg == 5 ? B_GA : B_GB;
        store4_bf16((bf16_t*)(ws + off) + (size_t)m * D + cc, v); } };
struct EpiStore { bf16_t* C; size_t ldc; float scale;
    __device__ __forceinline__ void operator()(int m, int n, f32x4 v) const { store4_bf16(C + (size_t)m * ldc + n, v * scale); } };
__device__ void phase_proj(const Params& p, char* lds, int bid, int nb) {
    const bf16_t* H = (const bf16_t*)(p.ws + B_H); const bf16_t* W = (const bf16_t*)(p.ws + W_IN_T);
    constexpr int NU_MAIN = 130 * 24, NU_VAT = 8 * 65;
    for (int u = bid; u < NU_MAIN + NU_VAT; u += nb) {
        if (u < NU_MAIN) { const int mt = u / 24; int ct = u % 24; if (ct >= 16) ct += 4;
            sgemm_unit(RowsPlain{H, D}, RowsPlain{W, D}, D, mt * 128, ct * 256, EpiProj{p.ws});
        } else { const int v = u - NU_MAIN, mt = v / 65, ct = v % 65;
            sgemm_unit(RowsPlain{W + (size_t)4096 * D, D}, RowsPlain{H, D}, D, mt * 128, ct * 256, EpiStore{(bf16_t*)(p.ws + B_VAT), P, 1.f}); }
    }
}

__device__ void phase_attn(const Params& p, int l, char* lds, int bid, int nb) {
    const int tid = threadIdx.x, wid = tid >> 6, lane = tid & 63, c = lane & 15, g = lane >> 4, gw = bid * NW + wid, ngw = nb * NW;
    const bf16_t* QA = (const bf16_t*)(p.ws + B_QA); const bf16_t* KA = (const bf16_t*)(p.ws + B_KA); const bf16_t* VAT = (const bf16_t*)(p.ws + B_VAT);
    bf16_t* YA = (bf16_t*)(p.ws + B_YA);
    const float lam_init = 0.8f - 0.6f * expf(-0.3f * (float)l);
    float lam;
    { const float a = wave_sum(p.in[I_LQ1][l * 64 + lane] * p.in[I_LK1][l * 64 + lane]), b = wave_sum(p.in[I_LQ2][l * 64 + lane] * p.in[I_LK2][l * 64 + lane]);
      lam = expf(a) - expf(b) + lam_init; }
    constexpr int NQG = P / 16, QG0 = VALID0 / 16;
    const int ntask = (NQG - QG0) * 8;
    for (int t = gw; t < ntask; t += ngw) {
        const int qg = NQG - 1 - t / 8, hd = t % 8, q0 = qg * 16, q = q0 + c;
        bf16x8 qf[2][2];
#pragma unroll
        for (int mp = 0; mp < 2; ++mp)
#pragma unroll
            for (int ks = 0; ks < 2; ++ks) qf[mp][ks] = ld8(QA + (size_t)q * D + hd * 128 + mp * 64 + 32 * ks + 8 * g);
        f32x4 o[2][8];
#pragma unroll
        for (int mp = 0; mp < 2; ++mp)
#pragma unroll
            for (int dt = 0; dt < 8; ++dt) o[mp][dt] = (f32x4){0.f, 0.f, 0.f, 0.f};
        float mrun[2] = {NEGBIG, NEGBIG}, lrun[2] = {0.f, 0.f};
        for (int kb = 224; kb <= q0 + 15; kb += 32) {
            bf16x8 pf[2];
#pragma unroll
            for (int mp = 0; mp < 2; ++mp) {
                f32x4 s[2];
#pragma unroll
                for (int a = 0; a < 2; ++a) {
                    s[a] = (f32x4){0.f, 0.f, 0.f, 0.f};
                    const bf16_t* kr = KA + (size_t)(kb + 16 * a + c) * D + hd * 128 + mp * 64 + 8 * g;
#pragma unroll
                    for (int ks = 0; ks < 2; ++ks) s[a] = mfma16(ld8(kr + 32 * ks), qf[mp][ks], s[a]);
                }
                float mx = NEGBIG;
#pragma unroll
                for (int a = 0; a < 2; ++a)
#pragma unroll
                    for (int r = 0; r < 4; ++r) { const int key = kb + 16 * a + 4 * g + r; float v = s[a][r] * 0.125f; v = (key <= q && key >= VALID0) ? v : -INFINITY; s[a][r] = v; mx = fmaxf(mx, v); }
                mx = fmaxf(mx, __shfl_xor(mx, 16)); mx = fmaxf(mx, __shfl_xor(mx, 32));
                const float mn = fmaxf(mrun[mp], mx), alpha = __expf(mrun[mp] - mn);
                mrun[mp] = mn;
                float ps = 0.f;
#pragma unroll
                for (int a = 0; a < 2; ++a)
#pragma unroll
                    for (int r = 0; r < 4; ++r) { const float e = __expf(s[a][r] - mn); s[a][r] = e; ps += e; }
                lrun[mp] = lrun[mp] * alpha + ps;
#pragma unroll
                for (int dt = 0; dt < 8; ++dt) o[mp][dt] = o[mp][dt] * alpha;
                u32x4 w; w.x = pk2(s[0][0], s[0][1]); w.y = pk2(s[0][2], s[0][3]); w.z = pk2(s[1][0], s[1][1]); w.w = pk2(s[1][2], s[1][3]);
                pf[mp] = *(bf16x8*)&w;
            }
#pragma unroll
            for (int dt = 0; dt < 8; ++dt) {
                const bf16_t* vr = VAT + (size_t)(hd * 128 + 16 * dt + c) * P + kb + 4 * g;
                u32x2 v0 = *(const u32x2*)vr, v1 = *(const u32x2*)(vr + 16);
                u32x4 w; w.x = v0.x; w.y = v0.y; w.z = v1.x; w.w = v1.y;
                const bf16x8 vf = *(bf16x8*)&w;
                o[0][dt] = mfma16(vf, pf[0], o[0][dt]);
                o[1][dt] = mfma16(vf, pf[1], o[1][dt]);
            }
        }
        float l0 = lrun[0], l1 = lrun[1];
        l0 += __shfl_xor(l0, 16); l0 += __shfl_xor(l0, 32); l1 += __shfl_xor(l1, 16); l1 += __shfl_xor(l1, 32);
        const float i0 = 1.f / l0, i1 = lam / l1;
        float ss = 0.f;
#pragma unroll
        for (int dt = 0; dt < 8; ++dt) { o[0][dt] = o[0][dt] * i0 - o[1][dt] * i1; ss += (o[0][dt].x * o[0][dt].x + o[0][dt].y * o[0][dt].y) + (o[0][dt].z * o[0][dt].z + o[0][dt].w * o[0][dt].w); }
        ss += __shfl_xor(ss, 16); ss += __shfl_xor(ss, 32);
        const float rs = rsqrtf(ss * (1.f / 128.f) + LN_EPS) * (1.f - lam_init);
#pragma unroll
        for (int dt = 0; dt < 8; ++dt) { const f32x4 gg = *(const f32x4*)(p.in[I_ANG] + l * 128 + 16 * dt + 4 * g);
            store4_bf16(YA + (size_t)q * D + hd * 128 + 16 * dt + 4 * g, o[0][dt] * rs * gg); }
    }
}

__device__ void phase_conv(const Params& p, int l, char* lds, int bid, int nb) {
    const int tid = threadIdx.x, wid = tid >> 6, lane = tid & 63, gw = bid * NW + wid, ngw = nb * NW;
    const bf16_t* XM = (const bf16_t*)(p.ws + B_XM); bf16_t* XC = (bf16_t*)(p.ws + B_XC);
    const float* cw = p.in[I_CONVW] + (size_t)l * 4 * D; const float* cb = p.in[I_CONVB] + (size_t)l * D;
    const int nitem = P * (D / 8);
    for (int it = bid * NT + tid; it < nitem; it += nb * NT) {
        const int r = it >> 7, c0 = (it & 127) * 8;
        u32x4 o = {0u, 0u, 0u, 0u};
        if (r >= VALID0) {
            float acc[8];
#pragma unroll
            for (int i = 0; i < 8; ++i) acc[i] = cb[c0 + i];
#pragma unroll
            for (int j = 0; j < 4; ++j) { const int rr = r - 3 + j;
                if (rr >= VALID0) { const u32x4 x = *(const u32x4*)(XM + (size_t)rr * D + c0); const float* w = cw + j * D + c0;
                    acc[0] += w[0] * bf2f(x.x & 0xffffu); acc[1] += w[1] * bf2f(x.x >> 16); acc[2] += w[2] * bf2f(x.y & 0xffffu); acc[3] += w[3] * bf2f(x.y >> 16);
                    acc[4] += w[4] * bf2f(x.z & 0xffffu); acc[5] += w[5] * bf2f(x.z >> 16); acc[6] += w[6] * bf2f(x.w & 0xffffu); acc[7] += w[7] * bf2f(x.w >> 16); } }
            o.x = pk2(siluf_(acc[0]), siluf_(acc[1])); o.y = pk2(siluf_(acc[2]), siluf_(acc[3])); o.z = pk2(siluf_(acc[4]), siluf_(acc[5])); o.w = pk2(siluf_(acc[6]), siluf_(acc[7]));
        }
        *(u32x4*)(XC + (size_t)r * D + c0) = o;
    }
    const float* gli = (const float*)(p.ws + TAB_GLI); const float* glf = (const float*)(p.ws + TAB_GLF);
    float* tb = (float*)(p.ws + TAB_B); float* te = (float*)(p.ws + TAB_E); float* tpm = (float*)(p.ws + TAB_PM); float* tw = (float*)(p.ws + TAB_W);
    float* scg = (float*)(p.ws + TAB_SCG); float* scm = (float*)(p.ws + TAB_SCM);
    for (int t = gw; t < NSC * 4; t += ngw) {
        const int sc = t >> 2, h = t & 3; const size_t base = (size_t)h * P + sc * 256 + 4 * lane;
        const f32x4 lf = *(const f32x4*)(glf + base), li = *(const f32x4*)(gli + base);
        float b[4]; b[0] = lf.x; b[1] = b[0] + lf.y; b[2] = b[1] + lf.z; b[3] = b[2] + lf.w;
        float incl = b[3];
#pragma unroll
        for (int o = 1; o < 64; o <<= 1) { const float n = __shfl_up(incl, o); if (lane >= o) incl += n; }
        const float excl = incl - b[3];
        float e[4], pm[4];
#pragma unroll
        for (int i = 0; i < 4; ++i) { b[i] += excl; e[i] = li[i] - b[i]; }
        pm[0] = e[0]; pm[1] = fmaxf(pm[0], e[1]); pm[2] = fmaxf(pm[1], e[2]); pm[3] = fmaxf(pm[2], e[3]);
        float mi = pm[3];
#pragma unroll
        for (int o = 1; o < 64; o <<= 1) { const float n = __shfl_up(mi, o); if (lane >= o) mi = fmaxf(mi, n); }
        float mex = __shfl_up(mi, 1); if (lane == 0) mex = -INFINITY;
#pragma unroll
        for (int i = 0; i < 4; ++i) pm[i] = fmaxf(pm[i], mex);
        const float gtot = __shfl(incl, 63), emax = __shfl(mi, 63), mloc = gtot + emax;
        f32x4 ww;
#pragma unroll
        for (int i = 0; i < 4; ++i) ww[i] = __expf(e[i] + gtot - mloc);
        *(f32x4*)(tb + base) = (f32x4){b[0], b[1], b[2], b[3]};
        *(f32x4*)(te + base) = (f32x4){e[0], e[1], e[2], e[3]};
        *(f32x4*)(tpm + base) = (f32x4){pm[0], pm[1], pm[2], pm[3]};
        *(f32x4*)(tw + base) = ww;
        if (lane == 0) { scg[sc * 4 + h] = gtot; scm[sc * 4 + h] = mloc; }
    }
}

__device__ void phase_mqkv(const Params& p, char* lds, int bid, int nb) {
    const bf16_t* XC = (const bf16_t*)(p.ws + B_XC); const bf16_t* XM = (const bf16_t*)(p.ws + B_XM);
    const bf16_t* WQ = (const bf16_t*)(p.ws + W_Q_T); const bf16_t* WK = (const bf16_t*)(p.ws + W_K_T); const bf16_t* WV = (const bf16_t*)(p.ws + W_V_T);
    bf16_t* QM = (bf16_t*)(p.ws + B_QM); bf16_t* KM = (bf16_t*)(p.ws + B_KM); bf16_t* KMT = (bf16_t*)(p.ws + B_KMT); bf16_t* VMT = (bf16_t*)(p.ws + B_VMT);
    for (int u = bid; u < 4 * 520; u += nb) {
        const int w = u / 520, r = u % 520, h = r / 130, t = r % 130;
        if (w == 0) sgemm_unit(RowsPlain{XC + h * 256, D}, RowsPlain{WQ + (size_t)h * 65536, 256}, 256, t * 128, 0, EpiStore{QM + h * 256, D, 1.f});
        else if (w == 1) sgemm_unit(RowsPlain{XC + h * 256, D}, RowsPlain{WK + (size_t)h * 65536, 256}, 256, t * 128, 0, EpiStore{KM + h * 256, D, 0.0625f});
        else if (w == 2) sgemm_unit(RowsPlain{WK + (size_t)h * 65536, 256}, RowsPlain{XC + h * 256, D}, 256, (t / 65) * 128, (t % 65) * 256, EpiStore{KMT + (size_t)h * 256 * P, P, 0.0625f});
        else sgemm_unit(RowsPlain{WV + (size_t)h * 65536, 256}, RowsPlain{XM + h * 256, D}, 256, (t / 65) * 128, (t % 65) * 256, EpiStore{VMT + (size_t)h * 256 * P, P, 1.f});
    }
}

__device__ void phase_m1(const Params& p, char* lds, int bid, int nb) {
    const int tid = threadIdx.x, wid = tid >> 6, lane = tid & 63, c = lane & 15, g = lane >> 4, gw = bid * NW + wid, ngw = nb * NW;
    const bf16_t* KMT = (const bf16_t*)(p.ws + B_KMT); const bf16_t* VMT = (const bf16_t*)(p.ws + B_VMT);
    const float* tw = (const float*)(p.ws + TAB_W); bf16_t* CT = (bf16_t*)(p.ws + B_CT); float* NTv = (float*)(p.ws + TAB_NT);
    for (int t = gw; t < NSC * 4 * 16; t += ngw) {
        const int dvb = t & 15, h = (t >> 4) & 3, sc = t >> 6, s0 = sc * 256;
        f32x4 acc[16];
#pragma unroll
        for (int i = 0; i < 16; ++i) acc[i] = (f32x4){0.f, 0.f, 0.f, 0.f};
        float un[16];
#pragma unroll
        for (int i = 0; i < 16; ++i) un[i] = 0.f;
        for (int ks = 0; ks < 8; ++ks) {
            const int sb = s0 + 32 * ks + 8 * g;
            const f32x4 w0 = *(const f32x4*)(tw + (size_t)h * P + sb), w1 = *(const f32x4*)(tw + (size_t)h * P + sb + 4);
            const u32x4 vv = *(const u32x4*)(VMT + (size_t)(h * 256 + 16 * dvb + c) * P + sb);
            u32x4 vw; vw.x = pk2(bf2f(vv.x & 0xffffu) * w0.x, bf2f(vv.x >> 16) * w0.y); vw.y = pk2(bf2f(vv.y & 0xffffu) * w0.z, bf2f(vv.y >> 16) * w0.w);
            vw.z = pk2(bf2f(vv.z & 0xffffu) * w1.x, bf2f(vv.z >> 16) * w1.y); vw.w = pk2(bf2f(vv.w & 0xffffu) * w1.z, bf2f(vv.w >> 16) * w1.w);
            const bf16x8 vf = *(bf16x8*)&vw;
#pragma unroll
            for (int dk = 0; dk < 16; ++dk) {
                const u32x4 kk = *(const u32x4*)(KMT + (size_t)(h * 256 + 16 * dk + c) * P + sb);
                acc[dk] = mfma16(*(const bf16x8*)&kk, vf, acc[dk]);
                if (dvb == 0) un[dk] += bf2f(kk.x & 0xffffu) * w0.x + bf2f(kk.x >> 16) * w0.y + bf2f(kk.y & 0xffffu) * w0.z + bf2f(kk.y >> 16) * w0.w
                                      + bf2f(kk.z & 0xffffu) * w1.x + bf2f(kk.z >> 16) * w1.y + bf2f(kk.w & 0xffffu) * w1.z + bf2f(kk.w >> 16) * w1.w;
            }
        }
        bf16_t* dst = CT + ((size_t)(sc * 4 + h) * 256 + 16 * dvb + c) * 256;
#pragma unroll
        for (int dk = 0; dk < 16; ++dk) store4_bf16(dst + 16 * dk + 4 * g, acc[dk]);
        if (dvb == 0) {
#pragma unroll
            for (int dk = 0; dk < 16; ++dk) { float v = un[dk]; v += __shfl_xor(v, 16); v += __shfl_xor(v, 32); if (g == 0) NTv[(size_t)(sc * 4 + h) * 256 + 16 * dk + c] = v; }
        }
    }
}

__device__ void phase_m2(const Params& p, char* lds, int bid, int nb) {
    const float* scg = (const float*)(p.ws + TAB_SCG); const float* scm = (const float*)(p.ws + TAB_SCM);
    unsigned* CT = (unsigned*)(p.ws + B_CT); float* NTv = (float*)(p.ws + TAB_NT); float* mt = (float*)(p.ws + TAB_MT);
    const int gid = bid * NT + threadIdx.x, nth = nb * NT;
    for (int i = gid; i < 4 * 32768 + 1024; i += nth) {
        if (i < 4 * 32768) {
            const int h = i >> 15, idx = i & 32767;
            float m = 0.f, c0 = 0.f, c1 = 0.f;
            for (int sc = 0; sc < NSC; ++sc) {
                const float gg = scg[sc * 4 + h], ml = scm[sc * 4 + h], mn = fmaxf(gg + m, ml), dec = __expf(gg + m - mn), cor = __expf(ml - mn);
                unsigned* ptr = CT + (size_t)(sc * 4 + h) * 32768 + idx; const unsigned u = *ptr;
                c0 = dec * c0 + cor * bf2f(u & 0xffffu); c1 = dec * c1 + cor * bf2f(u >> 16);
                *ptr = pk2(c0, c1); m = mn;
            }
        } else {
            const int j = i - 4 * 32768, h = j >> 8, d = j & 255;
            float m = 0.f, n = 0.f;
            for (int sc = 0; sc < NSC; ++sc) {
                const float gg = scg[sc * 4 + h], ml = scm[sc * 4 + h], mn = fmaxf(gg + m, ml), dec = __expf(gg + m - mn), cor = __expf(ml - mn);
                float* ptr = NTv + (size_t)(sc * 4 + h) * 256 + d;
                n = dec * n + cor * *ptr; *ptr = n; m = mn;
                if (d == 0) mt[sc * 4 + h] = mn;
            }
        }
    }
}

__device__ void phase_m3(const Params& p, int l, char* lds, int bid, int nb) {
    const int tid = threadIdx.x, wid = tid >> 6, lane = tid & 63, c = lane & 15, g = lane >> 4, gw = bid * NW + wid, ngw = nb * NW;
    const bf16_t* QM = (const bf16_t*)(p.ws + B_QM); const bf16_t* KM = (const bf16_t*)(p.ws + B_KM); const bf16_t* VMT = (const bf16_t*)(p.ws + B_VMT);
    const bf16_t* CT = (const bf16_t*)(p.ws + B_CT); const float* NTv = (const float*)(p.ws + TAB_NT); const float* mt = (const float*)(p.ws + TAB_MT);
    const float* tb = (const float*)(p.ws + TAB_B); const float* te = (const float*)(p.ws + TAB_E); const float* tpm = (const float*)(p.ws + TAB_PM);
    const bf16_t* OP = (const bf16_t*)(p.ws + B_OP); bf16_t* YM = (bf16_t*)(p.ws + B_YM);
    constexpr int NRG = P / 16, RG0 = VALID0 / 16;
    const int ntask = (NRG - RG0) * 4;
    for (int t = gw; t < ntask; t += ngw) {
        const int rg = NRG - 1 - t / 4, h = t % 4, t0 = rg * 16, row = t0 + c, sc = t0 >> 8, s_start = sc << 8;
        bf16x8 qf[8];
#pragma unroll
        for (int ks = 0; ks < 8; ++ks) qf[ks] = ld8(QM + (size_t)row * D + h * 256 + 32 * ks + 8 * g);
        const float b_t = tb[(size_t)h * P + row], pm_t = tpm[(size_t)h * P + row];
        const float m_prev = sc > 0 ? mt[(sc - 1) * 4 + h] : 0.f;
        const float m_t = b_t + fmaxf(m_prev, pm_t), scale_t = __expf(b_t + m_prev - m_t);
        f32x4 acc[16];
#pragma unroll
        for (int i = 0; i < 16; ++i) acc[i] = (f32x4){0.f, 0.f, 0.f, 0.f};
        float den = 0.f;
        if (sc > 0) {
            const bf16_t* Cb = CT + (size_t)((sc - 1) * 4 + h) * 65536; const float* nv = NTv + (size_t)((sc - 1) * 4 + h) * 256;
#pragma unroll
            for (int ks = 0; ks < 8; ++ks) {
#pragma unroll
                for (int dt = 0; dt < 16; ++dt) acc[dt] = mfma16(ld8(Cb + (size_t)(16 * dt + c) * 256 + 32 * ks + 8 * g), qf[ks], acc[dt]);
                const f32x4 n0 = *(const f32x4*)(nv + 32 * ks + 8 * g), n1 = *(const f32x4*)(nv + 32 * ks + 8 * g + 4);
                const u32x4 qq = *(const u32x4*)&qf[ks];
                den += bf2f(qq.x & 0xffffu) * n0.x + bf2f(qq.x >> 16) * n0.y + bf2f(qq.y & 0xffffu) * n0.z + bf2f(qq.y >> 16) * n0.w
                     + bf2f(qq.z & 0xffffu) * n1.x + bf2f(qq.z >> 16) * n1.y + bf2f(qq.w & 0xffffu) * n1.z + bf2f(qq.w >> 16) * n1.w;
            }
            den *= scale_t;
#pragma unroll
            for (int dt = 0; dt < 16; ++dt) acc[dt] = acc[dt] * scale_t;
        }
        for (int kb = s_start; kb <= t0 + 15; kb += 32) {
            f32x4 s[2];
#pragma unroll
            for (int a = 0; a < 2; ++a) {
                s[a] = (f32x4){0.f, 0.f, 0.f, 0.f};
                const bf16_t* kr = KM + (size_t)(kb + 16 * a + c) * D + h * 256 + 8 * g;
#pragma unroll
                for (int ks = 0; ks < 8; ++ks) s[a] = mfma16(ld8(kr + 32 * ks), qf[ks], s[a]);
                const f32x4 ee = *(const f32x4*)(te + (size_t)h * P + kb + 16 * a + 4 * g);
#pragma unroll
                for (int r = 0; r < 4; ++r) { const int key = kb + 16 * a + 4 * g + r; const float arg = fminf(ee[r] + b_t - m_t, 0.f);
                    const float dd = key <= row ? __expf(arg) : 0.f; const float pv = s[a][r] * dd; s[a][r] = pv; den += pv; }
            }
            u32x4 w; w.x = pk2(s[0][0], s[0][1]); w.y = pk2(s[0][2], s[0][3]); w.z = pk2(s[1][0], s[1][1]); w.w = pk2(s[1][2], s[1][3]);
            const bf16x8 pf = *(bf16x8*)&w;
#pragma unroll
            for (int dt = 0; dt < 16; ++dt) {
                const bf16_t* vr = VMT + (size_t)(h * 256 + 16 * dt + c) * P + kb + 4 * g;
                const u32x2 v0 = *(const u32x2*)vr, v1 = *(const u32x2*)(vr + 16);
                u32x4 vv; vv.x = v0.x; vv.y = v0.y; vv.z = v1.x; vv.w = v1.y;
                acc[dt] = mfma16(*(bf16x8*)&vv, pf, acc[dt]);
            }
        }
        den += __shfl_xor(den, 16); den += __shfl_xor(den, 32);
        const float inv = 1.f / fmaxf(fabsf(den), __expf(-m_t));
        float s1 = 0.f;
#pragma unroll
        for (int dt = 0; dt < 16; ++dt) {
            const u32x2 og = *(const u32x2*)(OP + (size_t)row * D + h * 256 + 16 * dt + 4 * g);
            f32x4 v = acc[dt] * inv;
            v.x *= sigmoidf_(bf2f(og.x & 0xffffu)); v.y *= sigmoidf_(bf2f(og.x >> 16)); v.z *= sigmoidf_(bf2f(og.y & 0xffffu)); v.w *= sigmoidf_(bf2f(og.y >> 16));
            acc[dt] = v; s1 += (v.x + v.y) + (v.z + v.w);
        }
        s1 += __shfl_xor(s1, 16); s1 += __shfl_xor(s1, 32);
        const float mu = s1 * (1.f / 256.f);
        float s2 = 0.f;
#pragma unroll
        for (int dt = 0; dt < 16; ++dt) { acc[dt] = acc[dt] - mu; s2 += (acc[dt].x * acc[dt].x + acc[dt].y * acc[dt].y) + (acc[dt].z * acc[dt].z + acc[dt].w * acc[dt].w); }
        s2 += __shfl_xor(s2, 16); s2 += __shfl_xor(s2, 32);
        const float rstd = rsqrtf(s2 * (1.f / 256.f) + LN_EPS);
#pragma unroll
        for (int dt = 0; dt < 16; ++dt) { const f32x4 gg = *(const f32x4*)(p.in[I_MNG] + (size_t)l * D + h * 256 + 16 * dt + 4 * g);
            store4_bf16(YM + (size_t)row * D + h * 256 + 16 * dt + 4 * g, acc[dt] * rstd * gg); }
    }
}

struct EpiBr1 { float* MRG; const bf16_t* GA;
    __device__ __forceinline__ void operator()(int m, int n, f32x4 v) const { const u32x2 gg = *(const u32x2*)(GA + (size_t)m * D + n);
        f32x4 o; o.x = v.x * sigmoidf_(bf2f(gg.x & 0xffffu)); o.y = v.y * sigmoidf_(bf2f(gg.x >> 16)); o.z = v.z * sigmoidf_(bf2f(gg.y & 0xffffu)); o.w = v.w * sigmoidf_(bf2f(gg.y >> 16));
        *(f32x4*)(MRG + (size_t)m * D + n) = o; } };
struct EpiBr2 { const float* MRG; const bf16_t* GB; bf16_t* OUT;
    __device__ __forceinline__ void operator()(int m, int n, f32x4 v) const { const u32x2 gg = *(const u32x2*)(GB + (size_t)m * D + n); const f32x4 t = *(const f32x4*)(MRG + (size_t)m * D + n);
        f32x4 o; o.x = t.x + v.x * sigmoidf_(bf2f(gg.x & 0xffffu)); o.y = t.y + v.y * sigmoidf_(bf2f(gg.x >> 16)); o.z = t.z + v.z * sigmoidf_(bf2f(gg.y & 0xffffu)); o.w = t.w + v.w * sigmoidf_(bf2f(gg.y >> 16));
        store4_bf16(OUT + (size_t)m * D + n, o); } };
struct EpiOut { float* Z; const bf16_t* H;
    __device__ __forceinline__ void operator()(int m, int n, f32x4 v) const { const u32x2 hh = *(const u32x2*)(H + (size_t)m * D + n);
        f32x4 o; o.x = v.x + DN_ALPHA * bf2f(hh.x & 0xffffu); o.y = v.y + DN_ALPHA * bf2f(hh.x >> 16); o.z = v.z + DN_ALPHA * bf2f(hh.y & 0xffffu); o.w = v.w + DN_ALPHA * bf2f(hh.y >> 16);
        *(f32x4*)(Z + (size_t)m * D + n) = o; } };
__device__ void phase_br1(const Params& p, char* lds, int bid, int nb) {
    for (int u = bid; u < 130 * 4; u += nb)
        sgemm_unit(RowsPlain{(const bf16_t*)(p.ws + B_YM), D}, RowsPlain{(const bf16_t*)(p.ws + W_BM_T), D}, D, (u >> 2) * 128, (u & 3) * 256, EpiBr1{(float*)(p.ws + B_MRG), (const bf16_t*)(p.ws + B_GA)});
}
__device__ void phase_br2(const Params& p, char* lds, int bid, int nb) {
    for (int u = bid; u < 130 * 4; u += nb)
        sgemm_unit(RowsPlain{(const bf16_t*)(p.ws + B_YA), D}, RowsPlain{(const bf16_t*)(p.ws + W_BA_T), D}, D, (u >> 2) * 128, (u & 3) * 256,
                   EpiBr2{(const float*)(p.ws + B_MRG), (const bf16_t*)(p.ws + B_GB), (bf16_t*)(p.ws + B_MRGB)});
}
__device__ void phase_out(const Params& p, char* lds, int bid, int nb) {
    for (int u = bid; u < 130 * 4; u += nb)
        sgemm_unit(RowsPlain{(const bf16_t*)(p.ws + B_MRGB), D}, RowsPlain{(const bf16_t*)(p.ws + W_OUT_T), D}, D, (u >> 2) * 128, (u & 3) * 256, EpiOut{(float*)(p.ws + B_Z), (const bf16_t*)(p.ws + B_H)});
}

__device__ void phase_ln1(const Params& p, int l, char* lds, int bid, int nb) {
    const int tid = threadIdx.x, wid = tid >> 6, lane = tid & 63, gw = bid * NW + wid, ngw = nb * NW;
    float* wr = (float*)lds;
    for (int i = tid; i < D * 16 / 4; i += NT) ((f32x4*)wr)[i] = ((const f32x4*)p.in[I_WR])[i];
    __syncthreads();
    const float* Z = (const float*)(p.ws + B_Z); bf16_t* H1 = (bf16_t*)(p.ws + B_H1);
    unsigned* cnt = (unsigned*)(p.ws + WS_CTL) + CW_CNT + l * 16; int* elist = (int*)(p.ws + TAB_ELIST); float* topk = (float*)(p.ws + TAB_TOPK);
    for (int r = gw; r < P; r += ngw) {
        if (r < VALID0) { store_row_zero(H1 + (size_t)r * D, lane); continue; }
        f32x4 v[4];
#pragma unroll
        for (int j = 0; j < 4; ++j) v[j] = *(const f32x4*)(Z + (size_t)r * D + 4 * lane + 256 * j);
        ln_normalize(v, p.in[I_LN1G] + (size_t)l * D, p.in[I_LN1B] + (size_t)l * D, lane);
        store_row_bf16(H1 + (size_t)r * D, v, lane);
        float lg[16];
#pragma unroll
        for (int e = 0; e < 16; ++e) lg[e] = 0.f;
#pragma unroll
        for (int j = 0; j < 4; ++j)
#pragma unroll
            for (int i = 0; i < 4; ++i) { const int k = 4 * lane + 256 * j + i; const float x = v[j][i];
#pragma unroll
                for (int q = 0; q < 4; ++q) { const f32x4 w = *(const f32x4*)(wr + k * 16 + 4 * q); lg[4 * q] += x * w.x; lg[4 * q + 1] += x * w.y; lg[4 * q + 2] += x * w.z; lg[4 * q + 3] += x * w.w; } }
#pragma unroll
        for (int e = 0; e < 16; ++e) lg[e] = wave_sum(lg[e]);
        if (lane == 0) {
            float mx = lg[0];
#pragma unroll
            for (int e = 1; e < 16; ++e) mx = fmaxf(mx, lg[e]);
            float pr[16], sum = 0.f;
#pragma unroll
            for (int e = 0; e < 16; ++e) { pr[e] = expf(lg[e] - mx); sum += pr[e]; }
            const float isum = 1.f / sum;
            float sel[16];
#pragma unroll
            for (int e = 0; e < 16; ++e) { pr[e] *= isum; sel[e] = pr[e] + p.in[I_RB][e]; }
            int tg = 0; float best = -INFINITY;
#pragma unroll
            for (int gI = 0; gI < 4; ++gI) { const float gs = fmaxf(fmaxf(sel[4 * gI], sel[4 * gI + 1]), fmaxf(sel[4 * gI + 2], sel[4 * gI + 3])); if (gs > best) { best = gs; tg = gI; } }
            int i0 = 0; float b0 = -INFINITY;
#pragma unroll
            for (int e = 0; e < 16; ++e) if ((e >> 2) == tg && sel[e] > b0) { b0 = sel[e]; i0 = e; }
            int i1 = 0; float b1 = -INFINITY;
#pragma unroll
            for (int e = 0; e < 16; ++e) if ((e >> 2) == tg && e != i0 && sel[e] > b1) { b1 = sel[e]; i1 = e; }
            float p0 = 0.f, p1 = 0.f;
#pragma unroll
            for (int e = 0; e < 16; ++e) { if (e == i0) p0 = pr[e]; if (e == i1) p1 = pr[e]; }
            const float inv = 1.f / (p0 + p1);
            const unsigned pos0 = atomicAdd(cnt + i0, 1u), pos1 = atomicAdd(cnt + i1, 1u);
            elist[(size_t)i0 * P + pos0] = r; elist[(size_t)i1 * P + pos1] = r;
            float* tk = topk + (size_t)r * 8;
            ((int*)tk)[0] = i0; ((int*)tk)[1] = i1; ((int*)tk)[2] = (int)pos0; ((int*)tk)[3] = (int)pos1; tk[4] = p0 * inv; tk[5] = p1 * inv;
        }
    }
}

__device__ __forceinline__ void expert_offsets(const unsigned* cnt, int* s_cnt, int* s_off, int* s_tiles) {
    int off = 0;
    if (threadIdx.x == 0) { int tt = 0; for (int e = 0; e < 16; ++e) { const int c = (int)cnt[e]; const int tl = (c + 127) >> 7; s_cnt[e] = c; s_off[e] = off; s_tiles[e] = tt; off += tl * 128; tt += tl; } s_tiles[16] = tt; }
    __syncthreads();
}
__device__ void phase_e1(const Params& p, int l, char* lds, int bid, int nb) {
    int* s_cnt = (int*)lds; int* s_off = s_cnt + 16; int* s_tiles = s_off + 16;
    expert_offsets((const unsigned*)(p.ws + WS_CTL) + CW_CNT + l * 16, s_cnt, s_off, s_tiles);
    const int tid = threadIdx.x, wid = tid >> 6, lane = tid & 63, c = lane & 15, g = lane >> 4, wr = wid >> 2, wc = wid & 3;
    const bf16_t* H1 = (const bf16_t*)(p.ws + B_H1); const int* elist = (const int*)(p.ws + TAB_ELIST); bf16_t* HID = (bf16_t*)(p.ws + B_HID);
    const int total = s_tiles[16] * 8;
    for (int u = bid; u < total; u += nb) {
        const int rt = u >> 3, ct = u & 7; int e = 0;
        while (e < 15 && rt >= s_tiles[e + 1]) ++e;
        const int ti = rt - s_tiles[e], cntE = s_cnt[e], r0 = ti * 128 + 64 * wr, n0 = ct * 128 + 32 * wc;
        const bf16_t* Wg = (const bf16_t*)(p.ws + W_G_T) + (size_t)e * D * D; const bf16_t* Wu = (const bf16_t*)(p.ws + W_U_T) + (size_t)e * D * D;
        const bf16_t* ap[4];
#pragma unroll
        for (int i = 0; i < 4; ++i) { const int rr = r0 + 16 * i + c; const int tok = elist[(size_t)e * P + (rr < cntE ? rr : 0)]; ap[i] = H1 + (size_t)tok * D + 8 * g; }
        const bf16_t* gp[2]; const bf16_t* up[2];
#pragma unroll
        for (int j = 0; j < 2; ++j) { gp[j] = Wg + (size_t)(n0 + 16 * j + c) * D + 8 * g; up[j] = Wu + (size_t)(n0 + 16 * j + c) * D + 8 * g; }
        f32x4 ag[4][2], au[4][2];
#pragma unroll
        for (int i = 0; i < 4; ++i)
#pragma unroll
            for (int j = 0; j < 2; ++j) { ag[i][j] = (f32x4){0.f, 0.f, 0.f, 0.f}; au[i][j] = (f32x4){0.f, 0.f, 0.f, 0.f}; }
        for (int k0 = 0; k0 < D; k0 += 32) {
            bf16x8 a[4], bg[2], bu[2];
#pragma unroll
            for (int i = 0; i < 4; ++i) a[i] = ld8(ap[i] + k0);
#pragma unroll
            for (int j = 0; j < 2; ++j) { bg[j] = ld8(gp[j] + k0); bu[j] = ld8(up[j] + k0); }
#pragma unroll
            for (int i = 0; i < 4; ++i)
#pragma unroll
                for (int j = 0; j < 2; ++j) { ag[i][j] = mfma16(bg[j], a[i], ag[i][j]); au[i][j] = mfma16(bu[j], a[i], au[i][j]); }
        }
#pragma unroll
        for (int i = 0; i < 4; ++i)
#pragma unroll
            for (int j = 0; j < 2; ++j) { f32x4 o;
#pragma unroll
                for (int r = 0; r < 4; ++r) o[r] = siluf_(ag[i][j][r]) * au[i][j][r];
                store4_bf16(HID + (size_t)(s_off[e] + r0 + 16 * i + c) * D + n0 + 16 * j + 4 * g, o); }
    }
}
__device__ void phase_e2(const Params& p, int l, char* lds, int bid, int nb) {
    int* s_cnt = (int*)lds; int* s_off = s_cnt + 16; int* s_tiles = s_off + 16;
    expert_offsets((const unsigned*)(p.ws + WS_CTL) + CW_CNT + l * 16, s_cnt, s_off, s_tiles);
    const bf16_t* HID = (const bf16_t*)(p.ws + B_HID); bf16_t* YB = (bf16_t*)(p.ws + B_YB);
    const int total = s_tiles[16] * 4;
    for (int u = bid; u < total; u += nb) {
        const int rt = u >> 2, ct = u & 3; int e = 0;
        while (e < 15 && rt >= s_tiles[e + 1]) ++e;
        const int ti = rt - s_tiles[e];
        sgemm_unit(RowsPlain{HID + (size_t)s_off[e] * D, D}, RowsPlain{(const bf16_t*)(p.ws + W_D_T) + (size_t)e * D * D, D}, D, ti * 128, ct * 256, EpiStore{YB + (size_t)s_off[e] * D, D, 1.f});
    }
}
__device__ void phase_combine(const Params& p, int l, char* lds, int bid, int nb) {
    const int tid = threadIdx.x, wid = tid >> 6, lane = tid & 63, gw = bid * NW + wid, ngw = nb * NW;
    const bool last = (l == DEPTH - 1);
    if (!last) { convert_weights(p, l + 1, lds, gw, ngw, wid, lane); __syncthreads(); }
    int* s_cnt = (int*)(lds + 65536); int* s_off = s_cnt + 16; int* s_tiles = s_off + 16;
    expert_offsets((const unsigned*)(p.ws + WS_CTL) + CW_CNT + l * 16, s_cnt, s_off, s_tiles);
    float* g8 = (float*)lds;
    if (!last) load_gate_w(p, l + 1, g8);
    const bf16_t* H1 = (const bf16_t*)(p.ws + B_H1); const bf16_t* YB = (const bf16_t*)(p.ws + B_YB); bf16_t* H = (bf16_t*)(p.ws + B_H);
    const float* topk = (const float*)(p.ws + TAB_TOPK);
    for (int r = gw; r < P; r += ngw) {
        if (r < VALID0) { if (!last) { store_row_zero(H + (size_t)r * D, lane); gates_row_pad(p, r, lane); } continue; }
        if (last && r < 256) continue;
        const float* tk = topk + (size_t)r * 8;
        const int e0 = ((const int*)tk)[0], e1 = ((const int*)tk)[1], p0 = ((const int*)tk)[2], p1 = ((const int*)tk)[3]; const float w0 = tk[4], w1 = tk[5];
        const bf16_t* y0 = YB + (size_t)(s_off[e0] + p0) * D; const bf16_t* y1 = YB + (size_t)(s_off[e1] + p1) * D; const bf16_t* hr = H1 + (size_t)r * D;
        f32x4 v[4];
#pragma unroll
        for (int j = 0; j < 4; ++j) { const int cc = 4 * lane + 256 * j; const u32x2 a = *(const u32x2*)(y0 + cc), b = *(const u32x2*)(y1 + cc), hh = *(const u32x2*)(hr + cc);
            v[j].x = DN_ALPHA * bf2f(hh.x & 0xffffu) + w0 * bf2f(a.x & 0xffffu) + w1 * bf2f(b.x & 0xffffu);
            v[j].y = DN_ALPHA * bf2f(hh.x >> 16) + w0 * bf2f(a.x >> 16) + w1 * bf2f(b.x >> 16);
            v[j].z = DN_ALPHA * bf2f(hh.y & 0xffffu) + w0 * bf2f(a.y & 0xffffu) + w1 * bf2f(b.y & 0xffffu);
            v[j].w = DN_ALPHA * bf2f(hh.y >> 16) + w0 * bf2f(a.y >> 16) + w1 * bf2f(b.y >> 16); }
        ln_normalize(v, p.in[I_LN2G] + (size_t)l * D, p.in[I_LN2B] + (size_t)l * D, lane);
        if (last) {
            float* o = p.out + (size_t)(r - 256) * D;
#pragma unroll
            for (int j = 0; j < 4; ++j) *(f32x4*)(o + 4 * lane + 256 * j) = v[j];
        } else { store_row_bf16(H + (size_t)r * D, v, lane); gates_row(p, l + 1, g8, v, r, lane); }
    }
}

constexpr int LDS_BYTES = 73728;
template <int PH>
__global__ void __launch_bounds__(NT) phase_kernel(Params p, int l) {
    extern __shared__ __attribute__((aligned(16))) char lds[];
    const int bid = blockIdx.x, nb = gridDim.x;
    if constexpr (PH == 0) phase_prologue(p, lds, bid, nb);
    if constexpr (PH == 1) phase_proj(p, lds, bid, nb);
    if constexpr (PH == 2) phase_attn(p, l, lds, bid, nb);
    if constexpr (PH == 3) phase_conv(p, l, lds, bid, nb);
    if constexpr (PH == 4) phase_mqkv(p, lds, bid, nb);
    if constexpr (PH == 5) phase_m1(p, lds, bid, nb);
    if constexpr (PH == 6) phase_m2(p, lds, bid, nb);
    if constexpr (PH == 7) phase_m3(p, l, lds, bid, nb);
    if constexpr (PH == 8) phase_br1(p, lds, bid, nb);
    if constexpr (PH == 9) phase_br2(p, lds, bid, nb);
    if constexpr (PH == 10) phase_out(p, lds, bid, nb);
    if constexpr (PH == 11) phase_ln1(p, l, lds, bid, nb);
    if constexpr (PH == 12) phase_e1(p, l, lds, bid, nb);
    if constexpr (PH == 13) phase_e2(p, l, lds, bid, nb);
    if constexpr (PH == 14) phase_combine(p, l, lds, bid, nb);
}
template <int PH> static void launch_phase(const Params& p, int l, int grid, hipStream_t s) {
    static bool attr = false;
    if (!attr) { (void)hipFuncSetAttribute((const void*)phase_kernel<PH>, hipFuncAttributeMaxDynamicSharedMemorySize, LDS_BYTES); attr = true; }
    hipLaunchKernelGGL(phase_kernel<PH>, dim3(grid), dim3(NT), LDS_BYTES, s, p, l);
}

extern "C" void kernel_launch(void* const* d_in, const int* in_sizes, int n_in, void* d_out, int out_size, void* d_ws, size_t ws_size, hipStream_t stream) {
    if (n_in != 30 || ws_size < WS_END) { fprintf(stderr, "kernel_launch: unexpected n_in %d or ws_size %zu (< %zu)\n", n_in, ws_size, (size_t)WS_END); return; }
    Params p{};
    for (int i = 0; i < 30; ++i) p.in[i] = (const float*)d_in[i];
    p.out = (float*)d_out; p.ws = (unsigned char*)d_ws;
    (void)hipMemsetAsync((char*)d_ws + WS_CTL, 0, CTL_BYTES, stream);
    const int G = 512;
    launch_phase<0>(p, 0, G, stream);
    for (int l = 0; l < DEPTH; ++l) {
        launch_phase<1>(p, l, G, stream);
        launch_phase<2>(p, l, G, stream);
        launch_phase<3>(p, l, G, stream);
        launch_phase<4>(p, l, G, stream);
        launch_phase<5>(p, l, G, stream);
        launch_phase<6>(p, l, G, stream);
        launch_phase<7>(p, l, G, stream);
        launch_phase<8>(p, l, G, stream);
        launch_phase<9>(p, l, G, stream);
        launch_phase<10>(p, l, G, stream);
        launch_phase<11>(p, l, G, stream);
        launch_phase<12>(p, l, G, stream);
        launch_phase<13>(p, l, G, stream);
        launch_phase<14>(p, l, G, stream);
    }
}
```

```cpp
#include <hip/hip_runtime.h>
#include <cstdio>
#include <cstdint>

constexpr int D = 1024;
constexpr int SEQ = 16384;
constexpr int NMETA = 16;
constexpr int P = 16640;
constexpr int VALID0 = 240;
constexpr int DEPTH = 2;
constexpr int DIN = 7176;
constexpr int NSC = 65;
constexpr int NEXP = 16;
constexpr float LN_EPS = 1e-5f;
constexpr float DN_ALPHA = 1.4142135623730951f;
constexpr float NEGBIG = -1e30f;
constexpr int NT = 512;
constexpr int NW = 8;

typedef unsigned short bf16_t;
typedef short bf16x8 __attribute__((ext_vector_type(8)));
typedef float f32x4 __attribute__((ext_vector_type(4)));
typedef unsigned u32x4 __attribute__((ext_vector_type(4)));
typedef unsigned u32x2 __attribute__((ext_vector_type(2)));

constexpr size_t MiB = 1u << 20;
constexpr size_t RB = (size_t)P * D * 2;
constexpr size_t WS_CTL = 0;
constexpr size_t CTL_BYTES = 1 * MiB;
constexpr size_t WS_TAB = 1 * MiB;
constexpr size_t TAB_GLI = WS_TAB;
constexpr size_t TAB_GLF = TAB_GLI + 4 * P * 4;
constexpr size_t TAB_B   = TAB_GLF + 4 * P * 4;
constexpr size_t TAB_E   = TAB_B + 4 * P * 4;
constexpr size_t TAB_PM  = TAB_E + 4 * P * 4;
constexpr size_t TAB_W   = TAB_PM + 4 * P * 4;
constexpr size_t TAB_SCG = TAB_W + 4 * P * 4;
constexpr size_t TAB_SCM = TAB_SCG + 4096;
constexpr size_t TAB_MT  = TAB_SCM + 4096;
constexpr size_t TAB_NT  = TAB_MT + 4096;
constexpr size_t TAB_TOPK = TAB_NT + (size_t)NSC * 4 * 256 * 4;
constexpr size_t TAB_ELIST = TAB_TOPK + (size_t)P * 32;
constexpr size_t TAB_END = TAB_ELIST + (size_t)NEXP * P * 4;
static_assert(TAB_END <= 8 * MiB, "tables");
constexpr size_t WS_W = 8 * MiB;
constexpr size_t W_IN_T = WS_W;
constexpr size_t W_Q_T = W_IN_T + (size_t)7168 * 1024 * 2;
constexpr size_t W_K_T = W_Q_T + 4 * 65536 * 2;
constexpr size_t W_V_T = W_K_T + 4 * 65536 * 2;
constexpr size_t W_BM_T = W_V_T + 4 * 65536 * 2;
constexpr size_t W_BA_T = W_BM_T + (size_t)D * D * 2;
constexpr size_t W_OUT_T = W_BA_T + (size_t)D * D * 2;
constexpr size_t W_G_T = W_OUT_T + (size_t)D * D * 2;
constexpr size_t W_U_T = W_G_T + (size_t)NEXP * D * D * 2;
constexpr size_t W_D_T = W_U_T + (size_t)NEXP * D * D * 2;
constexpr size_t W_END = W_D_T + (size_t)NEXP * D * D * 2;
static_assert(W_END <= 128 * MiB, "weights");
constexpr size_t WS_SLOT = 128 * MiB;
constexpr size_t SLOT(int i) { return WS_SLOT + (size_t)i * RB; }
constexpr size_t WS_END = WS_SLOT + 11 * RB;
constexpr size_t B_H = SLOT(0);
constexpr size_t B_XM = SLOT(1), B_YM = SLOT(1);
constexpr size_t B_OP = SLOT(2), B_MRGB = SLOT(2);
constexpr size_t B_QA = SLOT(3), B_QM = SLOT(3);
constexpr size_t B_KA = SLOT(4), B_XC = SLOT(4), B_CT = SLOT(4);
constexpr size_t B_VAT = SLOT(5), B_KM = SLOT(5), B_H1 = SLOT(5);
constexpr size_t B_GA = SLOT(6);
constexpr size_t B_GB = SLOT(7);
constexpr size_t B_YA = SLOT(8);
constexpr size_t B_KMT = SLOT(9), B_MRG = SLOT(9);
constexpr size_t B_VMT = SLOT(10);
constexpr size_t B_Z = SLOT(3);
constexpr size_t B_HID = SLOT(6);
constexpr size_t B_YB = SLOT(1);
constexpr int HID_ROWS_MAX = (int)(3 * RB / (D * 2));
constexpr int CW_CNT = 64;

struct Params {
    const float* in[30];
    float* out;
    unsigned char* ws;
};
enum { I_X = 0, I_META, I_LNG, I_LNB, I_WIN, I_CONVW, I_CONVB, I_WQM, I_WKM, I_WVM, I_BI, I_BF, I_MNG, I_LQ1, I_LK1, I_LQ2, I_LK2, I_ANG,
       I_WBM, I_WBA, I_WOUT, I_LN1G, I_LN1B, I_LN2G, I_LN2B, I_WR, I_RB, I_WG, I_WU, I_WD };

__device__ __forceinline__ float bf2f(unsigned v) { return __uint_as_float(v << 16); }
__device__ __forceinline__ unsigned f2bf(float f) { unsigned u = __float_as_uint(f); return (u + 0x7fffu + ((u >> 16) & 1u)) >> 16; }
__device__ __forceinline__ unsigned pk2(float lo, float hi) { return f2bf(lo) | (f2bf(hi) << 16); }
__device__ __forceinline__ float wave_sum(float v) {
#pragma unroll
    for (int o = 1; o < 64; o <<= 1) v += __shfl_xor(v, o);
    return v;
}
__device__ __forceinline__ float sigmoidf_(float x) { return 1.f / (1.f + __expf(-x)); }
__device__ __forceinline__ float siluf_(float x) { return x / (1.f + __expf(-x)); }
__device__ __forceinline__ float logsigmoidf_(float x) { return x >= 0.f ? -log1pf(__expf(-x)) : x - log1pf(__expf(x)); }
__device__ __forceinline__ f32x4 mfma16(bf16x8 a, bf16x8 b, f32x4 c) { return __builtin_amdgcn_mfma_f32_16x16x32_bf16(a, b, c, 0, 0, 0); }
__device__ __forceinline__ bf16x8 ld8(const bf16_t* p) { return *(const bf16x8*)p; }

__device__ __forceinline__ void transpose_item(const float* W, int K, size_t ldsrc, int k0, int n_src0, bf16_t* WT, int dst_row0, float* scr, int lane) {
#pragma unroll 8
    for (int i = 0; i < 32; ++i) { const int kk = 2 * i + (lane >> 5); scr[kk * 33 + (lane & 31)] = W[(size_t)(k0 + kk) * ldsrc + n_src0 + (lane & 31)]; }
    __builtin_amdgcn_wave_barrier();
    asm volatile("s_waitcnt lgkmcnt(0)" ::: "memory");
    const int c = lane & 7;
#pragma unroll
    for (int j = 0; j < 4; ++j) { const int n = (lane >> 3) + 8 * j; const float* s = scr + (8 * c) * 33 + n;
        u32x4 o; o.x = pk2(s[0 * 33], s[1 * 33]); o.y = pk2(s[2 * 33], s[3 * 33]); o.z = pk2(s[4 * 33], s[5 * 33]); o.w = pk2(s[6 * 33], s[7 * 33]);
        *(u32x4*)(WT + (size_t)(dst_row0 + n) * K + k0 + 8 * c) = o; }
    asm volatile("s_waitcnt lgkmcnt(0)" ::: "memory");
    __builtin_amdgcn_wave_barrier();
}
__device__ __forceinline__ void convert_weights(const Params& p, int l, char* lds, int gw, int ngw, int wid, int lane) {
    float* scr = (float*)lds + wid * (64 * 33);
    unsigned char* ws = p.ws;
    constexpr int I_IN = 16 * 224, I_QKV = 3 * 4 * 4 * 8, I_SQ = 16 * 32, I_EXP = 3 * 16 * 512;
    constexpr int TOTAL = I_IN + I_QKV + 3 * I_SQ + I_EXP;
    for (int it = gw; it < TOTAL; it += ngw) {
        int r = it;
        if (r < I_IN) { const int kb = r / 224, nb = r % 224, r0 = nb * 32, nsrc = r0 < 2048 ? r0 : r0 + 8;
            transpose_item(p.in[I_WIN] + (size_t)l * D * DIN, D, DIN, kb * 64, nsrc, (bf16_t*)(ws + W_IN_T), r0, scr, lane); continue; }
        r -= I_IN;
        if (r < I_QKV) { const int w = r / 128, rr = r % 128, h = rr / 32, t = rr % 32, kb = t / 8, nb = t % 8;
            const float* src = p.in[w == 0 ? I_WQM : (w == 1 ? I_WKM : I_WVM)] + ((size_t)l * 4 + h) * 65536;
            bf16_t* dst = (bf16_t*)(ws + (w == 0 ? W_Q_T : (w == 1 ? W_K_T : W_V_T))) + (size_t)h * 65536;
            transpose_item(src, 256, 256, kb * 64, nb * 32, dst, nb * 32, scr, lane); continue; }
        r -= I_QKV;
        if (r < 3 * I_SQ) { const int w = r / I_SQ, t = r % I_SQ, kb = t / 32, nb = t % 32;
            const float* src = p.in[w == 0 ? I_WBM : (w == 1 ? I_WBA : I_WOUT)] + (size_t)l * D * D;
            bf16_t* dst = (bf16_t*)(ws + (w == 0 ? W_BM_T : (w == 1 ? W_BA_T : W_OUT_T)));
            transpose_item(src, D, D, kb * 64, nb * 32, dst, nb * 32, scr, lane); continue; }
        r -= 3 * I_SQ;
        { const int w = r / (16 * 512), rr = r % (16 * 512), e = rr / 512, t = rr % 512, kb = t / 32, nb = t % 32;
            const float* src = p.in[w == 0 ? I_WG : (w == 1 ? I_WU : I_WD)] + ((size_t)l * NEXP + e) * D * D;
            bf16_t* dst = (bf16_t*)(ws + (w == 0 ? W_G_T : (w == 1 ? W_U_T : W_D_T))) + (size_t)e * D * D;
            transpose_item(src, D, D, kb * 64, nb * 32, dst, nb * 32, scr, lane); }
    }
}

__device__ __forceinline__ void ln_normalize(f32x4 (&v)[4], const float* g, const float* b, int lane) {
    float s = 0.f;
#pragma unroll
    for (int j = 0; j < 4; ++j) s += (v[j].x + v[j].y) + (v[j].z + v[j].w);
    const float mean = wave_sum(s) * (1.f / D);
    float s2 = 0.f;
#pragma unroll
    for (int j = 0; j < 4; ++j) { v[j] = v[j] - mean; s2 += (v[j].x * v[j].x + v[j].y * v[j].y) + (v[j].z * v[j].z + v[j].w * v[j].w); }
    const float rstd = rsqrtf(wave_sum(s2) * (1.f / D) + LN_EPS);
#pragma unroll
    for (int j = 0; j < 4; ++j) { const f32x4 gg = *(const f32x4*)(g + 4 * lane + 256 * j), bb = *(const f32x4*)(b + 4 * lane + 256 * j); v[j] = v[j] * rstd * gg + bb; }
}
__device__ __forceinline__ void store_row_bf16(bf16_t* row, const f32x4 (&v)[4], int lane) {
#pragma unroll
    for (int j = 0; j < 4; ++j) { u32x2 o; o.x = pk2(v[j].x, v[j].y); o.y = pk2(v[j].z, v[j].w); *(u32x2*)(row + 4 * lane + 256 * j) = o; }
}
__device__ __forceinline__ void store_row_zero(bf16_t* row, int lane) {
#pragma unroll
    for (int j = 0; j < 4; ++j) { u32x2 o; o.x = 0u; o.y = 0u; *(u32x2*)(row + 4 * lane + 256 * j) = o; }
}
__device__ __forceinline__ void load_gate_w(const Params& p, int l, float* g8) {
    const float* w = p.in[I_WIN] + (size_t)l * D * DIN + 2048;
    for (int i = threadIdx.x; i < D * 8; i += NT) { const int k = i >> 3, c = i & 7; g8[i] = w[(size_t)k * DIN + c]; }
    __syncthreads();
}
__device__ __forceinline__ void gates_row(const Params& p, int l, const float* g8, const f32x4 (&v)[4], int prow, int lane) {
    float acc[8];
#pragma unroll
    for (int c = 0; c < 8; ++c) acc[c] = 0.f;
#pragma unroll
    for (int j = 0; j < 4; ++j)
#pragma unroll
        for (int i = 0; i < 4; ++i) { const int k = 4 * lane + 256 * j + i; const float x = v[j][i];
            const f32x4 w0 = *(const f32x4*)(g8 + k * 8), w1 = *(const f32x4*)(g8 + k * 8 + 4);
            acc[0] += x * w0.x; acc[1] += x * w0.y; acc[2] += x * w0.z; acc[3] += x * w0.w; acc[4] += x * w1.x; acc[5] += x * w1.y; acc[6] += x * w1.z; acc[7] += x * w1.w; }
#pragma unroll
    for (int c = 0; c < 8; ++c) acc[c] = wave_sum(acc[c]);
    if (lane < 4) {
        float* gli = (float*)(p.ws + TAB_GLI); float* glf = (float*)(p.ws + TAB_GLF);
        const float bi = p.in[I_BI][l * 4 + lane], bfv = p.in[I_BF][l * 4 + lane];
        float ai = acc[0], af = acc[4];
        if (lane == 1) { ai = acc[1]; af = acc[5]; } else if (lane == 2) { ai = acc[2]; af = acc[6]; } else if (lane == 3) { ai = acc[3]; af = acc[7]; }
        gli[(size_t)lane * P + prow] = ai + bi;
        glf[(size_t)lane * P + prow] = logsigmoidf_(af + bfv);
    }
}
__device__ __forceinline__ void gates_row_pad(const Params& p, int prow, int lane) {
    if (lane < 4) { ((float*)(p.ws + TAB_GLI))[(size_t)lane * P + prow] = NEGBIG; ((float*)(p.ws + TAB_GLF))[(size_t)lane * P + prow] = 0.f; }
}

__device__ __forceinline__ void phase_prologue(const Params& p, char* lds, int bid, int nb) {
    const int tid = threadIdx.x, wid = tid >> 6, lane = tid & 63, gw = bid * NW + wid, ngw = nb * NW;
    convert_weights(p, 0, lds, gw, ngw, wid, lane);
    __syncthreads();
    float* g8 = (float*)lds;
    load_gate_w(p, 0, g8);
    bf16_t* H = (bf16_t*)(p.ws + B_H);
    for (int r = gw; r < P; r += ngw) {
        if (r < VALID0) { store_row_zero(H + (size_t)r * D, lane); gates_row_pad(p, r, lane); continue; }
        const float* src = r < 256 ? p.in[I_META] + (size_t)(r - VALID0) * D : p.in[I_X] + (size_t)(r - 256) * D;
        f32x4 v[4];
#pragma unroll
        for (int j = 0; j < 4; ++j) v[j] = *(const f32x4*)(src + 4 * lane + 256 * j);
        ln_normalize(v, p.in[I_LNG], p.in[I_LNB], lane);
        store_row_bf16(H + (size_t)r * D, v, lane);
        gates_row(p, 0, g8, v, r, lane);
    }
}

struct RowsPlain { const bf16_t* base; size_t ld; __device__ __forceinline__ const bf16_t* row(int m) const { return base + (size_t)m * ld; } };
template <class AR, class BR, class Epi>
__device__ __forceinline__ void sgemm_unit(const AR& ar, const BR& br, int K, int m0, int n0, const Epi& epi) {
    const int tid = threadIdx.x, wid = tid >> 6, lane = tid & 63, c = lane & 15, g = lane >> 4, wr = wid >> 2, wc = wid & 3;
    const int mw = m0 + 64 * wr, nw = n0 + 64 * wc;
    const bf16_t* ap[4]; const bf16_t* bp[4];
#pragma unroll
    for (int i = 0; i < 4; ++i) { ap[i] = ar.row(mw + 16 * i + c) + 8 * g; bp[i] = br.row(nw + 16 * i + c) + 8 * g; }
    f32x4 acc[4][4];
#pragma unroll
    for (int i = 0; i < 4; ++i)
#pragma unroll
        for (int j = 0; j < 4; ++j) acc[i][j] = (f32x4){0.f, 0.f, 0.f, 0.f};
    for (int k0 = 0; k0 < K; k0 += 32) {
        bf16x8 a[4], b[4];
#pragma unroll
        for (int i = 0; i < 4; ++i) { a[i] = ld8(ap[i] + k0); b[i] = ld8(bp[i] + k0); }
#pragma unroll
        for (int i = 0; i < 4; ++i)
#pragma unroll
            for (int j = 0; j < 4; ++j) acc[i][j] = mfma16(b[j], a[i], acc[i][j]);
    }
#pragma unroll
    for (int i = 0; i < 4; ++i)
#pragma unroll
        for (int j = 0; j < 4; ++j) epi(mw + 16 * i + c, nw + 16 * j + 4 * g, acc[i][j]);
}
__device__ __forceinline__ void store4_bf16(bf16_t* dst, f32x4 v) { u32x2 o; o.x = pk2(v.x, v.y); o.y = pk2(v.z, v.w); *(u32x2*)dst = o; }

struct EpiProj { unsigned char* ws;
    __device__ __forceinline__ void operator()(int m, int n, f32x4 v) const {
        const int seg = n >> 10, cc = n & 1023;
        const size_t off = seg == 0 ? B_XM : seg == 1 ? B_OP : seg == 2 ? B_QA : seg == 3 ? B_KA : seg == 5 ? B_GA : B_GB;
        store4_bf16((bf16_t*)(ws + off) + (size_t)m * D + cc, v); } };
struct EpiStore { bf16_t* C; size_t ldc; float scale;
    __device__ __forceinline__ void operator()(int m, int n, f32x4 v) const { store4_bf16(C + (size_t)m * ldc + n, v * scale); } };
__device__ __forceinline__ void phase_proj(const Params& p, char* lds, int bid, int nb) {
    const bf16_t* H = (const bf16_t*)(p.ws + B_H); const bf16_t* W = (const bf16_t*)(p.ws + W_IN_T);
    constexpr int NU_MAIN = 130 * 24, NU_VAT = 8 * 65;
    for (int u = bid; u < NU_MAIN + NU_VAT; u += nb) {
        if (u < NU_MAIN) { const int mt = u / 24; int ct = u % 24; if (ct >= 16) ct += 4;
            sgemm_unit(RowsPlain{H, D}, RowsPlain{W, D}, D, mt * 128, ct * 256, EpiProj{p.ws});
        } else { const int v = u - NU_MAIN, mt = v / 65, ct = v % 65;
            sgemm_unit(RowsPlain{W + (size_t)4096 * D, D}, RowsPlain{H, D}, D, mt * 128, ct * 256, EpiStore{(bf16_t*)(p.ws + B_VAT), P, 1.f}); }
    }
}

__device__ __forceinline__ void phase_attn(const Params& p, int l, char* lds, int bid, int nb) {
    const int tid = threadIdx.x, wid = tid >> 6, lane = tid & 63, c = lane & 15, g = lane >> 4, gw = bid * NW + wid, ngw = nb * NW;
    const bf16_t* QA = (const bf16_t*)(p.ws + B_QA); const bf16_t* KA = (const bf16_t*)(p.ws + B_KA); const bf16_t* VAT = (const bf16_t*)(p.ws + B_VAT);
    bf16_t* YA = (bf16_t*)(p.ws + B_YA);
    const float lam_init = 0.8f - 0.6f * expf(-0.3f * (float)l);
    float lam;
    { const float a = wave_sum(p.in[I_LQ1][l * 64 + lane] * p.in[I_LK1][l * 64 + lane]), b = wave_sum(p.in[I_LQ2][l * 64 + lane] * p.in[I_LK2][l * 64 + lane]);
      lam = expf(a) - expf(b) + lam_init; }
    constexpr int NQG = P / 16, QG0 = VALID0 / 16;
    const int ntask = (NQG - QG0) * 8;
    for (int t = gw; t < ntask; t += ngw) {
        const int qg = NQG - 1 - t / 8, hd = t % 8, q0 = qg * 16, q = q0 + c;
        bf16x8 qf[2][2];
#pragma unroll
        for (int mp = 0; mp < 2; ++mp)
#pragma unroll
            for (int ks = 0; ks < 2; ++ks) qf[mp][ks] = ld8(QA + (size_t)q * D + hd * 128 + mp * 64 + 32 * ks + 8 * g);
        f32x4 o[2][8];
#pragma unroll
        for (int mp = 0; mp < 2; ++mp)
#pragma unroll
            for (int dt = 0; dt < 8; ++dt) o[mp][dt] = (f32x4){0.f, 0.f, 0.f, 0.f};
        float mrun[2] = {NEGBIG, NEGBIG}, lrun[2] = {0.f, 0.f};
        for (int kb = 224; kb <= q0 + 15; kb += 32) {
            bf16x8 pf[2];
#pragma unroll
            for (int mp = 0; mp < 2; ++mp) {
                f32x4 s[2];
#pragma unroll
                for (int a = 0; a < 2; ++a) {
                    s[a] = (f32x4){0.f, 0.f, 0.f, 0.f};
                    const bf16_t* kr = KA + (size_t)(kb + 16 * a + c) * D + hd * 128 + mp * 64 + 8 * g;
#pragma unroll
                    for (int ks = 0; ks < 2; ++ks) s[a] = mfma16(ld8(kr + 32 * ks), qf[mp][ks], s[a]);
                }
                float mx = NEGBIG;
#pragma unroll
                for (int a = 0; a < 2; ++a)
#pragma unroll
                    for (int r = 0; r < 4; ++r) { const int key = kb + 16 * a + 4 * g + r; float v = s[a][r] * 0.125f; v = (key <= q && key >= VALID0) ? v : -INFINITY; s[a][r] = v; mx = fmaxf(mx, v); }
                mx = fmaxf(mx, __shfl_xor(mx, 16)); mx = fmaxf(mx, __shfl_xor(mx, 32));
                const float mn = fmaxf(mrun[mp], mx), alpha = __expf(mrun[mp] - mn);
                mrun[mp] = mn;
                float ps = 0.f;
#pragma unroll
                for (int a = 0; a < 2; ++a)
#pragma unroll
                    for (int r = 0; r < 4; ++r) { const float e = __expf(s[a][r] - mn); s[a][r] = e; ps += e; }
                lrun[mp] = lrun[mp] * alpha + ps;
#pragma unroll
                for (int dt = 0; dt < 8; ++dt) o[mp][dt] = o[mp][dt] * alpha;
                u32x4 w; w.x = pk2(s[0][0], s[0][1]); w.y = pk2(s[0][2], s[0][3]); w.z = pk2(s[1][0], s[1][1]); w.w = pk2(s[1][2], s[1][3]);
                pf[mp] = *(bf16x8*)&w;
            }
#pragma unroll
            for (int dt = 0; dt < 8; ++dt) {
                const bf16_t* vr = VAT + (size_t)(hd * 128 + 16 * dt + c) * P + kb + 4 * g;
                u32x2 v0 = *(const u32x2*)vr, v1 = *(const u32x2*)(vr + 16);
                u32x4 w; w.x = v0.x; w.y = v0.y; w.z = v1.x; w.w = v1.y;
                const bf16x8 vf = *(bf16x8*)&w;
                o[0][dt] = mfma16(vf, pf[0], o[0][dt]);
                o[1][dt] = mfma16(vf, pf[1], o[1][dt]);
            }
        }
        float l0 = lrun[0], l1 = lrun[1];
        l0 += __shfl_xor(l0, 16); l0 += __shfl_xor(l0, 32); l1 += __shfl_xor(l1, 16); l1 += __shfl_xor(l1, 32);
        const float i0 = 1.f / l0, i1 = lam / l1;
        float ss = 0.f;
#pragma unroll
        for (int dt = 0; dt < 8; ++dt) { o[0][dt] = o[0][dt] * i0 - o[1][dt] * i1; ss += (o[0][dt].x * o[0][dt].x + o[0][dt].y * o[0][dt].y) + (o[0][dt].z * o[0][dt].z + o[0][dt].w * o[0][dt].w); }
        ss += __shfl_xor(ss, 16); ss += __shfl_xor(ss, 32);
        const float rs = rsqrtf(ss * (1.f / 128.f) + LN_EPS) * (1.f - lam_init);
#pragma unroll
        for (int dt = 0; dt < 8; ++dt) { const f32x4 gg = *(const f32x4*)(p.in[I_ANG] + l * 128 + 16 * dt + 4 * g);
            store4_bf16(YA + (size_t)q * D + hd * 128 + 16 * dt + 4 * g, o[0][dt] * rs * gg); }
    }
}

__device__ __forceinline__ void phase_conv(const Params& p, int l, char* lds, int bid, int nb) {
    const int tid = threadIdx.x, wid = tid >> 6, lane = tid & 63, gw = bid * NW + wid, ngw = nb * NW;
    const bf16_t* XM = (const bf16_t*)(p.ws + B_XM); bf16_t* XC = (bf16_t*)(p.ws + B_XC);
    const float* cw = p.in[I_CONVW] + (size_t)l * 4 * D; const float* cb = p.in[I_CONVB] + (size_t)l * D;
    const int nitem = P * (D / 8);
    for (int it = bid * NT + tid; it < nitem; it += nb * NT) {
        const int r = it >> 7, c0 = (it & 127) * 8;
        u32x4 o = {0u, 0u, 0u, 0u};
        if (r >= VALID0) {
            float acc[8];
#pragma unroll
            for (int i = 0; i < 8; ++i) acc[i] = cb[c0 + i];
#pragma unroll
            for (int j = 0; j < 4; ++j) { const int rr = r - 3 + j;
                if (rr >= VALID0) { const u32x4 x = *(const u32x4*)(XM + (size_t)rr * D + c0); const float* w = cw + j * D + c0;
                    acc[0] += w[0] * bf2f(x.x & 0xffffu); acc[1] += w[1] * bf2f(x.x >> 16); acc[2] += w[2] * bf2f(x.y & 0xffffu); acc[3] += w[3] * bf2f(x.y >> 16);
                    acc[4] += w[4] * bf2f(x.z & 0xffffu); acc[5] += w[5] * bf2f(x.z >> 16); acc[6] += w[6] * bf2f(x.w & 0xffffu); acc[7] += w[7] * bf2f(x.w >> 16); } }
            o.x = pk2(siluf_(acc[0]), siluf_(acc[1])); o.y = pk2(siluf_(acc[2]), siluf_(acc[3])); o.z = pk2(siluf_(acc[4]), siluf_(acc[5])); o.w = pk2(siluf_(acc[6]), siluf_(acc[7]));
        }
        *(u32x4*)(XC + (size_t)r * D + c0) = o;
    }
    const float* gli = (const float*)(p.ws + TAB_GLI); const float* glf = (const float*)(p.ws + TAB_GLF);
    float* tb = (float*)(p.ws + TAB_B); float* te = (float*)(p.ws + TAB_E); float* tpm = (float*)(p.ws + TAB_PM); float* tw = (float*)(p.ws + TAB_W);
    float* scg = (float*)(p.ws + TAB_SCG); float* scm = (float*)(p.ws + TAB_SCM);
    for (int t = gw; t < NSC * 4; t += ngw) {
        const int sc = t >> 2, h = t & 3; const size_t base = (size_t)h * P + sc * 256 + 4 * lane;
        const f32x4 lf = *(const f32x4*)(glf + base), li = *(const f32x4*)(gli + base);
        float b[4]; b[0] = lf.x; b[1] = b[0] + lf.y; b[2] = b[1] + lf.z; b[3] = b[2] + lf.w;
        float incl = b[3];
#pragma unroll
        for (int o = 1; o < 64; o <<= 1) { const float n = __shfl_up(incl, o); if (lane >= o) incl += n; }
        const float excl = incl - b[3];
        float e[4], pm[4];
#pragma unroll
        for (int i = 0; i < 4; ++i) { b[i] += excl; e[i] = li[i] - b[i]; }
        pm[0] = e[0]; pm[1] = fmaxf(pm[0], e[1]); pm[2] = fmaxf(pm[1], e[2]); pm[3] = fmaxf(pm[2], e[3]);
        float mi = pm[3];
#pragma unroll
        for (int o = 1; o < 64; o <<= 1) { const float n = __shfl_up(mi, o); if (lane >= o) mi = fmaxf(mi, n); }
        float mex = __shfl_up(mi, 1); if (lane == 0) mex = -INFINITY;
#pragma unroll
        for (int i = 0; i < 4; ++i) pm[i] = fmaxf(pm[i], mex);
        const float gtot = __shfl(incl, 63), emax = __shfl(mi, 63), mloc = gtot + emax;
        f32x4 ww;
#pragma unroll
        for (int i = 0; i < 4; ++i) ww[i] = __expf(e[i] + gtot - mloc);
        *(f32x4*)(tb + base) = (f32x4){b[0], b[1], b[2], b[3]};
        *(f32x4*)(te + base) = (f32x4){e[0], e[1], e[2], e[3]};
        *(f32x4*)(tpm + base) = (f32x4){pm[0], pm[1], pm[2], pm[3]};
        *(f32x4*)(tw + base) = ww;
        if (lane == 0) { scg[sc * 4 + h] = gtot; scm[sc * 4 + h] = mloc; }
    }
}

__device__ __forceinline__ void phase_mqkv(const Params& p, char* lds, int bid, int nb) {
    const bf16_t* XC = (const bf16_t*)(p.ws + B_XC); const bf16_t* XM = (const bf16_t*)(p.ws + B_XM);
    const bf16_t* WQ = (const bf16_t*)(p.ws + W_Q_T); const bf16_t* WK = (const bf16_t*)(p.ws + W_K_T); const bf16_t* WV = (const bf16_t*)(p.ws + W_V_T);
    bf16_t* QM = (bf16_t*)(p.ws + B_QM); bf16_t* KM = (bf16_t*)(p.ws + B_KM); bf16_t* KMT = (bf16_t*)(p.ws + B_KMT); bf16_t* VMT = (bf16_t*)(p.ws + B_VMT);
    for (int u = bid; u < 4 * 520; u += nb) {
        const int w = u / 520, r = u % 520, h = r / 130, t = r % 130;
        if (w == 0) sgemm_unit(RowsPlain{XC + h * 256, D}, RowsPlain{WQ + (size_t)h * 65536, 256}, 256, t * 128, 0, EpiStore{QM + h * 256, D, 1.f});
        else if (w == 1) sgemm_unit(RowsPlain{XC + h * 256, D}, RowsPlain{WK + (size_t)h * 65536, 256}, 256, t * 128, 0, EpiStore{KM + h * 256, D, 0.0625f});
        else if (w == 2) sgemm_unit(RowsPlain{WK + (size_t)h * 65536, 256}, RowsPlain{XC + h * 256, D}, 256, (t / 65) * 128, (t % 65) * 256, EpiStore{KMT + (size_t)h * 256 * P, P, 0.0625f});
        else sgemm_unit(RowsPlain{WV + (size_t)h * 65536, 256}, RowsPlain{XM + h * 256, D}, 256, (t / 65) * 128, (t % 65) * 256, EpiStore{VMT + (size_t)h * 256 * P, P, 1.f});
    }
}

__device__ __forceinline__ void phase_m1(const Params& p, char* lds, int bid, int nb) {
    const int tid = threadIdx.x, wid = tid >> 6, lane = tid & 63, c = lane & 15, g = lane >> 4, gw = bid * NW + wid, ngw = nb * NW;
    const bf16_t* KMT = (const bf16_t*)(p.ws + B_KMT); const bf16_t* VMT = (const bf16_t*)(p.ws + B_VMT);
    const float* tw = (const float*)(p.ws + TAB_W); bf16_t* CT = (bf16_t*)(p.ws + B_CT); float* NTv = (float*)(p.ws + TAB_NT);
    for (int t = gw; t < NSC * 4 * 16; t += ngw) {
        const int dvb = t & 15, h = (t >> 4) & 3, sc = t >> 6, s0 = sc * 256;
        f32x4 acc[16];
#pragma unroll
        for (int i = 0; i < 16; ++i) acc[i] = (f32x4){0.f, 0.f, 0.f, 0.f};
        float un[16];
#pragma unroll
        for (int i = 0; i < 16; ++i) un[i] = 0.f;
        for (int ks = 0; ks < 8; ++ks) {
            const int sb = s0 + 32 * ks + 8 * g;
            const f32x4 w0 = *(const f32x4*)(tw + (size_t)h * P + sb), w1 = *(const f32x4*)(tw + (size_t)h * P + sb + 4);
            const u32x4 vv = *(const u32x4*)(VMT + (size_t)(h * 256 + 16 * dvb + c) * P + sb);
            u32x4 vw; vw.x = pk2(bf2f(vv.x & 0xffffu) * w0.x, bf2f(vv.x >> 16) * w0.y); vw.y = pk2(bf2f(vv.y & 0xffffu) * w0.z, bf2f(vv.y >> 16) * w0.w);
            vw.z = pk2(bf2f(vv.z & 0xffffu) * w1.x, bf2f(vv.z >> 16) * w1.y); vw.w = pk2(bf2f(vv.w & 0xffffu) * w1.z, bf2f(vv.w >> 16) * w1.w);
            const bf16x8 vf = *(bf16x8*)&vw;
#pragma unroll
            for (int dk = 0; dk < 16; ++dk) {
                const u32x4 kk = *(const u32x4*)(KMT + (size_t)(h * 256 + 16 * dk + c) * P + sb);
                acc[dk] = mfma16(*(const bf16x8*)&kk, vf, acc[dk]);
                if (dvb == 0) un[dk] += bf2f(kk.x & 0xffffu) * w0.x + bf2f(kk.x >> 16) * w0.y + bf2f(kk.y & 0xffffu) * w0.z + bf2f(kk.y >> 16) * w0.w
                                      + bf2f(kk.z & 0xffffu) * w1.x + bf2f(kk.z >> 16) * w1.y + bf2f(kk.w & 0xffffu) * w1.z + bf2f(kk.w >> 16) * w1.w;
            }
        }
        bf16_t* dst = CT + ((size_t)(sc * 4 + h) * 256 + 16 * dvb + c) * 256;
#pragma unroll
        for (int dk = 0; dk < 16; ++dk) store4_bf16(dst + 16 * dk + 4 * g, acc[dk]);
        if (dvb == 0) {
#pragma unroll
            for (int dk = 0; dk < 16; ++dk) { float v = un[dk]; v += __shfl_xor(v, 16); v += __shfl_xor(v, 32); if (g == 0) NTv[(size_t)(sc * 4 + h) * 256 + 16 * dk + c] = v; }
        }
    }
}

__device__ __forceinline__ void phase_m2(const Params& p, char* lds, int bid, int nb) {
    const float* scg = (const float*)(p.ws + TAB_SCG); const float* scm = (const float*)(p.ws + TAB_SCM);
    unsigned* CT = (unsigned*)(p.ws + B_CT); float* NTv = (float*)(p.ws + TAB_NT); float* mt = (float*)(p.ws + TAB_MT);
    const int gid = bid * NT + threadIdx.x, nth = nb * NT;
    for (int i = gid; i < 4 * 32768 + 1024; i += nth) {
        if (i < 4 * 32768) {
            const int h = i >> 15, idx = i & 32767;
            float m = 0.f, c0 = 0.f, c1 = 0.f;
            for (int sc = 0; sc < NSC; ++sc) {
                const float gg = scg[sc * 4 + h], ml = scm[sc * 4 + h], mn = fmaxf(gg + m, ml), dec = __expf(gg + m - mn), cor = __expf(ml - mn);
                unsigned* ptr = CT + (size_t)(sc * 4 + h) * 32768 + idx; const unsigned u = *ptr;
                c0 = dec * c0 + cor * bf2f(u & 0xffffu); c1 = dec * c1 + cor * bf2f(u >> 16);
                *ptr = pk2(c0, c1); m = mn;
            }
        } else {
            const int j = i - 4 * 32768, h = j >> 8, d = j & 255;
            float m = 0.f, n = 0.f;
            for (int sc = 0; sc < NSC; ++sc) {
                const float gg = scg[sc * 4 + h], ml = scm[sc * 4 + h], mn = fmaxf(gg + m, ml), dec = __expf(gg + m - mn), cor = __expf(ml - mn);
                float* ptr = NTv + (size_t)(sc * 4 + h) * 256 + d;
                n = dec * n + cor * *ptr; *ptr = n; m = mn;
                if (d == 0) mt[sc * 4 + h] = mn;
            }
        }
    }
}

__device__ __forceinline__ void phase_m3(const Params& p, int l, char* lds, int bid, int nb) {
    const int tid = threadIdx.x, wid = tid >> 6, lane = tid & 63, c = lane & 15, g = lane >> 4, gw = bid * NW + wid, ngw = nb * NW;
    const bf16_t* QM = (const bf16_t*)(p.ws + B_QM); const bf16_t* KM = (const bf16_t*)(p.ws + B_KM); const bf16_t* VMT = (const bf16_t*)(p.ws + B_VMT);
    const bf16_t* CT = (const bf16_t*)(p.ws + B_CT); const float* NTv = (const float*)(p.ws + TAB_NT); const float* mt = (const float*)(p.ws + TAB_MT);
    const float* tb = (const float*)(p.ws + TAB_B); const float* te = (const float*)(p.ws + TAB_E); const float* tpm = (const float*)(p.ws + TAB_PM);
    const bf16_t* OP = (const bf16_t*)(p.ws + B_OP); bf16_t* YM = (bf16_t*)(p.ws + B_YM);
    constexpr int NRG = P / 16, RG0 = VALID0 / 16;
    const int ntask = (NRG - RG0) * 4;
    for (int t = gw; t < ntask; t += ngw) {
        const int rg = NRG - 1 - t / 4, h = t % 4, t0 = rg * 16, row = t0 + c, sc = t0 >> 8, s_start = sc << 8;
        bf16x8 qf[8];
#pragma unroll
        for (int ks = 0; ks < 8; ++ks) qf[ks] = ld8(QM + (size_t)row * D + h * 256 + 32 * ks + 8 * g);
        const float b_t = tb[(size_t)h * P + row], pm_t = tpm[(size_t)h * P + row];
        const float m_prev = sc > 0 ? mt[(sc - 1) * 4 + h] : 0.f;
        const float m_t = b_t + fmaxf(m_prev, pm_t), scale_t = __expf(b_t + m_prev - m_t);
        f32x4 acc[16];
#pragma unroll
        for (int i = 0; i < 16; ++i) acc[i] = (f32x4){0.f, 0.f, 0.f, 0.f};
        float den = 0.f;
        if (sc > 0) {
            const bf16_t* Cb = CT + (size_t)((sc - 1) * 4 + h) * 65536; const float* nv = NTv + (size_t)((sc - 1) * 4 + h) * 256;
#pragma unroll 2
            for (int ks = 0; ks < 8; ++ks) {
#pragma unroll
                for (int dt = 0; dt < 16; ++dt) acc[dt] = mfma16(ld8(Cb + (size_t)(16 * dt + c) * 256 + 32 * ks + 8 * g), qf[ks], acc[dt]);
                const f32x4 n0 = *(const f32x4*)(nv + 32 * ks + 8 * g), n1 = *(const f32x4*)(nv + 32 * ks + 8 * g + 4);
                const u32x4 qq = *(const u32x4*)&qf[ks];
                den += bf2f(qq.x & 0xffffu) * n0.x + bf2f(qq.x >> 16) * n0.y + bf2f(qq.y & 0xffffu) * n0.z + bf2f(qq.y >> 16) * n0.w
                     + bf2f(qq.z & 0xffffu) * n1.x + bf2f(qq.z >> 16) * n1.y + bf2f(qq.w & 0xffffu) * n1.z + bf2f(qq.w >> 16) * n1.w;
            }
            den *= scale_t;
#pragma unroll
            for (int dt = 0; dt < 16; ++dt) acc[dt] = acc[dt] * scale_t;
        }
        for (int kb = s_start; kb <= t0 + 15; kb += 32) {
            f32x4 s[2];
#pragma unroll
            for (int a = 0; a < 2; ++a) {
                s[a] = (f32x4){0.f, 0.f, 0.f, 0.f};
                const bf16_t* kr = KM + (size_t)(kb + 16 * a + c) * D + h * 256 + 8 * g;
#pragma unroll
                for (int ks = 0; ks < 8; ++ks) s[a] = mfma16(ld8(kr + 32 * ks), qf[ks], s[a]);
                const f32x4 ee = *(const f32x4*)(te + (size_t)h * P + kb + 16 * a + 4 * g);
#pragma unroll
                for (int r = 0; r < 4; ++r) { const int key = kb + 16 * a + 4 * g + r; const float arg = fminf(ee[r] + b_t - m_t, 0.f);
                    const float dd = key <= row ? __expf(arg) : 0.f; const float pv = s[a][r] * dd; s[a][r] = pv; den += pv; }
            }
            u32x4 w; w.x = pk2(s[0][0], s[0][1]); w.y = pk2(s[0][2], s[0][3]); w.z = pk2(s[1][0], s[1][1]); w.w = pk2(s[1][2], s[1][3]);
            const bf16x8 pf = *(bf16x8*)&w;
#pragma unroll
            for (int dt = 0; dt < 16; ++dt) {
                const bf16_t* vr = VMT + (size_t)(h * 256 + 16 * dt + c) * P + kb + 4 * g;
                const u32x2 v0 = *(const u32x2*)vr, v1 = *(const u32x2*)(vr + 16);
                u32x4 vv; vv.x = v0.x; vv.y = v0.y; vv.z = v1.x; vv.w = v1.y;
                acc[dt] = mfma16(*(bf16x8*)&vv, pf, acc[dt]);
            }
        }
        den += __shfl_xor(den, 16); den += __shfl_xor(den, 32);
        const float inv = 1.f / fmaxf(fabsf(den), __expf(-m_t));
        float s1 = 0.f;
#pragma unroll
        for (int dt = 0; dt < 16; ++dt) {
            const u32x2 og = *(const u32x2*)(OP + (size_t)row * D + h * 256 + 16 * dt + 4 * g);
            f32x4 v = acc[dt] * inv;
            v.x *= sigmoidf_(bf2f(og.x & 0xffffu)); v.y *= sigmoidf_(bf2f(og.x >> 16)); v.z *= sigmoidf_(bf2f(og.y & 0xffffu)); v.w *= sigmoidf_(bf2f(og.y >> 16));
            acc[dt] = v; s1 += (v.x + v.y) + (v.z + v.w);
        }
        s1 += __shfl_xor(s1, 16); s1 += __shfl_xor(s1, 32);
        const float mu = s1 * (1.f / 256.f);
        float s2 = 0.f;
#pragma unroll
        for (int dt = 0; dt < 16; ++dt) { acc[dt] = acc[dt] - mu; s2 += (acc[dt].x * acc[dt].x + acc[dt].y * acc[dt].y) + (acc[dt].z * acc[dt].z + acc[dt].w * acc[dt].w); }
        s2 += __shfl_xor(s2, 16); s2 += __shfl_xor(s2, 32);
        const float rstd = rsqrtf(s2 * (1.f / 256.f) + LN_EPS);
#pragma unroll
        for (int dt = 0; dt < 16; ++dt) { const f32x4 gg = *(const f32x4*)(p.in[I_MNG] + (size_t)l * D + h * 256 + 16 * dt + 4 * g);
            store4_bf16(YM + (size_t)row * D + h * 256 + 16 * dt + 4 * g, acc[dt] * rstd * gg); }
    }
}

struct EpiBr1 { float* MRG; const bf16_t* GA;
    __device__ __forceinline__ void operator()(int m, int n, f32x4 v) const { const u32x2 gg = *(const u32x2*)(GA + (size_t)m * D + n);
        f32x4 o; o.x = v.x * sigmoidf_(bf2f(gg.x & 0xffffu)); o.y = v.y * sigmoidf_(bf2f(gg.x >> 16)); o.z = v.z * sigmoidf_(bf2f(gg.y & 0xffffu)); o.w = v.w * sigmoidf_(bf2f(gg.y >> 16));
        *(f32x4*)(MRG + (size_t)m * D + n) = o; } };
struct EpiBr2 { const float* MRG; const bf16_t* GB; bf16_t* OUT;
    __device__ __forceinline__ void operator()(int m, int n, f32x4 v) const { const u32x2 gg = *(const u32x2*)(GB + (size_t)m * D + n); const f32x4 t = *(const f32x4*)(MRG + (size_t)m * D + n);
        f32x4 o; o.x = t.x + v.x * sigmoidf_(bf2f(gg.x & 0xffffu)); o.y = t.y + v.y * sigmoidf_(bf2f(gg.x >> 16)); o.z = t.z + v.z * sigmoidf_(bf2f(gg.y & 0xffffu)); o.w = t.w + v.w * sigmoidf_(bf2f(gg.y >> 16));
        store4_bf16(OUT + (size_t)m * D + n, o); } };
struct EpiOut { float* Z; const bf16_t* H;
    __device__ __forceinline__ void operator()(int m, int n, f32x4 v) const { const u32x2 hh = *(const u32x2*)(H + (size_t)m * D + n);
        f32x4 o; o.x = v.x + DN_ALPHA * bf2f(hh.x & 0xffffu); o.y = v.y + DN_ALPHA * bf2f(hh.x >> 16); o.z = v.z + DN_ALPHA * bf2f(hh.y & 0xffffu); o.w = v.w + DN_ALPHA * bf2f(hh.y >> 16);
        *(f32x4*)(Z + (size_t)m * D + n) = o; } };
__device__ __forceinline__ void phase_br1(const Params& p, char* lds, int bid, int nb) {
    for (int u = bid; u < 130 * 4; u += nb)
        sgemm_unit(RowsPlain{(const bf16_t*)(p.ws + B_YM), D}, RowsPlain{(const bf16_t*)(p.ws + W_BM_T), D}, D, (u >> 2) * 128, (u & 3) * 256, EpiBr1{(float*)(p.ws + B_MRG), (const bf16_t*)(p.ws + B_GA)});
}
__device__ __forceinline__ void phase_br2(const Params& p, char* lds, int bid, int nb) {
    for (int u = bid; u < 130 * 4; u += nb)
        sgemm_unit(RowsPlain{(const bf16_t*)(p.ws + B_YA), D}, RowsPlain{(const bf16_t*)(p.ws + W_BA_T), D}, D, (u >> 2) * 128, (u & 3) * 256,
                   EpiBr2{(const float*)(p.ws + B_MRG), (const bf16_t*)(p.ws + B_GB), (bf16_t*)(p.ws + B_MRGB)});
}
__device__ __forceinline__ void phase_out(const Params& p, char* lds, int bid, int nb) {
    for (int u = bid; u < 130 * 4; u += nb)
        sgemm_unit(RowsPlain{(const bf16_t*)(p.ws + B_MRGB), D}, RowsPlain{(const bf16_t*)(p.ws + W_OUT_T), D}, D, (u >> 2) * 128, (u & 3) * 256, EpiOut{(float*)(p.ws + B_Z), (const bf16_t*)(p.ws + B_H)});
}

__device__ __forceinline__ void phase_ln1(const Params& p, int l, char* lds, int bid, int nb) {
    const int tid = threadIdx.x, wid = tid >> 6, lane = tid & 63, gw = bid * NW + wid, ngw = nb * NW;
    float* wr = (float*)lds;
    for (int i = tid; i < D * 16 / 4; i += NT) ((f32x4*)wr)[i] = ((const f32x4*)p.in[I_WR])[i];
    __syncthreads();
    const float* Z = (const float*)(p.ws + B_Z); bf16_t* H1 = (bf16_t*)(p.ws + B_H1);
    unsigned* cnt = (unsigned*)(p.ws + WS_CTL) + CW_CNT + l * 16; int* elist = (int*)(p.ws + TAB_ELIST); float* topk = (float*)(p.ws + TAB_TOPK);
    for (int r = gw; r < P; r += ngw) {
        if (r < VALID0) { store_row_zero(H1 + (size_t)r * D, lane); continue; }
        f32x4 v[4];
#pragma unroll
        for (int j = 0; j < 4; ++j) v[j] = *(const f32x4*)(Z + (size_t)r * D + 4 * lane + 256 * j);
        ln_normalize(v, p.in[I_LN1G] + (size_t)l * D, p.in[I_LN1B] + (size_t)l * D, lane);
        store_row_bf16(H1 + (size_t)r * D, v, lane);
        float lg[16];
#pragma unroll
        for (int e = 0; e < 16; ++e) lg[e] = 0.f;
#pragma unroll
        for (int j = 0; j < 4; ++j)
#pragma unroll
            for (int i = 0; i < 4; ++i) { const int k = 4 * lane + 256 * j + i; const float x = v[j][i];
#pragma unroll
                for (int q = 0; q < 4; ++q) { const f32x4 w = *(const f32x4*)(wr + k * 16 + 4 * q); lg[4 * q] += x * w.x; lg[4 * q + 1] += x * w.y; lg[4 * q + 2] += x * w.z; lg[4 * q + 3] += x * w.w; } }
#pragma unroll
        for (int e = 0; e < 16; ++e) lg[e] = wave_sum(lg[e]);
        if (lane == 0) {
            float mx = lg[0];
#pragma unroll
            for (int e = 1; e < 16; ++e) mx = fmaxf(mx, lg[e]);
            float pr[16], sum = 0.f;
#pragma unroll
            for (int e = 0; e < 16; ++e) { pr[e] = expf(lg[e] - mx); sum += pr[e]; }
            const float isum = 1.f / sum;
            float sel[16];
#pragma unroll
            for (int e = 0; e < 16; ++e) { pr[e] *= isum; sel[e] = pr[e] + p.in[I_RB][e]; }
            int tg = 0; float best = -INFINITY;
#pragma unroll
            for (int gI = 0; gI < 4; ++gI) { const float gs = fmaxf(fmaxf(sel[4 * gI], sel[4 * gI + 1]), fmaxf(sel[4 * gI + 2], sel[4 * gI + 3])); if (gs > best) { best = gs; tg = gI; } }
            int i0 = 0; float b0 = -INFINITY;
#pragma unroll
            for (int e = 0; e < 16; ++e) if ((e >> 2) == tg && sel[e] > b0) { b0 = sel[e]; i0 = e; }
            int i1 = 0; float b1 = -INFINITY;
#pragma unroll
            for (int e = 0; e < 16; ++e) if ((e >> 2) == tg && e != i0 && sel[e] > b1) { b1 = sel[e]; i1 = e; }
            float p0 = 0.f, p1 = 0.f;
#pragma unroll
            for (int e = 0; e < 16; ++e) { if (e == i0) p0 = pr[e]; if (e == i1) p1 = pr[e]; }
            const float inv = 1.f / (p0 + p1);
            const unsigned pos0 = atomicAdd(cnt + i0, 1u), pos1 = atomicAdd(cnt + i1, 1u);
            elist[(size_t)i0 * P + pos0] = r; elist[(size_t)i1 * P + pos1] = r;
            float* tk = topk + (size_t)r * 8;
            ((int*)tk)[0] = i0; ((int*)tk)[1] = i1; ((int*)tk)[2] = (int)pos0; ((int*)tk)[3] = (int)pos1; tk[4] = p0 * inv; tk[5] = p1 * inv;
        }
    }
}

__device__ __forceinline__ void expert_offsets(const unsigned* cnt, int* s_cnt, int* s_off, int* s_tiles) {
    int off = 0;
    if (threadIdx.x == 0) { int tt = 0; for (int e = 0; e < 16; ++e) { const int c = (int)cnt[e]; const int tl = (c + 127) >> 7; s_cnt[e] = c; s_off[e] = off; s_tiles[e] = tt; off += tl * 128; tt += tl; } s_tiles[16] = tt; }
    __syncthreads();
}
__device__ __forceinline__ void phase_e1(const Params& p, int l, char* lds, int bid, int nb) {
    int* s_cnt = (int*)lds; int* s_off = s_cnt + 16; int* s_tiles = s_off + 16;
    expert_offsets((const unsigned*)(p.ws + WS_CTL) + CW_CNT + l * 16, s_cnt, s_off, s_tiles);
    const int tid = threadIdx.x, wid = tid >> 6, lane = tid & 63, c = lane & 15, g = lane >> 4, wr = wid >> 2, wc = wid & 3;
    const bf16_t* H1 = (const bf16_t*)(p.ws + B_H1); const int* elist = (const int*)(p.ws + TAB_ELIST); bf16_t* HID = (bf16_t*)(p.ws + B_HID);
    const int total = s_tiles[16] * 8;
    for (int u = bid; u < total; u += nb) {
        const int rt = u >> 3, ct = u & 7; int e = 0;
        while (e < 15 && rt >= s_tiles[e + 1]) ++e;
        const int ti = rt - s_tiles[e], cntE = s_cnt[e], r0 = ti * 128 + 64 * wr, n0 = ct * 128 + 32 * wc;
        const bf16_t* Wg = (const bf16_t*)(p.ws + W_G_T) + (size_t)e * D * D; const bf16_t* Wu = (const bf16_t*)(p.ws + W_U_T) + (size_t)e * D * D;
        const bf16_t* ap[4];
#pragma unroll
        for (int i = 0; i < 4; ++i) { const int rr = r0 + 16 * i + c; const int tok = elist[(size_t)e * P + (rr < cntE ? rr : 0)]; ap[i] = H1 + (size_t)tok * D + 8 * g; }
        const bf16_t* gp[2]; const bf16_t* up[2];
#pragma unroll
        for (int j = 0; j < 2; ++j) { gp[j] = Wg + (size_t)(n0 + 16 * j + c) * D + 8 * g; up[j] = Wu + (size_t)(n0 + 16 * j + c) * D + 8 * g; }
        f32x4 ag[4][2], au[4][2];
#pragma unroll
        for (int i = 0; i < 4; ++i)
#pragma unroll
            for (int j = 0; j < 2; ++j) { ag[i][j] = (f32x4){0.f, 0.f, 0.f, 0.f}; au[i][j] = (f32x4){0.f, 0.f, 0.f, 0.f}; }
        for (int k0 = 0; k0 < D; k0 += 32) {
            bf16x8 a[4], bg[2], bu[2];
#pragma unroll
            for (int i = 0; i < 4; ++i) a[i] = ld8(ap[i] + k0);
#pragma unroll
            for (int j = 0; j < 2; ++j) { bg[j] = ld8(gp[j] + k0); bu[j] = ld8(up[j] + k0); }
#pragma unroll
            for (int i = 0; i < 4; ++i)
#pragma unroll
                for (int j = 0; j < 2; ++j) { ag[i][j] = mfma16(bg[j], a[i], ag[i][j]); au[i][j] = mfma16(bu[j], a[i], au[i][j]); }
        }
#pragma unroll
        for (int i = 0; i < 4; ++i)
#pragma unroll
            for (int j = 0; j < 2; ++j) { f32x4 o;
#pragma unroll
                for (int r = 0; r < 4; ++r) o[r] = siluf_(ag[i][j][r]) * au[i][j][r];
                store4_bf16(HID + (size_t)(s_off[e] + r0 + 16 * i + c) * D + n0 + 16 * j + 4 * g, o); }
    }
}
__device__ __forceinline__ void phase_e2(const Params& p, int l, char* lds, int bid, int nb) {
    int* s_cnt = (int*)lds; int* s_off = s_cnt + 16; int* s_tiles = s_off + 16;
    expert_offsets((const unsigned*)(p.ws + WS_CTL) + CW_CNT + l * 16, s_cnt, s_off, s_tiles);
    const bf16_t* HID = (const bf16_t*)(p.ws + B_HID); bf16_t* YB = (bf16_t*)(p.ws + B_YB);
    const int total = s_tiles[16] * 4;
    for (int u = bid; u < total; u += nb) {
        const int rt = u >> 2, ct = u & 3; int e = 0;
        while (e < 15 && rt >= s_tiles[e + 1]) ++e;
        const int ti = rt - s_tiles[e];
        sgemm_unit(RowsPlain{HID + (size_t)s_off[e] * D, D}, RowsPlain{(const bf16_t*)(p.ws + W_D_T) + (size_t)e * D * D, D}, D, ti * 128, ct * 256, EpiStore{YB + (size_t)s_off[e] * D, D, 1.f});
    }
}
__device__ __forceinline__ void phase_combine(const Params& p, int l, char* lds, int bid, int nb) {
    const int tid = threadIdx.x, wid = tid >> 6, lane = tid & 63, gw = bid * NW + wid, ngw = nb * NW;
    const bool last = (l == DEPTH - 1);
    if (!last) { convert_weights(p, l + 1, lds, gw, ngw, wid, lane); __syncthreads(); }
    int* s_cnt = (int*)(lds + 65536); int* s_off = s_cnt + 16; int* s_tiles = s_off + 16;
    expert_offsets((const unsigned*)(p.ws + WS_CTL) + CW_CNT + l * 16, s_cnt, s_off, s_tiles);
    float* g8 = (float*)lds;
    if (!last) load_gate_w(p, l + 1, g8);
    const bf16_t* H1 = (const bf16_t*)(p.ws + B_H1); const bf16_t* YB = (const bf16_t*)(p.ws + B_YB); bf16_t* H = (bf16_t*)(p.ws + B_H);
    const float* topk = (const float*)(p.ws + TAB_TOPK);
    for (int r = gw; r < P; r += ngw) {
        if (r < VALID0) { if (!last) { store_row_zero(H + (size_t)r * D, lane); gates_row_pad(p, r, lane); } continue; }
        if (last && r < 256) continue;
        const float* tk = topk + (size_t)r * 8;
        const int e0 = ((const int*)tk)[0], e1 = ((const int*)tk)[1], p0 = ((const int*)tk)[2], p1 = ((const int*)tk)[3]; const float w0 = tk[4], w1 = tk[5];
        const bf16_t* y0 = YB + (size_t)(s_off[e0] + p0) * D; const bf16_t* y1 = YB + (size_t)(s_off[e1] + p1) * D; const bf16_t* hr = H1 + (size_t)r * D;
        f32x4 v[4];
#pragma unroll
        for (int j = 0; j < 4; ++j) { const int cc = 4 * lane + 256 * j; const u32x2 a = *(const u32x2*)(y0 + cc), b = *(const u32x2*)(y1 + cc), hh = *(const u32x2*)(hr + cc);
            v[j].x = DN_ALPHA * bf2f(hh.x & 0xffffu) + w0 * bf2f(a.x & 0xffffu) + w1 * bf2f(b.x & 0xffffu);
            v[j].y = DN_ALPHA * bf2f(hh.x >> 16) + w0 * bf2f(a.x >> 16) + w1 * bf2f(b.x >> 16);
            v[j].z = DN_ALPHA * bf2f(hh.y & 0xffffu) + w0 * bf2f(a.y & 0xffffu) + w1 * bf2f(b.y & 0xffffu);
            v[j].w = DN_ALPHA * bf2f(hh.y >> 16) + w0 * bf2f(a.y >> 16) + w1 * bf2f(b.y >> 16); }
        ln_normalize(v, p.in[I_LN2G] + (size_t)l * D, p.in[I_LN2B] + (size_t)l * D, lane);
        if (last) {
            float* o = p.out + (size_t)(r - 256) * D;
#pragma unroll
            for (int j = 0; j < 4; ++j) *(f32x4*)(o + 4 * lane + 256 * j) = v[j];
        } else { store_row_bf16(H + (size_t)r * D, v, lane); gates_row(p, l + 1, g8, v, r, lane); }
    }
}

#define XB_TMO      128
#define XB_XCNT(j)  (256  + 64 * (j))
#define XB_XSUB(j)  (1280 + 64 * (j))
#define XB_XGEN(j)  (2304 + 64 * (j))
#define XB_TOP      3328
#define XB_TOPGEN   3392
#define XCD_BAR_WORDS 3456
#define XB_SPIN_CAP (1u << 18)
#define LAS __attribute__((address_space(3)))

__device__ __forceinline__ unsigned xb_ld(unsigned* p)              { return __hip_atomic_load(p, __ATOMIC_RELAXED, __HIP_MEMORY_SCOPE_AGENT); }
__device__ __forceinline__ unsigned xb_add(unsigned* p, unsigned v) { return __hip_atomic_fetch_add(p, v, __ATOMIC_RELAXED, __HIP_MEMORY_SCOPE_AGENT); }
__device__ __forceinline__ unsigned xb_xcc_id() { return (unsigned)__builtin_amdgcn_s_getreg((3 << 11) | 20) & 0xFu; }
#define XB_SPIN(cond, bar) do { unsigned _sp = 0; while (cond) { __builtin_amdgcn_s_sleep(1); \
    if ((++_sp & 255u) == 0u) { if (xb_ld(&(bar)[XB_TMO])) break; if (_sp > XB_SPIN_CAP) { atomicAdd(&(bar)[XB_TMO], 1u); break; } } } } while (0)

struct XcdBarrier {
    unsigned* bar; unsigned x;
    volatile LAS unsigned* st;
};
__device__ __forceinline__ XcdBarrier xcd_barrier_post(unsigned* bar, volatile LAS unsigned* st) {
    XcdBarrier b; b.bar = bar; b.x = xb_xcc_id(); b.st = st;
    if (threadIdx.x == 0) (void)xb_add(&bar[XB_XCNT(b.x)], 1u);
    return b;
}
__device__ __forceinline__ void xcd_barrier_complete(unsigned* bar, unsigned x, unsigned& nloc, unsigned& nx) {
    const unsigned G = gridDim.x * gridDim.y * gridDim.z;
    unsigned sum, cnt, mine, sp = 0u;
    for (;;) {
        sum = 0u; cnt = 0u; mine = 0u;
#pragma unroll
        for (unsigned j = 0; j < 16; ++j) { const unsigned c = xb_ld(&bar[XB_XCNT(j)]); sum += c; cnt += (c > 0u) ? 1u : 0u; mine = (j == x) ? c : mine; }
        if (sum == G) break;
        __builtin_amdgcn_s_sleep(1);
        if ((++sp & 255u) == 0u) { if (xb_ld(&bar[XB_TMO])) break; if (sp > XB_SPIN_CAP) { atomicAdd(&bar[XB_TMO], 1u); break; } }
    }
    nloc = mine > 0u ? mine : 1u; nx = cnt > 0u ? cnt : 1u;
}
__device__ __forceinline__ void xcd_barrier(const XcdBarrier& b) {
    asm volatile("s_waitcnt vmcnt(0)" ::: "memory");
    __syncthreads();
    if (threadIdx.x == 0) {
        unsigned* bar = b.bar;
        __builtin_amdgcn_s_waitcnt(0);
        unsigned nloc = b.st[0], nx = b.st[1];
        if (nloc == 0u) { xcd_barrier_complete(bar, b.x, nloc, nx); b.st[0] = nloc; b.st[1] = nx; }
        const unsigned old = xb_add(&bar[XB_XSUB(b.x)], 1u);
        const unsigned gen = old / nloc;
        if (old + 1u == (gen + 1u) * nloc) {
            __builtin_amdgcn_fence(__ATOMIC_RELEASE, "agent");
            asm volatile("s_waitcnt vmcnt(0)" ::: "memory");
            const unsigned og = xb_add(&bar[XB_TOP], 1u);
            const unsigned tg = og / nx;
            if (og + 1u == (tg + 1u) * nx) xb_add(&bar[XB_TOPGEN], 1u);
            else XB_SPIN(xb_ld(&bar[XB_TOPGEN]) == tg, bar);
            __builtin_amdgcn_fence(__ATOMIC_ACQUIRE, "agent");
            xb_add(&bar[XB_XGEN(b.x)], 1u);
            asm volatile("s_waitcnt vmcnt(0)" ::: "memory");
        } else {
            XB_SPIN(xb_ld(&bar[XB_XGEN(b.x)]) == gen, bar);
            __builtin_amdgcn_fence(__ATOMIC_ACQUIRE, "agent");
            asm volatile("s_waitcnt vmcnt(0)" ::: "memory");
        }
    }
    __syncthreads();
}

constexpr int LDS_BYTES = 98304;
constexpr int LDS_BAR_OFF = LDS_BYTES - 16;
constexpr int CW_BAR = 4096;
template <int L>
__device__ __forceinline__ void layer_body(const Params& p, char* lds, int bid, int nb, const XcdBarrier& bar) {
    phase_proj(p, lds, bid, nb); xcd_barrier(bar);
    phase_attn(p, L, lds, bid, nb); xcd_barrier(bar);
    phase_conv(p, L, lds, bid, nb); xcd_barrier(bar);
    phase_mqkv(p, lds, bid, nb); xcd_barrier(bar);
    phase_m1(p, lds, bid, nb); xcd_barrier(bar);
    phase_m2(p, lds, bid, nb); xcd_barrier(bar);
    phase_m3(p, L, lds, bid, nb); xcd_barrier(bar);
    phase_br1(p, lds, bid, nb); xcd_barrier(bar);
    phase_br2(p, lds, bid, nb); xcd_barrier(bar);
    phase_out(p, lds, bid, nb); xcd_barrier(bar);
    phase_ln1(p, L, lds, bid, nb); xcd_barrier(bar);
    phase_e1(p, L, lds, bid, nb); xcd_barrier(bar);
    phase_e2(p, L, lds, bid, nb); xcd_barrier(bar);
    phase_combine(p, L, lds, bid, nb); if (L + 1 < DEPTH) xcd_barrier(bar);
}
__global__ void __launch_bounds__(NT, 2) fwd_kernel(Params p) {
    extern __shared__ __attribute__((aligned(16))) char lds[];
    const int bid = blockIdx.x, nb = gridDim.x;
    if (threadIdx.x == 0) *(uint4*)(lds + LDS_BAR_OFF) = make_uint4(0u, 0u, 0u, 0u);
    __syncthreads();
    XcdBarrier bar = xcd_barrier_post((unsigned*)(p.ws + WS_CTL) + CW_BAR, (volatile LAS unsigned*)(lds + LDS_BAR_OFF));
    phase_prologue(p, lds, bid, nb); xcd_barrier(bar);
    layer_body<0>(p, lds, bid, nb, bar);
    layer_body<1>(p, lds, bid, nb, bar);
}

extern "C" void kernel_launch(void* const* d_in, const int* in_sizes, int n_in, void* d_out, int out_size, void* d_ws, size_t ws_size, hipStream_t stream) {
    if (n_in != 30 || ws_size < WS_END) { fprintf(stderr, "kernel_launch: unexpected n_in %d or ws_size %zu (< %zu)\n", n_in, ws_size, (size_t)WS_END); return; }
    static int grid = 0;
    if (grid == 0) {
        int dev = 0, cus = 0;
        if (hipGetDevice(&dev) != hipSuccess || hipDeviceGetAttribute(&cus, hipDeviceAttributeMultiprocessorCount, dev) != hipSuccess || cus <= 0) cus = 256;
        (void)hipFuncSetAttribute((const void*)fwd_kernel, hipFuncAttributeMaxDynamicSharedMemorySize, LDS_BYTES);
        grid = cus;
    }
    Params p{};
    for (int i = 0; i < 30; ++i) p.in[i] = (const float*)d_in[i];
    p.out = (float*)d_out; p.ws = (unsigned char*)d_ws;
    (void)hipMemsetAsync((char*)d_ws + WS_CTL, 0, CTL_BYTES, stream);
    hipLaunchKernelGGL(fwd_kernel, dim3(grid), dim3(NT), LDS_BYTES, stream, p);
}
```

```cpp
#include <hip/hip_runtime.h>
#include <cstdio>
#include <cstdint>

constexpr int D = 1024;
constexpr int SEQ = 16384;
constexpr int NMETA = 16;
constexpr int P = 16640;
constexpr int VALID0 = 240;
constexpr int DEPTH = 2;
constexpr int DIN = 7176;
constexpr int NSC = 65;
constexpr int NEXP = 16;
constexpr float LN_EPS = 1e-5f;
constexpr float DN_ALPHA = 1.4142135623730951f;
constexpr float NEGBIG = -1e30f;
constexpr int NT = 512;
constexpr int NW = 8;

typedef unsigned short bf16_t;
typedef short bf16x8 __attribute__((ext_vector_type(8)));
typedef float f32x4 __attribute__((ext_vector_type(4)));
typedef unsigned u32x4 __attribute__((ext_vector_type(4)));
typedef unsigned u32x2 __attribute__((ext_vector_type(2)));

constexpr size_t MiB = 1u << 20;
constexpr size_t RB = (size_t)P * D * 2;
constexpr size_t WS_CTL = 0;
constexpr size_t CTL_BYTES = 1 * MiB;
constexpr size_t WS_TAB = 1 * MiB;
constexpr size_t TAB_GLI = WS_TAB;
constexpr size_t TAB_GLF = TAB_GLI + 4 * P * 4;
constexpr size_t TAB_B   = TAB_GLF + 4 * P * 4;
constexpr size_t TAB_E   = TAB_B + 4 * P * 4;
constexpr size_t TAB_PM  = TAB_E + 4 * P * 4;
constexpr size_t TAB_W   = TAB_PM + 4 * P * 4;
constexpr size_t TAB_SCG = TAB_W + 4 * P * 4;
constexpr size_t TAB_SCM = TAB_SCG + 4096;
constexpr size_t TAB_MT  = TAB_SCM + 4096;
constexpr size_t TAB_NT  = TAB_MT + 4096;
constexpr size_t TAB_TOPK = TAB_NT + (size_t)NSC * 4 * 256 * 4;
constexpr size_t TAB_ELIST = TAB_TOPK + (size_t)P * 32;
constexpr size_t TAB_END = TAB_ELIST + (size_t)NEXP * P * 4;
static_assert(TAB_END <= 8 * MiB, "tables");
constexpr size_t WS_W = 8 * MiB;
constexpr size_t W_IN_T = WS_W;
constexpr size_t W_Q_T = W_IN_T + (size_t)7168 * 1024 * 2;
constexpr size_t W_K_T = W_Q_T + 4 * 65536 * 2;
constexpr size_t W_V_T = W_K_T + 4 * 65536 * 2;
constexpr size_t W_BM_T = W_V_T + 4 * 65536 * 2;
constexpr size_t W_BA_T = W_BM_T + (size_t)D * D * 2;
constexpr size_t W_OUT_T = W_BA_T + (size_t)D * D * 2;
constexpr size_t W_G_T = W_OUT_T + (size_t)D * D * 2;
constexpr size_t W_U_T = W_G_T + (size_t)NEXP * D * D * 2;
constexpr size_t W_D_T = W_U_T + (size_t)NEXP * D * D * 2;
constexpr size_t W_END = W_D_T + (size_t)NEXP * D * D * 2;
static_assert(W_END <= 128 * MiB, "weights");
constexpr size_t WS_SLOT = 128 * MiB;
constexpr size_t SLOT(int i) { return WS_SLOT + (size_t)i * RB; }
constexpr size_t WS_END = WS_SLOT + 11 * RB;
constexpr size_t B_H = SLOT(0);
constexpr size_t B_XM = SLOT(1), B_YM = SLOT(1);
constexpr size_t B_OP = SLOT(2), B_MRGB = SLOT(2);
constexpr size_t B_QA = SLOT(3), B_QM = SLOT(3);
constexpr size_t B_KA = SLOT(4), B_XC = SLOT(4), B_CT = SLOT(4);
constexpr size_t B_VAT = SLOT(5), B_KM = SLOT(5), B_H1 = SLOT(5);
constexpr size_t B_GA = SLOT(6);
constexpr size_t B_GB = SLOT(7);
constexpr size_t B_YA = SLOT(8);
constexpr size_t B_KMT = SLOT(9), B_MRG = SLOT(9);
constexpr size_t B_VMT = SLOT(10), B_VA = SLOT(10);
constexpr size_t B_Z = SLOT(3);
constexpr size_t B_HID = SLOT(6);
constexpr size_t B_YB = SLOT(1), B_XP = SLOT(1);
constexpr int HID_ROWS_MAX = (int)(3 * RB / (D * 2));
constexpr int CW_CNT = 64;

struct Params {
    const float* in[30];
    float* out;
    unsigned char* ws;
};
enum { I_X = 0, I_META, I_LNG, I_LNB, I_WIN, I_CONVW, I_CONVB, I_WQM, I_WKM, I_WVM, I_BI, I_BF, I_MNG, I_LQ1, I_LK1, I_LQ2, I_LK2, I_ANG,
       I_WBM, I_WBA, I_WOUT, I_LN1G, I_LN1B, I_LN2G, I_LN2B, I_WR, I_RB, I_WG, I_WU, I_WD };

__device__ __forceinline__ int tid_opaque() { int t = threadIdx.x; asm volatile("" : "+v"(t)); return t; }
#define TIDX tid_opaque()
__device__ __forceinline__ float bf2f(unsigned v) { return __uint_as_float(v << 16); }
__device__ __forceinline__ unsigned f2bf(float f) { unsigned u = __float_as_uint(f); return (u + 0x7fffu + ((u >> 16) & 1u)) >> 16; }
__device__ __forceinline__ unsigned pk2(float lo, float hi) { return f2bf(lo) | (f2bf(hi) << 16); }
__device__ __forceinline__ float wave_sum(float v) {
#pragma unroll
    for (int o = 1; o < 64; o <<= 1) v += __shfl_xor(v, o);
    return v;
}
__device__ __forceinline__ float sigmoidf_(float x) { return 1.f / (1.f + __expf(-x)); }
__device__ __forceinline__ float siluf_(float x) { return x / (1.f + __expf(-x)); }
__device__ __forceinline__ float logsigmoidf_(float x) { return x >= 0.f ? -log1pf(__expf(-x)) : x - log1pf(__expf(x)); }
__device__ __forceinline__ f32x4 mfma16(bf16x8 a, bf16x8 b, f32x4 c) { return __builtin_amdgcn_mfma_f32_16x16x32_bf16(a, b, c, 0, 0, 0); }
__device__ __forceinline__ bf16x8 ld8(const bf16_t* p) { return *(const bf16x8*)p; }

__device__ __forceinline__ void transpose_item(const float* W, int K, size_t ldsrc, int k0, int n_src0, bf16_t* WT, int dst_row0, float* scr, int lane) {
#pragma unroll 8
    for (int i = 0; i < 32; ++i) { const int kk = 2 * i + (lane >> 5); scr[kk * 33 + (lane & 31)] = W[(size_t)(k0 + kk) * ldsrc + n_src0 + (lane & 31)]; }
    __builtin_amdgcn_wave_barrier();
    asm volatile("s_waitcnt lgkmcnt(0)" ::: "memory");
    const int c = lane & 7;
#pragma unroll
    for (int j = 0; j < 4; ++j) { const int n = (lane >> 3) + 8 * j; const float* s = scr + (8 * c) * 33 + n;
        u32x4 o; o.x = pk2(s[0 * 33], s[1 * 33]); o.y = pk2(s[2 * 33], s[3 * 33]); o.z = pk2(s[4 * 33], s[5 * 33]); o.w = pk2(s[6 * 33], s[7 * 33]);
        *(u32x4*)(WT + (size_t)(dst_row0 + n) * K + k0 + 8 * c) = o; }
    asm volatile("s_waitcnt lgkmcnt(0)" ::: "memory");
    __builtin_amdgcn_wave_barrier();
}
__device__ __forceinline__ void convert_weights(const Params& p, int l, char* lds, int gw, int ngw, int wid, int lane) {
    float* scr = (float*)lds + wid * (64 * 33);
    unsigned char* ws = p.ws;
    constexpr int I_IN = 16 * 224, I_QKV = 3 * 4 * 4 * 8, I_SQ = 16 * 32, I_EXP = 3 * 16 * 512;
    constexpr int TOTAL = I_IN + I_QKV + 3 * I_SQ + I_EXP;
    for (int it = gw; it < TOTAL; it += ngw) {
        int r = it;
        if (r < I_IN) { const int kb = r / 224, nb = r % 224, r0 = nb * 32, nsrc = r0 < 2048 ? r0 : r0 + 8;
            transpose_item(p.in[I_WIN] + (size_t)l * D * DIN, D, DIN, kb * 64, nsrc, (bf16_t*)(ws + W_IN_T), r0, scr, lane); continue; }
        r -= I_IN;
        if (r < I_QKV) { const int w = r / 128, rr = r % 128, h = rr / 32, t = rr % 32, kb = t / 8, nb = t % 8;
            const float* src = p.in[w == 0 ? I_WQM : (w == 1 ? I_WKM : I_WVM)] + ((size_t)l * 4 + h) * 65536;
            bf16_t* dst = (bf16_t*)(ws + (w == 0 ? W_Q_T : (w == 1 ? W_K_T : W_V_T))) + (size_t)h * 65536;
            transpose_item(src, 256, 256, kb * 64, nb * 32, dst, nb * 32, scr, lane); continue; }
        r -= I_QKV;
        if (r < 3 * I_SQ) { const int w = r / I_SQ, t = r % I_SQ, kb = t / 32, nb = t % 32;
            const float* src = p.in[w == 0 ? I_WBM : (w == 1 ? I_WBA : I_WOUT)] + (size_t)l * D * D;
            bf16_t* dst = (bf16_t*)(ws + (w == 0 ? W_BM_T : (w == 1 ? W_BA_T : W_OUT_T)));
            transpose_item(src, D, D, kb * 64, nb * 32, dst, nb * 32, scr, lane); continue; }
        r -= 3 * I_SQ;
        { const int w = r / (16 * 512), rr = r % (16 * 512), e = rr / 512, t = rr % 512, kb = t / 32, nb = t % 32;
            const float* src = p.in[w == 0 ? I_WG : (w == 1 ? I_WU : I_WD)] + ((size_t)l * NEXP + e) * D * D;
            bf16_t* dst = (bf16_t*)(ws + (w == 0 ? W_G_T : (w == 1 ? W_U_T : W_D_T))) + (size_t)e * D * D;
            transpose_item(src, D, D, kb * 64, nb * 32, dst, nb * 32, scr, lane); }
    }
}

__device__ __forceinline__ void ln_normalize(f32x4 (&v)[4], const float* g, const float* b, int lane) {
    float s = 0.f;
#pragma unroll
    for (int j = 0; j < 4; ++j) s += (v[j].x + v[j].y) + (v[j].z + v[j].w);
    const float mean = wave_sum(s) * (1.f / D);
    float s2 = 0.f;
#pragma unroll
    for (int j = 0; j < 4; ++j) { v[j] = v[j] - mean; s2 += (v[j].x * v[j].x + v[j].y * v[j].y) + (v[j].z * v[j].z + v[j].w * v[j].w); }
    const float rstd = rsqrtf(wave_sum(s2) * (1.f / D) + LN_EPS);
#pragma unroll
    for (int j = 0; j < 4; ++j) { const f32x4 gg = *(const f32x4*)(g + 4 * lane + 256 * j), bb = *(const f32x4*)(b + 4 * lane + 256 * j); v[j] = v[j] * rstd * gg + bb; }
}
__device__ __forceinline__ void store_row_bf16(bf16_t* row, const f32x4 (&v)[4], int lane) {
#pragma unroll
    for (int j = 0; j < 4; ++j) { u32x2 o; o.x = pk2(v[j].x, v[j].y); o.y = pk2(v[j].z, v[j].w); *(u32x2*)(row + 4 * lane + 256 * j) = o; }
}
__device__ __forceinline__ void store_row_zero(bf16_t* row, int lane) {
#pragma unroll
    for (int j = 0; j < 4; ++j) { u32x2 o; o.x = 0u; o.y = 0u; *(u32x2*)(row + 4 * lane + 256 * j) = o; }
}
__device__ __forceinline__ void load_gate_w(const Params& p, int l, float* g8) {
    const float* w = p.in[I_WIN] + (size_t)l * D * DIN + 2048;
    for (int i = TIDX; i < D * 8; i += NT) { const int k = i >> 3, c = i & 7; g8[i] = w[(size_t)k * DIN + c]; }
    __syncthreads();
}
__device__ __forceinline__ void gates_row(const Params& p, int l, const float* g8, const f32x4 (&v)[4], int prow, int lane) {
    float acc[8];
#pragma unroll
    for (int c = 0; c < 8; ++c) acc[c] = 0.f;
#pragma unroll
    for (int j = 0; j < 4; ++j)
#pragma unroll
        for (int i = 0; i < 4; ++i) { const int k = 4 * lane + 256 * j + i; const float x = v[j][i];
            const f32x4 w0 = *(const f32x4*)(g8 + k * 8), w1 = *(const f32x4*)(g8 + k * 8 + 4);
            acc[0] += x * w0.x; acc[1] += x * w0.y; acc[2] += x * w0.z; acc[3] += x * w0.w; acc[4] += x * w1.x; acc[5] += x * w1.y; acc[6] += x * w1.z; acc[7] += x * w1.w; }
#pragma unroll
    for (int c = 0; c < 8; ++c) acc[c] = wave_sum(acc[c]);
    if (lane < 4) {
        float* gli = (float*)(p.ws + TAB_GLI); float* glf = (float*)(p.ws + TAB_GLF);
        const float bi = p.in[I_BI][l * 4 + lane], bfv = p.in[I_BF][l * 4 + lane];
        float ai = acc[0], af = acc[4];
        if (lane == 1) { ai = acc[1]; af = acc[5]; } else if (lane == 2) { ai = acc[2]; af = acc[6]; } else if (lane == 3) { ai = acc[3]; af = acc[7]; }
        gli[(size_t)lane * P + prow] = ai + bi;
        glf[(size_t)lane * P + prow] = logsigmoidf_(af + bfv);
    }
}
__device__ __forceinline__ void gates_row_pad(const Params& p, int prow, int lane) {
    if (lane < 4) { ((float*)(p.ws + TAB_GLI))[(size_t)lane * P + prow] = NEGBIG; ((float*)(p.ws + TAB_GLF))[(size_t)lane * P + prow] = 0.f; }
}

__device__ __forceinline__ void phase_prologue(const Params& p, char* lds, int bid, int nb) {
    const int tid = TIDX, wid = tid >> 6, lane = tid & 63, gw = bid * NW + wid, ngw = nb * NW;
    convert_weights(p, 0, lds, gw, ngw, wid, lane);
    __syncthreads();
    float* g8 = (float*)lds;
    load_gate_w(p, 0, g8);
    bf16_t* H = (bf16_t*)(p.ws + B_H);
    for (int r = gw; r < P; r += ngw) {
        if (r < VALID0) { store_row_zero(H + (size_t)r * D, lane); gates_row_pad(p, r, lane); continue; }
        const float* src = r < 256 ? p.in[I_META] + (size_t)(r - VALID0) * D : p.in[I_X] + (size_t)(r - 256) * D;
        f32x4 v[4];
#pragma unroll
        for (int j = 0; j < 4; ++j) v[j] = *(const f32x4*)(src + 4 * lane + 256 * j);
        ln_normalize(v, p.in[I_LNG], p.in[I_LNB], lane);
        store_row_bf16(H + (size_t)r * D, v, lane);
        gates_row(p, 0, g8, v, r, lane);
    }
}

struct RowsPlain { const bf16_t* base; size_t ld; __device__ __forceinline__ const bf16_t* row(int m) const { return base + (size_t)m * ld; } };
template <class AR, class BR, class Epi>
__device__ __forceinline__ void sgemm_unit(const AR& ar, const BR& br, int K, int m0, int n0, const Epi& epi) {
    const int tid = TIDX, wid = tid >> 6, lane = tid & 63, c = lane & 15, g = lane >> 4, wr = wid >> 2, wc = wid & 3;
    const int mw = m0 + 64 * wr, nw = n0 + 64 * wc;
    const bf16_t* ap[4]; const bf16_t* bp[4];
#pragma unroll
    for (int i = 0; i < 4; ++i) { ap[i] = ar.row(mw + 16 * i + c) + 8 * g; bp[i] = br.row(nw + 16 * i + c) + 8 * g; }
    f32x4 acc[4][4];
#pragma unroll
    for (int i = 0; i < 4; ++i)
#pragma unroll
        for (int j = 0; j < 4; ++j) acc[i][j] = (f32x4){0.f, 0.f, 0.f, 0.f};
    for (int k0 = 0; k0 < K; k0 += 32) {
        bf16x8 a[4], b[4];
#pragma unroll
        for (int i = 0; i < 4; ++i) { a[i] = ld8(ap[i] + k0); b[i] = ld8(bp[i] + k0); }
#pragma unroll
        for (int i = 0; i < 4; ++i)
#pragma unroll
            for (int j = 0; j < 4; ++j) acc[i][j] = mfma16(b[j], a[i], acc[i][j]);
    }
#pragma unroll
    for (int i = 0; i < 4; ++i)
#pragma unroll
        for (int j = 0; j < 4; ++j) epi(mw + 16 * i + c, nw + 16 * j + 4 * g, acc[i][j]);
}
__device__ __forceinline__ void store4_bf16(bf16_t* dst, f32x4 v) { u32x2 o; o.x = pk2(v.x, v.y); o.y = pk2(v.z, v.w); *(u32x2*)dst = o; }

struct EpiProj { unsigned char* ws;
    __device__ __forceinline__ void operator()(int m, int n, f32x4 v) const {
        const int seg = n >> 10, cc = n & 1023;
        const size_t off = seg == 0 ? B_XM : seg == 1 ? B_OP : seg == 2 ? B_QA : seg == 3 ? B_KA : seg == 4 ? B_VA : seg == 5 ? B_GA : B_GB;
        store4_bf16((bf16_t*)(ws + off) + (size_t)m * D + cc, v); } };
struct EpiStore { bf16_t* C; size_t ldc; float scale;
    __device__ __forceinline__ void operator()(int m, int n, f32x4 v) const { store4_bf16(C + (size_t)m * ldc + n, v * scale); } };
__device__ __forceinline__ void phase_proj(const Params& p, char* lds, int bid, int nb) {
    const bf16_t* H = (const bf16_t*)(p.ws + B_H); const bf16_t* W = (const bf16_t*)(p.ws + W_IN_T);
    constexpr int NU_MAIN = 130 * 24, NU_VAT = 8 * 65;
    for (int u = bid; u < NU_MAIN + NU_VAT; u += nb) {
        if (u < NU_MAIN) { const int mt = u / 24; int ct = u % 24; if (ct >= 16) ct += 4;
            sgemm_unit(RowsPlain{H, D}, RowsPlain{W, D}, D, mt * 128, ct * 256, EpiProj{p.ws});
        } else { const int v = u - NU_MAIN, mt = v / 65, ct = v % 65;
            sgemm_unit(RowsPlain{W + (size_t)4096 * D, D}, RowsPlain{H, D}, D, mt * 128, ct * 256, EpiStore{(bf16_t*)(p.ws + B_VAT), P, 1.f}); }
    }
}

namespace pg8 {
#define PG8_LAS __attribute__((address_space(3)))
constexpr int BM = 256, BK = 64, HALF = 128, HTB = HALF * BK * 2, STAGE_BYTES = 8 * HTB, NXCD = 8, WGM = 8;
__host__ __device__ __forceinline__ int lds_byte(int r, int c) { const int st = (r >> 4) * 2 + (c >> 5), rr = r & 15, cc = c & 31, ob = rr * 64 + cc * 2; return st * 1024 + (ob ^ (((ob >> 9) & 1) << 5)); }
__host__ __device__ __forceinline__ void stage_rc(int b, int& R, int& C) { const int st = b / 1024, sb = b % 1024, swz = sb ^ (((sb >> 9) & 1) << 5); R = (st >> 1) * 16 + swz / 64; C = (st & 1) * 32 + (swz % 64) / 2; }
__host__ __device__ __forceinline__ int perm32(int rho) { const int n = rho >> 4, i = rho & 15; return 8 * (i >> 2) + 4 * n + (i & 3); }
struct Unit { int pm, pn, grp; };
__device__ __forceinline__ bool decode_unit(long L, int nG, int nM, int nN, Unit& u) {
    const int nwg = nG * nM * nN; if (L >= nwg) return false;
    int wgid = (int)L; { const int q = nwg / NXCD, r = nwg % NXCD, xcd = wgid % NXCD, off = wgid / NXCD; wgid = (xcd < r ? xcd * (q + 1) : r * (q + 1) + (xcd - r) * q) + off; }
    const int per = nM * nN; u.grp = wgid / per; const int rem = wgid % per;
    const int nig = WGM * nN, gid = rem / nig, fm = gid * WGM, gsz = (nM - fm) < WGM ? (nM - fm) : WGM;
    u.pm = __builtin_amdgcn_readfirstlane(fm + ((rem % nig) % gsz)); u.pn = __builtin_amdgcn_readfirstlane((rem % nig) / gsz); u.grp = __builtin_amdgcn_readfirstlane(u.grp); return true;
}
__device__ __forceinline__ unsigned cvt_pk_bf16(float lo, float hi) { unsigned r; asm volatile("v_cvt_pk_bf16_f32 %0, %1, %2" : "=v"(r) : "v"(lo), "v"(hi)); return r; }

template <class Epi, class Sched, bool ALIGN_EPI = true>
__device__ __forceinline__ void gemm_phase(PG8_LAS unsigned char* lds, const Sched& S, const Epi& E) {
    const int tid = TIDX, wid = __builtin_amdgcn_readfirstlane(tid >> 6), lane = tid & 63, wr = wid >> 2, wc = wid & 3, fr = lane & 15, fq = lane >> 4;
    const int K = S.K, nt = K / BK;
    unsigned voffA[2], voffB[2];
#pragma unroll
    for (int i = 0; i < 2; ++i) { int R, C; stage_rc(tid * 16 + i * 8192, R, C); const int Rb = (R & ~31) + perm32(R & 31);
        voffA[i] = (unsigned)(R * S.lda + C) * 2u; voffB[i] = (unsigned)(Rb * S.ldb + C) * 2u; }
    const size_t kstep = (size_t)(BK * 2);
    const size_t hstepA = (size_t)HALF * S.lda * 2, hstepB = (size_t)HALF * S.ldb * 2;
    const unsigned ldsw = (unsigned)wid * 1024u;
    const int aoff = lds_byte(wr * 64 + fr, fq * 8), boff = lds_byte(wc * 32 + fr, fq * 8);
#define PG8_SA(b, h) (((b) * 2 + (h)) * HTB)
#define PG8_SB(b, h) ((4 + (b) * 2 + (h)) * HTB)
#define PG8_STAGE(bufoff, gbase, voff) do { _Pragma("unroll") for (int _i = 0; _i < 2; ++_i) \
        __builtin_amdgcn_global_load_lds((const unsigned*)((const char*)(gbase) + (voff)[_i]), (PG8_LAS unsigned*)(lds + (bufoff) + ldsw + _i * 8192), 16, 0, 0); } while (0)
#define PG8_LDA(dst, b, h) do { _Pragma("unroll") for (int m = 0; m < 4; ++m) _Pragma("unroll") for (int k = 0; k < 2; ++k) dst[m][k] = *(const PG8_LAS bf16x8*)(lds + PG8_SA(b, h) + aoff + m * 2048 + k * 1024); } while (0)
#define PG8_LDB(dst, b, h) do { _Pragma("unroll") for (int n = 0; n < 2; ++n) _Pragma("unroll") for (int k = 0; k < 2; ++k) dst[n][k] = *(const PG8_LAS bf16x8*)(lds + PG8_SB(b, h) + boff + n * 2048 + k * 1024); } while (0)
#define PG8_MMA(ai, bj, At, Bt) do { __builtin_amdgcn_s_setprio(1); _Pragma("unroll") for (int m = 0; m < 4; ++m) _Pragma("unroll") for (int n = 0; n < 2; ++n) _Pragma("unroll") for (int k = 0; k < 2; ++k) \
        acc[ai][bj][m][n] = __builtin_amdgcn_mfma_f32_16x16x32_bf16(Bt[n][k], At[m][k], acc[ai][bj][m][n], 0, 0, 0); __builtin_amdgcn_s_setprio(0); } while (0)
#define PG8_WAIT_V(n) asm volatile("s_waitcnt vmcnt(" #n ")" ::: "memory")
#define PG8_WAIT_L(n) asm volatile("s_waitcnt lgkmcnt(" #n ")" ::: "memory")
#define PG8_BAR __builtin_amdgcn_s_barrier()
#define PG8_SCHED __builtin_amdgcn_sched_barrier(0)
    Unit cur, nxt; int ui = 0;
    if (!S.next(0, cur)) return;
    f32x4 acc[2][2][4][2];
#pragma unroll
    for (int a = 0; a < 2; ++a)
#pragma unroll
        for (int b = 0; b < 2; ++b)
#pragma unroll
            for (int m = 0; m < 4; ++m)
#pragma unroll
                for (int n = 0; n < 2; ++n) acc[a][b][m][n] = (f32x4){0.f, 0.f, 0.f, 0.f};
    bf16x8 At[4][2], B0[2][2], B1[2][2];
    const char* cA = S.abase(cur); const char* cB = S.bbase(cur);
    PG8_STAGE(PG8_SB(0, 0), cB, voffB); PG8_STAGE(PG8_SB(0, 1), cB + hstepB, voffB); PG8_STAGE(PG8_SA(0, 0), cA, voffA); PG8_STAGE(PG8_SA(0, 1), cA + hstepA, voffA);
    if (wr == 1) PG8_BAR;
    PG8_WAIT_V(2); PG8_BAR;
    PG8_STAGE(PG8_SB(1, 0), cB + kstep, voffB); PG8_STAGE(PG8_SA(1, 0), cA + kstep, voffA); PG8_STAGE(PG8_SB(1, 1), cB + hstepB + kstep, voffB);
    PG8_WAIT_V(6); PG8_BAR;
    for (;;) {
        const bool has_next = S.next(ui + 1, nxt);
        const char* nA = has_next ? S.abase(nxt) : cA; const char* nB = has_next ? S.bbase(nxt) : cB;
        for (int t = 0; t < nt; t += 2) {
            const bool last = (t == nt - 2);
            const char* a1 = cA + (size_t)(t + 1) * kstep;
            const char* a2 = last ? nA : cA + (size_t)(t + 2) * kstep; const char* b2 = last ? nB : cB + (size_t)(t + 2) * kstep;
            const char* a3 = a2 + kstep; const char* b3 = b2 + kstep;
            PG8_LDB(B0, 0, 0); PG8_LDB(B1, 0, 1); PG8_SCHED; PG8_LDA(At, 0, 0); PG8_STAGE(PG8_SA(1, 1), a1 + hstepA, voffA);
            PG8_WAIT_V(8); PG8_WAIT_L(0); PG8_BAR; PG8_MMA(0, 0, At, B0); PG8_MMA(0, 1, At, B1); PG8_BAR; PG8_SCHED;
            PG8_LDA(At, 0, 1); PG8_STAGE(PG8_SB(0, 0), b2, voffB); PG8_STAGE(PG8_SB(0, 1), b2 + hstepB, voffB); PG8_STAGE(PG8_SA(0, 0), a2, voffA);
            PG8_WAIT_V(8); PG8_WAIT_L(0); PG8_BAR; PG8_MMA(1, 0, At, B0); PG8_MMA(1, 1, At, B1); PG8_BAR; PG8_SCHED;
            PG8_LDB(B0, 1, 0); PG8_LDB(B1, 1, 1); PG8_SCHED; PG8_LDA(At, 1, 0); PG8_STAGE(PG8_SA(0, 1), a2 + hstepA, voffA);
            PG8_WAIT_V(8); PG8_WAIT_L(0); PG8_BAR; PG8_MMA(0, 0, At, B0); PG8_MMA(0, 1, At, B1); PG8_BAR; PG8_SCHED;
            PG8_LDA(At, 1, 1); PG8_STAGE(PG8_SB(1, 0), b3, voffB); PG8_STAGE(PG8_SB(1, 1), b3 + hstepB, voffB); PG8_STAGE(PG8_SA(1, 0), a3, voffA);
            PG8_WAIT_V(8); PG8_WAIT_L(0); PG8_BAR; PG8_MMA(1, 0, At, B0); PG8_MMA(1, 1, At, B1); PG8_BAR; PG8_SCHED;
        }
        if constexpr (ALIGN_EPI) { if (wr == 0) PG8_BAR; }
        E(acc, cur, wr, wc, fr, fq);
        if (!has_next) break;
#pragma unroll
        for (int a = 0; a < 2; ++a)
#pragma unroll
            for (int b = 0; b < 2; ++b)
#pragma unroll
                for (int m = 0; m < 4; ++m)
#pragma unroll
                    for (int n = 0; n < 2; ++n) acc[a][b][m][n] = (f32x4){0.f, 0.f, 0.f, 0.f};
        cur = nxt; cA = nA; cB = nB; ++ui;
        if constexpr (ALIGN_EPI) { if (wr == 1) PG8_BAR; }
    }
    PG8_WAIT_V(0);
    if constexpr (!ALIGN_EPI) { if (wr == 0) PG8_BAR; }
    PG8_BAR;
#undef PG8_SA
#undef PG8_SB
#undef PG8_STAGE
#undef PG8_LDA
#undef PG8_LDB
#undef PG8_MMA
#undef PG8_WAIT_V
#undef PG8_WAIT_L
#undef PG8_BAR
#undef PG8_SCHED
}
__device__ __forceinline__ u32x4 pack8(f32x4 v0, f32x4 v1) { u32x4 w; w.x = cvt_pk_bf16(v0[0], v0[1]); w.y = cvt_pk_bf16(v0[2], v0[3]); w.z = cvt_pk_bf16(v1[0], v1[1]); w.w = cvt_pk_bf16(v1[2], v1[3]); return w; }
__device__ __forceinline__ void unpack8(u32x4 w, f32x4& v0, f32x4& v1) {
    v0[0] = __uint_as_float(w.x << 16); v0[1] = __uint_as_float(w.x & 0xffff0000u); v0[2] = __uint_as_float(w.y << 16); v0[3] = __uint_as_float(w.y & 0xffff0000u);
    v1[0] = __uint_as_float(w.z << 16); v1[1] = __uint_as_float(w.z & 0xffff0000u); v1[2] = __uint_as_float(w.w << 16); v1[3] = __uint_as_float(w.w & 0xffff0000u); }
template <class F> __device__ __forceinline__ void for_each_piece(const f32x4 (&acc)[2][2][4][2], const Unit& u, int wr, int wc, int fr, int fq, const F& f) {
    const int row0 = u.pm * BM + wr * 64 + fr, col0 = wc * 32 + 8 * fq;
#pragma unroll
    for (int ai = 0; ai < 2; ++ai)
#pragma unroll
        for (int m = 0; m < 4; ++m)
#pragma unroll
            for (int bj = 0; bj < 2; ++bj) f(row0 + ai * HALF + m * 16, col0 + bj * HALF, acc[ai][bj][m][0], acc[ai][bj][m][1]);
}
}

template <int MI, int NJ, class AR, class BR, class Epi>
__device__ __forceinline__ void sgemm_wave(const AR& ar, const BR& br, int K, int m0, int n0, const Epi& epi) {
    const int lane = TIDX & 63, c = lane & 15, g = lane >> 4;
    const bf16_t* ap[MI]; const bf16_t* bp[NJ];
#pragma unroll
    for (int i = 0; i < MI; ++i) ap[i] = ar.row(m0 + 16 * i + c) + 8 * g;
#pragma unroll
    for (int j = 0; j < NJ; ++j) bp[j] = br.row(n0 + 16 * j + c) + 8 * g;
    f32x4 acc[MI][NJ];
#pragma unroll
    for (int i = 0; i < MI; ++i)
#pragma unroll
        for (int j = 0; j < NJ; ++j) acc[i][j] = (f32x4){0.f, 0.f, 0.f, 0.f};
#pragma unroll 4
    for (int k0 = 0; k0 < K; k0 += 32) {
        bf16x8 a[MI], b[NJ];
#pragma unroll
        for (int i = 0; i < MI; ++i) a[i] = ld8(ap[i] + k0);
#pragma unroll
        for (int j = 0; j < NJ; ++j) b[j] = ld8(bp[j] + k0);
#pragma unroll
        for (int i = 0; i < MI; ++i)
#pragma unroll
            for (int j = 0; j < NJ; ++j) acc[i][j] = mfma16(b[j], a[i], acc[i][j]);
    }
#pragma unroll
    for (int i = 0; i < MI; ++i)
#pragma unroll
        for (int j = 0; j < NJ; ++j) epi(m0 + 16 * i + c, n0 + 16 * j + 4 * g, acc[i][j]);
}
__device__ __forceinline__ void zero_block(bf16_t* base, size_t ld, int nrows, int ncols, int gtid, int gthreads) {
    const int cpr = ncols / 8;
    for (int i = gtid; i < nrows * cpr; i += gthreads) { const int r = i / cpr, cc = (i % cpr) * 8; *(u32x4*)(base + (size_t)r * ld + cc) = (u32x4){0u, 0u, 0u, 0u}; }
}

struct SchedProj { const char* A; const char* B; int G, c; int K, lda, ldb;
    __device__ __forceinline__ bool next(int i, pg8::Unit& u) const { if (!pg8::decode_unit((long)i * G + c, 1, 64, 28, u)) return false; u.pm += 1; return true; }
    __device__ __forceinline__ const char* abase(const pg8::Unit& u) const { return A + (size_t)u.pm * 256 * D * 2; }
    __device__ __forceinline__ const char* bbase(const pg8::Unit& u) const { return B + (size_t)u.pn * 256 * D * 2; } };
struct EpiProjF { unsigned char* ws;
    __device__ __forceinline__ void operator()(const f32x4 (&acc)[2][2][4][2], const pg8::Unit& u, int wr, int wc, int fr, int fq) const {
        const int colt = u.pn * 256, seg = colt >> 10;
        const size_t off = seg == 0 ? B_XM : seg == 1 ? B_OP : seg == 2 ? B_QA : seg == 3 ? B_KA : seg == 4 ? B_VA : seg == 5 ? B_GA : B_GB;
        bf16_t* base = (bf16_t*)(ws + off) + (colt & 1023);
        pg8::for_each_piece(acc, u, wr, wc, fr, fq, [&](int row, int col, f32x4 v0, f32x4 v1) { *(u32x4*)(base + (size_t)row * D + col) = pg8::pack8(v0, v1); }); } };
struct SchedVAT { const char* A; const char* B; int G, c; int K, lda, ldb;
    __device__ __forceinline__ bool next(int i, pg8::Unit& u) const { if (!pg8::decode_unit((long)i * G + c, 1, 4, 64, u)) return false; u.pn += 1; return true; }
    __device__ __forceinline__ const char* abase(const pg8::Unit& u) const { return A + (size_t)u.pm * 256 * D * 2; }
    __device__ __forceinline__ const char* bbase(const pg8::Unit& u) const { return B + (size_t)u.pn * 256 * D * 2; } };
struct EpiStoreF { bf16_t* C; size_t ldc; float scale;
    __device__ __forceinline__ void operator()(const f32x4 (&acc)[2][2][4][2], const pg8::Unit& u, int wr, int wc, int fr, int fq) const {
        bf16_t* base = C + (size_t)u.pn * 256;
        pg8::for_each_piece(acc, u, wr, wc, fr, fq, [&](int row, int col, f32x4 v0, f32x4 v1) { *(u32x4*)(base + (size_t)row * ldc + col) = pg8::pack8(v0 * scale, v1 * scale); }); } };
__device__ __forceinline__ void phase_proj_f(const Params& p, char* lds, int bid, int nb) {
    const int tid = TIDX, wid = tid >> 6, gw = bid * NW + wid, ngw = nb * NW;
    const bf16_t* H = (const bf16_t*)(p.ws + B_H); const bf16_t* W = (const bf16_t*)(p.ws + W_IN_T);
    zero_block((bf16_t*)(p.ws + B_KA), D, VALID0, D, bid * NT + tid, nb * NT);
    zero_block((bf16_t*)(p.ws + B_VA), D, VALID0, D, bid * NT + tid, nb * NT);
    zero_block((bf16_t*)(p.ws + B_XM), D, VALID0, D, bid * NT + tid, nb * NT);
    zero_block((bf16_t*)(p.ws + B_VAT), P, D, VALID0, bid * NT + tid, nb * NT);
    for (int t = gw; t < 112 + 16; t += ngw) {
        if (t < 112) sgemm_wave<1, 4>(RowsPlain{H, D}, RowsPlain{W, D}, D, VALID0, t * 64, EpiProj{p.ws});
        else sgemm_wave<4, 1>(RowsPlain{W + (size_t)4096 * D, D}, RowsPlain{H, D}, D, (t - 112) * 64, VALID0, EpiStore{(bf16_t*)(p.ws + B_VAT), P, 1.f});
    }
    { SchedProj S{(const char*)H, (const char*)W, nb, bid, D, D, D};
      pg8::gemm_phase(( PG8_LAS unsigned char*)lds, S, EpiProjF{p.ws}); }
    { SchedVAT S{(const char*)(W + (size_t)4096 * D), (const char*)H, nb, bid, D, D, D};
      pg8::gemm_phase((PG8_LAS unsigned char*)lds, S, EpiStoreF{(bf16_t*)(p.ws + B_VAT), P, 1.f}); }
}

__device__ __forceinline__ void phase_attn(const Params& p, int l, char* lds, int bid, int nb) {
    const int tid = TIDX, wid = tid >> 6, lane = tid & 63, c = lane & 15, g = lane >> 4, gw = bid * NW + wid, ngw = nb * NW;
    const bf16_t* QA = (const bf16_t*)(p.ws + B_QA); const bf16_t* KA = (const bf16_t*)(p.ws + B_KA); const bf16_t* VAT = (const bf16_t*)(p.ws + B_VAT);
    bf16_t* YA = (bf16_t*)(p.ws + B_YA);
    const float lam_init = 0.8f - 0.6f * expf(-0.3f * (float)l);
    float lam;
    { const float a = wave_sum(p.in[I_LQ1][l * 64 + lane] * p.in[I_LK1][l * 64 + lane]), b = wave_sum(p.in[I_LQ2][l * 64 + lane] * p.in[I_LK2][l * 64 + lane]);
      lam = expf(a) - expf(b) + lam_init; }
    constexpr int NQG = P / 16, QG0 = VALID0 / 16;
    const int ntask = (NQG - QG0) * 8;
    for (int t = gw; t < ntask; t += ngw) {
        const int qg = NQG - 1 - t / 8, hd = t % 8, q0 = qg * 16, q = q0 + c;
        bf16x8 qf[2][2];
#pragma unroll
        for (int mp = 0; mp < 2; ++mp)
#pragma unroll
            for (int ks = 0; ks < 2; ++ks) qf[mp][ks] = ld8(QA + (size_t)q * D + hd * 128 + mp * 64 + 32 * ks + 8 * g);
        f32x4 o[2][8];
#pragma unroll
        for (int mp = 0; mp < 2; ++mp)
#pragma unroll
            for (int dt = 0; dt < 8; ++dt) o[mp][dt] = (f32x4){0.f, 0.f, 0.f, 0.f};
        float mrun[2] = {NEGBIG, NEGBIG}, lrun[2] = {0.f, 0.f};
        for (int kb = 224; kb <= q0 + 15; kb += 32) {
            bf16x8 pf[2];
#pragma unroll
            for (int mp = 0; mp < 2; ++mp) {
                f32x4 s[2];
#pragma unroll
                for (int a = 0; a < 2; ++a) {
                    s[a] = (f32x4){0.f, 0.f, 0.f, 0.f};
                    const bf16_t* kr = KA + (size_t)(kb + 16 * a + c) * D + hd * 128 + mp * 64 + 8 * g;
#pragma unroll
                    for (int ks = 0; ks < 2; ++ks) s[a] = mfma16(ld8(kr + 32 * ks), qf[mp][ks], s[a]);
                }
                float mx = NEGBIG;
#pragma unroll
                for (int a = 0; a < 2; ++a)
#pragma unroll
                    for (int r = 0; r < 4; ++r) { const int key = kb + 16 * a + 4 * g + r; float v = s[a][r] * 0.125f; v = (key <= q && key >= VALID0) ? v : -INFINITY; s[a][r] = v; mx = fmaxf(mx, v); }
                mx = fmaxf(mx, __shfl_xor(mx, 16)); mx = fmaxf(mx, __shfl_xor(mx, 32));
                const float mn = fmaxf(mrun[mp], mx), alpha = __expf(mrun[mp] - mn);
                mrun[mp] = mn;
                float ps = 0.f;
#pragma unroll
                for (int a = 0; a < 2; ++a)
#pragma unroll
                    for (int r = 0; r < 4; ++r) { const float e = __expf(s[a][r] - mn); s[a][r] = e; ps += e; }
                lrun[mp] = lrun[mp] * alpha + ps;
#pragma unroll
                for (int dt = 0; dt < 8; ++dt) o[mp][dt] = o[mp][dt] * alpha;
                u32x4 w; w.x = pk2(s[0][0], s[0][1]); w.y = pk2(s[0][2], s[0][3]); w.z = pk2(s[1][0], s[1][1]); w.w = pk2(s[1][2], s[1][3]);
                pf[mp] = *(bf16x8*)&w;
            }
#pragma unroll
            for (int dt = 0; dt < 8; ++dt) {
                const bf16_t* vr = VAT + (size_t)(hd * 128 + 16 * dt + c) * P + kb + 4 * g;
                u32x2 v0 = *(const u32x2*)vr, v1 = *(const u32x2*)(vr + 16);
                u32x4 w; w.x = v0.x; w.y = v0.y; w.z = v1.x; w.w = v1.y;
                const bf16x8 vf = *(bf16x8*)&w;
                o[0][dt] = mfma16(vf, pf[0], o[0][dt]);
                o[1][dt] = mfma16(vf, pf[1], o[1][dt]);
            }
        }
        float l0 = lrun[0], l1 = lrun[1];
        l0 += __shfl_xor(l0, 16); l0 += __shfl_xor(l0, 32); l1 += __shfl_xor(l1, 16); l1 += __shfl_xor(l1, 32);
        const float i0 = 1.f / l0, i1 = lam / l1;
        float ss = 0.f;
#pragma unroll
        for (int dt = 0; dt < 8; ++dt) { o[0][dt] = o[0][dt] * i0 - o[1][dt] * i1; ss += (o[0][dt].x * o[0][dt].x + o[0][dt].y * o[0][dt].y) + (o[0][dt].z * o[0][dt].z + o[0][dt].w * o[0][dt].w); }
        ss += __shfl_xor(ss, 16); ss += __shfl_xor(ss, 32);
        const float rs = rsqrtf(ss * (1.f / 128.f) + LN_EPS) * (1.f - lam_init);
#pragma unroll
        for (int dt = 0; dt < 8; ++dt) { const f32x4 gg = *(const f32x4*)(p.in[I_ANG] + l * 128 + 16 * dt + 4 * g);
            store4_bf16(YA + (size_t)q * D + hd * 128 + 16 * dt + 4 * g, o[0][dt] * rs * gg); }
    }
}

__device__ __forceinline__ void phase_conv(const Params& p, int l, char* lds, int bid, int nb) {
    const int tid = TIDX, wid = tid >> 6, lane = tid & 63, gw = bid * NW + wid, ngw = nb * NW;
    const bf16_t* XM = (const bf16_t*)(p.ws + B_XM); bf16_t* XC = (bf16_t*)(p.ws + B_XC);
    const float* cw = p.in[I_CONVW] + (size_t)l * 4 * D; const float* cb = p.in[I_CONVB] + (size_t)l * D;
    const int nitem = P * (D / 8);
    for (int it = bid * NT + tid; it < nitem; it += nb * NT) {
        const int r = it >> 7, c0 = (it & 127) * 8;
        u32x4 o = {0u, 0u, 0u, 0u};
        if (r >= VALID0) {
            float acc[8];
#pragma unroll
            for (int i = 0; i < 8; ++i) acc[i] = cb[c0 + i];
#pragma unroll
            for (int j = 0; j < 4; ++j) { const int rr = r - 3 + j;
                if (rr >= VALID0) { const u32x4 x = *(const u32x4*)(XM + (size_t)rr * D + c0); const float* w = cw + j * D + c0;
                    acc[0] += w[0] * bf2f(x.x & 0xffffu); acc[1] += w[1] * bf2f(x.x >> 16); acc[2] += w[2] * bf2f(x.y & 0xffffu); acc[3] += w[3] * bf2f(x.y >> 16);
                    acc[4] += w[4] * bf2f(x.z & 0xffffu); acc[5] += w[5] * bf2f(x.z >> 16); acc[6] += w[6] * bf2f(x.w & 0xffffu); acc[7] += w[7] * bf2f(x.w >> 16); } }
            o.x = pk2(siluf_(acc[0]), siluf_(acc[1])); o.y = pk2(siluf_(acc[2]), siluf_(acc[3])); o.z = pk2(siluf_(acc[4]), siluf_(acc[5])); o.w = pk2(siluf_(acc[6]), siluf_(acc[7]));
        }
        *(u32x4*)(XC + (size_t)r * D + c0) = o;
    }
    const float* gli = (const float*)(p.ws + TAB_GLI); const float* glf = (const float*)(p.ws + TAB_GLF);
    float* tb = (float*)(p.ws + TAB_B); float* te = (float*)(p.ws + TAB_E); float* tpm = (float*)(p.ws + TAB_PM); float* tw = (float*)(p.ws + TAB_W);
    float* scg = (float*)(p.ws + TAB_SCG); float* scm = (float*)(p.ws + TAB_SCM);
    for (int t = gw; t < NSC * 4; t += ngw) {
        const int sc = t >> 2, h = t & 3; const size_t base = (size_t)h * P + sc * 256 + 4 * lane;
        const f32x4 lf = *(const f32x4*)(glf + base), li = *(const f32x4*)(gli + base);
        float b[4]; b[0] = lf.x; b[1] = b[0] + lf.y; b[2] = b[1] + lf.z; b[3] = b[2] + lf.w;
        float incl = b[3];
#pragma unroll
        for (int o = 1; o < 64; o <<= 1) { const float n = __shfl_up(incl, o); if (lane >= o) incl += n; }
        const float excl = incl - b[3];
        float e[4], pm[4];
#pragma unroll
        for (int i = 0; i < 4; ++i) { b[i] += excl; e[i] = li[i] - b[i]; }
        pm[0] = e[0]; pm[1] = fmaxf(pm[0], e[1]); pm[2] = fmaxf(pm[1], e[2]); pm[3] = fmaxf(pm[2], e[3]);
        float mi = pm[3];
#pragma unroll
        for (int o = 1; o < 64; o <<= 1) { const float n = __shfl_up(mi, o); if (lane >= o) mi = fmaxf(mi, n); }
        float mex = __shfl_up(mi, 1); if (lane == 0) mex = -INFINITY;
#pragma unroll
        for (int i = 0; i < 4; ++i) pm[i] = fmaxf(pm[i], mex);
        const float gtot = __shfl(incl, 63), emax = __shfl(mi, 63), mloc = gtot + emax;
        f32x4 ww;
#pragma unroll
        for (int i = 0; i < 4; ++i) ww[i] = __expf(e[i] + gtot - mloc);
        *(f32x4*)(tb + base) = (f32x4){b[0], b[1], b[2], b[3]};
        *(f32x4*)(te + base) = (f32x4){e[0], e[1], e[2], e[3]};
        *(f32x4*)(tpm + base) = (f32x4){pm[0], pm[1], pm[2], pm[3]};
        *(f32x4*)(tw + base) = ww;
        if (lane == 0) { scg[sc * 4 + h] = gtot; scm[sc * 4 + h] = mloc; }
    }
}

__device__ __forceinline__ void phase_mqkv(const Params& p, char* lds, int bid, int nb) {
    const bf16_t* XC = (const bf16_t*)(p.ws + B_XC); const bf16_t* XM = (const bf16_t*)(p.ws + B_XM);
    const bf16_t* WQ = (const bf16_t*)(p.ws + W_Q_T); const bf16_t* WK = (const bf16_t*)(p.ws + W_K_T); const bf16_t* WV = (const bf16_t*)(p.ws + W_V_T);
    bf16_t* QM = (bf16_t*)(p.ws + B_QM); bf16_t* KM = (bf16_t*)(p.ws + B_KM); bf16_t* KMT = (bf16_t*)(p.ws + B_KMT); bf16_t* VMT = (bf16_t*)(p.ws + B_VMT);
    for (int u = bid; u < 4 * 520; u += nb) {
        const int w = u / 520, r = u % 520, h = r / 130, t = r % 130;
        if (w == 0) sgemm_unit(RowsPlain{XC + h * 256, D}, RowsPlain{WQ + (size_t)h * 65536, 256}, 256, t * 128, 0, EpiStore{QM + h * 256, D, 1.f});
        else if (w == 1) sgemm_unit(RowsPlain{XC + h * 256, D}, RowsPlain{WK + (size_t)h * 65536, 256}, 256, t * 128, 0, EpiStore{KM + h * 256, D, 0.0625f});
        else if (w == 2) sgemm_unit(RowsPlain{WK + (size_t)h * 65536, 256}, RowsPlain{XC + h * 256, D}, 256, (t / 65) * 128, (t % 65) * 256, EpiStore{KMT + (size_t)h * 256 * P, P, 0.0625f});
        else sgemm_unit(RowsPlain{WV + (size_t)h * 65536, 256}, RowsPlain{XM + h * 256, D}, 256, (t / 65) * 128, (t % 65) * 256, EpiStore{VMT + (size_t)h * 256 * P, P, 1.f});
    }
}

__device__ __forceinline__ void phase_m1(const Params& p, char* lds, int bid, int nb) {
    const int tid = TIDX, wid = tid >> 6, lane = tid & 63, c = lane & 15, g = lane >> 4, gw = bid * NW + wid, ngw = nb * NW;
    const bf16_t* KMT = (const bf16_t*)(p.ws + B_KMT); const bf16_t* VMT = (const bf16_t*)(p.ws + B_VMT);
    const float* tw = (const float*)(p.ws + TAB_W); bf16_t* CT = (bf16_t*)(p.ws + B_CT); float* NTv = (float*)(p.ws + TAB_NT);
    for (int t = gw; t < NSC * 4 * 16; t += ngw) {
        const int dvb = t & 15, h = (t >> 4) & 3, sc = t >> 6, s0 = sc * 256;
        f32x4 acc[16];
#pragma unroll
        for (int i = 0; i < 16; ++i) acc[i] = (f32x4){0.f, 0.f, 0.f, 0.f};
        float un[16];
#pragma unroll
        for (int i = 0; i < 16; ++i) un[i] = 0.f;
        for (int ks = 0; ks < 8; ++ks) {
            const int sb = s0 + 32 * ks + 8 * g;
            const f32x4 w0 = *(const f32x4*)(tw + (size_t)h * P + sb), w1 = *(const f32x4*)(tw + (size_t)h * P + sb + 4);
            const u32x4 vv = *(const u32x4*)(VMT + (size_t)(h * 256 + 16 * dvb + c) * P + sb);
            u32x4 vw; vw.x = pk2(bf2f(vv.x & 0xffffu) * w0.x, bf2f(vv.x >> 16) * w0.y); vw.y = pk2(bf2f(vv.y & 0xffffu) * w0.z, bf2f(vv.y >> 16) * w0.w);
            vw.z = pk2(bf2f(vv.z & 0xffffu) * w1.x, bf2f(vv.z >> 16) * w1.y); vw.w = pk2(bf2f(vv.w & 0xffffu) * w1.z, bf2f(vv.w >> 16) * w1.w);
            const bf16x8 vf = *(bf16x8*)&vw;
#pragma unroll
            for (int dk = 0; dk < 16; ++dk) {
                const u32x4 kk = *(const u32x4*)(KMT + (size_t)(h * 256 + 16 * dk + c) * P + sb);
                acc[dk] = mfma16(*(const bf16x8*)&kk, vf, acc[dk]);
                if (dvb == 0) un[dk] += bf2f(kk.x & 0xffffu) * w0.x + bf2f(kk.x >> 16) * w0.y + bf2f(kk.y & 0xffffu) * w0.z + bf2f(kk.y >> 16) * w0.w
                                      + bf2f(kk.z & 0xffffu) * w1.x + bf2f(kk.z >> 16) * w1.y + bf2f(kk.w & 0xffffu) * w1.z + bf2f(kk.w >> 16) * w1.w;
            }
        }
        bf16_t* dst = CT + ((size_t)(sc * 4 + h) * 256 + 16 * dvb + c) * 256;
#pragma unroll
        for (int dk = 0; dk < 16; ++dk) store4_bf16(dst + 16 * dk + 4 * g, acc[dk]);
        if (dvb == 0) {
#pragma unroll
            for (int dk = 0; dk < 16; ++dk) { float v = un[dk]; v += __shfl_xor(v, 16); v += __shfl_xor(v, 32); if (g == 0) NTv[(size_t)(sc * 4 + h) * 256 + 16 * dk + c] = v; }
        }
    }
}

__device__ __forceinline__ void phase_m2(const Params& p, char* lds, int bid, int nb) {
    const float* scg = (const float*)(p.ws + TAB_SCG); const float* scm = (const float*)(p.ws + TAB_SCM);
    unsigned* CT = (unsigned*)(p.ws + B_CT); float* NTv = (float*)(p.ws + TAB_NT); float* mt = (float*)(p.ws + TAB_MT);
    const int gid = bid * NT + TIDX, nth = nb * NT;
    for (int i = gid; i < 4 * 32768 + 1024; i += nth) {
        if (i < 4 * 32768) {
            const int h = i >> 15, idx = i & 32767;
            float m = 0.f, c0 = 0.f, c1 = 0.f;
            for (int sc = 0; sc < NSC; ++sc) {
                const float gg = scg[sc * 4 + h], ml = scm[sc * 4 + h], mn = fmaxf(gg + m, ml), dec = __expf(gg + m - mn), cor = __expf(ml - mn);
                unsigned* ptr = CT + (size_t)(sc * 4 + h) * 32768 + idx; const unsigned u = *ptr;
                c0 = dec * c0 + cor * bf2f(u & 0xffffu); c1 = dec * c1 + cor * bf2f(u >> 16);
                *ptr = pk2(c0, c1); m = mn;
            }
        } else {
            const int j = i - 4 * 32768, h = j >> 8, d = j & 255;
            float m = 0.f, n = 0.f;
            for (int sc = 0; sc < NSC; ++sc) {
                const float gg = scg[sc * 4 + h], ml = scm[sc * 4 + h], mn = fmaxf(gg + m, ml), dec = __expf(gg + m - mn), cor = __expf(ml - mn);
                float* ptr = NTv + (size_t)(sc * 4 + h) * 256 + d;
                n = dec * n + cor * *ptr; *ptr = n; m = mn;
                if (d == 0) mt[sc * 4 + h] = mn;
            }
        }
    }
}

__device__ __forceinline__ void phase_m3(const Params& p, int l, char* lds, int bid, int nb) {
    const int tid = TIDX, wid = tid >> 6, lane = tid & 63, c = lane & 15, g = lane >> 4, gw = bid * NW + wid, ngw = nb * NW;
    const bf16_t* QM = (const bf16_t*)(p.ws + B_QM); const bf16_t* KM = (const bf16_t*)(p.ws + B_KM); const bf16_t* VMT = (const bf16_t*)(p.ws + B_VMT);
    const bf16_t* CT = (const bf16_t*)(p.ws + B_CT); const float* NTv = (const float*)(p.ws + TAB_NT); const float* mt = (const float*)(p.ws + TAB_MT);
    const float* tb = (const float*)(p.ws + TAB_B); const float* te = (const float*)(p.ws + TAB_E); const float* tpm = (const float*)(p.ws + TAB_PM);
    const bf16_t* OP = (const bf16_t*)(p.ws + B_OP); bf16_t* YM = (bf16_t*)(p.ws + B_YM);
    constexpr int NRG = P / 16, RG0 = VALID0 / 16;
    const int ntask = (NRG - RG0) * 4;
    for (int t = gw; t < ntask; t += ngw) {
        const int rg = NRG - 1 - t / 4, h = t % 4, t0 = rg * 16, row = t0 + c, sc = t0 >> 8, s_start = sc << 8;
        bf16x8 qf[8];
#pragma unroll
        for (int ks = 0; ks < 8; ++ks) qf[ks] = ld8(QM + (size_t)row * D + h * 256 + 32 * ks + 8 * g);
        const float b_t = tb[(size_t)h * P + row], pm_t = tpm[(size_t)h * P + row];
        const float m_prev = sc > 0 ? mt[(sc - 1) * 4 + h] : 0.f;
        const float m_t = b_t + fmaxf(m_prev, pm_t), scale_t = __expf(b_t + m_prev - m_t);
        f32x4 acc[16];
#pragma unroll
        for (int i = 0; i < 16; ++i) acc[i] = (f32x4){0.f, 0.f, 0.f, 0.f};
        float den = 0.f;
        if (sc > 0) {
            const bf16_t* Cb = CT + (size_t)((sc - 1) * 4 + h) * 65536; const float* nv = NTv + (size_t)((sc - 1) * 4 + h) * 256;
#pragma unroll 2
            for (int ks = 0; ks < 8; ++ks) {
#pragma unroll
                for (int dt = 0; dt < 16; ++dt) acc[dt] = mfma16(ld8(Cb + (size_t)(16 * dt + c) * 256 + 32 * ks + 8 * g), qf[ks], acc[dt]);
                const f32x4 n0 = *(const f32x4*)(nv + 32 * ks + 8 * g), n1 = *(const f32x4*)(nv + 32 * ks + 8 * g + 4);
                const u32x4 qq = *(const u32x4*)&qf[ks];
                den += bf2f(qq.x & 0xffffu) * n0.x + bf2f(qq.x >> 16) * n0.y + bf2f(qq.y & 0xffffu) * n0.z + bf2f(qq.y >> 16) * n0.w
                     + bf2f(qq.z & 0xffffu) * n1.x + bf2f(qq.z >> 16) * n1.y + bf2f(qq.w & 0xffffu) * n1.z + bf2f(qq.w >> 16) * n1.w;
            }
            den *= scale_t;
#pragma unroll
            for (int dt = 0; dt < 16; ++dt) acc[dt] = acc[dt] * scale_t;
        }
        for (int kb = s_start; kb <= t0 + 15; kb += 32) {
            f32x4 s[2];
#pragma unroll
            for (int a = 0; a < 2; ++a) {
                s[a] = (f32x4){0.f, 0.f, 0.f, 0.f};
                const bf16_t* kr = KM + (size_t)(kb + 16 * a + c) * D + h * 256 + 8 * g;
#pragma unroll
                for (int ks = 0; ks < 8; ++ks) s[a] = mfma16(ld8(kr + 32 * ks), qf[ks], s[a]);
                const f32x4 ee = *(const f32x4*)(te + (size_t)h * P + kb + 16 * a + 4 * g);
#pragma unroll
                for (int r = 0; r < 4; ++r) { const int key = kb + 16 * a + 4 * g + r; const float arg = fminf(ee[r] + b_t - m_t, 0.f);
                    const float dd = key <= row ? __expf(arg) : 0.f; const float pv = s[a][r] * dd; s[a][r] = pv; den += pv; }
            }
            u32x4 w; w.x = pk2(s[0][0], s[0][1]); w.y = pk2(s[0][2], s[0][3]); w.z = pk2(s[1][0], s[1][1]); w.w = pk2(s[1][2], s[1][3]);
            const bf16x8 pf = *(bf16x8*)&w;
#pragma unroll
            for (int dt = 0; dt < 16; ++dt) {
                const bf16_t* vr = VMT + (size_t)(h * 256 + 16 * dt + c) * P + kb + 4 * g;
                const u32x2 v0 = *(const u32x2*)vr, v1 = *(const u32x2*)(vr + 16);
                u32x4 vv; vv.x = v0.x; vv.y = v0.y; vv.z = v1.x; vv.w = v1.y;
                acc[dt] = mfma16(*(bf16x8*)&vv, pf, acc[dt]);
            }
        }
        den += __shfl_xor(den, 16); den += __shfl_xor(den, 32);
        const float inv = 1.f / fmaxf(fabsf(den), __expf(-m_t));
        float s1 = 0.f;
#pragma unroll
        for (int dt = 0; dt < 16; ++dt) {
            const u32x2 og = *(const u32x2*)(OP + (size_t)row * D + h * 256 + 16 * dt + 4 * g);
            f32x4 v = acc[dt] * inv;
            v.x *= sigmoidf_(bf2f(og.x & 0xffffu)); v.y *= sigmoidf_(bf2f(og.x >> 16)); v.z *= sigmoidf_(bf2f(og.y & 0xffffu)); v.w *= sigmoidf_(bf2f(og.y >> 16));
            acc[dt] = v; s1 += (v.x + v.y) + (v.z + v.w);
        }
        s1 += __shfl_xor(s1, 16); s1 += __shfl_xor(s1, 32);
        const float mu = s1 * (1.f / 256.f);
        float s2 = 0.f;
#pragma unroll
        for (int dt = 0; dt < 16; ++dt) { acc[dt] = acc[dt] - mu; s2 += (acc[dt].x * acc[dt].x + acc[dt].y * acc[dt].y) + (acc[dt].z * acc[dt].z + acc[dt].w * acc[dt].w); }
        s2 += __shfl_xor(s2, 16); s2 += __shfl_xor(s2, 32);
        const float rstd = rsqrtf(s2 * (1.f / 256.f) + LN_EPS);
#pragma unroll
        for (int dt = 0; dt < 16; ++dt) { const f32x4 gg = *(const f32x4*)(p.in[I_MNG] + (size_t)l * D + h * 256 + 16 * dt + 4 * g);
            store4_bf16(YM + (size_t)row * D + h * 256 + 16 * dt + 4 * g, acc[dt] * rstd * gg); }
    }
}

struct EpiBr1 { float* MRG; const bf16_t* GA;
    __device__ __forceinline__ void operator()(int m, int n, f32x4 v) const { const u32x2 gg = *(const u32x2*)(GA + (size_t)m * D + n);
        f32x4 o; o.x = v.x * sigmoidf_(bf2f(gg.x & 0xffffu)); o.y = v.y * sigmoidf_(bf2f(gg.x >> 16)); o.z = v.z * sigmoidf_(bf2f(gg.y & 0xffffu)); o.w = v.w * sigmoidf_(bf2f(gg.y >> 16));
        *(f32x4*)(MRG + (size_t)m * D + n) = o; } };
struct EpiBr2 { const float* MRG; const bf16_t* GB; bf16_t* OUT;
    __device__ __forceinline__ void operator()(int m, int n, f32x4 v) const { const u32x2 gg = *(const u32x2*)(GB + (size_t)m * D + n); const f32x4 t = *(const f32x4*)(MRG + (size_t)m * D + n);
        f32x4 o; o.x = t.x + v.x * sigmoidf_(bf2f(gg.x & 0xffffu)); o.y = t.y + v.y * sigmoidf_(bf2f(gg.x >> 16)); o.z = t.z + v.z * sigmoidf_(bf2f(gg.y & 0xffffu)); o.w = t.w + v.w * sigmoidf_(bf2f(gg.y >> 16));
        store4_bf16(OUT + (size_t)m * D + n, o); } };
struct EpiOut { float* Z; const bf16_t* H;
    __device__ __forceinline__ void operator()(int m, int n, f32x4 v) const { const u32x2 hh = *(const u32x2*)(H + (size_t)m * D + n);
        f32x4 o; o.x = v.x + DN_ALPHA * bf2f(hh.x & 0xffffu); o.y = v.y + DN_ALPHA * bf2f(hh.x >> 16); o.z = v.z + DN_ALPHA * bf2f(hh.y & 0xffffu); o.w = v.w + DN_ALPHA * bf2f(hh.y >> 16);
        *(f32x4*)(Z + (size_t)m * D + n) = o; } };
__device__ __forceinline__ void phase_br1(const Params& p, char* lds, int bid, int nb) {
    for (int u = bid; u < 130 * 4; u += nb)
        sgemm_unit(RowsPlain{(const bf16_t*)(p.ws + B_YM), D}, RowsPlain{(const bf16_t*)(p.ws + W_BM_T), D}, D, (u >> 2) * 128, (u & 3) * 256, EpiBr1{(float*)(p.ws + B_MRG), (const bf16_t*)(p.ws + B_GA)});
}
__device__ __forceinline__ void phase_br2(const Params& p, char* lds, int bid, int nb) {
    for (int u = bid; u < 130 * 4; u += nb)
        sgemm_unit(RowsPlain{(const bf16_t*)(p.ws + B_YA), D}, RowsPlain{(const bf16_t*)(p.ws + W_BA_T), D}, D, (u >> 2) * 128, (u & 3) * 256,
                   EpiBr2{(const float*)(p.ws + B_MRG), (const bf16_t*)(p.ws + B_GB), (bf16_t*)(p.ws + B_MRGB)});
}
__device__ __forceinline__ void phase_out(const Params& p, char* lds, int bid, int nb) {
    for (int u = bid; u < 130 * 4; u += nb)
        sgemm_unit(RowsPlain{(const bf16_t*)(p.ws + B_MRGB), D}, RowsPlain{(const bf16_t*)(p.ws + W_OUT_T), D}, D, (u >> 2) * 128, (u & 3) * 256, EpiOut{(float*)(p.ws + B_Z), (const bf16_t*)(p.ws + B_H)});
}

__device__ __forceinline__ void phase_ln1(const Params& p, int l, char* lds, int bid, int nb) {
    const int tid = TIDX, wid = tid >> 6, lane = tid & 63, gw = bid * NW + wid, ngw = nb * NW;
    float* wr = (float*)lds;
    for (int i = tid; i < D * 16 / 4; i += NT) ((f32x4*)wr)[i] = ((const f32x4*)p.in[I_WR])[i];
    __syncthreads();
    const float* Z = (const float*)(p.ws + B_Z); bf16_t* H1 = (bf16_t*)(p.ws + B_H1);
    unsigned* cnt = (unsigned*)(p.ws + WS_CTL) + CW_CNT + l * 16; int* elist = (int*)(p.ws + TAB_ELIST); float* topk = (float*)(p.ws + TAB_TOPK);
    for (int r = gw; r < P; r += ngw) {
        if (r < VALID0) { store_row_zero(H1 + (size_t)r * D, lane); continue; }
        f32x4 v[4];
#pragma unroll
        for (int j = 0; j < 4; ++j) v[j] = *(const f32x4*)(Z + (size_t)r * D + 4 * lane + 256 * j);
        ln_normalize(v, p.in[I_LN1G] + (size_t)l * D, p.in[I_LN1B] + (size_t)l * D, lane);
        store_row_bf16(H1 + (size_t)r * D, v, lane);
        float lg[16];
#pragma unroll
        for (int e = 0; e < 16; ++e) lg[e] = 0.f;
#pragma unroll
        for (int j = 0; j < 4; ++j)
#pragma unroll
            for (int i = 0; i < 4; ++i) { const int k = 4 * lane + 256 * j + i; const float x = v[j][i];
#pragma unroll
                for (int q = 0; q < 4; ++q) { const f32x4 w = *(const f32x4*)(wr + k * 16 + 4 * q); lg[4 * q] += x * w.x; lg[4 * q + 1] += x * w.y; lg[4 * q + 2] += x * w.z; lg[4 * q + 3] += x * w.w; } }
#pragma unroll
        for (int e = 0; e < 16; ++e) lg[e] = wave_sum(lg[e]);
        if (lane == 0) {
            float mx = lg[0];
#pragma unroll
            for (int e = 1; e < 16; ++e) mx = fmaxf(mx, lg[e]);
            float pr[16], sum = 0.f;
#pragma unroll
            for (int e = 0; e < 16; ++e) { pr[e] = expf(lg[e] - mx); sum += pr[e]; }
            const float isum = 1.f / sum;
            float sel[16];
#pragma unroll
            for (int e = 0; e < 16; ++e) { pr[e] *= isum; sel[e] = pr[e] + p.in[I_RB][e]; }
            int tg = 0; float best = -INFINITY;
#pragma unroll
            for (int gI = 0; gI < 4; ++gI) { const float gs = fmaxf(fmaxf(sel[4 * gI], sel[4 * gI + 1]), fmaxf(sel[4 * gI + 2], sel[4 * gI + 3])); if (gs > best) { best = gs; tg = gI; } }
            int i0 = 0; float b0 = -INFINITY;
#pragma unroll
            for (int e = 0; e < 16; ++e) if ((e >> 2) == tg && sel[e] > b0) { b0 = sel[e]; i0 = e; }
            int i1 = 0; float b1 = -INFINITY;
#pragma unroll
            for (int e = 0; e < 16; ++e) if ((e >> 2) == tg && e != i0 && sel[e] > b1) { b1 = sel[e]; i1 = e; }
            float p0 = 0.f, p1 = 0.f;
#pragma unroll
            for (int e = 0; e < 16; ++e) { if (e == i0) p0 = pr[e]; if (e == i1) p1 = pr[e]; }
            const float inv = 1.f / (p0 + p1);
            const unsigned pos0 = atomicAdd(cnt + i0, 1u), pos1 = atomicAdd(cnt + i1, 1u);
            elist[(size_t)i0 * P + pos0] = r; elist[(size_t)i1 * P + pos1] = r;
            float* tk = topk + (size_t)r * 8;
            ((int*)tk)[0] = i0; ((int*)tk)[1] = i1; ((int*)tk)[2] = (int)pos0; ((int*)tk)[3] = (int)pos1; tk[4] = p0 * inv; tk[5] = p1 * inv;
        }
    }
}

__device__ __forceinline__ void expert_offsets(const unsigned* cnt, int* s_cnt, int* s_off, int* s_tiles) {
    int off = 0;
    if (TIDX == 0) { int tt = 0; for (int e = 0; e < 16; ++e) { const int c = (int)cnt[e]; const int tl = (c + 127) >> 7; s_cnt[e] = c; s_off[e] = off; s_tiles[e] = tt; off += tl * 128; tt += tl; } s_tiles[16] = tt; }
    __syncthreads();
}
__device__ __forceinline__ void phase_e1(const Params& p, int l, char* lds, int bid, int nb) {
    int* s_cnt = (int*)lds; int* s_off = s_cnt + 16; int* s_tiles = s_off + 16;
    expert_offsets((const unsigned*)(p.ws + WS_CTL) + CW_CNT + l * 16, s_cnt, s_off, s_tiles);
    const int tid = TIDX, wid = tid >> 6, lane = tid & 63, c = lane & 15, g = lane >> 4, wr = wid >> 2, wc = wid & 3;
    const bf16_t* H1 = (const bf16_t*)(p.ws + B_H1); const int* elist = (const int*)(p.ws + TAB_ELIST); bf16_t* HID = (bf16_t*)(p.ws + B_HID);
    const int total = s_tiles[16] * 8;
    for (int u = bid; u < total; u += nb) {
        const int rt = u >> 3, ct = u & 7; int e = 0;
        while (e < 15 && rt >= s_tiles[e + 1]) ++e;
        const int ti = rt - s_tiles[e], cntE = s_cnt[e], r0 = ti * 128 + 64 * wr, n0 = ct * 128 + 32 * wc;
        const bf16_t* Wg = (const bf16_t*)(p.ws + W_G_T) + (size_t)e * D * D; const bf16_t* Wu = (const bf16_t*)(p.ws + W_U_T) + (size_t)e * D * D;
        const bf16_t* ap[4];
#pragma unroll
        for (int i = 0; i < 4; ++i) { const int rr = r0 + 16 * i + c; const int tok = elist[(size_t)e * P + (rr < cntE ? rr : 0)]; ap[i] = H1 + (size_t)tok * D + 8 * g; }
        const bf16_t* gp[2]; const bf16_t* up[2];
#pragma unroll
        for (int j = 0; j < 2; ++j) { gp[j] = Wg + (size_t)(n0 + 16 * j + c) * D + 8 * g; up[j] = Wu + (size_t)(n0 + 16 * j + c) * D + 8 * g; }
        f32x4 ag[4][2], au[4][2];
#pragma unroll
        for (int i = 0; i < 4; ++i)
#pragma unroll
            for (int j = 0; j < 2; ++j) { ag[i][j] = (f32x4){0.f, 0.f, 0.f, 0.f}; au[i][j] = (f32x4){0.f, 0.f, 0.f, 0.f}; }
        for (int k0 = 0; k0 < D; k0 += 32) {
            bf16x8 a[4], bg[2], bu[2];
#pragma unroll
            for (int i = 0; i < 4; ++i) a[i] = ld8(ap[i] + k0);
#pragma unroll
            for (int j = 0; j < 2; ++j) { bg[j] = ld8(gp[j] + k0); bu[j] = ld8(up[j] + k0); }
#pragma unroll
            for (int i = 0; i < 4; ++i)
#pragma unroll
                for (int j = 0; j < 2; ++j) { ag[i][j] = mfma16(bg[j], a[i], ag[i][j]); au[i][j] = mfma16(bu[j], a[i], au[i][j]); }
        }
#pragma unroll
        for (int i = 0; i < 4; ++i)
#pragma unroll
            for (int j = 0; j < 2; ++j) { f32x4 o;
#pragma unroll
                for (int r = 0; r < 4; ++r) o[r] = siluf_(ag[i][j][r]) * au[i][j][r];
                store4_bf16(HID + (size_t)(s_off[e] + r0 + 16 * i + c) * D + n0 + 16 * j + 4 * g, o); }
    }
}
__device__ __forceinline__ void phase_e2(const Params& p, int l, char* lds, int bid, int nb) {
    int* s_cnt = (int*)lds; int* s_off = s_cnt + 16; int* s_tiles = s_off + 16;
    expert_offsets((const unsigned*)(p.ws + WS_CTL) + CW_CNT + l * 16, s_cnt, s_off, s_tiles);
    const bf16_t* HID = (const bf16_t*)(p.ws + B_HID); bf16_t* YB = (bf16_t*)(p.ws + B_YB);
    const int total = s_tiles[16] * 4;
    for (int u = bid; u < total; u += nb) {
        const int rt = u >> 2, ct = u & 3; int e = 0;
        while (e < 15 && rt >= s_tiles[e + 1]) ++e;
        const int ti = rt - s_tiles[e];
        sgemm_unit(RowsPlain{HID + (size_t)s_off[e] * D, D}, RowsPlain{(const bf16_t*)(p.ws + W_D_T) + (size_t)e * D * D, D}, D, ti * 128, ct * 256, EpiStore{YB + (size_t)s_off[e] * D, D, 1.f});
    }
}
__device__ __forceinline__ void phase_combine(const Params& p, int l, char* lds, int bid, int nb) {
    const int tid = TIDX, wid = tid >> 6, lane = tid & 63, gw = bid * NW + wid, ngw = nb * NW;
    const bool last = (l == DEPTH - 1);
    if (!last) { convert_weights(p, l + 1, lds, gw, ngw, wid, lane); __syncthreads(); }
    int* s_cnt = (int*)(lds + 65536); int* s_off = s_cnt + 16; int* s_tiles = s_off + 16;
    expert_offsets((const unsigned*)(p.ws + WS_CTL) + CW_CNT + l * 16, s_cnt, s_off, s_tiles);
    float* g8 = (float*)lds;
    if (!last) load_gate_w(p, l + 1, g8);
    const bf16_t* H1 = (const bf16_t*)(p.ws + B_H1); const bf16_t* YB = (const bf16_t*)(p.ws + B_YB); bf16_t* H = (bf16_t*)(p.ws + B_H);
    const float* topk = (const float*)(p.ws + TAB_TOPK);
    for (int r = gw; r < P; r += ngw) {
        if (r < VALID0) { if (!last) { store_row_zero(H + (size_t)r * D, lane); gates_row_pad(p, r, lane); } continue; }
        if (last && r < 256) continue;
        const float* tk = topk + (size_t)r * 8;
        const int e0 = ((const int*)tk)[0], e1 = ((const int*)tk)[1], p0 = ((const int*)tk)[2], p1 = ((const int*)tk)[3]; const float w0 = tk[4], w1 = tk[5];
        const bf16_t* y0 = YB + (size_t)(s_off[e0] + p0) * D; const bf16_t* y1 = YB + (size_t)(s_off[e1] + p1) * D; const bf16_t* hr = H1 + (size_t)r * D;
        f32x4 v[4];
#pragma unroll
        for (int j = 0; j < 4; ++j) { const int cc = 4 * lane + 256 * j; const u32x2 a = *(const u32x2*)(y0 + cc), b = *(const u32x2*)(y1 + cc), hh = *(const u32x2*)(hr + cc);
            v[j].x = DN_ALPHA * bf2f(hh.x & 0xffffu) + w0 * bf2f(a.x & 0xffffu) + w1 * bf2f(b.x & 0xffffu);
            v[j].y = DN_ALPHA * bf2f(hh.x >> 16) + w0 * bf2f(a.x >> 16) + w1 * bf2f(b.x >> 16);
            v[j].z = DN_ALPHA * bf2f(hh.y & 0xffffu) + w0 * bf2f(a.y & 0xffffu) + w1 * bf2f(b.y & 0xffffu);
            v[j].w = DN_ALPHA * bf2f(hh.y >> 16) + w0 * bf2f(a.y >> 16) + w1 * bf2f(b.y >> 16); }
        ln_normalize(v, p.in[I_LN2G] + (size_t)l * D, p.in[I_LN2B] + (size_t)l * D, lane);
        if (last) {
            float* o = p.out + (size_t)(r - 256) * D;
#pragma unroll
            for (int j = 0; j < 4; ++j) *(f32x4*)(o + 4 * lane + 256 * j) = v[j];
        } else { store_row_bf16(H + (size_t)r * D, v, lane); gates_row(p, l + 1, g8, v, r, lane); }
    }
}

#define XB_TMO      128
#define XB_XCNT(j)  (256  + 64 * (j))
#define XB_XSUB(j)  (1280 + 64 * (j))
#define XB_XGEN(j)  (2304 + 64 * (j))
#define XB_TOP      3328
#define XB_TOPGEN   3392
#define XCD_BAR_WORDS 3456
#define XB_SPIN_CAP (1u << 18)
#define LAS __attribute__((address_space(3)))

__device__ __forceinline__ unsigned xb_ld(unsigned* p)              { return __hip_atomic_load(p, __ATOMIC_RELAXED, __HIP_MEMORY_SCOPE_AGENT); }
__device__ __forceinline__ unsigned xb_add(unsigned* p, unsigned v) { return __hip_atomic_fetch_add(p, v, __ATOMIC_RELAXED, __HIP_MEMORY_SCOPE_AGENT); }
__device__ __forceinline__ unsigned xb_xcc_id() { return (unsigned)__builtin_amdgcn_s_getreg((3 << 11) | 20) & 0xFu; }
#define XB_SPIN(cond, bar) do { unsigned _sp = 0; while (cond) { __builtin_amdgcn_s_sleep(1); \
    if ((++_sp & 255u) == 0u) { if (xb_ld(&(bar)[XB_TMO])) break; if (_sp > XB_SPIN_CAP) { atomicAdd(&(bar)[XB_TMO], 1u); break; } } } } while (0)

struct XcdBarrier {
    unsigned* bar; unsigned x;
    volatile LAS unsigned* st;
};
__device__ __forceinline__ XcdBarrier xcd_barrier_post(unsigned* bar, volatile LAS unsigned* st) {
    XcdBarrier b; b.bar = bar; b.x = xb_xcc_id(); b.st = st;
    if (threadIdx.x == 0) (void)xb_add(&bar[XB_XCNT(b.x)], 1u);
    return b;
}
__device__ __forceinline__ void xcd_barrier_complete(unsigned* bar, unsigned x, unsigned& nloc, unsigned& nx) {
    const unsigned G = gridDim.x * gridDim.y * gridDim.z;
    unsigned sum, cnt, mine, sp = 0u;
    for (;;) {
        sum = 0u; cnt = 0u; mine = 0u;
#pragma unroll
        for (unsigned j = 0; j < 16; ++j) { const unsigned c = xb_ld(&bar[XB_XCNT(j)]); sum += c; cnt += (c > 0u) ? 1u : 0u; mine = (j == x) ? c : mine; }
        if (sum == G) break;
        __builtin_amdgcn_s_sleep(1);
        if ((++sp & 255u) == 0u) { if (xb_ld(&bar[XB_TMO])) break; if (sp > XB_SPIN_CAP) { atomicAdd(&bar[XB_TMO], 1u); break; } }
    }
    nloc = mine > 0u ? mine : 1u; nx = cnt > 0u ? cnt : 1u;
}
__device__ __forceinline__ void xcd_barrier(const XcdBarrier& b) {
    asm volatile("s_waitcnt vmcnt(0)" ::: "memory");
    __syncthreads();
    if (threadIdx.x == 0) {
        unsigned* bar = b.bar;
        __builtin_amdgcn_s_waitcnt(0);
        unsigned nloc = b.st[0], nx = b.st[1];
        if (nloc == 0u) { xcd_barrier_complete(bar, b.x, nloc, nx); b.st[0] = nloc; b.st[1] = nx; }
        const unsigned old = xb_add(&bar[XB_XSUB(b.x)], 1u);
        const unsigned gen = old / nloc;
        if (old + 1u == (gen + 1u) * nloc) {
            __builtin_amdgcn_fence(__ATOMIC_RELEASE, "agent");
            asm volatile("s_waitcnt vmcnt(0)" ::: "memory");
            const unsigned og = xb_add(&bar[XB_TOP], 1u);
            const unsigned tg = og / nx;
            if (og + 1u == (tg + 1u) * nx) xb_add(&bar[XB_TOPGEN], 1u);
            else XB_SPIN(xb_ld(&bar[XB_TOPGEN]) == tg, bar);
            __builtin_amdgcn_fence(__ATOMIC_ACQUIRE, "agent");
            xb_add(&bar[XB_XGEN(b.x)], 1u);
            asm volatile("s_waitcnt vmcnt(0)" ::: "memory");
        } else {
            XB_SPIN(xb_ld(&bar[XB_XGEN(b.x)]) == gen, bar);
            __builtin_amdgcn_fence(__ATOMIC_ACQUIRE, "agent");
            asm volatile("s_waitcnt vmcnt(0)" ::: "memory");
        }
    }
    __syncthreads();
}

constexpr int LDS_BYTES = 131072 + 1024;
constexpr int LDS_BAR_OFF = LDS_BYTES - 16;
constexpr int CW_BAR = 4096;
template <int L>
__device__ __forceinline__ void layer_body(const Params& p, char* lds, int bid, int nb, const XcdBarrier& bar) {
    phase_proj_f(p, lds, bid, nb); xcd_barrier(bar);
    phase_attn(p, L, lds, bid, nb); xcd_barrier(bar);
    phase_conv(p, L, lds, bid, nb); xcd_barrier(bar);
    phase_mqkv(p, lds, bid, nb); xcd_barrier(bar);
    phase_m1(p, lds, bid, nb); xcd_barrier(bar);
    phase_m2(p, lds, bid, nb); xcd_barrier(bar);
    phase_m3(p, L, lds, bid, nb); xcd_barrier(bar);
    phase_br1(p, lds, bid, nb); xcd_barrier(bar);
    phase_br2(p, lds, bid, nb); xcd_barrier(bar);
    phase_out(p, lds, bid, nb); xcd_barrier(bar);
    phase_ln1(p, L, lds, bid, nb); xcd_barrier(bar);
    phase_e1(p, L, lds, bid, nb); xcd_barrier(bar);
    phase_e2(p, L, lds, bid, nb); xcd_barrier(bar);
    phase_combine(p, L, lds, bid, nb); if (L + 1 < DEPTH) xcd_barrier(bar);
}
__global__ void __launch_bounds__(NT, 2) fwd_kernel(Params p) {
    extern __shared__ __attribute__((aligned(16))) char lds[];
    const int bid = blockIdx.x, nb = gridDim.x;
    if (threadIdx.x == 0) *(uint4*)(lds + LDS_BAR_OFF) = make_uint4(0u, 0u, 0u, 0u);
    __syncthreads();
    XcdBarrier bar = xcd_barrier_post((unsigned*)(p.ws + WS_CTL) + CW_BAR, (volatile LAS unsigned*)(lds + LDS_BAR_OFF));
    phase_prologue(p, lds, bid, nb); xcd_barrier(bar);
    layer_body<0>(p, lds, bid, nb, bar);
    layer_body<1>(p, lds, bid, nb, bar);
}

extern "C" void kernel_launch(void* const* d_in, const int* in_sizes, int n_in, void* d_out, int out_size, void* d_ws, size_t ws_size, hipStream_t stream) {
    if (n_in != 30 || ws_size < WS_END) { fprintf(stderr, "kernel_launch: unexpected n_in %d or ws_size %zu (< %zu)\n", n_in, ws_size, (size_t)WS_END); return; }
    static int grid = 0;
    if (grid == 0) {
        int dev = 0, cus = 0;
        if (hipGetDevice(&dev) != hipSuccess || hipDeviceGetAttribute(&cus, hipDeviceAttributeMultiprocessorCount, dev) != hipSuccess || cus <= 0) cus = 256;
        (void)hipFuncSetAttribute((const void*)fwd_kernel, hipFuncAttributeMaxDynamicSharedMemorySize, LDS_BYTES);
        grid = cus;
    }
    Params p{};
    for (int i = 0; i < 30; ++i) p.in[i] = (const float*)d_in[i];
    p.out = (float*)d_out; p.ws = (unsigned char*)d_ws;
    (void)hipMemsetAsync((char*)d_ws + WS_CTL, 0, CTL_BYTES, stream);
    hipLaunchKernelGGL(fwd_kernel, dim3(grid), dim3(NT), LDS_BYTES, stream, p);
}
```

```cpp
#include <hip/hip_runtime.h>
#include <cstdio>
#include <cstdint>

constexpr int D = 1024;
constexpr int SEQ = 16384;
constexpr int NMETA = 16;
constexpr int P = 16640;
constexpr int VALID0 = 240;
constexpr int DEPTH = 2;
constexpr int DIN = 7176;
constexpr int NSC = 65;
constexpr int NEXP = 16;
constexpr float LN_EPS = 1e-5f;
constexpr float DN_ALPHA = 1.4142135623730951f;
constexpr float NEGBIG = -1e30f;
constexpr int NT = 512;
constexpr int NW = 8;

typedef unsigned short bf16_t;
typedef short bf16x8 __attribute__((ext_vector_type(8)));
typedef float f32x4 __attribute__((ext_vector_type(4)));
typedef unsigned u32x4 __attribute__((ext_vector_type(4)));
typedef unsigned u32x2 __attribute__((ext_vector_type(2)));

constexpr size_t MiB = 1u << 20;
constexpr size_t RB = (size_t)P * D * 2;
constexpr size_t WS_CTL = 0;
constexpr size_t CTL_BYTES = 1 * MiB;
constexpr size_t WS_TAB = 1 * MiB;
constexpr size_t TAB_GLI = WS_TAB;
constexpr size_t TAB_GLF = TAB_GLI + 4 * P * 4;
constexpr size_t TAB_B   = TAB_GLF + 4 * P * 4;
constexpr size_t TAB_E   = TAB_B + 4 * P * 4;
constexpr size_t TAB_PM  = TAB_E + 4 * P * 4;
constexpr size_t TAB_W   = TAB_PM + 4 * P * 4;
constexpr size_t TAB_SCG = TAB_W + 4 * P * 4;
constexpr size_t TAB_SCM = TAB_SCG + 4096;
constexpr size_t TAB_MT  = TAB_SCM + 4096;
constexpr size_t TAB_NT  = TAB_MT + 4096;
constexpr size_t TAB_TOPK = TAB_NT + (size_t)NSC * 4 * 256 * 4;
constexpr size_t TAB_ELIST = TAB_TOPK + (size_t)P * 32;
constexpr size_t TAB_END = TAB_ELIST + (size_t)NEXP * P * 4;
static_assert(TAB_END <= 8 * MiB, "tables");
constexpr size_t WS_W = 8 * MiB;
constexpr size_t W_IN_T = WS_W;
constexpr size_t W_Q_T = W_IN_T + (size_t)7168 * 1024 * 2;
constexpr size_t W_K_T = W_Q_T + 4 * 65536 * 2;
constexpr size_t W_V_T = W_K_T + 4 * 65536 * 2;
constexpr size_t W_BM_T = W_V_T + 4 * 65536 * 2;
constexpr size_t W_BA_T = W_BM_T + (size_t)D * D * 2;
constexpr size_t W_OUT_T = W_BA_T + (size_t)D * D * 2;
constexpr size_t W_G_T = W_OUT_T + (size_t)D * D * 2;
constexpr size_t W_U_T = W_G_T + (size_t)NEXP * D * D * 2;
constexpr size_t W_D_T = W_U_T + (size_t)NEXP * D * D * 2;
constexpr size_t W_END = W_D_T + (size_t)NEXP * D * D * 2;
static_assert(W_END <= 128 * MiB, "weights");
constexpr size_t WS_SLOT = 128 * MiB;
constexpr size_t SLOT(int i) { return WS_SLOT + (size_t)i * RB; }
constexpr size_t WS_END = WS_SLOT + 11 * RB;
constexpr size_t B_H = SLOT(0);
constexpr size_t B_XM = SLOT(1), B_YM = SLOT(1);
constexpr size_t B_OP = SLOT(2), B_MRGB = SLOT(2);
constexpr size_t B_QA = SLOT(3), B_QM = SLOT(3);
constexpr size_t B_KA = SLOT(4), B_XC = SLOT(4), B_CT = SLOT(4);
constexpr size_t B_VAT = SLOT(5), B_KM = SLOT(5), B_H1 = SLOT(5);
constexpr size_t B_GA = SLOT(6);
constexpr size_t B_GB = SLOT(7);
constexpr size_t B_YA = SLOT(8);
constexpr size_t B_KMT = SLOT(9), B_MRG = SLOT(9);
constexpr size_t B_VMT = SLOT(10), B_VA = SLOT(10);
constexpr size_t B_Z = SLOT(3);
constexpr size_t B_HID = SLOT(6);
constexpr size_t B_YB = SLOT(1), B_XP = SLOT(1);
constexpr int HID_ROWS_MAX = (int)(3 * RB / (D * 2));
constexpr int CW_CNT = 64;

struct Params {
    const float* in[30];
    float* out;
    unsigned char* ws;
};
enum { I_X = 0, I_META, I_LNG, I_LNB, I_WIN, I_CONVW, I_CONVB, I_WQM, I_WKM, I_WVM, I_BI, I_BF, I_MNG, I_LQ1, I_LK1, I_LQ2, I_LK2, I_ANG,
       I_WBM, I_WBA, I_WOUT, I_LN1G, I_LN1B, I_LN2G, I_LN2B, I_WR, I_RB, I_WG, I_WU, I_WD };

__device__ __forceinline__ int tid_opaque() { int t = threadIdx.x; asm volatile("" : "+v"(t)); return t; }
#define TIDX tid_opaque()
__device__ __forceinline__ float bf2f(unsigned v) { return __uint_as_float(v << 16); }
__device__ __forceinline__ unsigned f2bf(float f) { unsigned u = __float_as_uint(f); return (u + 0x7fffu + ((u >> 16) & 1u)) >> 16; }
__device__ __forceinline__ unsigned pk2(float lo, float hi) { return f2bf(lo) | (f2bf(hi) << 16); }
__device__ __forceinline__ float wave_sum(float v) {
#pragma unroll
    for (int o = 1; o < 64; o <<= 1) v += __shfl_xor(v, o);
    return v;
}
__device__ __forceinline__ float sigmoidf_(float x) { return 1.f / (1.f + __expf(-x)); }
__device__ __forceinline__ float siluf_(float x) { return x / (1.f + __expf(-x)); }
__device__ __forceinline__ float logsigmoidf_(float x) { return x >= 0.f ? -log1pf(__expf(-x)) : x - log1pf(__expf(x)); }
__device__ __forceinline__ f32x4 mfma16(bf16x8 a, bf16x8 b, f32x4 c) { return __builtin_amdgcn_mfma_f32_16x16x32_bf16(a, b, c, 0, 0, 0); }
__device__ __forceinline__ bf16x8 ld8(const bf16_t* p) { return *(const bf16x8*)p; }

__device__ __forceinline__ void transpose_item(const float* W, int K, size_t ldsrc, int k0, int n_src0, bf16_t* WT, int dst_row0, float* scr, int lane) {
#pragma unroll 8
    for (int i = 0; i < 32; ++i) { const int kk = 2 * i + (lane >> 5); scr[kk * 33 + (lane & 31)] = W[(size_t)(k0 + kk) * ldsrc + n_src0 + (lane & 31)]; }
    __builtin_amdgcn_wave_barrier();
    asm volatile("s_waitcnt lgkmcnt(0)" ::: "memory");
    const int c = lane & 7;
#pragma unroll
    for (int j = 0; j < 4; ++j) { const int n = (lane >> 3) + 8 * j; const float* s = scr + (8 * c) * 33 + n;
        u32x4 o; o.x = pk2(s[0 * 33], s[1 * 33]); o.y = pk2(s[2 * 33], s[3 * 33]); o.z = pk2(s[4 * 33], s[5 * 33]); o.w = pk2(s[6 * 33], s[7 * 33]);
        *(u32x4*)(WT + (size_t)(dst_row0 + n) * K + k0 + 8 * c) = o; }
    asm volatile("s_waitcnt lgkmcnt(0)" ::: "memory");
    __builtin_amdgcn_wave_barrier();
}
__device__ __forceinline__ void convert_weights(const Params& p, int l, char* lds, int gw, int ngw, int wid, int lane) {
    float* scr = (float*)lds + wid * (64 * 33);
    unsigned char* ws = p.ws;
    constexpr int I_IN = 16 * 224, I_QKV = 3 * 4 * 4 * 8, I_SQ = 16 * 32, I_EXP = 3 * 16 * 512;
    constexpr int TOTAL = I_IN + I_QKV + 3 * I_SQ + I_EXP;
    for (int it = gw; it < TOTAL; it += ngw) {
        int r = it;
        if (r < I_IN) { const int kb = r / 224, nb = r % 224, r0 = nb * 32, nsrc = r0 < 2048 ? r0 : r0 + 8;
            transpose_item(p.in[I_WIN] + (size_t)l * D * DIN, D, DIN, kb * 64, nsrc, (bf16_t*)(ws + W_IN_T), r0, scr, lane); continue; }
        r -= I_IN;
        if (r < I_QKV) { const int w = r / 128, rr = r % 128, h = rr / 32, t = rr % 32, kb = t / 8, nb = t % 8;
            const float* src = p.in[w == 0 ? I_WQM : (w == 1 ? I_WKM : I_WVM)] + ((size_t)l * 4 + h) * 65536;
            bf16_t* dst = (bf16_t*)(ws + (w == 0 ? W_Q_T : (w == 1 ? W_K_T : W_V_T))) + (size_t)h * 65536;
            transpose_item(src, 256, 256, kb * 64, nb * 32, dst, nb * 32, scr, lane); continue; }
        r -= I_QKV;
        if (r < 3 * I_SQ) { const int w = r / I_SQ, t = r % I_SQ, kb = t / 32, nb = t % 32;
            const float* src = p.in[w == 0 ? I_WBM : (w == 1 ? I_WBA : I_WOUT)] + (size_t)l * D * D;
            bf16_t* dst = (bf16_t*)(ws + (w == 0 ? W_BM_T : (w == 1 ? W_BA_T : W_OUT_T)));
            transpose_item(src, D, D, kb * 64, nb * 32, dst, nb * 32, scr, lane); continue; }
        r -= 3 * I_SQ;
        { const int w = r / (16 * 512), rr = r % (16 * 512), e = rr / 512, t = rr % 512, kb = t / 32, nb = t % 32;
            const float* src = p.in[w == 0 ? I_WG : (w == 1 ? I_WU : I_WD)] + ((size_t)l * NEXP + e) * D * D;
            bf16_t* dst = (bf16_t*)(ws + (w == 0 ? W_G_T : (w == 1 ? W_U_T : W_D_T))) + (size_t)e * D * D;
            transpose_item(src, D, D, kb * 64, nb * 32, dst, nb * 32, scr, lane); }
    }
}

__device__ __forceinline__ void ln_normalize(f32x4 (&v)[4], const float* g, const float* b, int lane) {
    float s = 0.f;
#pragma unroll
    for (int j = 0; j < 4; ++j) s += (v[j].x + v[j].y) + (v[j].z + v[j].w);
    const float mean = wave_sum(s) * (1.f / D);
    float s2 = 0.f;
#pragma unroll
    for (int j = 0; j < 4; ++j) { v[j] = v[j] - mean; s2 += (v[j].x * v[j].x + v[j].y * v[j].y) + (v[j].z * v[j].z + v[j].w * v[j].w); }
    const float rstd = rsqrtf(wave_sum(s2) * (1.f / D) + LN_EPS);
#pragma unroll
    for (int j = 0; j < 4; ++j) { const f32x4 gg = *(const f32x4*)(g + 4 * lane + 256 * j), bb = *(const f32x4*)(b + 4 * lane + 256 * j); v[j] = v[j] * rstd * gg + bb; }
}
__device__ __forceinline__ void store_row_bf16(bf16_t* row, const f32x4 (&v)[4], int lane) {
#pragma unroll
    for (int j = 0; j < 4; ++j) { u32x2 o; o.x = pk2(v[j].x, v[j].y); o.y = pk2(v[j].z, v[j].w); *(u32x2*)(row + 4 * lane + 256 * j) = o; }
}
__device__ __forceinline__ void store_row_zero(bf16_t* row, int lane) {
#pragma unroll
    for (int j = 0; j < 4; ++j) { u32x2 o; o.x = 0u; o.y = 0u; *(u32x2*)(row + 4 * lane + 256 * j) = o; }
}
__device__ __forceinline__ void load_gate_w(const Params& p, int l, float* g8) {
    const float* w = p.in[I_WIN] + (size_t)l * D * DIN + 2048;
    for (int i = TIDX; i < D * 8; i += NT) { const int k = i >> 3, c = i & 7; g8[i] = w[(size_t)k * DIN + c]; }
    __syncthreads();
}
__device__ __forceinline__ void gates_row(const Params& p, int l, const float* g8, const f32x4 (&v)[4], int prow, int lane) {
    float acc[8];
#pragma unroll
    for (int c = 0; c < 8; ++c) acc[c] = 0.f;
#pragma unroll
    for (int j = 0; j < 4; ++j)
#pragma unroll
        for (int i = 0; i < 4; ++i) { const int k = 4 * lane + 256 * j + i; const float x = v[j][i];
            const f32x4 w0 = *(const f32x4*)(g8 + k * 8), w1 = *(const f32x4*)(g8 + k * 8 + 4);
            acc[0] += x * w0.x; acc[1] += x * w0.y; acc[2] += x * w0.z; acc[3] += x * w0.w; acc[4] += x * w1.x; acc[5] += x * w1.y; acc[6] += x * w1.z; acc[7] += x * w1.w; }
#pragma unroll
    for (int c = 0; c < 8; ++c) acc[c] = wave_sum(acc[c]);
    if (lane < 4) {
        float* gli = (float*)(p.ws + TAB_GLI); float* glf = (float*)(p.ws + TAB_GLF);
        const float bi = p.in[I_BI][l * 4 + lane], bfv = p.in[I_BF][l * 4 + lane];
        float ai = acc[0], af = acc[4];
        if (lane == 1) { ai = acc[1]; af = acc[5]; } else if (lane == 2) { ai = acc[2]; af = acc[6]; } else if (lane == 3) { ai = acc[3]; af = acc[7]; }
        gli[(size_t)lane * P + prow] = ai + bi;
        glf[(size_t)lane * P + prow] = logsigmoidf_(af + bfv);
    }
}
__device__ __forceinline__ void gates_row_pad(const Params& p, int prow, int lane) {
    if (lane < 4) { ((float*)(p.ws + TAB_GLI))[(size_t)lane * P + prow] = NEGBIG; ((float*)(p.ws + TAB_GLF))[(size_t)lane * P + prow] = 0.f; }
}

__device__ __forceinline__ void phase_prologue(const Params& p, char* lds, int bid, int nb) {
    const int tid = TIDX, wid = tid >> 6, lane = tid & 63, gw = bid * NW + wid, ngw = nb * NW;
    convert_weights(p, 0, lds, gw, ngw, wid, lane);
    __syncthreads();
    float* g8 = (float*)lds;
    load_gate_w(p, 0, g8);
    bf16_t* H = (bf16_t*)(p.ws + B_H);
    for (int r = gw; r < P; r += ngw) {
        if (r < VALID0) { store_row_zero(H + (size_t)r * D, lane); gates_row_pad(p, r, lane); continue; }
        const float* src = r < 256 ? p.in[I_META] + (size_t)(r - VALID0) * D : p.in[I_X] + (size_t)(r - 256) * D;
        f32x4 v[4];
#pragma unroll
        for (int j = 0; j < 4; ++j) v[j] = *(const f32x4*)(src + 4 * lane + 256 * j);
        ln_normalize(v, p.in[I_LNG], p.in[I_LNB], lane);
        store_row_bf16(H + (size_t)r * D, v, lane);
        gates_row(p, 0, g8, v, r, lane);
    }
}

struct RowsPlain { const bf16_t* base; size_t ld; __device__ __forceinline__ const bf16_t* row(int m) const { return base + (size_t)m * ld; } };
template <class AR, class BR, class Epi>
__device__ __forceinline__ void sgemm_unit(const AR& ar, const BR& br, int K, int m0, int n0, const Epi& epi) {
    const int tid = TIDX, wid = tid >> 6, lane = tid & 63, c = lane & 15, g = lane >> 4, wr = wid >> 2, wc = wid & 3;
    const int mw = m0 + 64 * wr, nw = n0 + 64 * wc;
    const bf16_t* ap[4]; const bf16_t* bp[4];
#pragma unroll
    for (int i = 0; i < 4; ++i) { ap[i] = ar.row(mw + 16 * i + c) + 8 * g; bp[i] = br.row(nw + 16 * i + c) + 8 * g; }
    f32x4 acc[4][4];
#pragma unroll
    for (int i = 0; i < 4; ++i)
#pragma unroll
        for (int j = 0; j < 4; ++j) acc[i][j] = (f32x4){0.f, 0.f, 0.f, 0.f};
    for (int k0 = 0; k0 < K; k0 += 32) {
        bf16x8 a[4], b[4];
#pragma unroll
        for (int i = 0; i < 4; ++i) { a[i] = ld8(ap[i] + k0); b[i] = ld8(bp[i] + k0); }
#pragma unroll
        for (int i = 0; i < 4; ++i)
#pragma unroll
            for (int j = 0; j < 4; ++j) acc[i][j] = mfma16(b[j], a[i], acc[i][j]);
    }
#pragma unroll
    for (int i = 0; i < 4; ++i)
#pragma unroll
        for (int j = 0; j < 4; ++j) epi(mw + 16 * i + c, nw + 16 * j + 4 * g, acc[i][j]);
}
__device__ __forceinline__ void store4_bf16(bf16_t* dst, f32x4 v) { u32x2 o; o.x = pk2(v.x, v.y); o.y = pk2(v.z, v.w); *(u32x2*)dst = o; }

struct EpiProj { unsigned char* ws;
    __device__ __forceinline__ void operator()(int m, int n, f32x4 v) const {
        const int seg = n >> 10, cc = n & 1023;
        const size_t off = seg == 0 ? B_XM : seg == 1 ? B_OP : seg == 2 ? B_QA : seg == 3 ? B_KA : seg == 4 ? B_VA : seg == 5 ? B_GA : B_GB;
        store4_bf16((bf16_t*)(ws + off) + (size_t)m * D + cc, v); } };
struct EpiStore { bf16_t* C; size_t ldc; float scale;
    __device__ __forceinline__ void operator()(int m, int n, f32x4 v) const { store4_bf16(C + (size_t)m * ldc + n, v * scale); } };
__device__ __forceinline__ void phase_proj(const Params& p, char* lds, int bid, int nb) {
    const bf16_t* H = (const bf16_t*)(p.ws + B_H); const bf16_t* W = (const bf16_t*)(p.ws + W_IN_T);
    constexpr int NU_MAIN = 130 * 24, NU_VAT = 8 * 65;
    for (int u = bid; u < NU_MAIN + NU_VAT; u += nb) {
        if (u < NU_MAIN) { const int mt = u / 24; int ct = u % 24; if (ct >= 16) ct += 4;
            sgemm_unit(RowsPlain{H, D}, RowsPlain{W, D}, D, mt * 128, ct * 256, EpiProj{p.ws});
        } else { const int v = u - NU_MAIN, mt = v / 65, ct = v % 65;
            sgemm_unit(RowsPlain{W + (size_t)4096 * D, D}, RowsPlain{H, D}, D, mt * 128, ct * 256, EpiStore{(bf16_t*)(p.ws + B_VAT), P, 1.f}); }
    }
}

namespace pg8 {
#define PG8_LAS __attribute__((address_space(3)))
constexpr int BM = 256, BK = 64, HALF = 128, HTB = HALF * BK * 2, STAGE_BYTES = 8 * HTB, NXCD = 8, WGM = 8;
__host__ __device__ __forceinline__ int lds_byte(int r, int c) { const int st = (r >> 4) * 2 + (c >> 5), rr = r & 15, cc = c & 31, ob = rr * 64 + cc * 2; return st * 1024 + (ob ^ (((ob >> 9) & 1) << 5)); }
__host__ __device__ __forceinline__ void stage_rc(int b, int& R, int& C) { const int st = b / 1024, sb = b % 1024, swz = sb ^ (((sb >> 9) & 1) << 5); R = (st >> 1) * 16 + swz / 64; C = (st & 1) * 32 + (swz % 64) / 2; }
__host__ __device__ __forceinline__ int perm32(int rho) { const int n = rho >> 4, i = rho & 15; return 8 * (i >> 2) + 4 * n + (i & 3); }
struct Unit { int pm, pn, grp; };
__device__ __forceinline__ bool decode_unit(long L, int nG, int nM, int nN, Unit& u) {
    const int nwg = nG * nM * nN; if (L >= nwg) return false;
    int wgid = (int)L; { const int q = nwg / NXCD, r = nwg % NXCD, xcd = wgid % NXCD, off = wgid / NXCD; wgid = (xcd < r ? xcd * (q + 1) : r * (q + 1) + (xcd - r) * q) + off; }
    const int per = nM * nN; u.grp = wgid / per; const int rem = wgid % per;
    const int nig = WGM * nN, gid = rem / nig, fm = gid * WGM, gsz = (nM - fm) < WGM ? (nM - fm) : WGM;
    u.pm = __builtin_amdgcn_readfirstlane(fm + ((rem % nig) % gsz)); u.pn = __builtin_amdgcn_readfirstlane((rem % nig) / gsz); u.grp = __builtin_amdgcn_readfirstlane(u.grp); return true;
}
__device__ __forceinline__ unsigned cvt_pk_bf16(float lo, float hi) { unsigned r; asm volatile("v_cvt_pk_bf16_f32 %0, %1, %2" : "=v"(r) : "v"(lo), "v"(hi)); return r; }

template <class Epi, class Sched, bool ALIGN_EPI = true>
__device__ __forceinline__ void gemm_phase(PG8_LAS unsigned char* lds, const Sched& S, const Epi& E) {
    const int tid = TIDX, wid = __builtin_amdgcn_readfirstlane(tid >> 6), lane = tid & 63, wr = wid >> 2, wc = wid & 3, fr = lane & 15, fq = lane >> 4;
    const int K = S.K, nt = K / BK;
    unsigned voffA[2], voffB[2];
#pragma unroll
    for (int i = 0; i < 2; ++i) { int R, C; stage_rc(tid * 16 + i * 8192, R, C); const int Rb = (R & ~31) + perm32(R & 31);
        voffA[i] = (unsigned)(R * S.lda + C) * 2u; voffB[i] = (unsigned)(Rb * S.ldb + C) * 2u; }
    const size_t kstep = (size_t)(BK * 2);
    const size_t hstepA = (size_t)HALF * S.lda * 2, hstepB = (size_t)HALF * S.ldb * 2;
    const unsigned ldsw = (unsigned)wid * 1024u;
    const int aoff = lds_byte(wr * 64 + fr, fq * 8), boff = lds_byte(wc * 32 + fr, fq * 8);
#define PG8_SA(b, h) (((b) * 2 + (h)) * HTB)
#define PG8_SB(b, h) ((4 + (b) * 2 + (h)) * HTB)
#define PG8_STAGE(bufoff, gbase, voff) do { _Pragma("unroll") for (int _i = 0; _i < 2; ++_i) \
        __builtin_amdgcn_global_load_lds((const unsigned*)((const char*)(gbase) + (voff)[_i]), (PG8_LAS unsigned*)(lds + (bufoff) + ldsw + _i * 8192), 16, 0, 0); } while (0)
#define PG8_LDA(dst, b, h) do { _Pragma("unroll") for (int m = 0; m < 4; ++m) _Pragma("unroll") for (int k = 0; k < 2; ++k) dst[m][k] = *(const PG8_LAS bf16x8*)(lds + PG8_SA(b, h) + aoff + m * 2048 + k * 1024); } while (0)
#define PG8_LDB(dst, b, h) do { _Pragma("unroll") for (int n = 0; n < 2; ++n) _Pragma("unroll") for (int k = 0; k < 2; ++k) dst[n][k] = *(const PG8_LAS bf16x8*)(lds + PG8_SB(b, h) + boff + n * 2048 + k * 1024); } while (0)
#define PG8_MMA(ai, bj, At, Bt) do { __builtin_amdgcn_s_setprio(1); _Pragma("unroll") for (int m = 0; m < 4; ++m) _Pragma("unroll") for (int n = 0; n < 2; ++n) _Pragma("unroll") for (int k = 0; k < 2; ++k) \
        acc[ai][bj][m][n] = __builtin_amdgcn_mfma_f32_16x16x32_bf16(Bt[n][k], At[m][k], acc[ai][bj][m][n], 0, 0, 0); __builtin_amdgcn_s_setprio(0); } while (0)
#define PG8_WAIT_V(n) asm volatile("s_waitcnt vmcnt(" #n ")" ::: "memory")
#define PG8_WAIT_L(n) asm volatile("s_waitcnt lgkmcnt(" #n ")" ::: "memory")
#define PG8_BAR __builtin_amdgcn_s_barrier()
#define PG8_SCHED __builtin_amdgcn_sched_barrier(0)
    Unit cur, nxt; int ui = 0;
    if (!S.next(0, cur)) return;
    f32x4 acc[2][2][4][2];
#pragma unroll
    for (int a = 0; a < 2; ++a)
#pragma unroll
        for (int b = 0; b < 2; ++b)
#pragma unroll
            for (int m = 0; m < 4; ++m)
#pragma unroll
                for (int n = 0; n < 2; ++n) acc[a][b][m][n] = (f32x4){0.f, 0.f, 0.f, 0.f};
    bf16x8 At[4][2], B0[2][2], B1[2][2];
    const char* cA = S.abase(cur); const char* cB = S.bbase(cur);
    PG8_STAGE(PG8_SB(0, 0), cB, voffB); PG8_STAGE(PG8_SB(0, 1), cB + hstepB, voffB); PG8_STAGE(PG8_SA(0, 0), cA, voffA); PG8_STAGE(PG8_SA(0, 1), cA + hstepA, voffA);
    if (wr == 1) PG8_BAR;
    PG8_WAIT_V(2); PG8_BAR;
    PG8_STAGE(PG8_SB(1, 0), cB + kstep, voffB); PG8_STAGE(PG8_SA(1, 0), cA + kstep, voffA); PG8_STAGE(PG8_SB(1, 1), cB + hstepB + kstep, voffB);
    PG8_WAIT_V(6); PG8_BAR;
    for (;;) {
        const bool has_next = S.next(ui + 1, nxt);
        const char* nA = has_next ? S.abase(nxt) : cA; const char* nB = has_next ? S.bbase(nxt) : cB;
        for (int t = 0; t < nt; t += 2) {
            const bool last = (t == nt - 2);
            const char* a1 = cA + (size_t)(t + 1) * kstep;
            const char* a2 = last ? nA : cA + (size_t)(t + 2) * kstep; const char* b2 = last ? nB : cB + (size_t)(t + 2) * kstep;
            const char* a3 = a2 + kstep; const char* b3 = b2 + kstep;
            PG8_LDB(B0, 0, 0); PG8_LDB(B1, 0, 1); PG8_SCHED; PG8_LDA(At, 0, 0); PG8_STAGE(PG8_SA(1, 1), a1 + hstepA, voffA);
            PG8_WAIT_V(8); PG8_WAIT_L(0); PG8_BAR; PG8_MMA(0, 0, At, B0); PG8_MMA(0, 1, At, B1); PG8_BAR; PG8_SCHED;
            PG8_LDA(At, 0, 1); PG8_STAGE(PG8_SB(0, 0), b2, voffB); PG8_STAGE(PG8_SB(0, 1), b2 + hstepB, voffB); PG8_STAGE(PG8_SA(0, 0), a2, voffA);
            PG8_WAIT_V(8); PG8_WAIT_L(0); PG8_BAR; PG8_MMA(1, 0, At, B0); PG8_MMA(1, 1, At, B1); PG8_BAR; PG8_SCHED;
            PG8_LDB(B0, 1, 0); PG8_LDB(B1, 1, 1); PG8_SCHED; PG8_LDA(At, 1, 0); PG8_STAGE(PG8_SA(0, 1), a2 + hstepA, voffA);
            PG8_WAIT_V(8); PG8_WAIT_L(0); PG8_BAR; PG8_MMA(0, 0, At, B0); PG8_MMA(0, 1, At, B1); PG8_BAR; PG8_SCHED;
            PG8_LDA(At, 1, 1); PG8_STAGE(PG8_SB(1, 0), b3, voffB); PG8_STAGE(PG8_SB(1, 1), b3 + hstepB, voffB); PG8_STAGE(PG8_SA(1, 0), a3, voffA);
            PG8_WAIT_V(8); PG8_WAIT_L(0); PG8_BAR; PG8_MMA(1, 0, At, B0); PG8_MMA(1, 1, At, B1); PG8_BAR; PG8_SCHED;
        }
        if constexpr (ALIGN_EPI) { if (wr == 0) PG8_BAR; }
        E(acc, cur, wr, wc, fr, fq);
        if (!has_next) break;
#pragma unroll
        for (int a = 0; a < 2; ++a)
#pragma unroll
            for (int b = 0; b < 2; ++b)
#pragma unroll
                for (int m = 0; m < 4; ++m)
#pragma unroll
                    for (int n = 0; n < 2; ++n) acc[a][b][m][n] = (f32x4){0.f, 0.f, 0.f, 0.f};
        cur = nxt; cA = nA; cB = nB; ++ui;
        if constexpr (ALIGN_EPI) { if (wr == 1) PG8_BAR; }
    }
    PG8_WAIT_V(0);
    if constexpr (!ALIGN_EPI) { if (wr == 0) PG8_BAR; }
    PG8_BAR;
#undef PG8_SA
#undef PG8_SB
#undef PG8_STAGE
#undef PG8_LDA
#undef PG8_LDB
#undef PG8_MMA
#undef PG8_WAIT_V
#undef PG8_WAIT_L
#undef PG8_BAR
#undef PG8_SCHED
}
__device__ __forceinline__ u32x4 pack8(f32x4 v0, f32x4 v1) { u32x4 w; w.x = cvt_pk_bf16(v0[0], v0[1]); w.y = cvt_pk_bf16(v0[2], v0[3]); w.z = cvt_pk_bf16(v1[0], v1[1]); w.w = cvt_pk_bf16(v1[2], v1[3]); return w; }
__device__ __forceinline__ void unpack8(u32x4 w, f32x4& v0, f32x4& v1) {
    v0[0] = __uint_as_float(w.x << 16); v0[1] = __uint_as_float(w.x & 0xffff0000u); v0[2] = __uint_as_float(w.y << 16); v0[3] = __uint_as_float(w.y & 0xffff0000u);
    v1[0] = __uint_as_float(w.z << 16); v1[1] = __uint_as_float(w.z & 0xffff0000u); v1[2] = __uint_as_float(w.w << 16); v1[3] = __uint_as_float(w.w & 0xffff0000u); }
template <class F> __device__ __forceinline__ void for_each_piece(const f32x4 (&acc)[2][2][4][2], const Unit& u, int wr, int wc, int fr, int fq, const F& f) {
    const int row0 = u.pm * BM + wr * 64 + fr, col0 = wc * 32 + 8 * fq;
#pragma unroll
    for (int ai = 0; ai < 2; ++ai)
#pragma unroll
        for (int m = 0; m < 4; ++m)
#pragma unroll
            for (int bj = 0; bj < 2; ++bj) f(row0 + ai * HALF + m * 16, col0 + bj * HALF, acc[ai][bj][m][0], acc[ai][bj][m][1]);
}
}

template <int MI, int NJ, class AR, class BR, class Epi>
__device__ __forceinline__ void sgemm_wave(const AR& ar, const BR& br, int K, int m0, int n0, const Epi& epi) {
    const int lane = TIDX & 63, c = lane & 15, g = lane >> 4;
    const bf16_t* ap[MI]; const bf16_t* bp[NJ];
#pragma unroll
    for (int i = 0; i < MI; ++i) ap[i] = ar.row(m0 + 16 * i + c) + 8 * g;
#pragma unroll
    for (int j = 0; j < NJ; ++j) bp[j] = br.row(n0 + 16 * j + c) + 8 * g;
    f32x4 acc[MI][NJ];
#pragma unroll
    for (int i = 0; i < MI; ++i)
#pragma unroll
        for (int j = 0; j < NJ; ++j) acc[i][j] = (f32x4){0.f, 0.f, 0.f, 0.f};
#pragma unroll 4
    for (int k0 = 0; k0 < K; k0 += 32) {
        bf16x8 a[MI], b[NJ];
#pragma unroll
        for (int i = 0; i < MI; ++i) a[i] = ld8(ap[i] + k0);
#pragma unroll
        for (int j = 0; j < NJ; ++j) b[j] = ld8(bp[j] + k0);
#pragma unroll
        for (int i = 0; i < MI; ++i)
#pragma unroll
            for (int j = 0; j < NJ; ++j) acc[i][j] = mfma16(b[j], a[i], acc[i][j]);
    }
#pragma unroll
    for (int i = 0; i < MI; ++i)
#pragma unroll
        for (int j = 0; j < NJ; ++j) epi(m0 + 16 * i + c, n0 + 16 * j + 4 * g, acc[i][j]);
}
__device__ __forceinline__ void zero_block(bf16_t* base, size_t ld, int nrows, int ncols, int gtid, int gthreads) {
    const int cpr = ncols / 8;
    for (int i = gtid; i < nrows * cpr; i += gthreads) { const int r = i / cpr, cc = (i % cpr) * 8; *(u32x4*)(base + (size_t)r * ld + cc) = (u32x4){0u, 0u, 0u, 0u}; }
}

struct SchedProj { const char* A; const char* B; int G, c; int K, lda, ldb;
    __device__ __forceinline__ bool next(int i, pg8::Unit& u) const { if (!pg8::decode_unit((long)i * G + c, 1, 64, 28, u)) return false; u.pm += 1; return true; }
    __device__ __forceinline__ const char* abase(const pg8::Unit& u) const { return A + (size_t)u.pm * 256 * D * 2; }
    __device__ __forceinline__ const char* bbase(const pg8::Unit& u) const { return B + (size_t)u.pn * 256 * D * 2; } };
struct EpiProjF { unsigned char* ws;
    __device__ __forceinline__ void operator()(const f32x4 (&acc)[2][2][4][2], const pg8::Unit& u, int wr, int wc, int fr, int fq) const {
        const int colt = u.pn * 256, seg = colt >> 10;
        const size_t off = seg == 0 ? B_XM : seg == 1 ? B_OP : seg == 2 ? B_QA : seg == 3 ? B_KA : seg == 4 ? B_VA : seg == 5 ? B_GA : B_GB;
        bf16_t* base = (bf16_t*)(ws + off) + (colt & 1023);
        pg8::for_each_piece(acc, u, wr, wc, fr, fq, [&](int row, int col, f32x4 v0, f32x4 v1) { *(u32x4*)(base + (size_t)row * D + col) = pg8::pack8(v0, v1); }); } };
struct SchedVAT { const char* A; const char* B; int G, c; int K, lda, ldb;
    __device__ __forceinline__ bool next(int i, pg8::Unit& u) const { if (!pg8::decode_unit((long)i * G + c, 1, 4, 64, u)) return false; u.pn += 1; return true; }
    __device__ __forceinline__ const char* abase(const pg8::Unit& u) const { return A + (size_t)u.pm * 256 * D * 2; }
    __device__ __forceinline__ const char* bbase(const pg8::Unit& u) const { return B + (size_t)u.pn * 256 * D * 2; } };
struct EpiStoreF { bf16_t* C; size_t ldc; float scale;
    __device__ __forceinline__ void operator()(const f32x4 (&acc)[2][2][4][2], const pg8::Unit& u, int wr, int wc, int fr, int fq) const {
        bf16_t* base = C + (size_t)u.pn * 256;
        pg8::for_each_piece(acc, u, wr, wc, fr, fq, [&](int row, int col, f32x4 v0, f32x4 v1) { *(u32x4*)(base + (size_t)row * ldc + col) = pg8::pack8(v0 * scale, v1 * scale); }); } };
__device__ __forceinline__ void phase_proj_f(const Params& p, char* lds, int bid, int nb) {
    const int tid = TIDX, wid = tid >> 6, gw = bid * NW + wid, ngw = nb * NW;
    const bf16_t* H = (const bf16_t*)(p.ws + B_H); const bf16_t* W = (const bf16_t*)(p.ws + W_IN_T);
    zero_block((bf16_t*)(p.ws + B_KA), D, VALID0, D, bid * NT + tid, nb * NT);
    zero_block((bf16_t*)(p.ws + B_VA), D, VALID0, D, bid * NT + tid, nb * NT);
    zero_block((bf16_t*)(p.ws + B_XM), D, VALID0, D, bid * NT + tid, nb * NT);
    zero_block((bf16_t*)(p.ws + B_VAT), P, D, VALID0, bid * NT + tid, nb * NT);
    for (int t = gw; t < 112 + 16; t += ngw) {
        if (t < 112) sgemm_wave<1, 4>(RowsPlain{H, D}, RowsPlain{W, D}, D, VALID0, t * 64, EpiProj{p.ws});
        else sgemm_wave<4, 1>(RowsPlain{W + (size_t)4096 * D, D}, RowsPlain{H, D}, D, (t - 112) * 64, VALID0, EpiStore{(bf16_t*)(p.ws + B_VAT), P, 1.f});
    }
    { SchedProj S{(const char*)H, (const char*)W, nb, bid, D, D, D};
      pg8::gemm_phase(( PG8_LAS unsigned char*)lds, S, EpiProjF{p.ws}); }
    { SchedVAT S{(const char*)(W + (size_t)4096 * D), (const char*)H, nb, bid, D, D, D};
      pg8::gemm_phase((PG8_LAS unsigned char*)lds, S, EpiStoreF{(bf16_t*)(p.ws + B_VAT), P, 1.f}); }
}

__device__ __forceinline__ void phase_attn(const Params& p, int l, char* lds, int bid, int nb) {
    const int tid = TIDX, wid = tid >> 6, lane = tid & 63, c = lane & 15, g = lane >> 4, gw = bid * NW + wid, ngw = nb * NW;
    const bf16_t* QA = (const bf16_t*)(p.ws + B_QA); const bf16_t* KA = (const bf16_t*)(p.ws + B_KA); const bf16_t* VAT = (const bf16_t*)(p.ws + B_VAT);
    bf16_t* YA = (bf16_t*)(p.ws + B_YA);
    const float lam_init = 0.8f - 0.6f * expf(-0.3f * (float)l);
    float lam;
    { const float a = wave_sum(p.in[I_LQ1][l * 64 + lane] * p.in[I_LK1][l * 64 + lane]), b = wave_sum(p.in[I_LQ2][l * 64 + lane] * p.in[I_LK2][l * 64 + lane]);
      lam = expf(a) - expf(b) + lam_init; }
    constexpr int NQG = P / 16, QG0 = VALID0 / 16;
    const int ntask = (NQG - QG0) * 8;
    for (int t = gw; t < ntask; t += ngw) {
        const int qg = NQG - 1 - t / 8, hd = t % 8, q0 = qg * 16, q = q0 + c;
        bf16x8 qf[2][2];
#pragma unroll
        for (int mp = 0; mp < 2; ++mp)
#pragma unroll
            for (int ks = 0; ks < 2; ++ks) qf[mp][ks] = ld8(QA + (size_t)q * D + hd * 128 + mp * 64 + 32 * ks + 8 * g);
        f32x4 o[2][8];
#pragma unroll
        for (int mp = 0; mp < 2; ++mp)
#pragma unroll
            for (int dt = 0; dt < 8; ++dt) o[mp][dt] = (f32x4){0.f, 0.f, 0.f, 0.f};
        float mrun[2] = {NEGBIG, NEGBIG}, lrun[2] = {0.f, 0.f};
        for (int kb = 224; kb <= q0 + 15; kb += 32) {
            bf16x8 pf[2];
#pragma unroll
            for (int mp = 0; mp < 2; ++mp) {
                f32x4 s[2];
#pragma unroll
                for (int a = 0; a < 2; ++a) {
                    s[a] = (f32x4){0.f, 0.f, 0.f, 0.f};
                    const bf16_t* kr = KA + (size_t)(kb + 16 * a + c) * D + hd * 128 + mp * 64 + 8 * g;
#pragma unroll
                    for (int ks = 0; ks < 2; ++ks) s[a] = mfma16(ld8(kr + 32 * ks), qf[mp][ks], s[a]);
                }
                float mx = NEGBIG;
#pragma unroll
                for (int a = 0; a < 2; ++a)
#pragma unroll
                    for (int r = 0; r < 4; ++r) { const int key = kb + 16 * a + 4 * g + r; float v = s[a][r] * 0.125f; v = (key <= q && key >= VALID0) ? v : -INFINITY; s[a][r] = v; mx = fmaxf(mx, v); }
                mx = fmaxf(mx, __shfl_xor(mx, 16)); mx = fmaxf(mx, __shfl_xor(mx, 32));
                const float mn = fmaxf(mrun[mp], mx), alpha = __expf(mrun[mp] - mn);
                mrun[mp] = mn;
                float ps = 0.f;
#pragma unroll
                for (int a = 0; a < 2; ++a)
#pragma unroll
                    for (int r = 0; r < 4; ++r) { const float e = __expf(s[a][r] - mn); s[a][r] = e; ps += e; }
                lrun[mp] = lrun[mp] * alpha + ps;
#pragma unroll
                for (int dt = 0; dt < 8; ++dt) o[mp][dt] = o[mp][dt] * alpha;
                u32x4 w; w.x = pk2(s[0][0], s[0][1]); w.y = pk2(s[0][2], s[0][3]); w.z = pk2(s[1][0], s[1][1]); w.w = pk2(s[1][2], s[1][3]);
                pf[mp] = *(bf16x8*)&w;
            }
#pragma unroll
            for (int dt = 0; dt < 8; ++dt) {
                const bf16_t* vr = VAT + (size_t)(hd * 128 + 16 * dt + c) * P + kb + 4 * g;
                u32x2 v0 = *(const u32x2*)vr, v1 = *(const u32x2*)(vr + 16);
                u32x4 w; w.x = v0.x; w.y = v0.y; w.z = v1.x; w.w = v1.y;
                const bf16x8 vf = *(bf16x8*)&w;
                o[0][dt] = mfma16(vf, pf[0], o[0][dt]);
                o[1][dt] = mfma16(vf, pf[1], o[1][dt]);
            }
        }
        float l0 = lrun[0], l1 = lrun[1];
        l0 += __shfl_xor(l0, 16); l0 += __shfl_xor(l0, 32); l1 += __shfl_xor(l1, 16); l1 += __shfl_xor(l1, 32);
        const float i0 = 1.f / l0, i1 = lam / l1;
        float ss = 0.f;
#pragma unroll
        for (int dt = 0; dt < 8; ++dt) { o[0][dt] = o[0][dt] * i0 - o[1][dt] * i1; ss += (o[0][dt].x * o[0][dt].x + o[0][dt].y * o[0][dt].y) + (o[0][dt].z * o[0][dt].z + o[0][dt].w * o[0][dt].w); }
        ss += __shfl_xor(ss, 16); ss += __shfl_xor(ss, 32);
        const float rs = rsqrtf(ss * (1.f / 128.f) + LN_EPS) * (1.f - lam_init);
#pragma unroll
        for (int dt = 0; dt < 8; ++dt) { const f32x4 gg = *(const f32x4*)(p.in[I_ANG] + l * 128 + 16 * dt + 4 * g);
            store4_bf16(YA + (size_t)q * D + hd * 128 + 16 * dt + 4 * g, o[0][dt] * rs * gg); }
    }
}

namespace fa {
typedef short s16x4 __attribute__((ext_vector_type(4)));
typedef float f32x16 __attribute__((ext_vector_type(16)));
constexpr int KVBLK = 64, SHM_V = 64 * 128 * 2, SHM_K = 64 * 64 * 2, PITCH = 1024;
constexpr int LDS_NEED = 2 * SHM_V + 2 * SHM_K + NW * 64 * 4;
constexpr float SCALE = 0.125f, THR = 8.f;
#define FA_SBAR() __builtin_amdgcn_sched_barrier(0)
__device__ __forceinline__ int kswz(int row, int chunk) { return row * 128 + ((chunk ^ ((row >> 1) & 7)) << 4); }
__device__ __forceinline__ int v_st(int k, int c) { const int kk = (k & ~0xC) | ((k & 4) << 1) | ((k & 8) >> 1); return ((kk >> 3) * 4 + (c >> 5)) * 512 + ((kk & 7) * 32 + (c & 31)) * 2; }
__device__ __forceinline__ int v_rd_base(int lane) { return ((lane & 3) << 3) | (((lane >> 2) & 3) << 6) | (((lane >> 4) & 1) << 5) | (((lane >> 5) & 1) << 8); }
constexpr int v_rd_off(int d0, int ks, int half) { return d0 * 512 + ks * 4096 + half * 2048; }
__device__ __forceinline__ int crow(int r, int hi) { return (r & 3) + 8 * (r >> 2) + 4 * hi; }
__device__ __forceinline__ unsigned cvtpk(float lo, float hi) { unsigned r; asm volatile("v_cvt_pk_bf16_f32 %0, %1, %2" : "=v"(r) : "v"(lo), "v"(hi)); return r; }
__device__ __forceinline__ void mask_tile(f32x16& p0, f32x16& p1, int pos, int kbase, int hi, int lowkey) {
    const float NEG = -__builtin_inff();
#pragma unroll
    for (int r = 0; r < 16; ++r) {
        const int k0 = kbase + (r & 3) + 8 * (r >> 2) + 4 * hi;
        if (k0 > pos || k0 < lowkey) p0[r] = NEG;
        if (k0 + 32 > pos || k0 + 32 < lowkey) p1[r] = NEG;
    }
}
__device__ __forceinline__ void partialSM(f32x16& p0, f32x16& p1, float& m_reg, float& mn, float& alpha) {
    float pmax = p0[0];
#pragma unroll
    for (int r = 1; r < 16; ++r) pmax = fmaxf(pmax, p0[r]);
#pragma unroll
    for (int r = 0; r < 16; ++r) pmax = fmaxf(pmax, p1[r]);
    { auto rr = __builtin_amdgcn_permlane32_swap(__float_as_uint(pmax), __float_as_uint(pmax), false, false);
      pmax = fmaxf(__uint_as_float(rr[0]), __uint_as_float(rr[1])); }
    constexpr float C2 = 1.4426950408889634f * SCALE;
    if (__builtin_expect(__all((pmax - m_reg) * SCALE <= THR), 1)) { mn = m_reg; alpha = 1.f; }
    else { mn = fmaxf(m_reg, pmax); alpha = __builtin_amdgcn_exp2f((m_reg - mn) * C2); m_reg = mn; }
    const float mnL = -mn * C2;
#pragma unroll
    for (int r = 0; r < 16; ++r) p0[r] = fmaf(p0[r], C2, mnL);
#pragma unroll
    for (int r = 0; r < 16; ++r) p1[r] = fmaf(p1[r], C2, mnL);
#pragma unroll
    for (int r = 0; r < 16; ++r) p0[r] = __builtin_amdgcn_exp2f(p0[r]);
}
__device__ __forceinline__ void finishSM(f32x16& p0, f32x16& p1, float alpha, float& l_reg, bf16x8& pa0, bf16x8& pa1, bf16x8& pa2, bf16x8& pa3) {
#pragma unroll
    for (int r = 0; r < 16; ++r) p1[r] = __builtin_amdgcn_exp2f(p1[r]);
    float ps = 0;
#pragma unroll
    for (int r = 0; r < 16; ++r) ps += p0[r];
#pragma unroll
    for (int r = 0; r < 16; ++r) ps += p1[r];
    { auto rr = __builtin_amdgcn_permlane32_swap(__float_as_uint(ps), __float_as_uint(ps), false, false);
      ps = __uint_as_float(rr[0]) + __uint_as_float(rr[1]); }
    l_reg = l_reg * alpha + ps;
#define FA_PK4(Pv, B_, OUT) do { unsigned a0 = cvtpk(Pv[B_+0], Pv[B_+1]), a1 = cvtpk(Pv[B_+2], Pv[B_+3]);                          \
        unsigned b0 = cvtpk(Pv[B_+4], Pv[B_+5]), b1 = cvtpk(Pv[B_+6], Pv[B_+7]);                                             \
        auto r0 = __builtin_amdgcn_permlane32_swap(a0, b0, false, false); auto r1 = __builtin_amdgcn_permlane32_swap(a1, b1, false, false); \
        u32x4 w = {r0[0], r1[0], r0[1], r1[1]}; OUT = *reinterpret_cast<bf16x8*>(&w); } while (0)
    FA_PK4(p0, 0, pa0); FA_PK4(p0, 8, pa1); FA_PK4(p1, 0, pa2); FA_PK4(p1, 8, pa3);
#undef FA_PK4
}
template <int KB>
__device__ __forceinline__ void qkt(f32x16& p0, f32x16& p1, const char* K_lds, int r32, int hi, const bf16x8* qr) {
    p0 = f32x16{}; p1 = f32x16{};
#pragma unroll
    for (int d0 = 0; d0 < 4; ++d0) { const char* a = K_lds + KB * SHM_K + kswz(r32, 2 * d0 + hi);
        bf16x8 b0 = *reinterpret_cast<const bf16x8*>(a);
        bf16x8 b1 = *reinterpret_cast<const bf16x8*>(a + 32 * 128);
        p0 = __builtin_amdgcn_mfma_f32_32x32x16_bf16(b0, qr[d0], p0, 0, 0, 0);
        p1 = __builtin_amdgcn_mfma_f32_32x32x16_bf16(b1, qr[d0], p1, 0, 0, 0); }
}
template <int VB>
__device__ __forceinline__ void pv_tile(f32x16* o, int vb0, bf16x8 pa0, bf16x8 pa1, bf16x8 pa2, bf16x8 pa3) {
#define FA_TRRD(dst, off) asm volatile("ds_read_b64_tr_b16 %0, %1 offset:%2" : "=&v"(dst) : "v"(vb0), "i"(off) : "memory")
#define FA_PV_D0(d0) do { s16x4 l0, l1, l2, l3, h0, h1, h2, h3; constexpr int b_ = VB * SHM_V + v_rd_off(d0, 0, 0); \
        FA_TRRD(l0, b_); FA_TRRD(h0, b_ + 2048); FA_TRRD(l1, b_ + 4096); FA_TRRD(h1, b_ + 6144); FA_TRRD(l2, b_ + 8192); FA_TRRD(h2, b_ + 10240); FA_TRRD(l3, b_ + 12288); FA_TRRD(h3, b_ + 14336); \
        asm volatile("s_waitcnt lgkmcnt(0)" ::: "memory"); FA_SBAR();   \
        o[d0] = __builtin_amdgcn_mfma_f32_32x32x16_bf16(pa0, (bf16x8){l0[0], l0[1], l0[2], l0[3], h0[0], h0[1], h0[2], h0[3]}, o[d0], 0, 0, 0);   \
        o[d0] = __builtin_amdgcn_mfma_f32_32x32x16_bf16(pa1, (bf16x8){l1[0], l1[1], l1[2], l1[3], h1[0], h1[1], h1[2], h1[3]}, o[d0], 0, 0, 0);   \
        o[d0] = __builtin_amdgcn_mfma_f32_32x32x16_bf16(pa2, (bf16x8){l2[0], l2[1], l2[2], l2[3], h2[0], h2[1], h2[2], h2[3]}, o[d0], 0, 0, 0);   \
        o[d0] = __builtin_amdgcn_mfma_f32_32x32x16_bf16(pa3, (bf16x8){l3[0], l3[1], l3[2], l3[3], h3[0], h3[1], h3[2], h3[3]}, o[d0], 0, 0, 0); } while (0)
    FA_PV_D0(0); FA_PV_D0(1); FA_PV_D0(2); FA_PV_D0(3);
#undef FA_PV_D0
#undef FA_TRRD
}
__device__ __forceinline__ void attn_pass(const bf16_t* Qp, const bf16_t* Kp, const bf16_t* Vp, int P0, int NT, char* lds, f32x16 (&o)[4], float& l_out) {
    const int tid = TIDX, wid = __builtin_amdgcn_readfirstlane(tid >> 6), lane = tid & 63, r32 = lane & 31, hi = lane >> 5;
    char* V_lds = lds; char* K_lds = lds + 2 * SHM_V;
    float* wsl = (float*)(lds + 2 * SHM_V + 2 * SHM_K) + wid * 64; float* al_l = wsl + 32;
    const int qlo = P0 + wid * 32, pos = qlo + r32;
    float m_reg = -1e30f, l_reg = 0.f;
#pragma unroll
    for (int d = 0; d < 4; ++d) o[d] = f32x16{};
    const int ksr = tid >> 3, ksc = tid & 7, kws = kswz(ksr, ksc);
    const int sr = tid >> 4, sc = (tid & 15) * 8, vst0 = v_st(sr, sc), vst1 = v_st(32 + sr, sc);
    const int vb0 = (int)(uintptr_t)V_lds + v_rd_base(lane);
    bf16x8 qr[4];
#pragma unroll
    for (int d0 = 0; d0 < 4; ++d0) qr[d0] = ld8(Qp + (size_t)pos * PITCH + d0 * 16 + hi * 8);
    bf16x8 st_k, st_v0, st_v1;
#define FA_KBASE(t) ((3 + (t)) * KVBLK)
#define FA_SLOAD(t) do { const int kb_ = FA_KBASE(t); st_k = ld8(Kp + (size_t)(kb_ + ksr) * PITCH + ksc * 8); \
        st_v0 = ld8(Vp + (size_t)(kb_ + sr) * PITCH + sc); st_v1 = ld8(Vp + (size_t)(kb_ + 32 + sr) * PITCH + sc); } while (0)
#define FA_SWRITE_K(bf) do { *(bf16x8*)(K_lds + (bf) * SHM_K + kws) = st_k; } while (0)
#define FA_SWRITE_V(bf) do { *(bf16x8*)(V_lds + (bf) * SHM_V + vst0) = st_v0; *(bf16x8*)(V_lds + (bf) * SHM_V + vst1) = st_v1; } while (0)
#define FA_VMW() asm volatile("s_waitcnt vmcnt(0)" ::: "memory")
#define FA_RESC(a) do { if (__any((a) < 1.f)) { if (hi == 0) al_l[r32] = (a); asm volatile("s_waitcnt lgkmcnt(0)" ::: "memory");              \
                     for (int d_ = 0; d_ < 4; ++d_) for (int r = 0; r < 16; ++r) o[d_][r] *= al_l[crow(r, hi)]; } } while (0)
#define FA_MASKT(P0_, P1_, t) do { const int kb_ = FA_KBASE(t); if ((t) == 0 || kb_ + KVBLK - 1 > qlo) mask_tile(P0_, P1_, pos, kb_, hi, VALID0); } while (0)
    f32x16 pA0, pA1, pB0, pB1; float mnA, mnB, alA, alB; bf16x8 pa0, pa1, pa2, pa3;
    FA_SLOAD(0); FA_VMW(); FA_SWRITE_K(0); FA_SWRITE_V(0); FA_SBAR();
    if (NT > 1) FA_SLOAD(1);
    __syncthreads();
    FA_SBAR(); qkt<0>(pA0, pA1, K_lds, r32, hi, qr);
    FA_MASKT(pA0, pA1, 0); partialSM(pA0, pA1, m_reg, mnA, alA);
    if (NT > 1) { FA_VMW(); FA_SWRITE_K(1); FA_SWRITE_V(1); }
    __syncthreads();
#define FA_HALF_STEP(PX0, PX1, mnX, alX, PY0, PY1, alY, t, KB, VB, SB) do {                                                      \
        FA_SBAR(); qkt<KB>(PX0, PX1, K_lds, r32, hi, qr);                                             \
        finishSM(PY0, PY1, alY, l_reg, pa0, pa1, pa2, pa3); FA_SBAR();                                                           \
        if ((t) + 1 < NT) { FA_SLOAD((t) + 1); FA_SBAR(); }                                               \
        pv_tile<VB>(o, vb0, pa0, pa1, pa2, pa3); FA_MASKT(PX0, PX1, (t)); partialSM(PX0, PX1, m_reg, mnX, alX);                                        \
        __syncthreads();                                                                                                      \
        if ((t) + 1 < NT) { FA_VMW(); FA_SWRITE_K(SB); FA_SWRITE_V(SB); }                                                                          \
        FA_RESC(alX); __syncthreads(); } while (0)
    for (int t = 1; t + 1 < NT; t += 2) {
        FA_HALF_STEP(pB0, pB1, mnB, alB, pA0, pA1, alA, t, 1, 0, 0);
        FA_HALF_STEP(pA0, pA1, mnA, alA, pB0, pB1, alB, t + 1, 0, 1, 1);
    }
    const bool even = (NT & 1) == 0;
    if (even) { FA_SBAR(); qkt<1>(pB0, pB1, K_lds, r32, hi, qr); FA_SBAR(); }
    finishSM(pA0, pA1, alA, l_reg, pa0, pa1, pa2, pa3); FA_SBAR();
    pv_tile<0>(o, vb0, pa0, pa1, pa2, pa3);
    if (even) { FA_MASKT(pB0, pB1, NT - 1); partialSM(pB0, pB1, m_reg, mnB, alB); __syncthreads(); FA_RESC(alB);
        finishSM(pB0, pB1, alB, l_reg, pa0, pa1, pa2, pa3); FA_SBAR(); pv_tile<1>(o, vb0, pa0, pa1, pa2, pa3); }
    l_out = l_reg;
    __syncthreads();
#undef FA_KBASE
#undef FA_SLOAD
#undef FA_SWRITE_K
#undef FA_SWRITE_V
#undef FA_VMW
#undef FA_RESC
#undef FA_MASKT
#undef FA_HALF_STEP
}
__device__ __forceinline__ void attn_unit(const Params& p, int l, int hd, int j, float lam, float lam_init, char* lds) {
    const int tid = TIDX, wid = __builtin_amdgcn_readfirstlane(tid >> 6), lane = tid & 63, r32 = lane & 31, hi = lane >> 5;
    const bf16_t* QA = (const bf16_t*)(p.ws + B_QA) + hd * 128; const bf16_t* KA = (const bf16_t*)(p.ws + B_KA) + hd * 128; const bf16_t* VA = (const bf16_t*)(p.ws + B_VA) + hd * 128;
    bf16_t* YA = (bf16_t*)(p.ws + B_YA) + hd * 128;
    const int P0 = j * 256, NT = 4 * j + 1;
    float* li_l = (float*)(lds + 2 * SHM_V + 2 * SHM_K) + wid * 64;
    bf16_t* Yw = YA + (size_t)(P0 + wid * 32) * PITCH;
    f32x16 o[4]; float lr;
    attn_pass(QA, KA, VA, P0, NT, lds, o, lr);
    if (hi == 0) li_l[r32] = lr;
    asm volatile("s_waitcnt lgkmcnt(0)" ::: "memory");
#pragma unroll
    for (int r = 0; r < 16; ++r) { const int orow = crow(r, hi); const float rl = __builtin_amdgcn_rcpf(li_l[orow]);
#pragma unroll
        for (int d0 = 0; d0 < 4; ++d0) { const float v = o[d0][r] * rl; const float vn = __shfl_xor(v, 1);
            if ((r32 & 1) == 0) *(unsigned*)(Yw + (size_t)orow * PITCH + d0 * 32 + r32) = cvtpk(v, vn); } }
    asm volatile("s_waitcnt vmcnt(0)" ::: "memory");
    __syncthreads();
    attn_pass(QA + 64, KA + 64, VA, P0, NT, lds, o, lr);
    if (hi == 0) li_l[r32] = lr;
    asm volatile("s_waitcnt lgkmcnt(0)" ::: "memory");
    const float scale_out = 1.f - lam_init;
#pragma unroll
    for (int r = 0; r < 16; ++r) { const int orow = crow(r, hi); const float rl = lam * __builtin_amdgcn_rcpf(li_l[orow]);
        float cv[4]; float ss = 0.f;
#pragma unroll
        for (int d0 = 0; d0 < 4; ++d0) { const float o1 = bf2f((unsigned)Yw[(size_t)orow * PITCH + d0 * 32 + r32]); cv[d0] = o1 - o[d0][r] * rl; ss += cv[d0] * cv[d0]; }
        ss += __shfl_xor(ss, 1); ss += __shfl_xor(ss, 2); ss += __shfl_xor(ss, 4); ss += __shfl_xor(ss, 8); ss += __shfl_xor(ss, 16);
        const float rs = rsqrtf(ss * (1.f / 128.f) + LN_EPS) * scale_out;
#pragma unroll
        for (int d0 = 0; d0 < 4; ++d0) o[d0][r] = cv[d0] * rs * p.in[I_ANG][l * 128 + d0 * 32 + r32]; }
    asm volatile("s_waitcnt vmcnt(0)" ::: "memory");
    __syncthreads();
#pragma unroll
    for (int r = 0; r < 16; ++r) { const int orow = crow(r, hi);
#pragma unroll
        for (int d0 = 0; d0 < 4; ++d0) { const float v = o[d0][r]; const float vn = __shfl_xor(v, 1);
            if ((r32 & 1) == 0) *(unsigned*)(Yw + (size_t)orow * PITCH + d0 * 32 + r32) = cvtpk(v, vn); } }
    __syncthreads();
}
}
__device__ __forceinline__ void phase_attn_f(const Params& p, int l, char* lds, int bid, int nb) {
    const int lane = TIDX & 63;
    const float lam_init = 0.8f - 0.6f * expf(-0.3f * (float)l);
    float lam;
    { const float a = wave_sum(p.in[I_LQ1][l * 64 + lane] * p.in[I_LK1][l * 64 + lane]), b = wave_sum(p.in[I_LQ2][l * 64 + lane] * p.in[I_LK2][l * 64 + lane]);
      lam = expf(a) - expf(b) + lam_init; }
    for (int u = bid; u < 256 + 8; u += nb) {
        if (u < 256) { const int hd = u & 7, jj = u >> 3;
            fa::attn_unit(p, l, hd, 64 - jj, lam, lam_init, lds);
            fa::attn_unit(p, l, hd, 1 + jj, lam, lam_init, lds);
        } else fa::attn_unit(p, l, u - 256, 0, lam, lam_init, lds);
    }
}

__device__ __forceinline__ void phase_conv(const Params& p, int l, char* lds, int bid, int nb) {
    const int tid = TIDX, wid = tid >> 6, lane = tid & 63, gw = bid * NW + wid, ngw = nb * NW;
    const bf16_t* XM = (const bf16_t*)(p.ws + B_XM); bf16_t* XC = (bf16_t*)(p.ws + B_XC);
    const float* cw = p.in[I_CONVW] + (size_t)l * 4 * D; const float* cb = p.in[I_CONVB] + (size_t)l * D;
    const int nitem = P * (D / 8);
    for (int it = bid * NT + tid; it < nitem; it += nb * NT) {
        const int r = it >> 7, c0 = (it & 127) * 8;
        u32x4 o = {0u, 0u, 0u, 0u};
        if (r >= VALID0) {
            float acc[8];
#pragma unroll
            for (int i = 0; i < 8; ++i) acc[i] = cb[c0 + i];
#pragma unroll
            for (int j = 0; j < 4; ++j) { const int rr = r - 3 + j;
                if (rr >= VALID0) { const u32x4 x = *(const u32x4*)(XM + (size_t)rr * D + c0); const float* w = cw + j * D + c0;
                    acc[0] += w[0] * bf2f(x.x & 0xffffu); acc[1] += w[1] * bf2f(x.x >> 16); acc[2] += w[2] * bf2f(x.y & 0xffffu); acc[3] += w[3] * bf2f(x.y >> 16);
                    acc[4] += w[4] * bf2f(x.z & 0xffffu); acc[5] += w[5] * bf2f(x.z >> 16); acc[6] += w[6] * bf2f(x.w & 0xffffu); acc[7] += w[7] * bf2f(x.w >> 16); } }
            o.x = pk2(siluf_(acc[0]), siluf_(acc[1])); o.y = pk2(siluf_(acc[2]), siluf_(acc[3])); o.z = pk2(siluf_(acc[4]), siluf_(acc[5])); o.w = pk2(siluf_(acc[6]), siluf_(acc[7]));
        }
        *(u32x4*)(XC + (size_t)r * D + c0) = o;
    }
    const float* gli = (const float*)(p.ws + TAB_GLI); const float* glf = (const float*)(p.ws + TAB_GLF);
    float* tb = (float*)(p.ws + TAB_B); float* te = (float*)(p.ws + TAB_E); float* tpm = (float*)(p.ws + TAB_PM); float* tw = (float*)(p.ws + TAB_W);
    float* scg = (float*)(p.ws + TAB_SCG); float* scm = (float*)(p.ws + TAB_SCM);
    for (int t = gw; t < NSC * 4; t += ngw) {
        const int sc = t >> 2, h = t & 3; const size_t base = (size_t)h * P + sc * 256 + 4 * lane;
        const f32x4 lf = *(const f32x4*)(glf + base), li = *(const f32x4*)(gli + base);
        float b[4]; b[0] = lf.x; b[1] = b[0] + lf.y; b[2] = b[1] + lf.z; b[3] = b[2] + lf.w;
        float incl = b[3];
#pragma unroll
        for (int o = 1; o < 64; o <<= 1) { const float n = __shfl_up(incl, o); if (lane >= o) incl += n; }
        const float excl = incl - b[3];
        float e[4], pm[4];
#pragma unroll
        for (int i = 0; i < 4; ++i) { b[i] += excl; e[i] = li[i] - b[i]; }
        pm[0] = e[0]; pm[1] = fmaxf(pm[0], e[1]); pm[2] = fmaxf(pm[1], e[2]); pm[3] = fmaxf(pm[2], e[3]);
        float mi = pm[3];
#pragma unroll
        for (int o = 1; o < 64; o <<= 1) { const float n = __shfl_up(mi, o); if (lane >= o) mi = fmaxf(mi, n); }
        float mex = __shfl_up(mi, 1); if (lane == 0) mex = -INFINITY;
#pragma unroll
        for (int i = 0; i < 4; ++i) pm[i] = fmaxf(pm[i], mex);
        const float gtot = __shfl(incl, 63), emax = __shfl(mi, 63), mloc = gtot + emax;
        f32x4 ww;
#pragma unroll
        for (int i = 0; i < 4; ++i) ww[i] = __expf(e[i] + gtot - mloc);
        *(f32x4*)(tb + base) = (f32x4){b[0], b[1], b[2], b[3]};
        *(f32x4*)(te + base) = (f32x4){e[0], e[1], e[2], e[3]};
        *(f32x4*)(tpm + base) = (f32x4){pm[0], pm[1], pm[2], pm[3]};
        *(f32x4*)(tw + base) = ww;
        if (lane == 0) { scg[sc * 4 + h] = gtot; scm[sc * 4 + h] = mloc; }
    }
}

__device__ __forceinline__ void phase_mqkv(const Params& p, char* lds, int bid, int nb) {
    const bf16_t* XC = (const bf16_t*)(p.ws + B_XC); const bf16_t* XM = (const bf16_t*)(p.ws + B_XM);
    const bf16_t* WQ = (const bf16_t*)(p.ws + W_Q_T); const bf16_t* WK = (const bf16_t*)(p.ws + W_K_T); const bf16_t* WV = (const bf16_t*)(p.ws + W_V_T);
    bf16_t* QM = (bf16_t*)(p.ws + B_QM); bf16_t* KM = (bf16_t*)(p.ws + B_KM); bf16_t* KMT = (bf16_t*)(p.ws + B_KMT); bf16_t* VMT = (bf16_t*)(p.ws + B_VMT);
    for (int u = bid; u < 4 * 520; u += nb) {
        const int w = u / 520, r = u % 520, h = r / 130, t = r % 130;
        if (w == 0) sgemm_unit(RowsPlain{XC + h * 256, D}, RowsPlain{WQ + (size_t)h * 65536, 256}, 256, t * 128, 0, EpiStore{QM + h * 256, D, 1.f});
        else if (w == 1) sgemm_unit(RowsPlain{XC + h * 256, D}, RowsPlain{WK + (size_t)h * 65536, 256}, 256, t * 128, 0, EpiStore{KM + h * 256, D, 0.0625f});
        else if (w == 2) sgemm_unit(RowsPlain{WK + (size_t)h * 65536, 256}, RowsPlain{XC + h * 256, D}, 256, (t / 65) * 128, (t % 65) * 256, EpiStore{KMT + (size_t)h * 256 * P, P, 0.0625f});
        else sgemm_unit(RowsPlain{WV + (size_t)h * 65536, 256}, RowsPlain{XM + h * 256, D}, 256, (t / 65) * 128, (t % 65) * 256, EpiStore{VMT + (size_t)h * 256 * P, P, 1.f});
    }
}

__device__ __forceinline__ void phase_m1(const Params& p, char* lds, int bid, int nb) {
    const int tid = TIDX, wid = tid >> 6, lane = tid & 63, c = lane & 15, g = lane >> 4, gw = bid * NW + wid, ngw = nb * NW;
    const bf16_t* KMT = (const bf16_t*)(p.ws + B_KMT); const bf16_t* VMT = (const bf16_t*)(p.ws + B_VMT);
    const float* tw = (const float*)(p.ws + TAB_W); bf16_t* CT = (bf16_t*)(p.ws + B_CT); float* NTv = (float*)(p.ws + TAB_NT);
    for (int t = gw; t < NSC * 4 * 16; t += ngw) {
        const int dvb = t & 15, h = (t >> 4) & 3, sc = t >> 6, s0 = sc * 256;
        f32x4 acc[16];
#pragma unroll
        for (int i = 0; i < 16; ++i) acc[i] = (f32x4){0.f, 0.f, 0.f, 0.f};
        float un[16];
#pragma unroll
        for (int i = 0; i < 16; ++i) un[i] = 0.f;
        for (int ks = 0; ks < 8; ++ks) {
            const int sb = s0 + 32 * ks + 8 * g;
            const f32x4 w0 = *(const f32x4*)(tw + (size_t)h * P + sb), w1 = *(const f32x4*)(tw + (size_t)h * P + sb + 4);
            const u32x4 vv = *(const u32x4*)(VMT + (size_t)(h * 256 + 16 * dvb + c) * P + sb);
            u32x4 vw; vw.x = pk2(bf2f(vv.x & 0xffffu) * w0.x, bf2f(vv.x >> 16) * w0.y); vw.y = pk2(bf2f(vv.y & 0xffffu) * w0.z, bf2f(vv.y >> 16) * w0.w);
            vw.z = pk2(bf2f(vv.z & 0xffffu) * w1.x, bf2f(vv.z >> 16) * w1.y); vw.w = pk2(bf2f(vv.w & 0xffffu) * w1.z, bf2f(vv.w >> 16) * w1.w);
            const bf16x8 vf = *(bf16x8*)&vw;
#pragma unroll
            for (int dk = 0; dk < 16; ++dk) {
                const u32x4 kk = *(const u32x4*)(KMT + (size_t)(h * 256 + 16 * dk + c) * P + sb);
                acc[dk] = mfma16(*(const bf16x8*)&kk, vf, acc[dk]);
                if (dvb == 0) un[dk] += bf2f(kk.x & 0xffffu) * w0.x + bf2f(kk.x >> 16) * w0.y + bf2f(kk.y & 0xffffu) * w0.z + bf2f(kk.y >> 16) * w0.w
                                      + bf2f(kk.z & 0xffffu) * w1.x + bf2f(kk.z >> 16) * w1.y + bf2f(kk.w & 0xffffu) * w1.z + bf2f(kk.w >> 16) * w1.w;
            }
        }
        bf16_t* dst = CT + ((size_t)(sc * 4 + h) * 256 + 16 * dvb + c) * 256;
#pragma unroll
        for (int dk = 0; dk < 16; ++dk) store4_bf16(dst + 16 * dk + 4 * g, acc[dk]);
        if (dvb == 0) {
#pragma unroll
            for (int dk = 0; dk < 16; ++dk) { float v = un[dk]; v += __shfl_xor(v, 16); v += __shfl_xor(v, 32); if (g == 0) NTv[(size_t)(sc * 4 + h) * 256 + 16 * dk + c] = v; }
        }
    }
}

__device__ __forceinline__ void phase_m2(const Params& p, char* lds, int bid, int nb) {
    const float* scg = (const float*)(p.ws + TAB_SCG); const float* scm = (const float*)(p.ws + TAB_SCM);
    unsigned* CT = (unsigned*)(p.ws + B_CT); float* NTv = (float*)(p.ws + TAB_NT); float* mt = (float*)(p.ws + TAB_MT);
    const int gid = bid * NT + TIDX, nth = nb * NT;
    for (int i = gid; i < 4 * 32768 + 1024; i += nth) {
        if (i < 4 * 32768) {
            const int h = i >> 15, idx = i & 32767;
            float m = 0.f, c0 = 0.f, c1 = 0.f;
            for (int sc = 0; sc < NSC; ++sc) {
                const float gg = scg[sc * 4 + h], ml = scm[sc * 4 + h], mn = fmaxf(gg + m, ml), dec = __expf(gg + m - mn), cor = __expf(ml - mn);
                unsigned* ptr = CT + (size_t)(sc * 4 + h) * 32768 + idx; const unsigned u = *ptr;
                c0 = dec * c0 + cor * bf2f(u & 0xffffu); c1 = dec * c1 + cor * bf2f(u >> 16);
                *ptr = pk2(c0, c1); m = mn;
            }
        } else {
            const int j = i - 4 * 32768, h = j >> 8, d = j & 255;
            float m = 0.f, n = 0.f;
            for (int sc = 0; sc < NSC; ++sc) {
                const float gg = scg[sc * 4 + h], ml = scm[sc * 4 + h], mn = fmaxf(gg + m, ml), dec = __expf(gg + m - mn), cor = __expf(ml - mn);
                float* ptr = NTv + (size_t)(sc * 4 + h) * 256 + d;
                n = dec * n + cor * *ptr; *ptr = n; m = mn;
                if (d == 0) mt[sc * 4 + h] = mn;
            }
        }
    }
}

__device__ __forceinline__ void phase_m3(const Params& p, int l, char* lds, int bid, int nb) {
    const int tid = TIDX, wid = tid >> 6, lane = tid & 63, c = lane & 15, g = lane >> 4, gw = bid * NW + wid, ngw = nb * NW;
    const bf16_t* QM = (const bf16_t*)(p.ws + B_QM); const bf16_t* KM = (const bf16_t*)(p.ws + B_KM); const bf16_t* VMT = (const bf16_t*)(p.ws + B_VMT);
    const bf16_t* CT = (const bf16_t*)(p.ws + B_CT); const float* NTv = (const float*)(p.ws + TAB_NT); const float* mt = (const float*)(p.ws + TAB_MT);
    const float* tb = (const float*)(p.ws + TAB_B); const float* te = (const float*)(p.ws + TAB_E); const float* tpm = (const float*)(p.ws + TAB_PM);
    const bf16_t* OP = (const bf16_t*)(p.ws + B_OP); bf16_t* YM = (bf16_t*)(p.ws + B_YM);
    constexpr int NRG = P / 16, RG0 = VALID0 / 16;
    const int ntask = (NRG - RG0) * 4;
    for (int t = gw; t < ntask; t += ngw) {
        const int rg = NRG - 1 - t / 4, h = t % 4, t0 = rg * 16, row = t0 + c, sc = t0 >> 8, s_start = sc << 8;
        bf16x8 qf[8];
#pragma unroll
        for (int ks = 0; ks < 8; ++ks) qf[ks] = ld8(QM + (size_t)row * D + h * 256 + 32 * ks + 8 * g);
        const float b_t = tb[(size_t)h * P + row], pm_t = tpm[(size_t)h * P + row];
        const float m_prev = sc > 0 ? mt[(sc - 1) * 4 + h] : 0.f;
        const float m_t = b_t + fmaxf(m_prev, pm_t), scale_t = __expf(b_t + m_prev - m_t);
        f32x4 acc[16];
#pragma unroll
        for (int i = 0; i < 16; ++i) acc[i] = (f32x4){0.f, 0.f, 0.f, 0.f};
        float den = 0.f;
        if (sc > 0) {
            const bf16_t* Cb = CT + (size_t)((sc - 1) * 4 + h) * 65536; const float* nv = NTv + (size_t)((sc - 1) * 4 + h) * 256;
#pragma unroll 2
            for (int ks = 0; ks < 8; ++ks) {
#pragma unroll
                for (int dt = 0; dt < 16; ++dt) acc[dt] = mfma16(ld8(Cb + (size_t)(16 * dt + c) * 256 + 32 * ks + 8 * g), qf[ks], acc[dt]);
                const f32x4 n0 = *(const f32x4*)(nv + 32 * ks + 8 * g), n1 = *(const f32x4*)(nv + 32 * ks + 8 * g + 4);
                const u32x4 qq = *(const u32x4*)&qf[ks];
                den += bf2f(qq.x & 0xffffu) * n0.x + bf2f(qq.x >> 16) * n0.y + bf2f(qq.y & 0xffffu) * n0.z + bf2f(qq.y >> 16) * n0.w
                     + bf2f(qq.z & 0xffffu) * n1.x + bf2f(qq.z >> 16) * n1.y + bf2f(qq.w & 0xffffu) * n1.z + bf2f(qq.w >> 16) * n1.w;
            }
            den *= scale_t;
#pragma unroll
            for (int dt = 0; dt < 16; ++dt) acc[dt] = acc[dt] * scale_t;
        }
        for (int kb = s_start; kb <= t0 + 15; kb += 32) {
            f32x4 s[2];
#pragma unroll
            for (int a = 0; a < 2; ++a) {
                s[a] = (f32x4){0.f, 0.f, 0.f, 0.f};
                const bf16_t* kr = KM + (size_t)(kb + 16 * a + c) * D + h * 256 + 8 * g;
#pragma unroll
                for (int ks = 0; ks < 8; ++ks) s[a] = mfma16(ld8(kr + 32 * ks), qf[ks], s[a]);
                const f32x4 ee = *(const f32x4*)(te + (size_t)h * P + kb + 16 * a + 4 * g);
#pragma unroll
                for (int r = 0; r < 4; ++r) { const int key = kb + 16 * a + 4 * g + r; const float arg = fminf(ee[r] + b_t - m_t, 0.f);
                    const float dd = key <= row ? __expf(arg) : 0.f; const float pv = s[a][r] * dd; s[a][r] = pv; den += pv; }
            }
            u32x4 w; w.x = pk2(s[0][0], s[0][1]); w.y = pk2(s[0][2], s[0][3]); w.z = pk2(s[1][0], s[1][1]); w.w = pk2(s[1][2], s[1][3]);
            const bf16x8 pf = *(bf16x8*)&w;
#pragma unroll
            for (int dt = 0; dt < 16; ++dt) {
                const bf16_t* vr = VMT + (size_t)(h * 256 + 16 * dt + c) * P + kb + 4 * g;
                const u32x2 v0 = *(const u32x2*)vr, v1 = *(const u32x2*)(vr + 16);
                u32x4 vv; vv.x = v0.x; vv.y = v0.y; vv.z = v1.x; vv.w = v1.y;
                acc[dt] = mfma16(*(bf16x8*)&vv, pf, acc[dt]);
            }
        }
        den += __shfl_xor(den, 16); den += __shfl_xor(den, 32);
        const float inv = 1.f / fmaxf(fabsf(den), __expf(-m_t));
        float s1 = 0.f;
#pragma unroll
        for (int dt = 0; dt < 16; ++dt) {
            const u32x2 og = *(const u32x2*)(OP + (size_t)row * D + h * 256 + 16 * dt + 4 * g);
            f32x4 v = acc[dt] * inv;
            v.x *= sigmoidf_(bf2f(og.x & 0xffffu)); v.y *= sigmoidf_(bf2f(og.x >> 16)); v.z *= sigmoidf_(bf2f(og.y & 0xffffu)); v.w *= sigmoidf_(bf2f(og.y >> 16));
            acc[dt] = v; s1 += (v.x + v.y) + (v.z + v.w);
        }
        s1 += __shfl_xor(s1, 16); s1 += __shfl_xor(s1, 32);
        const float mu = s1 * (1.f / 256.f);
        float s2 = 0.f;
#pragma unroll
        for (int dt = 0; dt < 16; ++dt) { acc[dt] = acc[dt] - mu; s2 += (acc[dt].x * acc[dt].x + acc[dt].y * acc[dt].y) + (acc[dt].z * acc[dt].z + acc[dt].w * acc[dt].w); }
        s2 += __shfl_xor(s2, 16); s2 += __shfl_xor(s2, 32);
        const float rstd = rsqrtf(s2 * (1.f / 256.f) + LN_EPS);
#pragma unroll
        for (int dt = 0; dt < 16; ++dt) { const f32x4 gg = *(const f32x4*)(p.in[I_MNG] + (size_t)l * D + h * 256 + 16 * dt + 4 * g);
            store4_bf16(YM + (size_t)row * D + h * 256 + 16 * dt + 4 * g, acc[dt] * rstd * gg); }
    }
}

struct EpiBr1 { float* MRG; const bf16_t* GA;
    __device__ __forceinline__ void operator()(int m, int n, f32x4 v) const { const u32x2 gg = *(const u32x2*)(GA + (size_t)m * D + n);
        f32x4 o; o.x = v.x * sigmoidf_(bf2f(gg.x & 0xffffu)); o.y = v.y * sigmoidf_(bf2f(gg.x >> 16)); o.z = v.z * sigmoidf_(bf2f(gg.y & 0xffffu)); o.w = v.w * sigmoidf_(bf2f(gg.y >> 16));
        *(f32x4*)(MRG + (size_t)m * D + n) = o; } };
struct EpiBr2 { const float* MRG; const bf16_t* GB; bf16_t* OUT;
    __device__ __forceinline__ void operator()(int m, int n, f32x4 v) const { const u32x2 gg = *(const u32x2*)(GB + (size_t)m * D + n); const f32x4 t = *(const f32x4*)(MRG + (size_t)m * D + n);
        f32x4 o; o.x = t.x + v.x * sigmoidf_(bf2f(gg.x & 0xffffu)); o.y = t.y + v.y * sigmoidf_(bf2f(gg.x >> 16)); o.z = t.z + v.z * sigmoidf_(bf2f(gg.y & 0xffffu)); o.w = t.w + v.w * sigmoidf_(bf2f(gg.y >> 16));
        store4_bf16(OUT + (size_t)m * D + n, o); } };
struct EpiOut { float* Z; const bf16_t* H;
    __device__ __forceinline__ void operator()(int m, int n, f32x4 v) const { const u32x2 hh = *(const u32x2*)(H + (size_t)m * D + n);
        f32x4 o; o.x = v.x + DN_ALPHA * bf2f(hh.x & 0xffffu); o.y = v.y + DN_ALPHA * bf2f(hh.x >> 16); o.z = v.z + DN_ALPHA * bf2f(hh.y & 0xffffu); o.w = v.w + DN_ALPHA * bf2f(hh.y >> 16);
        *(f32x4*)(Z + (size_t)m * D + n) = o; } };
__device__ __forceinline__ void phase_br1(const Params& p, char* lds, int bid, int nb) {
    for (int u = bid; u < 130 * 4; u += nb)
        sgemm_unit(RowsPlain{(const bf16_t*)(p.ws + B_YM), D}, RowsPlain{(const bf16_t*)(p.ws + W_BM_T), D}, D, (u >> 2) * 128, (u & 3) * 256, EpiBr1{(float*)(p.ws + B_MRG), (const bf16_t*)(p.ws + B_GA)});
}
__device__ __forceinline__ void phase_br2(const Params& p, char* lds, int bid, int nb) {
    for (int u = bid; u < 130 * 4; u += nb)
        sgemm_unit(RowsPlain{(const bf16_t*)(p.ws + B_YA), D}, RowsPlain{(const bf16_t*)(p.ws + W_BA_T), D}, D, (u >> 2) * 128, (u & 3) * 256,
                   EpiBr2{(const float*)(p.ws + B_MRG), (const bf16_t*)(p.ws + B_GB), (bf16_t*)(p.ws + B_MRGB)});
}
__device__ __forceinline__ void phase_out(const Params& p, char* lds, int bid, int nb) {
    for (int u = bid; u < 130 * 4; u += nb)
        sgemm_unit(RowsPlain{(const bf16_t*)(p.ws + B_MRGB), D}, RowsPlain{(const bf16_t*)(p.ws + W_OUT_T), D}, D, (u >> 2) * 128, (u & 3) * 256, EpiOut{(float*)(p.ws + B_Z), (const bf16_t*)(p.ws + B_H)});
}

__device__ __forceinline__ void phase_ln1(const Params& p, int l, char* lds, int bid, int nb) {
    const int tid = TIDX, wid = tid >> 6, lane = tid & 63, gw = bid * NW + wid, ngw = nb * NW;
    float* wr = (float*)lds;
    for (int i = tid; i < D * 16 / 4; i += NT) ((f32x4*)wr)[i] = ((const f32x4*)p.in[I_WR])[i];
    __syncthreads();
    const float* Z = (const float*)(p.ws + B_Z); bf16_t* H1 = (bf16_t*)(p.ws + B_H1);
    unsigned* cnt = (unsigned*)(p.ws + WS_CTL) + CW_CNT + l * 16; int* elist = (int*)(p.ws + TAB_ELIST); float* topk = (float*)(p.ws + TAB_TOPK);
    for (int r = gw; r < P; r += ngw) {
        if (r < VALID0) { store_row_zero(H1 + (size_t)r * D, lane); continue; }
        f32x4 v[4];
#pragma unroll
        for (int j = 0; j < 4; ++j) v[j] = *(const f32x4*)(Z + (size_t)r * D + 4 * lane + 256 * j);
        ln_normalize(v, p.in[I_LN1G] + (size_t)l * D, p.in[I_LN1B] + (size_t)l * D, lane);
        store_row_bf16(H1 + (size_t)r * D, v, lane);
        float lg[16];
#pragma unroll
        for (int e = 0; e < 16; ++e) lg[e] = 0.f;
#pragma unroll
        for (int j = 0; j < 4; ++j)
#pragma unroll
            for (int i = 0; i < 4; ++i) { const int k = 4 * lane + 256 * j + i; const float x = v[j][i];
#pragma unroll
                for (int q = 0; q < 4; ++q) { const f32x4 w = *(const f32x4*)(wr + k * 16 + 4 * q); lg[4 * q] += x * w.x; lg[4 * q + 1] += x * w.y; lg[4 * q + 2] += x * w.z; lg[4 * q + 3] += x * w.w; } }
#pragma unroll
        for (int e = 0; e < 16; ++e) lg[e] = wave_sum(lg[e]);
        if (lane == 0) {
            float mx = lg[0];
#pragma unroll
            for (int e = 1; e < 16; ++e) mx = fmaxf(mx, lg[e]);
            float pr[16], sum = 0.f;
#pragma unroll
            for (int e = 0; e < 16; ++e) { pr[e] = expf(lg[e] - mx); sum += pr[e]; }
            const float isum = 1.f / sum;
            float sel[16];
#pragma unroll
            for (int e = 0; e < 16; ++e) { pr[e] *= isum; sel[e] = pr[e] + p.in[I_RB][e]; }
            int tg = 0; float best = -INFINITY;
#pragma unroll
            for (int gI = 0; gI < 4; ++gI) { const float gs = fmaxf(fmaxf(sel[4 * gI], sel[4 * gI + 1]), fmaxf(sel[4 * gI + 2], sel[4 * gI + 3])); if (gs > best) { best = gs; tg = gI; } }
            int i0 = 0; float b0 = -INFINITY;
#pragma unroll
            for (int e = 0; e < 16; ++e) if ((e >> 2) == tg && sel[e] > b0) { b0 = sel[e]; i0 = e; }
            int i1 = 0; float b1 = -INFINITY;
#pragma unroll
            for (int e = 0; e < 16; ++e) if ((e >> 2) == tg && e != i0 && sel[e] > b1) { b1 = sel[e]; i1 = e; }
            float p0 = 0.f, p1 = 0.f;
#pragma unroll
            for (int e = 0; e < 16; ++e) { if (e == i0) p0 = pr[e]; if (e == i1) p1 = pr[e]; }
            const float inv = 1.f / (p0 + p1);
            const unsigned pos0 = atomicAdd(cnt + i0, 1u), pos1 = atomicAdd(cnt + i1, 1u);
            elist[(size_t)i0 * P + pos0] = r; elist[(size_t)i1 * P + pos1] = r;
            float* tk = topk + (size_t)r * 8;
            ((int*)tk)[0] = i0; ((int*)tk)[1] = i1; ((int*)tk)[2] = (int)pos0; ((int*)tk)[3] = (int)pos1; tk[4] = p0 * inv; tk[5] = p1 * inv;
        }
    }
}

__device__ __forceinline__ void expert_offsets(const unsigned* cnt, int* s_cnt, int* s_off, int* s_tiles) {
    int off = 0;
    if (TIDX == 0) { int tt = 0; for (int e = 0; e < 16; ++e) { const int c = (int)cnt[e]; const int tl = (c + 127) >> 7; s_cnt[e] = c; s_off[e] = off; s_tiles[e] = tt; off += tl * 128; tt += tl; } s_tiles[16] = tt; }
    __syncthreads();
}
__device__ __forceinline__ void phase_e1(const Params& p, int l, char* lds, int bid, int nb) {
    int* s_cnt = (int*)lds; int* s_off = s_cnt + 16; int* s_tiles = s_off + 16;
    expert_offsets((const unsigned*)(p.ws + WS_CTL) + CW_CNT + l * 16, s_cnt, s_off, s_tiles);
    const int tid = TIDX, wid = tid >> 6, lane = tid & 63, c = lane & 15, g = lane >> 4, wr = wid >> 2, wc = wid & 3;
    const bf16_t* H1 = (const bf16_t*)(p.ws + B_H1); const int* elist = (const int*)(p.ws + TAB_ELIST); bf16_t* HID = (bf16_t*)(p.ws + B_HID);
    const int total = s_tiles[16] * 8;
    for (int u = bid; u < total; u += nb) {
        const int rt = u >> 3, ct = u & 7; int e = 0;
        while (e < 15 && rt >= s_tiles[e + 1]) ++e;
        const int ti = rt - s_tiles[e], cntE = s_cnt[e], r0 = ti * 128 + 64 * wr, n0 = ct * 128 + 32 * wc;
        const bf16_t* Wg = (const bf16_t*)(p.ws + W_G_T) + (size_t)e * D * D; const bf16_t* Wu = (const bf16_t*)(p.ws + W_U_T) + (size_t)e * D * D;
        const bf16_t* ap[4];
#pragma unroll
        for (int i = 0; i < 4; ++i) { const int rr = r0 + 16 * i + c; const int tok = elist[(size_t)e * P + (rr < cntE ? rr : 0)]; ap[i] = H1 + (size_t)tok * D + 8 * g; }
        const bf16_t* gp[2]; const bf16_t* up[2];
#pragma unroll
        for (int j = 0; j < 2; ++j) { gp[j] = Wg + (size_t)(n0 + 16 * j + c) * D + 8 * g; up[j] = Wu + (size_t)(n0 + 16 * j + c) * D + 8 * g; }
        f32x4 ag[4][2], au[4][2];
#pragma unroll
        for (int i = 0; i < 4; ++i)
#pragma unroll
            for (int j = 0; j < 2; ++j) { ag[i][j] = (f32x4){0.f, 0.f, 0.f, 0.f}; au[i][j] = (f32x4){0.f, 0.f, 0.f, 0.f}; }
        for (int k0 = 0; k0 < D; k0 += 32) {
            bf16x8 a[4], bg[2], bu[2];
#pragma unroll
            for (int i = 0; i < 4; ++i) a[i] = ld8(ap[i] + k0);
#pragma unroll
            for (int j = 0; j < 2; ++j) { bg[j] = ld8(gp[j] + k0); bu[j] = ld8(up[j] + k0); }
#pragma unroll
            for (int i = 0; i < 4; ++i)
#pragma unroll
                for (int j = 0; j < 2; ++j) { ag[i][j] = mfma16(bg[j], a[i], ag[i][j]); au[i][j] = mfma16(bu[j], a[i], au[i][j]); }
        }
#pragma unroll
        for (int i = 0; i < 4; ++i)
#pragma unroll
            for (int j = 0; j < 2; ++j) { f32x4 o;
#pragma unroll
                for (int r = 0; r < 4; ++r) o[r] = siluf_(ag[i][j][r]) * au[i][j][r];
                store4_bf16(HID + (size_t)(s_off[e] + r0 + 16 * i + c) * D + n0 + 16 * j + 4 * g, o); }
    }
}
__device__ __forceinline__ void phase_e2(const Params& p, int l, char* lds, int bid, int nb) {
    int* s_cnt = (int*)lds; int* s_off = s_cnt + 16; int* s_tiles = s_off + 16;
    expert_offsets((const unsigned*)(p.ws + WS_CTL) + CW_CNT + l * 16, s_cnt, s_off, s_tiles);
    const bf16_t* HID = (const bf16_t*)(p.ws + B_HID); bf16_t* YB = (bf16_t*)(p.ws + B_YB);
    const int total = s_tiles[16] * 4;
    for (int u = bid; u < total; u += nb) {
        const int rt = u >> 2, ct = u & 3; int e = 0;
        while (e < 15 && rt >= s_tiles[e + 1]) ++e;
        const int ti = rt - s_tiles[e];
        sgemm_unit(RowsPlain{HID + (size_t)s_off[e] * D, D}, RowsPlain{(const bf16_t*)(p.ws + W_D_T) + (size_t)e * D * D, D}, D, ti * 128, ct * 256, EpiStore{YB + (size_t)s_off[e] * D, D, 1.f});
    }
}
__device__ __forceinline__ void phase_combine(const Params& p, int l, char* lds, int bid, int nb) {
    const int tid = TIDX, wid = tid >> 6, lane = tid & 63, gw = bid * NW + wid, ngw = nb * NW;
    const bool last = (l == DEPTH - 1);
    if (!last) { convert_weights(p, l + 1, lds, gw, ngw, wid, lane); __syncthreads(); }
    int* s_cnt = (int*)(lds + 65536); int* s_off = s_cnt + 16; int* s_tiles = s_off + 16;
    expert_offsets((const unsigned*)(p.ws + WS_CTL) + CW_CNT + l * 16, s_cnt, s_off, s_tiles);
    float* g8 = (float*)lds;
    if (!last) load_gate_w(p, l + 1, g8);
    const bf16_t* H1 = (const bf16_t*)(p.ws + B_H1); const bf16_t* YB = (const bf16_t*)(p.ws + B_YB); bf16_t* H = (bf16_t*)(p.ws + B_H);
    const float* topk = (const float*)(p.ws + TAB_TOPK);
    for (int r = gw; r < P; r += ngw) {
        if (r < VALID0) { if (!last) { store_row_zero(H + (size_t)r * D, lane); gates_row_pad(p, r, lane); } continue; }
        if (last && r < 256) continue;
        const float* tk = topk + (size_t)r * 8;
        const int e0 = ((const int*)tk)[0], e1 = ((const int*)tk)[1], p0 = ((const int*)tk)[2], p1 = ((const int*)tk)[3]; const float w0 = tk[4], w1 = tk[5];
        const bf16_t* y0 = YB + (size_t)(s_off[e0] + p0) * D; const bf16_t* y1 = YB + (size_t)(s_off[e1] + p1) * D; const bf16_t* hr = H1 + (size_t)r * D;
        f32x4 v[4];
#pragma unroll
        for (int j = 0; j < 4; ++j) { const int cc = 4 * lane + 256 * j; const u32x2 a = *(const u32x2*)(y0 + cc), b = *(const u32x2*)(y1 + cc), hh = *(const u32x2*)(hr + cc);
            v[j].x = DN_ALPHA * bf2f(hh.x & 0xffffu) + w0 * bf2f(a.x & 0xffffu) + w1 * bf2f(b.x & 0xffffu);
            v[j].y = DN_ALPHA * bf2f(hh.x >> 16) + w0 * bf2f(a.x >> 16) + w1 * bf2f(b.x >> 16);
            v[j].z = DN_ALPHA * bf2f(hh.y & 0xffffu) + w0 * bf2f(a.y & 0xffffu) + w1 * bf2f(b.y & 0xffffu);
            v[j].w = DN_ALPHA * bf2f(hh.y >> 16) + w0 * bf2f(a.y >> 16) + w1 * bf2f(b.y >> 16); }
        ln_normalize(v, p.in[I_LN2G] + (size_t)l * D, p.in[I_LN2B] + (size_t)l * D, lane);
        if (last) {
            float* o = p.out + (size_t)(r - 256) * D;
#pragma unroll
            for (int j = 0; j < 4; ++j) *(f32x4*)(o + 4 * lane + 256 * j) = v[j];
        } else { store_row_bf16(H + (size_t)r * D, v, lane); gates_row(p, l + 1, g8, v, r, lane); }
    }
}

#define XB_TMO      128
#define XB_XCNT(j)  (256  + 64 * (j))
#define XB_XSUB(j)  (1280 + 64 * (j))
#define XB_XGEN(j)  (2304 + 64 * (j))
#define XB_TOP      3328
#define XB_TOPGEN   3392
#define XCD_BAR_WORDS 3456
#define XB_SPIN_CAP (1u << 18)
#define LAS __attribute__((address_space(3)))

__device__ __forceinline__ unsigned xb_ld(unsigned* p)              { return __hip_atomic_load(p, __ATOMIC_RELAXED, __HIP_MEMORY_SCOPE_AGENT); }
__device__ __forceinline__ unsigned xb_add(unsigned* p, unsigned v) { return __hip_atomic_fetch_add(p, v, __ATOMIC_RELAXED, __HIP_MEMORY_SCOPE_AGENT); }
__device__ __forceinline__ unsigned xb_xcc_id() { return (unsigned)__builtin_amdgcn_s_getreg((3 << 11) | 20) & 0xFu; }
#define XB_SPIN(cond, bar) do { unsigned _sp = 0; while (cond) { __builtin_amdgcn_s_sleep(1); \
    if ((++_sp & 255u) == 0u) { if (xb_ld(&(bar)[XB_TMO])) break; if (_sp > XB_SPIN_CAP) { atomicAdd(&(bar)[XB_TMO], 1u); break; } } } } while (0)

struct XcdBarrier {
    unsigned* bar; unsigned x;
    volatile LAS unsigned* st;
};
__device__ __forceinline__ XcdBarrier xcd_barrier_post(unsigned* bar, volatile LAS unsigned* st) {
    XcdBarrier b; b.bar = bar; b.x = xb_xcc_id(); b.st = st;
    if (threadIdx.x == 0) (void)xb_add(&bar[XB_XCNT(b.x)], 1u);
    return b;
}
__device__ __forceinline__ void xcd_barrier_complete(unsigned* bar, unsigned x, unsigned& nloc, unsigned& nx) {
    const unsigned G = gridDim.x * gridDim.y * gridDim.z;
    unsigned sum, cnt, mine, sp = 0u;
    for (;;) {
        sum = 0u; cnt = 0u; mine = 0u;
#pragma unroll
        for (unsigned j = 0; j < 16; ++j) { const unsigned c = xb_ld(&bar[XB_XCNT(j)]); sum += c; cnt += (c > 0u) ? 1u : 0u; mine = (j == x) ? c : mine; }
        if (sum == G) break;
        __builtin_amdgcn_s_sleep(1);
        if ((++sp & 255u) == 0u) { if (xb_ld(&bar[XB_TMO])) break; if (sp > XB_SPIN_CAP) { atomicAdd(&bar[XB_TMO], 1u); break; } }
    }
    nloc = mine > 0u ? mine : 1u; nx = cnt > 0u ? cnt : 1u;
}
__device__ __forceinline__ void xcd_barrier(const XcdBarrier& b) {
    asm volatile("s_waitcnt vmcnt(0)" ::: "memory");
    __syncthreads();
    if (threadIdx.x == 0) {
        unsigned* bar = b.bar;
        __builtin_amdgcn_s_waitcnt(0);
        unsigned nloc = b.st[0], nx = b.st[1];
        if (nloc == 0u) { xcd_barrier_complete(bar, b.x, nloc, nx); b.st[0] = nloc; b.st[1] = nx; }
        const unsigned old = xb_add(&bar[XB_XSUB(b.x)], 1u);
        const unsigned gen = old / nloc;
        if (old + 1u == (gen + 1u) * nloc) {
            __builtin_amdgcn_fence(__ATOMIC_RELEASE, "agent");
            asm volatile("s_waitcnt vmcnt(0)" ::: "memory");
            const unsigned og = xb_add(&bar[XB_TOP], 1u);
            const unsigned tg = og / nx;
            if (og + 1u == (tg + 1u) * nx) xb_add(&bar[XB_TOPGEN], 1u);
            else XB_SPIN(xb_ld(&bar[XB_TOPGEN]) == tg, bar);
            __builtin_amdgcn_fence(__ATOMIC_ACQUIRE, "agent");
            xb_add(&bar[XB_XGEN(b.x)], 1u);
            asm volatile("s_waitcnt vmcnt(0)" ::: "memory");
        } else {
            XB_SPIN(xb_ld(&bar[XB_XGEN(b.x)]) == gen, bar);
            __builtin_amdgcn_fence(__ATOMIC_ACQUIRE, "agent");
            asm volatile("s_waitcnt vmcnt(0)" ::: "memory");
        }
    }
    __syncthreads();
}

constexpr int LDS_BYTES = 131072 + 1024;
constexpr int LDS_BAR_OFF = LDS_BYTES - 16;
constexpr int CW_BAR = 4096;
template <int L>
__device__ __forceinline__ void layer_body(const Params& p, char* lds, int bid, int nb, const XcdBarrier& bar) {
    phase_proj_f(p, lds, bid, nb); xcd_barrier(bar);
    phase_attn_f(p, L, lds, bid, nb); xcd_barrier(bar);
    phase_conv(p, L, lds, bid, nb); xcd_barrier(bar);
    phase_mqkv(p, lds, bid, nb); xcd_barrier(bar);
    phase_m1(p, lds, bid, nb); xcd_barrier(bar);
    phase_m2(p, lds, bid, nb); xcd_barrier(bar);
    phase_m3(p, L, lds, bid, nb); xcd_barrier(bar);
    phase_br1(p, lds, bid, nb); xcd_barrier(bar);
    phase_br2(p, lds, bid, nb); xcd_barrier(bar);
    phase_out(p, lds, bid, nb); xcd_barrier(bar);
    phase_ln1(p, L, lds, bid, nb); xcd_barrier(bar);
    phase_e1(p, L, lds, bid, nb); xcd_barrier(bar);
    phase_e2(p, L, lds, bid, nb); xcd_barrier(bar);
    phase_combine(p, L, lds, bid, nb); if (L + 1 < DEPTH) xcd_barrier(bar);
}
__global__ void __launch_bounds__(NT, 2) fwd_kernel(Params p) {
    extern __shared__ __attribute__((aligned(16))) char lds[];
    const int bid = blockIdx.x, nb = gridDim.x;
    if (threadIdx.x == 0) *(uint4*)(lds + LDS_BAR_OFF) = make_uint4(0u, 0u, 0u, 0u);
    __syncthreads();
    XcdBarrier bar = xcd_barrier_post((unsigned*)(p.ws + WS_CTL) + CW_BAR, (volatile LAS unsigned*)(lds + LDS_BAR_OFF));
    phase_prologue(p, lds, bid, nb); xcd_barrier(bar);
    layer_body<0>(p, lds, bid, nb, bar);
    layer_body<1>(p, lds, bid, nb, bar);
}

extern "C" void kernel_launch(void* const* d_in, const int* in_sizes, int n_in, void* d_out, int out_size, void* d_ws, size_t ws_size, hipStream_t stream) {
    if (n_in != 30 || ws_size < WS_END) { fprintf(stderr, "kernel_launch: unexpected n_in %d or ws_size %zu (< %zu)\n", n_in, ws_size, (size_t)WS_END); return; }
    static int grid = 0;
    if (grid == 0) {
        int dev = 0, cus = 0;
        if (hipGetDevice(&dev) != hipSuccess || hipDeviceGetAttribute(&cus, hipDeviceAttributeMultiprocessorCount, dev) != hipSuccess || cus <= 0) cus = 256;
        (void)hipFuncSetAttribute((const void*)fwd_kernel, hipFuncAttributeMaxDynamicSharedMemorySize, LDS_BYTES);
        grid = cus;
    }
    Params p{};
    for (int i = 0; i < 30; ++i) p.in[i] = (const float*)d_in[i];
    p.out = (float*)d_out; p.ws = (unsigned char*)d_ws;
    (void)hipMemsetAsync((char*)d_ws + WS_CTL, 0, CTL_BYTES, stream);
    hipLaunchKernelGGL(fwd_kernel, dim3(grid), dim3(NT), LDS_BYTES, stream, p);
}
```

```cpp
#include <hip/hip_runtime.h>
#include <cstdio>
#include <cstdint>

constexpr int D = 1024;
constexpr int SEQ = 16384;
constexpr int NMETA = 16;
constexpr int P = 16640;
constexpr int VALID0 = 240;
constexpr int DEPTH = 2;
constexpr int DIN = 7176;
constexpr int NSC = 65;
constexpr int NEXP = 16;
constexpr float LN_EPS = 1e-5f;
constexpr float DN_ALPHA = 1.4142135623730951f;
constexpr float NEGBIG = -1e30f;
constexpr int NT = 512;
constexpr int NW = 8;

typedef unsigned short bf16_t;
typedef short bf16x8 __attribute__((ext_vector_type(8)));
typedef float f32x4 __attribute__((ext_vector_type(4)));
typedef unsigned u32x4 __attribute__((ext_vector_type(4)));
typedef unsigned u32x2 __attribute__((ext_vector_type(2)));

constexpr size_t MiB = 1u << 20;
constexpr size_t RB = (size_t)P * D * 2;
constexpr size_t WS_CTL = 0;
constexpr size_t CTL_BYTES = 1 * MiB;
constexpr size_t WS_TAB = 1 * MiB;
constexpr size_t TAB_GLI = WS_TAB;
constexpr size_t TAB_GLF = TAB_GLI + 4 * P * 4;
constexpr size_t TAB_B   = TAB_GLF + 4 * P * 4;
constexpr size_t TAB_E   = TAB_B + 4 * P * 4;
constexpr size_t TAB_PM  = TAB_E + 4 * P * 4;
constexpr size_t TAB_W   = TAB_PM + 4 * P * 4;
constexpr size_t TAB_SCG = TAB_W + 4 * P * 4;
constexpr size_t TAB_SCM = TAB_SCG + 4096;
constexpr size_t TAB_MT  = TAB_SCM + 4096;
constexpr size_t TAB_NT  = TAB_MT + 4096;
constexpr size_t TAB_TOPK = TAB_NT + (size_t)NSC * 4 * 256 * 4;
constexpr size_t TAB_ELIST = TAB_TOPK + (size_t)P * 32;
constexpr size_t TAB_END = TAB_ELIST + (size_t)NEXP * P * 4;
static_assert(TAB_END <= 8 * MiB, "tables");
constexpr size_t WS_W = 8 * MiB;
constexpr size_t W_IN_T = WS_W;
constexpr size_t W_Q_T = W_IN_T + (size_t)7168 * 1024 * 2;
constexpr size_t W_K_T = W_Q_T + 4 * 65536 * 2;
constexpr size_t W_V_T = W_K_T + 4 * 65536 * 2;
constexpr size_t W_BM_T = W_V_T + 4 * 65536 * 2;
constexpr size_t W_BA_T = W_BM_T + (size_t)D * D * 2;
constexpr size_t W_OUT_T = W_BA_T + (size_t)D * D * 2;
constexpr size_t W_G_T = W_OUT_T + (size_t)D * D * 2;
constexpr size_t W_U_T = W_G_T + (size_t)NEXP * D * D * 2;
constexpr size_t W_D_T = W_U_T + (size_t)NEXP * D * D * 2;
constexpr size_t W_END = W_D_T + (size_t)NEXP * D * D * 2;
static_assert(W_END <= 128 * MiB, "weights");
constexpr size_t WS_SLOT = 128 * MiB;
constexpr size_t SLOT(int i) { return WS_SLOT + (size_t)i * RB; }
constexpr size_t WS_END = WS_SLOT + 11 * RB;
constexpr size_t B_H = SLOT(0);
constexpr size_t B_XM = SLOT(1), B_YM = SLOT(1);
constexpr size_t B_OP = SLOT(2), B_MRGB = SLOT(2);
constexpr size_t B_QA = SLOT(3), B_QM = SLOT(3);
constexpr size_t B_KA = SLOT(4), B_XC = SLOT(4), B_CT = SLOT(4);
constexpr size_t B_VAT = SLOT(5), B_KM = SLOT(5), B_H1 = SLOT(5);
constexpr size_t B_GA = SLOT(6);
constexpr size_t B_GB = SLOT(7);
constexpr size_t B_YA = SLOT(8);
constexpr size_t B_KMT = SLOT(9), B_MRG = SLOT(9);
constexpr size_t B_VMT = SLOT(10), B_VA = SLOT(10);
constexpr size_t B_Z = SLOT(3);
constexpr size_t B_HID = SLOT(6);
constexpr size_t B_YB = SLOT(1), B_XP = SLOT(1);
constexpr int HID_ROWS_MAX = (int)(3 * RB / (D * 2));
constexpr int CW_CNT = 64;

struct Params {
    const float* in[30];
    float* out;
    unsigned char* ws;
};
enum { I_X = 0, I_META, I_LNG, I_LNB, I_WIN, I_CONVW, I_CONVB, I_WQM, I_WKM, I_WVM, I_BI, I_BF, I_MNG, I_LQ1, I_LK1, I_LQ2, I_LK2, I_ANG,
       I_WBM, I_WBA, I_WOUT, I_LN1G, I_LN1B, I_LN2G, I_LN2B, I_WR, I_RB, I_WG, I_WU, I_WD };

__device__ __forceinline__ int tid_opaque() { int t = threadIdx.x; asm volatile("" : "+v"(t)); return t; }
#define TIDX tid_opaque()
__device__ __forceinline__ float bf2f(unsigned v) { return __uint_as_float(v << 16); }
__device__ __forceinline__ unsigned f2bf(float f) { unsigned u = __float_as_uint(f); return (u + 0x7fffu + ((u >> 16) & 1u)) >> 16; }
__device__ __forceinline__ unsigned pk2(float lo, float hi) { return f2bf(lo) | (f2bf(hi) << 16); }
__device__ __forceinline__ float wave_sum(float v) {
#pragma unroll
    for (int o = 1; o < 64; o <<= 1) v += __shfl_xor(v, o);
    return v;
}
__device__ __forceinline__ float sigmoidf_(float x) { return 1.f / (1.f + __expf(-x)); }
__device__ __forceinline__ float siluf_(float x) { return x / (1.f + __expf(-x)); }
__device__ __forceinline__ float logsigmoidf_(float x) { return x >= 0.f ? -log1pf(__expf(-x)) : x - log1pf(__expf(x)); }
__device__ __forceinline__ f32x4 mfma16(bf16x8 a, bf16x8 b, f32x4 c) { return __builtin_amdgcn_mfma_f32_16x16x32_bf16(a, b, c, 0, 0, 0); }
__device__ __forceinline__ bf16x8 ld8(const bf16_t* p) { return *(const bf16x8*)p; }

__device__ __forceinline__ void transpose_item(const float* W, int K, size_t ldsrc, int k0, int n_src0, bf16_t* WT, int dst_row0, float* scr, int lane) {
#pragma unroll 8
    for (int i = 0; i < 32; ++i) { const int kk = 2 * i + (lane >> 5); scr[kk * 33 + (lane & 31)] = W[(size_t)(k0 + kk) * ldsrc + n_src0 + (lane & 31)]; }
    __builtin_amdgcn_wave_barrier();
    asm volatile("s_waitcnt lgkmcnt(0)" ::: "memory");
    const int c = lane & 7;
#pragma unroll
    for (int j = 0; j < 4; ++j) { const int n = (lane >> 3) + 8 * j; const float* s = scr + (8 * c) * 33 + n;
        u32x4 o; o.x = pk2(s[0 * 33], s[1 * 33]); o.y = pk2(s[2 * 33], s[3 * 33]); o.z = pk2(s[4 * 33], s[5 * 33]); o.w = pk2(s[6 * 33], s[7 * 33]);
        *(u32x4*)(WT + (size_t)(dst_row0 + n) * K + k0 + 8 * c) = o; }
    asm volatile("s_waitcnt lgkmcnt(0)" ::: "memory");
    __builtin_amdgcn_wave_barrier();
}
__device__ __forceinline__ void convert_weights(const Params& p, int l, char* lds, int gw, int ngw, int wid, int lane) {
    float* scr = (float*)lds + wid * (64 * 33);
    unsigned char* ws = p.ws;
    constexpr int I_IN = 16 * 224, I_QKV = 3 * 4 * 4 * 8, I_SQ = 16 * 32, I_EXP = 3 * 16 * 512;
    constexpr int TOTAL = I_IN + I_QKV + 3 * I_SQ + I_EXP;
    for (int it = gw; it < TOTAL; it += ngw) {
        int r = it;
        if (r < I_IN) { const int kb = r / 224, nb = r % 224, r0 = nb * 32, nsrc = r0 < 2048 ? r0 : r0 + 8;
            transpose_item(p.in[I_WIN] + (size_t)l * D * DIN, D, DIN, kb * 64, nsrc, (bf16_t*)(ws + W_IN_T), r0, scr, lane); continue; }
        r -= I_IN;
        if (r < I_QKV) { const int w = r / 128, rr = r % 128, h = rr / 32, t = rr % 32, kb = t / 8, nb = t % 8;
            const float* src = p.in[w == 0 ? I_WQM : (w == 1 ? I_WKM : I_WVM)] + ((size_t)l * 4 + h) * 65536;
            bf16_t* dst = (bf16_t*)(ws + (w == 0 ? W_Q_T : (w == 1 ? W_K_T : W_V_T))) + (size_t)h * 65536;
            transpose_item(src, 256, 256, kb * 64, nb * 32, dst, nb * 32, scr, lane); continue; }
        r -= I_QKV;
        if (r < 3 * I_SQ) { const int w = r / I_SQ, t = r % I_SQ, kb = t / 32, nb = t % 32;
            const float* src = p.in[w == 0 ? I_WBM : (w == 1 ? I_WBA : I_WOUT)] + (size_t)l * D * D;
            bf16_t* dst = (bf16_t*)(ws + (w == 0 ? W_BM_T : (w == 1 ? W_BA_T : W_OUT_T)));
            transpose_item(src, D, D, kb * 64, nb * 32, dst, nb * 32, scr, lane); continue; }
        r -= 3 * I_SQ;
        { const int w = r / (16 * 512), rr = r % (16 * 512), e = rr / 512, t = rr % 512, kb = t / 32, nb = t % 32;
            const float* src = p.in[w == 0 ? I_WG : (w == 1 ? I_WU : I_WD)] + ((size_t)l * NEXP + e) * D * D;
            if (w == 2) transpose_item(src, D, D, kb * 64, nb * 32, (bf16_t*)(ws + W_D_T) + (size_t)e * D * D, nb * 32, scr, lane);
            else { const int j0 = nb * 32; transpose_item(src, D, D, kb * 64, j0, (bf16_t*)(ws + W_G_T) + (size_t)e * 2048 * D, 256 * (j0 >> 7) + (j0 & 127) + (w == 1 ? 128 : 0), scr, lane); } }
    }
}

__device__ __forceinline__ void ln_normalize(f32x4 (&v)[4], const float* g, const float* b, int lane) {
    float s = 0.f;
#pragma unroll
    for (int j = 0; j < 4; ++j) s += (v[j].x + v[j].y) + (v[j].z + v[j].w);
    const float mean = wave_sum(s) * (1.f / D);
    float s2 = 0.f;
#pragma unroll
    for (int j = 0; j < 4; ++j) { v[j] = v[j] - mean; s2 += (v[j].x * v[j].x + v[j].y * v[j].y) + (v[j].z * v[j].z + v[j].w * v[j].w); }
    const float rstd = rsqrtf(wave_sum(s2) * (1.f / D) + LN_EPS);
#pragma unroll
    for (int j = 0; j < 4; ++j) { const f32x4 gg = *(const f32x4*)(g + 4 * lane + 256 * j), bb = *(const f32x4*)(b + 4 * lane + 256 * j); v[j] = v[j] * rstd * gg + bb; }
}
__device__ __forceinline__ void store_row_bf16(bf16_t* row, const f32x4 (&v)[4], int lane) {
#pragma unroll
    for (int j = 0; j < 4; ++j) { u32x2 o; o.x = pk2(v[j].x, v[j].y); o.y = pk2(v[j].z, v[j].w); *(u32x2*)(row + 4 * lane + 256 * j) = o; }
}
__device__ __forceinline__ void store_row_zero(bf16_t* row, int lane) {
#pragma unroll
    for (int j = 0; j < 4; ++j) { u32x2 o; o.x = 0u; o.y = 0u; *(u32x2*)(row + 4 * lane + 256 * j) = o; }
}
__device__ __forceinline__ void load_gate_w(const Params& p, int l, float* g8) {
    const float* w = p.in[I_WIN] + (size_t)l * D * DIN + 2048;
    for (int i = TIDX; i < D * 8; i += NT) { const int k = i >> 3, c = i & 7; g8[i] = w[(size_t)k * DIN + c]; }
    __syncthreads();
}
__device__ __forceinline__ void gates_row(const Params& p, int l, const float* g8, const f32x4 (&v)[4], int prow, int lane) {
    float acc[8];
#pragma unroll
    for (int c = 0; c < 8; ++c) acc[c] = 0.f;
#pragma unroll
    for (int j = 0; j < 4; ++j)
#pragma unroll
        for (int i = 0; i < 4; ++i) { const int k = 4 * lane + 256 * j + i; const float x = v[j][i];
            const f32x4 w0 = *(const f32x4*)(g8 + k * 8), w1 = *(const f32x4*)(g8 + k * 8 + 4);
            acc[0] += x * w0.x; acc[1] += x * w0.y; acc[2] += x * w0.z; acc[3] += x * w0.w; acc[4] += x * w1.x; acc[5] += x * w1.y; acc[6] += x * w1.z; acc[7] += x * w1.w; }
#pragma unroll
    for (int c = 0; c < 8; ++c) acc[c] = wave_sum(acc[c]);
    if (lane < 4) {
        float* gli = (float*)(p.ws + TAB_GLI); float* glf = (float*)(p.ws + TAB_GLF);
        const float bi = p.in[I_BI][l * 4 + lane], bfv = p.in[I_BF][l * 4 + lane];
        float ai = acc[0], af = acc[4];
        if (lane == 1) { ai = acc[1]; af = acc[5]; } else if (lane == 2) { ai = acc[2]; af = acc[6]; } else if (lane == 3) { ai = acc[3]; af = acc[7]; }
        gli[(size_t)lane * P + prow] = ai + bi;
        glf[(size_t)lane * P + prow] = logsigmoidf_(af + bfv);
    }
}
__device__ __forceinline__ void gates_row_pad(const Params& p, int prow, int lane) {
    if (lane < 4) { ((float*)(p.ws + TAB_GLI))[(size_t)lane * P + prow] = NEGBIG; ((float*)(p.ws + TAB_GLF))[(size_t)lane * P + prow] = 0.f; }
}

__device__ __forceinline__ void phase_prologue(const Params& p, char* lds, int bid, int nb) {
    const int tid = TIDX, wid = tid >> 6, lane = tid & 63, gw = bid * NW + wid, ngw = nb * NW;
    convert_weights(p, 0, lds, gw, ngw, wid, lane);
    __syncthreads();
    float* g8 = (float*)lds;
    load_gate_w(p, 0, g8);
    bf16_t* H = (bf16_t*)(p.ws + B_H);
    for (int r = gw; r < P; r += ngw) {
        if (r < VALID0) { store_row_zero(H + (size_t)r * D, lane); gates_row_pad(p, r, lane); continue; }
        const float* src = r < 256 ? p.in[I_META] + (size_t)(r - VALID0) * D : p.in[I_X] + (size_t)(r - 256) * D;
        f32x4 v[4];
#pragma unroll
        for (int j = 0; j < 4; ++j) v[j] = *(const f32x4*)(src + 4 * lane + 256 * j);
        ln_normalize(v, p.in[I_LNG], p.in[I_LNB], lane);
        store_row_bf16(H + (size_t)r * D, v, lane);
        gates_row(p, 0, g8, v, r, lane);
    }
}

struct RowsPlain { const bf16_t* base; size_t ld; __device__ __forceinline__ const bf16_t* row(int m) const { return base + (size_t)m * ld; } };
template <class AR, class BR, class Epi>
__device__ __forceinline__ void sgemm_unit(const AR& ar, const BR& br, int K, int m0, int n0, const Epi& epi) {
    const int tid = TIDX, wid = tid >> 6, lane = tid & 63, c = lane & 15, g = lane >> 4, wr = wid >> 2, wc = wid & 3;
    const int mw = m0 + 64 * wr, nw = n0 + 64 * wc;
    const bf16_t* ap[4]; const bf16_t* bp[4];
#pragma unroll
    for (int i = 0; i < 4; ++i) { ap[i] = ar.row(mw + 16 * i + c) + 8 * g; bp[i] = br.row(nw + 16 * i + c) + 8 * g; }
    f32x4 acc[4][4];
#pragma unroll
    for (int i = 0; i < 4; ++i)
#pragma unroll
        for (int j = 0; j < 4; ++j) acc[i][j] = (f32x4){0.f, 0.f, 0.f, 0.f};
    for (int k0 = 0; k0 < K; k0 += 32) {
        bf16x8 a[4], b[4];
#pragma unroll
        for (int i = 0; i < 4; ++i) { a[i] = ld8(ap[i] + k0); b[i] = ld8(bp[i] + k0); }
#pragma unroll
        for (int i = 0; i < 4; ++i)
#pragma unroll
            for (int j = 0; j < 4; ++j) acc[i][j] = mfma16(b[j], a[i], acc[i][j]);
    }
#pragma unroll
    for (int i = 0; i < 4; ++i)
#pragma unroll
        for (int j = 0; j < 4; ++j) epi(mw + 16 * i + c, nw + 16 * j + 4 * g, acc[i][j]);
}
__device__ __forceinline__ void store4_bf16(bf16_t* dst, f32x4 v) { u32x2 o; o.x = pk2(v.x, v.y); o.y = pk2(v.z, v.w); *(u32x2*)dst = o; }

struct EpiProj { unsigned char* ws;
    __device__ __forceinline__ void operator()(int m, int n, f32x4 v) const {
        const int seg = n >> 10, cc = n & 1023;
        const size_t off = seg == 0 ? B_XM : seg == 1 ? B_OP : seg == 2 ? B_QA : seg == 3 ? B_KA : seg == 4 ? B_VA : seg == 5 ? B_GA : B_GB;
        store4_bf16((bf16_t*)(ws + off) + (size_t)m * D + cc, v); } };
struct EpiStore { bf16_t* C; size_t ldc; float scale;
    __device__ __forceinline__ void operator()(int m, int n, f32x4 v) const { store4_bf16(C + (size_t)m * ldc + n, v * scale); } };
__device__ __forceinline__ void phase_proj(const Params& p, char* lds, int bid, int nb) {
    const bf16_t* H = (const bf16_t*)(p.ws + B_H); const bf16_t* W = (const bf16_t*)(p.ws + W_IN_T);
    constexpr int NU_MAIN = 130 * 24, NU_VAT = 8 * 65;
    for (int u = bid; u < NU_MAIN + NU_VAT; u += nb) {
        if (u < NU_MAIN) { const int mt = u / 24; int ct = u % 24; if (ct >= 16) ct += 4;
            sgemm_unit(RowsPlain{H, D}, RowsPlain{W, D}, D, mt * 128, ct * 256, EpiProj{p.ws});
        } else { const int v = u - NU_MAIN, mt = v / 65, ct = v % 65;
            sgemm_unit(RowsPlain{W + (size_t)4096 * D, D}, RowsPlain{H, D}, D, mt * 128, ct * 256, EpiStore{(bf16_t*)(p.ws + B_VAT), P, 1.f}); }
    }
}

namespace pg8 {
#define PG8_LAS __attribute__((address_space(3)))
constexpr int BM = 256, BK = 64, HALF = 128, HTB = HALF * BK * 2, STAGE_BYTES = 8 * HTB, NXCD = 8, WGM = 8;
__host__ __device__ __forceinline__ int lds_byte(int r, int c) { const int st = (r >> 4) * 2 + (c >> 5), rr = r & 15, cc = c & 31, ob = rr * 64 + cc * 2; return st * 1024 + (ob ^ (((ob >> 9) & 1) << 5)); }
__host__ __device__ __forceinline__ void stage_rc(int b, int& R, int& C) { const int st = b / 1024, sb = b % 1024, swz = sb ^ (((sb >> 9) & 1) << 5); R = (st >> 1) * 16 + swz / 64; C = (st & 1) * 32 + (swz % 64) / 2; }
__host__ __device__ __forceinline__ int perm32(int rho) { const int n = rho >> 4, i = rho & 15; return 8 * (i >> 2) + 4 * n + (i & 3); }
struct Unit { int pm, pn, grp; };
__device__ __forceinline__ bool decode_unit(long L, int nG, int nM, int nN, Unit& u) {
    const int nwg = nG * nM * nN; if (L >= nwg) return false;
    int wgid = (int)L; { const int q = nwg / NXCD, r = nwg % NXCD, xcd = wgid % NXCD, off = wgid / NXCD; wgid = (xcd < r ? xcd * (q + 1) : r * (q + 1) + (xcd - r) * q) + off; }
    const int per = nM * nN; u.grp = wgid / per; const int rem = wgid % per;
    const int nig = WGM * nN, gid = rem / nig, fm = gid * WGM, gsz = (nM - fm) < WGM ? (nM - fm) : WGM;
    u.pm = __builtin_amdgcn_readfirstlane(fm + ((rem % nig) % gsz)); u.pn = __builtin_amdgcn_readfirstlane((rem % nig) / gsz); u.grp = __builtin_amdgcn_readfirstlane(u.grp); return true;
}
__device__ __forceinline__ unsigned cvt_pk_bf16(float lo, float hi) { unsigned r; asm volatile("v_cvt_pk_bf16_f32 %0, %1, %2" : "=v"(r) : "v"(lo), "v"(hi)); return r; }

template <class Epi, class Sched, bool ALIGN_EPI = true>
__device__ __forceinline__ void gemm_phase(PG8_LAS unsigned char* lds, const Sched& S, const Epi& E) {
    const int tid = TIDX, wid = __builtin_amdgcn_readfirstlane(tid >> 6), lane = tid & 63, wr = wid >> 2, wc = wid & 3, fr = lane & 15, fq = lane >> 4;
    const int K = S.K, nt = K / BK;
    unsigned voffA[2], voffB[2];
#pragma unroll
    for (int i = 0; i < 2; ++i) { int R, C; stage_rc(tid * 16 + i * 8192, R, C); const int Rb = (R & ~31) + perm32(R & 31);
        voffA[i] = (unsigned)(R * S.lda + C) * 2u; voffB[i] = (unsigned)(Rb * S.ldb + C) * 2u; }
    const size_t kstep = (size_t)(BK * 2);
    const size_t hstepA = (size_t)HALF * S.lda * 2, hstepB = (size_t)HALF * S.ldb * 2;
    const unsigned ldsw = (unsigned)wid * 1024u;
    const int aoff = lds_byte(wr * 64 + fr, fq * 8), boff = lds_byte(wc * 32 + fr, fq * 8);
#define PG8_SA(b, h) (((b) * 2 + (h)) * HTB)
#define PG8_SB(b, h) ((4 + (b) * 2 + (h)) * HTB)
#define PG8_STAGE(bufoff, gbase, voff) do { _Pragma("unroll") for (int _i = 0; _i < 2; ++_i) \
        __builtin_amdgcn_global_load_lds((const unsigned*)((const char*)(gbase) + (voff)[_i]), (PG8_LAS unsigned*)(lds + (bufoff) + ldsw + _i * 8192), 16, 0, 0); } while (0)
#define PG8_LDA(dst, b, h) do { _Pragma("unroll") for (int m = 0; m < 4; ++m) _Pragma("unroll") for (int k = 0; k < 2; ++k) dst[m][k] = *(const PG8_LAS bf16x8*)(lds + PG8_SA(b, h) + aoff + m * 2048 + k * 1024); } while (0)
#define PG8_LDB(dst, b, h) do { _Pragma("unroll") for (int n = 0; n < 2; ++n) _Pragma("unroll") for (int k = 0; k < 2; ++k) dst[n][k] = *(const PG8_LAS bf16x8*)(lds + PG8_SB(b, h) + boff + n * 2048 + k * 1024); } while (0)
#define PG8_MMA(ai, bj, At, Bt) do { __builtin_amdgcn_s_setprio(1); _Pragma("unroll") for (int m = 0; m < 4; ++m) _Pragma("unroll") for (int n = 0; n < 2; ++n) _Pragma("unroll") for (int k = 0; k < 2; ++k) \
        acc[ai][bj][m][n] = __builtin_amdgcn_mfma_f32_16x16x32_bf16(Bt[n][k], At[m][k], acc[ai][bj][m][n], 0, 0, 0); __builtin_amdgcn_s_setprio(0); } while (0)
#define PG8_WAIT_V(n) asm volatile("s_waitcnt vmcnt(" #n ")" ::: "memory")
#define PG8_WAIT_L(n) asm volatile("s_waitcnt lgkmcnt(" #n ")" ::: "memory")
#define PG8_BAR __builtin_amdgcn_s_barrier()
#define PG8_SCHED __builtin_amdgcn_sched_barrier(0)
    Unit cur, nxt; int ui = 0;
    if (!S.next(0, cur)) return;
    f32x4 acc[2][2][4][2];
#pragma unroll
    for (int a = 0; a < 2; ++a)
#pragma unroll
        for (int b = 0; b < 2; ++b)
#pragma unroll
            for (int m = 0; m < 4; ++m)
#pragma unroll
                for (int n = 0; n < 2; ++n) acc[a][b][m][n] = (f32x4){0.f, 0.f, 0.f, 0.f};
    bf16x8 At[4][2], B0[2][2], B1[2][2];
    const char* cA = S.abase(cur); const char* cB = S.bbase(cur);
    PG8_STAGE(PG8_SB(0, 0), cB, voffB); PG8_STAGE(PG8_SB(0, 1), cB + hstepB, voffB); PG8_STAGE(PG8_SA(0, 0), cA, voffA); PG8_STAGE(PG8_SA(0, 1), cA + hstepA, voffA);
    if (wr == 1) PG8_BAR;
    PG8_WAIT_V(2); PG8_BAR;
    PG8_STAGE(PG8_SB(1, 0), cB + kstep, voffB); PG8_STAGE(PG8_SA(1, 0), cA + kstep, voffA); PG8_STAGE(PG8_SB(1, 1), cB + hstepB + kstep, voffB);
    PG8_WAIT_V(6); PG8_BAR;
    for (;;) {
        const bool has_next = S.next(ui + 1, nxt);
        const char* nA = has_next ? S.abase(nxt) : cA; const char* nB = has_next ? S.bbase(nxt) : cB;
        for (int t = 0; t < nt; t += 2) {
            const bool last = (t == nt - 2);
            const char* a1 = cA + (size_t)(t + 1) * kstep;
            const char* a2 = last ? nA : cA + (size_t)(t + 2) * kstep; const char* b2 = last ? nB : cB + (size_t)(t + 2) * kstep;
            const char* a3 = a2 + kstep; const char* b3 = b2 + kstep;
            PG8_LDB(B0, 0, 0); PG8_LDB(B1, 0, 1); PG8_SCHED; PG8_LDA(At, 0, 0); PG8_STAGE(PG8_SA(1, 1), a1 + hstepA, voffA);
            PG8_WAIT_V(8); PG8_WAIT_L(0); PG8_BAR; PG8_MMA(0, 0, At, B0); PG8_MMA(0, 1, At, B1); PG8_BAR; PG8_SCHED;
            PG8_LDA(At, 0, 1); PG8_STAGE(PG8_SB(0, 0), b2, voffB); PG8_STAGE(PG8_SB(0, 1), b2 + hstepB, voffB); PG8_STAGE(PG8_SA(0, 0), a2, voffA);
            PG8_WAIT_V(8); PG8_WAIT_L(0); PG8_BAR; PG8_MMA(1, 0, At, B0); PG8_MMA(1, 1, At, B1); PG8_BAR; PG8_SCHED;
            PG8_LDB(B0, 1, 0); PG8_LDB(B1, 1, 1); PG8_SCHED; PG8_LDA(At, 1, 0); PG8_STAGE(PG8_SA(0, 1), a2 + hstepA, voffA);
            PG8_WAIT_V(8); PG8_WAIT_L(0); PG8_BAR; PG8_MMA(0, 0, At, B0); PG8_MMA(0, 1, At, B1); PG8_BAR; PG8_SCHED;
            PG8_LDA(At, 1, 1); PG8_STAGE(PG8_SB(1, 0), b3, voffB); PG8_STAGE(PG8_SB(1, 1), b3 + hstepB, voffB); PG8_STAGE(PG8_SA(1, 0), a3, voffA);
            PG8_WAIT_V(8); PG8_WAIT_L(0); PG8_BAR; PG8_MMA(1, 0, At, B0); PG8_MMA(1, 1, At, B1); PG8_BAR; PG8_SCHED;
        }
        if constexpr (ALIGN_EPI) { if (wr == 0) PG8_BAR; }
        E(acc, cur, wr, wc, fr, fq);
        if (!has_next) break;
#pragma unroll
        for (int a = 0; a < 2; ++a)
#pragma unroll
            for (int b = 0; b < 2; ++b)
#pragma unroll
                for (int m = 0; m < 4; ++m)
#pragma unroll
                    for (int n = 0; n < 2; ++n) acc[a][b][m][n] = (f32x4){0.f, 0.f, 0.f, 0.f};
        cur = nxt; cA = nA; cB = nB; ++ui;
        if constexpr (ALIGN_EPI) { if (wr == 1) PG8_BAR; }
    }
    PG8_WAIT_V(0);
    if constexpr (!ALIGN_EPI) { if (wr == 0) PG8_BAR; }
    PG8_BAR;
#undef PG8_SA
#undef PG8_SB
#undef PG8_STAGE
#undef PG8_LDA
#undef PG8_LDB
#undef PG8_MMA
#undef PG8_WAIT_V
#undef PG8_WAIT_L
#undef PG8_BAR
#undef PG8_SCHED
}
__device__ __forceinline__ u32x4 pack8(f32x4 v0, f32x4 v1) { u32x4 w; w.x = cvt_pk_bf16(v0[0], v0[1]); w.y = cvt_pk_bf16(v0[2], v0[3]); w.z = cvt_pk_bf16(v1[0], v1[1]); w.w = cvt_pk_bf16(v1[2], v1[3]); return w; }
__device__ __forceinline__ void unpack8(u32x4 w, f32x4& v0, f32x4& v1) {
    v0[0] = __uint_as_float(w.x << 16); v0[1] = __uint_as_float(w.x & 0xffff0000u); v0[2] = __uint_as_float(w.y << 16); v0[3] = __uint_as_float(w.y & 0xffff0000u);
    v1[0] = __uint_as_float(w.z << 16); v1[1] = __uint_as_float(w.z & 0xffff0000u); v1[2] = __uint_as_float(w.w << 16); v1[3] = __uint_as_float(w.w & 0xffff0000u); }
template <class F> __device__ __forceinline__ void for_each_piece(const f32x4 (&acc)[2][2][4][2], const Unit& u, int wr, int wc, int fr, int fq, const F& f) {
    const int row0 = u.pm * BM + wr * 64 + fr, col0 = wc * 32 + 8 * fq;
#pragma unroll
    for (int ai = 0; ai < 2; ++ai)
#pragma unroll
        for (int m = 0; m < 4; ++m)
#pragma unroll
            for (int bj = 0; bj < 2; ++bj) f(row0 + ai * HALF + m * 16, col0 + bj * HALF, acc[ai][bj][m][0], acc[ai][bj][m][1]);
}
}

template <int MI, int NJ, class AR, class BR, class Epi>
__device__ __forceinline__ void sgemm_wave(const AR& ar, const BR& br, int K, int m0, int n0, const Epi& epi) {
    const int lane = TIDX & 63, c = lane & 15, g = lane >> 4;
    const bf16_t* ap[MI]; const bf16_t* bp[NJ];
#pragma unroll
    for (int i = 0; i < MI; ++i) ap[i] = ar.row(m0 + 16 * i + c) + 8 * g;
#pragma unroll
    for (int j = 0; j < NJ; ++j) bp[j] = br.row(n0 + 16 * j + c) + 8 * g;
    f32x4 acc[MI][NJ];
#pragma unroll
    for (int i = 0; i < MI; ++i)
#pragma unroll
        for (int j = 0; j < NJ; ++j) acc[i][j] = (f32x4){0.f, 0.f, 0.f, 0.f};
#pragma unroll 4
    for (int k0 = 0; k0 < K; k0 += 32) {
        bf16x8 a[MI], b[NJ];
#pragma unroll
        for (int i = 0; i < MI; ++i) a[i] = ld8(ap[i] + k0);
#pragma unroll
        for (int j = 0; j < NJ; ++j) b[j] = ld8(bp[j] + k0);
#pragma unroll
        for (int i = 0; i < MI; ++i)
#pragma unroll
            for (int j = 0; j < NJ; ++j) acc[i][j] = mfma16(b[j], a[i], acc[i][j]);
    }
#pragma unroll
    for (int i = 0; i < MI; ++i)
#pragma unroll
        for (int j = 0; j < NJ; ++j) epi(m0 + 16 * i + c, n0 + 16 * j + 4 * g, acc[i][j]);
}
__device__ __forceinline__ void zero_block(bf16_t* base, size_t ld, int nrows, int ncols, int gtid, int gthreads) {
    const int cpr = ncols / 8;
    for (int i = gtid; i < nrows * cpr; i += gthreads) { const int r = i / cpr, cc = (i % cpr) * 8; *(u32x4*)(base + (size_t)r * ld + cc) = (u32x4){0u, 0u, 0u, 0u}; }
}

struct SchedProj { const char* A; const char* B; int G, c; int K, lda, ldb;
    __device__ __forceinline__ bool next(int i, pg8::Unit& u) const { if (!pg8::decode_unit((long)i * G + c, 1, 64, 28, u)) return false; u.pm += 1; return true; }
    __device__ __forceinline__ const char* abase(const pg8::Unit& u) const { return A + (size_t)u.pm * 256 * D * 2; }
    __device__ __forceinline__ const char* bbase(const pg8::Unit& u) const { return B + (size_t)u.pn * 256 * D * 2; } };
struct EpiProjF { unsigned char* ws;
    __device__ __forceinline__ void operator()(const f32x4 (&acc)[2][2][4][2], const pg8::Unit& u, int wr, int wc, int fr, int fq) const {
        const int colt = u.pn * 256, seg = colt >> 10;
        const size_t off = seg == 0 ? B_XM : seg == 1 ? B_OP : seg == 2 ? B_QA : seg == 3 ? B_KA : seg == 4 ? B_VA : seg == 5 ? B_GA : B_GB;
        bf16_t* base = (bf16_t*)(ws + off) + (colt & 1023);
        pg8::for_each_piece(acc, u, wr, wc, fr, fq, [&](int row, int col, f32x4 v0, f32x4 v1) { *(u32x4*)(base + (size_t)row * D + col) = pg8::pack8(v0, v1); }); } };
struct SchedVAT { const char* A; const char* B; int G, c; int K, lda, ldb;
    __device__ __forceinline__ bool next(int i, pg8::Unit& u) const { if (!pg8::decode_unit((long)i * G + c, 1, 4, 64, u)) return false; u.pn += 1; return true; }
    __device__ __forceinline__ const char* abase(const pg8::Unit& u) const { return A + (size_t)u.pm * 256 * D * 2; }
    __device__ __forceinline__ const char* bbase(const pg8::Unit& u) const { return B + (size_t)u.pn * 256 * D * 2; } };
struct EpiStoreF { bf16_t* C; size_t ldc; float scale;
    __device__ __forceinline__ void operator()(const f32x4 (&acc)[2][2][4][2], const pg8::Unit& u, int wr, int wc, int fr, int fq) const {
        bf16_t* base = C + (size_t)u.pn * 256;
        pg8::for_each_piece(acc, u, wr, wc, fr, fq, [&](int row, int col, f32x4 v0, f32x4 v1) { *(u32x4*)(base + (size_t)row * ldc + col) = pg8::pack8(v0 * scale, v1 * scale); }); } };
__device__ __forceinline__ void phase_proj_f(const Params& p, char* lds, int bid, int nb) {
    const int tid = TIDX, wid = tid >> 6, gw = bid * NW + wid, ngw = nb * NW;
    const bf16_t* H = (const bf16_t*)(p.ws + B_H); const bf16_t* W = (const bf16_t*)(p.ws + W_IN_T);
    zero_block((bf16_t*)(p.ws + B_KA), D, VALID0, D, bid * NT + tid, nb * NT);
    zero_block((bf16_t*)(p.ws + B_VA), D, VALID0, D, bid * NT + tid, nb * NT);
    zero_block((bf16_t*)(p.ws + B_XM), D, VALID0, D, bid * NT + tid, nb * NT);
    for (int t = gw; t < 112; t += ngw) sgemm_wave<1, 4>(RowsPlain{H, D}, RowsPlain{W, D}, D, VALID0, t * 64, EpiProj{p.ws});
    { SchedProj S{(const char*)H, (const char*)W, nb, bid, D, D, D};
      pg8::gemm_phase(( PG8_LAS unsigned char*)lds, S, EpiProjF{p.ws}); }
}

__device__ __forceinline__ void phase_attn(const Params& p, int l, char* lds, int bid, int nb) {
    const int tid = TIDX, wid = tid >> 6, lane = tid & 63, c = lane & 15, g = lane >> 4, gw = bid * NW + wid, ngw = nb * NW;
    const bf16_t* QA = (const bf16_t*)(p.ws + B_QA); const bf16_t* KA = (const bf16_t*)(p.ws + B_KA); const bf16_t* VAT = (const bf16_t*)(p.ws + B_VAT);
    bf16_t* YA = (bf16_t*)(p.ws + B_YA);
    const float lam_init = 0.8f - 0.6f * expf(-0.3f * (float)l);
    float lam;
    { const float a = wave_sum(p.in[I_LQ1][l * 64 + lane] * p.in[I_LK1][l * 64 + lane]), b = wave_sum(p.in[I_LQ2][l * 64 + lane] * p.in[I_LK2][l * 64 + lane]);
      lam = expf(a) - expf(b) + lam_init; }
    constexpr int NQG = P / 16, QG0 = VALID0 / 16;
    const int ntask = (NQG - QG0) * 8;
    for (int t = gw; t < ntask; t += ngw) {
        const int qg = NQG - 1 - t / 8, hd = t % 8, q0 = qg * 16, q = q0 + c;
        bf16x8 qf[2][2];
#pragma unroll
        for (int mp = 0; mp < 2; ++mp)
#pragma unroll
            for (int ks = 0; ks < 2; ++ks) qf[mp][ks] = ld8(QA + (size_t)q * D + hd * 128 + mp * 64 + 32 * ks + 8 * g);
        f32x4 o[2][8];
#pragma unroll
        for (int mp = 0; mp < 2; ++mp)
#pragma unroll
            for (int dt = 0; dt < 8; ++dt) o[mp][dt] = (f32x4){0.f, 0.f, 0.f, 0.f};
        float mrun[2] = {NEGBIG, NEGBIG}, lrun[2] = {0.f, 0.f};
        for (int kb = 224; kb <= q0 + 15; kb += 32) {
            bf16x8 pf[2];
#pragma unroll
            for (int mp = 0; mp < 2; ++mp) {
                f32x4 s[2];
#pragma unroll
                for (int a = 0; a < 2; ++a) {
                    s[a] = (f32x4){0.f, 0.f, 0.f, 0.f};
                    const bf16_t* kr = KA + (size_t)(kb + 16 * a + c) * D + hd * 128 + mp * 64 + 8 * g;
#pragma unroll
                    for (int ks = 0; ks < 2; ++ks) s[a] = mfma16(ld8(kr + 32 * ks), qf[mp][ks], s[a]);
                }
                float mx = NEGBIG;
#pragma unroll
                for (int a = 0; a < 2; ++a)
#pragma unroll
                    for (int r = 0; r < 4; ++r) { const int key = kb + 16 * a + 4 * g + r; float v = s[a][r] * 0.125f; v = (key <= q && key >= VALID0) ? v : -INFINITY; s[a][r] = v; mx = fmaxf(mx, v); }
                mx = fmaxf(mx, __shfl_xor(mx, 16)); mx = fmaxf(mx, __shfl_xor(mx, 32));
                const float mn = fmaxf(mrun[mp], mx), alpha = __expf(mrun[mp] - mn);
                mrun[mp] = mn;
                float ps = 0.f;
#pragma unroll
                for (int a = 0; a < 2; ++a)
#pragma unroll
                    for (int r = 0; r < 4; ++r) { const float e = __expf(s[a][r] - mn); s[a][r] = e; ps += e; }
                lrun[mp] = lrun[mp] * alpha + ps;
#pragma unroll
                for (int dt = 0; dt < 8; ++dt) o[mp][dt] = o[mp][dt] * alpha;
                u32x4 w; w.x = pk2(s[0][0], s[0][1]); w.y = pk2(s[0][2], s[0][3]); w.z = pk2(s[1][0], s[1][1]); w.w = pk2(s[1][2], s[1][3]);
                pf[mp] = *(bf16x8*)&w;
            }
#pragma unroll
            for (int dt = 0; dt < 8; ++dt) {
                const bf16_t* vr = VAT + (size_t)(hd * 128 + 16 * dt + c) * P + kb + 4 * g;
                u32x2 v0 = *(const u32x2*)vr, v1 = *(const u32x2*)(vr + 16);
                u32x4 w; w.x = v0.x; w.y = v0.y; w.z = v1.x; w.w = v1.y;
                const bf16x8 vf = *(bf16x8*)&w;
                o[0][dt] = mfma16(vf, pf[0], o[0][dt]);
                o[1][dt] = mfma16(vf, pf[1], o[1][dt]);
            }
        }
        float l0 = lrun[0], l1 = lrun[1];
        l0 += __shfl_xor(l0, 16); l0 += __shfl_xor(l0, 32); l1 += __shfl_xor(l1, 16); l1 += __shfl_xor(l1, 32);
        const float i0 = 1.f / l0, i1 = lam / l1;
        float ss = 0.f;
#pragma unroll
        for (int dt = 0; dt < 8; ++dt) { o[0][dt] = o[0][dt] * i0 - o[1][dt] * i1; ss += (o[0][dt].x * o[0][dt].x + o[0][dt].y * o[0][dt].y) + (o[0][dt].z * o[0][dt].z + o[0][dt].w * o[0][dt].w); }
        ss += __shfl_xor(ss, 16); ss += __shfl_xor(ss, 32);
        const float rs = rsqrtf(ss * (1.f / 128.f) + LN_EPS) * (1.f - lam_init);
#pragma unroll
        for (int dt = 0; dt < 8; ++dt) { const f32x4 gg = *(const f32x4*)(p.in[I_ANG] + l * 128 + 16 * dt + 4 * g);
            store4_bf16(YA + (size_t)q * D + hd * 128 + 16 * dt + 4 * g, o[0][dt] * rs * gg); }
    }
}

namespace fa {
typedef short s16x4 __attribute__((ext_vector_type(4)));
typedef float f32x16 __attribute__((ext_vector_type(16)));
constexpr int KVBLK = 64, SHM_V = 64 * 128 * 2, SHM_K = 64 * 64 * 2, PITCH = 1024;
constexpr int LDS_NEED = 2 * SHM_V + 2 * SHM_K + NW * 64 * 4;
constexpr float SCALE = 0.125f, THR = 8.f;
#define FA_SBAR() __builtin_amdgcn_sched_barrier(0)
__device__ __forceinline__ int kswz(int row, int chunk) { return row * 128 + ((chunk ^ ((row >> 1) & 7)) << 4); }
__device__ __forceinline__ int v_st(int k, int c) { const int kk = (k & ~0xC) | ((k & 4) << 1) | ((k & 8) >> 1); return ((kk >> 3) * 4 + (c >> 5)) * 512 + ((kk & 7) * 32 + (c & 31)) * 2; }
__device__ __forceinline__ int v_rd_base(int lane) { return ((lane & 3) << 3) | (((lane >> 2) & 3) << 6) | (((lane >> 4) & 1) << 5) | (((lane >> 5) & 1) << 8); }
constexpr int v_rd_off(int d0, int ks, int half) { return d0 * 512 + ks * 4096 + half * 2048; }
__device__ __forceinline__ int crow(int r, int hi) { return (r & 3) + 8 * (r >> 2) + 4 * hi; }
__device__ __forceinline__ unsigned cvtpk(float lo, float hi) { unsigned r; asm volatile("v_cvt_pk_bf16_f32 %0, %1, %2" : "=v"(r) : "v"(lo), "v"(hi)); return r; }
__device__ __forceinline__ void mask_tile(f32x16& p0, f32x16& p1, int pos, int kbase, int hi, int lowkey) {
    const float NEG = -__builtin_inff();
#pragma unroll
    for (int r = 0; r < 16; ++r) {
        const int k0 = kbase + (r & 3) + 8 * (r >> 2) + 4 * hi;
        if (k0 > pos || k0 < lowkey) p0[r] = NEG;
        if (k0 + 32 > pos || k0 + 32 < lowkey) p1[r] = NEG;
    }
}
__device__ __forceinline__ void partialSM(f32x16& p0, f32x16& p1, float& m_reg, float& mn, float& alpha) {
    float pmax = p0[0];
#pragma unroll
    for (int r = 1; r < 16; ++r) pmax = fmaxf(pmax, p0[r]);
#pragma unroll
    for (int r = 0; r < 16; ++r) pmax = fmaxf(pmax, p1[r]);
    { auto rr = __builtin_amdgcn_permlane32_swap(__float_as_uint(pmax), __float_as_uint(pmax), false, false);
      pmax = fmaxf(__uint_as_float(rr[0]), __uint_as_float(rr[1])); }
    constexpr float C2 = 1.4426950408889634f * SCALE;
    if (__builtin_expect(__all((pmax - m_reg) * SCALE <= THR), 1)) { mn = m_reg; alpha = 1.f; }
    else { mn = fmaxf(m_reg, pmax); alpha = __builtin_amdgcn_exp2f((m_reg - mn) * C2); m_reg = mn; }
    const float mnL = -mn * C2;
#pragma unroll
    for (int r = 0; r < 16; ++r) p0[r] = fmaf(p0[r], C2, mnL);
#pragma unroll
    for (int r = 0; r < 16; ++r) p1[r] = fmaf(p1[r], C2, mnL);
#pragma unroll
    for (int r = 0; r < 16; ++r) p0[r] = __builtin_amdgcn_exp2f(p0[r]);
}
__device__ __forceinline__ void finishSM(f32x16& p0, f32x16& p1, float alpha, float& l_reg, bf16x8& pa0, bf16x8& pa1, bf16x8& pa2, bf16x8& pa3) {
#pragma unroll
    for (int r = 0; r < 16; ++r) p1[r] = __builtin_amdgcn_exp2f(p1[r]);
    float ps = 0;
#pragma unroll
    for (int r = 0; r < 16; ++r) ps += p0[r];
#pragma unroll
    for (int r = 0; r < 16; ++r) ps += p1[r];
    { auto rr = __builtin_amdgcn_permlane32_swap(__float_as_uint(ps), __float_as_uint(ps), false, false);
      ps = __uint_as_float(rr[0]) + __uint_as_float(rr[1]); }
    l_reg = l_reg * alpha + ps;
#define FA_PK4(Pv, B_, OUT) do { unsigned a0 = cvtpk(Pv[B_+0], Pv[B_+1]), a1 = cvtpk(Pv[B_+2], Pv[B_+3]);                          \
        unsigned b0 = cvtpk(Pv[B_+4], Pv[B_+5]), b1 = cvtpk(Pv[B_+6], Pv[B_+7]);                                             \
        auto r0 = __builtin_amdgcn_permlane32_swap(a0, b0, false, false); auto r1 = __builtin_amdgcn_permlane32_swap(a1, b1, false, false); \
        u32x4 w = {r0[0], r1[0], r0[1], r1[1]}; OUT = *reinterpret_cast<bf16x8*>(&w); } while (0)
    FA_PK4(p0, 0, pa0); FA_PK4(p0, 8, pa1); FA_PK4(p1, 0, pa2); FA_PK4(p1, 8, pa3);
#undef FA_PK4
}
template <int KB>
__device__ __forceinline__ void qkt(f32x16& p0, f32x16& p1, const char* K_lds, int r32, int hi, const bf16x8* qr) {
    p0 = f32x16{}; p1 = f32x16{};
#pragma unroll
    for (int d0 = 0; d0 < 4; ++d0) { const char* a = K_lds + KB * SHM_K + kswz(r32, 2 * d0 + hi);
        bf16x8 b0 = *reinterpret_cast<const bf16x8*>(a);
        bf16x8 b1 = *reinterpret_cast<const bf16x8*>(a + 32 * 128);
        p0 = __builtin_amdgcn_mfma_f32_32x32x16_bf16(b0, qr[d0], p0, 0, 0, 0);
        p1 = __builtin_amdgcn_mfma_f32_32x32x16_bf16(b1, qr[d0], p1, 0, 0, 0); }
}
template <int VB>
__device__ __forceinline__ void pv_tile(f32x16* o, int vb0, bf16x8 pa0, bf16x8 pa1, bf16x8 pa2, bf16x8 pa3) {
#define FA_TRRD(dst, off) asm volatile("ds_read_b64_tr_b16 %0, %1 offset:%2" : "=&v"(dst) : "v"(vb0), "i"(off) : "memory")
#define FA_PV_D0(d0) do { s16x4 l0, l1, l2, l3, h0, h1, h2, h3; constexpr int b_ = VB * SHM_V + v_rd_off(d0, 0, 0); \
        FA_TRRD(l0, b_); FA_TRRD(h0, b_ + 2048); FA_TRRD(l1, b_ + 4096); FA_TRRD(h1, b_ + 6144); FA_TRRD(l2, b_ + 8192); FA_TRRD(h2, b_ + 10240); FA_TRRD(l3, b_ + 12288); FA_TRRD(h3, b_ + 14336); \
        asm volatile("s_waitcnt lgkmcnt(0)" ::: "memory"); FA_SBAR();   \
        o[d0] = __builtin_amdgcn_mfma_f32_32x32x16_bf16(pa0, (bf16x8){l0[0], l0[1], l0[2], l0[3], h0[0], h0[1], h0[2], h0[3]}, o[d0], 0, 0, 0);   \
        o[d0] = __builtin_amdgcn_mfma_f32_32x32x16_bf16(pa1, (bf16x8){l1[0], l1[1], l1[2], l1[3], h1[0], h1[1], h1[2], h1[3]}, o[d0], 0, 0, 0);   \
        o[d0] = __builtin_amdgcn_mfma_f32_32x32x16_bf16(pa2, (bf16x8){l2[0], l2[1], l2[2], l2[3], h2[0], h2[1], h2[2], h2[3]}, o[d0], 0, 0, 0);   \
        o[d0] = __builtin_amdgcn_mfma_f32_32x32x16_bf16(pa3, (bf16x8){l3[0], l3[1], l3[2], l3[3], h3[0], h3[1], h3[2], h3[3]}, o[d0], 0, 0, 0); } while (0)
    FA_PV_D0(0); FA_PV_D0(1); FA_PV_D0(2); FA_PV_D0(3);
#undef FA_PV_D0
#undef FA_TRRD
}
__device__ __forceinline__ void attn_pass(const bf16_t* Qp, const bf16_t* Kp, const bf16_t* Vp, int P0, int NT, char* lds, f32x16 (&o)[4], float& l_out) {
    const int tid = TIDX, wid = __builtin_amdgcn_readfirstlane(tid >> 6), lane = tid & 63, r32 = lane & 31, hi = lane >> 5;
    char* V_lds = lds; char* K_lds = lds + 2 * SHM_V;
    float* wsl = (float*)(lds + 2 * SHM_V + 2 * SHM_K) + wid * 64; float* al_l = wsl + 32;
    const int qlo = P0 + wid * 32, pos = qlo + r32;
    float m_reg = -1e30f, l_reg = 0.f;
#pragma unroll
    for (int d = 0; d < 4; ++d) o[d] = f32x16{};
    const int ksr = tid >> 3, ksc = tid & 7, kws = kswz(ksr, ksc);
    const int sr = tid >> 4, sc = (tid & 15) * 8, vst0 = v_st(sr, sc), vst1 = v_st(32 + sr, sc);
    const int vb0 = (int)(uintptr_t)V_lds + v_rd_base(lane);
    bf16x8 qr[4];
#pragma unroll
    for (int d0 = 0; d0 < 4; ++d0) qr[d0] = ld8(Qp + (size_t)pos * PITCH + d0 * 16 + hi * 8);
    bf16x8 st_k, st_v0, st_v1;
#define FA_KBASE(t) ((3 + (t)) * KVBLK)
#define FA_SLOAD(t) do { const int kb_ = FA_KBASE(t); st_k = ld8(Kp + (size_t)(kb_ + ksr) * PITCH + ksc * 8); \
        st_v0 = ld8(Vp + (size_t)(kb_ + sr) * PITCH + sc); st_v1 = ld8(Vp + (size_t)(kb_ + 32 + sr) * PITCH + sc); } while (0)
#define FA_SWRITE_K(bf) do { *(bf16x8*)(K_lds + (bf) * SHM_K + kws) = st_k; } while (0)
#define FA_SWRITE_V(bf) do { *(bf16x8*)(V_lds + (bf) * SHM_V + vst0) = st_v0; *(bf16x8*)(V_lds + (bf) * SHM_V + vst1) = st_v1; } while (0)
#define FA_VMW() asm volatile("s_waitcnt vmcnt(0)" ::: "memory")
#define FA_RESC(a) do { if (__any((a) < 1.f)) { if (hi == 0) al_l[r32] = (a); asm volatile("s_waitcnt lgkmcnt(0)" ::: "memory");              \
                     for (int d_ = 0; d_ < 4; ++d_) for (int r = 0; r < 16; ++r) o[d_][r] *= al_l[crow(r, hi)]; } } while (0)
#define FA_MASKT(P0_, P1_, t) do { const int kb_ = FA_KBASE(t); if ((t) == 0 || kb_ + KVBLK - 1 > qlo) mask_tile(P0_, P1_, pos, kb_, hi, VALID0); } while (0)
    f32x16 pA0, pA1, pB0, pB1; float mnA, mnB, alA, alB; bf16x8 pa0, pa1, pa2, pa3;
    FA_SLOAD(0); FA_VMW(); FA_SWRITE_K(0); FA_SWRITE_V(0); FA_SBAR();
    if (NT > 1) FA_SLOAD(1);
    __syncthreads();
    FA_SBAR(); qkt<0>(pA0, pA1, K_lds, r32, hi, qr);
    FA_MASKT(pA0, pA1, 0); partialSM(pA0, pA1, m_reg, mnA, alA);
    if (NT > 1) { FA_VMW(); FA_SWRITE_K(1); FA_SWRITE_V(1); }
    __syncthreads();
#define FA_HALF_STEP(PX0, PX1, mnX, alX, PY0, PY1, alY, t, KB, VB, SB) do {                                                      \
        FA_SBAR(); qkt<KB>(PX0, PX1, K_lds, r32, hi, qr);                                             \
        finishSM(PY0, PY1, alY, l_reg, pa0, pa1, pa2, pa3); FA_SBAR();                                                           \
        if ((t) + 1 < NT) { FA_SLOAD((t) + 1); FA_SBAR(); }                                               \
        pv_tile<VB>(o, vb0, pa0, pa1, pa2, pa3); FA_MASKT(PX0, PX1, (t)); partialSM(PX0, PX1, m_reg, mnX, alX);                                        \
        __syncthreads();                                                                                                      \
        if ((t) + 1 < NT) { FA_VMW(); FA_SWRITE_K(SB); FA_SWRITE_V(SB); }                                                                          \
        FA_RESC(alX); __syncthreads(); } while (0)
    for (int t = 1; t + 1 < NT; t += 2) {
        FA_HALF_STEP(pB0, pB1, mnB, alB, pA0, pA1, alA, t, 1, 0, 0);
        FA_HALF_STEP(pA0, pA1, mnA, alA, pB0, pB1, alB, t + 1, 0, 1, 1);
    }
    const bool even = (NT & 1) == 0;
    if (even) { FA_SBAR(); qkt<1>(pB0, pB1, K_lds, r32, hi, qr); FA_SBAR(); }
    finishSM(pA0, pA1, alA, l_reg, pa0, pa1, pa2, pa3); FA_SBAR();
    pv_tile<0>(o, vb0, pa0, pa1, pa2, pa3);
    if (even) { FA_MASKT(pB0, pB1, NT - 1); partialSM(pB0, pB1, m_reg, mnB, alB); __syncthreads(); FA_RESC(alB);
        finishSM(pB0, pB1, alB, l_reg, pa0, pa1, pa2, pa3); FA_SBAR(); pv_tile<1>(o, vb0, pa0, pa1, pa2, pa3); }
    l_out = l_reg;
    __syncthreads();
#undef FA_KBASE
#undef FA_SLOAD
#undef FA_SWRITE_K
#undef FA_SWRITE_V
#undef FA_VMW
#undef FA_RESC
#undef FA_MASKT
#undef FA_HALF_STEP
}
__device__ __forceinline__ void attn_unit(const Params& p, int l, int hd, int j, float lam, float lam_init, char* lds) {
    const int tid = TIDX, wid = __builtin_amdgcn_readfirstlane(tid >> 6), lane = tid & 63, r32 = lane & 31, hi = lane >> 5;
    const bf16_t* QA = (const bf16_t*)(p.ws + B_QA) + hd * 128; const bf16_t* KA = (const bf16_t*)(p.ws + B_KA) + hd * 128; const bf16_t* VA = (const bf16_t*)(p.ws + B_VA) + hd * 128;
    bf16_t* YA = (bf16_t*)(p.ws + B_YA) + hd * 128;
    const int P0 = j * 256, NT = 4 * j + 1;
    float* li_l = (float*)(lds + 2 * SHM_V + 2 * SHM_K) + wid * 64;
    bf16_t* Yw = YA + (size_t)(P0 + wid * 32) * PITCH;
    f32x16 o[4]; float lr;
    attn_pass(QA, KA, VA, P0, NT, lds, o, lr);
    if (hi == 0) li_l[r32] = lr;
    asm volatile("s_waitcnt lgkmcnt(0)" ::: "memory");
#pragma unroll
    for (int r = 0; r < 16; ++r) { const int orow = crow(r, hi); const float rl = __builtin_amdgcn_rcpf(li_l[orow]);
#pragma unroll
        for (int d0 = 0; d0 < 4; ++d0) { const float v = o[d0][r] * rl; const float vn = __shfl_xor(v, 1);
            if ((r32 & 1) == 0) *(unsigned*)(Yw + (size_t)orow * PITCH + d0 * 32 + r32) = cvtpk(v, vn); } }
    asm volatile("s_waitcnt vmcnt(0)" ::: "memory");
    __syncthreads();
    attn_pass(QA + 64, KA + 64, VA, P0, NT, lds, o, lr);
    if (hi == 0) li_l[r32] = lr;
    asm volatile("s_waitcnt lgkmcnt(0)" ::: "memory");
    const float scale_out = 1.f - lam_init;
#pragma unroll
    for (int r = 0; r < 16; ++r) { const int orow = crow(r, hi); const float rl = lam * __builtin_amdgcn_rcpf(li_l[orow]);
        float cv[4]; float ss = 0.f;
#pragma unroll
        for (int d0 = 0; d0 < 4; ++d0) { const float o1 = bf2f((unsigned)Yw[(size_t)orow * PITCH + d0 * 32 + r32]); cv[d0] = o1 - o[d0][r] * rl; ss += cv[d0] * cv[d0]; }
        ss += __shfl_xor(ss, 1); ss += __shfl_xor(ss, 2); ss += __shfl_xor(ss, 4); ss += __shfl_xor(ss, 8); ss += __shfl_xor(ss, 16);
        const float rs = rsqrtf(ss * (1.f / 128.f) + LN_EPS) * scale_out;
#pragma unroll
        for (int d0 = 0; d0 < 4; ++d0) o[d0][r] = cv[d0] * rs * p.in[I_ANG][l * 128 + d0 * 32 + r32]; }
    asm volatile("s_waitcnt vmcnt(0)" ::: "memory");
    __syncthreads();
#pragma unroll
    for (int r = 0; r < 16; ++r) { const int orow = crow(r, hi);
#pragma unroll
        for (int d0 = 0; d0 < 4; ++d0) { const float v = o[d0][r]; const float vn = __shfl_xor(v, 1);
            if ((r32 & 1) == 0) *(unsigned*)(Yw + (size_t)orow * PITCH + d0 * 32 + r32) = cvtpk(v, vn); } }
    __syncthreads();
}
}
__device__ __forceinline__ void phase_attn_f(const Params& p, int l, char* lds, int bid, int nb) {
    const int lane = TIDX & 63;
    const float lam_init = 0.8f - 0.6f * expf(-0.3f * (float)l);
    float lam;
    { const float a = wave_sum(p.in[I_LQ1][l * 64 + lane] * p.in[I_LK1][l * 64 + lane]), b = wave_sum(p.in[I_LQ2][l * 64 + lane] * p.in[I_LK2][l * 64 + lane]);
      lam = expf(a) - expf(b) + lam_init; }
    for (int u = bid; u < 256 + 8; u += nb) {
        if (u < 256) { const int hd = u & 7, jj = u >> 3;
            fa::attn_unit(p, l, hd, 64 - jj, lam, lam_init, lds);
            fa::attn_unit(p, l, hd, 1 + jj, lam, lam_init, lds);
        } else fa::attn_unit(p, l, u - 256, 0, lam, lam_init, lds);
    }
}

__device__ __forceinline__ void phase_conv(const Params& p, int l, char* lds, int bid, int nb) {
    const int tid = TIDX, wid = tid >> 6, lane = tid & 63, gw = bid * NW + wid, ngw = nb * NW;
    const bf16_t* XM = (const bf16_t*)(p.ws + B_XM); bf16_t* XC = (bf16_t*)(p.ws + B_XC);
    const float* cw = p.in[I_CONVW] + (size_t)l * 4 * D; const float* cb = p.in[I_CONVB] + (size_t)l * D;
    const int nitem = P * (D / 8);
    for (int it = bid * NT + tid; it < nitem; it += nb * NT) {
        const int r = it >> 7, c0 = (it & 127) * 8;
        u32x4 o = {0u, 0u, 0u, 0u};
        if (r >= VALID0) {
            float acc[8];
#pragma unroll
            for (int i = 0; i < 8; ++i) acc[i] = cb[c0 + i];
#pragma unroll
            for (int j = 0; j < 4; ++j) { const int rr = r - 3 + j;
                if (rr >= VALID0) { const u32x4 x = *(const u32x4*)(XM + (size_t)rr * D + c0); const float* w = cw + j * D + c0;
                    acc[0] += w[0] * bf2f(x.x & 0xffffu); acc[1] += w[1] * bf2f(x.x >> 16); acc[2] += w[2] * bf2f(x.y & 0xffffu); acc[3] += w[3] * bf2f(x.y >> 16);
                    acc[4] += w[4] * bf2f(x.z & 0xffffu); acc[5] += w[5] * bf2f(x.z >> 16); acc[6] += w[6] * bf2f(x.w & 0xffffu); acc[7] += w[7] * bf2f(x.w >> 16); } }
            o.x = pk2(siluf_(acc[0]), siluf_(acc[1])); o.y = pk2(siluf_(acc[2]), siluf_(acc[3])); o.z = pk2(siluf_(acc[4]), siluf_(acc[5])); o.w = pk2(siluf_(acc[6]), siluf_(acc[7]));
        }
        *(u32x4*)(XC + (size_t)r * D + c0) = o;
    }
    const float* gli = (const float*)(p.ws + TAB_GLI); const float* glf = (const float*)(p.ws + TAB_GLF);
    float* tb = (float*)(p.ws + TAB_B); float* te = (float*)(p.ws + TAB_E); float* tpm = (float*)(p.ws + TAB_PM); float* tw = (float*)(p.ws + TAB_W);
    float* scg = (float*)(p.ws + TAB_SCG); float* scm = (float*)(p.ws + TAB_SCM);
    for (int t = gw; t < NSC * 4; t += ngw) {
        const int sc = t >> 2, h = t & 3; const size_t base = (size_t)h * P + sc * 256 + 4 * lane;
        const f32x4 lf = *(const f32x4*)(glf + base), li = *(const f32x4*)(gli + base);
        float b[4]; b[0] = lf.x; b[1] = b[0] + lf.y; b[2] = b[1] + lf.z; b[3] = b[2] + lf.w;
        float incl = b[3];
#pragma unroll
        for (int o = 1; o < 64; o <<= 1) { const float n = __shfl_up(incl, o); if (lane >= o) incl += n; }
        const float excl = incl - b[3];
        float e[4], pm[4];
#pragma unroll
        for (int i = 0; i < 4; ++i) { b[i] += excl; e[i] = li[i] - b[i]; }
        pm[0] = e[0]; pm[1] = fmaxf(pm[0], e[1]); pm[2] = fmaxf(pm[1], e[2]); pm[3] = fmaxf(pm[2], e[3]);
        float mi = pm[3];
#pragma unroll
        for (int o = 1; o < 64; o <<= 1) { const float n = __shfl_up(mi, o); if (lane >= o) mi = fmaxf(mi, n); }
        float mex = __shfl_up(mi, 1); if (lane == 0) mex = -INFINITY;
#pragma unroll
        for (int i = 0; i < 4; ++i) pm[i] = fmaxf(pm[i], mex);
        const float gtot = __shfl(incl, 63), emax = __shfl(mi, 63), mloc = gtot + emax;
        f32x4 ww;
#pragma unroll
        for (int i = 0; i < 4; ++i) ww[i] = __expf(e[i] + gtot - mloc);
        *(f32x4*)(tb + base) = (f32x4){b[0], b[1], b[2], b[3]};
        *(f32x4*)(te + base) = (f32x4){e[0], e[1], e[2], e[3]};
        *(f32x4*)(tpm + base) = (f32x4){pm[0], pm[1], pm[2], pm[3]};
        *(f32x4*)(tw + base) = ww;
        if (lane == 0) { scg[sc * 4 + h] = gtot; scm[sc * 4 + h] = mloc; }
    }
}

__device__ __forceinline__ void phase_mqkv(const Params& p, char* lds, int bid, int nb) {
    const bf16_t* XC = (const bf16_t*)(p.ws + B_XC); const bf16_t* XM = (const bf16_t*)(p.ws + B_XM);
    const bf16_t* WQ = (const bf16_t*)(p.ws + W_Q_T); const bf16_t* WK = (const bf16_t*)(p.ws + W_K_T); const bf16_t* WV = (const bf16_t*)(p.ws + W_V_T);
    bf16_t* QM = (bf16_t*)(p.ws + B_QM); bf16_t* KM = (bf16_t*)(p.ws + B_KM); bf16_t* KMT = (bf16_t*)(p.ws + B_KMT); bf16_t* VMT = (bf16_t*)(p.ws + B_VMT);
    for (int u = bid; u < 4 * 520; u += nb) {
        const int w = u / 520, r = u % 520, h = r / 130, t = r % 130;
        if (w == 0) sgemm_unit(RowsPlain{XC + h * 256, D}, RowsPlain{WQ + (size_t)h * 65536, 256}, 256, t * 128, 0, EpiStore{QM + h * 256, D, 1.f});
        else if (w == 1) sgemm_unit(RowsPlain{XC + h * 256, D}, RowsPlain{WK + (size_t)h * 65536, 256}, 256, t * 128, 0, EpiStore{KM + h * 256, D, 0.0625f});
        else if (w == 2) sgemm_unit(RowsPlain{WK + (size_t)h * 65536, 256}, RowsPlain{XC + h * 256, D}, 256, (t / 65) * 128, (t % 65) * 256, EpiStore{KMT + (size_t)h * 256 * P, P, 0.0625f});
        else sgemm_unit(RowsPlain{WV + (size_t)h * 65536, 256}, RowsPlain{XM + h * 256, D}, 256, (t / 65) * 128, (t % 65) * 256, EpiStore{VMT + (size_t)h * 256 * P, P, 1.f});
    }
}

__device__ __forceinline__ void phase_m1(const Params& p, char* lds, int bid, int nb) {
    const int tid = TIDX, wid = tid >> 6, lane = tid & 63, c = lane & 15, g = lane >> 4, gw = bid * NW + wid, ngw = nb * NW;
    const bf16_t* KMT = (const bf16_t*)(p.ws + B_KMT); const bf16_t* VMT = (const bf16_t*)(p.ws + B_VMT);
    const float* tw = (const float*)(p.ws + TAB_W); bf16_t* CT = (bf16_t*)(p.ws + B_CT); float* NTv = (float*)(p.ws + TAB_NT);
    for (int t = gw; t < NSC * 4 * 16; t += ngw) {
        const int dvb = t & 15, h = (t >> 4) & 3, sc = t >> 6, s0 = sc * 256;
        f32x4 acc[16];
#pragma unroll
        for (int i = 0; i < 16; ++i) acc[i] = (f32x4){0.f, 0.f, 0.f, 0.f};
        float un[16];
#pragma unroll
        for (int i = 0; i < 16; ++i) un[i] = 0.f;
        for (int ks = 0; ks < 8; ++ks) {
            const int sb = s0 + 32 * ks + 8 * g;
            const f32x4 w0 = *(const f32x4*)(tw + (size_t)h * P + sb), w1 = *(const f32x4*)(tw + (size_t)h * P + sb + 4);
            const u32x4 vv = *(const u32x4*)(VMT + (size_t)(h * 256 + 16 * dvb + c) * P + sb);
            u32x4 vw; vw.x = pk2(bf2f(vv.x & 0xffffu) * w0.x, bf2f(vv.x >> 16) * w0.y); vw.y = pk2(bf2f(vv.y & 0xffffu) * w0.z, bf2f(vv.y >> 16) * w0.w);
            vw.z = pk2(bf2f(vv.z & 0xffffu) * w1.x, bf2f(vv.z >> 16) * w1.y); vw.w = pk2(bf2f(vv.w & 0xffffu) * w1.z, bf2f(vv.w >> 16) * w1.w);
            const bf16x8 vf = *(bf16x8*)&vw;
#pragma unroll
            for (int dk = 0; dk < 16; ++dk) {
                const u32x4 kk = *(const u32x4*)(KMT + (size_t)(h * 256 + 16 * dk + c) * P + sb);
                acc[dk] = mfma16(*(const bf16x8*)&kk, vf, acc[dk]);
                if (dvb == 0) un[dk] += bf2f(kk.x & 0xffffu) * w0.x + bf2f(kk.x >> 16) * w0.y + bf2f(kk.y & 0xffffu) * w0.z + bf2f(kk.y >> 16) * w0.w
                                      + bf2f(kk.z & 0xffffu) * w1.x + bf2f(kk.z >> 16) * w1.y + bf2f(kk.w & 0xffffu) * w1.z + bf2f(kk.w >> 16) * w1.w;
            }
        }
        bf16_t* dst = CT + ((size_t)(sc * 4 + h) * 256 + 16 * dvb + c) * 256;
#pragma unroll
        for (int dk = 0; dk < 16; ++dk) store4_bf16(dst + 16 * dk + 4 * g, acc[dk]);
        if (dvb == 0) {
#pragma unroll
            for (int dk = 0; dk < 16; ++dk) { float v = un[dk]; v += __shfl_xor(v, 16); v += __shfl_xor(v, 32); if (g == 0) NTv[(size_t)(sc * 4 + h) * 256 + 16 * dk + c] = v; }
        }
    }
}

__device__ __forceinline__ void phase_m2(const Params& p, char* lds, int bid, int nb) {
    const float* scg = (const float*)(p.ws + TAB_SCG); const float* scm = (const float*)(p.ws + TAB_SCM);
    unsigned* CT = (unsigned*)(p.ws + B_CT); float* NTv = (float*)(p.ws + TAB_NT); float* mt = (float*)(p.ws + TAB_MT);
    const int gid = bid * NT + TIDX, nth = nb * NT;
    for (int i = gid; i < 4 * 32768 + 1024; i += nth) {
        if (i < 4 * 32768) {
            const int h = i >> 15, idx = i & 32767;
            float m = 0.f, c0 = 0.f, c1 = 0.f;
            for (int sc = 0; sc < NSC; ++sc) {
                const float gg = scg[sc * 4 + h], ml = scm[sc * 4 + h], mn = fmaxf(gg + m, ml), dec = __expf(gg + m - mn), cor = __expf(ml - mn);
                unsigned* ptr = CT + (size_t)(sc * 4 + h) * 32768 + idx; const unsigned u = *ptr;
                c0 = dec * c0 + cor * bf2f(u & 0xffffu); c1 = dec * c1 + cor * bf2f(u >> 16);
                *ptr = pk2(c0, c1); m = mn;
            }
        } else {
            const int j = i - 4 * 32768, h = j >> 8, d = j & 255;
            float m = 0.f, n = 0.f;
            for (int sc = 0; sc < NSC; ++sc) {
                const float gg = scg[sc * 4 + h], ml = scm[sc * 4 + h], mn = fmaxf(gg + m, ml), dec = __expf(gg + m - mn), cor = __expf(ml - mn);
                float* ptr = NTv + (size_t)(sc * 4 + h) * 256 + d;
                n = dec * n + cor * *ptr; *ptr = n; m = mn;
                if (d == 0) mt[sc * 4 + h] = mn;
            }
        }
    }
}

__device__ __forceinline__ void phase_m3(const Params& p, int l, char* lds, int bid, int nb) {
    const int tid = TIDX, wid = tid >> 6, lane = tid & 63, c = lane & 15, g = lane >> 4, gw = bid * NW + wid, ngw = nb * NW;
    const bf16_t* QM = (const bf16_t*)(p.ws + B_QM); const bf16_t* KM = (const bf16_t*)(p.ws + B_KM); const bf16_t* VMT = (const bf16_t*)(p.ws + B_VMT);
    const bf16_t* CT = (const bf16_t*)(p.ws + B_CT); const float* NTv = (const float*)(p.ws + TAB_NT); const float* mt = (const float*)(p.ws + TAB_MT);
    const float* tb = (const float*)(p.ws + TAB_B); const float* te = (const float*)(p.ws + TAB_E); const float* tpm = (const float*)(p.ws + TAB_PM);
    const bf16_t* OP = (const bf16_t*)(p.ws + B_OP); bf16_t* YM = (bf16_t*)(p.ws + B_YM);
    constexpr int NRG = P / 16, RG0 = VALID0 / 16;
    const int ntask = (NRG - RG0) * 4;
    for (int t = gw; t < ntask; t += ngw) {
        const int rg = NRG - 1 - t / 4, h = t % 4, t0 = rg * 16, row = t0 + c, sc = t0 >> 8, s_start = sc << 8;
        bf16x8 qf[8];
#pragma unroll
        for (int ks = 0; ks < 8; ++ks) qf[ks] = ld8(QM + (size_t)row * D + h * 256 + 32 * ks + 8 * g);
        const float b_t = tb[(size_t)h * P + row], pm_t = tpm[(size_t)h * P + row];
        const float m_prev = sc > 0 ? mt[(sc - 1) * 4 + h] : 0.f;
        const float m_t = b_t + fmaxf(m_prev, pm_t), scale_t = __expf(b_t + m_prev - m_t);
        f32x4 acc[16];
#pragma unroll
        for (int i = 0; i < 16; ++i) acc[i] = (f32x4){0.f, 0.f, 0.f, 0.f};
        float den = 0.f;
        if (sc > 0) {
            const bf16_t* Cb = CT + (size_t)((sc - 1) * 4 + h) * 65536; const float* nv = NTv + (size_t)((sc - 1) * 4 + h) * 256;
#pragma unroll 2
            for (int ks = 0; ks < 8; ++ks) {
#pragma unroll
                for (int dt = 0; dt < 16; ++dt) acc[dt] = mfma16(ld8(Cb + (size_t)(16 * dt + c) * 256 + 32 * ks + 8 * g), qf[ks], acc[dt]);
                const f32x4 n0 = *(const f32x4*)(nv + 32 * ks + 8 * g), n1 = *(const f32x4*)(nv + 32 * ks + 8 * g + 4);
                const u32x4 qq = *(const u32x4*)&qf[ks];
                den += bf2f(qq.x & 0xffffu) * n0.x + bf2f(qq.x >> 16) * n0.y + bf2f(qq.y & 0xffffu) * n0.z + bf2f(qq.y >> 16) * n0.w
                     + bf2f(qq.z & 0xffffu) * n1.x + bf2f(qq.z >> 16) * n1.y + bf2f(qq.w & 0xffffu) * n1.z + bf2f(qq.w >> 16) * n1.w;
            }
            den *= scale_t;
#pragma unroll
            for (int dt = 0; dt < 16; ++dt) acc[dt] = acc[dt] * scale_t;
        }
        for (int kb = s_start; kb <= t0 + 15; kb += 32) {
            f32x4 s[2];
#pragma unroll
            for (int a = 0; a < 2; ++a) {
                s[a] = (f32x4){0.f, 0.f, 0.f, 0.f};
                const bf16_t* kr = KM + (size_t)(kb + 16 * a + c) * D + h * 256 + 8 * g;
#pragma unroll
                for (int ks = 0; ks < 8; ++ks) s[a] = mfma16(ld8(kr + 32 * ks), qf[ks], s[a]);
                const f32x4 ee = *(const f32x4*)(te + (size_t)h * P + kb + 16 * a + 4 * g);
#pragma unroll
                for (int r = 0; r < 4; ++r) { const int key = kb + 16 * a + 4 * g + r; const float arg = fminf(ee[r] + b_t - m_t, 0.f);
                    const float dd = key <= row ? __expf(arg) : 0.f; const float pv = s[a][r] * dd; s[a][r] = pv; den += pv; }
            }
            u32x4 w; w.x = pk2(s[0][0], s[0][1]); w.y = pk2(s[0][2], s[0][3]); w.z = pk2(s[1][0], s[1][1]); w.w = pk2(s[1][2], s[1][3]);
            const bf16x8 pf = *(bf16x8*)&w;
#pragma unroll
            for (int dt = 0; dt < 16; ++dt) {
                const bf16_t* vr = VMT + (size_t)(h * 256 + 16 * dt + c) * P + kb + 4 * g;
                const u32x2 v0 = *(const u32x2*)vr, v1 = *(const u32x2*)(vr + 16);
                u32x4 vv; vv.x = v0.x; vv.y = v0.y; vv.z = v1.x; vv.w = v1.y;
                acc[dt] = mfma16(*(bf16x8*)&vv, pf, acc[dt]);
            }
        }
        den += __shfl_xor(den, 16); den += __shfl_xor(den, 32);
        const float inv = 1.f / fmaxf(fabsf(den), __expf(-m_t));
        float s1 = 0.f;
#pragma unroll
        for (int dt = 0; dt < 16; ++dt) {
            const u32x2 og = *(const u32x2*)(OP + (size_t)row * D + h * 256 + 16 * dt + 4 * g);
            f32x4 v = acc[dt] * inv;
            v.x *= sigmoidf_(bf2f(og.x & 0xffffu)); v.y *= sigmoidf_(bf2f(og.x >> 16)); v.z *= sigmoidf_(bf2f(og.y & 0xffffu)); v.w *= sigmoidf_(bf2f(og.y >> 16));
            acc[dt] = v; s1 += (v.x + v.y) + (v.z + v.w);
        }
        s1 += __shfl_xor(s1, 16); s1 += __shfl_xor(s1, 32);
        const float mu = s1 * (1.f / 256.f);
        float s2 = 0.f;
#pragma unroll
        for (int dt = 0; dt < 16; ++dt) { acc[dt] = acc[dt] - mu; s2 += (acc[dt].x * acc[dt].x + acc[dt].y * acc[dt].y) + (acc[dt].z * acc[dt].z + acc[dt].w * acc[dt].w); }
        s2 += __shfl_xor(s2, 16); s2 += __shfl_xor(s2, 32);
        const float rstd = rsqrtf(s2 * (1.f / 256.f) + LN_EPS);
#pragma unroll
        for (int dt = 0; dt < 16; ++dt) { const f32x4 gg = *(const f32x4*)(p.in[I_MNG] + (size_t)l * D + h * 256 + 16 * dt + 4 * g);
            store4_bf16(YM + (size_t)row * D + h * 256 + 16 * dt + 4 * g, acc[dt] * rstd * gg); }
    }
}

struct EpiBr1 { float* MRG; const bf16_t* GA;
    __device__ __forceinline__ void operator()(int m, int n, f32x4 v) const { const u32x2 gg = *(const u32x2*)(GA + (size_t)m * D + n);
        f32x4 o; o.x = v.x * sigmoidf_(bf2f(gg.x & 0xffffu)); o.y = v.y * sigmoidf_(bf2f(gg.x >> 16)); o.z = v.z * sigmoidf_(bf2f(gg.y & 0xffffu)); o.w = v.w * sigmoidf_(bf2f(gg.y >> 16));
        *(f32x4*)(MRG + (size_t)m * D + n) = o; } };
struct EpiBr2 { const float* MRG; const bf16_t* GB; bf16_t* OUT;
    __device__ __forceinline__ void operator()(int m, int n, f32x4 v) const { const u32x2 gg = *(const u32x2*)(GB + (size_t)m * D + n); const f32x4 t = *(const f32x4*)(MRG + (size_t)m * D + n);
        f32x4 o; o.x = t.x + v.x * sigmoidf_(bf2f(gg.x & 0xffffu)); o.y = t.y + v.y * sigmoidf_(bf2f(gg.x >> 16)); o.z = t.z + v.z * sigmoidf_(bf2f(gg.y & 0xffffu)); o.w = t.w + v.w * sigmoidf_(bf2f(gg.y >> 16));
        store4_bf16(OUT + (size_t)m * D + n, o); } };
struct EpiOut { float* Z; const bf16_t* H;
    __device__ __forceinline__ void operator()(int m, int n, f32x4 v) const { const u32x2 hh = *(const u32x2*)(H + (size_t)m * D + n);
        f32x4 o; o.x = v.x + DN_ALPHA * bf2f(hh.x & 0xffffu); o.y = v.y + DN_ALPHA * bf2f(hh.x >> 16); o.z = v.z + DN_ALPHA * bf2f(hh.y & 0xffffu); o.w = v.w + DN_ALPHA * bf2f(hh.y >> 16);
        *(f32x4*)(Z + (size_t)m * D + n) = o; } };
__device__ __forceinline__ void phase_br1(const Params& p, char* lds, int bid, int nb) {
    for (int u = bid; u < 130 * 4; u += nb)
        sgemm_unit(RowsPlain{(const bf16_t*)(p.ws + B_YM), D}, RowsPlain{(const bf16_t*)(p.ws + W_BM_T), D}, D, (u >> 2) * 128, (u & 3) * 256, EpiBr1{(float*)(p.ws + B_MRG), (const bf16_t*)(p.ws + B_GA)});
}
__device__ __forceinline__ void phase_br2(const Params& p, char* lds, int bid, int nb) {
    for (int u = bid; u < 130 * 4; u += nb)
        sgemm_unit(RowsPlain{(const bf16_t*)(p.ws + B_YA), D}, RowsPlain{(const bf16_t*)(p.ws + W_BA_T), D}, D, (u >> 2) * 128, (u & 3) * 256,
                   EpiBr2{(const float*)(p.ws + B_MRG), (const bf16_t*)(p.ws + B_GB), (bf16_t*)(p.ws + B_MRGB)});
}
__device__ __forceinline__ void phase_out(const Params& p, char* lds, int bid, int nb) {
    for (int u = bid; u < 130 * 4; u += nb)
        sgemm_unit(RowsPlain{(const bf16_t*)(p.ws + B_MRGB), D}, RowsPlain{(const bf16_t*)(p.ws + W_OUT_T), D}, D, (u >> 2) * 128, (u & 3) * 256, EpiOut{(float*)(p.ws + B_Z), (const bf16_t*)(p.ws + B_H)});
}

struct SchedMqkvN { const char* XC; const char* WQ; const char* WK; int G, c; int K, lda, ldb;
    __device__ __forceinline__ bool next(int i, pg8::Unit& u) const { if (!pg8::decode_unit((long)i * G + c, 8, 64, 1, u)) return false; u.pm += 1; return true; }
    __device__ __forceinline__ const char* abase(const pg8::Unit& u) const { return XC + (size_t)(u.grp & 3) * 512 + (size_t)u.pm * 256 * D * 2; }
    __device__ __forceinline__ const char* bbase(const pg8::Unit& u) const { return ((u.grp >> 2) ? WK : WQ) + (size_t)(u.grp & 3) * 65536 * 2; } };
struct SchedMqkvT { const char* XC; const char* XM; const char* WK; const char* WV; int G, c; int K, lda, ldb;
    __device__ __forceinline__ bool next(int i, pg8::Unit& u) const { if (!pg8::decode_unit((long)i * G + c, 8, 1, 64, u)) return false; u.pn += 1; return true; }
    __device__ __forceinline__ const char* abase(const pg8::Unit& u) const { return ((u.grp >> 2) ? WV : WK) + (size_t)(u.grp & 3) * 65536 * 2; }
    __device__ __forceinline__ const char* bbase(const pg8::Unit& u) const { return ((u.grp >> 2) ? XM : XC) + (size_t)(u.grp & 3) * 512 + (size_t)u.pn * 256 * D * 2; } };
struct EpiGrpF { bf16_t* base0; bf16_t* base1; size_t hstride; size_t ldc; float s0, s1;
    __device__ __forceinline__ void operator()(const f32x4 (&acc)[2][2][4][2], const pg8::Unit& u, int wr, int wc, int fr, int fq) const {
        const int which = u.grp >> 2, h = u.grp & 3; const float sc = which ? s1 : s0;
        bf16_t* base = (which ? base1 : base0) + (size_t)h * hstride + (size_t)u.pn * 256;
        const size_t ld = ldc;
        pg8::for_each_piece(acc, u, wr, wc, fr, fq, [&](int row, int col, f32x4 v0, f32x4 v1) { *(u32x4*)(base + (size_t)row * ld + col) = pg8::pack8(v0 * sc, v1 * sc); }); } };
__device__ __forceinline__ void phase_mqkv_f(const Params& p, char* lds, int bid, int nb) {
    const int tid = TIDX, wid = tid >> 6, gw = bid * NW + wid, ngw = nb * NW;
    const bf16_t* XC = (const bf16_t*)(p.ws + B_XC); const bf16_t* XM = (const bf16_t*)(p.ws + B_XM);
    const bf16_t* WQ = (const bf16_t*)(p.ws + W_Q_T); const bf16_t* WK = (const bf16_t*)(p.ws + W_K_T); const bf16_t* WV = (const bf16_t*)(p.ws + W_V_T);
    bf16_t* QM = (bf16_t*)(p.ws + B_QM); bf16_t* KM = (bf16_t*)(p.ws + B_KM); bf16_t* KMT = (bf16_t*)(p.ws + B_KMT); bf16_t* VMT = (bf16_t*)(p.ws + B_VMT);
    zero_block(KM, D, VALID0, D, bid * NT + tid, nb * NT);
    zero_block(KMT, P, D, VALID0, bid * NT + tid, nb * NT);
    zero_block(VMT, P, D, VALID0, bid * NT + tid, nb * NT);
    for (int t = gw; t < 64; t += ngw) {
        const int which = (t >> 4) & 1, h = (t >> 2) & 3, q = t & 3;
        if (t < 32) sgemm_wave<1, 4>(RowsPlain{XC + h * 256, D}, RowsPlain{(which ? WK : WQ) + (size_t)h * 65536, 256}, 256, VALID0, q * 64, EpiStore{(which ? KM : QM) + h * 256, D, which ? 0.0625f : 1.f});
        else sgemm_wave<4, 1>(RowsPlain{(which ? WV : WK) + (size_t)h * 65536, 256}, RowsPlain{(which ? XM : XC) + h * 256, D}, 256, q * 64, VALID0, EpiStore{(which ? VMT : KMT) + (size_t)h * 256 * P, P, which ? 1.f : 0.0625f});
    }
    { SchedMqkvN S{(const char*)XC, (const char*)WQ, (const char*)WK, nb, bid, 256, D, 256};
      pg8::gemm_phase((PG8_LAS unsigned char*)lds, S, EpiGrpF{QM, KM, 256, D, 1.f, 0.0625f}); }
    { SchedMqkvT S{(const char*)XC, (const char*)XM, (const char*)WK, (const char*)WV, nb, bid, 256, 256, D};
      pg8::gemm_phase((PG8_LAS unsigned char*)lds, S, EpiGrpF{KMT, VMT, (size_t)256 * P, P, 0.0625f, 1.f}); }
}
struct SchedSq { const char* A; const char* B; int G, c; int K, lda, ldb;
    __device__ __forceinline__ bool next(int i, pg8::Unit& u) const { if (!pg8::decode_unit((long)i * G + c, 1, 64, 4, u)) return false; u.pm += 1; return true; }
    __device__ __forceinline__ const char* abase(const pg8::Unit& u) const { return A + (size_t)u.pm * 256 * D * 2; }
    __device__ __forceinline__ const char* bbase(const pg8::Unit& u) const { return B + (size_t)u.pn * 256 * D * 2; } };
__device__ __forceinline__ f32x4 sig4(f32x4 v) { f32x4 o; o.x = sigmoidf_(v.x); o.y = sigmoidf_(v.y); o.z = sigmoidf_(v.z); o.w = sigmoidf_(v.w); return o; }
struct EpiBr1F { float* MRG; const bf16_t* GA;
    __device__ __forceinline__ void operator()(const f32x4 (&acc)[2][2][4][2], const pg8::Unit& u, int wr, int wc, int fr, int fq) const {
        const int cb = u.pn * 256;
        pg8::for_each_piece(acc, u, wr, wc, fr, fq, [&](int row, int col, f32x4 v0, f32x4 v1) { const size_t idx = (size_t)row * D + cb + col;
            f32x4 g0, g1; pg8::unpack8(*(const u32x4*)(GA + idx), g0, g1);
            *(f32x4*)(MRG + idx) = v0 * sig4(g0); *(f32x4*)(MRG + idx + 4) = v1 * sig4(g1); }); } };
struct EpiBr2F { const float* MRG; const bf16_t* GB; bf16_t* OUT;
    __device__ __forceinline__ void operator()(const f32x4 (&acc)[2][2][4][2], const pg8::Unit& u, int wr, int wc, int fr, int fq) const {
        const int cb = u.pn * 256;
        pg8::for_each_piece(acc, u, wr, wc, fr, fq, [&](int row, int col, f32x4 v0, f32x4 v1) { const size_t idx = (size_t)row * D + cb + col;
            f32x4 g0, g1; pg8::unpack8(*(const u32x4*)(GB + idx), g0, g1);
            const f32x4 t0 = *(const f32x4*)(MRG + idx), t1 = *(const f32x4*)(MRG + idx + 4);
            *(u32x4*)(OUT + idx) = pg8::pack8(t0 + v0 * sig4(g0), t1 + v1 * sig4(g1)); }); } };
struct EpiOutF { float* Z; const bf16_t* H;
    __device__ __forceinline__ void operator()(const f32x4 (&acc)[2][2][4][2], const pg8::Unit& u, int wr, int wc, int fr, int fq) const {
        const int cb = u.pn * 256;
        pg8::for_each_piece(acc, u, wr, wc, fr, fq, [&](int row, int col, f32x4 v0, f32x4 v1) { const size_t idx = (size_t)row * D + cb + col;
            f32x4 h0, h1; pg8::unpack8(*(const u32x4*)(H + idx), h0, h1);
            *(f32x4*)(Z + idx) = v0 + h0 * DN_ALPHA; *(f32x4*)(Z + idx + 4) = v1 + h1 * DN_ALPHA; }); } };
__device__ __forceinline__ void phase_br1_f(const Params& p, char* lds, int bid, int nb) {
    const int gw = bid * NW + (TIDX >> 6), ngw = nb * NW;
    const bf16_t* A = (const bf16_t*)(p.ws + B_YM); const bf16_t* W = (const bf16_t*)(p.ws + W_BM_T);
    for (int t = gw; t < 16; t += ngw) sgemm_wave<1, 4>(RowsPlain{A, D}, RowsPlain{W, D}, D, VALID0, t * 64, EpiBr1{(float*)(p.ws + B_MRG), (const bf16_t*)(p.ws + B_GA)});
    SchedSq S{(const char*)A, (const char*)W, nb, bid, D, D, D};
    pg8::gemm_phase((PG8_LAS unsigned char*)lds, S, EpiBr1F{(float*)(p.ws + B_MRG), (const bf16_t*)(p.ws + B_GA)});
}
__device__ __forceinline__ void phase_br2_f(const Params& p, char* lds, int bid, int nb) {
    const int gw = bid * NW + (TIDX >> 6), ngw = nb * NW;
    const bf16_t* A = (const bf16_t*)(p.ws + B_YA); const bf16_t* W = (const bf16_t*)(p.ws + W_BA_T);
    for (int t = gw; t < 16; t += ngw) sgemm_wave<1, 4>(RowsPlain{A, D}, RowsPlain{W, D}, D, VALID0, t * 64, EpiBr2{(const float*)(p.ws + B_MRG), (const bf16_t*)(p.ws + B_GB), (bf16_t*)(p.ws + B_MRGB)});
    SchedSq S{(const char*)A, (const char*)W, nb, bid, D, D, D};
    pg8::gemm_phase((PG8_LAS unsigned char*)lds, S, EpiBr2F{(const float*)(p.ws + B_MRG), (const bf16_t*)(p.ws + B_GB), (bf16_t*)(p.ws + B_MRGB)});
}
__device__ __forceinline__ void phase_out_f(const Params& p, char* lds, int bid, int nb) {
    const int gw = bid * NW + (TIDX >> 6), ngw = nb * NW;
    const bf16_t* A = (const bf16_t*)(p.ws + B_MRGB); const bf16_t* W = (const bf16_t*)(p.ws + W_OUT_T);
    for (int t = gw; t < 16; t += ngw) sgemm_wave<1, 4>(RowsPlain{A, D}, RowsPlain{W, D}, D, VALID0, t * 64, EpiOut{(float*)(p.ws + B_Z), (const bf16_t*)(p.ws + B_H)});
    SchedSq S{(const char*)A, (const char*)W, nb, bid, D, D, D};
    pg8::gemm_phase((PG8_LAS unsigned char*)lds, S, EpiOutF{(float*)(p.ws + B_Z), (const bf16_t*)(p.ws + B_H)});
}

__device__ __forceinline__ void phase_ln1(const Params& p, int l, char* lds, int bid, int nb) {
    const int tid = TIDX, wid = tid >> 6, lane = tid & 63, gw = bid * NW + wid, ngw = nb * NW;
    float* wr = (float*)lds;
    for (int i = tid; i < D * 16 / 4; i += NT) ((f32x4*)wr)[i] = ((const f32x4*)p.in[I_WR])[i];
    __syncthreads();
    const float* Z = (const float*)(p.ws + B_Z); bf16_t* H1 = (bf16_t*)(p.ws + B_H1);
    unsigned* cnt = (unsigned*)(p.ws + WS_CTL) + CW_CNT + l * 16; int* elist = (int*)(p.ws + TAB_ELIST); float* topk = (float*)(p.ws + TAB_TOPK);
    for (int r = gw; r < P; r += ngw) {
        if (r < VALID0) { store_row_zero(H1 + (size_t)r * D, lane); continue; }
        f32x4 v[4];
#pragma unroll
        for (int j = 0; j < 4; ++j) v[j] = *(const f32x4*)(Z + (size_t)r * D + 4 * lane + 256 * j);
        ln_normalize(v, p.in[I_LN1G] + (size_t)l * D, p.in[I_LN1B] + (size_t)l * D, lane);
        store_row_bf16(H1 + (size_t)r * D, v, lane);
        float lg[16];
#pragma unroll
        for (int e = 0; e < 16; ++e) lg[e] = 0.f;
#pragma unroll
        for (int j = 0; j < 4; ++j)
#pragma unroll
            for (int i = 0; i < 4; ++i) { const int k = 4 * lane + 256 * j + i; const float x = v[j][i];
#pragma unroll
                for (int q = 0; q < 4; ++q) { const f32x4 w = *(const f32x4*)(wr + k * 16 + 4 * q); lg[4 * q] += x * w.x; lg[4 * q + 1] += x * w.y; lg[4 * q + 2] += x * w.z; lg[4 * q + 3] += x * w.w; } }
#pragma unroll
        for (int e = 0; e < 16; ++e) lg[e] = wave_sum(lg[e]);
        if (lane == 0) {
            float mx = lg[0];
#pragma unroll
            for (int e = 1; e < 16; ++e) mx = fmaxf(mx, lg[e]);
            float pr[16], sum = 0.f;
#pragma unroll
            for (int e = 0; e < 16; ++e) { pr[e] = expf(lg[e] - mx); sum += pr[e]; }
            const float isum = 1.f / sum;
            float sel[16];
#pragma unroll
            for (int e = 0; e < 16; ++e) { pr[e] *= isum; sel[e] = pr[e] + p.in[I_RB][e]; }
            int tg = 0; float best = -INFINITY;
#pragma unroll
            for (int gI = 0; gI < 4; ++gI) { const float gs = fmaxf(fmaxf(sel[4 * gI], sel[4 * gI + 1]), fmaxf(sel[4 * gI + 2], sel[4 * gI + 3])); if (gs > best) { best = gs; tg = gI; } }
            int i0 = 0; float b0 = -INFINITY;
#pragma unroll
            for (int e = 0; e < 16; ++e) if ((e >> 2) == tg && sel[e] > b0) { b0 = sel[e]; i0 = e; }
            int i1 = 0; float b1 = -INFINITY;
#pragma unroll
            for (int e = 0; e < 16; ++e) if ((e >> 2) == tg && e != i0 && sel[e] > b1) { b1 = sel[e]; i1 = e; }
            float p0 = 0.f, p1 = 0.f;
#pragma unroll
            for (int e = 0; e < 16; ++e) { if (e == i0) p0 = pr[e]; if (e == i1) p1 = pr[e]; }
            const float inv = 1.f / (p0 + p1);
            const unsigned pos0 = atomicAdd(cnt + i0, 1u), pos1 = atomicAdd(cnt + i1, 1u);
            elist[(size_t)i0 * P + pos0] = r; elist[(size_t)i1 * P + pos1] = r;
            float* tk = topk + (size_t)r * 8;
            ((int*)tk)[0] = i0; ((int*)tk)[1] = i1; ((int*)tk)[2] = (int)pos0; ((int*)tk)[3] = (int)pos1; tk[4] = p0 * inv; tk[5] = p1 * inv;
        }
    }
}

__device__ __forceinline__ void expert_offsets(const unsigned* cnt, int* s_cnt, int* s_off, int* s_tiles) {
    int off = 0;
    if (TIDX == 0) { int tt = 0; for (int e = 0; e < 16; ++e) { const int c = (int)cnt[e]; const int tl = (c + 255) >> 8; s_cnt[e] = c; s_off[e] = off; s_tiles[e] = tt; off += tl * 256; tt += tl; } s_tiles[16] = tt; }
    __syncthreads();
}
__device__ __forceinline__ void phase_e1(const Params& p, int l, char* lds, int bid, int nb) {
    int* s_cnt = (int*)lds; int* s_off = s_cnt + 16; int* s_tiles = s_off + 16;
    expert_offsets((const unsigned*)(p.ws + WS_CTL) + CW_CNT + l * 16, s_cnt, s_off, s_tiles);
    const int tid = TIDX, wid = tid >> 6, lane = tid & 63, c = lane & 15, g = lane >> 4, wr = wid >> 2, wc = wid & 3;
    const bf16_t* H1 = (const bf16_t*)(p.ws + B_H1); const int* elist = (const int*)(p.ws + TAB_ELIST); bf16_t* HID = (bf16_t*)(p.ws + B_HID);
    const int total = s_tiles[16] * 8;
    for (int u = bid; u < total; u += nb) {
        const int rt = u >> 3, ct = u & 7; int e = 0;
        while (e < 15 && rt >= s_tiles[e + 1]) ++e;
        const int ti = rt - s_tiles[e], cntE = s_cnt[e], r0 = ti * 128 + 64 * wr, n0 = ct * 128 + 32 * wc;
        const bf16_t* Wg = (const bf16_t*)(p.ws + W_G_T) + (size_t)e * D * D; const bf16_t* Wu = (const bf16_t*)(p.ws + W_U_T) + (size_t)e * D * D;
        const bf16_t* ap[4];
#pragma unroll
        for (int i = 0; i < 4; ++i) { const int rr = r0 + 16 * i + c; const int tok = elist[(size_t)e * P + (rr < cntE ? rr : 0)]; ap[i] = H1 + (size_t)tok * D + 8 * g; }
        const bf16_t* gp[2]; const bf16_t* up[2];
#pragma unroll
        for (int j = 0; j < 2; ++j) { gp[j] = Wg + (size_t)(n0 + 16 * j + c) * D + 8 * g; up[j] = Wu + (size_t)(n0 + 16 * j + c) * D + 8 * g; }
        f32x4 ag[4][2], au[4][2];
#pragma unroll
        for (int i = 0; i < 4; ++i)
#pragma unroll
            for (int j = 0; j < 2; ++j) { ag[i][j] = (f32x4){0.f, 0.f, 0.f, 0.f}; au[i][j] = (f32x4){0.f, 0.f, 0.f, 0.f}; }
        for (int k0 = 0; k0 < D; k0 += 32) {
            bf16x8 a[4], bg[2], bu[2];
#pragma unroll
            for (int i = 0; i < 4; ++i) a[i] = ld8(ap[i] + k0);
#pragma unroll
            for (int j = 0; j < 2; ++j) { bg[j] = ld8(gp[j] + k0); bu[j] = ld8(up[j] + k0); }
#pragma unroll
            for (int i = 0; i < 4; ++i)
#pragma unroll
                for (int j = 0; j < 2; ++j) { ag[i][j] = mfma16(bg[j], a[i], ag[i][j]); au[i][j] = mfma16(bu[j], a[i], au[i][j]); }
        }
#pragma unroll
        for (int i = 0; i < 4; ++i)
#pragma unroll
            for (int j = 0; j < 2; ++j) { f32x4 o;
#pragma unroll
                for (int r = 0; r < 4; ++r) o[r] = siluf_(ag[i][j][r]) * au[i][j][r];
                store4_bf16(HID + (size_t)(s_off[e] + r0 + 16 * i + c) * D + n0 + 16 * j + 4 * g, o); }
    }
}
__device__ __forceinline__ void phase_e2(const Params& p, int l, char* lds, int bid, int nb) {
    int* s_cnt = (int*)lds; int* s_off = s_cnt + 16; int* s_tiles = s_off + 16;
    expert_offsets((const unsigned*)(p.ws + WS_CTL) + CW_CNT + l * 16, s_cnt, s_off, s_tiles);
    const bf16_t* HID = (const bf16_t*)(p.ws + B_HID); bf16_t* YB = (bf16_t*)(p.ws + B_YB);
    const int total = s_tiles[16] * 4;
    for (int u = bid; u < total; u += nb) {
        const int rt = u >> 2, ct = u & 3; int e = 0;
        while (e < 15 && rt >= s_tiles[e + 1]) ++e;
        const int ti = rt - s_tiles[e];
        sgemm_unit(RowsPlain{HID + (size_t)s_off[e] * D, D}, RowsPlain{(const bf16_t*)(p.ws + W_D_T) + (size_t)e * D * D, D}, D, ti * 128, ct * 256, EpiStore{YB + (size_t)s_off[e] * D, D, 1.f});
    }
}
constexpr int LDS_TAB_OFF = 131072;
__device__ __forceinline__ void phase_perm(const Params& p, int l, char* lds, int bid, int nb) {
    int* s_cnt = (int*)(lds + LDS_TAB_OFF); int* s_off = s_cnt + 16; int* s_tiles = s_off + 16;
    expert_offsets((const unsigned*)(p.ws + WS_CTL) + CW_CNT + l * 16, s_cnt, s_off, s_tiles);
    const int tid = TIDX, wid = tid >> 6, lane = tid & 63, gw = bid * NW + wid, ngw = nb * NW;
    const bf16_t* H1 = (const bf16_t*)(p.ws + B_H1); bf16_t* XP = (bf16_t*)(p.ws + B_XP); const float* topk = (const float*)(p.ws + TAB_TOPK);
    for (int r = VALID0 + gw; r < P; r += ngw) {
        const int* tk = (const int*)(topk + (size_t)r * 8);
        const int e0 = tk[0], e1 = tk[1], p0 = tk[2], p1 = tk[3];
        const u32x4* src = (const u32x4*)(H1 + (size_t)r * D) + lane * 2;
        const u32x4 a = src[0], b = src[1];
        u32x4* d0 = (u32x4*)(XP + (size_t)(s_off[e0] + p0) * D) + lane * 2; u32x4* d1 = (u32x4*)(XP + (size_t)(s_off[e1] + p1) * D) + lane * 2;
        d0[0] = a; d0[1] = b; d1[0] = a; d1[1] = b;
    }
}
struct SchedMoE { const char* A; const char* B; size_t estride; int nN; const int* s_off; const int* s_tiles; int G, c; int K, lda, ldb;
    __device__ __forceinline__ bool next(int i, pg8::Unit& u) const {
        const int nwg = s_tiles[16] * nN; const long L = (long)i * G + c; if (L >= nwg) return false;
        int wgid = (int)L; { const int q = nwg / 8, r = nwg % 8, xcd = wgid % 8, off = wgid / 8; wgid = (xcd < r ? xcd * (q + 1) : r * (q + 1) + (xcd - r) * q) + off; }
        const int rt = wgid / nN; int e = 0;
        while (e < 15 && rt >= s_tiles[e + 1]) ++e;
        u.grp = __builtin_amdgcn_readfirstlane(e); u.pm = __builtin_amdgcn_readfirstlane((s_off[e] >> 8) + rt - s_tiles[e]); u.pn = __builtin_amdgcn_readfirstlane(wgid % nN); return true; }
    __device__ __forceinline__ const char* abase(const pg8::Unit& u) const { return A + (size_t)u.pm * 256 * D * 2; }
    __device__ __forceinline__ const char* bbase(const pg8::Unit& u) const { return B + (size_t)u.grp * estride + (size_t)u.pn * 256 * D * 2; } };
struct EpiE1F { bf16_t* HID;
    __device__ __forceinline__ void operator()(const f32x4 (&acc)[2][2][4][2], const pg8::Unit& u, int wr, int wc, int fr, int fq) const {
        const int row0 = u.pm * 256 + wr * 64 + fr, col0 = u.pn * 128 + wc * 32 + 8 * fq;
#pragma unroll
        for (int ai = 0; ai < 2; ++ai)
#pragma unroll
            for (int m = 0; m < 4; ++m) { f32x4 h0, h1;
#pragma unroll
                for (int r = 0; r < 4; ++r) { h0[r] = siluf_(acc[ai][0][m][0][r]) * acc[ai][1][m][0][r]; h1[r] = siluf_(acc[ai][0][m][1][r]) * acc[ai][1][m][1][r]; }
                *(u32x4*)(HID + (size_t)(row0 + ai * 128 + m * 16) * D + col0) = pg8::pack8(h0, h1); } } };
struct EpiE2F { bf16_t* YB;
    __device__ __forceinline__ void operator()(const f32x4 (&acc)[2][2][4][2], const pg8::Unit& u, int wr, int wc, int fr, int fq) const {
        bf16_t* base = YB + u.pn * 256;
        pg8::for_each_piece(acc, u, wr, wc, fr, fq, [&](int row, int col, f32x4 v0, f32x4 v1) { *(u32x4*)(base + (size_t)row * D + col) = pg8::pack8(v0, v1); }); } };
__device__ __forceinline__ void phase_e1_f(const Params& p, int l, char* lds, int bid, int nb) {
    int* s_cnt = (int*)(lds + LDS_TAB_OFF); int* s_off = s_cnt + 16; int* s_tiles = s_off + 16;
    expert_offsets((const unsigned*)(p.ws + WS_CTL) + CW_CNT + l * 16, s_cnt, s_off, s_tiles);
    SchedMoE S{(const char*)(p.ws + B_XP), (const char*)(p.ws + W_G_T), (size_t)2048 * D * 2, 8, s_off, s_tiles, nb, bid, D, D, D};
    pg8::gemm_phase((PG8_LAS unsigned char*)lds, S, EpiE1F{(bf16_t*)(p.ws + B_HID)});
}
__device__ __forceinline__ void phase_e2_f(const Params& p, int l, char* lds, int bid, int nb) {
    int* s_cnt = (int*)(lds + LDS_TAB_OFF); int* s_off = s_cnt + 16; int* s_tiles = s_off + 16;
    expert_offsets((const unsigned*)(p.ws + WS_CTL) + CW_CNT + l * 16, s_cnt, s_off, s_tiles);
    SchedMoE S{(const char*)(p.ws + B_HID), (const char*)(p.ws + W_D_T), (size_t)D * D * 2, 4, s_off, s_tiles, nb, bid, D, D, D};
    pg8::gemm_phase((PG8_LAS unsigned char*)lds, S, EpiE2F{(bf16_t*)(p.ws + B_YB)});
}

__device__ __forceinline__ void phase_combine(const Params& p, int l, char* lds, int bid, int nb) {
    const int tid = TIDX, wid = tid >> 6, lane = tid & 63, gw = bid * NW + wid, ngw = nb * NW;
    const bool last = (l == DEPTH - 1);
    if (!last) { convert_weights(p, l + 1, lds, gw, ngw, wid, lane); __syncthreads(); }
    int* s_cnt = (int*)(lds + 65536); int* s_off = s_cnt + 16; int* s_tiles = s_off + 16;
    expert_offsets((const unsigned*)(p.ws + WS_CTL) + CW_CNT + l * 16, s_cnt, s_off, s_tiles);
    float* g8 = (float*)lds;
    if (!last) load_gate_w(p, l + 1, g8);
    const bf16_t* H1 = (const bf16_t*)(p.ws + B_H1); const bf16_t* YB = (const bf16_t*)(p.ws + B_YB); bf16_t* H = (bf16_t*)(p.ws + B_H);
    const float* topk = (const float*)(p.ws + TAB_TOPK);
    for (int r = gw; r < P; r += ngw) {
        if (r < VALID0) { if (!last) { store_row_zero(H + (size_t)r * D, lane); gates_row_pad(p, r, lane); } continue; }
        if (last && r < 256) continue;
        const float* tk = topk + (size_t)r * 8;
        const int e0 = ((const int*)tk)[0], e1 = ((const int*)tk)[1], p0 = ((const int*)tk)[2], p1 = ((const int*)tk)[3]; const float w0 = tk[4], w1 = tk[5];
        const bf16_t* y0 = YB + (size_t)(s_off[e0] + p0) * D; const bf16_t* y1 = YB + (size_t)(s_off[e1] + p1) * D; const bf16_t* hr = H1 + (size_t)r * D;
        f32x4 v[4];
#pragma unroll
        for (int j = 0; j < 4; ++j) { const int cc = 4 * lane + 256 * j; const u32x2 a = *(const u32x2*)(y0 + cc), b = *(const u32x2*)(y1 + cc), hh = *(const u32x2*)(hr + cc);
            v[j].x = DN_ALPHA * bf2f(hh.x & 0xffffu) + w0 * bf2f(a.x & 0xffffu) + w1 * bf2f(b.x & 0xffffu);
            v[j].y = DN_ALPHA * bf2f(hh.x >> 16) + w0 * bf2f(a.x >> 16) + w1 * bf2f(b.x >> 16);
            v[j].z = DN_ALPHA * bf2f(hh.y & 0xffffu) + w0 * bf2f(a.y & 0xffffu) + w1 * bf2f(b.y & 0xffffu);
            v[j].w = DN_ALPHA * bf2f(hh.y >> 16) + w0 * bf2f(a.y >> 16) + w1 * bf2f(b.y >> 16); }
        ln_normalize(v, p.in[I_LN2G] + (size_t)l * D, p.in[I_LN2B] + (size_t)l * D, lane);
        if (last) {
            float* o = p.out + (size_t)(r - 256) * D;
#pragma unroll
            for (int j = 0; j < 4; ++j) *(f32x4*)(o + 4 * lane + 256 * j) = v[j];
        } else { store_row_bf16(H + (size_t)r * D, v, lane); gates_row(p, l + 1, g8, v, r, lane); }
    }
}

#define XB_TMO      128
#define XB_XCNT(j)  (256  + 64 * (j))
#define XB_XSUB(j)  (1280 + 64 * (j))
#define XB_XGEN(j)  (2304 + 64 * (j))
#define XB_TOP      3328
#define XB_TOPGEN   3392
#define XCD_BAR_WORDS 3456
#define XB_SPIN_CAP (1u << 18)
#define LAS __attribute__((address_space(3)))

__device__ __forceinline__ unsigned xb_ld(unsigned* p)              { return __hip_atomic_load(p, __ATOMIC_RELAXED, __HIP_MEMORY_SCOPE_AGENT); }
__device__ __forceinline__ unsigned xb_add(unsigned* p, unsigned v) { return __hip_atomic_fetch_add(p, v, __ATOMIC_RELAXED, __HIP_MEMORY_SCOPE_AGENT); }
__device__ __forceinline__ unsigned xb_xcc_id() { return (unsigned)__builtin_amdgcn_s_getreg((3 << 11) | 20) & 0xFu; }
#define XB_SPIN(cond, bar) do { unsigned _sp = 0; while (cond) { __builtin_amdgcn_s_sleep(1); \
    if ((++_sp & 255u) == 0u) { if (xb_ld(&(bar)[XB_TMO])) break; if (_sp > XB_SPIN_CAP) { atomicAdd(&(bar)[XB_TMO], 1u); break; } } } } while (0)

struct XcdBarrier {
    unsigned* bar; unsigned x;
    volatile LAS unsigned* st;
};
__device__ __forceinline__ XcdBarrier xcd_barrier_post(unsigned* bar, volatile LAS unsigned* st) {
    XcdBarrier b; b.bar = bar; b.x = xb_xcc_id(); b.st = st;
    if (threadIdx.x == 0) (void)xb_add(&bar[XB_XCNT(b.x)], 1u);
    return b;
}
__device__ __forceinline__ void xcd_barrier_complete(unsigned* bar, unsigned x, unsigned& nloc, unsigned& nx) {
    const unsigned G = gridDim.x * gridDim.y * gridDim.z;
    unsigned sum, cnt, mine, sp = 0u;
    for (;;) {
        sum = 0u; cnt = 0u; mine = 0u;
#pragma unroll
        for (unsigned j = 0; j < 16; ++j) { const unsigned c = xb_ld(&bar[XB_XCNT(j)]); sum += c; cnt += (c > 0u) ? 1u : 0u; mine = (j == x) ? c : mine; }
        if (sum == G) break;
        __builtin_amdgcn_s_sleep(1);
        if ((++sp & 255u) == 0u) { if (xb_ld(&bar[XB_TMO])) break; if (sp > XB_SPIN_CAP) { atomicAdd(&bar[XB_TMO], 1u); break; } }
    }
    nloc = mine > 0u ? mine : 1u; nx = cnt > 0u ? cnt : 1u;
}
__device__ __forceinline__ void xcd_barrier(const XcdBarrier& b) {
    asm volatile("s_waitcnt vmcnt(0)" ::: "memory");
    __syncthreads();
    if (threadIdx.x == 0) {
        unsigned* bar = b.bar;
        __builtin_amdgcn_s_waitcnt(0);
        unsigned nloc = b.st[0], nx = b.st[1];
        if (nloc == 0u) { xcd_barrier_complete(bar, b.x, nloc, nx); b.st[0] = nloc; b.st[1] = nx; }
        const unsigned old = xb_add(&bar[XB_XSUB(b.x)], 1u);
        const unsigned gen = old / nloc;
        if (old + 1u == (gen + 1u) * nloc) {
            __builtin_amdgcn_fence(__ATOMIC_RELEASE, "agent");
            asm volatile("s_waitcnt vmcnt(0)" ::: "memory");
            const unsigned og = xb_add(&bar[XB_TOP], 1u);
            const unsigned tg = og / nx;
            if (og + 1u == (tg + 1u) * nx) xb_add(&bar[XB_TOPGEN], 1u);
            else XB_SPIN(xb_ld(&bar[XB_TOPGEN]) == tg, bar);
            __builtin_amdgcn_fence(__ATOMIC_ACQUIRE, "agent");
            xb_add(&bar[XB_XGEN(b.x)], 1u);
            asm volatile("s_waitcnt vmcnt(0)" ::: "memory");
        } else {
            XB_SPIN(xb_ld(&bar[XB_XGEN(b.x)]) == gen, bar);
            __builtin_amdgcn_fence(__ATOMIC_ACQUIRE, "agent");
            asm volatile("s_waitcnt vmcnt(0)" ::: "memory");
        }
    }
    __syncthreads();
}

constexpr int LDS_BYTES = 131072 + 1024;
constexpr int LDS_BAR_OFF = LDS_BYTES - 16;
constexpr int CW_BAR = 4096;
template <int L>
__device__ __forceinline__ void layer_body(const Params& p, char* lds, int bid, int nb, const XcdBarrier& bar) {
    phase_proj_f(p, lds, bid, nb); xcd_barrier(bar);
    phase_attn_f(p, L, lds, bid, nb); xcd_barrier(bar);
    phase_conv(p, L, lds, bid, nb); xcd_barrier(bar);
    phase_mqkv_f(p, lds, bid, nb); xcd_barrier(bar);
    phase_m1(p, lds, bid, nb); xcd_barrier(bar);
    phase_m2(p, lds, bid, nb); xcd_barrier(bar);
    phase_m3(p, L, lds, bid, nb); xcd_barrier(bar);
    phase_br1_f(p, lds, bid, nb); xcd_barrier(bar);
    phase_br2_f(p, lds, bid, nb); xcd_barrier(bar);
    phase_out_f(p, lds, bid, nb); xcd_barrier(bar);
    phase_ln1(p, L, lds, bid, nb); xcd_barrier(bar);
    phase_perm(p, L, lds, bid, nb); xcd_barrier(bar);
    phase_e1_f(p, L, lds, bid, nb); xcd_barrier(bar);
    phase_e2_f(p, L, lds, bid, nb); xcd_barrier(bar);
    phase_combine(p, L, lds, bid, nb); if (L + 1 < DEPTH) xcd_barrier(bar);
}
__global__ void __launch_bounds__(NT, 2) fwd_kernel(Params p) {
    extern __shared__ __attribute__((aligned(16))) char lds[];
    const int bid = blockIdx.x, nb = gridDim.x;
    if (threadIdx.x == 0) *(uint4*)(lds + LDS_BAR_OFF) = make_uint4(0u, 0u, 0u, 0u);
    __syncthreads();
    XcdBarrier bar = xcd_barrier_post((unsigned*)(p.ws + WS_CTL) + CW_BAR, (volatile LAS unsigned*)(lds + LDS_BAR_OFF));
    phase_prologue(p, lds, bid, nb); xcd_barrier(bar);
    layer_body<0>(p, lds, bid, nb, bar);
    layer_body<1>(p, lds, bid, nb, bar);
}

extern "C" void kernel_launch(void* const* d_in, const int* in_sizes, int n_in, void* d_out, int out_size, void* d_ws, size_t ws_size, hipStream_t stream) {
    if (n_in != 30 || ws_size < WS_END) { fprintf(stderr, "kernel_launch: unexpected n_in %d or ws_size %zu (< %zu)\n", n_in, ws_size, (size_t)WS_END); return; }
    static int grid = 0;
    if (grid == 0) {
        int dev = 0, cus = 0;
        if (hipGetDevice(&dev) != hipSuccess || hipDeviceGetAttribute(&cus, hipDeviceAttributeMultiprocessorCount, dev) != hipSuccess || cus <= 0) cus = 256;
        (void)hipFuncSetAttribute((const void*)fwd_kernel, hipFuncAttributeMaxDynamicSharedMemorySize, LDS_BYTES);
        grid = cus;
    }
    Params p{};
    for (int i = 0; i < 30; ++i) p.in[i] = (const float*)d_in[i];
    p.out = (float*)d_out; p.ws = (unsigned char*)d_ws;
    (void)hipMemsetAsync((char*)d_ws + WS_CTL, 0, CTL_BYTES, stream);
    hipLaunchKernelGGL(fwd_kernel, dim3(grid), dim3(NT), LDS_BYTES, stream, p);
}
```

```cpp
#include <hip/hip_runtime.h>
#include <cstdio>
#include <cstdint>

constexpr int D = 1024;
constexpr int SEQ = 16384;
constexpr int NMETA = 16;
constexpr int P = 16640;
constexpr int VALID0 = 240;
constexpr int DEPTH = 2;
constexpr int DIN = 7176;
constexpr int NSC = 65;
constexpr int NEXP = 16;
constexpr float LN_EPS = 1e-5f;
constexpr float DN_ALPHA = 1.4142135623730951f;
constexpr float NEGBIG = -1e30f;
constexpr int NT = 512;
constexpr int NW = 8;

typedef unsigned short bf16_t;
typedef short bf16x8 __attribute__((ext_vector_type(8)));
typedef float f32x4 __attribute__((ext_vector_type(4)));
typedef unsigned u32x4 __attribute__((ext_vector_type(4)));
typedef unsigned u32x2 __attribute__((ext_vector_type(2)));

constexpr size_t MiB = 1u << 20;
constexpr size_t RB = (size_t)P * D * 2;
constexpr size_t WS_CTL = 0;
constexpr size_t CTL_BYTES = 1 * MiB;
constexpr size_t WS_TAB = 1 * MiB;
constexpr size_t TAB_GLI = WS_TAB;
constexpr size_t TAB_GLF = TAB_GLI + 4 * P * 4;
constexpr size_t TAB_B   = TAB_GLF + 4 * P * 4;
constexpr size_t TAB_E   = TAB_B + 4 * P * 4;
constexpr size_t TAB_PM  = TAB_E + 4 * P * 4;
constexpr size_t TAB_W   = TAB_PM + 4 * P * 4;
constexpr size_t TAB_SCG = TAB_W + 4 * P * 4;
constexpr size_t TAB_SCM = TAB_SCG + 4096;
constexpr size_t TAB_MT  = TAB_SCM + 4096;
constexpr size_t TAB_NT  = TAB_MT + 4096;
constexpr size_t TAB_TOPK = TAB_NT + (size_t)NSC * 4 * 256 * 4;
constexpr size_t TAB_ELIST = TAB_TOPK + (size_t)P * 32;
constexpr size_t TAB_END = TAB_ELIST + (size_t)NEXP * P * 4;
static_assert(TAB_END <= 8 * MiB, "tables");
constexpr size_t WS_W = 8 * MiB;
constexpr size_t W_IN_T = WS_W;
constexpr size_t W_Q_T = W_IN_T + (size_t)7168 * 1024 * 2;
constexpr size_t W_K_T = W_Q_T + 4 * 65536 * 2;
constexpr size_t W_V_T = W_K_T + 4 * 65536 * 2;
constexpr size_t W_BM_T = W_V_T + 4 * 65536 * 2;
constexpr size_t W_BA_T = W_BM_T + (size_t)D * D * 2;
constexpr size_t W_OUT_T = W_BA_T + (size_t)D * D * 2;
constexpr size_t W_G_T = W_OUT_T + (size_t)D * D * 2;
constexpr size_t W_U_T = W_G_T + (size_t)NEXP * D * D * 2;
constexpr size_t W_D_T = W_U_T + (size_t)NEXP * D * D * 2;
constexpr size_t W_END = W_D_T + (size_t)NEXP * D * D * 2;
static_assert(W_END <= 128 * MiB, "weights");
constexpr size_t WS_SLOT = 128 * MiB;
constexpr size_t SLOT(int i) { return WS_SLOT + (size_t)i * RB; }
constexpr size_t WS_END = WS_SLOT + 11 * RB;
constexpr size_t B_H = SLOT(0);
constexpr size_t B_XM = SLOT(1), B_YM = SLOT(1);
constexpr size_t B_OP = SLOT(2), B_MRGB = SLOT(2);
constexpr size_t B_QA = SLOT(3), B_QM = SLOT(3);
constexpr size_t B_KA = SLOT(4), B_XC = SLOT(4), B_CT = SLOT(4);
constexpr size_t B_VAT = SLOT(5), B_KM = SLOT(5), B_H1 = SLOT(5);
constexpr size_t B_GA = SLOT(6);
constexpr size_t B_GB = SLOT(7);
constexpr size_t B_YA = SLOT(8);
constexpr size_t B_KMT = SLOT(9), B_MRG = SLOT(9);
constexpr size_t B_VMT = SLOT(10), B_VA = SLOT(10);
constexpr size_t B_Z = SLOT(3);
constexpr size_t B_HID = SLOT(6);
constexpr size_t B_YB = SLOT(1), B_XP = SLOT(1);
constexpr int HID_ROWS_MAX = (int)(3 * RB / (D * 2));
constexpr int CW_CNT = 64;

struct Params {
    const float* in[30];
    float* out;
    unsigned char* ws;
};
enum { I_X = 0, I_META, I_LNG, I_LNB, I_WIN, I_CONVW, I_CONVB, I_WQM, I_WKM, I_WVM, I_BI, I_BF, I_MNG, I_LQ1, I_LK1, I_LQ2, I_LK2, I_ANG,
       I_WBM, I_WBA, I_WOUT, I_LN1G, I_LN1B, I_LN2G, I_LN2B, I_WR, I_RB, I_WG, I_WU, I_WD };

__device__ __forceinline__ int tid_opaque() { int t = threadIdx.x; asm volatile("" : "+v"(t)); return t; }
#define TIDX tid_opaque()
__device__ __forceinline__ float bf2f(unsigned v) { return __uint_as_float(v << 16); }
__device__ __forceinline__ unsigned f2bf(float f) { unsigned u = __float_as_uint(f); return (u + 0x7fffu + ((u >> 16) & 1u)) >> 16; }
__device__ __forceinline__ unsigned pk2(float lo, float hi) { return f2bf(lo) | (f2bf(hi) << 16); }
__device__ __forceinline__ float wave_sum(float v) {
#pragma unroll
    for (int o = 1; o < 64; o <<= 1) v += __shfl_xor(v, o);
    return v;
}
__device__ __forceinline__ float sigmoidf_(float x) { return 1.f / (1.f + __expf(-x)); }
__device__ __forceinline__ float siluf_(float x) { return x / (1.f + __expf(-x)); }
__device__ __forceinline__ float logsigmoidf_(float x) { return x >= 0.f ? -log1pf(__expf(-x)) : x - log1pf(__expf(x)); }
__device__ __forceinline__ f32x4 mfma16(bf16x8 a, bf16x8 b, f32x4 c) { return __builtin_amdgcn_mfma_f32_16x16x32_bf16(a, b, c, 0, 0, 0); }
__device__ __forceinline__ bf16x8 ld8(const bf16_t* p) { return *(const bf16x8*)p; }

__device__ __forceinline__ void transpose_item(const float* W, int K, size_t ldsrc, int k0, int n_src0, bf16_t* WT, int dst_row0, float* scr, int lane) {
#pragma unroll 8
    for (int i = 0; i < 32; ++i) { const int kk = 2 * i + (lane >> 5); scr[kk * 33 + (lane & 31)] = W[(size_t)(k0 + kk) * ldsrc + n_src0 + (lane & 31)]; }
    __builtin_amdgcn_wave_barrier();
    asm volatile("s_waitcnt lgkmcnt(0)" ::: "memory");
    const int c = lane & 7;
#pragma unroll
    for (int j = 0; j < 4; ++j) { const int n = (lane >> 3) + 8 * j; const float* s = scr + (8 * c) * 33 + n;
        u32x4 o; o.x = pk2(s[0 * 33], s[1 * 33]); o.y = pk2(s[2 * 33], s[3 * 33]); o.z = pk2(s[4 * 33], s[5 * 33]); o.w = pk2(s[6 * 33], s[7 * 33]);
        *(u32x4*)(WT + (size_t)(dst_row0 + n) * K + k0 + 8 * c) = o; }
    asm volatile("s_waitcnt lgkmcnt(0)" ::: "memory");
    __builtin_amdgcn_wave_barrier();
}
__device__ __forceinline__ void convert_weights(const Params& p, int l, char* lds, int gw, int ngw, int wid, int lane) {
    float* scr = (float*)lds + wid * (64 * 33);
    unsigned char* ws = p.ws;
    constexpr int I_IN = 16 * 224, I_QKV = 3 * 4 * 4 * 8, I_SQ = 16 * 32, I_EXP = 3 * 16 * 512;
    constexpr int TOTAL = I_IN + I_QKV + 3 * I_SQ + I_EXP;
    for (int it = gw; it < TOTAL; it += ngw) {
        int r = it;
        if (r < I_IN) { const int kb = r / 224, nb = r % 224, r0 = nb * 32, nsrc = r0 < 2048 ? r0 : r0 + 8;
            transpose_item(p.in[I_WIN] + (size_t)l * D * DIN, D, DIN, kb * 64, nsrc, (bf16_t*)(ws + W_IN_T), r0, scr, lane); continue; }
        r -= I_IN;
        if (r < I_QKV) { const int w = r / 128, rr = r % 128, h = rr / 32, t = rr % 32, kb = t / 8, nb = t % 8;
            const float* src = p.in[w == 0 ? I_WQM : (w == 1 ? I_WKM : I_WVM)] + ((size_t)l * 4 + h) * 65536;
            bf16_t* dst = (bf16_t*)(ws + (w == 0 ? W_Q_T : (w == 1 ? W_K_T : W_V_T))) + (size_t)h * 65536;
            transpose_item(src, 256, 256, kb * 64, nb * 32, dst, nb * 32, scr, lane); continue; }
        r -= I_QKV;
        if (r < 3 * I_SQ) { const int w = r / I_SQ, t = r % I_SQ, kb = t / 32, nb = t % 32;
            const float* src = p.in[w == 0 ? I_WBM : (w == 1 ? I_WBA : I_WOUT)] + (size_t)l * D * D;
            bf16_t* dst = (bf16_t*)(ws + (w == 0 ? W_BM_T : (w == 1 ? W_BA_T : W_OUT_T)));
            transpose_item(src, D, D, kb * 64, nb * 32, dst, nb * 32, scr, lane); continue; }
        r -= 3 * I_SQ;
        { const int w = r / (16 * 512), rr = r % (16 * 512), e = rr / 512, t = rr % 512, kb = t / 32, nb = t % 32;
            const float* src = p.in[w == 0 ? I_WG : (w == 1 ? I_WU : I_WD)] + ((size_t)l * NEXP + e) * D * D;
            if (w == 2) transpose_item(src, D, D, kb * 64, nb * 32, (bf16_t*)(ws + W_D_T) + (size_t)e * D * D, nb * 32, scr, lane);
            else { const int j0 = nb * 32; transpose_item(src, D, D, kb * 64, j0, (bf16_t*)(ws + W_G_T) + (size_t)e * 2048 * D, 256 * (j0 >> 7) + (j0 & 127) + (w == 1 ? 128 : 0), scr, lane); } }
    }
}

__device__ __forceinline__ void ln_normalize(f32x4 (&v)[4], const float* g, const float* b, int lane) {
    float s = 0.f;
#pragma unroll
    for (int j = 0; j < 4; ++j) s += (v[j].x + v[j].y) + (v[j].z + v[j].w);
    const float mean = wave_sum(s) * (1.f / D);
    float s2 = 0.f;
#pragma unroll
    for (int j = 0; j < 4; ++j) { v[j] = v[j] - mean; s2 += (v[j].x * v[j].x + v[j].y * v[j].y) + (v[j].z * v[j].z + v[j].w * v[j].w); }
    const float rstd = rsqrtf(wave_sum(s2) * (1.f / D) + LN_EPS);
#pragma unroll
    for (int j = 0; j < 4; ++j) { const f32x4 gg = *(const f32x4*)(g + 4 * lane + 256 * j), bb = *(const f32x4*)(b + 4 * lane + 256 * j); v[j] = v[j] * rstd * gg + bb; }
}
__device__ __forceinline__ void store_row_bf16(bf16_t* row, const f32x4 (&v)[4], int lane) {
#pragma unroll
    for (int j = 0; j < 4; ++j) { u32x2 o; o.x = pk2(v[j].x, v[j].y); o.y = pk2(v[j].z, v[j].w); *(u32x2*)(row + 4 * lane + 256 * j) = o; }
}
__device__ __forceinline__ void store_row_zero(bf16_t* row, int lane) {
#pragma unroll
    for (int j = 0; j < 4; ++j) { u32x2 o; o.x = 0u; o.y = 0u; *(u32x2*)(row + 4 * lane + 256 * j) = o; }
}
__device__ __forceinline__ void load_gate_w(const Params& p, int l, float* g8) {
    const float* w = p.in[I_WIN] + (size_t)l * D * DIN + 2048;
    for (int i = TIDX; i < D * 8; i += NT) { const int k = i >> 3, c = i & 7; g8[i] = w[(size_t)k * DIN + c]; }
    __syncthreads();
}
__device__ __forceinline__ void gates_row(const Params& p, int l, const float* g8, const f32x4 (&v)[4], int prow, int lane) {
    float acc[8];
#pragma unroll
    for (int c = 0; c < 8; ++c) acc[c] = 0.f;
#pragma unroll
    for (int j = 0; j < 4; ++j)
#pragma unroll
        for (int i = 0; i < 4; ++i) { const int k = 4 * lane + 256 * j + i; const float x = v[j][i];
            const f32x4 w0 = *(const f32x4*)(g8 + k * 8), w1 = *(const f32x4*)(g8 + k * 8 + 4);
            acc[0] += x * w0.x; acc[1] += x * w0.y; acc[2] += x * w0.z; acc[3] += x * w0.w; acc[4] += x * w1.x; acc[5] += x * w1.y; acc[6] += x * w1.z; acc[7] += x * w1.w; }
#pragma unroll
    for (int c = 0; c < 8; ++c) acc[c] = wave_sum(acc[c]);
    if (lane < 4) {
        float* gli = (float*)(p.ws + TAB_GLI); float* glf = (float*)(p.ws + TAB_GLF);
        const float bi = p.in[I_BI][l * 4 + lane], bfv = p.in[I_BF][l * 4 + lane];
        float ai = acc[0], af = acc[4];
        if (lane == 1) { ai = acc[1]; af = acc[5]; } else if (lane == 2) { ai = acc[2]; af = acc[6]; } else if (lane == 3) { ai = acc[3]; af = acc[7]; }
        gli[(size_t)lane * P + prow] = ai + bi;
        glf[(size_t)lane * P + prow] = logsigmoidf_(af + bfv);
    }
}
__device__ __forceinline__ void gates_row_pad(const Params& p, int prow, int lane) {
    if (lane < 4) { ((float*)(p.ws + TAB_GLI))[(size_t)lane * P + prow] = NEGBIG; ((float*)(p.ws + TAB_GLF))[(size_t)lane * P + prow] = 0.f; }
}

__device__ __forceinline__ void phase_prologue(const Params& p, char* lds, int bid, int nb) {
    const int tid = TIDX, wid = tid >> 6, lane = tid & 63, gw = bid * NW + wid, ngw = nb * NW;
    convert_weights(p, 0, lds, gw, ngw, wid, lane);
    __syncthreads();
    float* g8 = (float*)lds;
    load_gate_w(p, 0, g8);
    bf16_t* H = (bf16_t*)(p.ws + B_H);
    for (int r = gw; r < P; r += ngw) {
        if (r < VALID0) { store_row_zero(H + (size_t)r * D, lane); gates_row_pad(p, r, lane); continue; }
        const float* src = r < 256 ? p.in[I_META] + (size_t)(r - VALID0) * D : p.in[I_X] + (size_t)(r - 256) * D;
        f32x4 v[4];
#pragma unroll
        for (int j = 0; j < 4; ++j) v[j] = *(const f32x4*)(src + 4 * lane + 256 * j);
        ln_normalize(v, p.in[I_LNG], p.in[I_LNB], lane);
        store_row_bf16(H + (size_t)r * D, v, lane);
        gates_row(p, 0, g8, v, r, lane);
    }
}

struct RowsPlain { const bf16_t* base; size_t ld; __device__ __forceinline__ const bf16_t* row(int m) const { return base + (size_t)m * ld; } };
template <class AR, class BR, class Epi>
__device__ __forceinline__ void sgemm_unit(const AR& ar, const BR& br, int K, int m0, int n0, const Epi& epi) {
    const int tid = TIDX, wid = tid >> 6, lane = tid & 63, c = lane & 15, g = lane >> 4, wr = wid >> 2, wc = wid & 3;
    const int mw = m0 + 64 * wr, nw = n0 + 64 * wc;
    const bf16_t* ap[4]; const bf16_t* bp[4];
#pragma unroll
    for (int i = 0; i < 4; ++i) { ap[i] = ar.row(mw + 16 * i + c) + 8 * g; bp[i] = br.row(nw + 16 * i + c) + 8 * g; }
    f32x4 acc[4][4];
#pragma unroll
    for (int i = 0; i < 4; ++i)
#pragma unroll
        for (int j = 0; j < 4; ++j) acc[i][j] = (f32x4){0.f, 0.f, 0.f, 0.f};
    for (int k0 = 0; k0 < K; k0 += 32) {
        bf16x8 a[4], b[4];
#pragma unroll
        for (int i = 0; i < 4; ++i) { a[i] = ld8(ap[i] + k0); b[i] = ld8(bp[i] + k0); }
#pragma unroll
        for (int i = 0; i < 4; ++i)
#pragma unroll
            for (int j = 0; j < 4; ++j) acc[i][j] = mfma16(b[j], a[i], acc[i][j]);
    }
#pragma unroll
    for (int i = 0; i < 4; ++i)
#pragma unroll
        for (int j = 0; j < 4; ++j) epi(mw + 16 * i + c, nw + 16 * j + 4 * g, acc[i][j]);
}
__device__ __forceinline__ void store4_bf16(bf16_t* dst, f32x4 v) { u32x2 o; o.x = pk2(v.x, v.y); o.y = pk2(v.z, v.w); *(u32x2*)dst = o; }

struct EpiProj { unsigned char* ws;
    __device__ __forceinline__ void operator()(int m, int n, f32x4 v) const {
        const int seg = n >> 10, cc = n & 1023;
        const size_t off = seg == 0 ? B_XM : seg == 1 ? B_OP : seg == 2 ? B_QA : seg == 3 ? B_KA : seg == 4 ? B_VA : seg == 5 ? B_GA : B_GB;
        store4_bf16((bf16_t*)(ws + off) + (size_t)m * D + cc, v); } };
struct EpiStore { bf16_t* C; size_t ldc; float scale;
    __device__ __forceinline__ void operator()(int m, int n, f32x4 v) const { store4_bf16(C + (size_t)m * ldc + n, v * scale); } };
__device__ __forceinline__ void phase_proj(const Params& p, char* lds, int bid, int nb) {
    const bf16_t* H = (const bf16_t*)(p.ws + B_H); const bf16_t* W = (const bf16_t*)(p.ws + W_IN_T);
    constexpr int NU_MAIN = 130 * 24, NU_VAT = 8 * 65;
    for (int u = bid; u < NU_MAIN + NU_VAT; u += nb) {
        if (u < NU_MAIN) { const int mt = u / 24; int ct = u % 24; if (ct >= 16) ct += 4;
            sgemm_unit(RowsPlain{H, D}, RowsPlain{W, D}, D, mt * 128, ct * 256, EpiProj{p.ws});
        } else { const int v = u - NU_MAIN, mt = v / 65, ct = v % 65;
            sgemm_unit(RowsPlain{W + (size_t)4096 * D, D}, RowsPlain{H, D}, D, mt * 128, ct * 256, EpiStore{(bf16_t*)(p.ws + B_VAT), P, 1.f}); }
    }
}

namespace pg8 {
#define PG8_LAS __attribute__((address_space(3)))
constexpr int BM = 256, BK = 64, HALF = 128, HTB = HALF * BK * 2, STAGE_BYTES = 8 * HTB, NXCD = 8, WGM = 8;
__host__ __device__ __forceinline__ int lds_byte(int r, int c) { const int st = (r >> 4) * 2 + (c >> 5), rr = r & 15, cc = c & 31, ob = rr * 64 + cc * 2; return st * 1024 + (ob ^ (((ob >> 9) & 1) << 5)); }
__host__ __device__ __forceinline__ void stage_rc(int b, int& R, int& C) { const int st = b / 1024, sb = b % 1024, swz = sb ^ (((sb >> 9) & 1) << 5); R = (st >> 1) * 16 + swz / 64; C = (st & 1) * 32 + (swz % 64) / 2; }
__host__ __device__ __forceinline__ int perm32(int rho) { const int n = rho >> 4, i = rho & 15; return 8 * (i >> 2) + 4 * n + (i & 3); }
struct Unit { int pm, pn, grp; };
__device__ __forceinline__ bool decode_unit(long L, int nG, int nM, int nN, Unit& u) {
    const int nwg = nG * nM * nN; if (L >= nwg) return false;
    int wgid = (int)L; { const int q = nwg / NXCD, r = nwg % NXCD, xcd = wgid % NXCD, off = wgid / NXCD; wgid = (xcd < r ? xcd * (q + 1) : r * (q + 1) + (xcd - r) * q) + off; }
    const int per = nM * nN; u.grp = wgid / per; const int rem = wgid % per;
    const int nig = WGM * nN, gid = rem / nig, fm = gid * WGM, gsz = (nM - fm) < WGM ? (nM - fm) : WGM;
    u.pm = __builtin_amdgcn_readfirstlane(fm + ((rem % nig) % gsz)); u.pn = __builtin_amdgcn_readfirstlane((rem % nig) / gsz); u.grp = __builtin_amdgcn_readfirstlane(u.grp); return true;
}
__device__ __forceinline__ unsigned cvt_pk_bf16(float lo, float hi) { unsigned r; asm volatile("v_cvt_pk_bf16_f32 %0, %1, %2" : "=v"(r) : "v"(lo), "v"(hi)); return r; }

template <class Epi, class Sched, bool ALIGN_EPI = true>
__device__ __forceinline__ void gemm_phase(PG8_LAS unsigned char* lds, const Sched& S, const Epi& E) {
    const int tid = TIDX, wid = __builtin_amdgcn_readfirstlane(tid >> 6), lane = tid & 63, wr = wid >> 2, wc = wid & 3, fr = lane & 15, fq = lane >> 4;
    const int K = S.K, nt = K / BK;
    unsigned voffA[2], voffB[2];
#pragma unroll
    for (int i = 0; i < 2; ++i) { int R, C; stage_rc(tid * 16 + i * 8192, R, C); const int Rb = (R & ~31) + perm32(R & 31);
        voffA[i] = (unsigned)(R * S.lda + C) * 2u; voffB[i] = (unsigned)(Rb * S.ldb + C) * 2u; }
    const size_t kstep = (size_t)(BK * 2);
    const size_t hstepA = (size_t)HALF * S.lda * 2, hstepB = (size_t)HALF * S.ldb * 2;
    const unsigned ldsw = (unsigned)wid * 1024u;
    const int aoff = lds_byte(wr * 64 + fr, fq * 8), boff = lds_byte(wc * 32 + fr, fq * 8);
#define PG8_SA(b, h) (((b) * 2 + (h)) * HTB)
#define PG8_SB(b, h) ((4 + (b) * 2 + (h)) * HTB)
#define PG8_STAGE(bufoff, gbase, voff) do { _Pragma("unroll") for (int _i = 0; _i < 2; ++_i) \
        __builtin_amdgcn_global_load_lds((const unsigned*)((const char*)(gbase) + (voff)[_i]), (PG8_LAS unsigned*)(lds + (bufoff) + ldsw + _i * 8192), 16, 0, 0); } while (0)
#define PG8_LDA(dst, b, h) do { _Pragma("unroll") for (int m = 0; m < 4; ++m) _Pragma("unroll") for (int k = 0; k < 2; ++k) dst[m][k] = *(const PG8_LAS bf16x8*)(lds + PG8_SA(b, h) + aoff + m * 2048 + k * 1024); } while (0)
#define PG8_LDB(dst, b, h) do { _Pragma("unroll") for (int n = 0; n < 2; ++n) _Pragma("unroll") for (int k = 0; k < 2; ++k) dst[n][k] = *(const PG8_LAS bf16x8*)(lds + PG8_SB(b, h) + boff + n * 2048 + k * 1024); } while (0)
#define PG8_MMA(ai, bj, At, Bt) do { __builtin_amdgcn_s_setprio(1); _Pragma("unroll") for (int m = 0; m < 4; ++m) _Pragma("unroll") for (int n = 0; n < 2; ++n) _Pragma("unroll") for (int k = 0; k < 2; ++k) \
        acc[ai][bj][m][n] = __builtin_amdgcn_mfma_f32_16x16x32_bf16(Bt[n][k], At[m][k], acc[ai][bj][m][n], 0, 0, 0); __builtin_amdgcn_s_setprio(0); } while (0)
#define PG8_WAIT_V(n) asm volatile("s_waitcnt vmcnt(" #n ")" ::: "memory")
#define PG8_WAIT_L(n) asm volatile("s_waitcnt lgkmcnt(" #n ")" ::: "memory")
#define PG8_BAR __builtin_amdgcn_s_barrier()
#define PG8_SCHED __builtin_amdgcn_sched_barrier(0)
    Unit cur, nxt; int ui = 0;
    if (!S.next(0, cur)) return;
    f32x4 acc[2][2][4][2];
#pragma unroll
    for (int a = 0; a < 2; ++a)
#pragma unroll
        for (int b = 0; b < 2; ++b)
#pragma unroll
            for (int m = 0; m < 4; ++m)
#pragma unroll
                for (int n = 0; n < 2; ++n) acc[a][b][m][n] = (f32x4){0.f, 0.f, 0.f, 0.f};
    bf16x8 At[4][2], B0[2][2], B1[2][2];
    const char* cA = S.abase(cur); const char* cB = S.bbase(cur);
    PG8_STAGE(PG8_SB(0, 0), cB, voffB); PG8_STAGE(PG8_SB(0, 1), cB + hstepB, voffB); PG8_STAGE(PG8_SA(0, 0), cA, voffA); PG8_STAGE(PG8_SA(0, 1), cA + hstepA, voffA);
    if (wr == 1) PG8_BAR;
    PG8_WAIT_V(2); PG8_BAR;
    PG8_STAGE(PG8_SB(1, 0), cB + kstep, voffB); PG8_STAGE(PG8_SA(1, 0), cA + kstep, voffA); PG8_STAGE(PG8_SB(1, 1), cB + hstepB + kstep, voffB);
    PG8_WAIT_V(6); PG8_BAR;
    for (;;) {
        const bool has_next = S.next(ui + 1, nxt);
        const char* nA = has_next ? S.abase(nxt) : cA; const char* nB = has_next ? S.bbase(nxt) : cB;
        for (int t = 0; t < nt; t += 2) {
            const bool last = (t == nt - 2);
            const char* a1 = cA + (size_t)(t + 1) * kstep;
            const char* a2 = last ? nA : cA + (size_t)(t + 2) * kstep; const char* b2 = last ? nB : cB + (size_t)(t + 2) * kstep;
            const char* a3 = a2 + kstep; const char* b3 = b2 + kstep;
            PG8_LDB(B0, 0, 0); PG8_LDB(B1, 0, 1); PG8_SCHED; PG8_LDA(At, 0, 0); PG8_STAGE(PG8_SA(1, 1), a1 + hstepA, voffA);
            PG8_WAIT_V(8); PG8_WAIT_L(0); PG8_BAR; PG8_MMA(0, 0, At, B0); PG8_MMA(0, 1, At, B1); PG8_BAR; PG8_SCHED;
            PG8_LDA(At, 0, 1); PG8_STAGE(PG8_SB(0, 0), b2, voffB); PG8_STAGE(PG8_SB(0, 1), b2 + hstepB, voffB); PG8_STAGE(PG8_SA(0, 0), a2, voffA);
            PG8_WAIT_V(8); PG8_WAIT_L(0); PG8_BAR; PG8_MMA(1, 0, At, B0); PG8_MMA(1, 1, At, B1); PG8_BAR; PG8_SCHED;
            PG8_LDB(B0, 1, 0); PG8_LDB(B1, 1, 1); PG8_SCHED; PG8_LDA(At, 1, 0); PG8_STAGE(PG8_SA(0, 1), a2 + hstepA, voffA);
            PG8_WAIT_V(8); PG8_WAIT_L(0); PG8_BAR; PG8_MMA(0, 0, At, B0); PG8_MMA(0, 1, At, B1); PG8_BAR; PG8_SCHED;
            PG8_LDA(At, 1, 1); PG8_STAGE(PG8_SB(1, 0), b3, voffB); PG8_STAGE(PG8_SB(1, 1), b3 + hstepB, voffB); PG8_STAGE(PG8_SA(1, 0), a3, voffA);
            PG8_WAIT_V(8); PG8_WAIT_L(0); PG8_BAR; PG8_MMA(1, 0, At, B0); PG8_MMA(1, 1, At, B1); PG8_BAR; PG8_SCHED;
        }
        if constexpr (ALIGN_EPI) { if (wr == 0) PG8_BAR; }
        E(acc, cur, wr, wc, fr, fq);
        if (!has_next) break;
#pragma unroll
        for (int a = 0; a < 2; ++a)
#pragma unroll
            for (int b = 0; b < 2; ++b)
#pragma unroll
                for (int m = 0; m < 4; ++m)
#pragma unroll
                    for (int n = 0; n < 2; ++n) acc[a][b][m][n] = (f32x4){0.f, 0.f, 0.f, 0.f};
        cur = nxt; cA = nA; cB = nB; ++ui;
        if constexpr (ALIGN_EPI) { if (wr == 1) PG8_BAR; }
    }
    PG8_WAIT_V(0);
    if constexpr (!ALIGN_EPI) { if (wr == 0) PG8_BAR; }
    PG8_BAR;
#undef PG8_SA
#undef PG8_SB
#undef PG8_STAGE
#undef PG8_LDA
#undef PG8_LDB
#undef PG8_MMA
#undef PG8_WAIT_V
#undef PG8_WAIT_L
#undef PG8_BAR
#undef PG8_SCHED
}
__device__ __forceinline__ u32x4 pack8(f32x4 v0, f32x4 v1) { u32x4 w; w.x = cvt_pk_bf16(v0[0], v0[1]); w.y = cvt_pk_bf16(v0[2], v0[3]); w.z = cvt_pk_bf16(v1[0], v1[1]); w.w = cvt_pk_bf16(v1[2], v1[3]); return w; }
__device__ __forceinline__ void unpack8(u32x4 w, f32x4& v0, f32x4& v1) {
    v0[0] = __uint_as_float(w.x << 16); v0[1] = __uint_as_float(w.x & 0xffff0000u); v0[2] = __uint_as_float(w.y << 16); v0[3] = __uint_as_float(w.y & 0xffff0000u);
    v1[0] = __uint_as_float(w.z << 16); v1[1] = __uint_as_float(w.z & 0xffff0000u); v1[2] = __uint_as_float(w.w << 16); v1[3] = __uint_as_float(w.w & 0xffff0000u); }
template <class F> __device__ __forceinline__ void for_each_piece(const f32x4 (&acc)[2][2][4][2], const Unit& u, int wr, int wc, int fr, int fq, const F& f) {
    const int row0 = u.pm * BM + wr * 64 + fr, col0 = wc * 32 + 8 * fq;
#pragma unroll
    for (int ai = 0; ai < 2; ++ai)
#pragma unroll
        for (int m = 0; m < 4; ++m)
#pragma unroll
            for (int bj = 0; bj < 2; ++bj) f(row0 + ai * HALF + m * 16, col0 + bj * HALF, acc[ai][bj][m][0], acc[ai][bj][m][1]);
}
}

template <int MI, int NJ, class AR, class BR, class Epi>
__device__ __forceinline__ void sgemm_wave(const AR& ar, const BR& br, int K, int m0, int n0, const Epi& epi) {
    const int lane = TIDX & 63, c = lane & 15, g = lane >> 4;
    const bf16_t* ap[MI]; const bf16_t* bp[NJ];
#pragma unroll
    for (int i = 0; i < MI; ++i) ap[i] = ar.row(m0 + 16 * i + c) + 8 * g;
#pragma unroll
    for (int j = 0; j < NJ; ++j) bp[j] = br.row(n0 + 16 * j + c) + 8 * g;
    f32x4 acc[MI][NJ];
#pragma unroll
    for (int i = 0; i < MI; ++i)
#pragma unroll
        for (int j = 0; j < NJ; ++j) acc[i][j] = (f32x4){0.f, 0.f, 0.f, 0.f};
#pragma unroll 4
    for (int k0 = 0; k0 < K; k0 += 32) {
        bf16x8 a[MI], b[NJ];
#pragma unroll
        for (int i = 0; i < MI; ++i) a[i] = ld8(ap[i] + k0);
#pragma unroll
        for (int j = 0; j < NJ; ++j) b[j] = ld8(bp[j] + k0);
#pragma unroll
        for (int i = 0; i < MI; ++i)
#pragma unroll
            for (int j = 0; j < NJ; ++j) acc[i][j] = mfma16(b[j], a[i], acc[i][j]);
    }
#pragma unroll
    for (int i = 0; i < MI; ++i)
#pragma unroll
        for (int j = 0; j < NJ; ++j) epi(m0 + 16 * i + c, n0 + 16 * j + 4 * g, acc[i][j]);
}
__device__ __forceinline__ void zero_block(bf16_t* base, size_t ld, int nrows, int ncols, int gtid, int gthreads) {
    const int cpr = ncols / 8;
    for (int i = gtid; i < nrows * cpr; i += gthreads) { const int r = i / cpr, cc = (i % cpr) * 8; *(u32x4*)(base + (size_t)r * ld + cc) = (u32x4){0u, 0u, 0u, 0u}; }
}

struct SchedProj { const char* A; const char* B; int G, c; int K, lda, ldb;
    __device__ __forceinline__ bool next(int i, pg8::Unit& u) const { if (!pg8::decode_unit((long)i * G + c, 1, 64, 28, u)) return false; u.pm += 1; return true; }
    __device__ __forceinline__ const char* abase(const pg8::Unit& u) const { return A + (size_t)u.pm * 256 * D * 2; }
    __device__ __forceinline__ const char* bbase(const pg8::Unit& u) const { return B + (size_t)u.pn * 256 * D * 2; } };
struct EpiProjF { unsigned char* ws;
    __device__ __forceinline__ void operator()(const f32x4 (&acc)[2][2][4][2], const pg8::Unit& u, int wr, int wc, int fr, int fq) const {
        const int colt = u.pn * 256, seg = colt >> 10;
        const size_t off = seg == 0 ? B_XM : seg == 1 ? B_OP : seg == 2 ? B_QA : seg == 3 ? B_KA : seg == 4 ? B_VA : seg == 5 ? B_GA : B_GB;
        bf16_t* base = (bf16_t*)(ws + off) + (colt & 1023);
        pg8::for_each_piece(acc, u, wr, wc, fr, fq, [&](int row, int col, f32x4 v0, f32x4 v1) { *(u32x4*)(base + (size_t)row * D + col) = pg8::pack8(v0, v1); }); } };
struct SchedVAT { const char* A; const char* B; int G, c; int K, lda, ldb;
    __device__ __forceinline__ bool next(int i, pg8::Unit& u) const { if (!pg8::decode_unit((long)i * G + c, 1, 4, 64, u)) return false; u.pn += 1; return true; }
    __device__ __forceinline__ const char* abase(const pg8::Unit& u) const { return A + (size_t)u.pm * 256 * D * 2; }
    __device__ __forceinline__ const char* bbase(const pg8::Unit& u) const { return B + (size_t)u.pn * 256 * D * 2; } };
struct EpiStoreF { bf16_t* C; size_t ldc; float scale;
    __device__ __forceinline__ void operator()(const f32x4 (&acc)[2][2][4][2], const pg8::Unit& u, int wr, int wc, int fr, int fq) const {
        bf16_t* base = C + (size_t)u.pn * 256;
        pg8::for_each_piece(acc, u, wr, wc, fr, fq, [&](int row, int col, f32x4 v0, f32x4 v1) { *(u32x4*)(base + (size_t)row * ldc + col) = pg8::pack8(v0 * scale, v1 * scale); }); } };
__device__ __forceinline__ void phase_proj_f(const Params& p, char* lds, int bid, int nb) {
    const int tid = TIDX, wid = tid >> 6, gw = bid * NW + wid, ngw = nb * NW;
    const bf16_t* H = (const bf16_t*)(p.ws + B_H); const bf16_t* W = (const bf16_t*)(p.ws + W_IN_T);
    zero_block((bf16_t*)(p.ws + B_KA), D, VALID0, D, bid * NT + tid, nb * NT);
    zero_block((bf16_t*)(p.ws + B_VA), D, VALID0, D, bid * NT + tid, nb * NT);
    zero_block((bf16_t*)(p.ws + B_XM), D, VALID0, D, bid * NT + tid, nb * NT);
    for (int t = gw; t < 112; t += ngw) sgemm_wave<1, 4>(RowsPlain{H, D}, RowsPlain{W, D}, D, VALID0, t * 64, EpiProj{p.ws});
    { SchedProj S{(const char*)H, (const char*)W, nb, bid, D, D, D};
      pg8::gemm_phase(( PG8_LAS unsigned char*)lds, S, EpiProjF{p.ws}); }
}

__device__ __forceinline__ void phase_attn(const Params& p, int l, char* lds, int bid, int nb) {
    const int tid = TIDX, wid = tid >> 6, lane = tid & 63, c = lane & 15, g = lane >> 4, gw = bid * NW + wid, ngw = nb * NW;
    const bf16_t* QA = (const bf16_t*)(p.ws + B_QA); const bf16_t* KA = (const bf16_t*)(p.ws + B_KA); const bf16_t* VAT = (const bf16_t*)(p.ws + B_VAT);
    bf16_t* YA = (bf16_t*)(p.ws + B_YA);
    const float lam_init = 0.8f - 0.6f * expf(-0.3f * (float)l);
    float lam;
    { const float a = wave_sum(p.in[I_LQ1][l * 64 + lane] * p.in[I_LK1][l * 64 + lane]), b = wave_sum(p.in[I_LQ2][l * 64 + lane] * p.in[I_LK2][l * 64 + lane]);
      lam = expf(a) - expf(b) + lam_init; }
    constexpr int NQG = P / 16, QG0 = VALID0 / 16;
    const int ntask = (NQG - QG0) * 8;
    for (int t = gw; t < ntask; t += ngw) {
        const int qg = NQG - 1 - t / 8, hd = t % 8, q0 = qg * 16, q = q0 + c;
        bf16x8 qf[2][2];
#pragma unroll
        for (int mp = 0; mp < 2; ++mp)
#pragma unroll
            for (int ks = 0; ks < 2; ++ks) qf[mp][ks] = ld8(QA + (size_t)q * D + hd * 128 + mp * 64 + 32 * ks + 8 * g);
        f32x4 o[2][8];
#pragma unroll
        for (int mp = 0; mp < 2; ++mp)
#pragma unroll
            for (int dt = 0; dt < 8; ++dt) o[mp][dt] = (f32x4){0.f, 0.f, 0.f, 0.f};
        float mrun[2] = {NEGBIG, NEGBIG}, lrun[2] = {0.f, 0.f};
        for (int kb = 224; kb <= q0 + 15; kb += 32) {
            bf16x8 pf[2];
#pragma unroll
            for (int mp = 0; mp < 2; ++mp) {
                f32x4 s[2];
#pragma unroll
                for (int a = 0; a < 2; ++a) {
                    s[a] = (f32x4){0.f, 0.f, 0.f, 0.f};
                    const bf16_t* kr = KA + (size_t)(kb + 16 * a + c) * D + hd * 128 + mp * 64 + 8 * g;
#pragma unroll
                    for (int ks = 0; ks < 2; ++ks) s[a] = mfma16(ld8(kr + 32 * ks), qf[mp][ks], s[a]);
                }
                float mx = NEGBIG;
#pragma unroll
                for (int a = 0; a < 2; ++a)
#pragma unroll
                    for (int r = 0; r < 4; ++r) { const int key = kb + 16 * a + 4 * g + r; float v = s[a][r] * 0.125f; v = (key <= q && key >= VALID0) ? v : -INFINITY; s[a][r] = v; mx = fmaxf(mx, v); }
                mx = fmaxf(mx, __shfl_xor(mx, 16)); mx = fmaxf(mx, __shfl_xor(mx, 32));
                const float mn = fmaxf(mrun[mp], mx), alpha = __expf(mrun[mp] - mn);
                mrun[mp] = mn;
                float ps = 0.f;
#pragma unroll
                for (int a = 0; a < 2; ++a)
#pragma unroll
                    for (int r = 0; r < 4; ++r) { const float e = __expf(s[a][r] - mn); s[a][r] = e; ps += e; }
                lrun[mp] = lrun[mp] * alpha + ps;
#pragma unroll
                for (int dt = 0; dt < 8; ++dt) o[mp][dt] = o[mp][dt] * alpha;
                u32x4 w; w.x = pk2(s[0][0], s[0][1]); w.y = pk2(s[0][2], s[0][3]); w.z = pk2(s[1][0], s[1][1]); w.w = pk2(s[1][2], s[1][3]);
                pf[mp] = *(bf16x8*)&w;
            }
#pragma unroll
            for (int dt = 0; dt < 8; ++dt) {
                const bf16_t* vr = VAT + (size_t)(hd * 128 + 16 * dt + c) * P + kb + 4 * g;
                u32x2 v0 = *(const u32x2*)vr, v1 = *(const u32x2*)(vr + 16);
                u32x4 w; w.x = v0.x; w.y = v0.y; w.z = v1.x; w.w = v1.y;
                const bf16x8 vf = *(bf16x8*)&w;
                o[0][dt] = mfma16(vf, pf[0], o[0][dt]);
                o[1][dt] = mfma16(vf, pf[1], o[1][dt]);
            }
        }
        float l0 = lrun[0], l1 = lrun[1];
        l0 += __shfl_xor(l0, 16); l0 += __shfl_xor(l0, 32); l1 += __shfl_xor(l1, 16); l1 += __shfl_xor(l1, 32);
        const float i0 = 1.f / l0, i1 = lam / l1;
        float ss = 0.f;
#pragma unroll
        for (int dt = 0; dt < 8; ++dt) { o[0][dt] = o[0][dt] * i0 - o[1][dt] * i1; ss += (o[0][dt].x * o[0][dt].x + o[0][dt].y * o[0][dt].y) + (o[0][dt].z * o[0][dt].z + o[0][dt].w * o[0][dt].w); }
        ss += __shfl_xor(ss, 16); ss += __shfl_xor(ss, 32);
        const float rs = rsqrtf(ss * (1.f / 128.f) + LN_EPS) * (1.f - lam_init);
#pragma unroll
        for (int dt = 0; dt < 8; ++dt) { const f32x4 gg = *(const f32x4*)(p.in[I_ANG] + l * 128 + 16 * dt + 4 * g);
            store4_bf16(YA + (size_t)q * D + hd * 128 + 16 * dt + 4 * g, o[0][dt] * rs * gg); }
    }
}

namespace fa {
typedef short s16x4 __attribute__((ext_vector_type(4)));
typedef float f32x16 __attribute__((ext_vector_type(16)));
constexpr int KVBLK = 64, SHM_V = 64 * 128 * 2, SHM_K = 64 * 64 * 2, PITCH = 1024;
constexpr int LDS_NEED = 2 * SHM_V + 2 * SHM_K + NW * 64 * 4;
constexpr float SCALE = 0.125f, THR = 8.f;
#define FA_SBAR() __builtin_amdgcn_sched_barrier(0)
__device__ __forceinline__ int kswz(int row, int chunk) { return row * 128 + ((chunk ^ ((row >> 1) & 7)) << 4); }
__device__ __forceinline__ int v_st(int k, int c) { const int kk = (k & ~0xC) | ((k & 4) << 1) | ((k & 8) >> 1); return ((kk >> 3) * 4 + (c >> 5)) * 512 + ((kk & 7) * 32 + (c & 31)) * 2; }
__device__ __forceinline__ int v_rd_base(int lane) { return ((lane & 3) << 3) | (((lane >> 2) & 3) << 6) | (((lane >> 4) & 1) << 5) | (((lane >> 5) & 1) << 8); }
constexpr int v_rd_off(int d0, int ks, int half) { return d0 * 512 + ks * 4096 + half * 2048; }
__device__ __forceinline__ int crow(int r, int hi) { return (r & 3) + 8 * (r >> 2) + 4 * hi; }
__device__ __forceinline__ unsigned cvtpk(float lo, float hi) { unsigned r; asm volatile("v_cvt_pk_bf16_f32 %0, %1, %2" : "=v"(r) : "v"(lo), "v"(hi)); return r; }
__device__ __forceinline__ void mask_tile(f32x16& p0, f32x16& p1, int pos, int kbase, int hi, int lowkey) {
    const float NEG = -__builtin_inff();
#pragma unroll
    for (int r = 0; r < 16; ++r) {
        const int k0 = kbase + (r & 3) + 8 * (r >> 2) + 4 * hi;
        if (k0 > pos || k0 < lowkey) p0[r] = NEG;
        if (k0 + 32 > pos || k0 + 32 < lowkey) p1[r] = NEG;
    }
}
__device__ __forceinline__ void partialSM(f32x16& p0, f32x16& p1, float& m_reg, float& mn, float& alpha) {
    float pmax = p0[0];
#pragma unroll
    for (int r = 1; r < 16; ++r) pmax = fmaxf(pmax, p0[r]);
#pragma unroll
    for (int r = 0; r < 16; ++r) pmax = fmaxf(pmax, p1[r]);
    { auto rr = __builtin_amdgcn_permlane32_swap(__float_as_uint(pmax), __float_as_uint(pmax), false, false);
      pmax = fmaxf(__uint_as_float(rr[0]), __uint_as_float(rr[1])); }
    constexpr float C2 = 1.4426950408889634f * SCALE;
    if (__builtin_expect(__all((pmax - m_reg) * SCALE <= THR), 1)) { mn = m_reg; alpha = 1.f; }
    else { mn = fmaxf(m_reg, pmax); alpha = __builtin_amdgcn_exp2f((m_reg - mn) * C2); m_reg = mn; }
    const float mnL = -mn * C2;
#pragma unroll
    for (int r = 0; r < 16; ++r) p0[r] = fmaf(p0[r], C2, mnL);
#pragma unroll
    for (int r = 0; r < 16; ++r) p1[r] = fmaf(p1[r], C2, mnL);
#pragma unroll
    for (int r = 0; r < 16; ++r) p0[r] = __builtin_amdgcn_exp2f(p0[r]);
}
__device__ __forceinline__ void finishSM(f32x16& p0, f32x16& p1, float alpha, float& l_reg, bf16x8& pa0, bf16x8& pa1, bf16x8& pa2, bf16x8& pa3) {
#pragma unroll
    for (int r = 0; r < 16; ++r) p1[r] = __builtin_amdgcn_exp2f(p1[r]);
    float ps = 0;
#pragma unroll
    for (int r = 0; r < 16; ++r) ps += p0[r];
#pragma unroll
    for (int r = 0; r < 16; ++r) ps += p1[r];
    { auto rr = __builtin_amdgcn_permlane32_swap(__float_as_uint(ps), __float_as_uint(ps), false, false);
      ps = __uint_as_float(rr[0]) + __uint_as_float(rr[1]); }
    l_reg = l_reg * alpha + ps;
#define FA_PK4(Pv, B_, OUT) do { unsigned a0 = cvtpk(Pv[B_+0], Pv[B_+1]), a1 = cvtpk(Pv[B_+2], Pv[B_+3]);                          \
        unsigned b0 = cvtpk(Pv[B_+4], Pv[B_+5]), b1 = cvtpk(Pv[B_+6], Pv[B_+7]);                                             \
        auto r0 = __builtin_amdgcn_permlane32_swap(a0, b0, false, false); auto r1 = __builtin_amdgcn_permlane32_swap(a1, b1, false, false); \
        u32x4 w = {r0[0], r1[0], r0[1], r1[1]}; OUT = *reinterpret_cast<bf16x8*>(&w); } while (0)
    FA_PK4(p0, 0, pa0); FA_PK4(p0, 8, pa1); FA_PK4(p1, 0, pa2); FA_PK4(p1, 8, pa3);
#undef FA_PK4
}
template <int KB>
__device__ __forceinline__ void qkt(f32x16& p0, f32x16& p1, const char* K_lds, int r32, int hi, const bf16x8* qr) {
    p0 = f32x16{}; p1 = f32x16{};
#pragma unroll
    for (int d0 = 0; d0 < 4; ++d0) { const char* a = K_lds + KB * SHM_K + kswz(r32, 2 * d0 + hi);
        bf16x8 b0 = *reinterpret_cast<const bf16x8*>(a);
        bf16x8 b1 = *reinterpret_cast<const bf16x8*>(a + 32 * 128);
        p0 = __builtin_amdgcn_mfma_f32_32x32x16_bf16(b0, qr[d0], p0, 0, 0, 0);
        p1 = __builtin_amdgcn_mfma_f32_32x32x16_bf16(b1, qr[d0], p1, 0, 0, 0); }
}
template <int VB>
__device__ __forceinline__ void pv_tile(f32x16* o, int vb0, bf16x8 pa0, bf16x8 pa1, bf16x8 pa2, bf16x8 pa3) {
#define FA_TRRD(dst, off) asm volatile("ds_read_b64_tr_b16 %0, %1 offset:%2" : "=&v"(dst) : "v"(vb0), "i"(off) : "memory")
#define FA_PV_D0(d0) do { s16x4 l0, l1, l2, l3, h0, h1, h2, h3; constexpr int b_ = VB * SHM_V + v_rd_off(d0, 0, 0); \
        FA_TRRD(l0, b_); FA_TRRD(h0, b_ + 2048); FA_TRRD(l1, b_ + 4096); FA_TRRD(h1, b_ + 6144); FA_TRRD(l2, b_ + 8192); FA_TRRD(h2, b_ + 10240); FA_TRRD(l3, b_ + 12288); FA_TRRD(h3, b_ + 14336); \
        asm volatile("s_waitcnt lgkmcnt(0)" ::: "memory"); FA_SBAR();   \
        o[d0] = __builtin_amdgcn_mfma_f32_32x32x16_bf16(pa0, (bf16x8){l0[0], l0[1], l0[2], l0[3], h0[0], h0[1], h0[2], h0[3]}, o[d0], 0, 0, 0);   \
        o[d0] = __builtin_amdgcn_mfma_f32_32x32x16_bf16(pa1, (bf16x8){l1[0], l1[1], l1[2], l1[3], h1[0], h1[1], h1[2], h1[3]}, o[d0], 0, 0, 0);   \
        o[d0] = __builtin_amdgcn_mfma_f32_32x32x16_bf16(pa2, (bf16x8){l2[0], l2[1], l2[2], l2[3], h2[0], h2[1], h2[2], h2[3]}, o[d0], 0, 0, 0);   \
        o[d0] = __builtin_amdgcn_mfma_f32_32x32x16_bf16(pa3, (bf16x8){l3[0], l3[1], l3[2], l3[3], h3[0], h3[1], h3[2], h3[3]}, o[d0], 0, 0, 0); } while (0)
    FA_PV_D0(0); FA_PV_D0(1); FA_PV_D0(2); FA_PV_D0(3);
#undef FA_PV_D0
#undef FA_TRRD
}
__device__ __forceinline__ void attn_pass(const bf16_t* Qp, const bf16_t* Kp, const bf16_t* Vp, int P0, int NT, char* lds, f32x16 (&o)[4], float& l_out) {
    const int tid = TIDX, wid = __builtin_amdgcn_readfirstlane(tid >> 6), lane = tid & 63, r32 = lane & 31, hi = lane >> 5;
    char* V_lds = lds; char* K_lds = lds + 2 * SHM_V;
    float* wsl = (float*)(lds + 2 * SHM_V + 2 * SHM_K) + wid * 64; float* al_l = wsl + 32;
    const int qlo = P0 + wid * 32, pos = qlo + r32;
    float m_reg = -1e30f, l_reg = 0.f;
#pragma unroll
    for (int d = 0; d < 4; ++d) o[d] = f32x16{};
    const int ksr = tid >> 3, ksc = tid & 7, kws = kswz(ksr, ksc);
    const int sr = tid >> 4, sc = (tid & 15) * 8, vst0 = v_st(sr, sc), vst1 = v_st(32 + sr, sc);
    const int vb0 = (int)(uintptr_t)V_lds + v_rd_base(lane);
    bf16x8 qr[4];
#pragma unroll
    for (int d0 = 0; d0 < 4; ++d0) qr[d0] = ld8(Qp + (size_t)pos * PITCH + d0 * 16 + hi * 8);
    bf16x8 st_k, st_v0, st_v1;
#define FA_KBASE(t) ((3 + (t)) * KVBLK)
#define FA_SLOAD(t) do { const int kb_ = FA_KBASE(t); st_k = ld8(Kp + (size_t)(kb_ + ksr) * PITCH + ksc * 8); \
        st_v0 = ld8(Vp + (size_t)(kb_ + sr) * PITCH + sc); st_v1 = ld8(Vp + (size_t)(kb_ + 32 + sr) * PITCH + sc); } while (0)
#define FA_SWRITE_K(bf) do { *(bf16x8*)(K_lds + (bf) * SHM_K + kws) = st_k; } while (0)
#define FA_SWRITE_V(bf) do { *(bf16x8*)(V_lds + (bf) * SHM_V + vst0) = st_v0; *(bf16x8*)(V_lds + (bf) * SHM_V + vst1) = st_v1; } while (0)
#define FA_VMW() asm volatile("s_waitcnt vmcnt(0)" ::: "memory")
#define FA_RESC(a) do { if (__any((a) < 1.f)) { if (hi == 0) al_l[r32] = (a); asm volatile("s_waitcnt lgkmcnt(0)" ::: "memory");              \
                     for (int d_ = 0; d_ < 4; ++d_) for (int r = 0; r < 16; ++r) o[d_][r] *= al_l[crow(r, hi)]; } } while (0)
#define FA_MASKT(P0_, P1_, t) do { const int kb_ = FA_KBASE(t); if ((t) == 0 || kb_ + KVBLK - 1 > qlo) mask_tile(P0_, P1_, pos, kb_, hi, VALID0); } while (0)
    f32x16 pA0, pA1, pB0, pB1; float mnA, mnB, alA, alB; bf16x8 pa0, pa1, pa2, pa3;
    FA_SLOAD(0); FA_VMW(); FA_SWRITE_K(0); FA_SWRITE_V(0); FA_SBAR();
    if (NT > 1) FA_SLOAD(1);
    __syncthreads();
    FA_SBAR(); qkt<0>(pA0, pA1, K_lds, r32, hi, qr);
    FA_MASKT(pA0, pA1, 0); partialSM(pA0, pA1, m_reg, mnA, alA);
    if (NT > 1) { FA_VMW(); FA_SWRITE_K(1); FA_SWRITE_V(1); }
    __syncthreads();
#define FA_HALF_STEP(PX0, PX1, mnX, alX, PY0, PY1, alY, t, KB, VB, SB) do {                                                      \
        FA_SBAR(); qkt<KB>(PX0, PX1, K_lds, r32, hi, qr);                                             \
        finishSM(PY0, PY1, alY, l_reg, pa0, pa1, pa2, pa3); FA_SBAR();                                                           \
        if ((t) + 1 < NT) { FA_SLOAD((t) + 1); FA_SBAR(); }                                               \
        pv_tile<VB>(o, vb0, pa0, pa1, pa2, pa3); FA_MASKT(PX0, PX1, (t)); partialSM(PX0, PX1, m_reg, mnX, alX);                                        \
        __syncthreads();                                                                                                      \
        if ((t) + 1 < NT) { FA_VMW(); FA_SWRITE_K(SB); FA_SWRITE_V(SB); }                                                                          \
        FA_RESC(alX); __syncthreads(); } while (0)
    for (int t = 1; t + 1 < NT; t += 2) {
        FA_HALF_STEP(pB0, pB1, mnB, alB, pA0, pA1, alA, t, 1, 0, 0);
        FA_HALF_STEP(pA0, pA1, mnA, alA, pB0, pB1, alB, t + 1, 0, 1, 1);
    }
    const bool even = (NT & 1) == 0;
    if (even) { FA_SBAR(); qkt<1>(pB0, pB1, K_lds, r32, hi, qr); FA_SBAR(); }
    finishSM(pA0, pA1, alA, l_reg, pa0, pa1, pa2, pa3); FA_SBAR();
    pv_tile<0>(o, vb0, pa0, pa1, pa2, pa3);
    if (even) { FA_MASKT(pB0, pB1, NT - 1); partialSM(pB0, pB1, m_reg, mnB, alB); __syncthreads(); FA_RESC(alB);
        finishSM(pB0, pB1, alB, l_reg, pa0, pa1, pa2, pa3); FA_SBAR(); pv_tile<1>(o, vb0, pa0, pa1, pa2, pa3); }
    l_out = l_reg;
    __syncthreads();
#undef FA_KBASE
#undef FA_SLOAD
#undef FA_SWRITE_K
#undef FA_SWRITE_V
#undef FA_VMW
#undef FA_RESC
#undef FA_MASKT
#undef FA_HALF_STEP
}
__device__ __forceinline__ void attn_unit(const Params& p, int l, int hd, int j, float lam, float lam_init, char* lds) {
    const int tid = TIDX, wid = __builtin_amdgcn_readfirstlane(tid >> 6), lane = tid & 63, r32 = lane & 31, hi = lane >> 5;
    const bf16_t* QA = (const bf16_t*)(p.ws + B_QA) + hd * 128; const bf16_t* KA = (const bf16_t*)(p.ws + B_KA) + hd * 128; const bf16_t* VA = (const bf16_t*)(p.ws + B_VA) + hd * 128;
    bf16_t* YA = (bf16_t*)(p.ws + B_YA) + hd * 128;
    const int P0 = j * 256, NT = 4 * j + 1;
    float* li_l = (float*)(lds + 2 * SHM_V + 2 * SHM_K) + wid * 64;
    bf16_t* Yw = YA + (size_t)(P0 + wid * 32) * PITCH;
    f32x16 o[4]; float lr;
    attn_pass(QA, KA, VA, P0, NT, lds, o, lr);
    if (hi == 0) li_l[r32] = lr;
    asm volatile("s_waitcnt lgkmcnt(0)" ::: "memory");
#pragma unroll
    for (int r = 0; r < 16; ++r) { const int orow = crow(r, hi); const float rl = __builtin_amdgcn_rcpf(li_l[orow]);
#pragma unroll
        for (int d0 = 0; d0 < 4; ++d0) { const float v = o[d0][r] * rl; const float vn = __shfl_xor(v, 1);
            if ((r32 & 1) == 0) *(unsigned*)(Yw + (size_t)orow * PITCH + d0 * 32 + r32) = cvtpk(v, vn); } }
    asm volatile("s_waitcnt vmcnt(0)" ::: "memory");
    __syncthreads();
    attn_pass(QA + 64, KA + 64, VA, P0, NT, lds, o, lr);
    if (hi == 0) li_l[r32] = lr;
    asm volatile("s_waitcnt lgkmcnt(0)" ::: "memory");
    const float scale_out = 1.f - lam_init;
#pragma unroll
    for (int r = 0; r < 16; ++r) { const int orow = crow(r, hi); const float rl = lam * __builtin_amdgcn_rcpf(li_l[orow]);
        float cv[4]; float ss = 0.f;
#pragma unroll
        for (int d0 = 0; d0 < 4; ++d0) { const float o1 = bf2f((unsigned)Yw[(size_t)orow * PITCH + d0 * 32 + r32]); cv[d0] = o1 - o[d0][r] * rl; ss += cv[d0] * cv[d0]; }
        ss += __shfl_xor(ss, 1); ss += __shfl_xor(ss, 2); ss += __shfl_xor(ss, 4); ss += __shfl_xor(ss, 8); ss += __shfl_xor(ss, 16);
        const float rs = rsqrtf(ss * (1.f / 128.f) + LN_EPS) * scale_out;
#pragma unroll
        for (int d0 = 0; d0 < 4; ++d0) o[d0][r] = cv[d0] * rs * p.in[I_ANG][l * 128 + d0 * 32 + r32]; }
    asm volatile("s_waitcnt vmcnt(0)" ::: "memory");
    __syncthreads();
#pragma unroll
    for (int r = 0; r < 16; ++r) { const int orow = crow(r, hi);
#pragma unroll
        for (int d0 = 0; d0 < 4; ++d0) { const float v = o[d0][r]; const float vn = __shfl_xor(v, 1);
            if ((r32 & 1) == 0) *(unsigned*)(Yw + (size_t)orow * PITCH + d0 * 32 + r32) = cvtpk(v, vn); } }
    __syncthreads();
}
}
__device__ __forceinline__ void phase_attn_f(const Params& p, int l, char* lds, int bid, int nb) {
    const int lane = TIDX & 63;
    const float lam_init = 0.8f - 0.6f * expf(-0.3f * (float)l);
    float lam;
    { const float a = wave_sum(p.in[I_LQ1][l * 64 + lane] * p.in[I_LK1][l * 64 + lane]), b = wave_sum(p.in[I_LQ2][l * 64 + lane] * p.in[I_LK2][l * 64 + lane]);
      lam = expf(a) - expf(b) + lam_init; }
    for (int u = bid; u < 256 + 8; u += nb) {
        if (u < 256) { const int hd = u & 7, jj = u >> 3;
            fa::attn_unit(p, l, hd, 64 - jj, lam, lam_init, lds);
            fa::attn_unit(p, l, hd, 1 + jj, lam, lam_init, lds);
        } else fa::attn_unit(p, l, u - 256, 0, lam, lam_init, lds);
    }
}

__device__ __forceinline__ void phase_conv(const Params& p, int l, char* lds, int bid, int nb) {
    const int tid = TIDX, wid = tid >> 6, lane = tid & 63, gw = bid * NW + wid, ngw = nb * NW;
    const bf16_t* XM = (const bf16_t*)(p.ws + B_XM); bf16_t* XC = (bf16_t*)(p.ws + B_XC);
    const float* cw = p.in[I_CONVW] + (size_t)l * 4 * D; const float* cb = p.in[I_CONVB] + (size_t)l * D;
    const int nitem = P * (D / 8);
    for (int it = bid * NT + tid; it < nitem; it += nb * NT) {
        const int r = it >> 7, c0 = (it & 127) * 8;
        u32x4 o = {0u, 0u, 0u, 0u};
        if (r >= VALID0) {
            float acc[8];
#pragma unroll
            for (int i = 0; i < 8; ++i) acc[i] = cb[c0 + i];
#pragma unroll
            for (int j = 0; j < 4; ++j) { const int rr = r - 3 + j;
                if (rr >= VALID0) { const u32x4 x = *(const u32x4*)(XM + (size_t)rr * D + c0); const float* w = cw + j * D + c0;
                    acc[0] += w[0] * bf2f(x.x & 0xffffu); acc[1] += w[1] * bf2f(x.x >> 16); acc[2] += w[2] * bf2f(x.y & 0xffffu); acc[3] += w[3] * bf2f(x.y >> 16);
                    acc[4] += w[4] * bf2f(x.z & 0xffffu); acc[5] += w[5] * bf2f(x.z >> 16); acc[6] += w[6] * bf2f(x.w & 0xffffu); acc[7] += w[7] * bf2f(x.w >> 16); } }
            o.x = pk2(siluf_(acc[0]), siluf_(acc[1])); o.y = pk2(siluf_(acc[2]), siluf_(acc[3])); o.z = pk2(siluf_(acc[4]), siluf_(acc[5])); o.w = pk2(siluf_(acc[6]), siluf_(acc[7]));
        }
        *(u32x4*)(XC + (size_t)r * D + c0) = o;
    }
    const float* gli = (const float*)(p.ws + TAB_GLI); const float* glf = (const float*)(p.ws + TAB_GLF);
    float* tb = (float*)(p.ws + TAB_B); float* te = (float*)(p.ws + TAB_E); float* tpm = (float*)(p.ws + TAB_PM); float* tw = (float*)(p.ws + TAB_W);
    float* scg = (float*)(p.ws + TAB_SCG); float* scm = (float*)(p.ws + TAB_SCM);
    for (int t = gw; t < NSC * 4; t += ngw) {
        const int sc = t >> 2, h = t & 3; const size_t base = (size_t)h * P + sc * 256 + 4 * lane;
        const f32x4 lf = *(const f32x4*)(glf + base), li = *(const f32x4*)(gli + base);
        float b[4]; b[0] = lf.x; b[1] = b[0] + lf.y; b[2] = b[1] + lf.z; b[3] = b[2] + lf.w;
        float incl = b[3];
#pragma unroll
        for (int o = 1; o < 64; o <<= 1) { const float n = __shfl_up(incl, o); if (lane >= o) incl += n; }
        const float excl = incl - b[3];
        float e[4], pm[4];
#pragma unroll
        for (int i = 0; i < 4; ++i) { b[i] += excl; e[i] = li[i] - b[i]; }
        pm[0] = e[0]; pm[1] = fmaxf(pm[0], e[1]); pm[2] = fmaxf(pm[1], e[2]); pm[3] = fmaxf(pm[2], e[3]);
        float mi = pm[3];
#pragma unroll
        for (int o = 1; o < 64; o <<= 1) { const float n = __shfl_up(mi, o); if (lane >= o) mi = fmaxf(mi, n); }
        float mex = __shfl_up(mi, 1); if (lane == 0) mex = -INFINITY;
#pragma unroll
        for (int i = 0; i < 4; ++i) pm[i] = fmaxf(pm[i], mex);
        const float gtot = __shfl(incl, 63), emax = __shfl(mi, 63), mloc = gtot + emax;
        f32x4 ww;
#pragma unroll
        for (int i = 0; i < 4; ++i) ww[i] = __expf(e[i] + gtot - mloc);
        *(f32x4*)(tb + base) = (f32x4){b[0], b[1], b[2], b[3]};
        *(f32x4*)(te + base) = (f32x4){e[0], e[1], e[2], e[3]};
        *(f32x4*)(tpm + base) = (f32x4){pm[0], pm[1], pm[2], pm[3]};
        *(f32x4*)(tw + base) = ww;
        if (lane == 0) { scg[sc * 4 + h] = gtot; scm[sc * 4 + h] = mloc; }
    }
}

__device__ __forceinline__ void phase_mqkv(const Params& p, char* lds, int bid, int nb) {
    const bf16_t* XC = (const bf16_t*)(p.ws + B_XC); const bf16_t* XM = (const bf16_t*)(p.ws + B_XM);
    const bf16_t* WQ = (const bf16_t*)(p.ws + W_Q_T); const bf16_t* WK = (const bf16_t*)(p.ws + W_K_T); const bf16_t* WV = (const bf16_t*)(p.ws + W_V_T);
    bf16_t* QM = (bf16_t*)(p.ws + B_QM); bf16_t* KM = (bf16_t*)(p.ws + B_KM); bf16_t* KMT = (bf16_t*)(p.ws + B_KMT); bf16_t* VMT = (bf16_t*)(p.ws + B_VMT);
    for (int u = bid; u < 4 * 520; u += nb) {
        const int w = u / 520, r = u % 520, h = r / 130, t = r % 130;
        if (w == 0) sgemm_unit(RowsPlain{XC + h * 256, D}, RowsPlain{WQ + (size_t)h * 65536, 256}, 256, t * 128, 0, EpiStore{QM + h * 256, D, 1.f});
        else if (w == 1) sgemm_unit(RowsPlain{XC + h * 256, D}, RowsPlain{WK + (size_t)h * 65536, 256}, 256, t * 128, 0, EpiStore{KM + h * 256, D, 0.0625f});
        else if (w == 2) sgemm_unit(RowsPlain{WK + (size_t)h * 65536, 256}, RowsPlain{XC + h * 256, D}, 256, (t / 65) * 128, (t % 65) * 256, EpiStore{KMT + (size_t)h * 256 * P, P, 0.0625f});
        else sgemm_unit(RowsPlain{WV + (size_t)h * 65536, 256}, RowsPlain{XM + h * 256, D}, 256, (t / 65) * 128, (t % 65) * 256, EpiStore{VMT + (size_t)h * 256 * P, P, 1.f});
    }
}

__device__ __forceinline__ void phase_m1(const Params& p, char* lds, int bid, int nb) {
    const int tid = TIDX, wid = __builtin_amdgcn_readfirstlane(tid >> 6), lane = tid & 63, c = lane & 15, g = lane >> 4, gw = bid * NW + wid, ngw = nb * NW;
    const bf16_t* KMT = (const bf16_t*)(p.ws + B_KMT); const bf16_t* VMT = (const bf16_t*)(p.ws + B_VMT);
    const float* tw = (const float*)(p.ws + TAB_W); bf16_t* CT = (bf16_t*)(p.ws + B_CT); float* NTv = (float*)(p.ws + TAB_NT);
    for (int u = bid; u < NSC * 4 * 2; u += nb) {
        const int dvb = (u & 1) * 8 + wid, h = (u >> 1) & 3, sc = u >> 3, s0 = sc * 256;
        f32x4 acc[16];
#pragma unroll
        for (int i = 0; i < 16; ++i) acc[i] = (f32x4){0.f, 0.f, 0.f, 0.f};
        float un[16];
#pragma unroll
        for (int i = 0; i < 16; ++i) un[i] = 0.f;
        for (int ks = 0; ks < 8; ++ks) {
            const int sb = s0 + 32 * ks + 8 * g;
            const f32x4 w0 = *(const f32x4*)(tw + (size_t)h * P + sb), w1 = *(const f32x4*)(tw + (size_t)h * P + sb + 4);
            const u32x4 vv = *(const u32x4*)(VMT + (size_t)(h * 256 + 16 * dvb + c) * P + sb);
            u32x4 vw; vw.x = pk2(bf2f(vv.x & 0xffffu) * w0.x, bf2f(vv.x >> 16) * w0.y); vw.y = pk2(bf2f(vv.y & 0xffffu) * w0.z, bf2f(vv.y >> 16) * w0.w);
            vw.z = pk2(bf2f(vv.z & 0xffffu) * w1.x, bf2f(vv.z >> 16) * w1.y); vw.w = pk2(bf2f(vv.w & 0xffffu) * w1.z, bf2f(vv.w >> 16) * w1.w);
            const bf16x8 vf = *(bf16x8*)&vw;
#pragma unroll
            for (int dk = 0; dk < 16; ++dk) {
                const u32x4 kk = *(const u32x4*)(KMT + (size_t)(h * 256 + 16 * dk + c) * P + sb);
                acc[dk] = mfma16(*(const bf16x8*)&kk, vf, acc[dk]);
                if (dvb == 0) un[dk] += bf2f(kk.x & 0xffffu) * w0.x + bf2f(kk.x >> 16) * w0.y + bf2f(kk.y & 0xffffu) * w0.z + bf2f(kk.y >> 16) * w0.w
                                      + bf2f(kk.z & 0xffffu) * w1.x + bf2f(kk.z >> 16) * w1.y + bf2f(kk.w & 0xffffu) * w1.z + bf2f(kk.w >> 16) * w1.w;
            }
        }
        bf16_t* dst = CT + ((size_t)(sc * 4 + h) * 256 + 16 * dvb + c) * 256;
#pragma unroll
        for (int dk = 0; dk < 16; ++dk) store4_bf16(dst + 16 * dk + 4 * g, acc[dk]);
        if (dvb == 0) {
#pragma unroll
            for (int dk = 0; dk < 16; ++dk) { float v = un[dk]; v += __shfl_xor(v, 16); v += __shfl_xor(v, 32); if (g == 0) NTv[(size_t)(sc * 4 + h) * 256 + 16 * dk + c] = v; }
        }
    }
}

__device__ __forceinline__ void phase_m2(const Params& p, char* lds, int bid, int nb) {
    const float* scg = (const float*)(p.ws + TAB_SCG); const float* scm = (const float*)(p.ws + TAB_SCM);
    unsigned* CT = (unsigned*)(p.ws + B_CT); float* NTv = (float*)(p.ws + TAB_NT); float* mt = (float*)(p.ws + TAB_MT);
    const int gid = bid * NT + TIDX, nth = nb * NT;
    for (int i = gid; i < 4 * 32768 + 1024; i += nth) {
        if (i < 4 * 32768) {
            const int h = i >> 15, idx = i & 32767;
            unsigned* base = CT + (size_t)h * 32768 + idx;
            unsigned u[NSC];
#pragma unroll
            for (int sc = 0; sc < NSC; ++sc) u[sc] = base[(size_t)sc * 4 * 32768];
            float m = 0.f, c0 = 0.f, c1 = 0.f;
#pragma unroll
            for (int sc = 0; sc < NSC; ++sc) {
                const float gg = scg[sc * 4 + h], ml = scm[sc * 4 + h], mn = fmaxf(gg + m, ml), dec = __expf(gg + m - mn), cor = __expf(ml - mn);
                c0 = dec * c0 + cor * bf2f(u[sc] & 0xffffu); c1 = dec * c1 + cor * bf2f(u[sc] >> 16);
                base[(size_t)sc * 4 * 32768] = pk2(c0, c1); m = mn;
            }
        } else {
            const int j = i - 4 * 32768, h = j >> 8, d = j & 255;
            float m = 0.f, n = 0.f;
            for (int sc = 0; sc < NSC; ++sc) {
                const float gg = scg[sc * 4 + h], ml = scm[sc * 4 + h], mn = fmaxf(gg + m, ml), dec = __expf(gg + m - mn), cor = __expf(ml - mn);
                float* ptr = NTv + (size_t)(sc * 4 + h) * 256 + d;
                n = dec * n + cor * *ptr; *ptr = n; m = mn;
                if (d == 0) mt[sc * 4 + h] = mn;
            }
        }
    }
}

__device__ __forceinline__ void phase_m3(const Params& p, int l, char* lds, int bid, int nb) {
    const int tid = TIDX, wid = __builtin_amdgcn_readfirstlane(tid >> 6), lane = tid & 63, c = lane & 15, g = lane >> 4, gw = bid * NW + wid, ngw = nb * NW;
    const bf16_t* QM = (const bf16_t*)(p.ws + B_QM); const bf16_t* KM = (const bf16_t*)(p.ws + B_KM); const bf16_t* VMT = (const bf16_t*)(p.ws + B_VMT);
    const bf16_t* CT = (const bf16_t*)(p.ws + B_CT); const float* NTv = (const float*)(p.ws + TAB_NT); const float* mt = (const float*)(p.ws + TAB_MT);
    const float* tb = (const float*)(p.ws + TAB_B); const float* te = (const float*)(p.ws + TAB_E); const float* tpm = (const float*)(p.ws + TAB_PM);
    const bf16_t* OP = (const bf16_t*)(p.ws + B_OP); bf16_t* YM = (bf16_t*)(p.ws + B_YM);
    constexpr int NRG = P / 16, RG0 = VALID0 / 16;
    const int ntask = (NRG - RG0) * 4;
    for (int u = bid; u < NSC * 4 * 2; u += nb) {
        const int half = u < NSC * 4 ? 1 : 0, uu = u < NSC * 4 ? u : u - NSC * 4, sc = (NSC - 1) - (uu >> 2), h = uu & 3, rg = sc * 16 + half * 8 + wid;
        if (rg < RG0) continue;
        const int t0 = rg * 16, row = t0 + c, s_start = sc << 8;
        bf16x8 qf[8];
#pragma unroll
        for (int ks = 0; ks < 8; ++ks) qf[ks] = ld8(QM + (size_t)row * D + h * 256 + 32 * ks + 8 * g);
        const float b_t = tb[(size_t)h * P + row], pm_t = tpm[(size_t)h * P + row];
        const float m_prev = sc > 0 ? mt[(sc - 1) * 4 + h] : 0.f;
        const float m_t = b_t + fmaxf(m_prev, pm_t), scale_t = __expf(b_t + m_prev - m_t);
        f32x4 acc[16];
#pragma unroll
        for (int i = 0; i < 16; ++i) acc[i] = (f32x4){0.f, 0.f, 0.f, 0.f};
        float den = 0.f;
        if (sc > 0) {
            const bf16_t* Cb = CT + (size_t)((sc - 1) * 4 + h) * 65536; const float* nv = NTv + (size_t)((sc - 1) * 4 + h) * 256;
#pragma unroll 2
            for (int ks = 0; ks < 8; ++ks) {
#pragma unroll
                for (int dt = 0; dt < 16; ++dt) acc[dt] = mfma16(ld8(Cb + (size_t)(16 * dt + c) * 256 + 32 * ks + 8 * g), qf[ks], acc[dt]);
                const f32x4 n0 = *(const f32x4*)(nv + 32 * ks + 8 * g), n1 = *(const f32x4*)(nv + 32 * ks + 8 * g + 4);
                const u32x4 qq = *(const u32x4*)&qf[ks];
                den += bf2f(qq.x & 0xffffu) * n0.x + bf2f(qq.x >> 16) * n0.y + bf2f(qq.y & 0xffffu) * n0.z + bf2f(qq.y >> 16) * n0.w
                     + bf2f(qq.z & 0xffffu) * n1.x + bf2f(qq.z >> 16) * n1.y + bf2f(qq.w & 0xffffu) * n1.z + bf2f(qq.w >> 16) * n1.w;
            }
            den *= scale_t;
#pragma unroll
            for (int dt = 0; dt < 16; ++dt) acc[dt] = acc[dt] * scale_t;
        }
        for (int kb = s_start; kb <= t0 + 15; kb += 32) {
            f32x4 s[2];
#pragma unroll
            for (int a = 0; a < 2; ++a) {
                s[a] = (f32x4){0.f, 0.f, 0.f, 0.f};
                const bf16_t* kr = KM + (size_t)(kb + 16 * a + c) * D + h * 256 + 8 * g;
#pragma unroll
                for (int ks = 0; ks < 8; ++ks) s[a] = mfma16(ld8(kr + 32 * ks), qf[ks], s[a]);
                const f32x4 ee = *(const f32x4*)(te + (size_t)h * P + kb + 16 * a + 4 * g);
#pragma unroll
                for (int r = 0; r < 4; ++r) { const int key = kb + 16 * a + 4 * g + r; const float arg = fminf(ee[r] + b_t - m_t, 0.f);
                    const float dd = key <= row ? __expf(arg) : 0.f; const float pv = s[a][r] * dd; s[a][r] = pv; den += pv; }
            }
            u32x4 w; w.x = pk2(s[0][0], s[0][1]); w.y = pk2(s[0][2], s[0][3]); w.z = pk2(s[1][0], s[1][1]); w.w = pk2(s[1][2], s[1][3]);
            const bf16x8 pf = *(bf16x8*)&w;
#pragma unroll
            for (int dt = 0; dt < 16; ++dt) {
                const bf16_t* vr = VMT + (size_t)(h * 256 + 16 * dt + c) * P + kb + 4 * g;
                const u32x2 v0 = *(const u32x2*)vr, v1 = *(const u32x2*)(vr + 16);
                u32x4 vv; vv.x = v0.x; vv.y = v0.y; vv.z = v1.x; vv.w = v1.y;
                acc[dt] = mfma16(*(bf16x8*)&vv, pf, acc[dt]);
            }
        }
        den += __shfl_xor(den, 16); den += __shfl_xor(den, 32);
        const float inv = 1.f / fmaxf(fabsf(den), __expf(-m_t));
        float s1 = 0.f;
#pragma unroll
        for (int dt = 0; dt < 16; ++dt) {
            const u32x2 og = *(const u32x2*)(OP + (size_t)row * D + h * 256 + 16 * dt + 4 * g);
            f32x4 v = acc[dt] * inv;
            v.x *= sigmoidf_(bf2f(og.x & 0xffffu)); v.y *= sigmoidf_(bf2f(og.x >> 16)); v.z *= sigmoidf_(bf2f(og.y & 0xffffu)); v.w *= sigmoidf_(bf2f(og.y >> 16));
            acc[dt] = v; s1 += (v.x + v.y) + (v.z + v.w);
        }
        s1 += __shfl_xor(s1, 16); s1 += __shfl_xor(s1, 32);
        const float mu = s1 * (1.f / 256.f);
        float s2 = 0.f;
#pragma unroll
        for (int dt = 0; dt < 16; ++dt) { acc[dt] = acc[dt] - mu; s2 += (acc[dt].x * acc[dt].x + acc[dt].y * acc[dt].y) + (acc[dt].z * acc[dt].z + acc[dt].w * acc[dt].w); }
        s2 += __shfl_xor(s2, 16); s2 += __shfl_xor(s2, 32);
        const float rstd = rsqrtf(s2 * (1.f / 256.f) + LN_EPS);
#pragma unroll
        for (int dt = 0; dt < 16; ++dt) { const f32x4 gg = *(const f32x4*)(p.in[I_MNG] + (size_t)l * D + h * 256 + 16 * dt + 4 * g);
            store4_bf16(YM + (size_t)row * D + h * 256 + 16 * dt + 4 * g, acc[dt] * rstd * gg); }
    }
}

struct EpiBr1 { float* MRG; const bf16_t* GA;
    __device__ __forceinline__ void operator()(int m, int n, f32x4 v) const { const u32x2 gg = *(const u32x2*)(GA + (size_t)m * D + n);
        f32x4 o; o.x = v.x * sigmoidf_(bf2f(gg.x & 0xffffu)); o.y = v.y * sigmoidf_(bf2f(gg.x >> 16)); o.z = v.z * sigmoidf_(bf2f(gg.y & 0xffffu)); o.w = v.w * sigmoidf_(bf2f(gg.y >> 16));
        *(f32x4*)(MRG + (size_t)m * D + n) = o; } };
struct EpiBr2 { const float* MRG; const bf16_t* GB; bf16_t* OUT;
    __device__ __forceinline__ void operator()(int m, int n, f32x4 v) const { const u32x2 gg = *(const u32x2*)(GB + (size_t)m * D + n); const f32x4 t = *(const f32x4*)(MRG + (size_t)m * D + n);
        f32x4 o; o.x = t.x + v.x * sigmoidf_(bf2f(gg.x & 0xffffu)); o.y = t.y + v.y * sigmoidf_(bf2f(gg.x >> 16)); o.z = t.z + v.z * sigmoidf_(bf2f(gg.y & 0xffffu)); o.w = t.w + v.w * sigmoidf_(bf2f(gg.y >> 16));
        store4_bf16(OUT + (size_t)m * D + n, o); } };
struct EpiOut { float* Z; const bf16_t* H;
    __device__ __forceinline__ void operator()(int m, int n, f32x4 v) const { const u32x2 hh = *(const u32x2*)(H + (size_t)m * D + n);
        f32x4 o; o.x = v.x + DN_ALPHA * bf2f(hh.x & 0xffffu); o.y = v.y + DN_ALPHA * bf2f(hh.x >> 16); o.z = v.z + DN_ALPHA * bf2f(hh.y & 0xffffu); o.w = v.w + DN_ALPHA * bf2f(hh.y >> 16);
        *(f32x4*)(Z + (size_t)m * D + n) = o; } };
__device__ __forceinline__ void phase_br1(const Params& p, char* lds, int bid, int nb) {
    for (int u = bid; u < 130 * 4; u += nb)
        sgemm_unit(RowsPlain{(const bf16_t*)(p.ws + B_YM), D}, RowsPlain{(const bf16_t*)(p.ws + W_BM_T), D}, D, (u >> 2) * 128, (u & 3) * 256, EpiBr1{(float*)(p.ws + B_MRG), (const bf16_t*)(p.ws + B_GA)});
}
__device__ __forceinline__ void phase_br2(const Params& p, char* lds, int bid, int nb) {
    for (int u = bid; u < 130 * 4; u += nb)
        sgemm_unit(RowsPlain{(const bf16_t*)(p.ws + B_YA), D}, RowsPlain{(const bf16_t*)(p.ws + W_BA_T), D}, D, (u >> 2) * 128, (u & 3) * 256,
                   EpiBr2{(const float*)(p.ws + B_MRG), (const bf16_t*)(p.ws + B_GB), (bf16_t*)(p.ws + B_MRGB)});
}
__device__ __forceinline__ void phase_out(const Params& p, char* lds, int bid, int nb) {
    for (int u = bid; u < 130 * 4; u += nb)
        sgemm_unit(RowsPlain{(const bf16_t*)(p.ws + B_MRGB), D}, RowsPlain{(const bf16_t*)(p.ws + W_OUT_T), D}, D, (u >> 2) * 128, (u & 3) * 256, EpiOut{(float*)(p.ws + B_Z), (const bf16_t*)(p.ws + B_H)});
}

struct SchedMqkvN { const char* XC; const char* WQ; const char* WK; int G, c; int K, lda, ldb;
    __device__ __forceinline__ bool next(int i, pg8::Unit& u) const { if (!pg8::decode_unit((long)i * G + c, 8, 64, 1, u)) return false; u.pm += 1; return true; }
    __device__ __forceinline__ const char* abase(const pg8::Unit& u) const { return XC + (size_t)(u.grp & 3) * 512 + (size_t)u.pm * 256 * D * 2; }
    __device__ __forceinline__ const char* bbase(const pg8::Unit& u) const { return ((u.grp >> 2) ? WK : WQ) + (size_t)(u.grp & 3) * 65536 * 2; } };
struct SchedMqkvT { const char* XC; const char* XM; const char* WK; const char* WV; int G, c; int K, lda, ldb;
    __device__ __forceinline__ bool next(int i, pg8::Unit& u) const { if (!pg8::decode_unit((long)i * G + c, 8, 1, 64, u)) return false; u.pn += 1; return true; }
    __device__ __forceinline__ const char* abase(const pg8::Unit& u) const { return ((u.grp >> 2) ? WV : WK) + (size_t)(u.grp & 3) * 65536 * 2; }
    __device__ __forceinline__ const char* bbase(const pg8::Unit& u) const { return ((u.grp >> 2) ? XM : XC) + (size_t)(u.grp & 3) * 512 + (size_t)u.pn * 256 * D * 2; } };
struct EpiGrpF { bf16_t* base0; bf16_t* base1; size_t hstride; size_t ldc; float s0, s1;
    __device__ __forceinline__ void operator()(const f32x4 (&acc)[2][2][4][2], const pg8::Unit& u, int wr, int wc, int fr, int fq) const {
        const int which = u.grp >> 2, h = u.grp & 3; const float sc = which ? s1 : s0;
        bf16_t* base = (which ? base1 : base0) + (size_t)h * hstride + (size_t)u.pn * 256;
        const size_t ld = ldc;
        pg8::for_each_piece(acc, u, wr, wc, fr, fq, [&](int row, int col, f32x4 v0, f32x4 v1) { *(u32x4*)(base + (size_t)row * ld + col) = pg8::pack8(v0 * sc, v1 * sc); }); } };
__device__ __forceinline__ void phase_mqkv_f(const Params& p, char* lds, int bid, int nb) {
    const int tid = TIDX, wid = tid >> 6, gw = bid * NW + wid, ngw = nb * NW;
    const bf16_t* XC = (const bf16_t*)(p.ws + B_XC); const bf16_t* XM = (const bf16_t*)(p.ws + B_XM);
    const bf16_t* WQ = (const bf16_t*)(p.ws + W_Q_T); const bf16_t* WK = (const bf16_t*)(p.ws + W_K_T); const bf16_t* WV = (const bf16_t*)(p.ws + W_V_T);
    bf16_t* QM = (bf16_t*)(p.ws + B_QM); bf16_t* KM = (bf16_t*)(p.ws + B_KM); bf16_t* KMT = (bf16_t*)(p.ws + B_KMT); bf16_t* VMT = (bf16_t*)(p.ws + B_VMT);
    zero_block(KM, D, VALID0, D, bid * NT + tid, nb * NT);
    zero_block(KMT, P, D, VALID0, bid * NT + tid, nb * NT);
    zero_block(VMT, P, D, VALID0, bid * NT + tid, nb * NT);
    for (int t = gw; t < 64; t += ngw) {
        const int which = (t >> 4) & 1, h = (t >> 2) & 3, q = t & 3;
        if (t < 32) sgemm_wave<1, 4>(RowsPlain{XC + h * 256, D}, RowsPlain{(which ? WK : WQ) + (size_t)h * 65536, 256}, 256, VALID0, q * 64, EpiStore{(which ? KM : QM) + h * 256, D, which ? 0.0625f : 1.f});
        else sgemm_wave<4, 1>(RowsPlain{(which ? WV : WK) + (size_t)h * 65536, 256}, RowsPlain{(which ? XM : XC) + h * 256, D}, 256, q * 64, VALID0, EpiStore{(which ? VMT : KMT) + (size_t)h * 256 * P, P, which ? 1.f : 0.0625f});
    }
    { SchedMqkvN S{(const char*)XC, (const char*)WQ, (const char*)WK, nb, bid, 256, D, 256};
      pg8::gemm_phase((PG8_LAS unsigned char*)lds, S, EpiGrpF{QM, KM, 256, D, 1.f, 0.0625f}); }
    { SchedMqkvT S{(const char*)XC, (const char*)XM, (const char*)WK, (const char*)WV, nb, bid, 256, 256, D};
      pg8::gemm_phase((PG8_LAS unsigned char*)lds, S, EpiGrpF{KMT, VMT, (size_t)256 * P, P, 0.0625f, 1.f}); }
}
struct SchedSq { const char* A; const char* B; int G, c; int K, lda, ldb;
    __device__ __forceinline__ bool next(int i, pg8::Unit& u) const { if (!pg8::decode_unit((long)i * G + c, 1, 64, 4, u)) return false; u.pm += 1; return true; }
    __device__ __forceinline__ const char* abase(const pg8::Unit& u) const { return A + (size_t)u.pm * 256 * D * 2; }
    __device__ __forceinline__ const char* bbase(const pg8::Unit& u) const { return B + (size_t)u.pn * 256 * D * 2; } };
__device__ __forceinline__ f32x4 sig4(f32x4 v) { f32x4 o; o.x = sigmoidf_(v.x); o.y = sigmoidf_(v.y); o.z = sigmoidf_(v.z); o.w = sigmoidf_(v.w); return o; }
struct EpiBr1F { float* MRG; const bf16_t* GA;
    __device__ __forceinline__ void operator()(const f32x4 (&acc)[2][2][4][2], const pg8::Unit& u, int wr, int wc, int fr, int fq) const {
        const int cb = u.pn * 256;
        pg8::for_each_piece(acc, u, wr, wc, fr, fq, [&](int row, int col, f32x4 v0, f32x4 v1) { const size_t idx = (size_t)row * D + cb + col;
            f32x4 g0, g1; pg8::unpack8(*(const u32x4*)(GA + idx), g0, g1);
            *(f32x4*)(MRG + idx) = v0 * sig4(g0); *(f32x4*)(MRG + idx + 4) = v1 * sig4(g1); }); } };
struct EpiBr2F { const float* MRG; const bf16_t* GB; bf16_t* OUT;
    __device__ __forceinline__ void operator()(const f32x4 (&acc)[2][2][4][2], const pg8::Unit& u, int wr, int wc, int fr, int fq) const {
        const int cb = u.pn * 256;
        pg8::for_each_piece(acc, u, wr, wc, fr, fq, [&](int row, int col, f32x4 v0, f32x4 v1) { const size_t idx = (size_t)row * D + cb + col;
            f32x4 g0, g1; pg8::unpack8(*(const u32x4*)(GB + idx), g0, g1);
            const f32x4 t0 = *(const f32x4*)(MRG + idx), t1 = *(const f32x4*)(MRG + idx + 4);
            *(u32x4*)(OUT + idx) = pg8::pack8(t0 + v0 * sig4(g0), t1 + v1 * sig4(g1)); }); } };
struct EpiOutF { float* Z; const bf16_t* H;
    __device__ __forceinline__ void operator()(const f32x4 (&acc)[2][2][4][2], const pg8::Unit& u, int wr, int wc, int fr, int fq) const {
        const int cb = u.pn * 256;
        pg8::for_each_piece(acc, u, wr, wc, fr, fq, [&](int row, int col, f32x4 v0, f32x4 v1) { const size_t idx = (size_t)row * D + cb + col;
            f32x4 h0, h1; pg8::unpack8(*(const u32x4*)(H + idx), h0, h1);
            *(f32x4*)(Z + idx) = v0 + h0 * DN_ALPHA; *(f32x4*)(Z + idx + 4) = v1 + h1 * DN_ALPHA; }); } };
__device__ __forceinline__ void phase_br1_f(const Params& p, char* lds, int bid, int nb) {
    const int gw = bid * NW + (TIDX >> 6), ngw = nb * NW;
    const bf16_t* A = (const bf16_t*)(p.ws + B_YM); const bf16_t* W = (const bf16_t*)(p.ws + W_BM_T);
    for (int t = gw; t < 16; t += ngw) sgemm_wave<1, 4>(RowsPlain{A, D}, RowsPlain{W, D}, D, VALID0, t * 64, EpiBr1{(float*)(p.ws + B_MRG), (const bf16_t*)(p.ws + B_GA)});
    SchedSq S{(const char*)A, (const char*)W, nb, bid, D, D, D};
    pg8::gemm_phase((PG8_LAS unsigned char*)lds, S, EpiBr1F{(float*)(p.ws + B_MRG), (const bf16_t*)(p.ws + B_GA)});
}
__device__ __forceinline__ void phase_br2_f(const Params& p, char* lds, int bid, int nb) {
    const int gw = bid * NW + (TIDX >> 6), ngw = nb * NW;
    const bf16_t* A = (const bf16_t*)(p.ws + B_YA); const bf16_t* W = (const bf16_t*)(p.ws + W_BA_T);
    for (int t = gw; t < 16; t += ngw) sgemm_wave<1, 4>(RowsPlain{A, D}, RowsPlain{W, D}, D, VALID0, t * 64, EpiBr2{(const float*)(p.ws + B_MRG), (const bf16_t*)(p.ws + B_GB), (bf16_t*)(p.ws + B_MRGB)});
    SchedSq S{(const char*)A, (const char*)W, nb, bid, D, D, D};
    pg8::gemm_phase((PG8_LAS unsigned char*)lds, S, EpiBr2F{(const float*)(p.ws + B_MRG), (const bf16_t*)(p.ws + B_GB), (bf16_t*)(p.ws + B_MRGB)});
}
__device__ __forceinline__ void phase_out_f(const Params& p, char* lds, int bid, int nb) {
    const int gw = bid * NW + (TIDX >> 6), ngw = nb * NW;
    const bf16_t* A = (const bf16_t*)(p.ws + B_MRGB); const bf16_t* W = (const bf16_t*)(p.ws + W_OUT_T);
    for (int t = gw; t < 16; t += ngw) sgemm_wave<1, 4>(RowsPlain{A, D}, RowsPlain{W, D}, D, VALID0, t * 64, EpiOut{(float*)(p.ws + B_Z), (const bf16_t*)(p.ws + B_H)});
    SchedSq S{(const char*)A, (const char*)W, nb, bid, D, D, D};
    pg8::gemm_phase((PG8_LAS unsigned char*)lds, S, EpiOutF{(float*)(p.ws + B_Z), (const bf16_t*)(p.ws + B_H)});
}

__device__ __forceinline__ void phase_ln1(const Params& p, int l, char* lds, int bid, int nb) {
    const int tid = TIDX, wid = tid >> 6, lane = tid & 63, gw = bid * NW + wid, ngw = nb * NW;
    float* wr = (float*)lds;
    for (int i = tid; i < D * 16 / 4; i += NT) ((f32x4*)wr)[i] = ((const f32x4*)p.in[I_WR])[i];
    __syncthreads();
    const float* Z = (const float*)(p.ws + B_Z); bf16_t* H1 = (bf16_t*)(p.ws + B_H1);
    unsigned* cnt = (unsigned*)(p.ws + WS_CTL) + CW_CNT + l * 16; int* elist = (int*)(p.ws + TAB_ELIST); float* topk = (float*)(p.ws + TAB_TOPK);
    for (int r = gw; r < P; r += ngw) {
        if (r < VALID0) { store_row_zero(H1 + (size_t)r * D, lane); continue; }
        f32x4 v[4];
#pragma unroll
        for (int j = 0; j < 4; ++j) v[j] = *(const f32x4*)(Z + (size_t)r * D + 4 * lane + 256 * j);
        ln_normalize(v, p.in[I_LN1G] + (size_t)l * D, p.in[I_LN1B] + (size_t)l * D, lane);
        store_row_bf16(H1 + (size_t)r * D, v, lane);
        float lg[16];
#pragma unroll
        for (int e = 0; e < 16; ++e) lg[e] = 0.f;
#pragma unroll
        for (int j = 0; j < 4; ++j)
#pragma unroll
            for (int i = 0; i < 4; ++i) { const int k = 4 * lane + 256 * j + i; const float x = v[j][i];
#pragma unroll
                for (int q = 0; q < 4; ++q) { const f32x4 w = *(const f32x4*)(wr + k * 16 + 4 * q); lg[4 * q] += x * w.x; lg[4 * q + 1] += x * w.y; lg[4 * q + 2] += x * w.z; lg[4 * q + 3] += x * w.w; } }
#pragma unroll
        for (int e = 0; e < 16; ++e) lg[e] = wave_sum(lg[e]);
        if (lane == 0) {
            float mx = lg[0];
#pragma unroll
            for (int e = 1; e < 16; ++e) mx = fmaxf(mx, lg[e]);
            float pr[16], sum = 0.f;
#pragma unroll
            for (int e = 0; e < 16; ++e) { pr[e] = expf(lg[e] - mx); sum += pr[e]; }
            const float isum = 1.f / sum;
            float sel[16];
#pragma unroll
            for (int e = 0; e < 16; ++e) { pr[e] *= isum; sel[e] = pr[e] + p.in[I_RB][e]; }
            int tg = 0; float best = -INFINITY;
#pragma unroll
            for (int gI = 0; gI < 4; ++gI) { const float gs = fmaxf(fmaxf(sel[4 * gI], sel[4 * gI + 1]), fmaxf(sel[4 * gI + 2], sel[4 * gI + 3])); if (gs > best) { best = gs; tg = gI; } }
            int i0 = 0; float b0 = -INFINITY;
#pragma unroll
            for (int e = 0; e < 16; ++e) if ((e >> 2) == tg && sel[e] > b0) { b0 = sel[e]; i0 = e; }
            int i1 = 0; float b1 = -INFINITY;
#pragma unroll
            for (int e = 0; e < 16; ++e) if ((e >> 2) == tg && e != i0 && sel[e] > b1) { b1 = sel[e]; i1 = e; }
            float p0 = 0.f, p1 = 0.f;
#pragma unroll
            for (int e = 0; e < 16; ++e) { if (e == i0) p0 = pr[e]; if (e == i1) p1 = pr[e]; }
            const float inv = 1.f / (p0 + p1);
            const unsigned pos0 = atomicAdd(cnt + i0, 1u), pos1 = atomicAdd(cnt + i1, 1u);
            elist[(size_t)i0 * P + pos0] = r; elist[(size_t)i1 * P + pos1] = r;
            float* tk = topk + (size_t)r * 8;
            ((int*)tk)[0] = i0; ((int*)tk)[1] = i1; ((int*)tk)[2] = (int)pos0; ((int*)tk)[3] = (int)pos1; tk[4] = p0 * inv; tk[5] = p1 * inv;
        }
    }
}

__device__ __forceinline__ void expert_offsets(const unsigned* cnt, int* s_cnt, int* s_off, int* s_tiles) {
    int off = 0;
    if (TIDX == 0) { int tt = 0; for (int e = 0; e < 16; ++e) { const int c = (int)cnt[e]; const int tl = (c + 255) >> 8; s_cnt[e] = c; s_off[e] = off; s_tiles[e] = tt; off += tl * 256; tt += tl; } s_tiles[16] = tt; }
    __syncthreads();
}
__device__ __forceinline__ void phase_e1(const Params& p, int l, char* lds, int bid, int nb) {
    int* s_cnt = (int*)lds; int* s_off = s_cnt + 16; int* s_tiles = s_off + 16;
    expert_offsets((const unsigned*)(p.ws + WS_CTL) + CW_CNT + l * 16, s_cnt, s_off, s_tiles);
    const int tid = TIDX, wid = tid >> 6, lane = tid & 63, c = lane & 15, g = lane >> 4, wr = wid >> 2, wc = wid & 3;
    const bf16_t* H1 = (const bf16_t*)(p.ws + B_H1); const int* elist = (const int*)(p.ws + TAB_ELIST); bf16_t* HID = (bf16_t*)(p.ws + B_HID);
    const int total = s_tiles[16] * 8;
    for (int u = bid; u < total; u += nb) {
        const int rt = u >> 3, ct = u & 7; int e = 0;
        while (e < 15 && rt >= s_tiles[e + 1]) ++e;
        const int ti = rt - s_tiles[e], cntE = s_cnt[e], r0 = ti * 128 + 64 * wr, n0 = ct * 128 + 32 * wc;
        const bf16_t* Wg = (const bf16_t*)(p.ws + W_G_T) + (size_t)e * D * D; const bf16_t* Wu = (const bf16_t*)(p.ws + W_U_T) + (size_t)e * D * D;
        const bf16_t* ap[4];
#pragma unroll
        for (int i = 0; i < 4; ++i) { const int rr = r0 + 16 * i + c; const int tok = elist[(size_t)e * P + (rr < cntE ? rr : 0)]; ap[i] = H1 + (size_t)tok * D + 8 * g; }
        const bf16_t* gp[2]; const bf16_t* up[2];
#pragma unroll
        for (int j = 0; j < 2; ++j) { gp[j] = Wg + (size_t)(n0 + 16 * j + c) * D + 8 * g; up[j] = Wu + (size_t)(n0 + 16 * j + c) * D + 8 * g; }
        f32x4 ag[4][2], au[4][2];
#pragma unroll
        for (int i = 0; i < 4; ++i)
#pragma unroll
            for (int j = 0; j < 2; ++j) { ag[i][j] = (f32x4){0.f, 0.f, 0.f, 0.f}; au[i][j] = (f32x4){0.f, 0.f, 0.f, 0.f}; }
        for (int k0 = 0; k0 < D; k0 += 32) {
            bf16x8 a[4], bg[2], bu[2];
#pragma unroll
            for (int i = 0; i < 4; ++i) a[i] = ld8(ap[i] + k0);
#pragma unroll
            for (int j = 0; j < 2; ++j) { bg[j] = ld8(gp[j] + k0); bu[j] = ld8(up[j] + k0); }
#pragma unroll
            for (int i = 0; i < 4; ++i)
#pragma unroll
                for (int j = 0; j < 2; ++j) { ag[i][j] = mfma16(bg[j], a[i], ag[i][j]); au[i][j] = mfma16(bu[j], a[i], au[i][j]); }
        }
#pragma unroll
        for (int i = 0; i < 4; ++i)
#pragma unroll
            for (int j = 0; j < 2; ++j) { f32x4 o;
#pragma unroll
                for (int r = 0; r < 4; ++r) o[r] = siluf_(ag[i][j][r]) * au[i][j][r];
                store4_bf16(HID + (size_t)(s_off[e] + r0 + 16 * i + c) * D + n0 + 16 * j + 4 * g, o); }
    }
}
__device__ __forceinline__ void phase_e2(const Params& p, int l, char* lds, int bid, int nb) {
    int* s_cnt = (int*)lds; int* s_off = s_cnt + 16; int* s_tiles = s_off + 16;
    expert_offsets((const unsigned*)(p.ws + WS_CTL) + CW_CNT + l * 16, s_cnt, s_off, s_tiles);
    const bf16_t* HID = (const bf16_t*)(p.ws + B_HID); bf16_t* YB = (bf16_t*)(p.ws + B_YB);
    const int total = s_tiles[16] * 4;
    for (int u = bid; u < total; u += nb) {
        const int rt = u >> 2, ct = u & 3; int e = 0;
        while (e < 15 && rt >= s_tiles[e + 1]) ++e;
        const int ti = rt - s_tiles[e];
        sgemm_unit(RowsPlain{HID + (size_t)s_off[e] * D, D}, RowsPlain{(const bf16_t*)(p.ws + W_D_T) + (size_t)e * D * D, D}, D, ti * 128, ct * 256, EpiStore{YB + (size_t)s_off[e] * D, D, 1.f});
    }
}
constexpr int LDS_TAB_OFF = 131072;
__device__ __forceinline__ void phase_perm(const Params& p, int l, char* lds, int bid, int nb) {
    int* s_cnt = (int*)(lds + LDS_TAB_OFF); int* s_off = s_cnt + 16; int* s_tiles = s_off + 16;
    expert_offsets((const unsigned*)(p.ws + WS_CTL) + CW_CNT + l * 16, s_cnt, s_off, s_tiles);
    const int tid = TIDX, wid = tid >> 6, lane = tid & 63, gw = bid * NW + wid, ngw = nb * NW;
    const bf16_t* H1 = (const bf16_t*)(p.ws + B_H1); bf16_t* XP = (bf16_t*)(p.ws + B_XP); const float* topk = (const float*)(p.ws + TAB_TOPK);
    for (int r = VALID0 + gw; r < P; r += ngw) {
        const int* tk = (const int*)(topk + (size_t)r * 8);
        const int e0 = tk[0], e1 = tk[1], p0 = tk[2], p1 = tk[3];
        const u32x4* src = (const u32x4*)(H1 + (size_t)r * D) + lane * 2;
        const u32x4 a = src[0], b = src[1];
        u32x4* d0 = (u32x4*)(XP + (size_t)(s_off[e0] + p0) * D) + lane * 2; u32x4* d1 = (u32x4*)(XP + (size_t)(s_off[e1] + p1) * D) + lane * 2;
        d0[0] = a; d0[1] = b; d1[0] = a; d1[1] = b;
    }
}
struct SchedMoE { const char* A; const char* B; size_t estride; int nN; const int* s_off; const int* s_tiles; int G, c; int K, lda, ldb;
    __device__ __forceinline__ bool next(int i, pg8::Unit& u) const {
        const int nwg = s_tiles[16] * nN; const long L = (long)i * G + c; if (L >= nwg) return false;
        int wgid = (int)L; { const int q = nwg / 8, r = nwg % 8, xcd = wgid % 8, off = wgid / 8; wgid = (xcd < r ? xcd * (q + 1) : r * (q + 1) + (xcd - r) * q) + off; }
        const int rt = wgid / nN; int e = 0;
        while (e < 15 && rt >= s_tiles[e + 1]) ++e;
        u.grp = __builtin_amdgcn_readfirstlane(e); u.pm = __builtin_amdgcn_readfirstlane((s_off[e] >> 8) + rt - s_tiles[e]); u.pn = __builtin_amdgcn_readfirstlane(wgid % nN); return true; }
    __device__ __forceinline__ const char* abase(const pg8::Unit& u) const { return A + (size_t)u.pm * 256 * D * 2; }
    __device__ __forceinline__ const char* bbase(const pg8::Unit& u) const { return B + (size_t)u.grp * estride + (size_t)u.pn * 256 * D * 2; } };
struct EpiE1F { bf16_t* HID;
    __device__ __forceinline__ void operator()(const f32x4 (&acc)[2][2][4][2], const pg8::Unit& u, int wr, int wc, int fr, int fq) const {
        const int row0 = u.pm * 256 + wr * 64 + fr, col0 = u.pn * 128 + wc * 32 + 8 * fq;
#pragma unroll
        for (int ai = 0; ai < 2; ++ai)
#pragma unroll
            for (int m = 0; m < 4; ++m) { f32x4 h0, h1;
#pragma unroll
                for (int r = 0; r < 4; ++r) { h0[r] = siluf_(acc[ai][0][m][0][r]) * acc[ai][1][m][0][r]; h1[r] = siluf_(acc[ai][0][m][1][r]) * acc[ai][1][m][1][r]; }
                *(u32x4*)(HID + (size_t)(row0 + ai * 128 + m * 16) * D + col0) = pg8::pack8(h0, h1); } } };
struct EpiE2F { bf16_t* YB;
    __device__ __forceinline__ void operator()(const f32x4 (&acc)[2][2][4][2], const pg8::Unit& u, int wr, int wc, int fr, int fq) const {
        bf16_t* base = YB + u.pn * 256;
        pg8::for_each_piece(acc, u, wr, wc, fr, fq, [&](int row, int col, f32x4 v0, f32x4 v1) { *(u32x4*)(base + (size_t)row * D + col) = pg8::pack8(v0, v1); }); } };
__device__ __forceinline__ void phase_e1_f(const Params& p, int l, char* lds, int bid, int nb) {
    int* s_cnt = (int*)(lds + LDS_TAB_OFF); int* s_off = s_cnt + 16; int* s_tiles = s_off + 16;
    expert_offsets((const unsigned*)(p.ws + WS_CTL) + CW_CNT + l * 16, s_cnt, s_off, s_tiles);
    SchedMoE S{(const char*)(p.ws + B_XP), (const char*)(p.ws + W_G_T), (size_t)2048 * D * 2, 8, s_off, s_tiles, nb, bid, D, D, D};
    pg8::gemm_phase((PG8_LAS unsigned char*)lds, S, EpiE1F{(bf16_t*)(p.ws + B_HID)});
}
__device__ __forceinline__ void phase_e2_f(const Params& p, int l, char* lds, int bid, int nb) {
    int* s_cnt = (int*)(lds + LDS_TAB_OFF); int* s_off = s_cnt + 16; int* s_tiles = s_off + 16;
    expert_offsets((const unsigned*)(p.ws + WS_CTL) + CW_CNT + l * 16, s_cnt, s_off, s_tiles);
    SchedMoE S{(const char*)(p.ws + B_HID), (const char*)(p.ws + W_D_T), (size_t)D * D * 2, 4, s_off, s_tiles, nb, bid, D, D, D};
    pg8::gemm_phase((PG8_LAS unsigned char*)lds, S, EpiE2F{(bf16_t*)(p.ws + B_YB)});
}

__device__ __forceinline__ void phase_combine(const Params& p, int l, char* lds, int bid, int nb) {
    const int tid = TIDX, wid = tid >> 6, lane = tid & 63, gw = bid * NW + wid, ngw = nb * NW;
    const bool last = (l == DEPTH - 1);
    if (!last) { convert_weights(p, l + 1, lds, gw, ngw, wid, lane); __syncthreads(); }
    int* s_cnt = (int*)(lds + 65536); int* s_off = s_cnt + 16; int* s_tiles = s_off + 16;
    expert_offsets((const unsigned*)(p.ws + WS_CTL) + CW_CNT + l * 16, s_cnt, s_off, s_tiles);
    float* g8 = (float*)lds;
    if (!last) load_gate_w(p, l + 1, g8);
    const bf16_t* H1 = (const bf16_t*)(p.ws + B_H1); const bf16_t* YB = (const bf16_t*)(p.ws + B_YB); bf16_t* H = (bf16_t*)(p.ws + B_H);
    const float* topk = (const float*)(p.ws + TAB_TOPK);
    for (int r = gw; r < P; r += ngw) {
        if (r < VALID0) { if (!last) { store_row_zero(H + (size_t)r * D, lane); gates_row_pad(p, r, lane); } continue; }
        if (last && r < 256) continue;
        const float* tk = topk + (size_t)r * 8;
        const int e0 = ((const int*)tk)[0], e1 = ((const int*)tk)[1], p0 = ((const int*)tk)[2], p1 = ((const int*)tk)[3]; const float w0 = tk[4], w1 = tk[5];
        const bf16_t* y0 = YB + (size_t)(s_off[e0] + p0) * D; const bf16_t* y1 = YB + (size_t)(s_off[e1] + p1) * D; const bf16_t* hr = H1 + (size_t)r * D;
        f32x4 v[4];
#pragma unroll
        for (int j = 0; j < 4; ++j) { const int cc = 4 * lane + 256 * j; const u32x2 a = *(const u32x2*)(y0 + cc), b = *(const u32x2*)(y1 + cc), hh = *(const u32x2*)(hr + cc);
            v[j].x = DN_ALPHA * bf2f(hh.x & 0xffffu) + w0 * bf2f(a.x & 0xffffu) + w1 * bf2f(b.x & 0xffffu);
            v[j].y = DN_ALPHA * bf2f(hh.x >> 16) + w0 * bf2f(a.x >> 16) + w1 * bf2f(b.x >> 16);
            v[j].z = DN_ALPHA * bf2f(hh.y & 0xffffu) + w0 * bf2f(a.y & 0xffffu) + w1 * bf2f(b.y & 0xffffu);
            v[j].w = DN_ALPHA * bf2f(hh.y >> 16) + w0 * bf2f(a.y >> 16) + w1 * bf2f(b.y >> 16); }
        ln_normalize(v, p.in[I_LN2G] + (size_t)l * D, p.in[I_LN2B] + (size_t)l * D, lane);
        if (last) {
            float* o = p.out + (size_t)(r - 256) * D;
#pragma unroll
            for (int j = 0; j < 4; ++j) *(f32x4*)(o + 4 * lane + 256 * j) = v[j];
        } else { store_row_bf16(H + (size_t)r * D, v, lane); gates_row(p, l + 1, g8, v, r, lane); }
    }
}

#define XB_TMO      128
#define XB_XCNT(j)  (256  + 64 * (j))
#define XB_XSUB(j)  (1280 + 64 * (j))
#define XB_XGEN(j)  (2304 + 64 * (j))
#define XB_TOP      3328
#define XB_TOPGEN   3392
#define XCD_BAR_WORDS 3456
#define XB_SPIN_CAP (1u << 18)
#define LAS __attribute__((address_space(3)))

__device__ __forceinline__ unsigned xb_ld(unsigned* p)              { return __hip_atomic_load(p, __ATOMIC_RELAXED, __HIP_MEMORY_SCOPE_AGENT); }
__device__ __forceinline__ unsigned xb_add(unsigned* p, unsigned v) { return __hip_atomic_fetch_add(p, v, __ATOMIC_RELAXED, __HIP_MEMORY_SCOPE_AGENT); }
__device__ __forceinline__ unsigned xb_xcc_id() { return (unsigned)__builtin_amdgcn_s_getreg((3 << 11) | 20) & 0xFu; }
#define XB_SPIN(cond, bar) do { unsigned _sp = 0; while (cond) { __builtin_amdgcn_s_sleep(1); \
    if ((++_sp & 255u) == 0u) { if (xb_ld(&(bar)[XB_TMO])) break; if (_sp > XB_SPIN_CAP) { atomicAdd(&(bar)[XB_TMO], 1u); break; } } } } while (0)

struct XcdBarrier {
    unsigned* bar; unsigned x;
    volatile LAS unsigned* st;
};
__device__ __forceinline__ XcdBarrier xcd_barrier_post(unsigned* bar, volatile LAS unsigned* st) {
    XcdBarrier b; b.bar = bar; b.x = xb_xcc_id(); b.st = st;
    if (threadIdx.x == 0) (void)xb_add(&bar[XB_XCNT(b.x)], 1u);
    return b;
}
__device__ __forceinline__ void xcd_barrier_complete(unsigned* bar, unsigned x, unsigned& nloc, unsigned& nx) {
    const unsigned G = gridDim.x * gridDim.y * gridDim.z;
    unsigned sum, cnt, mine, sp = 0u;
    for (;;) {
        sum = 0u; cnt = 0u; mine = 0u;
#pragma unroll
        for (unsigned j = 0; j < 16; ++j) { const unsigned c = xb_ld(&bar[XB_XCNT(j)]); sum += c; cnt += (c > 0u) ? 1u : 0u; mine = (j == x) ? c : mine; }
        if (sum == G) break;
        __builtin_amdgcn_s_sleep(1);
        if ((++sp & 255u) == 0u) { if (xb_ld(&bar[XB_TMO])) break; if (sp > XB_SPIN_CAP) { atomicAdd(&bar[XB_TMO], 1u); break; } }
    }
    nloc = mine > 0u ? mine : 1u; nx = cnt > 0u ? cnt : 1u;
}
__device__ __forceinline__ void xcd_barrier(const XcdBarrier& b) {
    asm volatile("s_waitcnt vmcnt(0)" ::: "memory");
    __syncthreads();
    if (threadIdx.x == 0) {
        unsigned* bar = b.bar;
        __builtin_amdgcn_s_waitcnt(0);
        unsigned nloc = b.st[0], nx = b.st[1];
        if (nloc == 0u) { xcd_barrier_complete(bar, b.x, nloc, nx); b.st[0] = nloc; b.st[1] = nx; }
        const unsigned old = xb_add(&bar[XB_XSUB(b.x)], 1u);
        const unsigned gen = old / nloc;
        if (old + 1u == (gen + 1u) * nloc) {
            __builtin_amdgcn_fence(__ATOMIC_RELEASE, "agent");
            asm volatile("s_waitcnt vmcnt(0)" ::: "memory");
            const unsigned og = xb_add(&bar[XB_TOP], 1u);
            const unsigned tg = og / nx;
            if (og + 1u == (tg + 1u) * nx) xb_add(&bar[XB_TOPGEN], 1u);
            else XB_SPIN(xb_ld(&bar[XB_TOPGEN]) == tg, bar);
            __builtin_amdgcn_fence(__ATOMIC_ACQUIRE, "agent");
            xb_add(&bar[XB_XGEN(b.x)], 1u);
            asm volatile("s_waitcnt vmcnt(0)" ::: "memory");
        } else {
            XB_SPIN(xb_ld(&bar[XB_XGEN(b.x)]) == gen, bar);
            __builtin_amdgcn_fence(__ATOMIC_ACQUIRE, "agent");
            asm volatile("s_waitcnt vmcnt(0)" ::: "memory");
        }
    }
    __syncthreads();
}

constexpr int LDS_BYTES = 131072 + 1024;
constexpr int LDS_BAR_OFF = LDS_BYTES - 16;
constexpr int CW_BAR = 4096;
template <int L>
__device__ __forceinline__ void layer_body(const Params& p, char* lds, int bid, int nb, const XcdBarrier& bar) {
    phase_proj_f(p, lds, bid, nb); xcd_barrier(bar);
    phase_attn_f(p, L, lds, bid, nb); xcd_barrier(bar);
    phase_conv(p, L, lds, bid, nb); xcd_barrier(bar);
    phase_mqkv_f(p, lds, bid, nb); xcd_barrier(bar);
    phase_m1(p, lds, bid, nb); xcd_barrier(bar);
    phase_m2(p, lds, bid, nb); xcd_barrier(bar);
    phase_m3(p, L, lds, bid, nb); xcd_barrier(bar);
    phase_br1_f(p, lds, bid, nb); xcd_barrier(bar);
    phase_br2_f(p, lds, bid, nb); xcd_barrier(bar);
    phase_out_f(p, lds, bid, nb); xcd_barrier(bar);
    phase_ln1(p, L, lds, bid, nb); xcd_barrier(bar);
    phase_perm(p, L, lds, bid, nb); xcd_barrier(bar);
    phase_e1_f(p, L, lds, bid, nb); xcd_barrier(bar);
    phase_e2_f(p, L, lds, bid, nb); xcd_barrier(bar);
    phase_combine(p, L, lds, bid, nb); if (L + 1 < DEPTH) xcd_barrier(bar);
}
__global__ void __launch_bounds__(NT, 2) fwd_kernel(Params p) {
    extern __shared__ __attribute__((aligned(16))) char lds[];
    const int bid = blockIdx.x, nb = gridDim.x;
    if (threadIdx.x == 0) *(uint4*)(lds + LDS_BAR_OFF) = make_uint4(0u, 0u, 0u, 0u);
    __syncthreads();
    XcdBarrier bar = xcd_barrier_post((unsigned*)(p.ws + WS_CTL) + CW_BAR, (volatile LAS unsigned*)(lds + LDS_BAR_OFF));
    phase_prologue(p, lds, bid, nb); xcd_barrier(bar);
    layer_body<0>(p, lds, bid, nb, bar);
    layer_body<1>(p, lds, bid, nb, bar);
}

extern "C" void kernel_launch(void* const* d_in, const int* in_sizes, int n_in, void* d_out, int out_size, void* d_ws, size_t ws_size, hipStream_t stream) {
    if (n_in != 30 || ws_size < WS_END) { fprintf(stderr, "kernel_launch: unexpected n_in %d or ws_size %zu (< %zu)\n", n_in, ws_size, (size_t)WS_END); return; }
    static int grid = 0;
    if (grid == 0) {
        int dev = 0, cus = 0;
        if (hipGetDevice(&dev) != hipSuccess || hipDeviceGetAttribute(&cus, hipDeviceAttributeMultiprocessorCount, dev) != hipSuccess || cus <= 0) cus = 256;
        (void)hipFuncSetAttribute((const void*)fwd_kernel, hipFuncAttributeMaxDynamicSharedMemorySize, LDS_BYTES);
        grid = cus;
    }
    Params p{};
    for (int i = 0; i < 30; ++i) p.in[i] = (const float*)d_in[i];
    p.out = (float*)d_out; p.ws = (unsigned char*)d_ws;
    (void)hipMemsetAsync((char*)d_ws + WS_CTL, 0, CTL_BYTES, stream);
    hipLaunchKernelGGL(fwd_kernel, dim3(grid), dim3(NT), LDS_BYTES, stream, p);
}
```

```cpp
#include <hip/hip_runtime.h>
#include <cstdio>
#include <cstdint>

constexpr int D = 1024;
constexpr int SEQ = 16384;
constexpr int NMETA = 16;
constexpr int P = 16640;
constexpr int VALID0 = 240;
constexpr int DEPTH = 2;
constexpr int DIN = 7176;
constexpr int NSC = 65;
constexpr int NEXP = 16;
constexpr float LN_EPS = 1e-5f;
constexpr float DN_ALPHA = 1.4142135623730951f;
constexpr float NEGBIG = -1e30f;
constexpr int NT = 512;
constexpr int NW = 8;

typedef unsigned short bf16_t;
typedef short bf16x8 __attribute__((ext_vector_type(8)));
typedef float f32x4 __attribute__((ext_vector_type(4)));
typedef unsigned u32x4 __attribute__((ext_vector_type(4)));
typedef unsigned u32x2 __attribute__((ext_vector_type(2)));

constexpr size_t MiB = 1u << 20;
constexpr size_t RB = (size_t)P * D * 2;
constexpr size_t WS_CTL = 0;
constexpr size_t CTL_BYTES = 1 * MiB;
constexpr size_t WS_TAB = 1 * MiB;
constexpr size_t TAB_GLI = WS_TAB;
constexpr size_t TAB_GLF = TAB_GLI + 4 * P * 4;
constexpr size_t TAB_B   = TAB_GLF + 4 * P * 4;
constexpr size_t TAB_E   = TAB_B + 4 * P * 4;
constexpr size_t TAB_PM  = TAB_E + 4 * P * 4;
constexpr size_t TAB_W   = TAB_PM + 4 * P * 4;
constexpr size_t TAB_SCG = TAB_W + 4 * P * 4;
constexpr size_t TAB_SCM = TAB_SCG + 4096;
constexpr size_t TAB_MT  = TAB_SCM + 4096;
constexpr size_t TAB_NT  = TAB_MT + 4096;
constexpr size_t TAB_TOPK = TAB_NT + (size_t)NSC * 4 * 256 * 4;
constexpr size_t TAB_ELIST = TAB_TOPK + (size_t)P * 32;
constexpr size_t TAB_DENP = TAB_ELIST + (size_t)NEXP * P * 4;
constexpr size_t TAB_DENI = TAB_DENP + (size_t)P * 16 * 4;
constexpr size_t TAB_END = TAB_DENI + (size_t)P * 4 * 4;
static_assert(TAB_END <= 8 * MiB, "tables");
constexpr size_t WS_W = 8 * MiB;
constexpr size_t W_IN_T = WS_W;
constexpr size_t W_Q_T = W_IN_T + (size_t)7168 * 1024 * 2;
constexpr size_t W_K_T = W_Q_T + 4 * 65536 * 2;
constexpr size_t W_V_T = W_K_T + 4 * 65536 * 2;
constexpr size_t W_BM_T = W_V_T + 4 * 65536 * 2;
constexpr size_t W_BA_T = W_BM_T + (size_t)D * D * 2;
constexpr size_t W_OUT_T = W_BA_T + (size_t)D * D * 2;
constexpr size_t W_G_T = W_OUT_T + (size_t)D * D * 2;
constexpr size_t W_U_T = W_G_T + (size_t)NEXP * D * D * 2;
constexpr size_t W_D_T = W_U_T + (size_t)NEXP * D * D * 2;
constexpr size_t W_END = W_D_T + (size_t)NEXP * D * D * 2;
static_assert(W_END <= 128 * MiB, "weights");
constexpr size_t WS_SLOT = 128 * MiB;
constexpr size_t SLOT(int i) { return WS_SLOT + (size_t)i * RB; }
constexpr size_t WS_END = WS_SLOT + 12 * RB;
constexpr size_t B_H = SLOT(0);
constexpr size_t B_XM = SLOT(1), B_PM = SLOT(1);
constexpr size_t B_OP = SLOT(2), B_MRGB = SLOT(2);
constexpr size_t B_QA = SLOT(3), B_QM = SLOT(3), B_MRG = SLOT(3);
constexpr size_t B_KA = SLOT(4), B_XC = SLOT(4), B_CT = SLOT(4);
constexpr size_t B_KM = SLOT(5), B_OI = SLOT(5), B_H1 = SLOT(5);
constexpr size_t B_GA = SLOT(6);
constexpr size_t B_GB = SLOT(7);
constexpr size_t B_YA = SLOT(8);
constexpr size_t B_KMT = SLOT(9), B_YM = SLOT(9);
constexpr size_t B_VA = SLOT(10), B_VMT = SLOT(10);
constexpr size_t B_VWT = SLOT(11);
constexpr size_t B_Z = SLOT(10);
constexpr size_t B_HID = SLOT(6);
constexpr size_t B_XP = SLOT(1);
constexpr size_t B_YB = SLOT(9);
constexpr int HID_ROWS_MAX = (int)(3 * RB / (D * 2));
constexpr int CW_CNT = 64;

struct Params {
    const float* in[30];
    float* out;
    unsigned char* ws;
};
enum { I_X = 0, I_META, I_LNG, I_LNB, I_WIN, I_CONVW, I_CONVB, I_WQM, I_WKM, I_WVM, I_BI, I_BF, I_MNG, I_LQ1, I_LK1, I_LQ2, I_LK2, I_ANG,
       I_WBM, I_WBA, I_WOUT, I_LN1G, I_LN1B, I_LN2G, I_LN2B, I_WR, I_RB, I_WG, I_WU, I_WD };

__device__ __forceinline__ int tid_opaque() { int t = threadIdx.x; asm volatile("" : "+v"(t)); return t; }
#define TIDX tid_opaque()
__device__ __forceinline__ float bf2f(unsigned v) { return __uint_as_float(v << 16); }
__device__ __forceinline__ unsigned f2bf(float f) { unsigned u = __float_as_uint(f); return (u + 0x7fffu + ((u >> 16) & 1u)) >> 16; }
__device__ __forceinline__ unsigned pk2(float lo, float hi) { return f2bf(lo) | (f2bf(hi) << 16); }
template <int M> __device__ __forceinline__ float sx(float v) {
    static_assert(M == 1 || M == 2 || M == 4 || M == 8 || M == 16, "sx: xor mask within 32 lanes");
    return __int_as_float(__builtin_amdgcn_ds_swizzle(__float_as_int(v), 0x1f | (M << 10)));
}
__device__ __forceinline__ float sum32(float v) {
    auto rr = __builtin_amdgcn_permlane32_swap(__float_as_uint(v), __float_as_uint(v), false, false);
    return __uint_as_float(rr[0]) + __uint_as_float(rr[1]);
}
__device__ __forceinline__ float wave_sum(float v) {
    v += sx<1>(v); v += sx<2>(v); v += sx<4>(v); v += sx<8>(v); v += sx<16>(v); v = sum32(v);
    return v;
}
__device__ __forceinline__ float sigmoidf_(float x) { return 1.f / (1.f + __expf(-x)); }
__device__ __forceinline__ float siluf_(float x) { return x / (1.f + __expf(-x)); }
__device__ __forceinline__ float logsigmoidf_(float x) { return x >= 0.f ? -log1pf(__expf(-x)) : x - log1pf(__expf(x)); }
__device__ __forceinline__ f32x4 sig4(f32x4 v) { f32x4 o; o.x = sigmoidf_(v.x); o.y = sigmoidf_(v.y); o.z = sigmoidf_(v.z); o.w = sigmoidf_(v.w); return o; }
__device__ __forceinline__ f32x4 mfma16(bf16x8 a, bf16x8 b, f32x4 c) { return __builtin_amdgcn_mfma_f32_16x16x32_bf16(a, b, c, 0, 0, 0); }
__device__ __forceinline__ bf16x8 ld8(const bf16_t* p) { return *(const bf16x8*)p; }

__device__ __forceinline__ void transpose_item(const float* W, int K, size_t ldsrc, int k0, int n_src0, bf16_t* WT, int dst_row0, float* scr, int lane) {
#pragma unroll 8
    for (int i = 0; i < 32; ++i) { const int kk = 2 * i + (lane >> 5); scr[kk * 33 + (lane & 31)] = W[(size_t)(k0 + kk) * ldsrc + n_src0 + (lane & 31)]; }
    __builtin_amdgcn_wave_barrier();
    asm volatile("s_waitcnt lgkmcnt(0)" ::: "memory");
    const int c = lane & 7;
#pragma unroll
    for (int j = 0; j < 4; ++j) { const int n = (lane >> 3) + 8 * j; const float* s = scr + (8 * c) * 33 + n;
        u32x4 o; o.x = pk2(s[0 * 33], s[1 * 33]); o.y = pk2(s[2 * 33], s[3 * 33]); o.z = pk2(s[4 * 33], s[5 * 33]); o.w = pk2(s[6 * 33], s[7 * 33]);
        *(u32x4*)(WT + (size_t)(dst_row0 + n) * K + k0 + 8 * c) = o; }
    asm volatile("s_waitcnt lgkmcnt(0)" ::: "memory");
    __builtin_amdgcn_wave_barrier();
}
__device__ __forceinline__ void convert_weights(const Params& p, int l, char* lds, int gw, int ngw, int wid, int lane) {
    float* scr = (float*)lds + wid * (64 * 33);
    unsigned char* ws = p.ws;
    constexpr int I_IN = 16 * 224, I_QKV = 3 * 4 * 4 * 8, I_SQ = 16 * 32, I_EXP = 3 * 16 * 512;
    constexpr int TOTAL = I_IN + I_QKV + 3 * I_SQ + I_EXP;
    for (int it = gw; it < TOTAL; it += ngw) {
        int r = it;
        if (r < I_IN) { const int kb = r / 224, nb = r % 224, r0 = nb * 32, nsrc = r0 < 2048 ? r0 : r0 + 8;
            transpose_item(p.in[I_WIN] + (size_t)l * D * DIN, D, DIN, kb * 64, nsrc, (bf16_t*)(ws + W_IN_T), r0, scr, lane); continue; }
        r -= I_IN;
        if (r < I_QKV) { const int w = r / 128, rr = r % 128, h = rr / 32, t = rr % 32, kb = t / 8, nb = t % 8;
            const float* src = p.in[w == 0 ? I_WQM : (w == 1 ? I_WKM : I_WVM)] + ((size_t)l * 4 + h) * 65536;
            bf16_t* dst = (bf16_t*)(ws + (w == 0 ? W_Q_T : (w == 1 ? W_K_T : W_V_T))) + (size_t)h * 65536;
            transpose_item(src, 256, 256, kb * 64, nb * 32, dst, nb * 32, scr, lane); continue; }
        r -= I_QKV;
        if (r < 3 * I_SQ) { const int w = r / I_SQ, t = r % I_SQ, kb = t / 32, nb = t % 32;
            const float* src = p.in[w == 0 ? I_WBM : (w == 1 ? I_WBA : I_WOUT)] + (size_t)l * D * D;
            bf16_t* dst = (bf16_t*)(ws + (w == 0 ? W_BM_T : (w == 1 ? W_BA_T : W_OUT_T)));
            transpose_item(src, D, D, kb * 64, nb * 32, dst, nb * 32, scr, lane); continue; }
        r -= 3 * I_SQ;
        { const int w = r / (16 * 512), rr = r % (16 * 512), e = rr / 512, t = rr % 512, kb = t / 32, nb = t % 32;
            const float* src = p.in[w == 0 ? I_WG : (w == 1 ? I_WU : I_WD)] + ((size_t)l * NEXP + e) * D * D;
            if (w == 2) transpose_item(src, D, D, kb * 64, nb * 32, (bf16_t*)(ws + W_D_T) + (size_t)e * D * D, nb * 32, scr, lane);
            else { const int j0 = nb * 32; transpose_item(src, D, D, kb * 64, j0, (bf16_t*)(ws + W_G_T) + (size_t)e * 2048 * D, 256 * (j0 >> 7) + (j0 & 127) + (w == 1 ? 128 : 0), scr, lane); } }
    }
}

__device__ __forceinline__ void ln_normalize(f32x4 (&v)[4], const float* g, const float* b, int lane) {
    float s = 0.f;
#pragma unroll
    for (int j = 0; j < 4; ++j) s += (v[j].x + v[j].y) + (v[j].z + v[j].w);
    const float mean = wave_sum(s) * (1.f / D);
    float s2 = 0.f;
#pragma unroll
    for (int j = 0; j < 4; ++j) { v[j] = v[j] - mean; s2 += (v[j].x * v[j].x + v[j].y * v[j].y) + (v[j].z * v[j].z + v[j].w * v[j].w); }
    const float rstd = rsqrtf(wave_sum(s2) * (1.f / D) + LN_EPS);
#pragma unroll
    for (int j = 0; j < 4; ++j) { const f32x4 gg = *(const f32x4*)(g + 4 * lane + 256 * j), bb = *(const f32x4*)(b + 4 * lane + 256 * j); v[j] = v[j] * rstd * gg + bb; }
}
__device__ __forceinline__ void store_row_bf16(bf16_t* row, const f32x4 (&v)[4], int lane) {
#pragma unroll
    for (int j = 0; j < 4; ++j) { u32x2 o; o.x = pk2(v[j].x, v[j].y); o.y = pk2(v[j].z, v[j].w); *(u32x2*)(row + 4 * lane + 256 * j) = o; }
}
__device__ __forceinline__ void store_row_zero(bf16_t* row, int lane) {
#pragma unroll
    for (int j = 0; j < 4; ++j) { u32x2 o; o.x = 0u; o.y = 0u; *(u32x2*)(row + 4 * lane + 256 * j) = o; }
}
__device__ __forceinline__ void load_gate_w(const Params& p, int l, float* g8) {
    const float* w = p.in[I_WIN] + (size_t)l * D * DIN + 2048;
    for (int i = TIDX; i < D * 8; i += NT) { const int k = i >> 3, c = i & 7; g8[i] = w[(size_t)k * DIN + c]; }
    __syncthreads();
}
__device__ __forceinline__ void gates_row(const Params& p, int l, const float* g8, const f32x4 (&v)[4], int prow, int lane) {
    float acc[8];
#pragma unroll
    for (int c = 0; c < 8; ++c) acc[c] = 0.f;
#pragma unroll
    for (int j = 0; j < 4; ++j)
#pragma unroll
        for (int i = 0; i < 4; ++i) { const int k = 4 * lane + 256 * j + i; const float x = v[j][i];
            const f32x4 w0 = *(const f32x4*)(g8 + k * 8), w1 = *(const f32x4*)(g8 + k * 8 + 4);
            acc[0] += x * w0.x; acc[1] += x * w0.y; acc[2] += x * w0.z; acc[3] += x * w0.w; acc[4] += x * w1.x; acc[5] += x * w1.y; acc[6] += x * w1.z; acc[7] += x * w1.w; }
#pragma unroll
    for (int c = 0; c < 8; ++c) acc[c] = wave_sum(acc[c]);
    if (lane < 4) {
        float* gli = (float*)(p.ws + TAB_GLI); float* glf = (float*)(p.ws + TAB_GLF);
        const float bi = p.in[I_BI][l * 4 + lane], bfv = p.in[I_BF][l * 4 + lane];
        float ai = acc[0], af = acc[4];
        if (lane == 1) { ai = acc[1]; af = acc[5]; } else if (lane == 2) { ai = acc[2]; af = acc[6]; } else if (lane == 3) { ai = acc[3]; af = acc[7]; }
        gli[(size_t)lane * P + prow] = ai + bi;
        glf[(size_t)lane * P + prow] = logsigmoidf_(af + bfv);
    }
}
__device__ __forceinline__ void gates_row_pad(const Params& p, int prow, int lane) {
    if (lane < 4) { ((float*)(p.ws + TAB_GLI))[(size_t)lane * P + prow] = NEGBIG; ((float*)(p.ws + TAB_GLF))[(size_t)lane * P + prow] = 0.f; }
}

__device__ __forceinline__ void phase_prologue(const Params& p, char* lds, int bid, int nb) {
    const int tid = TIDX, wid = tid >> 6, lane = tid & 63, gw = bid * NW + wid, ngw = nb * NW;
    convert_weights(p, 0, lds, gw, ngw, wid, lane);
    __syncthreads();
    float* g8 = (float*)lds;
    load_gate_w(p, 0, g8);
    bf16_t* H = (bf16_t*)(p.ws + B_H);
    for (int r = gw; r < P; r += ngw) {
        if (r < VALID0) { store_row_zero(H + (size_t)r * D, lane); gates_row_pad(p, r, lane); continue; }
        const float* src = r < 256 ? p.in[I_META] + (size_t)(r - VALID0) * D : p.in[I_X] + (size_t)(r - 256) * D;
        f32x4 v[4];
#pragma unroll
        for (int j = 0; j < 4; ++j) v[j] = *(const f32x4*)(src + 4 * lane + 256 * j);
        ln_normalize(v, p.in[I_LNG], p.in[I_LNB], lane);
        store_row_bf16(H + (size_t)r * D, v, lane);
        gates_row(p, 0, g8, v, r, lane);
    }
}

struct RowsPlain { const bf16_t* base; size_t ld; __device__ __forceinline__ const bf16_t* row(int m) const { return base + (size_t)m * ld; } };
__device__ __forceinline__ void store4_bf16(bf16_t* dst, f32x4 v) { u32x2 o; o.x = pk2(v.x, v.y); o.y = pk2(v.z, v.w); *(u32x2*)dst = o; }

struct EpiProj { unsigned char* ws;
    __device__ __forceinline__ void operator()(int m, int n, f32x4 v) const {
        const int seg = n >> 10, cc = n & 1023;
        const size_t off = seg == 0 ? B_XM : seg == 1 ? B_OP : seg == 2 ? B_QA : seg == 3 ? B_KA : seg == 4 ? B_VA : seg == 5 ? B_GA : B_GB;
        store4_bf16((bf16_t*)(ws + off) + (size_t)m * D + cc, v); } };
struct EpiStore { bf16_t* C; size_t ldc; float scale;
    __device__ __forceinline__ void operator()(int m, int n, f32x4 v) const { store4_bf16(C + (size_t)m * ldc + n, v * scale); } };
namespace pg8 {
#define PG8_LAS __attribute__((address_space(3)))
constexpr int BM = 256, BK = 64, HALF = 128, HTB = HALF * BK * 2, STAGE_BYTES = 8 * HTB, NXCD = 8, WGM = 8;
__host__ __device__ __forceinline__ int lds_byte(int r, int c) { const int st = (r >> 4) * 2 + (c >> 5), rr = r & 15, cc = c & 31, ob = rr * 64 + cc * 2; return st * 1024 + (ob ^ (((ob >> 9) & 1) << 5)); }
__host__ __device__ __forceinline__ void stage_rc(int b, int& R, int& C) { const int st = b / 1024, sb = b % 1024, swz = sb ^ (((sb >> 9) & 1) << 5); R = (st >> 1) * 16 + swz / 64; C = (st & 1) * 32 + (swz % 64) / 2; }
__host__ __device__ __forceinline__ int perm32(int rho) { const int n = rho >> 4, i = rho & 15; return 8 * (i >> 2) + 4 * n + (i & 3); }
struct Unit { int pm, pn, grp; };
__device__ __forceinline__ bool decode_unit(long L, int nG, int nM, int nN, Unit& u) {
    const int nwg = nG * nM * nN; if (L >= nwg) return false;
    int wgid = (int)L; { const int q = nwg / NXCD, r = nwg % NXCD, xcd = wgid % NXCD, off = wgid / NXCD; wgid = (xcd < r ? xcd * (q + 1) : r * (q + 1) + (xcd - r) * q) + off; }
    const int per = nM * nN; u.grp = wgid / per; const int rem = wgid % per;
    const int nig = WGM * nN, gid = rem / nig, fm = gid * WGM, gsz = (nM - fm) < WGM ? (nM - fm) : WGM;
    u.pm = __builtin_amdgcn_readfirstlane(fm + ((rem % nig) % gsz)); u.pn = __builtin_amdgcn_readfirstlane((rem % nig) / gsz); u.grp = __builtin_amdgcn_readfirstlane(u.grp); return true;
}
__device__ __forceinline__ unsigned cvt_pk_bf16(float lo, float hi) { unsigned r; asm volatile("v_cvt_pk_bf16_f32 %0, %1, %2" : "=v"(r) : "v"(lo), "v"(hi)); return r; }

template <class Epi, class Sched, bool ALIGN_EPI = true>
__device__ __forceinline__ void gemm_phase(PG8_LAS unsigned char* lds, const Sched& S, const Epi& E) {
    const int tid = TIDX, wid = __builtin_amdgcn_readfirstlane(tid >> 6), lane = tid & 63, wr = wid >> 2, wc = wid & 3, fr = lane & 15, fq = lane >> 4;
    const int K = S.K, nt = K / BK;
    unsigned voffA[2], voffB[2];
#pragma unroll
    for (int i = 0; i < 2; ++i) { int R, C; stage_rc(tid * 16 + i * 8192, R, C); const int Rb = (R & ~31) + perm32(R & 31);
        voffA[i] = (unsigned)(R * S.lda + C) * 2u; voffB[i] = (unsigned)(Rb * S.ldb + C) * 2u; }
    const size_t kstep = (size_t)(BK * 2);
    const size_t hstepA = (size_t)HALF * S.lda * 2, hstepB = (size_t)HALF * S.ldb * 2;
    const unsigned ldsw = (unsigned)wid * 1024u;
    const int aoff = lds_byte(wr * 64 + fr, fq * 8), boff = lds_byte(wc * 32 + fr, fq * 8);
#define PG8_SA(b, h) (((b) * 2 + (h)) * HTB)
#define PG8_SB(b, h) ((4 + (b) * 2 + (h)) * HTB)
#define PG8_STAGE(bufoff, gbase, voff) do { _Pragma("unroll") for (int _i = 0; _i < 2; ++_i) \
        __builtin_amdgcn_global_load_lds((const unsigned*)((const char*)(gbase) + (voff)[_i]), (PG8_LAS unsigned*)(lds + (bufoff) + ldsw + _i * 8192), 16, 0, 0); } while (0)
#define PG8_LDA(dst, b, h) do { _Pragma("unroll") for (int m = 0; m < 4; ++m) _Pragma("unroll") for (int k = 0; k < 2; ++k) dst[m][k] = *(const PG8_LAS bf16x8*)(lds + PG8_SA(b, h) + aoff + m * 2048 + k * 1024); } while (0)
#define PG8_LDB(dst, b, h) do { _Pragma("unroll") for (int n = 0; n < 2; ++n) _Pragma("unroll") for (int k = 0; k < 2; ++k) dst[n][k] = *(const PG8_LAS bf16x8*)(lds + PG8_SB(b, h) + boff + n * 2048 + k * 1024); } while (0)
#define PG8_MMA(ai, bj, At, Bt) do { __builtin_amdgcn_s_setprio(1); _Pragma("unroll") for (int m = 0; m < 4; ++m) _Pragma("unroll") for (int n = 0; n < 2; ++n) _Pragma("unroll") for (int k = 0; k < 2; ++k) \
        acc[ai][bj][m][n] = __builtin_amdgcn_mfma_f32_16x16x32_bf16(Bt[n][k], At[m][k], acc[ai][bj][m][n], 0, 0, 0); __builtin_amdgcn_s_setprio(0); } while (0)
#define PG8_WAIT_V(n) asm volatile("s_waitcnt vmcnt(" #n ")" ::: "memory")
#define PG8_WAIT_L(n) asm volatile("s_waitcnt lgkmcnt(" #n ")" ::: "memory")
#define PG8_BAR __builtin_amdgcn_s_barrier()
#define PG8_SCHED __builtin_amdgcn_sched_barrier(0)
    Unit cur, nxt; int ui = 0;
    if (!S.next(0, cur)) return;
    f32x4 acc[2][2][4][2];
#pragma unroll
    for (int a = 0; a < 2; ++a)
#pragma unroll
        for (int b = 0; b < 2; ++b)
#pragma unroll
            for (int m = 0; m < 4; ++m)
#pragma unroll
                for (int n = 0; n < 2; ++n) acc[a][b][m][n] = (f32x4){0.f, 0.f, 0.f, 0.f};
    bf16x8 At[4][2], B0[2][2], B1[2][2];
    const char* cA = S.abase(cur); const char* cB = S.bbase(cur);
    PG8_STAGE(PG8_SB(0, 0), cB, voffB); PG8_STAGE(PG8_SB(0, 1), cB + hstepB, voffB); PG8_STAGE(PG8_SA(0, 0), cA, voffA); PG8_STAGE(PG8_SA(0, 1), cA + hstepA, voffA);
    if (wr == 1) PG8_BAR;
    PG8_WAIT_V(2); PG8_BAR;
    PG8_STAGE(PG8_SB(1, 0), cB + kstep, voffB); PG8_STAGE(PG8_SA(1, 0), cA + kstep, voffA); PG8_STAGE(PG8_SB(1, 1), cB + hstepB + kstep, voffB);
    PG8_WAIT_V(6); PG8_BAR;
    for (;;) {
        const bool has_next = S.next(ui + 1, nxt);
        const char* nA = has_next ? S.abase(nxt) : cA; const char* nB = has_next ? S.bbase(nxt) : cB;
        for (int t = 0; t < nt; t += 2) {
            const bool last = (t == nt - 2);
            const char* a1 = cA + (size_t)(t + 1) * kstep;
            const char* a2 = last ? nA : cA + (size_t)(t + 2) * kstep; const char* b2 = last ? nB : cB + (size_t)(t + 2) * kstep;
            const char* a3 = a2 + kstep; const char* b3 = b2 + kstep;
            PG8_LDB(B0, 0, 0); PG8_LDB(B1, 0, 1); PG8_SCHED; PG8_LDA(At, 0, 0); PG8_STAGE(PG8_SA(1, 1), a1 + hstepA, voffA);
            PG8_WAIT_V(8); PG8_WAIT_L(0); PG8_BAR; PG8_MMA(0, 0, At, B0); PG8_MMA(0, 1, At, B1); PG8_BAR; PG8_SCHED;
            PG8_LDA(At, 0, 1); PG8_STAGE(PG8_SB(0, 0), b2, voffB); PG8_STAGE(PG8_SB(0, 1), b2 + hstepB, voffB); PG8_STAGE(PG8_SA(0, 0), a2, voffA);
            PG8_WAIT_V(8); PG8_WAIT_L(0); PG8_BAR; PG8_MMA(1, 0, At, B0); PG8_MMA(1, 1, At, B1); PG8_BAR; PG8_SCHED;
            PG8_LDB(B0, 1, 0); PG8_LDB(B1, 1, 1); PG8_SCHED; PG8_LDA(At, 1, 0); PG8_STAGE(PG8_SA(0, 1), a2 + hstepA, voffA);
            PG8_WAIT_V(8); PG8_WAIT_L(0); PG8_BAR; PG8_MMA(0, 0, At, B0); PG8_MMA(0, 1, At, B1); PG8_BAR; PG8_SCHED;
            PG8_LDA(At, 1, 1); PG8_STAGE(PG8_SB(1, 0), b3, voffB); PG8_STAGE(PG8_SB(1, 1), b3 + hstepB, voffB); PG8_STAGE(PG8_SA(1, 0), a3, voffA);
            PG8_WAIT_V(8); PG8_WAIT_L(0); PG8_BAR; PG8_MMA(1, 0, At, B0); PG8_MMA(1, 1, At, B1); PG8_BAR; PG8_SCHED;
        }
        if constexpr (ALIGN_EPI) { if (wr == 0) PG8_BAR; }
        E(acc, cur, wr, wc, fr, fq);
        if (!has_next) break;
#pragma unroll
        for (int a = 0; a < 2; ++a)
#pragma unroll
            for (int b = 0; b < 2; ++b)
#pragma unroll
                for (int m = 0; m < 4; ++m)
#pragma unroll
                    for (int n = 0; n < 2; ++n) acc[a][b][m][n] = (f32x4){0.f, 0.f, 0.f, 0.f};
        cur = nxt; cA = nA; cB = nB; ++ui;
        if constexpr (ALIGN_EPI) { if (wr == 1) PG8_BAR; }
    }
    PG8_WAIT_V(0);
    if constexpr (!ALIGN_EPI) { if (wr == 0) PG8_BAR; }
    PG8_BAR;
#undef PG8_SA
#undef PG8_SB
#undef PG8_STAGE
#undef PG8_LDA
#undef PG8_LDB
#undef PG8_MMA
#undef PG8_WAIT_V
#undef PG8_WAIT_L
#undef PG8_BAR
#undef PG8_SCHED
}
__device__ __forceinline__ u32x4 pack8(f32x4 v0, f32x4 v1) { u32x4 w; w.x = cvt_pk_bf16(v0[0], v0[1]); w.y = cvt_pk_bf16(v0[2], v0[3]); w.z = cvt_pk_bf16(v1[0], v1[1]); w.w = cvt_pk_bf16(v1[2], v1[3]); return w; }
__device__ __forceinline__ void unpack8(u32x4 w, f32x4& v0, f32x4& v1) {
    v0[0] = __uint_as_float(w.x << 16); v0[1] = __uint_as_float(w.x & 0xffff0000u); v0[2] = __uint_as_float(w.y << 16); v0[3] = __uint_as_float(w.y & 0xffff0000u);
    v1[0] = __uint_as_float(w.z << 16); v1[1] = __uint_as_float(w.z & 0xffff0000u); v1[2] = __uint_as_float(w.w << 16); v1[3] = __uint_as_float(w.w & 0xffff0000u); }
template <class F> __device__ __forceinline__ void for_each_piece(const f32x4 (&acc)[2][2][4][2], const Unit& u, int wr, int wc, int fr, int fq, const F& f) {
    asm volatile("" : "+v"(fr), "+v"(fq));
    const int row0 = u.pm * BM + wr * 64 + fr, col0 = wc * 32 + 8 * fq;
#pragma unroll
    for (int ai = 0; ai < 2; ++ai)
#pragma unroll
        for (int m = 0; m < 4; ++m)
#pragma unroll
            for (int bj = 0; bj < 2; ++bj) f(row0 + ai * HALF + m * 16, col0 + bj * HALF, acc[ai][bj][m][0], acc[ai][bj][m][1]);
}
}

template <int MI, int NJ, class AR, class BR, class Epi>
__device__ __forceinline__ void sgemm_wave(const AR& ar, const BR& br, int K, int m0, int n0, const Epi& epi) {
    const int lane = TIDX & 63, c = lane & 15, g = lane >> 4;
    const bf16_t* ap[MI]; const bf16_t* bp[NJ];
#pragma unroll
    for (int i = 0; i < MI; ++i) ap[i] = ar.row(m0 + 16 * i + c) + 8 * g;
#pragma unroll
    for (int j = 0; j < NJ; ++j) bp[j] = br.row(n0 + 16 * j + c) + 8 * g;
    f32x4 acc[MI][NJ];
#pragma unroll
    for (int i = 0; i < MI; ++i)
#pragma unroll
        for (int j = 0; j < NJ; ++j) acc[i][j] = (f32x4){0.f, 0.f, 0.f, 0.f};
#pragma unroll 4
    for (int k0 = 0; k0 < K; k0 += 32) {
        bf16x8 a[MI], b[NJ];
#pragma unroll
        for (int i = 0; i < MI; ++i) a[i] = ld8(ap[i] + k0);
#pragma unroll
        for (int j = 0; j < NJ; ++j) b[j] = ld8(bp[j] + k0);
#pragma unroll
        for (int i = 0; i < MI; ++i)
#pragma unroll
            for (int j = 0; j < NJ; ++j) acc[i][j] = mfma16(b[j], a[i], acc[i][j]);
    }
#pragma unroll
    for (int i = 0; i < MI; ++i)
#pragma unroll
        for (int j = 0; j < NJ; ++j) epi(m0 + 16 * i + c, n0 + 16 * j + 4 * g, acc[i][j]);
}
__device__ __forceinline__ void zero_block(bf16_t* base, size_t ld, int nrows, int ncols, int gtid, int gthreads) {
    const int cpr = ncols / 8;
    for (int i = gtid; i < nrows * cpr; i += gthreads) { const int r = i / cpr, cc = (i % cpr) * 8; *(u32x4*)(base + (size_t)r * ld + cc) = (u32x4){0u, 0u, 0u, 0u}; }
}

struct SchedProj { const char* A; const char* B; int G, c; int K, lda, ldb;
    __device__ __forceinline__ bool next(int i, pg8::Unit& u) const { if (!pg8::decode_unit((long)i * G + c, 1, 64, 28, u)) return false; u.pm += 1; return true; }
    __device__ __forceinline__ const char* abase(const pg8::Unit& u) const { return A + (size_t)u.pm * 256 * D * 2; }
    __device__ __forceinline__ const char* bbase(const pg8::Unit& u) const { return B + (size_t)u.pn * 256 * D * 2; } };
struct EpiProjF { unsigned char* ws;
    __device__ __forceinline__ void operator()(const f32x4 (&acc)[2][2][4][2], const pg8::Unit& u, int wr, int wc, int fr, int fq) const {
        const int colt = u.pn * 256, seg = colt >> 10;
        const size_t off = seg == 0 ? B_XM : seg == 1 ? B_OP : seg == 2 ? B_QA : seg == 3 ? B_KA : seg == 4 ? B_VA : seg == 5 ? B_GA : B_GB;
        bf16_t* base = (bf16_t*)(ws + off) + (colt & 1023);
        pg8::for_each_piece(acc, u, wr, wc, fr, fq, [&](int row, int col, f32x4 v0, f32x4 v1) { *(u32x4*)(base + (size_t)row * D + col) = pg8::pack8(v0, v1); }); } };
struct SchedVAT { const char* A; const char* B; int G, c; int K, lda, ldb;
    __device__ __forceinline__ bool next(int i, pg8::Unit& u) const { if (!pg8::decode_unit((long)i * G + c, 1, 4, 64, u)) return false; u.pn += 1; return true; }
    __device__ __forceinline__ const char* abase(const pg8::Unit& u) const { return A + (size_t)u.pm * 256 * D * 2; }
    __device__ __forceinline__ const char* bbase(const pg8::Unit& u) const { return B + (size_t)u.pn * 256 * D * 2; } };
struct EpiStoreF { bf16_t* C; size_t ldc; float scale;
    __device__ __forceinline__ void operator()(const f32x4 (&acc)[2][2][4][2], const pg8::Unit& u, int wr, int wc, int fr, int fq) const {
        bf16_t* base = C + (size_t)u.pn * 256;
        pg8::for_each_piece(acc, u, wr, wc, fr, fq, [&](int row, int col, f32x4 v0, f32x4 v1) { *(u32x4*)(base + (size_t)row * ldc + col) = pg8::pack8(v0 * scale, v1 * scale); }); } };
__device__ __forceinline__ void phase_proj_f(const Params& p, char* lds, int bid, int nb) {
    const int tid = TIDX, wid = tid >> 6, gw = bid * NW + wid, ngw = nb * NW;
    const bf16_t* H = (const bf16_t*)(p.ws + B_H); const bf16_t* W = (const bf16_t*)(p.ws + W_IN_T);
    zero_block((bf16_t*)(p.ws + B_KA), D, VALID0, D, bid * NT + tid, nb * NT);
    zero_block((bf16_t*)(p.ws + B_VA), D, VALID0, D, bid * NT + tid, nb * NT);
    zero_block((bf16_t*)(p.ws + B_XM), D, VALID0, D, bid * NT + tid, nb * NT);
    for (int t = gw; t < 112; t += ngw) sgemm_wave<1, 4>(RowsPlain{H, D}, RowsPlain{W, D}, D, VALID0, t * 64, EpiProj{p.ws});
    { SchedProj S{(const char*)H, (const char*)W, nb, bid, D, D, D};
      pg8::gemm_phase(( PG8_LAS unsigned char*)lds, S, EpiProjF{p.ws}); }
}

namespace fa {
typedef short s16x4 __attribute__((ext_vector_type(4)));
typedef float f32x16 __attribute__((ext_vector_type(16)));
constexpr int KVBLK = 64, SHM_V = 64 * 128 * 2, SHM_K = 64 * 64 * 2, PITCH = 1024;
constexpr int LDS_NEED = 2 * SHM_V + 2 * SHM_K + NW * 64 * 4;
constexpr float SCALE = 0.125f, THR = 8.f;
#define FA_SBAR() __builtin_amdgcn_sched_barrier(0)
__device__ __forceinline__ int kswz(int row, int chunk) { return row * 128 + ((chunk ^ ((row >> 1) & 7)) << 4); }
__device__ __forceinline__ int v_st(int k, int c) { const int kk = (k & ~0xC) | ((k & 4) << 1) | ((k & 8) >> 1); return ((kk >> 3) * 4 + (c >> 5)) * 512 + ((kk & 7) * 32 + (c & 31)) * 2; }
__device__ __forceinline__ int v_rd_base(int lane) { return ((lane & 3) << 3) | (((lane >> 2) & 3) << 6) | (((lane >> 4) & 1) << 5) | (((lane >> 5) & 1) << 8); }
constexpr int v_rd_off(int d0, int ks, int half) { return d0 * 512 + ks * 4096 + half * 2048; }
__device__ __forceinline__ int crow(int r, int hi) { return (r & 3) + 8 * (r >> 2) + 4 * hi; }
__device__ __forceinline__ unsigned cvtpk(float lo, float hi) { unsigned r; asm volatile("v_cvt_pk_bf16_f32 %0, %1, %2" : "=v"(r) : "v"(lo), "v"(hi)); return r; }
__device__ __forceinline__ void mask_tile(f32x16& p0, f32x16& p1, int pos, int kbase, int hi, int lowkey) {
    const float NEG = -__builtin_inff();
#pragma unroll
    for (int r = 0; r < 16; ++r) {
        const int k0 = kbase + (r & 3) + 8 * (r >> 2) + 4 * hi;
        if (k0 > pos || k0 < lowkey) p0[r] = NEG;
        if (k0 + 32 > pos || k0 + 32 < lowkey) p1[r] = NEG;
    }
}
__device__ __forceinline__ void partialSM(f32x16& p0, f32x16& p1, float& m_reg, float& mn, float& alpha) {
    float pmax = p0[0];
#pragma unroll
    for (int r = 1; r < 16; ++r) pmax = fmaxf(pmax, p0[r]);
#pragma unroll
    for (int r = 0; r < 16; ++r) pmax = fmaxf(pmax, p1[r]);
    { auto rr = __builtin_amdgcn_permlane32_swap(__float_as_uint(pmax), __float_as_uint(pmax), false, false);
      pmax = fmaxf(__uint_as_float(rr[0]), __uint_as_float(rr[1])); }
    constexpr float C2 = 1.4426950408889634f * SCALE;
    if (__builtin_expect(__all((pmax - m_reg) * SCALE <= THR), 1)) { mn = m_reg; alpha = 1.f; }
    else { mn = fmaxf(m_reg, pmax); alpha = __builtin_amdgcn_exp2f((m_reg - mn) * C2); m_reg = mn; }
    const float mnL = -mn * C2;
#pragma unroll
    for (int r = 0; r < 16; ++r) p0[r] = fmaf(p0[r], C2, mnL);
#pragma unroll
    for (int r = 0; r < 16; ++r) p1[r] = fmaf(p1[r], C2, mnL);
#pragma unroll
    for (int r = 0; r < 16; ++r) p0[r] = __builtin_amdgcn_exp2f(p0[r]);
}
__device__ __forceinline__ void finishSM(f32x16& p0, f32x16& p1, float alpha, float& l_reg, bf16x8& pa0, bf16x8& pa1, bf16x8& pa2, bf16x8& pa3) {
#pragma unroll
    for (int r = 0; r < 16; ++r) p1[r] = __builtin_amdgcn_exp2f(p1[r]);
    float ps = 0;
#pragma unroll
    for (int r = 0; r < 16; ++r) ps += p0[r];
#pragma unroll
    for (int r = 0; r < 16; ++r) ps += p1[r];
    { auto rr = __builtin_amdgcn_permlane32_swap(__float_as_uint(ps), __float_as_uint(ps), false, false);
      ps = __uint_as_float(rr[0]) + __uint_as_float(rr[1]); }
    l_reg = l_reg * alpha + ps;
#define FA_PK4(Pv, B_, OUT) do { unsigned a0 = cvtpk(Pv[B_+0], Pv[B_+1]), a1 = cvtpk(Pv[B_+2], Pv[B_+3]);                          \
        unsigned b0 = cvtpk(Pv[B_+4], Pv[B_+5]), b1 = cvtpk(Pv[B_+6], Pv[B_+7]);                                             \
        auto r0 = __builtin_amdgcn_permlane32_swap(a0, b0, false, false); auto r1 = __builtin_amdgcn_permlane32_swap(a1, b1, false, false); \
        u32x4 w = {r0[0], r1[0], r0[1], r1[1]}; OUT = *reinterpret_cast<bf16x8*>(&w); } while (0)
    FA_PK4(p0, 0, pa0); FA_PK4(p0, 8, pa1); FA_PK4(p1, 0, pa2); FA_PK4(p1, 8, pa3);
#undef FA_PK4
}
template <int KB>
__device__ __forceinline__ void qkt(f32x16& p0, f32x16& p1, const char* K_lds, int r32, int hi, const bf16x8* qr) {
    p0 = f32x16{}; p1 = f32x16{};
#pragma unroll
    for (int d0 = 0; d0 < 4; ++d0) { const char* a = K_lds + KB * SHM_K + kswz(r32, 2 * d0 + hi);
        bf16x8 b0 = *reinterpret_cast<const bf16x8*>(a);
        bf16x8 b1 = *reinterpret_cast<const bf16x8*>(a + 32 * 128);
        p0 = __builtin_amdgcn_mfma_f32_32x32x16_bf16(b0, qr[d0], p0, 0, 0, 0);
        p1 = __builtin_amdgcn_mfma_f32_32x32x16_bf16(b1, qr[d0], p1, 0, 0, 0); }
}
template <int VB>
__device__ __forceinline__ void pv_tile(f32x16* o, int vb0, bf16x8 pa0, bf16x8 pa1, bf16x8 pa2, bf16x8 pa3) {
#define FA_TRRD(dst, off) asm volatile("ds_read_b64_tr_b16 %0, %1 offset:%2" : "=&v"(dst) : "v"(vb0), "i"(off) : "memory")
#define FA_PV_D0(d0) do { s16x4 l0, l1, l2, l3, h0, h1, h2, h3; constexpr int b_ = VB * SHM_V + v_rd_off(d0, 0, 0); \
        FA_TRRD(l0, b_); FA_TRRD(h0, b_ + 2048); FA_TRRD(l1, b_ + 4096); FA_TRRD(h1, b_ + 6144); FA_TRRD(l2, b_ + 8192); FA_TRRD(h2, b_ + 10240); FA_TRRD(l3, b_ + 12288); FA_TRRD(h3, b_ + 14336); \
        asm volatile("s_waitcnt lgkmcnt(0)" ::: "memory"); FA_SBAR();   \
        o[d0] = __builtin_amdgcn_mfma_f32_32x32x16_bf16(pa0, (bf16x8){l0[0], l0[1], l0[2], l0[3], h0[0], h0[1], h0[2], h0[3]}, o[d0], 0, 0, 0);   \
        o[d0] = __builtin_amdgcn_mfma_f32_32x32x16_bf16(pa1, (bf16x8){l1[0], l1[1], l1[2], l1[3], h1[0], h1[1], h1[2], h1[3]}, o[d0], 0, 0, 0);   \
        o[d0] = __builtin_amdgcn_mfma_f32_32x32x16_bf16(pa2, (bf16x8){l2[0], l2[1], l2[2], l2[3], h2[0], h2[1], h2[2], h2[3]}, o[d0], 0, 0, 0);   \
        o[d0] = __builtin_amdgcn_mfma_f32_32x32x16_bf16(pa3, (bf16x8){l3[0], l3[1], l3[2], l3[3], h3[0], h3[1], h3[2], h3[3]}, o[d0], 0, 0, 0); } while (0)
    FA_PV_D0(0); FA_PV_D0(1); FA_PV_D0(2); FA_PV_D0(3);
#undef FA_PV_D0
#undef FA_TRRD
}
__device__ __forceinline__ void attn_pass(const bf16_t* Qp, const bf16_t* Kp, const bf16_t* Vp, int P0, int NT, char* lds, f32x16 (&o)[4], float& l_out) {
    const int tid = TIDX, wid = __builtin_amdgcn_readfirstlane(tid >> 6), lane = tid & 63, r32 = lane & 31, hi = lane >> 5;
    char* V_lds = lds; char* K_lds = lds + 2 * SHM_V;
    float* wsl = (float*)(lds + 2 * SHM_V + 2 * SHM_K) + wid * 64; float* al_l = wsl + 32;
    const int qlo = P0 + wid * 32, pos = qlo + r32;
    float m_reg = -1e30f, l_reg = 0.f;
#pragma unroll
    for (int d = 0; d < 4; ++d) o[d] = f32x16{};
    const int ksr = tid >> 3, ksc = tid & 7, kws = kswz(ksr, ksc);
    const int sr = tid >> 4, sc = (tid & 15) * 8, vst0 = v_st(sr, sc), vst1 = v_st(32 + sr, sc);
    const int vb0 = (int)(uintptr_t)V_lds + v_rd_base(lane);
    bf16x8 qr[4];
#pragma unroll
    for (int d0 = 0; d0 < 4; ++d0) qr[d0] = ld8(Qp + (size_t)pos * PITCH + d0 * 16 + hi * 8);
    bf16x8 st_k, st_v0, st_v1;
#define FA_KBASE(t) ((3 + (t)) * KVBLK)
#define FA_SLOAD(t) do { const int kb_ = FA_KBASE(t); st_k = ld8(Kp + (size_t)(kb_ + ksr) * PITCH + ksc * 8); \
        st_v0 = ld8(Vp + (size_t)(kb_ + sr) * PITCH + sc); st_v1 = ld8(Vp + (size_t)(kb_ + 32 + sr) * PITCH + sc); } while (0)
#define FA_SWRITE_K(bf) do { *(bf16x8*)(K_lds + (bf) * SHM_K + kws) = st_k; } while (0)
#define FA_SWRITE_V(bf) do { *(bf16x8*)(V_lds + (bf) * SHM_V + vst0) = st_v0; *(bf16x8*)(V_lds + (bf) * SHM_V + vst1) = st_v1; } while (0)
#define FA_VMW() asm volatile("s_waitcnt vmcnt(0)" ::: "memory")
#define FA_RESC(a) do { if (__any((a) < 1.f)) { if (hi == 0) al_l[r32] = (a); asm volatile("s_waitcnt lgkmcnt(0)" ::: "memory");              \
                     for (int d_ = 0; d_ < 4; ++d_) for (int r = 0; r < 16; ++r) o[d_][r] *= al_l[crow(r, hi)]; } } while (0)
#define FA_MASKT(P0_, P1_, t) do { const int kb_ = FA_KBASE(t); if ((t) == 0 || kb_ + KVBLK - 1 > qlo) mask_tile(P0_, P1_, pos, kb_, hi, VALID0); } while (0)
    f32x16 pA0, pA1, pB0, pB1; float mnA, mnB, alA, alB; bf16x8 pa0, pa1, pa2, pa3;
    FA_SLOAD(0); FA_VMW(); FA_SWRITE_K(0); FA_SWRITE_V(0); FA_SBAR();
    if (NT > 1) FA_SLOAD(1);
    __syncthreads();
    FA_SBAR(); qkt<0>(pA0, pA1, K_lds, r32, hi, qr);
    FA_MASKT(pA0, pA1, 0); partialSM(pA0, pA1, m_reg, mnA, alA);
    if (NT > 1) { FA_VMW(); FA_SWRITE_K(1); FA_SWRITE_V(1); }
    __syncthreads();
#define FA_HALF_STEP(PX0, PX1, mnX, alX, PY0, PY1, alY, t, KB, VB, SB) do {                                                      \
        FA_SBAR(); qkt<KB>(PX0, PX1, K_lds, r32, hi, qr);                                             \
        finishSM(PY0, PY1, alY, l_reg, pa0, pa1, pa2, pa3); FA_SBAR();                                                           \
        if ((t) + 1 < NT) { FA_SLOAD((t) + 1); FA_SBAR(); }                                               \
        pv_tile<VB>(o, vb0, pa0, pa1, pa2, pa3); FA_MASKT(PX0, PX1, (t)); partialSM(PX0, PX1, m_reg, mnX, alX);                                        \
        __syncthreads();                                                                                                      \
        if ((t) + 1 < NT) { FA_VMW(); FA_SWRITE_K(SB); FA_SWRITE_V(SB); }                                                                          \
        FA_RESC(alX); __syncthreads(); } while (0)
    for (int t = 1; t + 1 < NT; t += 2) {
        FA_HALF_STEP(pB0, pB1, mnB, alB, pA0, pA1, alA, t, 1, 0, 0);
        FA_HALF_STEP(pA0, pA1, mnA, alA, pB0, pB1, alB, t + 1, 0, 1, 1);
    }
    const bool even = (NT & 1) == 0;
    if (even) { FA_SBAR(); qkt<1>(pB0, pB1, K_lds, r32, hi, qr); FA_SBAR(); }
    finishSM(pA0, pA1, alA, l_reg, pa0, pa1, pa2, pa3); FA_SBAR();
    pv_tile<0>(o, vb0, pa0, pa1, pa2, pa3);
    if (even) { FA_MASKT(pB0, pB1, NT - 1); partialSM(pB0, pB1, m_reg, mnB, alB); __syncthreads(); FA_RESC(alB);
        finishSM(pB0, pB1, alB, l_reg, pa0, pa1, pa2, pa3); FA_SBAR(); pv_tile<1>(o, vb0, pa0, pa1, pa2, pa3); }
    l_out = l_reg;
    __syncthreads();
#undef FA_KBASE
#undef FA_SLOAD
#undef FA_SWRITE_K
#undef FA_SWRITE_V
#undef FA_VMW
#undef FA_RESC
#undef FA_MASKT
#undef FA_HALF_STEP
}
__device__ __forceinline__ void attn_unit(const Params& p, int l, int hd, int j, float lam, float lam_init, char* lds) {
    const int tid = TIDX, wid = __builtin_amdgcn_readfirstlane(tid >> 6), lane = tid & 63, r32 = lane & 31, hi = lane >> 5;
    const bf16_t* QA = (const bf16_t*)(p.ws + B_QA) + hd * 128; const bf16_t* KA = (const bf16_t*)(p.ws + B_KA) + hd * 128; const bf16_t* VA = (const bf16_t*)(p.ws + B_VA) + hd * 128;
    bf16_t* YA = (bf16_t*)(p.ws + B_YA) + hd * 128;
    const int P0 = j * 256, NT = 4 * j + 1;
    float* li_l = (float*)(lds + 2 * SHM_V + 2 * SHM_K) + wid * 64;
    bf16_t* Yw = YA + (size_t)(P0 + wid * 32) * PITCH;
    f32x16 o[4]; float lr;
    attn_pass(QA, KA, VA, P0, NT, lds, o, lr);
    if (hi == 0) li_l[r32] = lr;
    asm volatile("s_waitcnt lgkmcnt(0)" ::: "memory");
#pragma unroll
    for (int r = 0; r < 16; ++r) { const int orow = crow(r, hi); const float rl = __builtin_amdgcn_rcpf(li_l[orow]);
#pragma unroll
        for (int d0 = 0; d0 < 4; ++d0) { const float v = o[d0][r] * rl; const float vn = sx<1>(v);
            if ((r32 & 1) == 0) *(unsigned*)(Yw + (size_t)orow * PITCH + d0 * 32 + r32) = cvtpk(v, vn); } }
    asm volatile("s_waitcnt vmcnt(0)" ::: "memory");
    __syncthreads();
    attn_pass(QA + 64, KA + 64, VA, P0, NT, lds, o, lr);
    if (hi == 0) li_l[r32] = lr;
    asm volatile("s_waitcnt lgkmcnt(0)" ::: "memory");
    const float scale_out = 1.f - lam_init;
#pragma unroll
    for (int r = 0; r < 16; ++r) { const int orow = crow(r, hi); const float rl = lam * __builtin_amdgcn_rcpf(li_l[orow]);
        float cv[4]; float ss = 0.f;
#pragma unroll
        for (int d0 = 0; d0 < 4; ++d0) { const float o1 = bf2f((unsigned)Yw[(size_t)orow * PITCH + d0 * 32 + r32]); cv[d0] = o1 - o[d0][r] * rl; ss += cv[d0] * cv[d0]; }
        ss += sx<1>(ss); ss += sx<2>(ss); ss += sx<4>(ss); ss += sx<8>(ss); ss += sx<16>(ss);
        const float rs = rsqrtf(ss * (1.f / 128.f) + LN_EPS) * scale_out;
#pragma unroll
        for (int d0 = 0; d0 < 4; ++d0) o[d0][r] = cv[d0] * rs * p.in[I_ANG][l * 128 + d0 * 32 + r32]; }
    asm volatile("s_waitcnt vmcnt(0)" ::: "memory");
    __syncthreads();
#pragma unroll
    for (int r = 0; r < 16; ++r) { const int orow = crow(r, hi);
#pragma unroll
        for (int d0 = 0; d0 < 4; ++d0) { const float v = o[d0][r]; const float vn = sx<1>(v);
            if ((r32 & 1) == 0) *(unsigned*)(Yw + (size_t)orow * PITCH + d0 * 32 + r32) = cvtpk(v, vn); } }
    __syncthreads();
}
}
__device__ __forceinline__ void phase_attn_f(const Params& p, int l, char* lds, int bid, int nb) {
    const int lane = TIDX & 63;
    const float lam_init = 0.8f - 0.6f * expf(-0.3f * (float)l);
    float lam;
    { const float a = wave_sum(p.in[I_LQ1][l * 64 + lane] * p.in[I_LK1][l * 64 + lane]), b = wave_sum(p.in[I_LQ2][l * 64 + lane] * p.in[I_LK2][l * 64 + lane]);
      lam = expf(a) - expf(b) + lam_init; }
    for (int u = bid; u < 256 + 8; u += nb) {
        if (u < 256) { const int hd = u & 7, jj = u >> 3;
            fa::attn_unit(p, l, hd, 64 - jj, lam, lam_init, lds);
            fa::attn_unit(p, l, hd, 1 + jj, lam, lam_init, lds);
        } else fa::attn_unit(p, l, u - 256, 0, lam, lam_init, lds);
    }
}

__device__ __forceinline__ void phase_conv(const Params& p, int l, char* lds, int bid, int nb) {
    const int tid = TIDX, wid = tid >> 6, lane = tid & 63, gw = bid * NW + wid, ngw = nb * NW;
    const bf16_t* XM = (const bf16_t*)(p.ws + B_XM); bf16_t* XC = (bf16_t*)(p.ws + B_XC);
    const float* cw = p.in[I_CONVW] + (size_t)l * 4 * D; const float* cb = p.in[I_CONVB] + (size_t)l * D;
    const int nitem = P * (D / 8);
    for (int it = bid * NT + tid; it < nitem; it += nb * NT) {
        const int r = it >> 7, c0 = (it & 127) * 8;
        u32x4 o = {0u, 0u, 0u, 0u};
        if (r >= VALID0) {
            float acc[8];
#pragma unroll
            for (int i = 0; i < 8; ++i) acc[i] = cb[c0 + i];
#pragma unroll
            for (int j = 0; j < 4; ++j) { const int rr = r - 3 + j;
                if (rr >= VALID0) { const u32x4 x = *(const u32x4*)(XM + (size_t)rr * D + c0); const float* w = cw + j * D + c0;
                    acc[0] += w[0] * bf2f(x.x & 0xffffu); acc[1] += w[1] * bf2f(x.x >> 16); acc[2] += w[2] * bf2f(x.y & 0xffffu); acc[3] += w[3] * bf2f(x.y >> 16);
                    acc[4] += w[4] * bf2f(x.z & 0xffffu); acc[5] += w[5] * bf2f(x.z >> 16); acc[6] += w[6] * bf2f(x.w & 0xffffu); acc[7] += w[7] * bf2f(x.w >> 16); } }
            o.x = pk2(siluf_(acc[0]), siluf_(acc[1])); o.y = pk2(siluf_(acc[2]), siluf_(acc[3])); o.z = pk2(siluf_(acc[4]), siluf_(acc[5])); o.w = pk2(siluf_(acc[6]), siluf_(acc[7]));
        }
        *(u32x4*)(XC + (size_t)r * D + c0) = o;
    }
    const float* gli = (const float*)(p.ws + TAB_GLI); const float* glf = (const float*)(p.ws + TAB_GLF);
    float* tb = (float*)(p.ws + TAB_B); float* te = (float*)(p.ws + TAB_E); float* tpm = (float*)(p.ws + TAB_PM); float* tw = (float*)(p.ws + TAB_W);
    float* scg = (float*)(p.ws + TAB_SCG); float* scm = (float*)(p.ws + TAB_SCM);
    for (int t = gw; t < NSC * 4; t += ngw) {
        const int sc = t >> 2, h = t & 3; const size_t base = (size_t)h * P + sc * 256 + 4 * lane;
        const f32x4 lf = *(const f32x4*)(glf + base), li = *(const f32x4*)(gli + base);
        float b[4]; b[0] = lf.x; b[1] = b[0] + lf.y; b[2] = b[1] + lf.z; b[3] = b[2] + lf.w;
        float incl = b[3];
#pragma unroll
        for (int o = 1; o < 64; o <<= 1) { const float n = __shfl_up(incl, o); if (lane >= o) incl += n; }
        const float excl = incl - b[3];
        float e[4], pm[4];
#pragma unroll
        for (int i = 0; i < 4; ++i) { b[i] += excl; e[i] = li[i] - b[i]; }
        pm[0] = e[0]; pm[1] = fmaxf(pm[0], e[1]); pm[2] = fmaxf(pm[1], e[2]); pm[3] = fmaxf(pm[2], e[3]);
        float mi = pm[3];
#pragma unroll
        for (int o = 1; o < 64; o <<= 1) { const float n = __shfl_up(mi, o); if (lane >= o) mi = fmaxf(mi, n); }
        float mex = __shfl_up(mi, 1); if (lane == 0) mex = -INFINITY;
#pragma unroll
        for (int i = 0; i < 4; ++i) pm[i] = fmaxf(pm[i], mex);
        const float gtot = __shfl(incl, 63), emax = __shfl(mi, 63), mloc = gtot + emax;
        f32x4 ww;
#pragma unroll
        for (int i = 0; i < 4; ++i) ww[i] = __expf(e[i] + gtot - mloc);
        *(f32x4*)(tb + base) = (f32x4){b[0], b[1], b[2], b[3]};
        *(f32x4*)(te + base) = (f32x4){e[0], e[1], e[2], e[3]};
        *(f32x4*)(tpm + base) = (f32x4){pm[0], pm[1], pm[2], pm[3]};
        *(f32x4*)(tw + base) = ww;
        if (lane == 0) { scg[sc * 4 + h] = gtot; scm[sc * 4 + h] = mloc; }
    }
}

__device__ __forceinline__ void phase_m1(const Params& p, char* lds, int bid, int nb, int nsc) {
    const int tid = TIDX, wid = __builtin_amdgcn_readfirstlane(tid >> 6), lane = tid & 63, c = lane & 15, g = lane >> 4, gw = bid * NW + wid, ngw = nb * NW;
    const bf16_t* KMT = (const bf16_t*)(p.ws + B_KMT); const bf16_t* VMT = (const bf16_t*)(p.ws + B_VMT);
    const float* tw = (const float*)(p.ws + TAB_W); bf16_t* CT = (bf16_t*)(p.ws + B_CT); float* NTv = (float*)(p.ws + TAB_NT);
    for (int u = bid; u < nsc * 4 * 2; u += nb) {
        const int dvb = (u & 1) * 8 + wid, h = (u >> 1) & 3, sc = u >> 3, s0 = sc * 256;
        f32x4 acc[16];
#pragma unroll
        for (int i = 0; i < 16; ++i) acc[i] = (f32x4){0.f, 0.f, 0.f, 0.f};
        float un[16];
#pragma unroll
        for (int i = 0; i < 16; ++i) un[i] = 0.f;
        for (int ks = 0; ks < 8; ++ks) {
            const int sb = s0 + 32 * ks + 8 * g;
            const f32x4 w0 = *(const f32x4*)(tw + (size_t)h * P + sb), w1 = *(const f32x4*)(tw + (size_t)h * P + sb + 4);
            const u32x4 vv = *(const u32x4*)(VMT + (size_t)(h * 256 + 16 * dvb + c) * P + sb);
            u32x4 vw; vw.x = pk2(bf2f(vv.x & 0xffffu) * w0.x, bf2f(vv.x >> 16) * w0.y); vw.y = pk2(bf2f(vv.y & 0xffffu) * w0.z, bf2f(vv.y >> 16) * w0.w);
            vw.z = pk2(bf2f(vv.z & 0xffffu) * w1.x, bf2f(vv.z >> 16) * w1.y); vw.w = pk2(bf2f(vv.w & 0xffffu) * w1.z, bf2f(vv.w >> 16) * w1.w);
            const bf16x8 vf = *(bf16x8*)&vw;
#pragma unroll
            for (int dk = 0; dk < 16; ++dk) {
                const u32x4 kk = *(const u32x4*)(KMT + (size_t)(h * 256 + 16 * dk + c) * P + sb);
                acc[dk] = mfma16(*(const bf16x8*)&kk, vf, acc[dk]);
                if (dvb == 0) un[dk] += bf2f(kk.x & 0xffffu) * w0.x + bf2f(kk.x >> 16) * w0.y + bf2f(kk.y & 0xffffu) * w0.z + bf2f(kk.y >> 16) * w0.w
                                      + bf2f(kk.z & 0xffffu) * w1.x + bf2f(kk.z >> 16) * w1.y + bf2f(kk.w & 0xffffu) * w1.z + bf2f(kk.w >> 16) * w1.w;
            }
        }
        bf16_t* dst = CT + ((size_t)(sc * 4 + h) * 256 + 16 * dvb + c) * 256;
#pragma unroll
        for (int dk = 0; dk < 16; ++dk) store4_bf16(dst + 16 * dk + 4 * g, acc[dk]);
        if (dvb == 0) {
#pragma unroll
            for (int dk = 0; dk < 16; ++dk) { float v = un[dk]; v += sx<16>(v); v = sum32(v); if (g == 0) NTv[(size_t)(sc * 4 + h) * 256 + 16 * dk + c] = v; }
        }
    }
}

namespace pg8 {
template <class F> __device__ __forceinline__ void for_each_piece_local(const f32x4 (&acc)[2][2][4][2], int wr, int wc, int fr, int fq, const F& f) {
    asm volatile("" : "+v"(fr), "+v"(fq));
    const int row0 = wr * 64 + fr, col0 = wc * 32 + 8 * fq;
#pragma unroll
    for (int ai = 0; ai < 2; ++ai)
#pragma unroll
        for (int m = 0; m < 4; ++m)
#pragma unroll
            for (int bj = 0; bj < 2; ++bj) f(row0 + ai * HALF + m * 16, col0 + bj * HALF, acc[ai][bj][m][0], acc[ai][bj][m][1]);
}
}
struct SchedM1 { const char* VWT; const char* KMT; int G, c; int K, lda, ldb;
    __device__ __forceinline__ bool next(int i, pg8::Unit& u) const { return pg8::decode_unit((long)i * G + c, 4, 64, 1, u); }
    __device__ __forceinline__ const char* abase(const pg8::Unit& u) const { return VWT + ((size_t)u.grp * 256 * P + (size_t)(u.pm + 1) * 256) * 2; }
    __device__ __forceinline__ const char* bbase(const pg8::Unit& u) const { return KMT + ((size_t)u.grp * 256 * P + (size_t)(u.pm + 1) * 256) * 2; } };
struct EpiM1 { bf16_t* CT;
    __device__ __forceinline__ void operator()(const f32x4 (&acc)[2][2][4][2], const pg8::Unit& u, int wr, int wc, int fr, int fq) const {
        bf16_t* base = CT + (size_t)((u.pm + 1) * 4 + u.grp) * 65536;
        pg8::for_each_piece_local(acc, wr, wc, fr, fq, [&](int row, int col, f32x4 v0, f32x4 v1) { *(u32x4*)(base + (size_t)row * 256 + col) = pg8::pack8(v0, v1); }); } };
__device__ __forceinline__ void phase_ms(const Params& p, char* lds, int bid, int nb) {
    phase_m1(p, lds, bid, nb, 1);
    const int tid = TIDX, wid = __builtin_amdgcn_readfirstlane(tid >> 6), lane = tid & 63, c = lane & 15, g = lane >> 4, gw = bid * NW + wid, ngw = nb * NW;
    const bf16_t* KMT = (const bf16_t*)(p.ws + B_KMT); const float* tw = (const float*)(p.ws + TAB_W); float* NTv = (float*)(p.ws + TAB_NT);
    for (int t = gw; t < 64 * 4 * 16; t += ngw) {
        const int dkb = t & 15, h = (t >> 4) & 3, sc = 1 + (t >> 6);
        const bf16_t* kr = KMT + (size_t)(h * 256 + 16 * dkb + c) * P + sc * 256 + 64 * g; const float* wp = tw + (size_t)h * P + sc * 256 + 64 * g;
        float a = 0.f;
#pragma unroll
        for (int i = 0; i < 8; ++i) { const u32x4 kk = *(const u32x4*)(kr + 8 * i); const f32x4 w0 = *(const f32x4*)(wp + 8 * i), w1 = *(const f32x4*)(wp + 8 * i + 4);
            a += bf2f(kk.x & 0xffffu) * w0.x + bf2f(kk.x >> 16) * w0.y + bf2f(kk.y & 0xffffu) * w0.z + bf2f(kk.y >> 16) * w0.w
               + bf2f(kk.z & 0xffffu) * w1.x + bf2f(kk.z >> 16) * w1.y + bf2f(kk.w & 0xffffu) * w1.z + bf2f(kk.w >> 16) * w1.w; }
        a += sx<16>(a); a = sum32(a);
        if (g == 0) NTv[(size_t)(sc * 4 + h) * 256 + 16 * dkb + c] = a;
    }
    SchedM1 S{(const char*)(p.ws + B_VWT), (const char*)KMT, nb, bid, 256, P, P};
    pg8::gemm_phase((PG8_LAS unsigned char*)lds, S, EpiM1{(bf16_t*)(p.ws + B_CT)});
}

__device__ __forceinline__ void phase_m2(const Params& p, char* lds, int bid, int nb) {
    const float* scg = (const float*)(p.ws + TAB_SCG); const float* scm = (const float*)(p.ws + TAB_SCM);
    unsigned* CT = (unsigned*)(p.ws + B_CT); float* NTv = (float*)(p.ws + TAB_NT); float* mt = (float*)(p.ws + TAB_MT);
    const int gid = bid * NT + TIDX, nth = nb * NT;
    for (int i = gid; i < 4 * 32768 + 1024; i += nth) {
        if (i < 4 * 32768) {
            const int h = i >> 15, idx = i & 32767;
            unsigned* base = CT + (size_t)h * 32768 + idx;
            unsigned u[NSC];
#pragma unroll
            for (int sc = 0; sc < NSC; ++sc) u[sc] = base[(size_t)sc * 4 * 32768];
            float m = 0.f, c0 = 0.f, c1 = 0.f;
#pragma unroll
            for (int sc = 0; sc < NSC; ++sc) {
                const float gg = scg[sc * 4 + h], ml = scm[sc * 4 + h], mn = fmaxf(gg + m, ml), dec = __expf(gg + m - mn), cor = __expf(ml - mn);
                c0 = dec * c0 + cor * bf2f(u[sc] & 0xffffu); c1 = dec * c1 + cor * bf2f(u[sc] >> 16);
                base[(size_t)sc * 4 * 32768] = pk2(c0, c1); m = mn;
            }
        } else {
            const int j = i - 4 * 32768, h = j >> 8, d = j & 255;
            float m = 0.f, n = 0.f;
            for (int sc = 0; sc < NSC; ++sc) {
                const float gg = scg[sc * 4 + h], ml = scm[sc * 4 + h], mn = fmaxf(gg + m, ml), dec = __expf(gg + m - mn), cor = __expf(ml - mn);
                float* ptr = NTv + (size_t)(sc * 4 + h) * 256 + d;
                n = dec * n + cor * *ptr; *ptr = n; m = mn;
                if (d == 0) mt[sc * 4 + h] = mn;
            }
        }
    }
}

__device__ __forceinline__ void phase_m3(const Params& p, int l, char* lds, int bid, int nb, bool sc0_only) {
    const int tid = TIDX, wid = __builtin_amdgcn_readfirstlane(tid >> 6), lane = tid & 63, c = lane & 15, g = lane >> 4, gw = bid * NW + wid, ngw = nb * NW;
    const bf16_t* QM = (const bf16_t*)(p.ws + B_QM); const bf16_t* KM = (const bf16_t*)(p.ws + B_KM); const bf16_t* VMT = (const bf16_t*)(p.ws + B_VMT);
    const bf16_t* CT = (const bf16_t*)(p.ws + B_CT); const float* NTv = (const float*)(p.ws + TAB_NT); const float* mt = (const float*)(p.ws + TAB_MT);
    const float* tb = (const float*)(p.ws + TAB_B); const float* te = (const float*)(p.ws + TAB_E); const float* tpm = (const float*)(p.ws + TAB_PM);
    const bf16_t* OP = (const bf16_t*)(p.ws + B_OP); bf16_t* YM = (bf16_t*)(p.ws + B_YM);
    constexpr int NRG = P / 16, RG0 = VALID0 / 16;
    const int ntask = (NRG - RG0) * 4;
    for (int u = (sc0_only ? 256 : 0) + bid; u < (sc0_only ? 260 : NSC * 4 * 2); u += nb) {
        const int half = u < NSC * 4 ? 1 : 0, uu = u < NSC * 4 ? u : u - NSC * 4, sc = (NSC - 1) - (uu >> 2), h = uu & 3, rg = sc * 16 + half * 8 + wid;
        if (rg < RG0) continue;
        const int t0 = rg * 16, row = t0 + c, s_start = sc << 8;
        bf16x8 qf[8];
#pragma unroll
        for (int ks = 0; ks < 8; ++ks) qf[ks] = ld8(QM + (size_t)row * D + h * 256 + 32 * ks + 8 * g);
        const float b_t = tb[(size_t)h * P + row], pm_t = tpm[(size_t)h * P + row];
        const float m_prev = sc > 0 ? mt[(sc - 1) * 4 + h] : 0.f;
        const float m_t = b_t + fmaxf(m_prev, pm_t), scale_t = __expf(b_t + m_prev - m_t);
        f32x4 acc[16];
#pragma unroll
        for (int i = 0; i < 16; ++i) acc[i] = (f32x4){0.f, 0.f, 0.f, 0.f};
        float den = 0.f;
        if (sc > 0) {
            const bf16_t* Cb = CT + (size_t)((sc - 1) * 4 + h) * 65536; const float* nv = NTv + (size_t)((sc - 1) * 4 + h) * 256;
#pragma unroll 2
            for (int ks = 0; ks < 8; ++ks) {
#pragma unroll
                for (int dt = 0; dt < 16; ++dt) acc[dt] = mfma16(ld8(Cb + (size_t)(16 * dt + c) * 256 + 32 * ks + 8 * g), qf[ks], acc[dt]);
                const f32x4 n0 = *(const f32x4*)(nv + 32 * ks + 8 * g), n1 = *(const f32x4*)(nv + 32 * ks + 8 * g + 4);
                const u32x4 qq = *(const u32x4*)&qf[ks];
                den += bf2f(qq.x & 0xffffu) * n0.x + bf2f(qq.x >> 16) * n0.y + bf2f(qq.y & 0xffffu) * n0.z + bf2f(qq.y >> 16) * n0.w
                     + bf2f(qq.z & 0xffffu) * n1.x + bf2f(qq.z >> 16) * n1.y + bf2f(qq.w & 0xffffu) * n1.z + bf2f(qq.w >> 16) * n1.w;
            }
            den *= scale_t;
#pragma unroll
            for (int dt = 0; dt < 16; ++dt) acc[dt] = acc[dt] * scale_t;
        }
        for (int kb = s_start; kb <= t0 + 15; kb += 32) {
            f32x4 s[2];
#pragma unroll
            for (int a = 0; a < 2; ++a) {
                s[a] = (f32x4){0.f, 0.f, 0.f, 0.f};
                const bf16_t* kr = KM + (size_t)(kb + 16 * a + c) * D + h * 256 + 8 * g;
#pragma unroll
                for (int ks = 0; ks < 8; ++ks) s[a] = mfma16(ld8(kr + 32 * ks), qf[ks], s[a]);
                const f32x4 ee = *(const f32x4*)(te + (size_t)h * P + kb + 16 * a + 4 * g);
#pragma unroll
                for (int r = 0; r < 4; ++r) { const int key = kb + 16 * a + 4 * g + r; const float arg = fminf(ee[r] + b_t - m_t, 0.f);
                    const float dd = key <= row ? __expf(arg) : 0.f; const float pv = s[a][r] * dd; s[a][r] = pv; den += pv; }
            }
            u32x4 w; w.x = pk2(s[0][0], s[0][1]); w.y = pk2(s[0][2], s[0][3]); w.z = pk2(s[1][0], s[1][1]); w.w = pk2(s[1][2], s[1][3]);
            const bf16x8 pf = *(bf16x8*)&w;
#pragma unroll
            for (int dt = 0; dt < 16; ++dt) {
                const bf16_t* vr = VMT + (size_t)(h * 256 + 16 * dt + c) * P + kb + 4 * g;
                const u32x2 v0 = *(const u32x2*)vr, v1 = *(const u32x2*)(vr + 16);
                u32x4 vv; vv.x = v0.x; vv.y = v0.y; vv.z = v1.x; vv.w = v1.y;
                acc[dt] = mfma16(*(bf16x8*)&vv, pf, acc[dt]);
            }
        }
        den += sx<16>(den); den = sum32(den);
        const float inv = 1.f / fmaxf(fabsf(den), __expf(-m_t));
        float s1 = 0.f;
#pragma unroll
        for (int dt = 0; dt < 16; ++dt) {
            const u32x2 og = *(const u32x2*)(OP + (size_t)row * D + h * 256 + 16 * dt + 4 * g);
            f32x4 v = acc[dt] * inv;
            v.x *= sigmoidf_(bf2f(og.x & 0xffffu)); v.y *= sigmoidf_(bf2f(og.x >> 16)); v.z *= sigmoidf_(bf2f(og.y & 0xffffu)); v.w *= sigmoidf_(bf2f(og.y >> 16));
            acc[dt] = v; s1 += (v.x + v.y) + (v.z + v.w);
        }
        s1 += sx<16>(s1); s1 = sum32(s1);
        const float mu = s1 * (1.f / 256.f);
        float s2 = 0.f;
#pragma unroll
        for (int dt = 0; dt < 16; ++dt) { acc[dt] = acc[dt] - mu; s2 += (acc[dt].x * acc[dt].x + acc[dt].y * acc[dt].y) + (acc[dt].z * acc[dt].z + acc[dt].w * acc[dt].w); }
        s2 += sx<16>(s2); s2 = sum32(s2);
        const float rstd = rsqrtf(s2 * (1.f / 256.f) + LN_EPS);
#pragma unroll
        for (int dt = 0; dt < 16; ++dt) { const f32x4 gg = *(const f32x4*)(p.in[I_MNG] + (size_t)l * D + h * 256 + 16 * dt + 4 * g);
            store4_bf16(YM + (size_t)row * D + h * 256 + 16 * dt + 4 * g, acc[dt] * rstd * gg); }
    }
}

struct EpiBr1 { float* MRG; const bf16_t* GA;
    __device__ __forceinline__ void operator()(int m, int n, f32x4 v) const { const u32x2 gg = *(const u32x2*)(GA + (size_t)m * D + n);
        f32x4 o; o.x = v.x * sigmoidf_(bf2f(gg.x & 0xffffu)); o.y = v.y * sigmoidf_(bf2f(gg.x >> 16)); o.z = v.z * sigmoidf_(bf2f(gg.y & 0xffffu)); o.w = v.w * sigmoidf_(bf2f(gg.y >> 16));
        *(f32x4*)(MRG + (size_t)m * D + n) = o; } };
struct EpiBr2 { const float* MRG; const bf16_t* GB; bf16_t* OUT;
    __device__ __forceinline__ void operator()(int m, int n, f32x4 v) const { const u32x2 gg = *(const u32x2*)(GB + (size_t)m * D + n); const f32x4 t = *(const f32x4*)(MRG + (size_t)m * D + n);
        f32x4 o; o.x = t.x + v.x * sigmoidf_(bf2f(gg.x & 0xffffu)); o.y = t.y + v.y * sigmoidf_(bf2f(gg.x >> 16)); o.z = t.z + v.z * sigmoidf_(bf2f(gg.y & 0xffffu)); o.w = t.w + v.w * sigmoidf_(bf2f(gg.y >> 16));
        store4_bf16(OUT + (size_t)m * D + n, o); } };
struct EpiOut { float* Z; const bf16_t* H;
    __device__ __forceinline__ void operator()(int m, int n, f32x4 v) const { const u32x2 hh = *(const u32x2*)(H + (size_t)m * D + n);
        f32x4 o; o.x = v.x + DN_ALPHA * bf2f(hh.x & 0xffffu); o.y = v.y + DN_ALPHA * bf2f(hh.x >> 16); o.z = v.z + DN_ALPHA * bf2f(hh.y & 0xffffu); o.w = v.w + DN_ALPHA * bf2f(hh.y >> 16);
        *(f32x4*)(Z + (size_t)m * D + n) = o; } };
constexpr int LDS_TAB_OFF = 131072;
constexpr int LDS_MT_OFF = LDS_TAB_OFF + 256;
constexpr int LDS_STAT_OFF = LDS_TAB_OFF + 2048;
__device__ __forceinline__ void compute_mtab_lds(const Params& p, char* lds) {
    float* mt = (float*)(lds + LDS_MT_OFF);
    const int t = TIDX;
    if (t < 4) { const float* scg = (const float*)(p.ws + TAB_SCG); const float* scm = (const float*)(p.ws + TAB_SCM); float m = 0.f;
        for (int sc = 0; sc < NSC; ++sc) { m = fmaxf(scg[sc * 4 + t] + m, scm[sc * 4 + t]); mt[sc * 4 + t] = m; } }
    __syncthreads();
}
struct SchedQK { const char* A; const char* B; int G, c; int K, lda, ldb;
    __device__ __forceinline__ bool next(int i, pg8::Unit& u) const { if (!pg8::decode_unit((long)i * G + c, 4, 64, 1, u)) return false; u.pm += 1; return true; }
    __device__ __forceinline__ const char* abase(const pg8::Unit& u) const { return A + ((size_t)u.pm * 256 * D + u.grp * 256) * 2; }
    __device__ __forceinline__ const char* bbase(const pg8::Unit& u) const { return B + ((size_t)u.pm * 256 * D + u.grp * 256) * 2; } };
struct EpiS { unsigned char* ws; const float* mt_lds;
    __device__ __forceinline__ void operator()(const f32x4 (&acc)[2][2][4][2], const pg8::Unit& u, int wr, int wc, int fr, int fq) const {
        asm volatile("" : "+v"(fr), "+v"(fq));
        const int h = u.grp, t0 = u.pm * 256; const float m_prev = mt_lds[(u.pm - 1) * 4 + h];
        const float* te = (const float*)(ws + TAB_E) + (size_t)h * P + t0; const float* tpm = (const float*)(ws + TAB_PM) + (size_t)h * P + t0;
        bf16_t* PMb = (bf16_t*)(ws + B_PM) + (size_t)t0 * D + h * 256; float* denp = (float*)(ws + TAB_DENP);
        const int c0 = wc * 32 + 8 * fq;
        f32x4 e[2][2];
#pragma unroll
        for (int bj = 0; bj < 2; ++bj) { e[bj][0] = *(const f32x4*)(te + c0 + bj * 128); e[bj][1] = *(const f32x4*)(te + c0 + bj * 128 + 4); }
#pragma unroll
        for (int ai = 0; ai < 2; ++ai)
#pragma unroll
            for (int m = 0; m < 4; ++m) { const int r = ai * 128 + wr * 64 + m * 16 + fr; const float pmx = fmaxf(m_prev, tpm[r]); float rs = 0.f;
#pragma unroll
                for (int bj = 0; bj < 2; ++bj) { f32x4 o0, o1;
#pragma unroll
                    for (int j = 0; j < 4; ++j) { const int s0 = c0 + bj * 128 + j, s1 = s0 + 4;
                        o0[j] = s0 <= r ? acc[ai][bj][m][0][j] * __expf(fminf(e[bj][0][j] - pmx, 0.f)) : 0.f;
                        o1[j] = s1 <= r ? acc[ai][bj][m][1][j] * __expf(fminf(e[bj][1][j] - pmx, 0.f)) : 0.f;
                        rs += o0[j] + o1[j]; }
                    *(u32x4*)(PMb + (size_t)r * D + c0 + bj * 128) = pg8::pack8(o0, o1); }
                rs += sx<16>(rs); rs = sum32(rs);
                if (fq == 0) denp[((size_t)(t0 + r) * 4 + h) * 4 + wc] = rs; } } };
struct SchedO1 { const char* A; const char* B; int G, c; int K, lda, ldb;
    __device__ __forceinline__ bool next(int i, pg8::Unit& u) const { if (!pg8::decode_unit((long)i * G + c, 4, 64, 1, u)) return false; u.pm += 1; return true; }
    __device__ __forceinline__ const char* abase(const pg8::Unit& u) const { return A + ((size_t)u.pm * 256 * D + u.grp * 256) * 2; }
    __device__ __forceinline__ const char* bbase(const pg8::Unit& u) const { return B + (size_t)((u.pm - 1) * 4 + u.grp) * 65536 * 2; } };
struct EpiO1 { unsigned char* ws;
    __device__ __forceinline__ void operator()(const f32x4 (&acc)[2][2][4][2], const pg8::Unit& u, int wr, int wc, int fr, int fq) const {
        asm volatile("" : "+v"(fr), "+v"(fq));
        const int h = u.grp, t0 = u.pm * 256; const float m_prev = ((const float*)(ws + TAB_MT))[(u.pm - 1) * 4 + h];
        const float* tpm = (const float*)(ws + TAB_PM) + (size_t)h * P + t0; bf16_t* OI = (bf16_t*)(ws + B_OI) + (size_t)t0 * D + h * 256;
        const int c0 = wc * 32 + 8 * fq;
#pragma unroll
        for (int ai = 0; ai < 2; ++ai)
#pragma unroll
            for (int m = 0; m < 4; ++m) { const int r = ai * 128 + wr * 64 + m * 16 + fr; const float sc = __expf(fminf(m_prev - tpm[r], 0.f));
#pragma unroll
                for (int bj = 0; bj < 2; ++bj) *(u32x4*)(OI + (size_t)r * D + c0 + bj * 128) = pg8::pack8(acc[ai][bj][m][0] * sc, acc[ai][bj][m][1] * sc); } } };
struct SchedO2 { const char* A; const char* B; int G, c; int K, lda, ldb;
    __device__ __forceinline__ bool next(int i, pg8::Unit& u) const { if (!pg8::decode_unit((long)i * G + c, 4, 64, 1, u)) return false; u.pm += 1; return true; }
    __device__ __forceinline__ const char* abase(const pg8::Unit& u) const { return A + ((size_t)u.pm * 256 * D + u.grp * 256) * 2; }
    __device__ __forceinline__ const char* bbase(const pg8::Unit& u) const { return B + ((size_t)u.grp * 256 * P + (size_t)u.pm * 256) * 2; } };
struct EpiO2 { unsigned char* ws; const float* mng; float* stat;
    __device__ __forceinline__ void operator()(f32x4 (&acc)[2][2][4][2], const pg8::Unit& u, int wr, int wc, int fr, int fq) const {
        asm volatile("" : "+v"(fr), "+v"(fq));
        const int h = u.grp, t0 = u.pm * 256; const float m_prev = ((const float*)(ws + TAB_MT))[(u.pm - 1) * 4 + h];
        const float* tpm = (const float*)(ws + TAB_PM) + (size_t)h * P + t0; const float* tb = (const float*)(ws + TAB_B) + (size_t)h * P + t0;
        const float* denp = (const float*)(ws + TAB_DENP); const float* deni = (const float*)(ws + TAB_DENI);
        const bf16_t* OI = (const bf16_t*)(ws + B_OI) + (size_t)t0 * D + h * 256; const bf16_t* OP = (const bf16_t*)(ws + B_OP) + (size_t)t0 * D + h * 256;
        bf16_t* YM = (bf16_t*)(ws + B_YM) + (size_t)t0 * D + h * 256;
        const int c0 = wc * 32 + 8 * fq;
#pragma unroll
        for (int ai = 0; ai < 2; ++ai)
#pragma unroll
            for (int m = 0; m < 4; ++m) { const int r = ai * 128 + wr * 64 + m * 16 + fr;
                const f32x4 dp = *(const f32x4*)(denp + ((size_t)(t0 + r) * 4 + h) * 4); const float den = (dp.x + dp.y) + (dp.z + dp.w) + deni[(size_t)(t0 + r) * 4 + h];
                const float m_t = tb[r] + fmaxf(m_prev, tpm[r]); const float inv = 1.f / fmaxf(fabsf(den), __expf(-m_t));
                float s1 = 0.f, s2 = 0.f;
#pragma unroll
                for (int bj = 0; bj < 2; ++bj) { f32x4 i0, i1, g0, g1; pg8::unpack8(*(const u32x4*)(OI + (size_t)r * D + c0 + bj * 128), i0, i1); pg8::unpack8(*(const u32x4*)(OP + (size_t)r * D + c0 + bj * 128), g0, g1);
                    f32x4 v0 = (acc[ai][bj][m][0] + i0) * inv * sig4(g0), v1 = (acc[ai][bj][m][1] + i1) * inv * sig4(g1);
                    acc[ai][bj][m][0] = v0; acc[ai][bj][m][1] = v1;
                    s1 += (v0.x + v0.y) + (v0.z + v0.w) + (v1.x + v1.y) + (v1.z + v1.w);
                    s2 += (v0.x * v0.x + v0.y * v0.y) + (v0.z * v0.z + v0.w * v0.w) + (v1.x * v1.x + v1.y * v1.y) + (v1.z * v1.z + v1.w * v1.w); }
                s1 += sx<16>(s1); s1 = sum32(s1); s2 += sx<16>(s2); s2 = sum32(s2);
                if (fq == 0) { stat[(r * 4 + wc) * 2] = s1; stat[(r * 4 + wc) * 2 + 1] = s2; } }
        asm volatile("s_waitcnt lgkmcnt(0)" ::: "memory"); __builtin_amdgcn_s_barrier(); asm volatile("" ::: "memory");
#pragma unroll
        for (int ai = 0; ai < 2; ++ai)
#pragma unroll
            for (int m = 0; m < 4; ++m) { const int r = ai * 128 + wr * 64 + m * 16 + fr;
                const f32x4 a = *(const f32x4*)(stat + r * 8), b = *(const f32x4*)(stat + r * 8 + 4);
                const float mu = ((a.x + a.z) + (b.x + b.z)) * (1.f / 256.f), ex2 = ((a.y + a.w) + (b.y + b.w)) * (1.f / 256.f);
                const float rstd = rsqrtf(fmaxf(ex2 - mu * mu, 0.f) + LN_EPS);
#pragma unroll
                for (int bj = 0; bj < 2; ++bj) { const f32x4 g0 = *(const f32x4*)(mng + h * 256 + c0 + bj * 128), g1 = *(const f32x4*)(mng + h * 256 + c0 + bj * 128 + 4);
                    *(u32x4*)(YM + (size_t)r * D + c0 + bj * 128) = pg8::pack8((acc[ai][bj][m][0] - mu) * rstd * g0, (acc[ai][bj][m][1] - mu) * rstd * g1); } } } };
__device__ __forceinline__ void phase_o1(const Params& p, char* lds, int bid, int nb) {
    const int tid = TIDX, wid = __builtin_amdgcn_readfirstlane(tid >> 6), lane = tid & 63, c = lane & 15, g = lane >> 4, gw = bid * NW + wid, ngw = nb * NW;
    const bf16_t* QM = (const bf16_t*)(p.ws + B_QM); const float* NTv = (const float*)(p.ws + TAB_NT); const float* mt = (const float*)(p.ws + TAB_MT);
    const float* tpm = (const float*)(p.ws + TAB_PM); float* deni = (float*)(p.ws + TAB_DENI);
    for (int it = gw; it < ((P - 256) / 16) * 4; it += ngw) {
        const int h = it & 3, t = 256 + (it >> 2) * 16 + c, sc = t >> 8;
        const bf16_t* qr = QM + (size_t)t * D + h * 256 + 64 * g; const float* nv = NTv + (size_t)((sc - 1) * 4 + h) * 256 + 64 * g;
        float a = 0.f;
#pragma unroll
        for (int i = 0; i < 8; ++i) { const u32x4 qq = *(const u32x4*)(qr + 8 * i); const f32x4 n0 = *(const f32x4*)(nv + 8 * i), n1 = *(const f32x4*)(nv + 8 * i + 4);
            a += bf2f(qq.x & 0xffffu) * n0.x + bf2f(qq.x >> 16) * n0.y + bf2f(qq.y & 0xffffu) * n0.z + bf2f(qq.y >> 16) * n0.w
               + bf2f(qq.z & 0xffffu) * n1.x + bf2f(qq.z >> 16) * n1.y + bf2f(qq.w & 0xffffu) * n1.z + bf2f(qq.w >> 16) * n1.w; }
        a += sx<16>(a); a = sum32(a);
        if (g == 0) deni[(size_t)t * 4 + h] = a * __expf(fminf(mt[(sc - 1) * 4 + h] - tpm[(size_t)h * P + t], 0.f));
    }
    SchedO1 S{(const char*)QM, (const char*)(p.ws + B_CT), nb, bid, 256, D, 256};
    pg8::gemm_phase((PG8_LAS unsigned char*)lds, S, EpiO1{p.ws});
}
__device__ __forceinline__ void phase_sg(const Params& p, char* lds, int bid, int nb) {
    compute_mtab_lds(p, lds);
    SchedQK S{(const char*)(p.ws + B_QM), (const char*)(p.ws + B_KM), nb, bid, 256, D, D};
    pg8::gemm_phase((PG8_LAS unsigned char*)lds, S, EpiS{p.ws, (const float*)(lds + LDS_MT_OFF)});
}
__device__ __forceinline__ void phase_o2(const Params& p, int l, char* lds, int bid, int nb) {
    phase_m3(p, l, lds, bid, nb, true);
    SchedO2 S{(const char*)(p.ws + B_PM), (const char*)(p.ws + B_VMT), nb, bid, 256, D, P};
    pg8::gemm_phase((PG8_LAS unsigned char*)lds, S, EpiO2{p.ws, p.in[I_MNG] + (size_t)l * D, (float*)(lds + LDS_STAT_OFF)});
}

struct SchedMqkvN { const char* XC; const char* WQ; const char* WK; int G, c; int K, lda, ldb;
    __device__ __forceinline__ bool next(int i, pg8::Unit& u) const { if (!pg8::decode_unit((long)i * G + c, 8, 64, 1, u)) return false; u.pm += 1; return true; }
    __device__ __forceinline__ const char* abase(const pg8::Unit& u) const { return XC + (size_t)(u.grp & 3) * 512 + (size_t)u.pm * 256 * D * 2; }
    __device__ __forceinline__ const char* bbase(const pg8::Unit& u) const { return ((u.grp >> 2) ? WK : WQ) + (size_t)(u.grp & 3) * 65536 * 2; } };
struct SchedMqkvT { const char* XC; const char* XM; const char* WK; const char* WV; int G, c; int K, lda, ldb;
    __device__ __forceinline__ bool next(int i, pg8::Unit& u) const { if (!pg8::decode_unit((long)i * G + c, 8, 1, 64, u)) return false; u.pn += 1; return true; }
    __device__ __forceinline__ const char* abase(const pg8::Unit& u) const { return ((u.grp >> 2) ? WV : WK) + (size_t)(u.grp & 3) * 65536 * 2; }
    __device__ __forceinline__ const char* bbase(const pg8::Unit& u) const { return ((u.grp >> 2) ? XM : XC) + (size_t)(u.grp & 3) * 512 + (size_t)u.pn * 256 * D * 2; } };
struct EpiGrpF { bf16_t* base0; bf16_t* base1; size_t hstride; size_t ldc; float s0, s1;
    __device__ __forceinline__ void operator()(const f32x4 (&acc)[2][2][4][2], const pg8::Unit& u, int wr, int wc, int fr, int fq) const {
        const int which = u.grp >> 2, h = u.grp & 3; const float sc = which ? s1 : s0;
        bf16_t* base = (which ? base1 : base0) + (size_t)h * hstride + (size_t)u.pn * 256;
        const size_t ld = ldc;
        pg8::for_each_piece(acc, u, wr, wc, fr, fq, [&](int row, int col, f32x4 v0, f32x4 v1) { *(u32x4*)(base + (size_t)row * ld + col) = pg8::pack8(v0 * sc, v1 * sc); }); } };
struct EpiMqkvT { unsigned char* ws;
    __device__ __forceinline__ void operator()(const f32x4 (&acc)[2][2][4][2], const pg8::Unit& u, int wr, int wc, int fr, int fq) const {
        bf16_t* KMT = (bf16_t*)(ws + B_KMT); bf16_t* VMT = (bf16_t*)(ws + B_VMT); bf16_t* VWT = (bf16_t*)(ws + B_VWT); const float* tw = (const float*)(ws + TAB_W);
        const int which = u.grp >> 2, h = u.grp & 3; const size_t cb = (size_t)u.pn * 256;
        if (which == 0) { bf16_t* base = KMT + (size_t)h * 256 * P + cb;
            pg8::for_each_piece(acc, u, wr, wc, fr, fq, [&](int row, int col, f32x4 v0, f32x4 v1) { *(u32x4*)(base + (size_t)row * P + col) = pg8::pack8(v0 * 0.0625f, v1 * 0.0625f); });
        } else { bf16_t* b0 = VMT + (size_t)h * 256 * P + cb; bf16_t* b1 = VWT + (size_t)h * 256 * P + cb; const float* w = tw + (size_t)h * P + cb;
            pg8::for_each_piece(acc, u, wr, wc, fr, fq, [&](int row, int col, f32x4 v0, f32x4 v1) { const f32x4 w0 = *(const f32x4*)(w + col), w1 = *(const f32x4*)(w + col + 4);
                *(u32x4*)(b0 + (size_t)row * P + col) = pg8::pack8(v0, v1); *(u32x4*)(b1 + (size_t)row * P + col) = pg8::pack8(v0 * w0, v1 * w1); }); } } };
struct EpiStoreW { bf16_t* C0; bf16_t* C1; size_t ldc; const float* w;
    __device__ __forceinline__ void operator()(int m, int n, f32x4 v) const { store4_bf16(C0 + (size_t)m * ldc + n, v); const f32x4 ww = *(const f32x4*)(w + n); store4_bf16(C1 + (size_t)m * ldc + n, v * ww); } };
__device__ __forceinline__ void phase_mqkv_f(const Params& p, char* lds, int bid, int nb) {
    const int tid = TIDX, wid = tid >> 6, gw = bid * NW + wid, ngw = nb * NW;
    const bf16_t* XC = (const bf16_t*)(p.ws + B_XC); const bf16_t* XM = (const bf16_t*)(p.ws + B_XM);
    const bf16_t* WQ = (const bf16_t*)(p.ws + W_Q_T); const bf16_t* WK = (const bf16_t*)(p.ws + W_K_T); const bf16_t* WV = (const bf16_t*)(p.ws + W_V_T);
    bf16_t* QM = (bf16_t*)(p.ws + B_QM); bf16_t* KM = (bf16_t*)(p.ws + B_KM); bf16_t* KMT = (bf16_t*)(p.ws + B_KMT); bf16_t* VMT = (bf16_t*)(p.ws + B_VMT); bf16_t* VWT = (bf16_t*)(p.ws + B_VWT);
    zero_block(KM, D, VALID0, D, bid * NT + tid, nb * NT);
    zero_block(VWT, P, D, VALID0, bid * NT + tid, nb * NT);
    zero_block(KMT, P, D, VALID0, bid * NT + tid, nb * NT);
    zero_block(VMT, P, D, VALID0, bid * NT + tid, nb * NT);
    for (int t = gw; t < 64; t += ngw) {
        const int which = (t >> 4) & 1, h = (t >> 2) & 3, q = t & 3;
        if (t < 32) sgemm_wave<1, 4>(RowsPlain{XC + h * 256, D}, RowsPlain{(which ? WK : WQ) + (size_t)h * 65536, 256}, 256, VALID0, q * 64, EpiStore{(which ? KM : QM) + h * 256, D, which ? 0.0625f : 1.f});
        else if (which == 0) sgemm_wave<4, 1>(RowsPlain{WK + (size_t)h * 65536, 256}, RowsPlain{XC + h * 256, D}, 256, q * 64, VALID0, EpiStore{KMT + (size_t)h * 256 * P, P, 0.0625f});
        else sgemm_wave<4, 1>(RowsPlain{WV + (size_t)h * 65536, 256}, RowsPlain{XM + h * 256, D}, 256, q * 64, VALID0, EpiStoreW{VMT + (size_t)h * 256 * P, VWT + (size_t)h * 256 * P, P, (const float*)(p.ws + TAB_W) + (size_t)h * P});
    }
    { SchedMqkvN S{(const char*)XC, (const char*)WQ, (const char*)WK, nb, bid, 256, D, 256};
      pg8::gemm_phase((PG8_LAS unsigned char*)lds, S, EpiGrpF{QM, KM, 256, D, 1.f, 0.0625f}); }
    { SchedMqkvT S{(const char*)XC, (const char*)XM, (const char*)WK, (const char*)WV, nb, bid, 256, 256, D};
      pg8::gemm_phase((PG8_LAS unsigned char*)lds, S, EpiMqkvT{p.ws}); }
}
struct SchedSq { const char* A; const char* B; int G, c; int K, lda, ldb;
    __device__ __forceinline__ bool next(int i, pg8::Unit& u) const { if (!pg8::decode_unit((long)i * G + c, 1, 64, 4, u)) return false; u.pm += 1; return true; }
    __device__ __forceinline__ const char* abase(const pg8::Unit& u) const { return A + (size_t)u.pm * 256 * D * 2; }
    __device__ __forceinline__ const char* bbase(const pg8::Unit& u) const { return B + (size_t)u.pn * 256 * D * 2; } };
struct EpiBr1F { float* MRG; const bf16_t* GA;
    __device__ __forceinline__ void operator()(const f32x4 (&acc)[2][2][4][2], const pg8::Unit& u, int wr, int wc, int fr, int fq) const {
        const int cb = u.pn * 256;
        pg8::for_each_piece(acc, u, wr, wc, fr, fq, [&](int row, int col, f32x4 v0, f32x4 v1) { const size_t idx = (size_t)row * D + cb + col;
            f32x4 g0, g1; pg8::unpack8(*(const u32x4*)(GA + idx), g0, g1);
            *(f32x4*)(MRG + idx) = v0 * sig4(g0); *(f32x4*)(MRG + idx + 4) = v1 * sig4(g1); }); } };
struct EpiBr2F { const float* MRG; const bf16_t* GB; bf16_t* OUT;
    __device__ __forceinline__ void operator()(const f32x4 (&acc)[2][2][4][2], const pg8::Unit& u, int wr, int wc, int fr, int fq) const {
        const int cb = u.pn * 256;
        pg8::for_each_piece(acc, u, wr, wc, fr, fq, [&](int row, int col, f32x4 v0, f32x4 v1) { const size_t idx = (size_t)row * D + cb + col;
            f32x4 g0, g1; pg8::unpack8(*(const u32x4*)(GB + idx), g0, g1);
            const f32x4 t0 = *(const f32x4*)(MRG + idx), t1 = *(const f32x4*)(MRG + idx + 4);
            *(u32x4*)(OUT + idx) = pg8::pack8(t0 + v0 * sig4(g0), t1 + v1 * sig4(g1)); }); } };
struct EpiOutF { float* Z; const bf16_t* H;
    __device__ __forceinline__ void operator()(const f32x4 (&acc)[2][2][4][2], const pg8::Unit& u, int wr, int wc, int fr, int fq) const {
        const int cb = u.pn * 256;
        pg8::for_each_piece(acc, u, wr, wc, fr, fq, [&](int row, int col, f32x4 v0, f32x4 v1) { const size_t idx = (size_t)row * D + cb + col;
            f32x4 h0, h1; pg8::unpack8(*(const u32x4*)(H + idx), h0, h1);
            *(f32x4*)(Z + idx) = v0 + h0 * DN_ALPHA; *(f32x4*)(Z + idx + 4) = v1 + h1 * DN_ALPHA; }); } };
__device__ __forceinline__ void phase_br1_f(const Params& p, char* lds, int bid, int nb) {
    const int gw = bid * NW + (TIDX >> 6), ngw = nb * NW;
    const bf16_t* A = (const bf16_t*)(p.ws + B_YM); const bf16_t* W = (const bf16_t*)(p.ws + W_BM_T);
    for (int t = gw; t < 16; t += ngw) sgemm_wave<1, 4>(RowsPlain{A, D}, RowsPlain{W, D}, D, VALID0, t * 64, EpiBr1{(float*)(p.ws + B_MRG), (const bf16_t*)(p.ws + B_GA)});
    SchedSq S{(const char*)A, (const char*)W, nb, bid, D, D, D};
    pg8::gemm_phase((PG8_LAS unsigned char*)lds, S, EpiBr1F{(float*)(p.ws + B_MRG), (const bf16_t*)(p.ws + B_GA)});
}
__device__ __forceinline__ void phase_br2_f(const Params& p, char* lds, int bid, int nb) {
    const int gw = bid * NW + (TIDX >> 6), ngw = nb * NW;
    const bf16_t* A = (const bf16_t*)(p.ws + B_YA); const bf16_t* W = (const bf16_t*)(p.ws + W_BA_T);
    for (int t = gw; t < 16; t += ngw) sgemm_wave<1, 4>(RowsPlain{A, D}, RowsPlain{W, D}, D, VALID0, t * 64, EpiBr2{(const float*)(p.ws + B_MRG), (const bf16_t*)(p.ws + B_GB), (bf16_t*)(p.ws + B_MRGB)});
    SchedSq S{(const char*)A, (const char*)W, nb, bid, D, D, D};
    pg8::gemm_phase((PG8_LAS unsigned char*)lds, S, EpiBr2F{(const float*)(p.ws + B_MRG), (const bf16_t*)(p.ws + B_GB), (bf16_t*)(p.ws + B_MRGB)});
}
__device__ __forceinline__ void phase_out_f(const Params& p, char* lds, int bid, int nb) {
    const int gw = bid * NW + (TIDX >> 6), ngw = nb * NW;
    const bf16_t* A = (const bf16_t*)(p.ws + B_MRGB); const bf16_t* W = (const bf16_t*)(p.ws + W_OUT_T);
    for (int t = gw; t < 16; t += ngw) sgemm_wave<1, 4>(RowsPlain{A, D}, RowsPlain{W, D}, D, VALID0, t * 64, EpiOut{(float*)(p.ws + B_Z), (const bf16_t*)(p.ws + B_H)});
    SchedSq S{(const char*)A, (const char*)W, nb, bid, D, D, D};
    pg8::gemm_phase((PG8_LAS unsigned char*)lds, S, EpiOutF{(float*)(p.ws + B_Z), (const bf16_t*)(p.ws + B_H)});
}

__device__ __forceinline__ void phase_ln1(const Params& p, int l, char* lds, int bid, int nb) {
    const int tid = TIDX, wid = tid >> 6, lane = tid & 63, gw = bid * NW + wid, ngw = nb * NW;
    float* wr = (float*)lds;
    for (int i = tid; i < D * 16 / 4; i += NT) ((f32x4*)wr)[i] = ((const f32x4*)p.in[I_WR])[i];
    __syncthreads();
    const float* Z = (const float*)(p.ws + B_Z); bf16_t* H1 = (bf16_t*)(p.ws + B_H1);
    unsigned* cnt = (unsigned*)(p.ws + WS_CTL) + CW_CNT + l * 16; int* elist = (int*)(p.ws + TAB_ELIST); float* topk = (float*)(p.ws + TAB_TOPK);
    for (int r = gw; r < P; r += ngw) {
        if (r < VALID0) { store_row_zero(H1 + (size_t)r * D, lane); continue; }
        f32x4 v[4];
#pragma unroll
        for (int j = 0; j < 4; ++j) v[j] = *(const f32x4*)(Z + (size_t)r * D + 4 * lane + 256 * j);
        ln_normalize(v, p.in[I_LN1G] + (size_t)l * D, p.in[I_LN1B] + (size_t)l * D, lane);
        store_row_bf16(H1 + (size_t)r * D, v, lane);
        float lg[16];
#pragma unroll
        for (int e = 0; e < 16; ++e) lg[e] = 0.f;
#pragma unroll
        for (int j = 0; j < 4; ++j)
#pragma unroll
            for (int i = 0; i < 4; ++i) { const int k = 4 * lane + 256 * j + i; const float x = v[j][i];
#pragma unroll
                for (int q = 0; q < 4; ++q) { const f32x4 w = *(const f32x4*)(wr + k * 16 + 4 * q); lg[4 * q] += x * w.x; lg[4 * q + 1] += x * w.y; lg[4 * q + 2] += x * w.z; lg[4 * q + 3] += x * w.w; } }
#pragma unroll
        for (int e = 0; e < 16; ++e) lg[e] = wave_sum(lg[e]);
        if (lane == 0) {
            float mx = lg[0];
#pragma unroll
            for (int e = 1; e < 16; ++e) mx = fmaxf(mx, lg[e]);
            float pr[16], sum = 0.f;
#pragma unroll
            for (int e = 0; e < 16; ++e) { pr[e] = expf(lg[e] - mx); sum += pr[e]; }
            const float isum = 1.f / sum;
            float sel[16];
#pragma unroll
            for (int e = 0; e < 16; ++e) { pr[e] *= isum; sel[e] = pr[e] + p.in[I_RB][e]; }
            int tg = 0; float best = -INFINITY;
#pragma unroll
            for (int gI = 0; gI < 4; ++gI) { const float gs = fmaxf(fmaxf(sel[4 * gI], sel[4 * gI + 1]), fmaxf(sel[4 * gI + 2], sel[4 * gI + 3])); if (gs > best) { best = gs; tg = gI; } }
            int i0 = 0; float b0 = -INFINITY;
#pragma unroll
            for (int e = 0; e < 16; ++e) if ((e >> 2) == tg && sel[e] > b0) { b0 = sel[e]; i0 = e; }
            int i1 = 0; float b1 = -INFINITY;
#pragma unroll
            for (int e = 0; e < 16; ++e) if ((e >> 2) == tg && e != i0 && sel[e] > b1) { b1 = sel[e]; i1 = e; }
            float p0 = 0.f, p1 = 0.f;
#pragma unroll
            for (int e = 0; e < 16; ++e) { if (e == i0) p0 = pr[e]; if (e == i1) p1 = pr[e]; }
            const float inv = 1.f / (p0 + p1);
            const unsigned pos0 = atomicAdd(cnt + i0, 1u), pos1 = atomicAdd(cnt + i1, 1u);
            elist[(size_t)i0 * P + pos0] = r; elist[(size_t)i1 * P + pos1] = r;
            float* tk = topk + (size_t)r * 8;
            ((int*)tk)[0] = i0; ((int*)tk)[1] = i1; ((int*)tk)[2] = (int)pos0; ((int*)tk)[3] = (int)pos1; tk[4] = p0 * inv; tk[5] = p1 * inv;
        }
    }
}

__device__ __forceinline__ void expert_offsets(const unsigned* cnt, int* s_cnt, int* s_off, int* s_tiles) {
    int off = 0;
    if (TIDX == 0) { int tt = 0; for (int e = 0; e < 16; ++e) { const int c = (int)cnt[e]; const int tl = (c + 255) >> 8; s_cnt[e] = c; s_off[e] = off; s_tiles[e] = tt; off += tl * 256; tt += tl; } s_tiles[16] = tt; }
    __syncthreads();
}
__device__ __forceinline__ void phase_perm(const Params& p, int l, char* lds, int bid, int nb) {
    int* s_cnt = (int*)(lds + LDS_TAB_OFF); int* s_off = s_cnt + 16; int* s_tiles = s_off + 16;
    expert_offsets((const unsigned*)(p.ws + WS_CTL) + CW_CNT + l * 16, s_cnt, s_off, s_tiles);
    const int tid = TIDX, wid = tid >> 6, lane = tid & 63, gw = bid * NW + wid, ngw = nb * NW;
    const bf16_t* H1 = (const bf16_t*)(p.ws + B_H1); bf16_t* XP = (bf16_t*)(p.ws + B_XP); const float* topk = (const float*)(p.ws + TAB_TOPK);
    for (int r = VALID0 + gw; r < P; r += ngw) {
        const int* tk = (const int*)(topk + (size_t)r * 8);
        const int e0 = tk[0], e1 = tk[1], p0 = tk[2], p1 = tk[3];
        const u32x4* src = (const u32x4*)(H1 + (size_t)r * D) + lane * 2;
        const u32x4 a = src[0], b = src[1];
        u32x4* d0 = (u32x4*)(XP + (size_t)(s_off[e0] + p0) * D) + lane * 2; u32x4* d1 = (u32x4*)(XP + (size_t)(s_off[e1] + p1) * D) + lane * 2;
        d0[0] = a; d0[1] = b; d1[0] = a; d1[1] = b;
    }
}
struct SchedMoE { const char* A; const char* B; size_t estride; int nN; const int* s_off; const int* s_tiles; int G, c; int K, lda, ldb;
    __device__ __forceinline__ bool next(int i, pg8::Unit& u) const {
        const int nwg = s_tiles[16] * nN; const long L = (long)i * G + c; if (L >= nwg) return false;
        int wgid = (int)L; { const int q = nwg / 8, r = nwg % 8, xcd = wgid % 8, off = wgid / 8; wgid = (xcd < r ? xcd * (q + 1) : r * (q + 1) + (xcd - r) * q) + off; }
        const int rt = wgid / nN; int e = 0;
        while (e < 15 && rt >= s_tiles[e + 1]) ++e;
        u.grp = __builtin_amdgcn_readfirstlane(e); u.pm = __builtin_amdgcn_readfirstlane((s_off[e] >> 8) + rt - s_tiles[e]); u.pn = __builtin_amdgcn_readfirstlane(wgid % nN); return true; }
    __device__ __forceinline__ const char* abase(const pg8::Unit& u) const { return A + (size_t)u.pm * 256 * D * 2; }
    __device__ __forceinline__ const char* bbase(const pg8::Unit& u) const { return B + (size_t)u.grp * estride + (size_t)u.pn * 256 * D * 2; } };
struct EpiE1F { bf16_t* HID;
    __device__ __forceinline__ void operator()(const f32x4 (&acc)[2][2][4][2], const pg8::Unit& u, int wr, int wc, int fr, int fq) const {
        asm volatile("" : "+v"(fr), "+v"(fq));
        const int row0 = u.pm * 256 + wr * 64 + fr, col0 = u.pn * 128 + wc * 32 + 8 * fq;
#pragma unroll
        for (int ai = 0; ai < 2; ++ai)
#pragma unroll
            for (int m = 0; m < 4; ++m) { f32x4 h0, h1;
#pragma unroll
                for (int r = 0; r < 4; ++r) { h0[r] = siluf_(acc[ai][0][m][0][r]) * acc[ai][1][m][0][r]; h1[r] = siluf_(acc[ai][0][m][1][r]) * acc[ai][1][m][1][r]; }
                *(u32x4*)(HID + (size_t)(row0 + ai * 128 + m * 16) * D + col0) = pg8::pack8(h0, h1); } } };
struct EpiE2F { bf16_t* YB;
    __device__ __forceinline__ void operator()(const f32x4 (&acc)[2][2][4][2], const pg8::Unit& u, int wr, int wc, int fr, int fq) const {
        bf16_t* base = YB + u.pn * 256;
        pg8::for_each_piece(acc, u, wr, wc, fr, fq, [&](int row, int col, f32x4 v0, f32x4 v1) { *(u32x4*)(base + (size_t)row * D + col) = pg8::pack8(v0, v1); }); } };
__device__ __forceinline__ void phase_e1_f(const Params& p, int l, char* lds, int bid, int nb) {
    int* s_cnt = (int*)(lds + LDS_TAB_OFF); int* s_off = s_cnt + 16; int* s_tiles = s_off + 16;
    expert_offsets((const unsigned*)(p.ws + WS_CTL) + CW_CNT + l * 16, s_cnt, s_off, s_tiles);
    SchedMoE S{(const char*)(p.ws + B_XP), (const char*)(p.ws + W_G_T), (size_t)2048 * D * 2, 8, s_off, s_tiles, nb, bid, D, D, D};
    pg8::gemm_phase((PG8_LAS unsigned char*)lds, S, EpiE1F{(bf16_t*)(p.ws + B_HID)});
}
__device__ __forceinline__ void phase_e2_f(const Params& p, int l, char* lds, int bid, int nb) {
    int* s_cnt = (int*)(lds + LDS_TAB_OFF); int* s_off = s_cnt + 16; int* s_tiles = s_off + 16;
    expert_offsets((const unsigned*)(p.ws + WS_CTL) + CW_CNT + l * 16, s_cnt, s_off, s_tiles);
    SchedMoE S{(const char*)(p.ws + B_HID), (const char*)(p.ws + W_D_T), (size_t)D * D * 2, 4, s_off, s_tiles, nb, bid, D, D, D};
    pg8::gemm_phase((PG8_LAS unsigned char*)lds, S, EpiE2F{(bf16_t*)(p.ws + B_YB)});
}

__device__ __forceinline__ void phase_combine(const Params& p, int l, char* lds, int bid, int nb) {
    const int tid = TIDX, wid = tid >> 6, lane = tid & 63, gw = bid * NW + wid, ngw = nb * NW;
    const bool last = (l == DEPTH - 1);
    if (!last) { convert_weights(p, l + 1, lds, gw, ngw, wid, lane); __syncthreads(); }
    int* s_cnt = (int*)(lds + 65536); int* s_off = s_cnt + 16; int* s_tiles = s_off + 16;
    expert_offsets((const unsigned*)(p.ws + WS_CTL) + CW_CNT + l * 16, s_cnt, s_off, s_tiles);
    float* g8 = (float*)lds;
    if (!last) load_gate_w(p, l + 1, g8);
    const bf16_t* H1 = (const bf16_t*)(p.ws + B_H1); const bf16_t* YB = (const bf16_t*)(p.ws + B_YB); bf16_t* H = (bf16_t*)(p.ws + B_H);
    const float* topk = (const float*)(p.ws + TAB_TOPK);
    for (int r = gw; r < P; r += ngw) {
        if (r < VALID0) { if (!last) { store_row_zero(H + (size_t)r * D, lane); gates_row_pad(p, r, lane); } continue; }
        if (last && r < 256) continue;
        const float* tk = topk + (size_t)r * 8;
        const int e0 = ((const int*)tk)[0], e1 = ((const int*)tk)[1], p0 = ((const int*)tk)[2], p1 = ((const int*)tk)[3]; const float w0 = tk[4], w1 = tk[5];
        const bf16_t* y0 = YB + (size_t)(s_off[e0] + p0) * D; const bf16_t* y1 = YB + (size_t)(s_off[e1] + p1) * D; const bf16_t* hr = H1 + (size_t)r * D;
        f32x4 v[4];
#pragma unroll
        for (int j = 0; j < 4; ++j) { const int cc = 4 * lane + 256 * j; const u32x2 a = *(const u32x2*)(y0 + cc), b = *(const u32x2*)(y1 + cc), hh = *(const u32x2*)(hr + cc);
            v[j].x = DN_ALPHA * bf2f(hh.x & 0xffffu) + w0 * bf2f(a.x & 0xffffu) + w1 * bf2f(b.x & 0xffffu);
            v[j].y = DN_ALPHA * bf2f(hh.x >> 16) + w0 * bf2f(a.x >> 16) + w1 * bf2f(b.x >> 16);
            v[j].z = DN_ALPHA * bf2f(hh.y & 0xffffu) + w0 * bf2f(a.y & 0xffffu) + w1 * bf2f(b.y & 0xffffu);
            v[j].w = DN_ALPHA * bf2f(hh.y >> 16) + w0 * bf2f(a.y >> 16) + w1 * bf2f(b.y >> 16); }
        ln_normalize(v, p.in[I_LN2G] + (size_t)l * D, p.in[I_LN2B] + (size_t)l * D, lane);
        if (last) {
            float* o = p.out + (size_t)(r - 256) * D;
#pragma unroll
            for (int j = 0; j < 4; ++j) *(f32x4*)(o + 4 * lane + 256 * j) = v[j];
        } else { store_row_bf16(H + (size_t)r * D, v, lane); gates_row(p, l + 1, g8, v, r, lane); }
    }
}

#define XB_TMO      128
#define XB_XCNT(j)  (256  + 64 * (j))
#define XB_XSUB(j)  (1280 + 64 * (j))
#define XB_XGEN(j)  (2304 + 64 * (j))
#define XB_TOP      3328
#define XB_TOPGEN   3392
#define XCD_BAR_WORDS 3456
#define XB_SPIN_CAP (1u << 18)
#define LAS __attribute__((address_space(3)))

__device__ __forceinline__ unsigned xb_ld(unsigned* p)              { return __hip_atomic_load(p, __ATOMIC_RELAXED, __HIP_MEMORY_SCOPE_AGENT); }
__device__ __forceinline__ unsigned xb_add(unsigned* p, unsigned v) { return __hip_atomic_fetch_add(p, v, __ATOMIC_RELAXED, __HIP_MEMORY_SCOPE_AGENT); }
__device__ __forceinline__ unsigned xb_xcc_id() { return (unsigned)__builtin_amdgcn_s_getreg((3 << 11) | 20) & 0xFu; }
#define XB_SPIN(cond, bar) do { unsigned _sp = 0; while (cond) { __builtin_amdgcn_s_sleep(1); \
    if ((++_sp & 255u) == 0u) { if (xb_ld(&(bar)[XB_TMO])) break; if (_sp > XB_SPIN_CAP) { atomicAdd(&(bar)[XB_TMO], 1u); break; } } } } while (0)

struct XcdBarrier {
    unsigned* bar; unsigned x;
    volatile LAS unsigned* st;
};
__device__ __forceinline__ XcdBarrier xcd_barrier_post(unsigned* bar, volatile LAS unsigned* st) {
    XcdBarrier b; b.bar = bar; b.x = xb_xcc_id(); b.st = st;
    if (threadIdx.x == 0) (void)xb_add(&bar[XB_XCNT(b.x)], 1u);
    return b;
}
__device__ __forceinline__ void xcd_barrier_complete(unsigned* bar, unsigned x, unsigned& nloc, unsigned& nx) {
    const unsigned G = gridDim.x * gridDim.y * gridDim.z;
    unsigned sum, cnt, mine, sp = 0u;
    for (;;) {
        sum = 0u; cnt = 0u; mine = 0u;
#pragma unroll
        for (unsigned j = 0; j < 16; ++j) { const unsigned c = xb_ld(&bar[XB_XCNT(j)]); sum += c; cnt += (c > 0u) ? 1u : 0u; mine = (j == x) ? c : mine; }
        if (sum == G) break;
        __builtin_amdgcn_s_sleep(1);
        if ((++sp & 255u) == 0u) { if (xb_ld(&bar[XB_TMO])) break; if (sp > XB_SPIN_CAP) { atomicAdd(&bar[XB_TMO], 1u); break; } }
    }
    nloc = mine > 0u ? mine : 1u; nx = cnt > 0u ? cnt : 1u;
}
__device__ __forceinline__ void xcd_barrier(const XcdBarrier& b) {
    asm volatile("s_waitcnt vmcnt(0)" ::: "memory");
    __syncthreads();
    if (threadIdx.x == 0) {
        unsigned* bar = b.bar;
        __builtin_amdgcn_s_waitcnt(0);
        unsigned nloc = b.st[0], nx = b.st[1];
        if (nloc == 0u) { xcd_barrier_complete(bar, b.x, nloc, nx); b.st[0] = nloc; b.st[1] = nx; }
        const unsigned old = xb_add(&bar[XB_XSUB(b.x)], 1u);
        const unsigned gen = old / nloc;
        if (old + 1u == (gen + 1u) * nloc) {
            __builtin_amdgcn_fence(__ATOMIC_RELEASE, "agent");
            asm volatile("s_waitcnt vmcnt(0)" ::: "memory");
            const unsigned og = xb_add(&bar[XB_TOP], 1u);
            const unsigned tg = og / nx;
            if (og + 1u == (tg + 1u) * nx) xb_add(&bar[XB_TOPGEN], 1u);
            else XB_SPIN(xb_ld(&bar[XB_TOPGEN]) == tg, bar);
            __builtin_amdgcn_fence(__ATOMIC_ACQUIRE, "agent");
            xb_add(&bar[XB_XGEN(b.x)], 1u);
            asm volatile("s_waitcnt vmcnt(0)" ::: "memory");
        } else {
            XB_SPIN(xb_ld(&bar[XB_XGEN(b.x)]) == gen, bar);
            __builtin_amdgcn_fence(__ATOMIC_ACQUIRE, "agent");
            asm volatile("s_waitcnt vmcnt(0)" ::: "memory");
        }
    }
    __syncthreads();
}

constexpr int LDS_BYTES = 131072 + 12288;
constexpr int LDS_BAR_OFF = LDS_BYTES - 16;
constexpr int CW_BAR = 4096;
template <int L>
__device__ __forceinline__ void layer_body(const Params& p, char* lds, int bid, int nb, const XcdBarrier& bar) {
    phase_proj_f(p, lds, bid, nb); xcd_barrier(bar);
    phase_attn_f(p, L, lds, bid, nb); xcd_barrier(bar);
    phase_conv(p, L, lds, bid, nb); xcd_barrier(bar);
    phase_mqkv_f(p, lds, bid, nb); xcd_barrier(bar);
    phase_ms(p, lds, bid, nb); phase_sg(p, lds, bid, nb); xcd_barrier(bar);
    phase_m2(p, lds, bid, nb); xcd_barrier(bar);
    phase_o1(p, lds, bid, nb); xcd_barrier(bar);
    phase_o2(p, L, lds, bid, nb); xcd_barrier(bar);
    phase_br1_f(p, lds, bid, nb); xcd_barrier(bar);
    phase_br2_f(p, lds, bid, nb); xcd_barrier(bar);
    phase_out_f(p, lds, bid, nb); xcd_barrier(bar);
    phase_ln1(p, L, lds, bid, nb); xcd_barrier(bar);
    phase_perm(p, L, lds, bid, nb); xcd_barrier(bar);
    phase_e1_f(p, L, lds, bid, nb); xcd_barrier(bar);
    phase_e2_f(p, L, lds, bid, nb); xcd_barrier(bar);
    phase_combine(p, L, lds, bid, nb); if (L + 1 < DEPTH) xcd_barrier(bar);
}
__global__ void __launch_bounds__(NT, 2) fwd_kernel(Params p) {
    extern __shared__ __attribute__((aligned(16))) char lds[];
    const int bid = blockIdx.x, nb = gridDim.x;
    if (threadIdx.x == 0) *(uint4*)(lds + LDS_BAR_OFF) = make_uint4(0u, 0u, 0u, 0u);
    __syncthreads();
    XcdBarrier bar = xcd_barrier_post((unsigned*)(p.ws + WS_CTL) + CW_BAR, (volatile LAS unsigned*)(lds + LDS_BAR_OFF));
    phase_prologue(p, lds, bid, nb); xcd_barrier(bar);
    layer_body<0>(p, lds, bid, nb, bar);
    layer_body<1>(p, lds, bid, nb, bar);
}

extern "C" void kernel_launch(void* const* d_in, const int* in_sizes, int n_in, void* d_out, int out_size, void* d_ws, size_t ws_size, hipStream_t stream) {
    if (n_in != 30 || ws_size < WS_END) { fprintf(stderr, "kernel_launch: unexpected n_in %d or ws_size %zu (< %zu)\n", n_in, ws_size, (size_t)WS_END); return; }
    static int grid = 0;
    if (grid == 0) {
        int dev = 0, cus = 0;
        if (hipGetDevice(&dev) != hipSuccess || hipDeviceGetAttribute(&cus, hipDeviceAttributeMultiprocessorCount, dev) != hipSuccess || cus <= 0) cus = 256;
        (void)hipFuncSetAttribute((const void*)fwd_kernel, hipFuncAttributeMaxDynamicSharedMemorySize, LDS_BYTES);
        grid = cus;
    }
    Params p{};
    for (int i = 0; i < 30; ++i) p.in[i] = (const float*)d_in[i];
    p.out = (float*)d_out; p.ws = (unsigned char*)d_ws;
    (void)hipMemsetAsync((char*)d_ws + WS_CTL, 0, CTL_BYTES, stream);
    hipLaunchKernelGGL(fwd_kernel, dim3(grid), dim3(NT), LDS_BYTES, stream, p);
}
```

```cpp
#include <hip/hip_runtime.h>
#include <cstdio>
#include <cstdint>

constexpr int D = 1024;
constexpr int SEQ = 16384;
constexpr int NMETA = 16;
constexpr int P = 16640;
constexpr int VALID0 = 240;
constexpr int DEPTH = 2;
constexpr int DIN = 7176;
constexpr int NSC = 65;
constexpr int NEXP = 16;
constexpr float LN_EPS = 1e-5f;
constexpr float DN_ALPHA = 1.4142135623730951f;
constexpr float NEGBIG = -1e30f;
constexpr int NT = 512;
constexpr int NW = 8;

typedef unsigned short bf16_t;
typedef short bf16x8 __attribute__((ext_vector_type(8)));
typedef float f32x4 __attribute__((ext_vector_type(4)));
typedef unsigned u32x4 __attribute__((ext_vector_type(4)));
typedef unsigned u32x2 __attribute__((ext_vector_type(2)));

constexpr size_t MiB = 1u << 20;
constexpr size_t RB = (size_t)P * D * 2;
constexpr size_t WS_CTL = 0;
constexpr size_t CTL_BYTES = 1 * MiB;
constexpr size_t WS_TAB = 1 * MiB;
constexpr size_t TAB_GLI = WS_TAB;
constexpr size_t TAB_GLF = TAB_GLI + 4 * P * 4;
constexpr size_t TAB_B   = TAB_GLF + 4 * P * 4;
constexpr size_t TAB_E   = TAB_B + 4 * P * 4;
constexpr size_t TAB_PM  = TAB_E + 4 * P * 4;
constexpr size_t TAB_W   = TAB_PM + 4 * P * 4;
constexpr size_t TAB_SCG = TAB_W + 4 * P * 4;
constexpr size_t TAB_SCM = TAB_SCG + 4096;
constexpr size_t TAB_MT  = TAB_SCM + 4096;
constexpr size_t TAB_NT  = TAB_MT + 4096;
constexpr size_t TAB_TOPK = TAB_NT + (size_t)NSC * 4 * 256 * 4;
constexpr size_t TAB_ELIST = TAB_TOPK + (size_t)P * 32;
constexpr size_t TAB_DENP = TAB_ELIST + (size_t)NEXP * P * 4;
constexpr size_t TAB_DENI = TAB_DENP + (size_t)P * 16 * 4;
constexpr size_t TAB_END = TAB_DENI + (size_t)P * 4 * 4;
static_assert(TAB_END <= 8 * MiB, "tables");
constexpr size_t WS_W = 8 * MiB;
constexpr size_t W_IN_T = WS_W;
constexpr size_t W_Q_T = W_IN_T + (size_t)7168 * 1024 * 2;
constexpr size_t W_K_T = W_Q_T + 4 * 65536 * 2;
constexpr size_t W_V_T = W_K_T + 4 * 65536 * 2;
constexpr size_t W_BM_T = W_V_T + 4 * 65536 * 2;
constexpr size_t W_BA_T = W_BM_T + (size_t)D * D * 2;
constexpr size_t W_OUT_T = W_BA_T + (size_t)D * D * 2;
constexpr size_t W_G_T = W_OUT_T + (size_t)D * D * 2;
constexpr size_t W_U_T = W_G_T + (size_t)NEXP * D * D * 2;
constexpr size_t W_D_T = W_U_T + (size_t)NEXP * D * D * 2;
constexpr size_t W_END = W_D_T + (size_t)NEXP * D * D * 2;
static_assert(W_END <= 128 * MiB, "weights");
constexpr size_t WS_SLOT = 128 * MiB;
constexpr size_t SLOT(int i) { return WS_SLOT + (size_t)i * RB; }
constexpr size_t WS_END = WS_SLOT + 12 * RB;
constexpr size_t B_H = SLOT(0);
constexpr size_t B_XM = SLOT(1), B_PM = SLOT(1);
constexpr size_t B_OP = SLOT(2), B_MRGB = SLOT(2);
constexpr size_t B_QA = SLOT(3), B_QM = SLOT(3), B_MRG = SLOT(3);
constexpr size_t B_KA = SLOT(4), B_XC = SLOT(4), B_CT = SLOT(4);
constexpr size_t B_KM = SLOT(5), B_OI = SLOT(5), B_H1 = SLOT(5);
constexpr size_t B_GA = SLOT(6);
constexpr size_t B_GB = SLOT(7);
constexpr size_t B_YA = SLOT(8);
constexpr size_t B_KMT = SLOT(9), B_YM = SLOT(9);
constexpr size_t B_VA = SLOT(10), B_VMT = SLOT(10);
constexpr size_t B_VWT = SLOT(11);
constexpr size_t B_Z = SLOT(10);
constexpr size_t B_HID = SLOT(6);
constexpr size_t B_XP = SLOT(1);
constexpr size_t B_YB = SLOT(9);
constexpr int HID_ROWS_MAX = (int)(3 * RB / (D * 2));
constexpr int CW_CNT = 64;

struct Params {
    const float* in[30];
    float* out;
    unsigned char* ws;
};
enum { I_X = 0, I_META, I_LNG, I_LNB, I_WIN, I_CONVW, I_CONVB, I_WQM, I_WKM, I_WVM, I_BI, I_BF, I_MNG, I_LQ1, I_LK1, I_LQ2, I_LK2, I_ANG,
       I_WBM, I_WBA, I_WOUT, I_LN1G, I_LN1B, I_LN2G, I_LN2B, I_WR, I_RB, I_WG, I_WU, I_WD };

__device__ __forceinline__ int tid_opaque() { int t = threadIdx.x; asm volatile("" : "+v"(t)); return t; }
#define TIDX tid_opaque()
__device__ __forceinline__ float bf2f(unsigned v) { return __uint_as_float(v << 16); }
__device__ __forceinline__ unsigned f2bf(float f) { unsigned u = __float_as_uint(f); return (u + 0x7fffu + ((u >> 16) & 1u)) >> 16; }
__device__ __forceinline__ unsigned pk2(float lo, float hi) { return f2bf(lo) | (f2bf(hi) << 16); }
template <int M> __device__ __forceinline__ float sx(float v) {
    static_assert(M == 1 || M == 2 || M == 4 || M == 8 || M == 16, "sx: xor mask within 32 lanes");
    return __int_as_float(__builtin_amdgcn_ds_swizzle(__float_as_int(v), 0x1f | (M << 10)));
}
__device__ __forceinline__ float sum32(float v) {
    auto rr = __builtin_amdgcn_permlane32_swap(__float_as_uint(v), __float_as_uint(v), false, false);
    return __uint_as_float(rr[0]) + __uint_as_float(rr[1]);
}
__device__ __forceinline__ float wave_sum(float v) {
    v += sx<1>(v); v += sx<2>(v); v += sx<4>(v); v += sx<8>(v); v += sx<16>(v); v = sum32(v);
    return v;
}
__device__ __forceinline__ float sigmoidf_(float x) { return 1.f / (1.f + __expf(-x)); }
__device__ __forceinline__ float siluf_(float x) { return x / (1.f + __expf(-x)); }
__device__ __forceinline__ float logsigmoidf_(float x) { return x >= 0.f ? -log1pf(__expf(-x)) : x - log1pf(__expf(x)); }
__device__ __forceinline__ f32x4 sig4(f32x4 v) { f32x4 o; o.x = sigmoidf_(v.x); o.y = sigmoidf_(v.y); o.z = sigmoidf_(v.z); o.w = sigmoidf_(v.w); return o; }
__device__ __forceinline__ f32x4 mfma16(bf16x8 a, bf16x8 b, f32x4 c) { return __builtin_amdgcn_mfma_f32_16x16x32_bf16(a, b, c, 0, 0, 0); }
__device__ __forceinline__ bf16x8 ld8(const bf16_t* p) { return *(const bf16x8*)p; }

__device__ __forceinline__ void transpose_item(const float* W, int K, size_t ldsrc, int k0, int n_src0, bf16_t* WT, int dst_row0, float* scr, int lane) {
#pragma unroll 8
    for (int i = 0; i < 32; ++i) { const int kk = 2 * i + (lane >> 5); scr[kk * 33 + (lane & 31)] = W[(size_t)(k0 + kk) * ldsrc + n_src0 + (lane & 31)]; }
    __builtin_amdgcn_wave_barrier();
    asm volatile("s_waitcnt lgkmcnt(0)" ::: "memory");
    const int c = lane & 7;
#pragma unroll
    for (int j = 0; j < 4; ++j) { const int n = (lane >> 3) + 8 * j; const float* s = scr + (8 * c) * 33 + n;
        u32x4 o; o.x = pk2(s[0 * 33], s[1 * 33]); o.y = pk2(s[2 * 33], s[3 * 33]); o.z = pk2(s[4 * 33], s[5 * 33]); o.w = pk2(s[6 * 33], s[7 * 33]);
        *(u32x4*)(WT + (size_t)(dst_row0 + n) * K + k0 + 8 * c) = o; }
    asm volatile("s_waitcnt lgkmcnt(0)" ::: "memory");
    __builtin_amdgcn_wave_barrier();
}
__device__ __forceinline__ void convert_weights(const Params& p, int l, char* lds, int gw, int ngw, int wid, int lane) {
    float* scr = (float*)lds + wid * (64 * 33);
    unsigned char* ws = p.ws;
    constexpr int I_IN = 16 * 224, I_QKV = 3 * 4 * 4 * 8, I_SQ = 16 * 32, I_EXP = 3 * 16 * 512;
    constexpr int TOTAL = I_IN + I_QKV + 3 * I_SQ + I_EXP;
    for (int it = gw; it < TOTAL; it += ngw) {
        int r = it;
        if (r < I_IN) { const int kb = r / 224, nb = r % 224, r0 = nb * 32, nsrc = r0 < 2048 ? r0 : r0 + 8;
            transpose_item(p.in[I_WIN] + (size_t)l * D * DIN, D, DIN, kb * 64, nsrc, (bf16_t*)(ws + W_IN_T), r0, scr, lane); continue; }
        r -= I_IN;
        if (r < I_QKV) { const int w = r / 128, rr = r % 128, h = rr / 32, t = rr % 32, kb = t / 8, nb = t % 8;
            const float* src = p.in[w == 0 ? I_WQM : (w == 1 ? I_WKM : I_WVM)] + ((size_t)l * 4 + h) * 65536;
            bf16_t* dst = (bf16_t*)(ws + (w == 0 ? W_Q_T : (w == 1 ? W_K_T : W_V_T))) + (size_t)h * 65536;
            transpose_item(src, 256, 256, kb * 64, nb * 32, dst, nb * 32, scr, lane); continue; }
        r -= I_QKV;
        if (r < 3 * I_SQ) { const int w = r / I_SQ, t = r % I_SQ, kb = t / 32, nb = t % 32;
            const float* src = p.in[w == 0 ? I_WBM : (w == 1 ? I_WBA : I_WOUT)] + (size_t)l * D * D;
            bf16_t* dst = (bf16_t*)(ws + (w == 0 ? W_BM_T : (w == 1 ? W_BA_T : W_OUT_T)));
            transpose_item(src, D, D, kb * 64, nb * 32, dst, nb * 32, scr, lane); continue; }
        r -= 3 * I_SQ;
        { const int w = r / (16 * 512), rr = r % (16 * 512), e = rr / 512, t = rr % 512, kb = t / 32, nb = t % 32;
            const float* src = p.in[w == 0 ? I_WG : (w == 1 ? I_WU : I_WD)] + ((size_t)l * NEXP + e) * D * D;
            if (w == 2) transpose_item(src, D, D, kb * 64, nb * 32, (bf16_t*)(ws + W_D_T) + (size_t)e * D * D, nb * 32, scr, lane);
            else { const int j0 = nb * 32; transpose_item(src, D, D, kb * 64, j0, (bf16_t*)(ws + W_G_T) + (size_t)e * 2048 * D, 256 * (j0 >> 7) + (j0 & 127) + (w == 1 ? 128 : 0), scr, lane); } }
    }
}

__device__ __forceinline__ void ln_normalize(f32x4 (&v)[4], const float* g, const float* b, int lane) {
    float s = 0.f;
#pragma unroll
    for (int j = 0; j < 4; ++j) s += (v[j].x + v[j].y) + (v[j].z + v[j].w);
    const float mean = wave_sum(s) * (1.f / D);
    float s2 = 0.f;
#pragma unroll
    for (int j = 0; j < 4; ++j) { v[j] = v[j] - mean; s2 += (v[j].x * v[j].x + v[j].y * v[j].y) + (v[j].z * v[j].z + v[j].w * v[j].w); }
    const float rstd = rsqrtf(wave_sum(s2) * (1.f / D) + LN_EPS);
#pragma unroll
    for (int j = 0; j < 4; ++j) { const f32x4 gg = *(const f32x4*)(g + 4 * lane + 256 * j), bb = *(const f32x4*)(b + 4 * lane + 256 * j); v[j] = v[j] * rstd * gg + bb; }
}
__device__ __forceinline__ void store_row_bf16(bf16_t* row, const f32x4 (&v)[4], int lane) {
#pragma unroll
    for (int j = 0; j < 4; ++j) { u32x2 o; o.x = pk2(v[j].x, v[j].y); o.y = pk2(v[j].z, v[j].w); *(u32x2*)(row + 4 * lane + 256 * j) = o; }
}
__device__ __forceinline__ void store_row_zero(bf16_t* row, int lane) {
#pragma unroll
    for (int j = 0; j < 4; ++j) { u32x2 o; o.x = 0u; o.y = 0u; *(u32x2*)(row + 4 * lane + 256 * j) = o; }
}
__device__ __forceinline__ void load_gate_w(const Params& p, int l, float* g8) {
    const float* w = p.in[I_WIN] + (size_t)l * D * DIN + 2048;
    for (int i = TIDX; i < D * 8; i += NT) { const int k = i >> 3, c = i & 7; g8[i] = w[(size_t)k * DIN + c]; }
    __syncthreads();
}
__device__ __forceinline__ void gates_row(const Params& p, int l, const float* g8, const f32x4 (&v)[4], int prow, int lane) {
    float acc[8];
#pragma unroll
    for (int c = 0; c < 8; ++c) acc[c] = 0.f;
#pragma unroll
    for (int j = 0; j < 4; ++j)
#pragma unroll
        for (int i = 0; i < 4; ++i) { const int k = 4 * lane + 256 * j + i; const float x = v[j][i];
            const f32x4 w0 = *(const f32x4*)(g8 + k * 8), w1 = *(const f32x4*)(g8 + k * 8 + 4);
            acc[0] += x * w0.x; acc[1] += x * w0.y; acc[2] += x * w0.z; acc[3] += x * w0.w; acc[4] += x * w1.x; acc[5] += x * w1.y; acc[6] += x * w1.z; acc[7] += x * w1.w; }
#pragma unroll
    for (int c = 0; c < 8; ++c) acc[c] = wave_sum(acc[c]);
    if (lane < 4) {
        float* gli = (float*)(p.ws + TAB_GLI); float* glf = (float*)(p.ws + TAB_GLF);
        const float bi = p.in[I_BI][l * 4 + lane], bfv = p.in[I_BF][l * 4 + lane];
        float ai = acc[0], af = acc[4];
        if (lane == 1) { ai = acc[1]; af = acc[5]; } else if (lane == 2) { ai = acc[2]; af = acc[6]; } else if (lane == 3) { ai = acc[3]; af = acc[7]; }
        gli[(size_t)lane * P + prow] = ai + bi;
        glf[(size_t)lane * P + prow] = logsigmoidf_(af + bfv);
    }
}
__device__ __forceinline__ void gates_row_pad(const Params& p, int prow, int lane) {
    if (lane < 4) { ((float*)(p.ws + TAB_GLI))[(size_t)lane * P + prow] = NEGBIG; ((float*)(p.ws + TAB_GLF))[(size_t)lane * P + prow] = 0.f; }
}

__device__ __forceinline__ void phase_prologue(const Params& p, char* lds, int bid, int nb) {
    const int tid = TIDX, wid = tid >> 6, lane = tid & 63, gw = bid * NW + wid, ngw = nb * NW;
    convert_weights(p, 0, lds, gw, ngw, wid, lane);
    __syncthreads();
    float* g8 = (float*)lds;
    load_gate_w(p, 0, g8);
    bf16_t* H = (bf16_t*)(p.ws + B_H);
    for (int r = gw; r < P; r += ngw) {
        if (r < VALID0) { store_row_zero(H + (size_t)r * D, lane); gates_row_pad(p, r, lane); continue; }
        const float* src = r < 256 ? p.in[I_META] + (size_t)(r - VALID0) * D : p.in[I_X] + (size_t)(r - 256) * D;
        f32x4 v[4];
#pragma unroll
        for (int j = 0; j < 4; ++j) v[j] = *(const f32x4*)(src + 4 * lane + 256 * j);
        ln_normalize(v, p.in[I_LNG], p.in[I_LNB], lane);
        store_row_bf16(H + (size_t)r * D, v, lane);
        gates_row(p, 0, g8, v, r, lane);
    }
}

struct RowsPlain { const bf16_t* base; size_t ld; __device__ __forceinline__ const bf16_t* row(int m) const { return base + (size_t)m * ld; } };
__device__ __forceinline__ void store4_bf16(bf16_t* dst, f32x4 v) { u32x2 o; o.x = pk2(v.x, v.y); o.y = pk2(v.z, v.w); *(u32x2*)dst = o; }

struct EpiProj { unsigned char* ws;
    __device__ __forceinline__ void operator()(int m, int n, f32x4 v) const {
        const int seg = n >> 10, cc = n & 1023;
        const size_t off = seg == 0 ? B_XM : seg == 1 ? B_OP : seg == 2 ? B_QA : seg == 3 ? B_KA : seg == 4 ? B_VA : seg == 5 ? B_GA : B_GB;
        store4_bf16((bf16_t*)(ws + off) + (size_t)m * D + cc, v); } };
struct EpiStore { bf16_t* C; size_t ldc; float scale;
    __device__ __forceinline__ void operator()(int m, int n, f32x4 v) const { store4_bf16(C + (size_t)m * ldc + n, v * scale); } };
namespace pg8 {
#define PG8_LAS __attribute__((address_space(3)))
constexpr int BM = 256, BK = 64, HALF = 128, HTB = HALF * BK * 2, STAGE_BYTES = 8 * HTB, NXCD = 8, WGM = 8;
__host__ __device__ __forceinline__ int lds_byte(int r, int c) { const int st = (r >> 4) * 2 + (c >> 5), rr = r & 15, cc = c & 31, ob = rr * 64 + cc * 2; return st * 1024 + (ob ^ (((ob >> 9) & 1) << 5)); }
__host__ __device__ __forceinline__ void stage_rc(int b, int& R, int& C) { const int st = b / 1024, sb = b % 1024, swz = sb ^ (((sb >> 9) & 1) << 5); R = (st >> 1) * 16 + swz / 64; C = (st & 1) * 32 + (swz % 64) / 2; }
__host__ __device__ __forceinline__ int perm32(int rho) { const int n = rho >> 4, i = rho & 15; return 8 * (i >> 2) + 4 * n + (i & 3); }
struct Unit { int pm, pn, grp; };
__device__ __forceinline__ bool decode_unit(long L, int nG, int nM, int nN, Unit& u) {
    const int nwg = nG * nM * nN; if (L >= nwg) return false;
    int wgid = (int)L; { const int q = nwg / NXCD, r = nwg % NXCD, xcd = wgid % NXCD, off = wgid / NXCD; wgid = (xcd < r ? xcd * (q + 1) : r * (q + 1) + (xcd - r) * q) + off; }
    const int per = nM * nN; u.grp = wgid / per; const int rem = wgid % per;
    const int nig = WGM * nN, gid = rem / nig, fm = gid * WGM, gsz = (nM - fm) < WGM ? (nM - fm) : WGM;
    u.pm = __builtin_amdgcn_readfirstlane(fm + ((rem % nig) % gsz)); u.pn = __builtin_amdgcn_readfirstlane((rem % nig) / gsz); u.grp = __builtin_amdgcn_readfirstlane(u.grp); return true;
}
__device__ __forceinline__ unsigned cvt_pk_bf16(float lo, float hi) { unsigned r; asm volatile("v_cvt_pk_bf16_f32 %0, %1, %2" : "=v"(r) : "v"(lo), "v"(hi)); return r; }

template <class Epi, class Sched, bool ALIGN_EPI = true>
__device__ __forceinline__ void gemm_phase(PG8_LAS unsigned char* lds, const Sched& S, const Epi& E) {
    const int tid = TIDX, wid = __builtin_amdgcn_readfirstlane(tid >> 6), lane = tid & 63, wr = wid >> 2, wc = wid & 3, fr = lane & 15, fq = lane >> 4;
    const int K = S.K, nt = K / BK;
    unsigned voffA[2], voffB[2];
#pragma unroll
    for (int i = 0; i < 2; ++i) { int R, C; stage_rc(tid * 16 + i * 8192, R, C); const int Rb = (R & ~31) + perm32(R & 31);
        voffA[i] = (unsigned)(R * S.lda + C) * 2u; voffB[i] = (unsigned)(Rb * S.ldb + C) * 2u; }
    const size_t kstep = (size_t)(BK * 2);
    const size_t hstepA = (size_t)HALF * S.lda * 2, hstepB = (size_t)HALF * S.ldb * 2;
    const unsigned ldsw = (unsigned)wid * 1024u;
    const int aoff = lds_byte(wr * 64 + fr, fq * 8), boff = lds_byte(wc * 32 + fr, fq * 8);
#define PG8_SA(b, h) (((b) * 2 + (h)) * HTB)
#define PG8_SB(b, h) ((4 + (b) * 2 + (h)) * HTB)
#define PG8_STAGE(bufoff, gbase, voff) do { _Pragma("unroll") for (int _i = 0; _i < 2; ++_i) \
        __builtin_amdgcn_global_load_lds((const unsigned*)((const char*)(gbase) + (voff)[_i]), (PG8_LAS unsigned*)(lds + (bufoff) + ldsw + _i * 8192), 16, 0, 0); } while (0)
#define PG8_LDA(dst, b, h) do { _Pragma("unroll") for (int m = 0; m < 4; ++m) _Pragma("unroll") for (int k = 0; k < 2; ++k) dst[m][k] = *(const PG8_LAS bf16x8*)(lds + PG8_SA(b, h) + aoff + m * 2048 + k * 1024); } while (0)
#define PG8_LDB(dst, b, h) do { _Pragma("unroll") for (int n = 0; n < 2; ++n) _Pragma("unroll") for (int k = 0; k < 2; ++k) dst[n][k] = *(const PG8_LAS bf16x8*)(lds + PG8_SB(b, h) + boff + n * 2048 + k * 1024); } while (0)
#define PG8_MMA(ai, bj, At, Bt) do { __builtin_amdgcn_s_setprio(1); _Pragma("unroll") for (int m = 0; m < 4; ++m) _Pragma("unroll") for (int n = 0; n < 2; ++n) _Pragma("unroll") for (int k = 0; k < 2; ++k) \
        acc[ai][bj][m][n] = __builtin_amdgcn_mfma_f32_16x16x32_bf16(Bt[n][k], At[m][k], acc[ai][bj][m][n], 0, 0, 0); __builtin_amdgcn_s_setprio(0); } while (0)
#define PG8_WAIT_V(n) asm volatile("s_waitcnt vmcnt(" #n ")" ::: "memory")
#define PG8_WAIT_L(n) asm volatile("s_waitcnt lgkmcnt(" #n ")" ::: "memory")
#define PG8_BAR __builtin_amdgcn_s_barrier()
#define PG8_SCHED __builtin_amdgcn_sched_barrier(0)
    Unit cur, nxt; int ui = 0;
    if (!S.next(0, cur)) return;
    f32x4 acc[2][2][4][2];
#pragma unroll
    for (int a = 0; a < 2; ++a)
#pragma unroll
        for (int b = 0; b < 2; ++b)
#pragma unroll
            for (int m = 0; m < 4; ++m)
#pragma unroll
                for (int n = 0; n < 2; ++n) acc[a][b][m][n] = (f32x4){0.f, 0.f, 0.f, 0.f};
    bf16x8 At[4][2], B0[2][2], B1[2][2];
    const char* cA = S.abase(cur); const char* cB = S.bbase(cur);
    PG8_STAGE(PG8_SB(0, 0), cB, voffB); PG8_STAGE(PG8_SB(0, 1), cB + hstepB, voffB); PG8_STAGE(PG8_SA(0, 0), cA, voffA); PG8_STAGE(PG8_SA(0, 1), cA + hstepA, voffA);
    if (wr == 1) PG8_BAR;
    PG8_WAIT_V(2); PG8_BAR;
    PG8_STAGE(PG8_SB(1, 0), cB + kstep, voffB); PG8_STAGE(PG8_SA(1, 0), cA + kstep, voffA); PG8_STAGE(PG8_SB(1, 1), cB + hstepB + kstep, voffB);
    PG8_WAIT_V(6); PG8_BAR;
    for (;;) {
        const bool has_next = S.next(ui + 1, nxt);
        const char* nA = has_next ? S.abase(nxt) : cA; const char* nB = has_next ? S.bbase(nxt) : cB;
        for (int t = 0; t < nt; t += 2) {
            const bool last = (t == nt - 2);
            const char* a1 = cA + (size_t)(t + 1) * kstep;
            const char* a2 = last ? nA : cA + (size_t)(t + 2) * kstep; const char* b2 = last ? nB : cB + (size_t)(t + 2) * kstep;
            const char* a3 = a2 + kstep; const char* b3 = b2 + kstep;
            PG8_LDB(B0, 0, 0); PG8_LDB(B1, 0, 1); PG8_SCHED; PG8_LDA(At, 0, 0); PG8_STAGE(PG8_SA(1, 1), a1 + hstepA, voffA);
            PG8_WAIT_V(8); PG8_WAIT_L(0); PG8_BAR; PG8_MMA(0, 0, At, B0); PG8_MMA(0, 1, At, B1); PG8_BAR; PG8_SCHED;
            PG8_LDA(At, 0, 1); PG8_STAGE(PG8_SB(0, 0), b2, voffB); PG8_STAGE(PG8_SB(0, 1), b2 + hstepB, voffB); PG8_STAGE(PG8_SA(0, 0), a2, voffA);
            PG8_WAIT_V(8); PG8_WAIT_L(0); PG8_BAR; PG8_MMA(1, 0, At, B0); PG8_MMA(1, 1, At, B1); PG8_BAR; PG8_SCHED;
            PG8_LDB(B0, 1, 0); PG8_LDB(B1, 1, 1); PG8_SCHED; PG8_LDA(At, 1, 0); PG8_STAGE(PG8_SA(0, 1), a2 + hstepA, voffA);
            PG8_WAIT_V(8); PG8_WAIT_L(0); PG8_BAR; PG8_MMA(0, 0, At, B0); PG8_MMA(0, 1, At, B1); PG8_BAR; PG8_SCHED;
            PG8_LDA(At, 1, 1); PG8_STAGE(PG8_SB(1, 0), b3, voffB); PG8_STAGE(PG8_SB(1, 1), b3 + hstepB, voffB); PG8_STAGE(PG8_SA(1, 0), a3, voffA);
            PG8_WAIT_V(8); PG8_WAIT_L(0); PG8_BAR; PG8_MMA(1, 0, At, B0); PG8_MMA(1, 1, At, B1); PG8_BAR; PG8_SCHED;
        }
        if constexpr (ALIGN_EPI) { if (wr == 0) PG8_BAR; }
        E(acc, cur, wr, wc, fr, fq);
        if (!has_next) break;
#pragma unroll
        for (int a = 0; a < 2; ++a)
#pragma unroll
            for (int b = 0; b < 2; ++b)
#pragma unroll
                for (int m = 0; m < 4; ++m)
#pragma unroll
                    for (int n = 0; n < 2; ++n) acc[a][b][m][n] = (f32x4){0.f, 0.f, 0.f, 0.f};
        cur = nxt; cA = nA; cB = nB; ++ui;
        if constexpr (ALIGN_EPI) { if (wr == 1) PG8_BAR; }
    }
    PG8_WAIT_V(0);
    if constexpr (!ALIGN_EPI) { if (wr == 0) PG8_BAR; }
    PG8_BAR;
#undef PG8_SA
#undef PG8_SB
#undef PG8_STAGE
#undef PG8_LDA
#undef PG8_LDB
#undef PG8_MMA
#undef PG8_WAIT_V
#undef PG8_WAIT_L
#undef PG8_BAR
#undef PG8_SCHED
}
__device__ __forceinline__ u32x4 pack8(f32x4 v0, f32x4 v1) { u32x4 w; w.x = cvt_pk_bf16(v0[0], v0[1]); w.y = cvt_pk_bf16(v0[2], v0[3]); w.z = cvt_pk_bf16(v1[0], v1[1]); w.w = cvt_pk_bf16(v1[2], v1[3]); return w; }
__device__ __forceinline__ void unpack8(u32x4 w, f32x4& v0, f32x4& v1) {
    v0[0] = __uint_as_float(w.x << 16); v0[1] = __uint_as_float(w.x & 0xffff0000u); v0[2] = __uint_as_float(w.y << 16); v0[3] = __uint_as_float(w.y & 0xffff0000u);
    v1[0] = __uint_as_float(w.z << 16); v1[1] = __uint_as_float(w.z & 0xffff0000u); v1[2] = __uint_as_float(w.w << 16); v1[3] = __uint_as_float(w.w & 0xffff0000u); }
template <class F> __device__ __forceinline__ void for_each_piece(const f32x4 (&acc)[2][2][4][2], const Unit& u, int wr, int wc, int fr, int fq, const F& f) {
    asm volatile("" : "+v"(fr), "+v"(fq));
    const int row0 = u.pm * BM + wr * 64 + fr, col0 = wc * 32 + 8 * fq;
#pragma unroll
    for (int ai = 0; ai < 2; ++ai)
#pragma unroll
        for (int m = 0; m < 4; ++m)
#pragma unroll
            for (int bj = 0; bj < 2; ++bj) f(row0 + ai * HALF + m * 16, col0 + bj * HALF, acc[ai][bj][m][0], acc[ai][bj][m][1]);
}
}

template <int MI, int NJ, class AR, class BR, class Epi>
__device__ __forceinline__ void sgemm_wave(const AR& ar, const BR& br, int K, int m0, int n0, const Epi& epi) {
    const int lane = TIDX & 63, c = lane & 15, g = lane >> 4;
    const bf16_t* ap[MI]; const bf16_t* bp[NJ];
#pragma unroll
    for (int i = 0; i < MI; ++i) ap[i] = ar.row(m0 + 16 * i + c) + 8 * g;
#pragma unroll
    for (int j = 0; j < NJ; ++j) bp[j] = br.row(n0 + 16 * j + c) + 8 * g;
    f32x4 acc[MI][NJ];
#pragma unroll
    for (int i = 0; i < MI; ++i)
#pragma unroll
        for (int j = 0; j < NJ; ++j) acc[i][j] = (f32x4){0.f, 0.f, 0.f, 0.f};
#pragma unroll 4
    for (int k0 = 0; k0 < K; k0 += 32) {
        bf16x8 a[MI], b[NJ];
#pragma unroll
        for (int i = 0; i < MI; ++i) a[i] = ld8(ap[i] + k0);
#pragma unroll
        for (int j = 0; j < NJ; ++j) b[j] = ld8(bp[j] + k0);
#pragma unroll
        for (int i = 0; i < MI; ++i)
#pragma unroll
            for (int j = 0; j < NJ; ++j) acc[i][j] = mfma16(b[j], a[i], acc[i][j]);
    }
#pragma unroll
    for (int i = 0; i < MI; ++i)
#pragma unroll
        for (int j = 0; j < NJ; ++j) epi(m0 + 16 * i + c, n0 + 16 * j + 4 * g, acc[i][j]);
}
template <int MI, int NJ, class AR, class BR, class Epi>
__device__ __forceinline__ void meta_gemm(const AR& ar, const BR& br, int K, int m0, int n0, const Epi& epi, char* lds) {
    const int tid = TIDX, wid = __builtin_amdgcn_readfirstlane(tid >> 6), lane = tid & 63, c = lane & 15, g = lane >> 4;
    const int kw = K >> 3, kb = wid * kw;
    f32x4 acc[MI][NJ];
#pragma unroll
    for (int i = 0; i < MI; ++i)
#pragma unroll
        for (int j = 0; j < NJ; ++j) acc[i][j] = (f32x4){0.f, 0.f, 0.f, 0.f};
    for (int k0 = kb; k0 < kb + kw; k0 += 32) {
        bf16x8 a[MI], b[NJ];
#pragma unroll
        for (int i = 0; i < MI; ++i) a[i] = ld8(ar.row(m0 + 16 * i + c) + 8 * g + k0);
#pragma unroll
        for (int j = 0; j < NJ; ++j) b[j] = ld8(br.row(n0 + 16 * j + c) + 8 * g + k0);
#pragma unroll
        for (int i = 0; i < MI; ++i)
#pragma unroll
            for (int j = 0; j < NJ; ++j) acc[i][j] = mfma16(b[j], a[i], acc[i][j]);
    }
    f32x4* part = (f32x4*)lds;
#pragma unroll
    for (int i = 0; i < MI; ++i)
#pragma unroll
        for (int j = 0; j < NJ; ++j) part[((wid * MI + i) * NJ + j) * 64 + lane] = acc[i][j];
    __syncthreads();
    if (wid == 0) {
#pragma unroll
        for (int i = 0; i < MI; ++i)
#pragma unroll
            for (int j = 0; j < NJ; ++j) { f32x4 s = acc[i][j];
#pragma unroll
                for (int w = 1; w < 8; ++w) s += part[((w * MI + i) * NJ + j) * 64 + lane];
                epi(m0 + 16 * i + c, n0 + 16 * j + 4 * g, s); }
    }
    __syncthreads();
}
__device__ __forceinline__ void zero_block(bf16_t* base, size_t ld, int nrows, int ncols, int gtid, int gthreads) {
    const int cpr = ncols / 8;
    for (int i = gtid; i < nrows * cpr; i += gthreads) { const int r = i / cpr, cc = (i % cpr) * 8; *(u32x4*)(base + (size_t)r * ld + cc) = (u32x4){0u, 0u, 0u, 0u}; }
}

struct SchedProj { const char* A; const char* B; int G, c; int K, lda, ldb;
    __device__ __forceinline__ bool next(int i, pg8::Unit& u) const { if (!pg8::decode_unit((long)i * G + c, 1, 64, 28, u)) return false; u.pm += 1; return true; }
    __device__ __forceinline__ const char* abase(const pg8::Unit& u) const { return A + (size_t)u.pm * 256 * D * 2; }
    __device__ __forceinline__ const char* bbase(const pg8::Unit& u) const { return B + (size_t)u.pn * 256 * D * 2; } };
struct EpiProjF { unsigned char* ws;
    __device__ __forceinline__ void operator()(const f32x4 (&acc)[2][2][4][2], const pg8::Unit& u, int wr, int wc, int fr, int fq) const {
        const int colt = u.pn * 256, seg = colt >> 10;
        const size_t off = seg == 0 ? B_XM : seg == 1 ? B_OP : seg == 2 ? B_QA : seg == 3 ? B_KA : seg == 4 ? B_VA : seg == 5 ? B_GA : B_GB;
        bf16_t* base = (bf16_t*)(ws + off) + (colt & 1023);
        pg8::for_each_piece(acc, u, wr, wc, fr, fq, [&](int row, int col, f32x4 v0, f32x4 v1) { *(u32x4*)(base + (size_t)row * D + col) = pg8::pack8(v0, v1); }); } };
struct SchedVAT { const char* A; const char* B; int G, c; int K, lda, ldb;
    __device__ __forceinline__ bool next(int i, pg8::Unit& u) const { if (!pg8::decode_unit((long)i * G + c, 1, 4, 64, u)) return false; u.pn += 1; return true; }
    __device__ __forceinline__ const char* abase(const pg8::Unit& u) const { return A + (size_t)u.pm * 256 * D * 2; }
    __device__ __forceinline__ const char* bbase(const pg8::Unit& u) const { return B + (size_t)u.pn * 256 * D * 2; } };
struct EpiStoreF { bf16_t* C; size_t ldc; float scale;
    __device__ __forceinline__ void operator()(const f32x4 (&acc)[2][2][4][2], const pg8::Unit& u, int wr, int wc, int fr, int fq) const {
        bf16_t* base = C + (size_t)u.pn * 256;
        pg8::for_each_piece(acc, u, wr, wc, fr, fq, [&](int row, int col, f32x4 v0, f32x4 v1) { *(u32x4*)(base + (size_t)row * ldc + col) = pg8::pack8(v0 * scale, v1 * scale); }); } };
__device__ __forceinline__ void phase_proj_f(const Params& p, char* lds, int bid, int nb) {
    const int tid = TIDX, wid = tid >> 6, gw = bid * NW + wid, ngw = nb * NW;
    const bf16_t* H = (const bf16_t*)(p.ws + B_H); const bf16_t* W = (const bf16_t*)(p.ws + W_IN_T);
    zero_block((bf16_t*)(p.ws + B_KA), D, VALID0, D, bid * NT + tid, nb * NT);
    zero_block((bf16_t*)(p.ws + B_VA), D, VALID0, D, bid * NT + tid, nb * NT);
    zero_block((bf16_t*)(p.ws + B_XM), D, VALID0, D, bid * NT + tid, nb * NT);
    for (int t = bid; t < 112; t += nb) meta_gemm<1, 4>(RowsPlain{H, D}, RowsPlain{W, D}, D, VALID0, t * 64, EpiProj{p.ws}, lds);
    { SchedProj S{(const char*)H, (const char*)W, nb, bid, D, D, D};
      pg8::gemm_phase(( PG8_LAS unsigned char*)lds, S, EpiProjF{p.ws}); }
}

namespace fa {
typedef short s16x4 __attribute__((ext_vector_type(4)));
typedef float f32x16 __attribute__((ext_vector_type(16)));
constexpr int KVBLK = 64, SHM_V = 64 * 128 * 2, SHM_K = 64 * 64 * 2, PITCH = 1024;
constexpr int LDS_NEED = 2 * SHM_V + 2 * SHM_K + NW * 64 * 4;
constexpr float SCALE = 0.125f, THR = 8.f;
#define FA_SBAR() __builtin_amdgcn_sched_barrier(0)
__device__ __forceinline__ int kswz(int row, int chunk) { return row * 128 + ((chunk ^ ((row >> 1) & 7)) << 4); }
__device__ __forceinline__ int v_st(int k, int c) { const int kk = (k & ~0xC) | ((k & 4) << 1) | ((k & 8) >> 1); return ((kk >> 3) * 4 + (c >> 5)) * 512 + ((kk & 7) * 32 + (c & 31)) * 2; }
__device__ __forceinline__ int v_rd_base(int lane) { return ((lane & 3) << 3) | (((lane >> 2) & 3) << 6) | (((lane >> 4) & 1) << 5) | (((lane >> 5) & 1) << 8); }
constexpr int v_rd_off(int d0, int ks, int half) { return d0 * 512 + ks * 4096 + half * 2048; }
__device__ __forceinline__ int crow(int r, int hi) { return (r & 3) + 8 * (r >> 2) + 4 * hi; }
__device__ __forceinline__ unsigned cvtpk(float lo, float hi) { unsigned r; asm volatile("v_cvt_pk_bf16_f32 %0, %1, %2" : "=v"(r) : "v"(lo), "v"(hi)); return r; }
__device__ __forceinline__ void mask_tile(f32x16& p0, f32x16& p1, int pos, int kbase, int hi, int lowkey) {
    const float NEG = -__builtin_inff();
#pragma unroll
    for (int r = 0; r < 16; ++r) {
        const int k0 = kbase + (r & 3) + 8 * (r >> 2) + 4 * hi;
        if (k0 > pos || k0 < lowkey) p0[r] = NEG;
        if (k0 + 32 > pos || k0 + 32 < lowkey) p1[r] = NEG;
    }
}
__device__ __forceinline__ void partialSM(f32x16& p0, f32x16& p1, float& m_reg, float& mn, float& alpha) {
    float pmax = p0[0];
#pragma unroll
    for (int r = 1; r < 16; ++r) pmax = fmaxf(pmax, p0[r]);
#pragma unroll
    for (int r = 0; r < 16; ++r) pmax = fmaxf(pmax, p1[r]);
    { auto rr = __builtin_amdgcn_permlane32_swap(__float_as_uint(pmax), __float_as_uint(pmax), false, false);
      pmax = fmaxf(__uint_as_float(rr[0]), __uint_as_float(rr[1])); }
    constexpr float C2 = 1.4426950408889634f * SCALE;
    if (__builtin_expect(__all((pmax - m_reg) * SCALE <= THR), 1)) { mn = m_reg; alpha = 1.f; }
    else { mn = fmaxf(m_reg, pmax); alpha = __builtin_amdgcn_exp2f((m_reg - mn) * C2); m_reg = mn; }
    const float mnL = -mn * C2;
#pragma unroll
    for (int r = 0; r < 16; ++r) p0[r] = fmaf(p0[r], C2, mnL);
#pragma unroll
    for (int r = 0; r < 16; ++r) p1[r] = fmaf(p1[r], C2, mnL);
#pragma unroll
    for (int r = 0; r < 16; ++r) p0[r] = __builtin_amdgcn_exp2f(p0[r]);
}
__device__ __forceinline__ void finishSM(f32x16& p0, f32x16& p1, float alpha, float& l_reg, bf16x8& pa0, bf16x8& pa1, bf16x8& pa2, bf16x8& pa3) {
#pragma unroll
    for (int r = 0; r < 16; ++r) p1[r] = __builtin_amdgcn_exp2f(p1[r]);
    float ps = 0;
#pragma unroll
    for (int r = 0; r < 16; ++r) ps += p0[r];
#pragma unroll
    for (int r = 0; r < 16; ++r) ps += p1[r];
    { auto rr = __builtin_amdgcn_permlane32_swap(__float_as_uint(ps), __float_as_uint(ps), false, false);
      ps = __uint_as_float(rr[0]) + __uint_as_float(rr[1]); }
    l_reg = l_reg * alpha + ps;
#define FA_PK4(Pv, B_, OUT) do { unsigned a0 = cvtpk(Pv[B_+0], Pv[B_+1]), a1 = cvtpk(Pv[B_+2], Pv[B_+3]);                          \
        unsigned b0 = cvtpk(Pv[B_+4], Pv[B_+5]), b1 = cvtpk(Pv[B_+6], Pv[B_+7]);                                             \
        auto r0 = __builtin_amdgcn_permlane32_swap(a0, b0, false, false); auto r1 = __builtin_amdgcn_permlane32_swap(a1, b1, false, false); \
        u32x4 w = {r0[0], r1[0], r0[1], r1[1]}; OUT = *reinterpret_cast<bf16x8*>(&w); } while (0)
    FA_PK4(p0, 0, pa0); FA_PK4(p0, 8, pa1); FA_PK4(p1, 0, pa2); FA_PK4(p1, 8, pa3);
#undef FA_PK4
}
template <int KB>
__device__ __forceinline__ void qkt(f32x16& p0, f32x16& p1, const char* K_lds, int r32, int hi, const bf16x8* qr) {
    p0 = f32x16{}; p1 = f32x16{};
#pragma unroll
    for (int d0 = 0; d0 < 4; ++d0) { const char* a = K_lds + KB * SHM_K + kswz(r32, 2 * d0 + hi);
        bf16x8 b0 = *reinterpret_cast<const bf16x8*>(a);
        bf16x8 b1 = *reinterpret_cast<const bf16x8*>(a + 32 * 128);
        p0 = __builtin_amdgcn_mfma_f32_32x32x16_bf16(b0, qr[d0], p0, 0, 0, 0);
        p1 = __builtin_amdgcn_mfma_f32_32x32x16_bf16(b1, qr[d0], p1, 0, 0, 0); }
}
template <int VB>
__device__ __forceinline__ void pv_tile(f32x16* o, int vb0, bf16x8 pa0, bf16x8 pa1, bf16x8 pa2, bf16x8 pa3) {
#define FA_TRRD(dst, off) asm volatile("ds_read_b64_tr_b16 %0, %1 offset:%2" : "=&v"(dst) : "v"(vb0), "i"(off) : "memory")
#define FA_PV_D0(d0) do { s16x4 l0, l1, l2, l3, h0, h1, h2, h3; constexpr int b_ = VB * SHM_V + v_rd_off(d0, 0, 0); \
        FA_TRRD(l0, b_); FA_TRRD(h0, b_ + 2048); FA_TRRD(l1, b_ + 4096); FA_TRRD(h1, b_ + 6144); FA_TRRD(l2, b_ + 8192); FA_TRRD(h2, b_ + 10240); FA_TRRD(l3, b_ + 12288); FA_TRRD(h3, b_ + 14336); \
        asm volatile("s_waitcnt lgkmcnt(0)" ::: "memory"); FA_SBAR();   \
        o[d0] = __builtin_amdgcn_mfma_f32_32x32x16_bf16(pa0, (bf16x8){l0[0], l0[1], l0[2], l0[3], h0[0], h0[1], h0[2], h0[3]}, o[d0], 0, 0, 0);   \
        o[d0] = __builtin_amdgcn_mfma_f32_32x32x16_bf16(pa1, (bf16x8){l1[0], l1[1], l1[2], l1[3], h1[0], h1[1], h1[2], h1[3]}, o[d0], 0, 0, 0);   \
        o[d0] = __builtin_amdgcn_mfma_f32_32x32x16_bf16(pa2, (bf16x8){l2[0], l2[1], l2[2], l2[3], h2[0], h2[1], h2[2], h2[3]}, o[d0], 0, 0, 0);   \
        o[d0] = __builtin_amdgcn_mfma_f32_32x32x16_bf16(pa3, (bf16x8){l3[0], l3[1], l3[2], l3[3], h3[0], h3[1], h3[2], h3[3]}, o[d0], 0, 0, 0); } while (0)
    FA_PV_D0(0); FA_PV_D0(1); FA_PV_D0(2); FA_PV_D0(3);
#undef FA_PV_D0
#undef FA_TRRD
}
__device__ __forceinline__ void attn_pass(const bf16_t* Qp, const bf16_t* Kp, const bf16_t* Vp, int P0, int NT, char* lds, f32x16 (&o)[4], float& l_out) {
    const int tid = TIDX, wid = __builtin_amdgcn_readfirstlane(tid >> 6), lane = tid & 63, r32 = lane & 31, hi = lane >> 5;
    char* V_lds = lds; char* K_lds = lds + 2 * SHM_V;
    float* wsl = (float*)(lds + 2 * SHM_V + 2 * SHM_K) + wid * 64; float* al_l = wsl + 32;
    const int qlo = P0 + wid * 32, pos = qlo + r32;
    float m_reg = -1e30f, l_reg = 0.f;
#pragma unroll
    for (int d = 0; d < 4; ++d) o[d] = f32x16{};
    const int ksr = tid >> 3, ksc = tid & 7, kws = kswz(ksr, ksc);
    const int sr = tid >> 4, sc = (tid & 15) * 8, vst0 = v_st(sr, sc), vst1 = v_st(32 + sr, sc);
    const int vb0 = (int)(uintptr_t)V_lds + v_rd_base(lane);
    bf16x8 qr[4];
#pragma unroll
    for (int d0 = 0; d0 < 4; ++d0) qr[d0] = ld8(Qp + (size_t)pos * PITCH + d0 * 16 + hi * 8);
    bf16x8 st_k, st_v0, st_v1;
#define FA_KBASE(t) ((3 + (t)) * KVBLK)
#define FA_SLOAD(t) do { const int kb_ = FA_KBASE(t); st_k = ld8(Kp + (size_t)(kb_ + ksr) * PITCH + ksc * 8); \
        st_v0 = ld8(Vp + (size_t)(kb_ + sr) * PITCH + sc); st_v1 = ld8(Vp + (size_t)(kb_ + 32 + sr) * PITCH + sc); } while (0)
#define FA_SWRITE_K(bf) do { *(bf16x8*)(K_lds + (bf) * SHM_K + kws) = st_k; } while (0)
#define FA_SWRITE_V(bf) do { *(bf16x8*)(V_lds + (bf) * SHM_V + vst0) = st_v0; *(bf16x8*)(V_lds + (bf) * SHM_V + vst1) = st_v1; } while (0)
#define FA_VMW() asm volatile("s_waitcnt vmcnt(0)" ::: "memory")
#define FA_RESC(a) do { if (__any((a) < 1.f)) { if (hi == 0) al_l[r32] = (a); asm volatile("s_waitcnt lgkmcnt(0)" ::: "memory");              \
                     for (int d_ = 0; d_ < 4; ++d_) for (int r = 0; r < 16; ++r) o[d_][r] *= al_l[crow(r, hi)]; } } while (0)
#define FA_MASKT(P0_, P1_, t) do { const int kb_ = FA_KBASE(t); if ((t) == 0 || kb_ + KVBLK - 1 > qlo) mask_tile(P0_, P1_, pos, kb_, hi, VALID0); } while (0)
    f32x16 pA0, pA1, pB0, pB1; float mnA, mnB, alA, alB; bf16x8 pa0, pa1, pa2, pa3;
    FA_SLOAD(0); FA_VMW(); FA_SWRITE_K(0); FA_SWRITE_V(0); FA_SBAR();
    if (NT > 1) FA_SLOAD(1);
    __syncthreads();
    FA_SBAR(); qkt<0>(pA0, pA1, K_lds, r32, hi, qr);
    FA_MASKT(pA0, pA1, 0); partialSM(pA0, pA1, m_reg, mnA, alA);
    if (NT > 1) { FA_VMW(); FA_SWRITE_K(1); FA_SWRITE_V(1); }
    __syncthreads();
#define FA_HALF_STEP(PX0, PX1, mnX, alX, PY0, PY1, alY, t, KB, VB, SB) do {                                                      \
        FA_SBAR(); qkt<KB>(PX0, PX1, K_lds, r32, hi, qr);                                             \
        finishSM(PY0, PY1, alY, l_reg, pa0, pa1, pa2, pa3); FA_SBAR();                                                           \
        if ((t) + 1 < NT) { FA_SLOAD((t) + 1); FA_SBAR(); }                                               \
        pv_tile<VB>(o, vb0, pa0, pa1, pa2, pa3); FA_MASKT(PX0, PX1, (t)); partialSM(PX0, PX1, m_reg, mnX, alX);                                        \
        __syncthreads();                                                                                                      \
        if ((t) + 1 < NT) { FA_VMW(); FA_SWRITE_K(SB); FA_SWRITE_V(SB); }                                                                          \
        FA_RESC(alX); __syncthreads(); } while (0)
    for (int t = 1; t + 1 < NT; t += 2) {
        FA_HALF_STEP(pB0, pB1, mnB, alB, pA0, pA1, alA, t, 1, 0, 0);
        FA_HALF_STEP(pA0, pA1, mnA, alA, pB0, pB1, alB, t + 1, 0, 1, 1);
    }
    const bool even = (NT & 1) == 0;
    if (even) { FA_SBAR(); qkt<1>(pB0, pB1, K_lds, r32, hi, qr); FA_SBAR(); }
    finishSM(pA0, pA1, alA, l_reg, pa0, pa1, pa2, pa3); FA_SBAR();
    pv_tile<0>(o, vb0, pa0, pa1, pa2, pa3);
    if (even) { FA_MASKT(pB0, pB1, NT - 1); partialSM(pB0, pB1, m_reg, mnB, alB); __syncthreads(); FA_RESC(alB);
        finishSM(pB0, pB1, alB, l_reg, pa0, pa1, pa2, pa3); FA_SBAR(); pv_tile<1>(o, vb0, pa0, pa1, pa2, pa3); }
    l_out = l_reg;
    __syncthreads();
#undef FA_KBASE
#undef FA_SLOAD
#undef FA_SWRITE_K
#undef FA_SWRITE_V
#undef FA_VMW
#undef FA_RESC
#undef FA_MASKT
#undef FA_HALF_STEP
}
__device__ __forceinline__ void attn_unit(const Params& p, int l, int hd, int j, float lam, float lam_init, char* lds) {
    const int tid = TIDX, wid = __builtin_amdgcn_readfirstlane(tid >> 6), lane = tid & 63, r32 = lane & 31, hi = lane >> 5;
    const bf16_t* QA = (const bf16_t*)(p.ws + B_QA) + hd * 128; const bf16_t* KA = (const bf16_t*)(p.ws + B_KA) + hd * 128; const bf16_t* VA = (const bf16_t*)(p.ws + B_VA) + hd * 128;
    bf16_t* YA = (bf16_t*)(p.ws + B_YA) + hd * 128;
    const int P0 = j * 256, NT = 4 * j + 1;
    float* li_l = (float*)(lds + 2 * SHM_V + 2 * SHM_K) + wid * 64;
    bf16_t* Yw = YA + (size_t)(P0 + wid * 32) * PITCH;
    f32x16 o[4]; float lr;
    attn_pass(QA, KA, VA, P0, NT, lds, o, lr);
    if (hi == 0) li_l[r32] = lr;
    asm volatile("s_waitcnt lgkmcnt(0)" ::: "memory");
#pragma unroll
    for (int r = 0; r < 16; ++r) { const int orow = crow(r, hi); const float rl = __builtin_amdgcn_rcpf(li_l[orow]);
#pragma unroll
        for (int d0 = 0; d0 < 4; ++d0) { const float v = o[d0][r] * rl; const float vn = sx<1>(v);
            if ((r32 & 1) == 0) *(unsigned*)(Yw + (size_t)orow * PITCH + d0 * 32 + r32) = cvtpk(v, vn); } }
    asm volatile("s_waitcnt vmcnt(0)" ::: "memory");
    __syncthreads();
    attn_pass(QA + 64, KA + 64, VA, P0, NT, lds, o, lr);
    if (hi == 0) li_l[r32] = lr;
    asm volatile("s_waitcnt lgkmcnt(0)" ::: "memory");
    const float scale_out = 1.f - lam_init;
#pragma unroll
    for (int r = 0; r < 16; ++r) { const int orow = crow(r, hi); const float rl = lam * __builtin_amdgcn_rcpf(li_l[orow]);
        float cv[4]; float ss = 0.f;
#pragma unroll
        for (int d0 = 0; d0 < 4; ++d0) { const float o1 = bf2f((unsigned)Yw[(size_t)orow * PITCH + d0 * 32 + r32]); cv[d0] = o1 - o[d0][r] * rl; ss += cv[d0] * cv[d0]; }
        ss += sx<1>(ss); ss += sx<2>(ss); ss += sx<4>(ss); ss += sx<8>(ss); ss += sx<16>(ss);
        const float rs = rsqrtf(ss * (1.f / 128.f) + LN_EPS) * scale_out;
#pragma unroll
        for (int d0 = 0; d0 < 4; ++d0) o[d0][r] = cv[d0] * rs * p.in[I_ANG][l * 128 + d0 * 32 + r32]; }
    asm volatile("s_waitcnt vmcnt(0)" ::: "memory");
    __syncthreads();
#pragma unroll
    for (int r = 0; r < 16; ++r) { const int orow = crow(r, hi);
#pragma unroll
        for (int d0 = 0; d0 < 4; ++d0) { const float v = o[d0][r]; const float vn = sx<1>(v);
            if ((r32 & 1) == 0) *(unsigned*)(Yw + (size_t)orow * PITCH + d0 * 32 + r32) = cvtpk(v, vn); } }
    __syncthreads();
}
}
__device__ __forceinline__ void phase_attn_f(const Params& p, int l, char* lds, int bid, int nb) {
    const int lane = TIDX & 63;
    const float lam_init = 0.8f - 0.6f * expf(-0.3f * (float)l);
    float lam;
    { const float a = wave_sum(p.in[I_LQ1][l * 64 + lane] * p.in[I_LK1][l * 64 + lane]), b = wave_sum(p.in[I_LQ2][l * 64 + lane] * p.in[I_LK2][l * 64 + lane]);
      lam = expf(a) - expf(b) + lam_init; }
    for (int u = bid; u < 256 + 8; u += nb) {
        if (u < 256) { const int hd = u & 7, jj = u >> 3;
            fa::attn_unit(p, l, hd, 64 - jj, lam, lam_init, lds);
            fa::attn_unit(p, l, hd, 1 + jj, lam, lam_init, lds);
        } else fa::attn_unit(p, l, u - 256, 0, lam, lam_init, lds);
    }
}

__device__ __forceinline__ void phase_conv(const Params& p, int l, char* lds, int bid, int nb) {
    const int tid = TIDX, wid = tid >> 6, lane = tid & 63, gw = bid * NW + wid, ngw = nb * NW;
    const bf16_t* XM = (const bf16_t*)(p.ws + B_XM); bf16_t* XC = (bf16_t*)(p.ws + B_XC);
    const float* cw = p.in[I_CONVW] + (size_t)l * 4 * D; const float* cb = p.in[I_CONVB] + (size_t)l * D;
    const int nitem = P * (D / 8);
    for (int it = bid * NT + tid; it < nitem; it += nb * NT) {
        const int r = it >> 7, c0 = (it & 127) * 8;
        u32x4 o = {0u, 0u, 0u, 0u};
        if (r >= VALID0) {
            float acc[8];
#pragma unroll
            for (int i = 0; i < 8; ++i) acc[i] = cb[c0 + i];
#pragma unroll
            for (int j = 0; j < 4; ++j) { const int rr = r - 3 + j;
                if (rr >= VALID0) { const u32x4 x = *(const u32x4*)(XM + (size_t)rr * D + c0); const float* w = cw + j * D + c0;
                    acc[0] += w[0] * bf2f(x.x & 0xffffu); acc[1] += w[1] * bf2f(x.x >> 16); acc[2] += w[2] * bf2f(x.y & 0xffffu); acc[3] += w[3] * bf2f(x.y >> 16);
                    acc[4] += w[4] * bf2f(x.z & 0xffffu); acc[5] += w[5] * bf2f(x.z >> 16); acc[6] += w[6] * bf2f(x.w & 0xffffu); acc[7] += w[7] * bf2f(x.w >> 16); } }
            o.x = pk2(siluf_(acc[0]), siluf_(acc[1])); o.y = pk2(siluf_(acc[2]), siluf_(acc[3])); o.z = pk2(siluf_(acc[4]), siluf_(acc[5])); o.w = pk2(siluf_(acc[6]), siluf_(acc[7]));
        }
        *(u32x4*)(XC + (size_t)r * D + c0) = o;
    }
    const float* gli = (const float*)(p.ws + TAB_GLI); const float* glf = (const float*)(p.ws + TAB_GLF);
    float* tb = (float*)(p.ws + TAB_B); float* te = (float*)(p.ws + TAB_E); float* tpm = (float*)(p.ws + TAB_PM); float* tw = (float*)(p.ws + TAB_W);
    float* scg = (float*)(p.ws + TAB_SCG); float* scm = (float*)(p.ws + TAB_SCM);
    for (int t = gw; t < NSC * 4; t += ngw) {
        const int sc = t >> 2, h = t & 3; const size_t base = (size_t)h * P + sc * 256 + 4 * lane;
        const f32x4 lf = *(const f32x4*)(glf + base), li = *(const f32x4*)(gli + base);
        float b[4]; b[0] = lf.x; b[1] = b[0] + lf.y; b[2] = b[1] + lf.z; b[3] = b[2] + lf.w;
        float incl = b[3];
#pragma unroll
        for (int o = 1; o < 64; o <<= 1) { const float n = __shfl_up(incl, o); if (lane >= o) incl += n; }
        const float excl = incl - b[3];
        float e[4], pm[4];
#pragma unroll
        for (int i = 0; i < 4; ++i) { b[i] += excl; e[i] = li[i] - b[i]; }
        pm[0] = e[0]; pm[1] = fmaxf(pm[0], e[1]); pm[2] = fmaxf(pm[1], e[2]); pm[3] = fmaxf(pm[2], e[3]);
        float mi = pm[3];
#pragma unroll
        for (int o = 1; o < 64; o <<= 1) { const float n = __shfl_up(mi, o); if (lane >= o) mi = fmaxf(mi, n); }
        float mex = __shfl_up(mi, 1); if (lane == 0) mex = -INFINITY;
#pragma unroll
        for (int i = 0; i < 4; ++i) pm[i] = fmaxf(pm[i], mex);
        const float gtot = __shfl(incl, 63), emax = __shfl(mi, 63), mloc = gtot + emax;
        f32x4 ww;
#pragma unroll
        for (int i = 0; i < 4; ++i) ww[i] = __expf(e[i] + gtot - mloc);
        *(f32x4*)(tb + base) = (f32x4){b[0], b[1], b[2], b[3]};
        *(f32x4*)(te + base) = (f32x4){e[0], e[1], e[2], e[3]};
        *(f32x4*)(tpm + base) = (f32x4){pm[0], pm[1], pm[2], pm[3]};
        *(f32x4*)(tw + base) = ww;
        if (lane == 0) { scg[sc * 4 + h] = gtot; scm[sc * 4 + h] = mloc; }
    }
}

__device__ __forceinline__ void phase_m1(const Params& p, char* lds, int bid, int nb, int nsc) {
    const int tid = TIDX, wid = __builtin_amdgcn_readfirstlane(tid >> 6), lane = tid & 63, c = lane & 15, g = lane >> 4, gw = bid * NW + wid, ngw = nb * NW;
    const bf16_t* KMT = (const bf16_t*)(p.ws + B_KMT); const bf16_t* VMT = (const bf16_t*)(p.ws + B_VMT);
    const float* tw = (const float*)(p.ws + TAB_W); bf16_t* CT = (bf16_t*)(p.ws + B_CT); float* NTv = (float*)(p.ws + TAB_NT);
    for (int u = bid; u < nsc * 4 * 2; u += nb) {
        const int dvb = (u & 1) * 8 + wid, h = (u >> 1) & 3, sc = u >> 3, s0 = sc * 256;
        f32x4 acc[16];
#pragma unroll
        for (int i = 0; i < 16; ++i) acc[i] = (f32x4){0.f, 0.f, 0.f, 0.f};
        float un[16];
#pragma unroll
        for (int i = 0; i < 16; ++i) un[i] = 0.f;
        for (int ks = 0; ks < 8; ++ks) {
            const int sb = s0 + 32 * ks + 8 * g;
            const f32x4 w0 = *(const f32x4*)(tw + (size_t)h * P + sb), w1 = *(const f32x4*)(tw + (size_t)h * P + sb + 4);
            const u32x4 vv = *(const u32x4*)(VMT + (size_t)(h * 256 + 16 * dvb + c) * P + sb);
            u32x4 vw; vw.x = pk2(bf2f(vv.x & 0xffffu) * w0.x, bf2f(vv.x >> 16) * w0.y); vw.y = pk2(bf2f(vv.y & 0xffffu) * w0.z, bf2f(vv.y >> 16) * w0.w);
            vw.z = pk2(bf2f(vv.z & 0xffffu) * w1.x, bf2f(vv.z >> 16) * w1.y); vw.w = pk2(bf2f(vv.w & 0xffffu) * w1.z, bf2f(vv.w >> 16) * w1.w);
            const bf16x8 vf = *(bf16x8*)&vw;
#pragma unroll
            for (int dk = 0; dk < 16; ++dk) {
                const u32x4 kk = *(const u32x4*)(KMT + (size_t)(h * 256 + 16 * dk + c) * P + sb);
                acc[dk] = mfma16(*(const bf16x8*)&kk, vf, acc[dk]);
                if (dvb == 0) un[dk] += bf2f(kk.x & 0xffffu) * w0.x + bf2f(kk.x >> 16) * w0.y + bf2f(kk.y & 0xffffu) * w0.z + bf2f(kk.y >> 16) * w0.w
                                      + bf2f(kk.z & 0xffffu) * w1.x + bf2f(kk.z >> 16) * w1.y + bf2f(kk.w & 0xffffu) * w1.z + bf2f(kk.w >> 16) * w1.w;
            }
        }
        bf16_t* dst = CT + ((size_t)(sc * 4 + h) * 256 + 16 * dvb + c) * 256;
#pragma unroll
        for (int dk = 0; dk < 16; ++dk) store4_bf16(dst + 16 * dk + 4 * g, acc[dk]);
        if (dvb == 0) {
#pragma unroll
            for (int dk = 0; dk < 16; ++dk) { float v = un[dk]; v += sx<16>(v); v = sum32(v); if (g == 0) NTv[(size_t)(sc * 4 + h) * 256 + 16 * dk + c] = v; }
        }
    }
}

namespace pg8 {
template <class F> __device__ __forceinline__ void for_each_piece_local(const f32x4 (&acc)[2][2][4][2], int wr, int wc, int fr, int fq, const F& f) {
    asm volatile("" : "+v"(fr), "+v"(fq));
    const int row0 = wr * 64 + fr, col0 = wc * 32 + 8 * fq;
#pragma unroll
    for (int ai = 0; ai < 2; ++ai)
#pragma unroll
        for (int m = 0; m < 4; ++m)
#pragma unroll
            for (int bj = 0; bj < 2; ++bj) f(row0 + ai * HALF + m * 16, col0 + bj * HALF, acc[ai][bj][m][0], acc[ai][bj][m][1]);
}
}
struct SchedM1 { const char* VWT; const char* KMT; int G, c; int K, lda, ldb;
    __device__ __forceinline__ bool next(int i, pg8::Unit& u) const { return pg8::decode_unit((long)i * G + c, 4, 64, 1, u); }
    __device__ __forceinline__ const char* abase(const pg8::Unit& u) const { return VWT + ((size_t)u.grp * 256 * P + (size_t)(u.pm + 1) * 256) * 2; }
    __device__ __forceinline__ const char* bbase(const pg8::Unit& u) const { return KMT + ((size_t)u.grp * 256 * P + (size_t)(u.pm + 1) * 256) * 2; } };
struct EpiM1 { bf16_t* CT;
    __device__ __forceinline__ void operator()(const f32x4 (&acc)[2][2][4][2], const pg8::Unit& u, int wr, int wc, int fr, int fq) const {
        bf16_t* base = CT + (size_t)((u.pm + 1) * 4 + u.grp) * 65536;
        pg8::for_each_piece_local(acc, wr, wc, fr, fq, [&](int row, int col, f32x4 v0, f32x4 v1) { *(u32x4*)(base + (size_t)row * 256 + col) = pg8::pack8(v0, v1); }); } };
__device__ __forceinline__ void phase_ms(const Params& p, char* lds, int bid, int nb) {
    phase_m1(p, lds, bid, nb, 1);
    const int tid = TIDX, wid = __builtin_amdgcn_readfirstlane(tid >> 6), lane = tid & 63, c = lane & 15, g = lane >> 4, gw = bid * NW + wid, ngw = nb * NW;
    const bf16_t* KMT = (const bf16_t*)(p.ws + B_KMT); const float* tw = (const float*)(p.ws + TAB_W); float* NTv = (float*)(p.ws + TAB_NT);
    for (int t = gw; t < 64 * 4 * 16; t += ngw) {
        const int dkb = t & 15, h = (t >> 4) & 3, sc = 1 + (t >> 6);
        const bf16_t* kr = KMT + (size_t)(h * 256 + 16 * dkb + c) * P + sc * 256 + 64 * g; const float* wp = tw + (size_t)h * P + sc * 256 + 64 * g;
        float a = 0.f;
#pragma unroll
        for (int i = 0; i < 8; ++i) { const u32x4 kk = *(const u32x4*)(kr + 8 * i); const f32x4 w0 = *(const f32x4*)(wp + 8 * i), w1 = *(const f32x4*)(wp + 8 * i + 4);
            a += bf2f(kk.x & 0xffffu) * w0.x + bf2f(kk.x >> 16) * w0.y + bf2f(kk.y & 0xffffu) * w0.z + bf2f(kk.y >> 16) * w0.w
               + bf2f(kk.z & 0xffffu) * w1.x + bf2f(kk.z >> 16) * w1.y + bf2f(kk.w & 0xffffu) * w1.z + bf2f(kk.w >> 16) * w1.w; }
        a += sx<16>(a); a = sum32(a);
        if (g == 0) NTv[(size_t)(sc * 4 + h) * 256 + 16 * dkb + c] = a;
    }
    SchedM1 S{(const char*)(p.ws + B_VWT), (const char*)KMT, nb, bid, 256, P, P};
    pg8::gemm_phase((PG8_LAS unsigned char*)lds, S, EpiM1{(bf16_t*)(p.ws + B_CT)});
}

__device__ __forceinline__ void phase_m2(const Params& p, char* lds, int bid, int nb) {
    const float* scg = (const float*)(p.ws + TAB_SCG); const float* scm = (const float*)(p.ws + TAB_SCM);
    unsigned* CT = (unsigned*)(p.ws + B_CT); float* NTv = (float*)(p.ws + TAB_NT); float* mt = (float*)(p.ws + TAB_MT);
    const int gid = bid * NT + TIDX, nth = nb * NT;
    for (int i = gid; i < 4 * 32768 + 1024; i += nth) {
        if (i < 4 * 32768) {
            const int h = i >> 15, idx = i & 32767;
            unsigned* base = CT + (size_t)h * 32768 + idx;
            unsigned u[NSC];
#pragma unroll
            for (int sc = 0; sc < NSC; ++sc) u[sc] = base[(size_t)sc * 4 * 32768];
            float m = 0.f, c0 = 0.f, c1 = 0.f;
#pragma unroll
            for (int sc = 0; sc < NSC; ++sc) {
                const float gg = scg[sc * 4 + h], ml = scm[sc * 4 + h], mn = fmaxf(gg + m, ml), dec = __expf(gg + m - mn), cor = __expf(ml - mn);
                c0 = dec * c0 + cor * bf2f(u[sc] & 0xffffu); c1 = dec * c1 + cor * bf2f(u[sc] >> 16);
                base[(size_t)sc * 4 * 32768] = pk2(c0, c1); m = mn;
            }
        } else {
            const int j = i - 4 * 32768, h = j >> 8, d = j & 255;
            float m = 0.f, n = 0.f;
            for (int sc = 0; sc < NSC; ++sc) {
                const float gg = scg[sc * 4 + h], ml = scm[sc * 4 + h], mn = fmaxf(gg + m, ml), dec = __expf(gg + m - mn), cor = __expf(ml - mn);
                float* ptr = NTv + (size_t)(sc * 4 + h) * 256 + d;
                n = dec * n + cor * *ptr; *ptr = n; m = mn;
                if (d == 0) mt[sc * 4 + h] = mn;
            }
        }
    }
}

__device__ __forceinline__ void phase_m3(const Params& p, int l, char* lds, int bid, int nb, bool sc0_only) {
    const int tid = TIDX, wid = __builtin_amdgcn_readfirstlane(tid >> 6), lane = tid & 63, c = lane & 15, g = lane >> 4, gw = bid * NW + wid, ngw = nb * NW;
    const bf16_t* QM = (const bf16_t*)(p.ws + B_QM); const bf16_t* KM = (const bf16_t*)(p.ws + B_KM); const bf16_t* VMT = (const bf16_t*)(p.ws + B_VMT);
    const bf16_t* CT = (const bf16_t*)(p.ws + B_CT); const float* NTv = (const float*)(p.ws + TAB_NT); const float* mt = (const float*)(p.ws + TAB_MT);
    const float* tb = (const float*)(p.ws + TAB_B); const float* te = (const float*)(p.ws + TAB_E); const float* tpm = (const float*)(p.ws + TAB_PM);
    const bf16_t* OP = (const bf16_t*)(p.ws + B_OP); bf16_t* YM = (bf16_t*)(p.ws + B_YM);
    constexpr int NRG = P / 16, RG0 = VALID0 / 16;
    const int ntask = (NRG - RG0) * 4;
    for (int u = (sc0_only ? 256 : 0) + bid; u < (sc0_only ? 260 : NSC * 4 * 2); u += nb) {
        const int half = u < NSC * 4 ? 1 : 0, uu = u < NSC * 4 ? u : u - NSC * 4, sc = (NSC - 1) - (uu >> 2), h = uu & 3, rg = sc * 16 + half * 8 + wid;
        if (rg < RG0) continue;
        const int t0 = rg * 16, row = t0 + c, s_start = sc << 8;
        bf16x8 qf[8];
#pragma unroll
        for (int ks = 0; ks < 8; ++ks) qf[ks] = ld8(QM + (size_t)row * D + h * 256 + 32 * ks + 8 * g);
        const float b_t = tb[(size_t)h * P + row], pm_t = tpm[(size_t)h * P + row];
        const float m_prev = sc > 0 ? mt[(sc - 1) * 4 + h] : 0.f;
        const float m_t = b_t + fmaxf(m_prev, pm_t), scale_t = __expf(b_t + m_prev - m_t);
        f32x4 acc[16];
#pragma unroll
        for (int i = 0; i < 16; ++i) acc[i] = (f32x4){0.f, 0.f, 0.f, 0.f};
        float den = 0.f;
        if (sc > 0) {
            const bf16_t* Cb = CT + (size_t)((sc - 1) * 4 + h) * 65536; const float* nv = NTv + (size_t)((sc - 1) * 4 + h) * 256;
#pragma unroll 2
            for (int ks = 0; ks < 8; ++ks) {
#pragma unroll
                for (int dt = 0; dt < 16; ++dt) acc[dt] = mfma16(ld8(Cb + (size_t)(16 * dt + c) * 256 + 32 * ks + 8 * g), qf[ks], acc[dt]);
                const f32x4 n0 = *(const f32x4*)(nv + 32 * ks + 8 * g), n1 = *(const f32x4*)(nv + 32 * ks + 8 * g + 4);
                const u32x4 qq = *(const u32x4*)&qf[ks];
                den += bf2f(qq.x & 0xffffu) * n0.x + bf2f(qq.x >> 16) * n0.y + bf2f(qq.y & 0xffffu) * n0.z + bf2f(qq.y >> 16) * n0.w
                     + bf2f(qq.z & 0xffffu) * n1.x + bf2f(qq.z >> 16) * n1.y + bf2f(qq.w & 0xffffu) * n1.z + bf2f(qq.w >> 16) * n1.w;
            }
            den *= scale_t;
#pragma unroll
            for (int dt = 0; dt < 16; ++dt) acc[dt] = acc[dt] * scale_t;
        }
        for (int kb = s_start; kb <= t0 + 15; kb += 32) {
            f32x4 s[2];
#pragma unroll
            for (int a = 0; a < 2; ++a) {
                s[a] = (f32x4){0.f, 0.f, 0.f, 0.f};
                const bf16_t* kr = KM + (size_t)(kb + 16 * a + c) * D + h * 256 + 8 * g;
#pragma unroll
                for (int ks = 0; ks < 8; ++ks) s[a] = mfma16(ld8(kr + 32 * ks), qf[ks], s[a]);
                const f32x4 ee = *(const f32x4*)(te + (size_t)h * P + kb + 16 * a + 4 * g);
#pragma unroll
                for (int r = 0; r < 4; ++r) { const int key = kb + 16 * a + 4 * g + r; const float arg = fminf(ee[r] + b_t - m_t, 0.f);
                    const float dd = key <= row ? __expf(arg) : 0.f; const float pv = s[a][r] * dd; s[a][r] = pv; den += pv; }
            }
            u32x4 w; w.x = pk2(s[0][0], s[0][1]); w.y = pk2(s[0][2], s[0][3]); w.z = pk2(s[1][0], s[1][1]); w.w = pk2(s[1][2], s[1][3]);
            const bf16x8 pf = *(bf16x8*)&w;
#pragma unroll
            for (int dt = 0; dt < 16; ++dt) {
                const bf16_t* vr = VMT + (size_t)(h * 256 + 16 * dt + c) * P + kb + 4 * g;
                const u32x2 v0 = *(const u32x2*)vr, v1 = *(const u32x2*)(vr + 16);
                u32x4 vv; vv.x = v0.x; vv.y = v0.y; vv.z = v1.x; vv.w = v1.y;
                acc[dt] = mfma16(*(bf16x8*)&vv, pf, acc[dt]);
            }
        }
        den += sx<16>(den); den = sum32(den);
        const float inv = 1.f / fmaxf(fabsf(den), __expf(-m_t));
        float s1 = 0.f;
#pragma unroll
        for (int dt = 0; dt < 16; ++dt) {
            const u32x2 og = *(const u32x2*)(OP + (size_t)row * D + h * 256 + 16 * dt + 4 * g);
            f32x4 v = acc[dt] * inv;
            v.x *= sigmoidf_(bf2f(og.x & 0xffffu)); v.y *= sigmoidf_(bf2f(og.x >> 16)); v.z *= sigmoidf_(bf2f(og.y & 0xffffu)); v.w *= sigmoidf_(bf2f(og.y >> 16));
            acc[dt] = v; s1 += (v.x + v.y) + (v.z + v.w);
        }
        s1 += sx<16>(s1); s1 = sum32(s1);
        const float mu = s1 * (1.f / 256.f);
        float s2 = 0.f;
#pragma unroll
        for (int dt = 0; dt < 16; ++dt) { acc[dt] = acc[dt] - mu; s2 += (acc[dt].x * acc[dt].x + acc[dt].y * acc[dt].y) + (acc[dt].z * acc[dt].z + acc[dt].w * acc[dt].w); }
        s2 += sx<16>(s2); s2 = sum32(s2);
        const float rstd = rsqrtf(s2 * (1.f / 256.f) + LN_EPS);
#pragma unroll
        for (int dt = 0; dt < 16; ++dt) { const f32x4 gg = *(const f32x4*)(p.in[I_MNG] + (size_t)l * D + h * 256 + 16 * dt + 4 * g);
            store4_bf16(YM + (size_t)row * D + h * 256 + 16 * dt + 4 * g, acc[dt] * rstd * gg); }
    }
}

struct EpiBr1 { float* MRG; const bf16_t* GA;
    __device__ __forceinline__ void operator()(int m, int n, f32x4 v) const { const u32x2 gg = *(const u32x2*)(GA + (size_t)m * D + n);
        f32x4 o; o.x = v.x * sigmoidf_(bf2f(gg.x & 0xffffu)); o.y = v.y * sigmoidf_(bf2f(gg.x >> 16)); o.z = v.z * sigmoidf_(bf2f(gg.y & 0xffffu)); o.w = v.w * sigmoidf_(bf2f(gg.y >> 16));
        *(f32x4*)(MRG + (size_t)m * D + n) = o; } };
struct EpiBr2 { const float* MRG; const bf16_t* GB; bf16_t* OUT;
    __device__ __forceinline__ void operator()(int m, int n, f32x4 v) const { const u32x2 gg = *(const u32x2*)(GB + (size_t)m * D + n); const f32x4 t = *(const f32x4*)(MRG + (size_t)m * D + n);
        f32x4 o; o.x = t.x + v.x * sigmoidf_(bf2f(gg.x & 0xffffu)); o.y = t.y + v.y * sigmoidf_(bf2f(gg.x >> 16)); o.z = t.z + v.z * sigmoidf_(bf2f(gg.y & 0xffffu)); o.w = t.w + v.w * sigmoidf_(bf2f(gg.y >> 16));
        store4_bf16(OUT + (size_t)m * D + n, o); } };
struct EpiOut { float* Z; const bf16_t* H;
    __device__ __forceinline__ void operator()(int m, int n, f32x4 v) const { const u32x2 hh = *(const u32x2*)(H + (size_t)m * D + n);
        f32x4 o; o.x = v.x + DN_ALPHA * bf2f(hh.x & 0xffffu); o.y = v.y + DN_ALPHA * bf2f(hh.x >> 16); o.z = v.z + DN_ALPHA * bf2f(hh.y & 0xffffu); o.w = v.w + DN_ALPHA * bf2f(hh.y >> 16);
        *(f32x4*)(Z + (size_t)m * D + n) = o; } };
constexpr int LDS_TAB_OFF = 131072;
constexpr int LDS_MT_OFF = LDS_TAB_OFF + 256;
constexpr int LDS_STAT_OFF = LDS_TAB_OFF + 2048;
__device__ __forceinline__ void compute_mtab_lds(const Params& p, char* lds) {
    float* mt = (float*)(lds + LDS_MT_OFF);
    const int t = TIDX;
    if (t < 4) { const float* scg = (const float*)(p.ws + TAB_SCG); const float* scm = (const float*)(p.ws + TAB_SCM); float m = 0.f;
        for (int sc = 0; sc < NSC; ++sc) { m = fmaxf(scg[sc * 4 + t] + m, scm[sc * 4 + t]); mt[sc * 4 + t] = m; } }
    __syncthreads();
}
struct SchedQK { const char* A; const char* B; int G, c; int K, lda, ldb;
    __device__ __forceinline__ bool next(int i, pg8::Unit& u) const { if (!pg8::decode_unit((long)i * G + c, 4, 64, 1, u)) return false; u.pm += 1; return true; }
    __device__ __forceinline__ const char* abase(const pg8::Unit& u) const { return A + ((size_t)u.pm * 256 * D + u.grp * 256) * 2; }
    __device__ __forceinline__ const char* bbase(const pg8::Unit& u) const { return B + ((size_t)u.pm * 256 * D + u.grp * 256) * 2; } };
struct EpiS { unsigned char* ws; const float* mt_lds;
    __device__ __forceinline__ void operator()(const f32x4 (&acc)[2][2][4][2], const pg8::Unit& u, int wr, int wc, int fr, int fq) const {
        asm volatile("" : "+v"(fr), "+v"(fq));
        const int h = u.grp, t0 = u.pm * 256; const float m_prev = mt_lds[(u.pm - 1) * 4 + h];
        const float* te = (const float*)(ws + TAB_E) + (size_t)h * P + t0; const float* tpm = (const float*)(ws + TAB_PM) + (size_t)h * P + t0;
        bf16_t* PMb = (bf16_t*)(ws + B_PM) + (size_t)t0 * D + h * 256; float* denp = (float*)(ws + TAB_DENP);
        const int c0 = wc * 32 + 8 * fq;
        f32x4 e[2][2];
#pragma unroll
        for (int bj = 0; bj < 2; ++bj) { e[bj][0] = *(const f32x4*)(te + c0 + bj * 128); e[bj][1] = *(const f32x4*)(te + c0 + bj * 128 + 4); }
#pragma unroll
        for (int ai = 0; ai < 2; ++ai)
#pragma unroll
            for (int m = 0; m < 4; ++m) { const int r = ai * 128 + wr * 64 + m * 16 + fr; const float pmx = fmaxf(m_prev, tpm[r]); float rs = 0.f;
#pragma unroll
                for (int bj = 0; bj < 2; ++bj) { f32x4 o0, o1;
#pragma unroll
                    for (int j = 0; j < 4; ++j) { const int s0 = c0 + bj * 128 + j, s1 = s0 + 4;
                        o0[j] = s0 <= r ? acc[ai][bj][m][0][j] * __expf(fminf(e[bj][0][j] - pmx, 0.f)) : 0.f;
                        o1[j] = s1 <= r ? acc[ai][bj][m][1][j] * __expf(fminf(e[bj][1][j] - pmx, 0.f)) : 0.f;
                        rs += o0[j] + o1[j]; }
                    *(u32x4*)(PMb + (size_t)r * D + c0 + bj * 128) = pg8::pack8(o0, o1); }
                rs += sx<16>(rs); rs = sum32(rs);
                if (fq == 0) denp[((size_t)(t0 + r) * 4 + h) * 4 + wc] = rs; } } };
struct SchedO1 { const char* A; const char* B; int G, c; int K, lda, ldb;
    __device__ __forceinline__ bool next(int i, pg8::Unit& u) const { if (!pg8::decode_unit((long)i * G + c, 4, 64, 1, u)) return false; u.pm += 1; return true; }
    __device__ __forceinline__ const char* abase(const pg8::Unit& u) const { return A + ((size_t)u.pm * 256 * D + u.grp * 256) * 2; }
    __device__ __forceinline__ const char* bbase(const pg8::Unit& u) const { return B + (size_t)((u.pm - 1) * 4 + u.grp) * 65536 * 2; } };
struct EpiO1 { unsigned char* ws;
    __device__ __forceinline__ void operator()(const f32x4 (&acc)[2][2][4][2], const pg8::Unit& u, int wr, int wc, int fr, int fq) const {
        asm volatile("" : "+v"(fr), "+v"(fq));
        const int h = u.grp, t0 = u.pm * 256; const float m_prev = ((const float*)(ws + TAB_MT))[(u.pm - 1) * 4 + h];
        const float* tpm = (const float*)(ws + TAB_PM) + (size_t)h * P + t0; bf16_t* OI = (bf16_t*)(ws + B_OI) + (size_t)t0 * D + h * 256;
        const int c0 = wc * 32 + 8 * fq;
#pragma unroll
        for (int ai = 0; ai < 2; ++ai)
#pragma unroll
            for (int m = 0; m < 4; ++m) { const int r = ai * 128 + wr * 64 + m * 16 + fr; const float sc = __expf(fminf(m_prev - tpm[r], 0.f));
#pragma unroll
                for (int bj = 0; bj < 2; ++bj) *(u32x4*)(OI + (size_t)r * D + c0 + bj * 128) = pg8::pack8(acc[ai][bj][m][0] * sc, acc[ai][bj][m][1] * sc); } } };
struct SchedO2 { const char* A; const char* B; int G, c; int K, lda, ldb;
    __device__ __forceinline__ bool next(int i, pg8::Unit& u) const { if (!pg8::decode_unit((long)i * G + c, 4, 64, 1, u)) return false; u.pm += 1; return true; }
    __device__ __forceinline__ const char* abase(const pg8::Unit& u) const { return A + ((size_t)u.pm * 256 * D + u.grp * 256) * 2; }
    __device__ __forceinline__ const char* bbase(const pg8::Unit& u) const { return B + ((size_t)u.grp * 256 * P + (size_t)u.pm * 256) * 2; } };
struct EpiO2 { unsigned char* ws; const float* mng; float* stat;
    __device__ __forceinline__ void operator()(f32x4 (&acc)[2][2][4][2], const pg8::Unit& u, int wr, int wc, int fr, int fq) const {
        asm volatile("" : "+v"(fr), "+v"(fq));
        const int h = u.grp, t0 = u.pm * 256; const float m_prev = ((const float*)(ws + TAB_MT))[(u.pm - 1) * 4 + h];
        const float* tpm = (const float*)(ws + TAB_PM) + (size_t)h * P + t0; const float* tb = (const float*)(ws + TAB_B) + (size_t)h * P + t0;
        const float* denp = (const float*)(ws + TAB_DENP); const float* deni = (const float*)(ws + TAB_DENI);
        const bf16_t* OI = (const bf16_t*)(ws + B_OI) + (size_t)t0 * D + h * 256; const bf16_t* OP = (const bf16_t*)(ws + B_OP) + (size_t)t0 * D + h * 256;
        bf16_t* YM = (bf16_t*)(ws + B_YM) + (size_t)t0 * D + h * 256;
        const int c0 = wc * 32 + 8 * fq;
#pragma unroll
        for (int ai = 0; ai < 2; ++ai)
#pragma unroll
            for (int m = 0; m < 4; ++m) { const int r = ai * 128 + wr * 64 + m * 16 + fr;
                const f32x4 dp = *(const f32x4*)(denp + ((size_t)(t0 + r) * 4 + h) * 4); const float den = (dp.x + dp.y) + (dp.z + dp.w) + deni[(size_t)(t0 + r) * 4 + h];
                const float m_t = tb[r] + fmaxf(m_prev, tpm[r]); const float inv = 1.f / fmaxf(fabsf(den), __expf(-m_t));
                float s1 = 0.f, s2 = 0.f;
#pragma unroll
                for (int bj = 0; bj < 2; ++bj) { f32x4 i0, i1, g0, g1; pg8::unpack8(*(const u32x4*)(OI + (size_t)r * D + c0 + bj * 128), i0, i1); pg8::unpack8(*(const u32x4*)(OP + (size_t)r * D + c0 + bj * 128), g0, g1);
                    f32x4 v0 = (acc[ai][bj][m][0] + i0) * inv * sig4(g0), v1 = (acc[ai][bj][m][1] + i1) * inv * sig4(g1);
                    acc[ai][bj][m][0] = v0; acc[ai][bj][m][1] = v1;
                    s1 += (v0.x + v0.y) + (v0.z + v0.w) + (v1.x + v1.y) + (v1.z + v1.w);
                    s2 += (v0.x * v0.x + v0.y * v0.y) + (v0.z * v0.z + v0.w * v0.w) + (v1.x * v1.x + v1.y * v1.y) + (v1.z * v1.z + v1.w * v1.w); }
                s1 += sx<16>(s1); s1 = sum32(s1); s2 += sx<16>(s2); s2 = sum32(s2);
                if (fq == 0) { stat[(r * 4 + wc) * 2] = s1; stat[(r * 4 + wc) * 2 + 1] = s2; } }
        asm volatile("s_waitcnt lgkmcnt(0)" ::: "memory"); __builtin_amdgcn_s_barrier(); asm volatile("" ::: "memory");
#pragma unroll
        for (int ai = 0; ai < 2; ++ai)
#pragma unroll
            for (int m = 0; m < 4; ++m) { const int r = ai * 128 + wr * 64 + m * 16 + fr;
                const f32x4 a = *(const f32x4*)(stat + r * 8), b = *(const f32x4*)(stat + r * 8 + 4);
                const float mu = ((a.x + a.z) + (b.x + b.z)) * (1.f / 256.f), ex2 = ((a.y + a.w) + (b.y + b.w)) * (1.f / 256.f);
                const float rstd = rsqrtf(fmaxf(ex2 - mu * mu, 0.f) + LN_EPS);
#pragma unroll
                for (int bj = 0; bj < 2; ++bj) { const f32x4 g0 = *(const f32x4*)(mng + h * 256 + c0 + bj * 128), g1 = *(const f32x4*)(mng + h * 256 + c0 + bj * 128 + 4);
                    *(u32x4*)(YM + (size_t)r * D + c0 + bj * 128) = pg8::pack8((acc[ai][bj][m][0] - mu) * rstd * g0, (acc[ai][bj][m][1] - mu) * rstd * g1); } } } };
__device__ __forceinline__ void phase_o1(const Params& p, char* lds, int bid, int nb) {
    const int tid = TIDX, wid = __builtin_amdgcn_readfirstlane(tid >> 6), lane = tid & 63, c = lane & 15, g = lane >> 4, gw = bid * NW + wid, ngw = nb * NW;
    const bf16_t* QM = (const bf16_t*)(p.ws + B_QM); const float* NTv = (const float*)(p.ws + TAB_NT); const float* mt = (const float*)(p.ws + TAB_MT);
    const float* tpm = (const float*)(p.ws + TAB_PM); float* deni = (float*)(p.ws + TAB_DENI);
    for (int it = gw; it < ((P - 256) / 16) * 4; it += ngw) {
        const int h = it & 3, t = 256 + (it >> 2) * 16 + c, sc = t >> 8;
        const bf16_t* qr = QM + (size_t)t * D + h * 256 + 64 * g; const float* nv = NTv + (size_t)((sc - 1) * 4 + h) * 256 + 64 * g;
        float a = 0.f;
#pragma unroll
        for (int i = 0; i < 8; ++i) { const u32x4 qq = *(const u32x4*)(qr + 8 * i); const f32x4 n0 = *(const f32x4*)(nv + 8 * i), n1 = *(const f32x4*)(nv + 8 * i + 4);
            a += bf2f(qq.x & 0xffffu) * n0.x + bf2f(qq.x >> 16) * n0.y + bf2f(qq.y & 0xffffu) * n0.z + bf2f(qq.y >> 16) * n0.w
               + bf2f(qq.z & 0xffffu) * n1.x + bf2f(qq.z >> 16) * n1.y + bf2f(qq.w & 0xffffu) * n1.z + bf2f(qq.w >> 16) * n1.w; }
        a += sx<16>(a); a = sum32(a);
        if (g == 0) deni[(size_t)t * 4 + h] = a * __expf(fminf(mt[(sc - 1) * 4 + h] - tpm[(size_t)h * P + t], 0.f));
    }
    SchedO1 S{(const char*)QM, (const char*)(p.ws + B_CT), nb, bid, 256, D, 256};
    pg8::gemm_phase((PG8_LAS unsigned char*)lds, S, EpiO1{p.ws});
}
__device__ __forceinline__ void phase_sg(const Params& p, char* lds, int bid, int nb) {
    compute_mtab_lds(p, lds);
    SchedQK S{(const char*)(p.ws + B_QM), (const char*)(p.ws + B_KM), nb, bid, 256, D, D};
    pg8::gemm_phase((PG8_LAS unsigned char*)lds, S, EpiS{p.ws, (const float*)(lds + LDS_MT_OFF)});
}
__device__ __forceinline__ void phase_o2(const Params& p, int l, char* lds, int bid, int nb) {
    phase_m3(p, l, lds, bid, nb, true);
    SchedO2 S{(const char*)(p.ws + B_PM), (const char*)(p.ws + B_VMT), nb, bid, 256, D, P};
    pg8::gemm_phase((PG8_LAS unsigned char*)lds, S, EpiO2{p.ws, p.in[I_MNG] + (size_t)l * D, (float*)(lds + LDS_STAT_OFF)});
}

struct SchedMqkvN { const char* XC; const char* WQ; const char* WK; int G, c; int K, lda, ldb;
    __device__ __forceinline__ bool next(int i, pg8::Unit& u) const { if (!pg8::decode_unit((long)i * G + c, 8, 64, 1, u)) return false; u.pm += 1; return true; }
    __device__ __forceinline__ const char* abase(const pg8::Unit& u) const { return XC + (size_t)(u.grp & 3) * 512 + (size_t)u.pm * 256 * D * 2; }
    __device__ __forceinline__ const char* bbase(const pg8::Unit& u) const { return ((u.grp >> 2) ? WK : WQ) + (size_t)(u.grp & 3) * 65536 * 2; } };
struct SchedMqkvT { const char* XC; const char* XM; const char* WK; const char* WV; int G, c; int K, lda, ldb;
    __device__ __forceinline__ bool next(int i, pg8::Unit& u) const { if (!pg8::decode_unit((long)i * G + c, 8, 1, 64, u)) return false; u.pn += 1; return true; }
    __device__ __forceinline__ const char* abase(const pg8::Unit& u) const { return ((u.grp >> 2) ? WV : WK) + (size_t)(u.grp & 3) * 65536 * 2; }
    __device__ __forceinline__ const char* bbase(const pg8::Unit& u) const { return ((u.grp >> 2) ? XM : XC) + (size_t)(u.grp & 3) * 512 + (size_t)u.pn * 256 * D * 2; } };
struct EpiGrpF { bf16_t* base0; bf16_t* base1; size_t hstride; size_t ldc; float s0, s1;
    __device__ __forceinline__ void operator()(const f32x4 (&acc)[2][2][4][2], const pg8::Unit& u, int wr, int wc, int fr, int fq) const {
        const int which = u.grp >> 2, h = u.grp & 3; const float sc = which ? s1 : s0;
        bf16_t* base = (which ? base1 : base0) + (size_t)h * hstride + (size_t)u.pn * 256;
        const size_t ld = ldc;
        pg8::for_each_piece(acc, u, wr, wc, fr, fq, [&](int row, int col, f32x4 v0, f32x4 v1) { *(u32x4*)(base + (size_t)row * ld + col) = pg8::pack8(v0 * sc, v1 * sc); }); } };
struct EpiMqkvT { unsigned char* ws;
    __device__ __forceinline__ void operator()(const f32x4 (&acc)[2][2][4][2], const pg8::Unit& u, int wr, int wc, int fr, int fq) const {
        bf16_t* KMT = (bf16_t*)(ws + B_KMT); bf16_t* VMT = (bf16_t*)(ws + B_VMT); bf16_t* VWT = (bf16_t*)(ws + B_VWT); const float* tw = (const float*)(ws + TAB_W);
        const int which = u.grp >> 2, h = u.grp & 3; const size_t cb = (size_t)u.pn * 256;
        if (which == 0) { bf16_t* base = KMT + (size_t)h * 256 * P + cb;
            pg8::for_each_piece(acc, u, wr, wc, fr, fq, [&](int row, int col, f32x4 v0, f32x4 v1) { *(u32x4*)(base + (size_t)row * P + col) = pg8::pack8(v0 * 0.0625f, v1 * 0.0625f); });
        } else { bf16_t* b0 = VMT + (size_t)h * 256 * P + cb; bf16_t* b1 = VWT + (size_t)h * 256 * P + cb; const float* w = tw + (size_t)h * P + cb;
            pg8::for_each_piece(acc, u, wr, wc, fr, fq, [&](int row, int col, f32x4 v0, f32x4 v1) { const f32x4 w0 = *(const f32x4*)(w + col), w1 = *(const f32x4*)(w + col + 4);
                *(u32x4*)(b0 + (size_t)row * P + col) = pg8::pack8(v0, v1); *(u32x4*)(b1 + (size_t)row * P + col) = pg8::pack8(v0 * w0, v1 * w1); }); } } };
struct EpiStoreW { bf16_t* C0; bf16_t* C1; size_t ldc; const float* w;
    __device__ __forceinline__ void operator()(int m, int n, f32x4 v) const { store4_bf16(C0 + (size_t)m * ldc + n, v); const f32x4 ww = *(const f32x4*)(w + n); store4_bf16(C1 + (size_t)m * ldc + n, v * ww); } };
__device__ __forceinline__ void phase_mqkv_f(const Params& p, char* lds, int bid, int nb) {
    const int tid = TIDX, wid = tid >> 6, gw = bid * NW + wid, ngw = nb * NW;
    const bf16_t* XC = (const bf16_t*)(p.ws + B_XC); const bf16_t* XM = (const bf16_t*)(p.ws + B_XM);
    const bf16_t* WQ = (const bf16_t*)(p.ws + W_Q_T); const bf16_t* WK = (const bf16_t*)(p.ws + W_K_T); const bf16_t* WV = (const bf16_t*)(p.ws + W_V_T);
    bf16_t* QM = (bf16_t*)(p.ws + B_QM); bf16_t* KM = (bf16_t*)(p.ws + B_KM); bf16_t* KMT = (bf16_t*)(p.ws + B_KMT); bf16_t* VMT = (bf16_t*)(p.ws + B_VMT); bf16_t* VWT = (bf16_t*)(p.ws + B_VWT);
    zero_block(KM, D, VALID0, D, bid * NT + tid, nb * NT);
    zero_block(VWT, P, D, VALID0, bid * NT + tid, nb * NT);
    zero_block(KMT, P, D, VALID0, bid * NT + tid, nb * NT);
    zero_block(VMT, P, D, VALID0, bid * NT + tid, nb * NT);
    for (int t = bid; t < 64; t += nb) {
        const int which = (t >> 4) & 1, h = (t >> 2) & 3, q = t & 3;
        if (t < 32) meta_gemm<1, 4>(RowsPlain{XC + h * 256, D}, RowsPlain{(which ? WK : WQ) + (size_t)h * 65536, 256}, 256, VALID0, q * 64, EpiStore{(which ? KM : QM) + h * 256, D, which ? 0.0625f : 1.f}, lds);
        else if (which == 0) meta_gemm<4, 1>(RowsPlain{WK + (size_t)h * 65536, 256}, RowsPlain{XC + h * 256, D}, 256, q * 64, VALID0, EpiStore{KMT + (size_t)h * 256 * P, P, 0.0625f}, lds);
        else meta_gemm<4, 1>(RowsPlain{WV + (size_t)h * 65536, 256}, RowsPlain{XM + h * 256, D}, 256, q * 64, VALID0, EpiStoreW{VMT + (size_t)h * 256 * P, VWT + (size_t)h * 256 * P, P, (const float*)(p.ws + TAB_W) + (size_t)h * P}, lds);
    }
    { SchedMqkvN S{(const char*)XC, (const char*)WQ, (const char*)WK, nb, bid, 256, D, 256};
      pg8::gemm_phase((PG8_LAS unsigned char*)lds, S, EpiGrpF{QM, KM, 256, D, 1.f, 0.0625f}); }
    { SchedMqkvT S{(const char*)XC, (const char*)XM, (const char*)WK, (const char*)WV, nb, bid, 256, 256, D};
      pg8::gemm_phase((PG8_LAS unsigned char*)lds, S, EpiMqkvT{p.ws}); }
}
struct SchedSq { const char* A; const char* B; int G, c; int K, lda, ldb;
    __device__ __forceinline__ bool next(int i, pg8::Unit& u) const { if (!pg8::decode_unit((long)i * G + c, 1, 64, 4, u)) return false; u.pm += 1; return true; }
    __device__ __forceinline__ const char* abase(const pg8::Unit& u) const { return A + (size_t)u.pm * 256 * D * 2; }
    __device__ __forceinline__ const char* bbase(const pg8::Unit& u) const { return B + (size_t)u.pn * 256 * D * 2; } };
struct EpiBr1F { float* MRG; const bf16_t* GA;
    __device__ __forceinline__ void operator()(const f32x4 (&acc)[2][2][4][2], const pg8::Unit& u, int wr, int wc, int fr, int fq) const {
        const int cb = u.pn * 256;
        pg8::for_each_piece(acc, u, wr, wc, fr, fq, [&](int row, int col, f32x4 v0, f32x4 v1) { const size_t idx = (size_t)row * D + cb + col;
            f32x4 g0, g1; pg8::unpack8(*(const u32x4*)(GA + idx), g0, g1);
            *(f32x4*)(MRG + idx) = v0 * sig4(g0); *(f32x4*)(MRG + idx + 4) = v1 * sig4(g1); }); } };
struct EpiBr2F { const float* MRG; const bf16_t* GB; bf16_t* OUT;
    __device__ __forceinline__ void operator()(const f32x4 (&acc)[2][2][4][2], const pg8::Unit& u, int wr, int wc, int fr, int fq) const {
        const int cb = u.pn * 256;
        pg8::for_each_piece(acc, u, wr, wc, fr, fq, [&](int row, int col, f32x4 v0, f32x4 v1) { const size_t idx = (size_t)row * D + cb + col;
            f32x4 g0, g1; pg8::unpack8(*(const u32x4*)(GB + idx), g0, g1);
            const f32x4 t0 = *(const f32x4*)(MRG + idx), t1 = *(const f32x4*)(MRG + idx + 4);
            *(u32x4*)(OUT + idx) = pg8::pack8(t0 + v0 * sig4(g0), t1 + v1 * sig4(g1)); }); } };
struct EpiOutF { float* Z; const bf16_t* H;
    __device__ __forceinline__ void operator()(const f32x4 (&acc)[2][2][4][2], const pg8::Unit& u, int wr, int wc, int fr, int fq) const {
        const int cb = u.pn * 256;
        pg8::for_each_piece(acc, u, wr, wc, fr, fq, [&](int row, int col, f32x4 v0, f32x4 v1) { const size_t idx = (size_t)row * D + cb + col;
            f32x4 h0, h1; pg8::unpack8(*(const u32x4*)(H + idx), h0, h1);
            *(f32x4*)(Z + idx) = v0 + h0 * DN_ALPHA; *(f32x4*)(Z + idx + 4) = v1 + h1 * DN_ALPHA; }); } };
__device__ __forceinline__ void phase_br1_f(const Params& p, char* lds, int bid, int nb) {
    const int gw = bid * NW + (TIDX >> 6), ngw = nb * NW;
    const bf16_t* A = (const bf16_t*)(p.ws + B_YM); const bf16_t* W = (const bf16_t*)(p.ws + W_BM_T);
    for (int t = bid; t < 16; t += nb) meta_gemm<1, 4>(RowsPlain{A, D}, RowsPlain{W, D}, D, VALID0, t * 64, EpiBr1{(float*)(p.ws + B_MRG), (const bf16_t*)(p.ws + B_GA)}, lds);
    SchedSq S{(const char*)A, (const char*)W, nb, bid, D, D, D};
    pg8::gemm_phase((PG8_LAS unsigned char*)lds, S, EpiBr1F{(float*)(p.ws + B_MRG), (const bf16_t*)(p.ws + B_GA)});
}
__device__ __forceinline__ void phase_br2_f(const Params& p, char* lds, int bid, int nb) {
    const int gw = bid * NW + (TIDX >> 6), ngw = nb * NW;
    const bf16_t* A = (const bf16_t*)(p.ws + B_YA); const bf16_t* W = (const bf16_t*)(p.ws + W_BA_T);
    for (int t = bid; t < 16; t += nb) meta_gemm<1, 4>(RowsPlain{A, D}, RowsPlain{W, D}, D, VALID0, t * 64, EpiBr2{(const float*)(p.ws + B_MRG), (const bf16_t*)(p.ws + B_GB), (bf16_t*)(p.ws + B_MRGB)}, lds);
    SchedSq S{(const char*)A, (const char*)W, nb, bid, D, D, D};
    pg8::gemm_phase((PG8_LAS unsigned char*)lds, S, EpiBr2F{(const float*)(p.ws + B_MRG), (const bf16_t*)(p.ws + B_GB), (bf16_t*)(p.ws + B_MRGB)});
}
__device__ __forceinline__ void phase_out_f(const Params& p, char* lds, int bid, int nb) {
    const int gw = bid * NW + (TIDX >> 6), ngw = nb * NW;
    const bf16_t* A = (const bf16_t*)(p.ws + B_MRGB); const bf16_t* W = (const bf16_t*)(p.ws + W_OUT_T);
    for (int t = bid; t < 16; t += nb) meta_gemm<1, 4>(RowsPlain{A, D}, RowsPlain{W, D}, D, VALID0, t * 64, EpiOut{(float*)(p.ws + B_Z), (const bf16_t*)(p.ws + B_H)}, lds);
    SchedSq S{(const char*)A, (const char*)W, nb, bid, D, D, D};
    pg8::gemm_phase((PG8_LAS unsigned char*)lds, S, EpiOutF{(float*)(p.ws + B_Z), (const bf16_t*)(p.ws + B_H)});
}

__device__ __forceinline__ void phase_ln1(const Params& p, int l, char* lds, int bid, int nb) {
    const int tid = TIDX, wid = tid >> 6, lane = tid & 63, gw = bid * NW + wid, ngw = nb * NW;
    float* wr = (float*)lds;
    for (int i = tid; i < D * 16 / 4; i += NT) ((f32x4*)wr)[i] = ((const f32x4*)p.in[I_WR])[i];
    unsigned* lcnt = (unsigned*)(lds + 65536); unsigned* lbase = lcnt + 16; int* lrow = (int*)(lds + 65536 + 256) + wid * 64;
    if (tid < 16) lcnt[tid] = 0u;
    __syncthreads();
    const float* Z = (const float*)(p.ws + B_Z); bf16_t* H1 = (bf16_t*)(p.ws + B_H1);
    unsigned* cnt = (unsigned*)(p.ws + WS_CTL) + CW_CNT + l * 16; float* topk = (float*)(p.ws + TAB_TOPK);
    int nrow = 0;
    for (int r = gw; r < P; r += ngw) {
        if (r < VALID0) { store_row_zero(H1 + (size_t)r * D, lane); continue; }
        f32x4 v[4];
#pragma unroll
        for (int j = 0; j < 4; ++j) v[j] = *(const f32x4*)(Z + (size_t)r * D + 4 * lane + 256 * j);
        ln_normalize(v, p.in[I_LN1G] + (size_t)l * D, p.in[I_LN1B] + (size_t)l * D, lane);
        store_row_bf16(H1 + (size_t)r * D, v, lane);
        float lg[16];
#pragma unroll
        for (int e = 0; e < 16; ++e) lg[e] = 0.f;
#pragma unroll
        for (int j = 0; j < 4; ++j)
#pragma unroll
            for (int i = 0; i < 4; ++i) { const int k = 4 * lane + 256 * j + i; const float x = v[j][i];
#pragma unroll
                for (int q = 0; q < 4; ++q) { const f32x4 w = *(const f32x4*)(wr + k * 16 + 4 * q); lg[4 * q] += x * w.x; lg[4 * q + 1] += x * w.y; lg[4 * q + 2] += x * w.z; lg[4 * q + 3] += x * w.w; } }
#pragma unroll
        for (int e = 0; e < 16; ++e) lg[e] = wave_sum(lg[e]);
        if (lane == 0) {
            float mx = lg[0];
#pragma unroll
            for (int e = 1; e < 16; ++e) mx = fmaxf(mx, lg[e]);
            float pr[16], sum = 0.f;
#pragma unroll
            for (int e = 0; e < 16; ++e) { pr[e] = expf(lg[e] - mx); sum += pr[e]; }
            const float isum = 1.f / sum;
            float sel[16];
#pragma unroll
            for (int e = 0; e < 16; ++e) { pr[e] *= isum; sel[e] = pr[e] + p.in[I_RB][e]; }
            int tg = 0; float best = -INFINITY;
#pragma unroll
            for (int gI = 0; gI < 4; ++gI) { const float gs = fmaxf(fmaxf(sel[4 * gI], sel[4 * gI + 1]), fmaxf(sel[4 * gI + 2], sel[4 * gI + 3])); if (gs > best) { best = gs; tg = gI; } }
            int i0 = 0; float b0 = -INFINITY;
#pragma unroll
            for (int e = 0; e < 16; ++e) if ((e >> 2) == tg && sel[e] > b0) { b0 = sel[e]; i0 = e; }
            int i1 = 0; float b1 = -INFINITY;
#pragma unroll
            for (int e = 0; e < 16; ++e) if ((e >> 2) == tg && e != i0 && sel[e] > b1) { b1 = sel[e]; i1 = e; }
            float p0 = 0.f, p1 = 0.f;
#pragma unroll
            for (int e = 0; e < 16; ++e) { if (e == i0) p0 = pr[e]; if (e == i1) p1 = pr[e]; }
            const float inv = 1.f / (p0 + p1);
            const unsigned pos0 = atomicAdd(lcnt + i0, 1u), pos1 = atomicAdd(lcnt + i1, 1u);
            lrow[nrow * 4] = i0; lrow[nrow * 4 + 1] = i1; lrow[nrow * 4 + 2] = (int)pos0; lrow[nrow * 4 + 3] = (int)pos1;
            float* tk = topk + (size_t)r * 8;
            ((int*)tk)[0] = i0; ((int*)tk)[1] = i1; tk[4] = p0 * inv; tk[5] = p1 * inv;
        }
        ++nrow;
    }
    __syncthreads();
    if (tid < 16) lbase[tid] = atomicAdd(cnt + tid, lcnt[tid]);
    __syncthreads();
    if (lane == 0) { int k = 0;
        for (int r = gw; r < P; r += ngw) { if (r < VALID0) continue;
            int* tk = (int*)(topk + (size_t)r * 8); tk[2] = (int)lbase[lrow[k * 4]] + lrow[k * 4 + 2]; tk[3] = (int)lbase[lrow[k * 4 + 1]] + lrow[k * 4 + 3]; ++k; } }
}

__device__ __forceinline__ void expert_offsets(const unsigned* cnt, int* s_cnt, int* s_off, int* s_tiles) {
    int off = 0;
    if (TIDX == 0) { int tt = 0; for (int e = 0; e < 16; ++e) { const int c = (int)cnt[e]; const int tl = (c + 255) >> 8; s_cnt[e] = c; s_off[e] = off; s_tiles[e] = tt; off += tl * 256; tt += tl; } s_tiles[16] = tt; }
    __syncthreads();
}
__device__ __forceinline__ void phase_perm(const Params& p, int l, char* lds, int bid, int nb) {
    int* s_cnt = (int*)(lds + LDS_TAB_OFF); int* s_off = s_cnt + 16; int* s_tiles = s_off + 16;
    expert_offsets((const unsigned*)(p.ws + WS_CTL) + CW_CNT + l * 16, s_cnt, s_off, s_tiles);
    const int tid = TIDX, wid = tid >> 6, lane = tid & 63, gw = bid * NW + wid, ngw = nb * NW;
    const bf16_t* H1 = (const bf16_t*)(p.ws + B_H1); bf16_t* XP = (bf16_t*)(p.ws + B_XP); const float* topk = (const float*)(p.ws + TAB_TOPK);
    for (int r = VALID0 + gw; r < P; r += ngw) {
        const int* tk = (const int*)(topk + (size_t)r * 8);
        const int e0 = tk[0], e1 = tk[1], p0 = tk[2], p1 = tk[3];
        const u32x4* src = (const u32x4*)(H1 + (size_t)r * D) + lane * 2;
        const u32x4 a = src[0], b = src[1];
        u32x4* d0 = (u32x4*)(XP + (size_t)(s_off[e0] + p0) * D) + lane * 2; u32x4* d1 = (u32x4*)(XP + (size_t)(s_off[e1] + p1) * D) + lane * 2;
        d0[0] = a; d0[1] = b; d1[0] = a; d1[1] = b;
    }
}
struct SchedMoE { const char* A; const char* B; size_t estride; int nN; const int* s_off; const int* s_tiles; int G, c; int K, lda, ldb;
    __device__ __forceinline__ bool next(int i, pg8::Unit& u) const {
        const int nwg = s_tiles[16] * nN; const long L = (long)i * G + c; if (L >= nwg) return false;
        int wgid = (int)L; { const int q = nwg / 8, r = nwg % 8, xcd = wgid % 8, off = wgid / 8; wgid = (xcd < r ? xcd * (q + 1) : r * (q + 1) + (xcd - r) * q) + off; }
        const int rt = wgid / nN; int e = 0;
        while (e < 15 && rt >= s_tiles[e + 1]) ++e;
        u.grp = __builtin_amdgcn_readfirstlane(e); u.pm = __builtin_amdgcn_readfirstlane((s_off[e] >> 8) + rt - s_tiles[e]); u.pn = __builtin_amdgcn_readfirstlane(wgid % nN); return true; }
    __device__ __forceinline__ const char* abase(const pg8::Unit& u) const { return A + (size_t)u.pm * 256 * D * 2; }
    __device__ __forceinline__ const char* bbase(const pg8::Unit& u) const { return B + (size_t)u.grp * estride + (size_t)u.pn * 256 * D * 2; } };
struct EpiE1F { bf16_t* HID;
    __device__ __forceinline__ void operator()(const f32x4 (&acc)[2][2][4][2], const pg8::Unit& u, int wr, int wc, int fr, int fq) const {
        asm volatile("" : "+v"(fr), "+v"(fq));
        const int row0 = u.pm * 256 + wr * 64 + fr, col0 = u.pn * 128 + wc * 32 + 8 * fq;
#pragma unroll
        for (int ai = 0; ai < 2; ++ai)
#pragma unroll
            for (int m = 0; m < 4; ++m) { f32x4 h0, h1;
#pragma unroll
                for (int r = 0; r < 4; ++r) { h0[r] = siluf_(acc[ai][0][m][0][r]) * acc[ai][1][m][0][r]; h1[r] = siluf_(acc[ai][0][m][1][r]) * acc[ai][1][m][1][r]; }
                *(u32x4*)(HID + (size_t)(row0 + ai * 128 + m * 16) * D + col0) = pg8::pack8(h0, h1); } } };
struct EpiE2F { bf16_t* YB;
    __device__ __forceinline__ void operator()(const f32x4 (&acc)[2][2][4][2], const pg8::Unit& u, int wr, int wc, int fr, int fq) const {
        bf16_t* base = YB + u.pn * 256;
        pg8::for_each_piece(acc, u, wr, wc, fr, fq, [&](int row, int col, f32x4 v0, f32x4 v1) { *(u32x4*)(base + (size_t)row * D + col) = pg8::pack8(v0, v1); }); } };
__device__ __forceinline__ void phase_e1_f(const Params& p, int l, char* lds, int bid, int nb) {
    int* s_cnt = (int*)(lds + LDS_TAB_OFF); int* s_off = s_cnt + 16; int* s_tiles = s_off + 16;
    expert_offsets((const unsigned*)(p.ws + WS_CTL) + CW_CNT + l * 16, s_cnt, s_off, s_tiles);
    SchedMoE S{(const char*)(p.ws + B_XP), (const char*)(p.ws + W_G_T), (size_t)2048 * D * 2, 8, s_off, s_tiles, nb, bid, D, D, D};
    pg8::gemm_phase((PG8_LAS unsigned char*)lds, S, EpiE1F{(bf16_t*)(p.ws + B_HID)});
}
__device__ __forceinline__ void phase_e2_f(const Params& p, int l, char* lds, int bid, int nb) {
    int* s_cnt = (int*)(lds + LDS_TAB_OFF); int* s_off = s_cnt + 16; int* s_tiles = s_off + 16;
    expert_offsets((const unsigned*)(p.ws + WS_CTL) + CW_CNT + l * 16, s_cnt, s_off, s_tiles);
    SchedMoE S{(const char*)(p.ws + B_HID), (const char*)(p.ws + W_D_T), (size_t)D * D * 2, 4, s_off, s_tiles, nb, bid, D, D, D};
    pg8::gemm_phase((PG8_LAS unsigned char*)lds, S, EpiE2F{(bf16_t*)(p.ws + B_YB)});
}

__device__ __forceinline__ void phase_combine(const Params& p, int l, char* lds, int bid, int nb) {
    const int tid = TIDX, wid = tid >> 6, lane = tid & 63, gw = bid * NW + wid, ngw = nb * NW;
    const bool last = (l == DEPTH - 1);
    if (!last) { convert_weights(p, l + 1, lds, gw, ngw, wid, lane); __syncthreads(); }
    int* s_cnt = (int*)(lds + 65536); int* s_off = s_cnt + 16; int* s_tiles = s_off + 16;
    expert_offsets((const unsigned*)(p.ws + WS_CTL) + CW_CNT + l * 16, s_cnt, s_off, s_tiles);
    float* g8 = (float*)lds;
    if (!last) load_gate_w(p, l + 1, g8);
    const bf16_t* H1 = (const bf16_t*)(p.ws + B_H1); const bf16_t* YB = (const bf16_t*)(p.ws + B_YB); bf16_t* H = (bf16_t*)(p.ws + B_H);
    const float* topk = (const float*)(p.ws + TAB_TOPK);
    for (int r = gw; r < P; r += ngw) {
        if (r < VALID0) { if (!last) { store_row_zero(H + (size_t)r * D, lane); gates_row_pad(p, r, lane); } continue; }
        if (last && r < 256) continue;
        const float* tk = topk + (size_t)r * 8;
        const int e0 = ((const int*)tk)[0], e1 = ((const int*)tk)[1], p0 = ((const int*)tk)[2], p1 = ((const int*)tk)[3]; const float w0 = tk[4], w1 = tk[5];
        const bf16_t* y0 = YB + (size_t)(s_off[e0] + p0) * D; const bf16_t* y1 = YB + (size_t)(s_off[e1] + p1) * D; const bf16_t* hr = H1 + (size_t)r * D;
        f32x4 v[4];
#pragma unroll
        for (int j = 0; j < 4; ++j) { const int cc = 4 * lane + 256 * j; const u32x2 a = *(const u32x2*)(y0 + cc), b = *(const u32x2*)(y1 + cc), hh = *(const u32x2*)(hr + cc);
            v[j].x = DN_ALPHA * bf2f(hh.x & 0xffffu) + w0 * bf2f(a.x & 0xffffu) + w1 * bf2f(b.x & 0xffffu);
            v[j].y = DN_ALPHA * bf2f(hh.x >> 16) + w0 * bf2f(a.x >> 16) + w1 * bf2f(b.x >> 16);
            v[j].z = DN_ALPHA * bf2f(hh.y & 0xffffu) + w0 * bf2f(a.y & 0xffffu) + w1 * bf2f(b.y & 0xffffu);
            v[j].w = DN_ALPHA * bf2f(hh.y >> 16) + w0 * bf2f(a.y >> 16) + w1 * bf2f(b.y >> 16); }
        ln_normalize(v, p.in[I_LN2G] + (size_t)l * D, p.in[I_LN2B] + (size_t)l * D, lane);
        if (last) {
            float* o = p.out + (size_t)(r - 256) * D;
#pragma unroll
            for (int j = 0; j < 4; ++j) *(f32x4*)(o + 4 * lane + 256 * j) = v[j];
        } else { store_row_bf16(H + (size_t)r * D, v, lane); gates_row(p, l + 1, g8, v, r, lane); }
    }
}

#define XB_TMO      128
#define XB_XCNT(j)  (256  + 64 * (j))
#define XB_XSUB(j)  (1280 + 64 * (j))
#define XB_XGEN(j)  (2304 + 64 * (j))
#define XB_TOP      3328
#define XB_TOPGEN   3392
#define XCD_BAR_WORDS 3456
#define XB_SPIN_CAP (1u << 18)
#define LAS __attribute__((address_space(3)))

__device__ __forceinline__ unsigned xb_ld(unsigned* p)              { return __hip_atomic_load(p, __ATOMIC_RELAXED, __HIP_MEMORY_SCOPE_AGENT); }
__device__ __forceinline__ unsigned xb_add(unsigned* p, unsigned v) { return __hip_atomic_fetch_add(p, v, __ATOMIC_RELAXED, __HIP_MEMORY_SCOPE_AGENT); }
__device__ __forceinline__ unsigned xb_xcc_id() { return (unsigned)__builtin_amdgcn_s_getreg((3 << 11) | 20) & 0xFu; }
#define XB_SPIN(cond, bar) do { unsigned _sp = 0; while (cond) { __builtin_amdgcn_s_sleep(1); \
    if ((++_sp & 255u) == 0u) { if (xb_ld(&(bar)[XB_TMO])) break; if (_sp > XB_SPIN_CAP) { atomicAdd(&(bar)[XB_TMO], 1u); break; } } } } while (0)

struct XcdBarrier {
    unsigned* bar; unsigned x;
    volatile LAS unsigned* st;
};
__device__ __forceinline__ XcdBarrier xcd_barrier_post(unsigned* bar, volatile LAS unsigned* st) {
    XcdBarrier b; b.bar = bar; b.x = xb_xcc_id(); b.st = st;
    if (threadIdx.x == 0) (void)xb_add(&bar[XB_XCNT(b.x)], 1u);
    return b;
}
__device__ __forceinline__ void xcd_barrier_complete(unsigned* bar, unsigned x, unsigned& nloc, unsigned& nx) {
    const unsigned G = gridDim.x * gridDim.y * gridDim.z;
    unsigned sum, cnt, mine, sp = 0u;
    for (;;) {
        sum = 0u; cnt = 0u; mine = 0u;
#pragma unroll
        for (unsigned j = 0; j < 16; ++j) { const unsigned c = xb_ld(&bar[XB_XCNT(j)]); sum += c; cnt += (c > 0u) ? 1u : 0u; mine = (j == x) ? c : mine; }
        if (sum == G) break;
        __builtin_amdgcn_s_sleep(1);
        if ((++sp & 255u) == 0u) { if (xb_ld(&bar[XB_TMO])) break; if (sp > XB_SPIN_CAP) { atomicAdd(&bar[XB_TMO], 1u); break; } }
    }
    nloc = mine > 0u ? mine : 1u; nx = cnt > 0u ? cnt : 1u;
}
__device__ __forceinline__ void xcd_barrier(const XcdBarrier& b) {
    asm volatile("s_waitcnt vmcnt(0)" ::: "memory");
    __syncthreads();
    if (threadIdx.x == 0) {
        unsigned* bar = b.bar;
        __builtin_amdgcn_s_waitcnt(0);
        unsigned nloc = b.st[0], nx = b.st[1];
        if (nloc == 0u) { xcd_barrier_complete(bar, b.x, nloc, nx); b.st[0] = nloc; b.st[1] = nx; }
        const unsigned old = xb_add(&bar[XB_XSUB(b.x)], 1u);
        const unsigned gen = old / nloc;
        if (old + 1u == (gen + 1u) * nloc) {
            __builtin_amdgcn_fence(__ATOMIC_RELEASE, "agent");
            asm volatile("s_waitcnt vmcnt(0)" ::: "memory");
            const unsigned og = xb_add(&bar[XB_TOP], 1u);
            const unsigned tg = og / nx;
            if (og + 1u == (tg + 1u) * nx) xb_add(&bar[XB_TOPGEN], 1u);
            else XB_SPIN(xb_ld(&bar[XB_TOPGEN]) == tg, bar);
            __builtin_amdgcn_fence(__ATOMIC_ACQUIRE, "agent");
            xb_add(&bar[XB_XGEN(b.x)], 1u);
            asm volatile("s_waitcnt vmcnt(0)" ::: "memory");
        } else {
            XB_SPIN(xb_ld(&bar[XB_XGEN(b.x)]) == gen, bar);
            __builtin_amdgcn_fence(__ATOMIC_ACQUIRE, "agent");
            asm volatile("s_waitcnt vmcnt(0)" ::: "memory");
        }
    }
    __syncthreads();
}

constexpr int LDS_BYTES = 131072 + 12288;
constexpr int LDS_BAR_OFF = LDS_BYTES - 16;
constexpr int CW_BAR = 4096;
template <int L>
__device__ __forceinline__ void layer_body(const Params& p, char* lds, int bid, int nb, const XcdBarrier& bar) {
    phase_proj_f(p, lds, bid, nb); xcd_barrier(bar);
    phase_attn_f(p, L, lds, bid, nb); xcd_barrier(bar);
    phase_conv(p, L, lds, bid, nb); xcd_barrier(bar);
    phase_mqkv_f(p, lds, bid, nb); xcd_barrier(bar);
    phase_ms(p, lds, bid, nb); phase_sg(p, lds, bid, nb); xcd_barrier(bar);
    phase_m2(p, lds, bid, nb); xcd_barrier(bar);
    phase_o1(p, lds, bid, nb); xcd_barrier(bar);
    phase_o2(p, L, lds, bid, nb); xcd_barrier(bar);
    phase_br1_f(p, lds, bid, nb); xcd_barrier(bar);
    phase_br2_f(p, lds, bid, nb); xcd_barrier(bar);
    phase_out_f(p, lds, bid, nb); xcd_barrier(bar);
    phase_ln1(p, L, lds, bid, nb); xcd_barrier(bar);
    phase_perm(p, L, lds, bid, nb); xcd_barrier(bar);
    phase_e1_f(p, L, lds, bid, nb); xcd_barrier(bar);
    phase_e2_f(p, L, lds, bid, nb); xcd_barrier(bar);
    phase_combine(p, L, lds, bid, nb); if (L + 1 < DEPTH) xcd_barrier(bar);
}
__global__ void __launch_bounds__(NT, 2) fwd_kernel(Params p) {
    extern __shared__ __attribute__((aligned(16))) char lds[];
    const int bid = blockIdx.x, nb = gridDim.x;
    if (threadIdx.x == 0) *(uint4*)(lds + LDS_BAR_OFF) = make_uint4(0u, 0u, 0u, 0u);
    __syncthreads();
    XcdBarrier bar = xcd_barrier_post((unsigned*)(p.ws + WS_CTL) + CW_BAR, (volatile LAS unsigned*)(lds + LDS_BAR_OFF));
    phase_prologue(p, lds, bid, nb); xcd_barrier(bar);
    layer_body<0>(p, lds, bid, nb, bar);
    layer_body<1>(p, lds, bid, nb, bar);
}

extern "C" void kernel_launch(void* const* d_in, const int* in_sizes, int n_in, void* d_out, int out_size, void* d_ws, size_t ws_size, hipStream_t stream) {
    if (n_in != 30 || ws_size < WS_END) { fprintf(stderr, "kernel_launch: unexpected n_in %d or ws_size %zu (< %zu)\n", n_in, ws_size, (size_t)WS_END); return; }
    static int grid = 0;
    if (grid == 0) {
        int dev = 0, cus = 0;
        if (hipGetDevice(&dev) != hipSuccess || hipDeviceGetAttribute(&cus, hipDeviceAttributeMultiprocessorCount, dev) != hipSuccess || cus <= 0) cus = 256;
        (void)hipFuncSetAttribute((const void*)fwd_kernel, hipFuncAttributeMaxDynamicSharedMemorySize, LDS_BYTES);
        grid = cus;
    }
    Params p{};
    for (int i = 0; i < 30; ++i) p.in[i] = (const float*)d_in[i];
    p.out = (float*)d_out; p.ws = (unsigned char*)d_ws;
    (void)hipMemsetAsync((char*)d_ws + WS_CTL, 0, CTL_BYTES, stream);
    hipLaunchKernelGGL(fwd_kernel, dim3(grid), dim3(NT), LDS_BYTES, stream, p);
}
```

```cpp
#include <hip/hip_runtime.h>
#include <cstdio>
#include <cstdint>

constexpr int D = 1024;
constexpr int SEQ = 16384;
constexpr int NMETA = 16;
constexpr int P = 16640;
constexpr int VALID0 = 240;
constexpr int DEPTH = 2;
constexpr int DIN = 7176;
constexpr int NSC = 65;
constexpr int NEXP = 16;
constexpr float LN_EPS = 1e-5f;
constexpr float DN_ALPHA = 1.4142135623730951f;
constexpr float NEGBIG = -1e30f;
constexpr int NT = 512;
constexpr int NW = 8;

typedef unsigned short bf16_t;
typedef short bf16x8 __attribute__((ext_vector_type(8)));
typedef float f32x4 __attribute__((ext_vector_type(4)));
typedef unsigned u32x4 __attribute__((ext_vector_type(4)));
typedef unsigned u32x2 __attribute__((ext_vector_type(2)));

constexpr size_t MiB = 1u << 20;
constexpr size_t RB = (size_t)P * D * 2;
constexpr size_t WS_CTL = 0;
constexpr size_t CTL_BYTES = 1 * MiB;
constexpr size_t WS_TAB = 1 * MiB;
constexpr size_t TAB_GLI = WS_TAB;
constexpr size_t TAB_GLF = TAB_GLI + 4 * P * 4;
constexpr size_t TAB_B   = TAB_GLF + 4 * P * 4;
constexpr size_t TAB_E   = TAB_B + 4 * P * 4;
constexpr size_t TAB_PM  = TAB_E + 4 * P * 4;
constexpr size_t TAB_W   = TAB_PM + 4 * P * 4;
constexpr size_t TAB_SCG = TAB_W + 4 * P * 4;
constexpr size_t TAB_SCM = TAB_SCG + 4096;
constexpr size_t TAB_MT  = TAB_SCM + 4096;
constexpr size_t TAB_NT  = TAB_MT + 4096;
constexpr size_t TAB_TOPK = TAB_NT + (size_t)NSC * 4 * 256 * 4;
constexpr size_t TAB_ELIST = TAB_TOPK + (size_t)P * 32;
constexpr size_t TAB_DENP = TAB_ELIST + (size_t)NEXP * P * 4;
constexpr size_t TAB_DENI = TAB_DENP + (size_t)P * 16 * 4;
constexpr size_t TAB_END = TAB_DENI + (size_t)P * 4 * 4;
static_assert(TAB_END <= 8 * MiB, "tables");
constexpr size_t WS_W = 8 * MiB;
constexpr size_t W_IN_T = WS_W;
constexpr size_t W_Q_T = W_IN_T + (size_t)7168 * 1024 * 2;
constexpr size_t W_K_T = W_Q_T + 4 * 65536 * 2;
constexpr size_t W_V_T = W_K_T + 4 * 65536 * 2;
constexpr size_t W_BM_T = W_V_T + 4 * 65536 * 2;
constexpr size_t W_BA_T = W_BM_T + (size_t)D * D * 2;
constexpr size_t W_OUT_T = W_BA_T + (size_t)D * D * 2;
constexpr size_t W_G_T = W_OUT_T + (size_t)D * D * 2;
constexpr size_t W_U_T = W_G_T + (size_t)NEXP * D * D * 2;
constexpr size_t W_D_T = W_U_T + (size_t)NEXP * D * D * 2;
constexpr size_t W_END = W_D_T + (size_t)NEXP * D * D * 2;
static_assert(W_END <= 128 * MiB, "weights");
constexpr size_t WS_SLOT = 128 * MiB;
constexpr size_t SLOT(int i) { return WS_SLOT + (size_t)i * RB; }
constexpr size_t WS_END = WS_SLOT + 12 * RB;
constexpr size_t B_H = SLOT(0);
constexpr size_t B_XM = SLOT(1), B_PM = SLOT(1);
constexpr size_t B_OP = SLOT(2), B_MRGB = SLOT(2);
constexpr size_t B_QA = SLOT(3), B_QM = SLOT(3), B_MRG = SLOT(3);
constexpr size_t B_KA = SLOT(4), B_XC = SLOT(4), B_CT = SLOT(4);
constexpr size_t B_KM = SLOT(5), B_OI = SLOT(5), B_H1 = SLOT(5);
constexpr size_t B_GA = SLOT(6);
constexpr size_t B_GB = SLOT(7);
constexpr size_t B_YA = SLOT(8);
constexpr size_t B_KMT = SLOT(9), B_YM = SLOT(9);
constexpr size_t B_VA = SLOT(10), B_VMT = SLOT(10);
constexpr size_t B_VWT = SLOT(11);
constexpr size_t B_Z = SLOT(10);
constexpr size_t B_HID = SLOT(6);
constexpr size_t B_XP = SLOT(1);
constexpr size_t B_YB = SLOT(9);
constexpr int HID_ROWS_MAX = (int)(3 * RB / (D * 2));
constexpr int CW_CNT = 64;

struct Params {
    const float* in[30];
    float* out;
    unsigned char* ws;
};
enum { I_X = 0, I_META, I_LNG, I_LNB, I_WIN, I_CONVW, I_CONVB, I_WQM, I_WKM, I_WVM, I_BI, I_BF, I_MNG, I_LQ1, I_LK1, I_LQ2, I_LK2, I_ANG,
       I_WBM, I_WBA, I_WOUT, I_LN1G, I_LN1B, I_LN2G, I_LN2B, I_WR, I_RB, I_WG, I_WU, I_WD };

__device__ __forceinline__ int tid_opaque() { int t = threadIdx.x; asm volatile("" : "+v"(t)); return t; }
#define TIDX tid_opaque()
__device__ __forceinline__ float bf2f(unsigned v) { return __uint_as_float(v << 16); }
__device__ __forceinline__ unsigned f2bf(float f) { unsigned u = __float_as_uint(f); return (u + 0x7fffu + ((u >> 16) & 1u)) >> 16; }
__device__ __forceinline__ unsigned pk2(float lo, float hi) { return f2bf(lo) | (f2bf(hi) << 16); }
template <int M> __device__ __forceinline__ float sx(float v) {
    static_assert(M == 1 || M == 2 || M == 4 || M == 8 || M == 16, "sx: xor mask within 32 lanes");
    return __int_as_float(__builtin_amdgcn_ds_swizzle(__float_as_int(v), 0x1f | (M << 10)));
}
__device__ __forceinline__ float sum32(float v) {
    auto rr = __builtin_amdgcn_permlane32_swap(__float_as_uint(v), __float_as_uint(v), false, false);
    return __uint_as_float(rr[0]) + __uint_as_float(rr[1]);
}
__device__ __forceinline__ float wave_sum(float v) {
    v += sx<1>(v); v += sx<2>(v); v += sx<4>(v); v += sx<8>(v); v += sx<16>(v); v = sum32(v);
    return v;
}
__device__ __forceinline__ float sigmoidf_(float x) { return 1.f / (1.f + __expf(-x)); }
__device__ __forceinline__ float siluf_(float x) { return x / (1.f + __expf(-x)); }
__device__ __forceinline__ float logsigmoidf_(float x) { return x >= 0.f ? -log1pf(__expf(-x)) : x - log1pf(__expf(x)); }
__device__ __forceinline__ f32x4 sig4(f32x4 v) { f32x4 o; o.x = sigmoidf_(v.x); o.y = sigmoidf_(v.y); o.z = sigmoidf_(v.z); o.w = sigmoidf_(v.w); return o; }
__device__ __forceinline__ f32x4 mfma16(bf16x8 a, bf16x8 b, f32x4 c) { return __builtin_amdgcn_mfma_f32_16x16x32_bf16(a, b, c, 0, 0, 0); }
__device__ __forceinline__ bf16x8 ld8(const bf16_t* p) { return *(const bf16x8*)p; }

__device__ __forceinline__ void transpose_item(const float* W, int K, size_t ldsrc, int k0, int n_src0, bf16_t* WT, int dst_row0, float* scr, int lane) {
#pragma unroll 8
    for (int i = 0; i < 32; ++i) { const int kk = 2 * i + (lane >> 5); scr[kk * 33 + (lane & 31)] = W[(size_t)(k0 + kk) * ldsrc + n_src0 + (lane & 31)]; }
    __builtin_amdgcn_wave_barrier();
    asm volatile("s_waitcnt lgkmcnt(0)" ::: "memory");
    const int c = lane & 7;
#pragma unroll
    for (int j = 0; j < 4; ++j) { const int n = (lane >> 3) + 8 * j; const float* s = scr + (8 * c) * 33 + n;
        u32x4 o; o.x = pk2(s[0 * 33], s[1 * 33]); o.y = pk2(s[2 * 33], s[3 * 33]); o.z = pk2(s[4 * 33], s[5 * 33]); o.w = pk2(s[6 * 33], s[7 * 33]);
        *(u32x4*)(WT + (size_t)(dst_row0 + n) * K + k0 + 8 * c) = o; }
    asm volatile("s_waitcnt lgkmcnt(0)" ::: "memory");
    __builtin_amdgcn_wave_barrier();
}
__device__ __forceinline__ void convert_weights(const Params& p, int l, char* lds, int gw, int ngw, int wid, int lane) {
    float* scr = (float*)lds + wid * (64 * 33);
    unsigned char* ws = p.ws;
    constexpr int I_IN = 16 * 224, I_QKV = 3 * 4 * 4 * 8, I_SQ = 16 * 32, I_EXP = 3 * 16 * 512;
    constexpr int TOTAL = I_IN + I_QKV + 3 * I_SQ + I_EXP;
    for (int it = gw; it < TOTAL; it += ngw) {
        int r = it;
        if (r < I_IN) { const int kb = r / 224, nb = r % 224, r0 = nb * 32, nsrc = r0 < 2048 ? r0 : r0 + 8;
            transpose_item(p.in[I_WIN] + (size_t)l * D * DIN, D, DIN, kb * 64, nsrc, (bf16_t*)(ws + W_IN_T), r0, scr, lane); continue; }
        r -= I_IN;
        if (r < I_QKV) { const int w = r / 128, rr = r % 128, h = rr / 32, t = rr % 32, kb = t / 8, nb = t % 8;
            const float* src = p.in[w == 0 ? I_WQM : (w == 1 ? I_WKM : I_WVM)] + ((size_t)l * 4 + h) * 65536;
            bf16_t* dst = (bf16_t*)(ws + (w == 0 ? W_Q_T : (w == 1 ? W_K_T : W_V_T))) + (size_t)h * 65536;
            transpose_item(src, 256, 256, kb * 64, nb * 32, dst, nb * 32, scr, lane); continue; }
        r -= I_QKV;
        if (r < 3 * I_SQ) { const int w = r / I_SQ, t = r % I_SQ, kb = t / 32, nb = t % 32;
            const float* src = p.in[w == 0 ? I_WBM : (w == 1 ? I_WBA : I_WOUT)] + (size_t)l * D * D;
            bf16_t* dst = (bf16_t*)(ws + (w == 0 ? W_BM_T : (w == 1 ? W_BA_T : W_OUT_T)));
            transpose_item(src, D, D, kb * 64, nb * 32, dst, nb * 32, scr, lane); continue; }
        r -= 3 * I_SQ;
        { const int w = r / (16 * 512), rr = r % (16 * 512), e = rr / 512, t = rr % 512, kb = t / 32, nb = t % 32;
            const float* src = p.in[w == 0 ? I_WG : (w == 1 ? I_WU : I_WD)] + ((size_t)l * NEXP + e) * D * D;
            if (w == 2) transpose_item(src, D, D, kb * 64, nb * 32, (bf16_t*)(ws + W_D_T) + (size_t)e * D * D, nb * 32, scr, lane);
            else { const int j0 = nb * 32; transpose_item(src, D, D, kb * 64, j0, (bf16_t*)(ws + W_G_T) + (size_t)e * 2048 * D, 256 * (j0 >> 7) + (j0 & 127) + (w == 1 ? 128 : 0), scr, lane); } }
    }
}

__device__ __forceinline__ void ln_normalize(f32x4 (&v)[4], const float* g, const float* b, int lane) {
    float s = 0.f;
#pragma unroll
    for (int j = 0; j < 4; ++j) s += (v[j].x + v[j].y) + (v[j].z + v[j].w);
    const float mean = wave_sum(s) * (1.f / D);
    float s2 = 0.f;
#pragma unroll
    for (int j = 0; j < 4; ++j) { v[j] = v[j] - mean; s2 += (v[j].x * v[j].x + v[j].y * v[j].y) + (v[j].z * v[j].z + v[j].w * v[j].w); }
    const float rstd = rsqrtf(wave_sum(s2) * (1.f / D) + LN_EPS);
#pragma unroll
    for (int j = 0; j < 4; ++j) { const f32x4 gg = *(const f32x4*)(g + 4 * lane + 256 * j), bb = *(const f32x4*)(b + 4 * lane + 256 * j); v[j] = v[j] * rstd * gg + bb; }
}
__device__ __forceinline__ void store_row_bf16(bf16_t* row, const f32x4 (&v)[4], int lane) {
#pragma unroll
    for (int j = 0; j < 4; ++j) { u32x2 o; o.x = pk2(v[j].x, v[j].y); o.y = pk2(v[j].z, v[j].w); *(u32x2*)(row + 4 * lane + 256 * j) = o; }
}
__device__ __forceinline__ void store_row_zero(bf16_t* row, int lane) {
#pragma unroll
    for (int j = 0; j < 4; ++j) { u32x2 o; o.x = 0u; o.y = 0u; *(u32x2*)(row + 4 * lane + 256 * j) = o; }
}
__device__ __forceinline__ void load_gate_w(const Params& p, int l, float* g8) {
    const float* w = p.in[I_WIN] + (size_t)l * D * DIN + 2048;
    for (int i = TIDX; i < D * 8; i += NT) { const int k = i >> 3, c = i & 7; g8[i] = w[(size_t)k * DIN + c]; }
    __syncthreads();
}
__device__ __forceinline__ void gates_row(const Params& p, int l, const float* g8, const f32x4 (&v)[4], int prow, int lane) {
    float acc[8];
#pragma unroll
    for (int c = 0; c < 8; ++c) acc[c] = 0.f;
#pragma unroll
    for (int j = 0; j < 4; ++j)
#pragma unroll
        for (int i = 0; i < 4; ++i) { const int k = 4 * lane + 256 * j + i; const float x = v[j][i];
            const f32x4 w0 = *(const f32x4*)(g8 + k * 8), w1 = *(const f32x4*)(g8 + k * 8 + 4);
            acc[0] += x * w0.x; acc[1] += x * w0.y; acc[2] += x * w0.z; acc[3] += x * w0.w; acc[4] += x * w1.x; acc[5] += x * w1.y; acc[6] += x * w1.z; acc[7] += x * w1.w; }
#pragma unroll
    for (int c = 0; c < 8; ++c) acc[c] = wave_sum(acc[c]);
    if (lane < 4) {
        float* gli = (float*)(p.ws + TAB_GLI); float* glf = (float*)(p.ws + TAB_GLF);
        const float bi = p.in[I_BI][l * 4 + lane], bfv = p.in[I_BF][l * 4 + lane];
        float ai = acc[0], af = acc[4];
        if (lane == 1) { ai = acc[1]; af = acc[5]; } else if (lane == 2) { ai = acc[2]; af = acc[6]; } else if (lane == 3) { ai = acc[3]; af = acc[7]; }
        gli[(size_t)lane * P + prow] = ai + bi;
        glf[(size_t)lane * P + prow] = logsigmoidf_(af + bfv);
    }
}
__device__ __forceinline__ void gates_row_pad(const Params& p, int prow, int lane) {
    if (lane < 4) { ((float*)(p.ws + TAB_GLI))[(size_t)lane * P + prow] = NEGBIG; ((float*)(p.ws + TAB_GLF))[(size_t)lane * P + prow] = 0.f; }
}

__device__ __forceinline__ void phase_prologue(const Params& p, char* lds, int bid, int nb) {
    const int tid = TIDX, wid = tid >> 6, lane = tid & 63, gw = bid * NW + wid, ngw = nb * NW;
    convert_weights(p, 0, lds, gw, ngw, wid, lane);
    __syncthreads();
    float* g8 = (float*)lds;
    load_gate_w(p, 0, g8);
    bf16_t* H = (bf16_t*)(p.ws + B_H);
    f32x4 vn[4];
#pragma unroll
    for (int j = 0; j < 4; ++j) vn[j] = (f32x4){0.f, 0.f, 0.f, 0.f};
#define PRO_SRC(r_) ((r_) < 256 ? p.in[I_META] + (size_t)((r_) - VALID0) * D : p.in[I_X] + (size_t)((r_) - 256) * D)
    if (gw >= VALID0 && gw < P) {
#pragma unroll
        for (int j = 0; j < 4; ++j) vn[j] = *(const f32x4*)(PRO_SRC(gw) + 4 * lane + 256 * j); }
    for (int r = gw; r < P; r += ngw) {
        f32x4 v[4];
#pragma unroll
        for (int j = 0; j < 4; ++j) v[j] = vn[j];
        { const int rn = r + ngw; if (rn >= VALID0 && rn < P) {
#pragma unroll
            for (int j = 0; j < 4; ++j) vn[j] = *(const f32x4*)(PRO_SRC(rn) + 4 * lane + 256 * j); } }
        if (r < VALID0) { store_row_zero(H + (size_t)r * D, lane); gates_row_pad(p, r, lane); continue; }
        ln_normalize(v, p.in[I_LNG], p.in[I_LNB], lane);
        store_row_bf16(H + (size_t)r * D, v, lane);
        gates_row(p, 0, g8, v, r, lane);
    }
}

struct RowsPlain { const bf16_t* base; size_t ld; __device__ __forceinline__ const bf16_t* row(int m) const { return base + (size_t)m * ld; } };
__device__ __forceinline__ void store4_bf16(bf16_t* dst, f32x4 v) { u32x2 o; o.x = pk2(v.x, v.y); o.y = pk2(v.z, v.w); *(u32x2*)dst = o; }

struct EpiProj { unsigned char* ws;
    __device__ __forceinline__ void operator()(int m, int n, f32x4 v) const {
        const int seg = n >> 10, cc = n & 1023;
        const size_t off = seg == 0 ? B_XM : seg == 1 ? B_OP : seg == 2 ? B_QA : seg == 3 ? B_KA : seg == 4 ? B_VA : seg == 5 ? B_GA : B_GB;
        store4_bf16((bf16_t*)(ws + off) + (size_t)m * D + cc, v); } };
struct EpiStore { bf16_t* C; size_t ldc; float scale;
    __device__ __forceinline__ void operator()(int m, int n, f32x4 v) const { store4_bf16(C + (size_t)m * ldc + n, v * scale); } };
namespace pg8 {
#define PG8_LAS __attribute__((address_space(3)))
constexpr int BM = 256, BK = 64, HALF = 128, HTB = HALF * BK * 2, STAGE_BYTES = 8 * HTB, NXCD = 8, WGM = 8;
__host__ __device__ __forceinline__ int lds_byte(int r, int c) { const int st = (r >> 4) * 2 + (c >> 5), rr = r & 15, cc = c & 31, ob = rr * 64 + cc * 2; return st * 1024 + (ob ^ (((ob >> 9) & 1) << 5)); }
__host__ __device__ __forceinline__ void stage_rc(int b, int& R, int& C) { const int st = b / 1024, sb = b % 1024, swz = sb ^ (((sb >> 9) & 1) << 5); R = (st >> 1) * 16 + swz / 64; C = (st & 1) * 32 + (swz % 64) / 2; }
__host__ __device__ __forceinline__ int perm32(int rho) { const int n = rho >> 4, i = rho & 15; return 8 * (i >> 2) + 4 * n + (i & 3); }
struct Unit { int pm, pn, grp; };
__device__ __forceinline__ bool decode_unit(long L, int nG, int nM, int nN, Unit& u) {
    const int nwg = nG * nM * nN; if (L >= nwg) return false;
    int wgid = (int)L; { const int q = nwg / NXCD, r = nwg % NXCD, xcd = wgid % NXCD, off = wgid / NXCD; wgid = (xcd < r ? xcd * (q + 1) : r * (q + 1) + (xcd - r) * q) + off; }
    const int per = nM * nN; u.grp = wgid / per; const int rem = wgid % per;
    const int nig = WGM * nN, gid = rem / nig, fm = gid * WGM, gsz = (nM - fm) < WGM ? (nM - fm) : WGM;
    u.pm = __builtin_amdgcn_readfirstlane(fm + ((rem % nig) % gsz)); u.pn = __builtin_amdgcn_readfirstlane((rem % nig) / gsz); u.grp = __builtin_amdgcn_readfirstlane(u.grp); return true;
}
__device__ __forceinline__ unsigned cvt_pk_bf16(float lo, float hi) { unsigned r; asm volatile("v_cvt_pk_bf16_f32 %0, %1, %2" : "=v"(r) : "v"(lo), "v"(hi)); return r; }

template <class Epi, class Sched, bool ALIGN_EPI = true>
__device__ __forceinline__ void gemm_phase(PG8_LAS unsigned char* lds, const Sched& S, const Epi& E) {
    const int tid = TIDX, wid = __builtin_amdgcn_readfirstlane(tid >> 6), lane = tid & 63, wr = wid >> 2, wc = wid & 3, fr = lane & 15, fq = lane >> 4;
    const int K = S.K, nt = K / BK;
    unsigned voffA[2], voffB[2];
#pragma unroll
    for (int i = 0; i < 2; ++i) { int R, C; stage_rc(tid * 16 + i * 8192, R, C); const int Rb = (R & ~31) + perm32(R & 31);
        voffA[i] = (unsigned)(R * S.lda + C) * 2u; voffB[i] = (unsigned)(Rb * S.ldb + C) * 2u; }
    const size_t kstep = (size_t)(BK * 2);
    const size_t hstepA = (size_t)HALF * S.lda * 2, hstepB = (size_t)HALF * S.ldb * 2;
    const unsigned ldsw = (unsigned)wid * 1024u;
    const int aoff = lds_byte(wr * 64 + fr, fq * 8), boff = lds_byte(wc * 32 + fr, fq * 8);
#define PG8_SA(b, h) (((b) * 2 + (h)) * HTB)
#define PG8_SB(b, h) ((4 + (b) * 2 + (h)) * HTB)
#define PG8_STAGE(bufoff, gbase, voff) do { _Pragma("unroll") for (int _i = 0; _i < 2; ++_i) \
        __builtin_amdgcn_global_load_lds((const unsigned*)((const char*)(gbase) + (voff)[_i]), (PG8_LAS unsigned*)(lds + (bufoff) + ldsw + _i * 8192), 16, 0, 0); } while (0)
#define PG8_LDA(dst, b, h) do { _Pragma("unroll") for (int m = 0; m < 4; ++m) _Pragma("unroll") for (int k = 0; k < 2; ++k) dst[m][k] = *(const PG8_LAS bf16x8*)(lds + PG8_SA(b, h) + aoff + m * 2048 + k * 1024); } while (0)
#define PG8_LDB(dst, b, h) do { _Pragma("unroll") for (int n = 0; n < 2; ++n) _Pragma("unroll") for (int k = 0; k < 2; ++k) dst[n][k] = *(const PG8_LAS bf16x8*)(lds + PG8_SB(b, h) + boff + n * 2048 + k * 1024); } while (0)
#define PG8_MMA(ai, bj, At, Bt) do { __builtin_amdgcn_s_setprio(1); _Pragma("unroll") for (int m = 0; m < 4; ++m) _Pragma("unroll") for (int n = 0; n < 2; ++n) _Pragma("unroll") for (int k = 0; k < 2; ++k) \
        acc[ai][bj][m][n] = __builtin_amdgcn_mfma_f32_16x16x32_bf16(Bt[n][k], At[m][k], acc[ai][bj][m][n], 0, 0, 0); __builtin_amdgcn_s_setprio(0); } while (0)
#define PG8_WAIT_V(n) asm volatile("s_waitcnt vmcnt(" #n ")" ::: "memory")
#define PG8_WAIT_L(n) asm volatile("s_waitcnt lgkmcnt(" #n ")" ::: "memory")
#define PG8_BAR __builtin_amdgcn_s_barrier()
#define PG8_SCHED __builtin_amdgcn_sched_barrier(0)
    Unit cur, nxt; int ui = 0;
    if (!S.next(0, cur)) return;
    f32x4 acc[2][2][4][2];
#pragma unroll
    for (int a = 0; a < 2; ++a)
#pragma unroll
        for (int b = 0; b < 2; ++b)
#pragma unroll
            for (int m = 0; m < 4; ++m)
#pragma unroll
                for (int n = 0; n < 2; ++n) acc[a][b][m][n] = (f32x4){0.f, 0.f, 0.f, 0.f};
    bf16x8 At[4][2], B0[2][2], B1[2][2];
    const char* cA = S.abase(cur); const char* cB = S.bbase(cur);
    PG8_STAGE(PG8_SB(0, 0), cB, voffB); PG8_STAGE(PG8_SB(0, 1), cB + hstepB, voffB); PG8_STAGE(PG8_SA(0, 0), cA, voffA); PG8_STAGE(PG8_SA(0, 1), cA + hstepA, voffA);
    if (wr == 1) PG8_BAR;
    PG8_WAIT_V(2); PG8_BAR;
    PG8_STAGE(PG8_SB(1, 0), cB + kstep, voffB); PG8_STAGE(PG8_SA(1, 0), cA + kstep, voffA); PG8_STAGE(PG8_SB(1, 1), cB + hstepB + kstep, voffB);
    PG8_WAIT_V(6); PG8_BAR;
    for (;;) {
        const bool has_next = S.next(ui + 1, nxt);
        const char* nA = has_next ? S.abase(nxt) : cA; const char* nB = has_next ? S.bbase(nxt) : cB;
        for (int t = 0; t < nt; t += 2) {
            const bool last = (t == nt - 2);
            const char* a1 = cA + (size_t)(t + 1) * kstep;
            const char* a2 = last ? nA : cA + (size_t)(t + 2) * kstep; const char* b2 = last ? nB : cB + (size_t)(t + 2) * kstep;
            const char* a3 = a2 + kstep; const char* b3 = b2 + kstep;
            PG8_LDB(B0, 0, 0); PG8_LDB(B1, 0, 1); PG8_SCHED; PG8_LDA(At, 0, 0); PG8_STAGE(PG8_SA(1, 1), a1 + hstepA, voffA);
            PG8_WAIT_V(8); PG8_WAIT_L(0); PG8_BAR; PG8_MMA(0, 0, At, B0); PG8_MMA(0, 1, At, B1); PG8_BAR; PG8_SCHED;
            PG8_LDA(At, 0, 1); PG8_STAGE(PG8_SB(0, 0), b2, voffB); PG8_STAGE(PG8_SB(0, 1), b2 + hstepB, voffB); PG8_STAGE(PG8_SA(0, 0), a2, voffA);
            PG8_WAIT_V(8); PG8_WAIT_L(0); PG8_BAR; PG8_MMA(1, 0, At, B0); PG8_MMA(1, 1, At, B1); PG8_BAR; PG8_SCHED;
            PG8_LDB(B0, 1, 0); PG8_LDB(B1, 1, 1); PG8_SCHED; PG8_LDA(At, 1, 0); PG8_STAGE(PG8_SA(0, 1), a2 + hstepA, voffA);
            PG8_WAIT_V(8); PG8_WAIT_L(0); PG8_BAR; PG8_MMA(0, 0, At, B0); PG8_MMA(0, 1, At, B1); PG8_BAR; PG8_SCHED;
            PG8_LDA(At, 1, 1); PG8_STAGE(PG8_SB(1, 0), b3, voffB); PG8_STAGE(PG8_SB(1, 1), b3 + hstepB, voffB); PG8_STAGE(PG8_SA(1, 0), a3, voffA);
            PG8_WAIT_V(8); PG8_WAIT_L(0); PG8_BAR; PG8_MMA(1, 0, At, B0); PG8_MMA(1, 1, At, B1); PG8_BAR; PG8_SCHED;
        }
        if constexpr (ALIGN_EPI) { if (wr == 0) PG8_BAR; }
        E(acc, cur, wr, wc, fr, fq);
        if (!has_next) break;
#pragma unroll
        for (int a = 0; a < 2; ++a)
#pragma unroll
            for (int b = 0; b < 2; ++b)
#pragma unroll
                for (int m = 0; m < 4; ++m)
#pragma unroll
                    for (int n = 0; n < 2; ++n) acc[a][b][m][n] = (f32x4){0.f, 0.f, 0.f, 0.f};
        cur = nxt; cA = nA; cB = nB; ++ui;
        if constexpr (ALIGN_EPI) { if (wr == 1) PG8_BAR; }
    }
    PG8_WAIT_V(0);
    if constexpr (!ALIGN_EPI) { if (wr == 0) PG8_BAR; }
    PG8_BAR;
#undef PG8_SA
#undef PG8_SB
#undef PG8_STAGE
#undef PG8_LDA
#undef PG8_LDB
#undef PG8_MMA
#undef PG8_WAIT_V
#undef PG8_WAIT_L
#undef PG8_BAR
#undef PG8_SCHED
}
__device__ __forceinline__ u32x4 pack8(f32x4 v0, f32x4 v1) { u32x4 w; w.x = cvt_pk_bf16(v0[0], v0[1]); w.y = cvt_pk_bf16(v0[2], v0[3]); w.z = cvt_pk_bf16(v1[0], v1[1]); w.w = cvt_pk_bf16(v1[2], v1[3]); return w; }
__device__ __forceinline__ void unpack8(u32x4 w, f32x4& v0, f32x4& v1) {
    v0[0] = __uint_as_float(w.x << 16); v0[1] = __uint_as_float(w.x & 0xffff0000u); v0[2] = __uint_as_float(w.y << 16); v0[3] = __uint_as_float(w.y & 0xffff0000u);
    v1[0] = __uint_as_float(w.z << 16); v1[1] = __uint_as_float(w.z & 0xffff0000u); v1[2] = __uint_as_float(w.w << 16); v1[3] = __uint_as_float(w.w & 0xffff0000u); }
template <class F> __device__ __forceinline__ void for_each_piece(const f32x4 (&acc)[2][2][4][2], const Unit& u, int wr, int wc, int fr, int fq, const F& f) {
    asm volatile("" : "+v"(fr), "+v"(fq));
    const int row0 = u.pm * BM + wr * 64 + fr, col0 = wc * 32 + 8 * fq;
#pragma unroll
    for (int ai = 0; ai < 2; ++ai)
#pragma unroll
        for (int m = 0; m < 4; ++m)
#pragma unroll
            for (int bj = 0; bj < 2; ++bj) f(row0 + ai * HALF + m * 16, col0 + bj * HALF, acc[ai][bj][m][0], acc[ai][bj][m][1]);
}
}

template <int MI, int NJ, class AR, class BR, class Epi>
__device__ __forceinline__ void sgemm_wave(const AR& ar, const BR& br, int K, int m0, int n0, const Epi& epi) {
    const int lane = TIDX & 63, c = lane & 15, g = lane >> 4;
    const bf16_t* ap[MI]; const bf16_t* bp[NJ];
#pragma unroll
    for (int i = 0; i < MI; ++i) ap[i] = ar.row(m0 + 16 * i + c) + 8 * g;
#pragma unroll
    for (int j = 0; j < NJ; ++j) bp[j] = br.row(n0 + 16 * j + c) + 8 * g;
    f32x4 acc[MI][NJ];
#pragma unroll
    for (int i = 0; i < MI; ++i)
#pragma unroll
        for (int j = 0; j < NJ; ++j) acc[i][j] = (f32x4){0.f, 0.f, 0.f, 0.f};
#pragma unroll 4
    for (int k0 = 0; k0 < K; k0 += 32) {
        bf16x8 a[MI], b[NJ];
#pragma unroll
        for (int i = 0; i < MI; ++i) a[i] = ld8(ap[i] + k0);
#pragma unroll
        for (int j = 0; j < NJ; ++j) b[j] = ld8(bp[j] + k0);
#pragma unroll
        for (int i = 0; i < MI; ++i)
#pragma unroll
            for (int j = 0; j < NJ; ++j) acc[i][j] = mfma16(b[j], a[i], acc[i][j]);
    }
#pragma unroll
    for (int i = 0; i < MI; ++i)
#pragma unroll
        for (int j = 0; j < NJ; ++j) epi(m0 + 16 * i + c, n0 + 16 * j + 4 * g, acc[i][j]);
}
template <int MI, int NJ, class AR, class BR, class Epi>
__device__ __forceinline__ void meta_gemm(const AR& ar, const BR& br, int K, int m0, int n0, const Epi& epi, char* lds) {
    const int tid = TIDX, wid = __builtin_amdgcn_readfirstlane(tid >> 6), lane = tid & 63, c = lane & 15, g = lane >> 4;
    const int kw = K >> 3, kb = wid * kw;
    f32x4 acc[MI][NJ];
#pragma unroll
    for (int i = 0; i < MI; ++i)
#pragma unroll
        for (int j = 0; j < NJ; ++j) acc[i][j] = (f32x4){0.f, 0.f, 0.f, 0.f};
    for (int k0 = kb; k0 < kb + kw; k0 += 32) {
        bf16x8 a[MI], b[NJ];
#pragma unroll
        for (int i = 0; i < MI; ++i) a[i] = ld8(ar.row(m0 + 16 * i + c) + 8 * g + k0);
#pragma unroll
        for (int j = 0; j < NJ; ++j) b[j] = ld8(br.row(n0 + 16 * j + c) + 8 * g + k0);
#pragma unroll
        for (int i = 0; i < MI; ++i)
#pragma unroll
            for (int j = 0; j < NJ; ++j) acc[i][j] = mfma16(b[j], a[i], acc[i][j]);
    }
    f32x4* part = (f32x4*)lds;
#pragma unroll
    for (int i = 0; i < MI; ++i)
#pragma unroll
        for (int j = 0; j < NJ; ++j) part[((wid * MI + i) * NJ + j) * 64 + lane] = acc[i][j];
    __syncthreads();
    if (wid == 0) {
#pragma unroll
        for (int i = 0; i < MI; ++i)
#pragma unroll
            for (int j = 0; j < NJ; ++j) { f32x4 s = acc[i][j];
#pragma unroll
                for (int w = 1; w < 8; ++w) s += part[((w * MI + i) * NJ + j) * 64 + lane];
                epi(m0 + 16 * i + c, n0 + 16 * j + 4 * g, s); }
    }
    __syncthreads();
}
__device__ __forceinline__ void zero_block(bf16_t* base, size_t ld, int nrows, int ncols, int gtid, int gthreads) {
    const int cpr = ncols / 8;
    for (int i = gtid; i < nrows * cpr; i += gthreads) { const int r = i / cpr, cc = (i % cpr) * 8; *(u32x4*)(base + (size_t)r * ld + cc) = (u32x4){0u, 0u, 0u, 0u}; }
}

struct SchedProj { const char* A; const char* B; int G, c; int K, lda, ldb;
    __device__ __forceinline__ bool next(int i, pg8::Unit& u) const { if (!pg8::decode_unit((long)i * G + c, 1, 64, 28, u)) return false; u.pm += 1; return true; }
    __device__ __forceinline__ const char* abase(const pg8::Unit& u) const { return A + (size_t)u.pm * 256 * D * 2; }
    __device__ __forceinline__ const char* bbase(const pg8::Unit& u) const { return B + (size_t)u.pn * 256 * D * 2; } };
struct EpiProjF { unsigned char* ws;
    __device__ __forceinline__ void operator()(const f32x4 (&acc)[2][2][4][2], const pg8::Unit& u, int wr, int wc, int fr, int fq) const {
        const int colt = u.pn * 256, seg = colt >> 10;
        const size_t off = seg == 0 ? B_XM : seg == 1 ? B_OP : seg == 2 ? B_QA : seg == 3 ? B_KA : seg == 4 ? B_VA : seg == 5 ? B_GA : B_GB;
        bf16_t* base = (bf16_t*)(ws + off) + (colt & 1023);
        pg8::for_each_piece(acc, u, wr, wc, fr, fq, [&](int row, int col, f32x4 v0, f32x4 v1) { *(u32x4*)(base + (size_t)row * D + col) = pg8::pack8(v0, v1); }); } };
struct SchedVAT { const char* A; const char* B; int G, c; int K, lda, ldb;
    __device__ __forceinline__ bool next(int i, pg8::Unit& u) const { if (!pg8::decode_unit((long)i * G + c, 1, 4, 64, u)) return false; u.pn += 1; return true; }
    __device__ __forceinline__ const char* abase(const pg8::Unit& u) const { return A + (size_t)u.pm * 256 * D * 2; }
    __device__ __forceinline__ const char* bbase(const pg8::Unit& u) const { return B + (size_t)u.pn * 256 * D * 2; } };
struct EpiStoreF { bf16_t* C; size_t ldc; float scale;
    __device__ __forceinline__ void operator()(const f32x4 (&acc)[2][2][4][2], const pg8::Unit& u, int wr, int wc, int fr, int fq) const {
        bf16_t* base = C + (size_t)u.pn * 256;
        pg8::for_each_piece(acc, u, wr, wc, fr, fq, [&](int row, int col, f32x4 v0, f32x4 v1) { *(u32x4*)(base + (size_t)row * ldc + col) = pg8::pack8(v0 * scale, v1 * scale); }); } };
__device__ __forceinline__ void phase_proj_f(const Params& p, char* lds, int bid, int nb) {
    const int tid = TIDX, wid = tid >> 6, gw = bid * NW + wid, ngw = nb * NW;
    const bf16_t* H = (const bf16_t*)(p.ws + B_H); const bf16_t* W = (const bf16_t*)(p.ws + W_IN_T);
    zero_block((bf16_t*)(p.ws + B_KA), D, VALID0, D, bid * NT + tid, nb * NT);
    zero_block((bf16_t*)(p.ws + B_VA), D, VALID0, D, bid * NT + tid, nb * NT);
    zero_block((bf16_t*)(p.ws + B_XM), D, VALID0, D, bid * NT + tid, nb * NT);
    for (int t = bid; t < 112; t += nb) meta_gemm<1, 4>(RowsPlain{H, D}, RowsPlain{W, D}, D, VALID0, t * 64, EpiProj{p.ws}, lds);
    { SchedProj S{(const char*)H, (const char*)W, nb, bid, D, D, D};
      pg8::gemm_phase(( PG8_LAS unsigned char*)lds, S, EpiProjF{p.ws}); }
}

namespace fa {
typedef short s16x4 __attribute__((ext_vector_type(4)));
typedef float f32x16 __attribute__((ext_vector_type(16)));
constexpr int KVBLK = 64, SHM_V = 64 * 128 * 2, SHM_K = 64 * 64 * 2, PITCH = 1024;
constexpr int LDS_NEED = 2 * SHM_V + 2 * SHM_K + NW * 64 * 4;
constexpr float SCALE = 0.125f, THR = 8.f;
#define FA_SBAR() __builtin_amdgcn_sched_barrier(0)
__device__ __forceinline__ int kswz(int row, int chunk) { return row * 128 + ((chunk ^ ((row >> 1) & 7)) << 4); }
__device__ __forceinline__ int v_st(int k, int c) { const int kk = (k & ~0xC) | ((k & 4) << 1) | ((k & 8) >> 1); return ((kk >> 3) * 4 + (c >> 5)) * 512 + ((kk & 7) * 32 + (c & 31)) * 2; }
__device__ __forceinline__ int v_rd_base(int lane) { return ((lane & 3) << 3) | (((lane >> 2) & 3) << 6) | (((lane >> 4) & 1) << 5) | (((lane >> 5) & 1) << 8); }
constexpr int v_rd_off(int d0, int ks, int half) { return d0 * 512 + ks * 4096 + half * 2048; }
__device__ __forceinline__ int crow(int r, int hi) { return (r & 3) + 8 * (r >> 2) + 4 * hi; }
__device__ __forceinline__ unsigned cvtpk(float lo, float hi) { unsigned r; asm volatile("v_cvt_pk_bf16_f32 %0, %1, %2" : "=v"(r) : "v"(lo), "v"(hi)); return r; }
__device__ __forceinline__ void mask_tile(f32x16& p0, f32x16& p1, int pos, int kbase, int hi, int lowkey) {
    const float NEG = -__builtin_inff();
#pragma unroll
    for (int r = 0; r < 16; ++r) {
        const int k0 = kbase + (r & 3) + 8 * (r >> 2) + 4 * hi;
        if (k0 > pos || k0 < lowkey) p0[r] = NEG;
        if (k0 + 32 > pos || k0 + 32 < lowkey) p1[r] = NEG;
    }
}
__device__ __forceinline__ void partialSM(f32x16& p0, f32x16& p1, float& m_reg, float& mn, float& alpha) {
    float pmax = p0[0];
#pragma unroll
    for (int r = 1; r < 16; ++r) pmax = fmaxf(pmax, p0[r]);
#pragma unroll
    for (int r = 0; r < 16; ++r) pmax = fmaxf(pmax, p1[r]);
    { auto rr = __builtin_amdgcn_permlane32_swap(__float_as_uint(pmax), __float_as_uint(pmax), false, false);
      pmax = fmaxf(__uint_as_float(rr[0]), __uint_as_float(rr[1])); }
    constexpr float C2 = 1.4426950408889634f * SCALE;
    if (__builtin_expect(__all((pmax - m_reg) * SCALE <= THR), 1)) { mn = m_reg; alpha = 1.f; }
    else { mn = fmaxf(m_reg, pmax); alpha = __builtin_amdgcn_exp2f((m_reg - mn) * C2); m_reg = mn; }
    const float mnL = -mn * C2;
#pragma unroll
    for (int r = 0; r < 16; ++r) p0[r] = fmaf(p0[r], C2, mnL);
#pragma unroll
    for (int r = 0; r < 16; ++r) p1[r] = fmaf(p1[r], C2, mnL);
#pragma unroll
    for (int r = 0; r < 16; ++r) p0[r] = __builtin_amdgcn_exp2f(p0[r]);
}
__device__ __forceinline__ void finishSM(f32x16& p0, f32x16& p1, float alpha, float& l_reg, bf16x8& pa0, bf16x8& pa1, bf16x8& pa2, bf16x8& pa3) {
#pragma unroll
    for (int r = 0; r < 16; ++r) p1[r] = __builtin_amdgcn_exp2f(p1[r]);
    float ps = 0;
#pragma unroll
    for (int r = 0; r < 16; ++r) ps += p0[r];
#pragma unroll
    for (int r = 0; r < 16; ++r) ps += p1[r];
    { auto rr = __builtin_amdgcn_permlane32_swap(__float_as_uint(ps), __float_as_uint(ps), false, false);
      ps = __uint_as_float(rr[0]) + __uint_as_float(rr[1]); }
    l_reg = l_reg * alpha + ps;
#define FA_PK4(Pv, B_, OUT) do { unsigned a0 = cvtpk(Pv[B_+0], Pv[B_+1]), a1 = cvtpk(Pv[B_+2], Pv[B_+3]);                          \
        unsigned b0 = cvtpk(Pv[B_+4], Pv[B_+5]), b1 = cvtpk(Pv[B_+6], Pv[B_+7]);                                             \
        auto r0 = __builtin_amdgcn_permlane32_swap(a0, b0, false, false); auto r1 = __builtin_amdgcn_permlane32_swap(a1, b1, false, false); \
        u32x4 w = {r0[0], r1[0], r0[1], r1[1]}; OUT = *reinterpret_cast<bf16x8*>(&w); } while (0)
    FA_PK4(p0, 0, pa0); FA_PK4(p0, 8, pa1); FA_PK4(p1, 0, pa2); FA_PK4(p1, 8, pa3);
#undef FA_PK4
}
template <int KB>
__device__ __forceinline__ void qkt(f32x16& p0, f32x16& p1, const char* K_lds, int r32, int hi, const bf16x8* qr) {
    p0 = f32x16{}; p1 = f32x16{};
#pragma unroll
    for (int d0 = 0; d0 < 4; ++d0) { const char* a = K_lds + KB * SHM_K + kswz(r32, 2 * d0 + hi);
        bf16x8 b0 = *reinterpret_cast<const bf16x8*>(a);
        bf16x8 b1 = *reinterpret_cast<const bf16x8*>(a + 32 * 128);
        p0 = __builtin_amdgcn_mfma_f32_32x32x16_bf16(b0, qr[d0], p0, 0, 0, 0);
        p1 = __builtin_amdgcn_mfma_f32_32x32x16_bf16(b1, qr[d0], p1, 0, 0, 0); }
}
template <int VB>
__device__ __forceinline__ void pv_tile(f32x16* o, int vb0, bf16x8 pa0, bf16x8 pa1, bf16x8 pa2, bf16x8 pa3) {
#define FA_TRRD(dst, off) asm volatile("ds_read_b64_tr_b16 %0, %1 offset:%2" : "=&v"(dst) : "v"(vb0), "i"(off) : "memory")
#define FA_PV_D0(d0) do { s16x4 l0, l1, l2, l3, h0, h1, h2, h3; constexpr int b_ = VB * SHM_V + v_rd_off(d0, 0, 0); \
        FA_TRRD(l0, b_); FA_TRRD(h0, b_ + 2048); FA_TRRD(l1, b_ + 4096); FA_TRRD(h1, b_ + 6144); FA_TRRD(l2, b_ + 8192); FA_TRRD(h2, b_ + 10240); FA_TRRD(l3, b_ + 12288); FA_TRRD(h3, b_ + 14336); \
        asm volatile("s_waitcnt lgkmcnt(0)" ::: "memory"); FA_SBAR();   \
        o[d0] = __builtin_amdgcn_mfma_f32_32x32x16_bf16(pa0, (bf16x8){l0[0], l0[1], l0[2], l0[3], h0[0], h0[1], h0[2], h0[3]}, o[d0], 0, 0, 0);   \
        o[d0] = __builtin_amdgcn_mfma_f32_32x32x16_bf16(pa1, (bf16x8){l1[0], l1[1], l1[2], l1[3], h1[0], h1[1], h1[2], h1[3]}, o[d0], 0, 0, 0);   \
        o[d0] = __builtin_amdgcn_mfma_f32_32x32x16_bf16(pa2, (bf16x8){l2[0], l2[1], l2[2], l2[3], h2[0], h2[1], h2[2], h2[3]}, o[d0], 0, 0, 0);   \
        o[d0] = __builtin_amdgcn_mfma_f32_32x32x16_bf16(pa3, (bf16x8){l3[0], l3[1], l3[2], l3[3], h3[0], h3[1], h3[2], h3[3]}, o[d0], 0, 0, 0); } while (0)
    FA_PV_D0(0); FA_PV_D0(1); FA_PV_D0(2); FA_PV_D0(3);
#undef FA_PV_D0
#undef FA_TRRD
}
__device__ __forceinline__ void attn_pass(const bf16_t* Qp, const bf16_t* Kp, const bf16_t* Vp, int P0, int NT, char* lds, f32x16 (&o)[4], float& l_out) {
    const int tid = TIDX, wid = __builtin_amdgcn_readfirstlane(tid >> 6), lane = tid & 63, r32 = lane & 31, hi = lane >> 5;
    char* V_lds = lds; char* K_lds = lds + 2 * SHM_V;
    float* wsl = (float*)(lds + 2 * SHM_V + 2 * SHM_K) + wid * 64; float* al_l = wsl + 32;
    const int qlo = P0 + wid * 32, pos = qlo + r32;
    float m_reg = -1e30f, l_reg = 0.f;
#pragma unroll
    for (int d = 0; d < 4; ++d) o[d] = f32x16{};
    const int ksr = tid >> 3, ksc = tid & 7, kws = kswz(ksr, ksc);
    const int sr = tid >> 4, sc = (tid & 15) * 8, vst0 = v_st(sr, sc), vst1 = v_st(32 + sr, sc);
    const int vb0 = (int)(uintptr_t)V_lds + v_rd_base(lane);
    bf16x8 qr[4];
#pragma unroll
    for (int d0 = 0; d0 < 4; ++d0) qr[d0] = ld8(Qp + (size_t)pos * PITCH + d0 * 16 + hi * 8);
    bf16x8 st_k, st_v0, st_v1;
#define FA_KBASE(t) ((3 + (t)) * KVBLK)
#define FA_SLOAD(t) do { const int kb_ = FA_KBASE(t); st_k = ld8(Kp + (size_t)(kb_ + ksr) * PITCH + ksc * 8); \
        st_v0 = ld8(Vp + (size_t)(kb_ + sr) * PITCH + sc); st_v1 = ld8(Vp + (size_t)(kb_ + 32 + sr) * PITCH + sc); } while (0)
#define FA_SWRITE_K(bf) do { *(bf16x8*)(K_lds + (bf) * SHM_K + kws) = st_k; } while (0)
#define FA_SWRITE_V(bf) do { *(bf16x8*)(V_lds + (bf) * SHM_V + vst0) = st_v0; *(bf16x8*)(V_lds + (bf) * SHM_V + vst1) = st_v1; } while (0)
#define FA_VMW() asm volatile("s_waitcnt vmcnt(0)" ::: "memory")
#define FA_RESC(a) do { if (__any((a) < 1.f)) { if (hi == 0) al_l[r32] = (a); asm volatile("s_waitcnt lgkmcnt(0)" ::: "memory");              \
                     for (int d_ = 0; d_ < 4; ++d_) for (int r = 0; r < 16; ++r) o[d_][r] *= al_l[crow(r, hi)]; } } while (0)
#define FA_MASKT(P0_, P1_, t) do { const int kb_ = FA_KBASE(t); if ((t) == 0 || kb_ + KVBLK - 1 > qlo) mask_tile(P0_, P1_, pos, kb_, hi, VALID0); } while (0)
    f32x16 pA0, pA1, pB0, pB1; float mnA, mnB, alA, alB; bf16x8 pa0, pa1, pa2, pa3;
    FA_SLOAD(0); FA_VMW(); FA_SWRITE_K(0); FA_SWRITE_V(0); FA_SBAR();
    if (NT > 1) FA_SLOAD(1);
    __syncthreads();
    FA_SBAR(); qkt<0>(pA0, pA1, K_lds, r32, hi, qr);
    FA_MASKT(pA0, pA1, 0); partialSM(pA0, pA1, m_reg, mnA, alA);
    if (NT > 1) { FA_VMW(); FA_SWRITE_K(1); FA_SWRITE_V(1); }
    __syncthreads();
#define FA_HALF_STEP(PX0, PX1, mnX, alX, PY0, PY1, alY, t, KB, VB, SB) do {                                                      \
        FA_SBAR(); qkt<KB>(PX0, PX1, K_lds, r32, hi, qr);                                             \
        finishSM(PY0, PY1, alY, l_reg, pa0, pa1, pa2, pa3); FA_SBAR();                                                           \
        if ((t) + 1 < NT) { FA_SLOAD((t) + 1); FA_SBAR(); }                                               \
        pv_tile<VB>(o, vb0, pa0, pa1, pa2, pa3); FA_MASKT(PX0, PX1, (t)); partialSM(PX0, PX1, m_reg, mnX, alX);                                        \
        __syncthreads();                                                                                                      \
        if ((t) + 1 < NT) { FA_VMW(); FA_SWRITE_K(SB); FA_SWRITE_V(SB); }                                                                          \
        FA_RESC(alX); __syncthreads(); } while (0)
    for (int t = 1; t + 1 < NT; t += 2) {
        FA_HALF_STEP(pB0, pB1, mnB, alB, pA0, pA1, alA, t, 1, 0, 0);
        FA_HALF_STEP(pA0, pA1, mnA, alA, pB0, pB1, alB, t + 1, 0, 1, 1);
    }
    const bool even = (NT & 1) == 0;
    if (even) { FA_SBAR(); qkt<1>(pB0, pB1, K_lds, r32, hi, qr); FA_SBAR(); }
    finishSM(pA0, pA1, alA, l_reg, pa0, pa1, pa2, pa3); FA_SBAR();
    pv_tile<0>(o, vb0, pa0, pa1, pa2, pa3);
    if (even) { FA_MASKT(pB0, pB1, NT - 1); partialSM(pB0, pB1, m_reg, mnB, alB); __syncthreads(); FA_RESC(alB);
        finishSM(pB0, pB1, alB, l_reg, pa0, pa1, pa2, pa3); FA_SBAR(); pv_tile<1>(o, vb0, pa0, pa1, pa2, pa3); }
    l_out = l_reg;
    __syncthreads();
#undef FA_KBASE
#undef FA_SLOAD
#undef FA_SWRITE_K
#undef FA_SWRITE_V
#undef FA_VMW
#undef FA_RESC
#undef FA_MASKT
#undef FA_HALF_STEP
}
__device__ __forceinline__ void attn_unit(const Params& p, int l, int hd, int j, float lam, float lam_init, char* lds) {
    const int tid = TIDX, wid = __builtin_amdgcn_readfirstlane(tid >> 6), lane = tid & 63, r32 = lane & 31, hi = lane >> 5;
    const bf16_t* QA = (const bf16_t*)(p.ws + B_QA) + hd * 128; const bf16_t* KA = (const bf16_t*)(p.ws + B_KA) + hd * 128; const bf16_t* VA = (const bf16_t*)(p.ws + B_VA) + hd * 128;
    bf16_t* YA = (bf16_t*)(p.ws + B_YA) + hd * 128;
    const int P0 = j * 256, NT = 4 * j + 1;
    float* li_l = (float*)(lds + 2 * SHM_V + 2 * SHM_K) + wid * 64;
    bf16_t* Yw = YA + (size_t)(P0 + wid * 32) * PITCH;
    f32x16 o[4]; float lr;
    attn_pass(QA, KA, VA, P0, NT, lds, o, lr);
    if (hi == 0) li_l[r32] = lr;
    asm volatile("s_waitcnt lgkmcnt(0)" ::: "memory");
#pragma unroll
    for (int r = 0; r < 16; ++r) { const int orow = crow(r, hi); const float rl = __builtin_amdgcn_rcpf(li_l[orow]);
#pragma unroll
        for (int d0 = 0; d0 < 4; ++d0) { const float v = o[d0][r] * rl; const float vn = sx<1>(v);
            if ((r32 & 1) == 0) *(unsigned*)(Yw + (size_t)orow * PITCH + d0 * 32 + r32) = cvtpk(v, vn); } }
    asm volatile("s_waitcnt vmcnt(0)" ::: "memory");
    __syncthreads();
    attn_pass(QA + 64, KA + 64, VA, P0, NT, lds, o, lr);
    if (hi == 0) li_l[r32] = lr;
    asm volatile("s_waitcnt lgkmcnt(0)" ::: "memory");
    const float scale_out = 1.f - lam_init;
#pragma unroll
    for (int r = 0; r < 16; ++r) { const int orow = crow(r, hi); const float rl = lam * __builtin_amdgcn_rcpf(li_l[orow]);
        float cv[4]; float ss = 0.f;
#pragma unroll
        for (int d0 = 0; d0 < 4; ++d0) { const float o1 = bf2f((unsigned)Yw[(size_t)orow * PITCH + d0 * 32 + r32]); cv[d0] = o1 - o[d0][r] * rl; ss += cv[d0] * cv[d0]; }
        ss += sx<1>(ss); ss += sx<2>(ss); ss += sx<4>(ss); ss += sx<8>(ss); ss += sx<16>(ss);
        const float rs = rsqrtf(ss * (1.f / 128.f) + LN_EPS) * scale_out;
#pragma unroll
        for (int d0 = 0; d0 < 4; ++d0) o[d0][r] = cv[d0] * rs * p.in[I_ANG][l * 128 + d0 * 32 + r32]; }
    asm volatile("s_waitcnt vmcnt(0)" ::: "memory");
    __syncthreads();
#pragma unroll
    for (int r = 0; r < 16; ++r) { const int orow = crow(r, hi);
#pragma unroll
        for (int d0 = 0; d0 < 4; ++d0) { const float v = o[d0][r]; const float vn = sx<1>(v);
            if ((r32 & 1) == 0) *(unsigned*)(Yw + (size_t)orow * PITCH + d0 * 32 + r32) = cvtpk(v, vn); } }
    __syncthreads();
}
}
__device__ __forceinline__ void phase_attn_f(const Params& p, int l, char* lds, int bid, int nb) {
    const int lane = TIDX & 63;
    const float lam_init = 0.8f - 0.6f * expf(-0.3f * (float)l);
    float lam;
    { const float a = wave_sum(p.in[I_LQ1][l * 64 + lane] * p.in[I_LK1][l * 64 + lane]), b = wave_sum(p.in[I_LQ2][l * 64 + lane] * p.in[I_LK2][l * 64 + lane]);
      lam = expf(a) - expf(b) + lam_init; }
    for (int u = bid; u < 256 + 8; u += nb) {
        if (u < 256) { const int hd = u & 7, jj = u >> 3;
            fa::attn_unit(p, l, hd, 64 - jj, lam, lam_init, lds);
            fa::attn_unit(p, l, hd, 1 + jj, lam, lam_init, lds);
        } else fa::attn_unit(p, l, u - 256, 0, lam, lam_init, lds);
    }
}

__device__ __forceinline__ void phase_conv(const Params& p, int l, char* lds, int bid, int nb) {
    const int tid = TIDX, wid = tid >> 6, lane = tid & 63, gw = bid * NW + wid, ngw = nb * NW;
    const bf16_t* XM = (const bf16_t*)(p.ws + B_XM); bf16_t* XC = (bf16_t*)(p.ws + B_XC);
    const float* cw = p.in[I_CONVW] + (size_t)l * 4 * D; const float* cb = p.in[I_CONVB] + (size_t)l * D;
    const int nitem = P * (D / 8);
    for (int it = bid * NT + tid; it < nitem; it += nb * NT) {
        const int r = it >> 7, c0 = (it & 127) * 8;
        u32x4 o = {0u, 0u, 0u, 0u};
        if (r >= VALID0) {
            float acc[8];
#pragma unroll
            for (int i = 0; i < 8; ++i) acc[i] = cb[c0 + i];
#pragma unroll
            for (int j = 0; j < 4; ++j) { const int rr = r - 3 + j;
                if (rr >= VALID0) { const u32x4 x = *(const u32x4*)(XM + (size_t)rr * D + c0); const float* w = cw + j * D + c0;
                    acc[0] += w[0] * bf2f(x.x & 0xffffu); acc[1] += w[1] * bf2f(x.x >> 16); acc[2] += w[2] * bf2f(x.y & 0xffffu); acc[3] += w[3] * bf2f(x.y >> 16);
                    acc[4] += w[4] * bf2f(x.z & 0xffffu); acc[5] += w[5] * bf2f(x.z >> 16); acc[6] += w[6] * bf2f(x.w & 0xffffu); acc[7] += w[7] * bf2f(x.w >> 16); } }
            o.x = pk2(siluf_(acc[0]), siluf_(acc[1])); o.y = pk2(siluf_(acc[2]), siluf_(acc[3])); o.z = pk2(siluf_(acc[4]), siluf_(acc[5])); o.w = pk2(siluf_(acc[6]), siluf_(acc[7]));
        }
        *(u32x4*)(XC + (size_t)r * D + c0) = o;
    }
    const float* gli = (const float*)(p.ws + TAB_GLI); const float* glf = (const float*)(p.ws + TAB_GLF);
    float* tb = (float*)(p.ws + TAB_B); float* te = (float*)(p.ws + TAB_E); float* tpm = (float*)(p.ws + TAB_PM); float* tw = (float*)(p.ws + TAB_W);
    float* scg = (float*)(p.ws + TAB_SCG); float* scm = (float*)(p.ws + TAB_SCM);
    for (int t = gw; t < NSC * 4; t += ngw) {
        const int sc = t >> 2, h = t & 3; const size_t base = (size_t)h * P + sc * 256 + 4 * lane;
        const f32x4 lf = *(const f32x4*)(glf + base), li = *(const f32x4*)(gli + base);
        float b[4]; b[0] = lf.x; b[1] = b[0] + lf.y; b[2] = b[1] + lf.z; b[3] = b[2] + lf.w;
        float incl = b[3];
#pragma unroll
        for (int o = 1; o < 64; o <<= 1) { const float n = __shfl_up(incl, o); if (lane >= o) incl += n; }
        const float excl = incl - b[3];
        float e[4], pm[4];
#pragma unroll
        for (int i = 0; i < 4; ++i) { b[i] += excl; e[i] = li[i] - b[i]; }
        pm[0] = e[0]; pm[1] = fmaxf(pm[0], e[1]); pm[2] = fmaxf(pm[1], e[2]); pm[3] = fmaxf(pm[2], e[3]);
        float mi = pm[3];
#pragma unroll
        for (int o = 1; o < 64; o <<= 1) { const float n = __shfl_up(mi, o); if (lane >= o) mi = fmaxf(mi, n); }
        float mex = __shfl_up(mi, 1); if (lane == 0) mex = -INFINITY;
#pragma unroll
        for (int i = 0; i < 4; ++i) pm[i] = fmaxf(pm[i], mex);
        const float gtot = __shfl(incl, 63), emax = __shfl(mi, 63), mloc = gtot + emax;
        f32x4 ww;
#pragma unroll
        for (int i = 0; i < 4; ++i) ww[i] = __expf(e[i] + gtot - mloc);
        *(f32x4*)(tb + base) = (f32x4){b[0], b[1], b[2], b[3]};
        *(f32x4*)(te + base) = (f32x4){e[0], e[1], e[2], e[3]};
        *(f32x4*)(tpm + base) = (f32x4){pm[0], pm[1], pm[2], pm[3]};
        *(f32x4*)(tw + base) = ww;
        if (lane == 0) { scg[sc * 4 + h] = gtot; scm[sc * 4 + h] = mloc; }
    }
}

__device__ __forceinline__ void phase_m1(const Params& p, char* lds, int bid, int nb, int nsc) {
    const int tid = TIDX, wid = __builtin_amdgcn_readfirstlane(tid >> 6), lane = tid & 63, c = lane & 15, g = lane >> 4, gw = bid * NW + wid, ngw = nb * NW;
    const bf16_t* KMT = (const bf16_t*)(p.ws + B_KMT); const bf16_t* VMT = (const bf16_t*)(p.ws + B_VMT);
    const float* tw = (const float*)(p.ws + TAB_W); bf16_t* CT = (bf16_t*)(p.ws + B_CT); float* NTv = (float*)(p.ws + TAB_NT);
    for (int u = bid; u < nsc * 4 * 2; u += nb) {
        const int dvb = (u & 1) * 8 + wid, h = (u >> 1) & 3, sc = u >> 3, s0 = sc * 256;
        f32x4 acc[16];
#pragma unroll
        for (int i = 0; i < 16; ++i) acc[i] = (f32x4){0.f, 0.f, 0.f, 0.f};
        float un[16];
#pragma unroll
        for (int i = 0; i < 16; ++i) un[i] = 0.f;
        for (int ks = (sc == 0 ? 7 : 0); ks < 8; ++ks) {
            const int sb = s0 + 32 * ks + 8 * g;
            const f32x4 w0 = *(const f32x4*)(tw + (size_t)h * P + sb), w1 = *(const f32x4*)(tw + (size_t)h * P + sb + 4);
            const u32x4 vv = *(const u32x4*)(VMT + (size_t)(h * 256 + 16 * dvb + c) * P + sb);
            u32x4 vw; vw.x = pk2(bf2f(vv.x & 0xffffu) * w0.x, bf2f(vv.x >> 16) * w0.y); vw.y = pk2(bf2f(vv.y & 0xffffu) * w0.z, bf2f(vv.y >> 16) * w0.w);
            vw.z = pk2(bf2f(vv.z & 0xffffu) * w1.x, bf2f(vv.z >> 16) * w1.y); vw.w = pk2(bf2f(vv.w & 0xffffu) * w1.z, bf2f(vv.w >> 16) * w1.w);
            const bf16x8 vf = *(bf16x8*)&vw;
#pragma unroll
            for (int dk = 0; dk < 16; ++dk) {
                const u32x4 kk = *(const u32x4*)(KMT + (size_t)(h * 256 + 16 * dk + c) * P + sb);
                acc[dk] = mfma16(*(const bf16x8*)&kk, vf, acc[dk]);
                if (dvb == 0) un[dk] += bf2f(kk.x & 0xffffu) * w0.x + bf2f(kk.x >> 16) * w0.y + bf2f(kk.y & 0xffffu) * w0.z + bf2f(kk.y >> 16) * w0.w
                                      + bf2f(kk.z & 0xffffu) * w1.x + bf2f(kk.z >> 16) * w1.y + bf2f(kk.w & 0xffffu) * w1.z + bf2f(kk.w >> 16) * w1.w;
            }
        }
        bf16_t* dst = CT + ((size_t)(sc * 4 + h) * 256 + 16 * dvb + c) * 256;
#pragma unroll
        for (int dk = 0; dk < 16; ++dk) store4_bf16(dst + 16 * dk + 4 * g, acc[dk]);
        if (dvb == 0) {
#pragma unroll
            for (int dk = 0; dk < 16; ++dk) { float v = un[dk]; v += sx<16>(v); v = sum32(v); if (g == 0) NTv[(size_t)(sc * 4 + h) * 256 + 16 * dk + c] = v; }
        }
    }
}

namespace pg8 {
template <class F> __device__ __forceinline__ void for_each_piece_local(const f32x4 (&acc)[2][2][4][2], int wr, int wc, int fr, int fq, const F& f) {
    asm volatile("" : "+v"(fr), "+v"(fq));
    const int row0 = wr * 64 + fr, col0 = wc * 32 + 8 * fq;
#pragma unroll
    for (int ai = 0; ai < 2; ++ai)
#pragma unroll
        for (int m = 0; m < 4; ++m)
#pragma unroll
            for (int bj = 0; bj < 2; ++bj) f(row0 + ai * HALF + m * 16, col0 + bj * HALF, acc[ai][bj][m][0], acc[ai][bj][m][1]);
}
}
struct SchedM1 { const char* VWT; const char* KMT; int G, c; int K, lda, ldb;
    __device__ __forceinline__ bool next(int i, pg8::Unit& u) const { return pg8::decode_unit((long)i * G + c, 4, 64, 1, u); }
    __device__ __forceinline__ const char* abase(const pg8::Unit& u) const { return VWT + ((size_t)u.grp * 256 * P + (size_t)(u.pm + 1) * 256) * 2; }
    __device__ __forceinline__ const char* bbase(const pg8::Unit& u) const { return KMT + ((size_t)u.grp * 256 * P + (size_t)(u.pm + 1) * 256) * 2; } };
struct EpiM1 { bf16_t* CT;
    __device__ __forceinline__ void operator()(const f32x4 (&acc)[2][2][4][2], const pg8::Unit& u, int wr, int wc, int fr, int fq) const {
        bf16_t* base = CT + (size_t)((u.pm + 1) * 4 + u.grp) * 65536;
        pg8::for_each_piece_local(acc, wr, wc, fr, fq, [&](int row, int col, f32x4 v0, f32x4 v1) { *(u32x4*)(base + (size_t)row * 256 + col) = pg8::pack8(v0, v1); }); } };
__device__ __forceinline__ void phase_ms(const Params& p, char* lds, int bid, int nb) {
    phase_m1(p, lds, bid, nb, 1);
    const int tid = TIDX, wid = __builtin_amdgcn_readfirstlane(tid >> 6), lane = tid & 63, c = lane & 15, g = lane >> 4, gw = bid * NW + wid, ngw = nb * NW;
    const bf16_t* KMT = (const bf16_t*)(p.ws + B_KMT); const float* tw = (const float*)(p.ws + TAB_W); float* NTv = (float*)(p.ws + TAB_NT);
    for (int t = gw; t < 64 * 4 * 16; t += ngw) {
        const int dkb = t & 15, h = (t >> 4) & 3, sc = 1 + (t >> 6);
        const bf16_t* kr = KMT + (size_t)(h * 256 + 16 * dkb + c) * P + sc * 256 + 64 * g; const float* wp = tw + (size_t)h * P + sc * 256 + 64 * g;
        float a = 0.f;
#pragma unroll
        for (int i = 0; i < 8; ++i) { const u32x4 kk = *(const u32x4*)(kr + 8 * i); const f32x4 w0 = *(const f32x4*)(wp + 8 * i), w1 = *(const f32x4*)(wp + 8 * i + 4);
            a += bf2f(kk.x & 0xffffu) * w0.x + bf2f(kk.x >> 16) * w0.y + bf2f(kk.y & 0xffffu) * w0.z + bf2f(kk.y >> 16) * w0.w
               + bf2f(kk.z & 0xffffu) * w1.x + bf2f(kk.z >> 16) * w1.y + bf2f(kk.w & 0xffffu) * w1.z + bf2f(kk.w >> 16) * w1.w; }
        a += sx<16>(a); a = sum32(a);
        if (g == 0) NTv[(size_t)(sc * 4 + h) * 256 + 16 * dkb + c] = a;
    }
    SchedM1 S{(const char*)(p.ws + B_VWT), (const char*)KMT, nb, bid, 256, P, P};
    pg8::gemm_phase((PG8_LAS unsigned char*)lds, S, EpiM1{(bf16_t*)(p.ws + B_CT)});
}

__device__ __forceinline__ void phase_m2(const Params& p, char* lds, int bid, int nb) {
    const float* scg = (const float*)(p.ws + TAB_SCG); const float* scm = (const float*)(p.ws + TAB_SCM);
    unsigned* CT = (unsigned*)(p.ws + B_CT); float* NTv = (float*)(p.ws + TAB_NT); float* mt = (float*)(p.ws + TAB_MT);
    const int gid = bid * NT + TIDX, nth = nb * NT;
    for (int i = gid; i < 4 * 32768 + 1024; i += nth) {
        if (i < 4 * 32768) {
            const int h = i >> 15, idx = i & 32767;
            unsigned* base = CT + (size_t)h * 32768 + idx;
            unsigned u[NSC];
#pragma unroll
            for (int sc = 0; sc < NSC; ++sc) u[sc] = base[(size_t)sc * 4 * 32768];
            float m = 0.f, c0 = 0.f, c1 = 0.f;
#pragma unroll
            for (int sc = 0; sc < NSC; ++sc) {
                const float gg = scg[sc * 4 + h], ml = scm[sc * 4 + h], mn = fmaxf(gg + m, ml), dec = __expf(gg + m - mn), cor = __expf(ml - mn);
                c0 = dec * c0 + cor * bf2f(u[sc] & 0xffffu); c1 = dec * c1 + cor * bf2f(u[sc] >> 16);
                base[(size_t)sc * 4 * 32768] = pk2(c0, c1); m = mn;
            }
        } else {
            const int j = i - 4 * 32768, h = j >> 8, d = j & 255;
            float* ptr0 = NTv + (size_t)h * 256 + d;
            float un[NSC];
#pragma unroll
            for (int sc = 0; sc < NSC; ++sc) un[sc] = ptr0[(size_t)sc * 1024];
            float m = 0.f, n = 0.f;
#pragma unroll
            for (int sc = 0; sc < NSC; ++sc) {
                const float gg = scg[sc * 4 + h], ml = scm[sc * 4 + h], mn = fmaxf(gg + m, ml), dec = __expf(gg + m - mn), cor = __expf(ml - mn);
                n = dec * n + cor * un[sc]; ptr0[(size_t)sc * 1024] = n; m = mn;
                if (d == 0) mt[sc * 4 + h] = mn;
            }
        }
    }
}

__device__ __forceinline__ void phase_m3(const Params& p, int l, char* lds, int bid, int nb, bool sc0_only) {
    const int tid = TIDX, wid = __builtin_amdgcn_readfirstlane(tid >> 6), lane = tid & 63, c = lane & 15, g = lane >> 4, gw = bid * NW + wid, ngw = nb * NW;
    const bf16_t* QM = (const bf16_t*)(p.ws + B_QM); const bf16_t* KM = (const bf16_t*)(p.ws + B_KM); const bf16_t* VMT = (const bf16_t*)(p.ws + B_VMT);
    const bf16_t* CT = (const bf16_t*)(p.ws + B_CT); const float* NTv = (const float*)(p.ws + TAB_NT); const float* mt = (const float*)(p.ws + TAB_MT);
    const float* tb = (const float*)(p.ws + TAB_B); const float* te = (const float*)(p.ws + TAB_E); const float* tpm = (const float*)(p.ws + TAB_PM);
    const bf16_t* OP = (const bf16_t*)(p.ws + B_OP); bf16_t* YM = (bf16_t*)(p.ws + B_YM);
    constexpr int NRG = P / 16, RG0 = VALID0 / 16;
    const int ntask = (NRG - RG0) * 4;
    for (int u = (sc0_only ? 256 : 0) + bid; u < (sc0_only ? 260 : NSC * 4 * 2); u += nb) {
        const int half = u < NSC * 4 ? 1 : 0, uu = u < NSC * 4 ? u : u - NSC * 4, sc = (NSC - 1) - (uu >> 2), h = uu & 3, rg = sc * 16 + half * 8 + wid;
        if (rg < RG0) continue;
        const int t0 = rg * 16, row = t0 + c, s_start = sc << 8;
        bf16x8 qf[8];
#pragma unroll
        for (int ks = 0; ks < 8; ++ks) qf[ks] = ld8(QM + (size_t)row * D + h * 256 + 32 * ks + 8 * g);
        const float b_t = tb[(size_t)h * P + row], pm_t = tpm[(size_t)h * P + row];
        const float m_prev = sc > 0 ? mt[(sc - 1) * 4 + h] : 0.f;
        const float m_t = b_t + fmaxf(m_prev, pm_t), scale_t = __expf(b_t + m_prev - m_t);
        f32x4 acc[16];
#pragma unroll
        for (int i = 0; i < 16; ++i) acc[i] = (f32x4){0.f, 0.f, 0.f, 0.f};
        float den = 0.f;
        if (sc > 0) {
            const bf16_t* Cb = CT + (size_t)((sc - 1) * 4 + h) * 65536; const float* nv = NTv + (size_t)((sc - 1) * 4 + h) * 256;
#pragma unroll 2
            for (int ks = 0; ks < 8; ++ks) {
#pragma unroll
                for (int dt = 0; dt < 16; ++dt) acc[dt] = mfma16(ld8(Cb + (size_t)(16 * dt + c) * 256 + 32 * ks + 8 * g), qf[ks], acc[dt]);
                const f32x4 n0 = *(const f32x4*)(nv + 32 * ks + 8 * g), n1 = *(const f32x4*)(nv + 32 * ks + 8 * g + 4);
                const u32x4 qq = *(const u32x4*)&qf[ks];
                den += bf2f(qq.x & 0xffffu) * n0.x + bf2f(qq.x >> 16) * n0.y + bf2f(qq.y & 0xffffu) * n0.z + bf2f(qq.y >> 16) * n0.w
                     + bf2f(qq.z & 0xffffu) * n1.x + bf2f(qq.z >> 16) * n1.y + bf2f(qq.w & 0xffffu) * n1.z + bf2f(qq.w >> 16) * n1.w;
            }
            den *= scale_t;
#pragma unroll
            for (int dt = 0; dt < 16; ++dt) acc[dt] = acc[dt] * scale_t;
        }
        for (int kb = (sc == 0 ? 224 : s_start); kb <= t0 + 15; kb += 32) {
            f32x4 s[2];
#pragma unroll
            for (int a = 0; a < 2; ++a) {
                s[a] = (f32x4){0.f, 0.f, 0.f, 0.f};
                const bf16_t* kr = KM + (size_t)(kb + 16 * a + c) * D + h * 256 + 8 * g;
#pragma unroll
                for (int ks = 0; ks < 8; ++ks) s[a] = mfma16(ld8(kr + 32 * ks), qf[ks], s[a]);
                const f32x4 ee = *(const f32x4*)(te + (size_t)h * P + kb + 16 * a + 4 * g);
#pragma unroll
                for (int r = 0; r < 4; ++r) { const int key = kb + 16 * a + 4 * g + r; const float arg = fminf(ee[r] + b_t - m_t, 0.f);
                    const float dd = key <= row ? __expf(arg) : 0.f; const float pv = s[a][r] * dd; s[a][r] = pv; den += pv; }
            }
            u32x4 w; w.x = pk2(s[0][0], s[0][1]); w.y = pk2(s[0][2], s[0][3]); w.z = pk2(s[1][0], s[1][1]); w.w = pk2(s[1][2], s[1][3]);
            const bf16x8 pf = *(bf16x8*)&w;
#pragma unroll
            for (int dt = 0; dt < 16; ++dt) {
                const bf16_t* vr = VMT + (size_t)(h * 256 + 16 * dt + c) * P + kb + 4 * g;
                const u32x2 v0 = *(const u32x2*)vr, v1 = *(const u32x2*)(vr + 16);
                u32x4 vv; vv.x = v0.x; vv.y = v0.y; vv.z = v1.x; vv.w = v1.y;
                acc[dt] = mfma16(*(bf16x8*)&vv, pf, acc[dt]);
            }
        }
        den += sx<16>(den); den = sum32(den);
        const float inv = 1.f / fmaxf(fabsf(den), __expf(-m_t));
        float s1 = 0.f;
#pragma unroll
        for (int dt = 0; dt < 16; ++dt) {
            const u32x2 og = *(const u32x2*)(OP + (size_t)row * D + h * 256 + 16 * dt + 4 * g);
            f32x4 v = acc[dt] * inv;
            v.x *= sigmoidf_(bf2f(og.x & 0xffffu)); v.y *= sigmoidf_(bf2f(og.x >> 16)); v.z *= sigmoidf_(bf2f(og.y & 0xffffu)); v.w *= sigmoidf_(bf2f(og.y >> 16));
            acc[dt] = v; s1 += (v.x + v.y) + (v.z + v.w);
        }
        s1 += sx<16>(s1); s1 = sum32(s1);
        const float mu = s1 * (1.f / 256.f);
        float s2 = 0.f;
#pragma unroll
        for (int dt = 0; dt < 16; ++dt) { acc[dt] = acc[dt] - mu; s2 += (acc[dt].x * acc[dt].x + acc[dt].y * acc[dt].y) + (acc[dt].z * acc[dt].z + acc[dt].w * acc[dt].w); }
        s2 += sx<16>(s2); s2 = sum32(s2);
        const float rstd = rsqrtf(s2 * (1.f / 256.f) + LN_EPS);
#pragma unroll
        for (int dt = 0; dt < 16; ++dt) { const f32x4 gg = *(const f32x4*)(p.in[I_MNG] + (size_t)l * D + h * 256 + 16 * dt + 4 * g);
            store4_bf16(YM + (size_t)row * D + h * 256 + 16 * dt + 4 * g, acc[dt] * rstd * gg); }
    }
}

struct EpiBr1 { float* MRG; const bf16_t* GA;
    __device__ __forceinline__ void operator()(int m, int n, f32x4 v) const { const u32x2 gg = *(const u32x2*)(GA + (size_t)m * D + n);
        f32x4 o; o.x = v.x * sigmoidf_(bf2f(gg.x & 0xffffu)); o.y = v.y * sigmoidf_(bf2f(gg.x >> 16)); o.z = v.z * sigmoidf_(bf2f(gg.y & 0xffffu)); o.w = v.w * sigmoidf_(bf2f(gg.y >> 16));
        *(f32x4*)(MRG + (size_t)m * D + n) = o; } };
struct EpiBr2 { const float* MRG; const bf16_t* GB; bf16_t* OUT;
    __device__ __forceinline__ void operator()(int m, int n, f32x4 v) const { const u32x2 gg = *(const u32x2*)(GB + (size_t)m * D + n); const f32x4 t = *(const f32x4*)(MRG + (size_t)m * D + n);
        f32x4 o; o.x = t.x + v.x * sigmoidf_(bf2f(gg.x & 0xffffu)); o.y = t.y + v.y * sigmoidf_(bf2f(gg.x >> 16)); o.z = t.z + v.z * sigmoidf_(bf2f(gg.y & 0xffffu)); o.w = t.w + v.w * sigmoidf_(bf2f(gg.y >> 16));
        store4_bf16(OUT + (size_t)m * D + n, o); } };
struct EpiOut { float* Z; const bf16_t* H;
    __device__ __forceinline__ void operator()(int m, int n, f32x4 v) const { const u32x2 hh = *(const u32x2*)(H + (size_t)m * D + n);
        f32x4 o; o.x = v.x + DN_ALPHA * bf2f(hh.x & 0xffffu); o.y = v.y + DN_ALPHA * bf2f(hh.x >> 16); o.z = v.z + DN_ALPHA * bf2f(hh.y & 0xffffu); o.w = v.w + DN_ALPHA * bf2f(hh.y >> 16);
        *(f32x4*)(Z + (size_t)m * D + n) = o; } };
constexpr int LDS_TAB_OFF = 131072;
constexpr int LDS_MT_OFF = LDS_TAB_OFF + 256;
constexpr int LDS_STAT_OFF = LDS_TAB_OFF + 2048;
__device__ __forceinline__ void compute_mtab_lds(const Params& p, char* lds) {
    float* mt = (float*)(lds + LDS_MT_OFF); float* tmp = (float*)(lds + LDS_STAT_OFF);
    const int t = TIDX;
    if (t < NSC * 4) { tmp[t] = ((const float*)(p.ws + TAB_SCG))[t]; tmp[NSC * 4 + t] = ((const float*)(p.ws + TAB_SCM))[t]; }
    __syncthreads();
    if (t < 4) { float m = 0.f;
        for (int sc = 0; sc < NSC; ++sc) { m = fmaxf(tmp[sc * 4 + t] + m, tmp[NSC * 4 + sc * 4 + t]); mt[sc * 4 + t] = m; } }
    __syncthreads();
}
struct SchedQK { const char* A; const char* B; int G, c; int K, lda, ldb;
    __device__ __forceinline__ bool next(int i, pg8::Unit& u) const { if (!pg8::decode_unit((long)i * G + c, 4, 64, 1, u)) return false; u.pm += 1; return true; }
    __device__ __forceinline__ const char* abase(const pg8::Unit& u) const { return A + ((size_t)u.pm * 256 * D + u.grp * 256) * 2; }
    __device__ __forceinline__ const char* bbase(const pg8::Unit& u) const { return B + ((size_t)u.pm * 256 * D + u.grp * 256) * 2; } };
struct EpiS { unsigned char* ws; const float* mt_lds;
    __device__ __forceinline__ void operator()(const f32x4 (&acc)[2][2][4][2], const pg8::Unit& u, int wr, int wc, int fr, int fq) const {
        asm volatile("" : "+v"(fr), "+v"(fq));
        const int h = u.grp, t0 = u.pm * 256; const float m_prev = mt_lds[(u.pm - 1) * 4 + h];
        const float* te = (const float*)(ws + TAB_E) + (size_t)h * P + t0; const float* tpm = (const float*)(ws + TAB_PM) + (size_t)h * P + t0;
        bf16_t* PMb = (bf16_t*)(ws + B_PM) + (size_t)t0 * D + h * 256; float* denp = (float*)(ws + TAB_DENP);
        const int c0 = wc * 32 + 8 * fq;
        f32x4 e[2][2];
#pragma unroll
        for (int bj = 0; bj < 2; ++bj) { e[bj][0] = *(const f32x4*)(te + c0 + bj * 128); e[bj][1] = *(const f32x4*)(te + c0 + bj * 128 + 4); }
#pragma unroll
        for (int ai = 0; ai < 2; ++ai)
#pragma unroll
            for (int m = 0; m < 4; ++m) { const int r = ai * 128 + wr * 64 + m * 16 + fr; const float pmx = fmaxf(m_prev, tpm[r]); float rs = 0.f;
#pragma unroll
                for (int bj = 0; bj < 2; ++bj) { f32x4 o0, o1;
#pragma unroll
                    for (int j = 0; j < 4; ++j) { const int s0 = c0 + bj * 128 + j, s1 = s0 + 4;
                        o0[j] = s0 <= r ? acc[ai][bj][m][0][j] * __expf(fminf(e[bj][0][j] - pmx, 0.f)) : 0.f;
                        o1[j] = s1 <= r ? acc[ai][bj][m][1][j] * __expf(fminf(e[bj][1][j] - pmx, 0.f)) : 0.f;
                        rs += o0[j] + o1[j]; }
                    *(u32x4*)(PMb + (size_t)r * D + c0 + bj * 128) = pg8::pack8(o0, o1); }
                rs += sx<16>(rs); rs = sum32(rs);
                if (fq == 0) denp[((size_t)(t0 + r) * 4 + h) * 4 + wc] = rs; } } };
struct SchedO1 { const char* A; const char* B; int G, c; int K, lda, ldb;
    __device__ __forceinline__ bool next(int i, pg8::Unit& u) const { if (!pg8::decode_unit((long)i * G + c, 4, 64, 1, u)) return false; u.pm += 1; return true; }
    __device__ __forceinline__ const char* abase(const pg8::Unit& u) const { return A + ((size_t)u.pm * 256 * D + u.grp * 256) * 2; }
    __device__ __forceinline__ const char* bbase(const pg8::Unit& u) const { return B + (size_t)((u.pm - 1) * 4 + u.grp) * 65536 * 2; } };
struct EpiO1 { unsigned char* ws;
    __device__ __forceinline__ void operator()(const f32x4 (&acc)[2][2][4][2], const pg8::Unit& u, int wr, int wc, int fr, int fq) const {
        asm volatile("" : "+v"(fr), "+v"(fq));
        const int h = u.grp, t0 = u.pm * 256; const float m_prev = ((const float*)(ws + TAB_MT))[(u.pm - 1) * 4 + h];
        const float* tpm = (const float*)(ws + TAB_PM) + (size_t)h * P + t0; bf16_t* OI = (bf16_t*)(ws + B_OI) + (size_t)t0 * D + h * 256;
        const int c0 = wc * 32 + 8 * fq;
#pragma unroll
        for (int ai = 0; ai < 2; ++ai)
#pragma unroll
            for (int m = 0; m < 4; ++m) { const int r = ai * 128 + wr * 64 + m * 16 + fr; const float sc = __expf(fminf(m_prev - tpm[r], 0.f));
#pragma unroll
                for (int bj = 0; bj < 2; ++bj) *(u32x4*)(OI + (size_t)r * D + c0 + bj * 128) = pg8::pack8(acc[ai][bj][m][0] * sc, acc[ai][bj][m][1] * sc); } } };
struct SchedO2 { const char* A; const char* B; int G, c; int K, lda, ldb;
    __device__ __forceinline__ bool next(int i, pg8::Unit& u) const { if (!pg8::decode_unit((long)i * G + c, 4, 64, 1, u)) return false; u.pm += 1; return true; }
    __device__ __forceinline__ const char* abase(const pg8::Unit& u) const { return A + ((size_t)u.pm * 256 * D + u.grp * 256) * 2; }
    __device__ __forceinline__ const char* bbase(const pg8::Unit& u) const { return B + ((size_t)u.grp * 256 * P + (size_t)u.pm * 256) * 2; } };
struct EpiO2 { unsigned char* ws; const float* mng; float* stat;
    __device__ __forceinline__ void operator()(f32x4 (&acc)[2][2][4][2], const pg8::Unit& u, int wr, int wc, int fr, int fq) const {
        asm volatile("" : "+v"(fr), "+v"(fq));
        const int h = u.grp, t0 = u.pm * 256; const float m_prev = ((const float*)(ws + TAB_MT))[(u.pm - 1) * 4 + h];
        const float* tpm = (const float*)(ws + TAB_PM) + (size_t)h * P + t0; const float* tb = (const float*)(ws + TAB_B) + (size_t)h * P + t0;
        const float* denp = (const float*)(ws + TAB_DENP); const float* deni = (const float*)(ws + TAB_DENI);
        const bf16_t* OI = (const bf16_t*)(ws + B_OI) + (size_t)t0 * D + h * 256; const bf16_t* OP = (const bf16_t*)(ws + B_OP) + (size_t)t0 * D + h * 256;
        bf16_t* YM = (bf16_t*)(ws + B_YM) + (size_t)t0 * D + h * 256;
        const int c0 = wc * 32 + 8 * fq;
#pragma unroll
        for (int ai = 0; ai < 2; ++ai)
#pragma unroll
            for (int m = 0; m < 4; ++m) { const int r = ai * 128 + wr * 64 + m * 16 + fr;
                const f32x4 dp = *(const f32x4*)(denp + ((size_t)(t0 + r) * 4 + h) * 4); const float den = (dp.x + dp.y) + (dp.z + dp.w) + deni[(size_t)(t0 + r) * 4 + h];
                const float m_t = tb[r] + fmaxf(m_prev, tpm[r]); const float inv = 1.f / fmaxf(fabsf(den), __expf(-m_t));
                float s1 = 0.f, s2 = 0.f;
#pragma unroll
                for (int bj = 0; bj < 2; ++bj) { f32x4 i0, i1, g0, g1; pg8::unpack8(*(const u32x4*)(OI + (size_t)r * D + c0 + bj * 128), i0, i1); pg8::unpack8(*(const u32x4*)(OP + (size_t)r * D + c0 + bj * 128), g0, g1);
                    f32x4 v0 = (acc[ai][bj][m][0] + i0) * inv * sig4(g0), v1 = (acc[ai][bj][m][1] + i1) * inv * sig4(g1);
                    acc[ai][bj][m][0] = v0; acc[ai][bj][m][1] = v1;
                    s1 += (v0.x + v0.y) + (v0.z + v0.w) + (v1.x + v1.y) + (v1.z + v1.w);
                    s2 += (v0.x * v0.x + v0.y * v0.y) + (v0.z * v0.z + v0.w * v0.w) + (v1.x * v1.x + v1.y * v1.y) + (v1.z * v1.z + v1.w * v1.w); }
                s1 += sx<16>(s1); s1 = sum32(s1); s2 += sx<16>(s2); s2 = sum32(s2);
                if (fq == 0) { stat[(r * 4 + wc) * 2] = s1; stat[(r * 4 + wc) * 2 + 1] = s2; } }
        asm volatile("s_waitcnt lgkmcnt(0)" ::: "memory"); __builtin_amdgcn_s_barrier(); asm volatile("" ::: "memory");
#pragma unroll
        for (int ai = 0; ai < 2; ++ai)
#pragma unroll
            for (int m = 0; m < 4; ++m) { const int r = ai * 128 + wr * 64 + m * 16 + fr;
                const f32x4 a = *(const f32x4*)(stat + r * 8), b = *(const f32x4*)(stat + r * 8 + 4);
                const float mu = ((a.x + a.z) + (b.x + b.z)) * (1.f / 256.f), ex2 = ((a.y + a.w) + (b.y + b.w)) * (1.f / 256.f);
                const float rstd = rsqrtf(fmaxf(ex2 - mu * mu, 0.f) + LN_EPS);
#pragma unroll
                for (int bj = 0; bj < 2; ++bj) { const f32x4 g0 = *(const f32x4*)(mng + h * 256 + c0 + bj * 128), g1 = *(const f32x4*)(mng + h * 256 + c0 + bj * 128 + 4);
                    *(u32x4*)(YM + (size_t)r * D + c0 + bj * 128) = pg8::pack8((acc[ai][bj][m][0] - mu) * rstd * g0, (acc[ai][bj][m][1] - mu) * rstd * g1); } } } };
__device__ __forceinline__ void phase_o1(const Params& p, char* lds, int bid, int nb) {
    const int tid = TIDX, wid = __builtin_amdgcn_readfirstlane(tid >> 6), lane = tid & 63, c = lane & 15, g = lane >> 4, gw = bid * NW + wid, ngw = nb * NW;
    const bf16_t* QM = (const bf16_t*)(p.ws + B_QM); const float* NTv = (const float*)(p.ws + TAB_NT); const float* mt = (const float*)(p.ws + TAB_MT);
    const float* tpm = (const float*)(p.ws + TAB_PM); float* deni = (float*)(p.ws + TAB_DENI);
    for (int it = gw; it < ((P - 256) / 16) * 4; it += ngw) {
        const int h = it & 3, t = 256 + (it >> 2) * 16 + c, sc = t >> 8;
        const bf16_t* qr = QM + (size_t)t * D + h * 256 + 64 * g; const float* nv = NTv + (size_t)((sc - 1) * 4 + h) * 256 + 64 * g;
        float a = 0.f;
#pragma unroll
        for (int i = 0; i < 8; ++i) { const u32x4 qq = *(const u32x4*)(qr + 8 * i); const f32x4 n0 = *(const f32x4*)(nv + 8 * i), n1 = *(const f32x4*)(nv + 8 * i + 4);
            a += bf2f(qq.x & 0xffffu) * n0.x + bf2f(qq.x >> 16) * n0.y + bf2f(qq.y & 0xffffu) * n0.z + bf2f(qq.y >> 16) * n0.w
               + bf2f(qq.z & 0xffffu) * n1.x + bf2f(qq.z >> 16) * n1.y + bf2f(qq.w & 0xffffu) * n1.z + bf2f(qq.w >> 16) * n1.w; }
        a += sx<16>(a); a = sum32(a);
        if (g == 0) deni[(size_t)t * 4 + h] = a * __expf(fminf(mt[(sc - 1) * 4 + h] - tpm[(size_t)h * P + t], 0.f));
    }
    SchedO1 S{(const char*)QM, (const char*)(p.ws + B_CT), nb, bid, 256, D, 256};
    pg8::gemm_phase((PG8_LAS unsigned char*)lds, S, EpiO1{p.ws});
}
__device__ __forceinline__ void phase_sg(const Params& p, char* lds, int bid, int nb) {
    compute_mtab_lds(p, lds);
    SchedQK S{(const char*)(p.ws + B_QM), (const char*)(p.ws + B_KM), nb, bid, 256, D, D};
    pg8::gemm_phase((PG8_LAS unsigned char*)lds, S, EpiS{p.ws, (const float*)(lds + LDS_MT_OFF)});
}
__device__ __forceinline__ void phase_o2(const Params& p, int l, char* lds, int bid, int nb) {
    phase_m3(p, l, lds, bid, nb, true);
    SchedO2 S{(const char*)(p.ws + B_PM), (const char*)(p.ws + B_VMT), nb, bid, 256, D, P};
    pg8::gemm_phase((PG8_LAS unsigned char*)lds, S, EpiO2{p.ws, p.in[I_MNG] + (size_t)l * D, (float*)(lds + LDS_STAT_OFF)});
}

struct SchedMqkvN { const char* XC; const char* WQ; const char* WK; int G, c; int K, lda, ldb;
    __device__ __forceinline__ bool next(int i, pg8::Unit& u) const { if (!pg8::decode_unit((long)i * G + c, 8, 64, 1, u)) return false; u.pm += 1; return true; }
    __device__ __forceinline__ const char* abase(const pg8::Unit& u) const { return XC + (size_t)(u.grp & 3) * 512 + (size_t)u.pm * 256 * D * 2; }
    __device__ __forceinline__ const char* bbase(const pg8::Unit& u) const { return ((u.grp >> 2) ? WK : WQ) + (size_t)(u.grp & 3) * 65536 * 2; } };
struct SchedMqkvT { const char* XC; const char* XM; const char* WK; const char* WV; int G, c; int K, lda, ldb;
    __device__ __forceinline__ bool next(int i, pg8::Unit& u) const { if (!pg8::decode_unit((long)i * G + c, 8, 1, 64, u)) return false; u.pn += 1; return true; }
    __device__ __forceinline__ const char* abase(const pg8::Unit& u) const { return ((u.grp >> 2) ? WV : WK) + (size_t)(u.grp & 3) * 65536 * 2; }
    __device__ __forceinline__ const char* bbase(const pg8::Unit& u) const { return ((u.grp >> 2) ? XM : XC) + (size_t)(u.grp & 3) * 512 + (size_t)u.pn * 256 * D * 2; } };
struct EpiGrpF { bf16_t* base0; bf16_t* base1; size_t hstride; size_t ldc; float s0, s1;
    __device__ __forceinline__ void operator()(const f32x4 (&acc)[2][2][4][2], const pg8::Unit& u, int wr, int wc, int fr, int fq) const {
        const int which = u.grp >> 2, h = u.grp & 3; const float sc = which ? s1 : s0;
        bf16_t* base = (which ? base1 : base0) + (size_t)h * hstride + (size_t)u.pn * 256;
        const size_t ld = ldc;
        pg8::for_each_piece(acc, u, wr, wc, fr, fq, [&](int row, int col, f32x4 v0, f32x4 v1) { *(u32x4*)(base + (size_t)row * ld + col) = pg8::pack8(v0 * sc, v1 * sc); }); } };
struct EpiMqkvT { unsigned char* ws;
    __device__ __forceinline__ void operator()(const f32x4 (&acc)[2][2][4][2], const pg8::Unit& u, int wr, int wc, int fr, int fq) const {
        bf16_t* KMT = (bf16_t*)(ws + B_KMT); bf16_t* VMT = (bf16_t*)(ws + B_VMT); bf16_t* VWT = (bf16_t*)(ws + B_VWT); const float* tw = (const float*)(ws + TAB_W);
        const int which = u.grp >> 2, h = u.grp & 3; const size_t cb = (size_t)u.pn * 256;
        if (which == 0) { bf16_t* base = KMT + (size_t)h * 256 * P + cb;
            pg8::for_each_piece(acc, u, wr, wc, fr, fq, [&](int row, int col, f32x4 v0, f32x4 v1) { *(u32x4*)(base + (size_t)row * P + col) = pg8::pack8(v0 * 0.0625f, v1 * 0.0625f); });
        } else { bf16_t* b0 = VMT + (size_t)h * 256 * P + cb; bf16_t* b1 = VWT + (size_t)h * 256 * P + cb; const float* w = tw + (size_t)h * P + cb;
            pg8::for_each_piece(acc, u, wr, wc, fr, fq, [&](int row, int col, f32x4 v0, f32x4 v1) { const f32x4 w0 = *(const f32x4*)(w + col), w1 = *(const f32x4*)(w + col + 4);
                *(u32x4*)(b0 + (size_t)row * P + col) = pg8::pack8(v0, v1); *(u32x4*)(b1 + (size_t)row * P + col) = pg8::pack8(v0 * w0, v1 * w1); }); } } };
struct EpiStoreW { bf16_t* C0; bf16_t* C1; size_t ldc; const float* w;
    __device__ __forceinline__ void operator()(int m, int n, f32x4 v) const { store4_bf16(C0 + (size_t)m * ldc + n, v); const f32x4 ww = *(const f32x4*)(w + n); store4_bf16(C1 + (size_t)m * ldc + n, v * ww); } };
__device__ __forceinline__ void phase_mqkv_f(const Params& p, char* lds, int bid, int nb) {
    const int tid = TIDX, wid = tid >> 6, gw = bid * NW + wid, ngw = nb * NW;
    const bf16_t* XC = (const bf16_t*)(p.ws + B_XC); const bf16_t* XM = (const bf16_t*)(p.ws + B_XM);
    const bf16_t* WQ = (const bf16_t*)(p.ws + W_Q_T); const bf16_t* WK = (const bf16_t*)(p.ws + W_K_T); const bf16_t* WV = (const bf16_t*)(p.ws + W_V_T);
    bf16_t* QM = (bf16_t*)(p.ws + B_QM); bf16_t* KM = (bf16_t*)(p.ws + B_KM); bf16_t* KMT = (bf16_t*)(p.ws + B_KMT); bf16_t* VMT = (bf16_t*)(p.ws + B_VMT); bf16_t* VWT = (bf16_t*)(p.ws + B_VWT);
    zero_block(KM, D, VALID0, D, bid * NT + tid, nb * NT);
    zero_block(VWT, P, D, VALID0, bid * NT + tid, nb * NT);
    zero_block(KMT, P, D, VALID0, bid * NT + tid, nb * NT);
    zero_block(VMT, P, D, VALID0, bid * NT + tid, nb * NT);
    for (int t = bid; t < 64; t += nb) {
        const int which = (t >> 4) & 1, h = (t >> 2) & 3, q = t & 3;
        if (t < 32) meta_gemm<1, 4>(RowsPlain{XC + h * 256, D}, RowsPlain{(which ? WK : WQ) + (size_t)h * 65536, 256}, 256, VALID0, q * 64, EpiStore{(which ? KM : QM) + h * 256, D, which ? 0.0625f : 1.f}, lds);
        else if (which == 0) meta_gemm<4, 1>(RowsPlain{WK + (size_t)h * 65536, 256}, RowsPlain{XC + h * 256, D}, 256, q * 64, VALID0, EpiStore{KMT + (size_t)h * 256 * P, P, 0.0625f}, lds);
        else meta_gemm<4, 1>(RowsPlain{WV + (size_t)h * 65536, 256}, RowsPlain{XM + h * 256, D}, 256, q * 64, VALID0, EpiStoreW{VMT + (size_t)h * 256 * P, VWT + (size_t)h * 256 * P, P, (const float*)(p.ws + TAB_W) + (size_t)h * P}, lds);
    }
    { SchedMqkvN S{(const char*)XC, (const char*)WQ, (const char*)WK, nb, bid, 256, D, 256};
      pg8::gemm_phase((PG8_LAS unsigned char*)lds, S, EpiGrpF{QM, KM, 256, D, 1.f, 0.0625f}); }
    { SchedMqkvT S{(const char*)XC, (const char*)XM, (const char*)WK, (const char*)WV, nb, bid, 256, 256, D};
      pg8::gemm_phase((PG8_LAS unsigned char*)lds, S, EpiMqkvT{p.ws}); }
}
struct SchedSq { const char* A; const char* B; int G, c; int K, lda, ldb;
    __device__ __forceinline__ bool next(int i, pg8::Unit& u) const { if (!pg8::decode_unit((long)i * G + c, 1, 64, 4, u)) return false; u.pm += 1; return true; }
    __device__ __forceinline__ const char* abase(const pg8::Unit& u) const { return A + (size_t)u.pm * 256 * D * 2; }
    __device__ __forceinline__ const char* bbase(const pg8::Unit& u) const { return B + (size_t)u.pn * 256 * D * 2; } };
struct EpiBr1F { float* MRG; const bf16_t* GA;
    __device__ __forceinline__ void operator()(const f32x4 (&acc)[2][2][4][2], const pg8::Unit& u, int wr, int wc, int fr, int fq) const {
        const int cb = u.pn * 256;
        pg8::for_each_piece(acc, u, wr, wc, fr, fq, [&](int row, int col, f32x4 v0, f32x4 v1) { const size_t idx = (size_t)row * D + cb + col;
            f32x4 g0, g1; pg8::unpack8(*(const u32x4*)(GA + idx), g0, g1);
            *(f32x4*)(MRG + idx) = v0 * sig4(g0); *(f32x4*)(MRG + idx + 4) = v1 * sig4(g1); }); } };
struct EpiBr2F { const float* MRG; const bf16_t* GB; bf16_t* OUT;
    __device__ __forceinline__ void operator()(const f32x4 (&acc)[2][2][4][2], const pg8::Unit& u, int wr, int wc, int fr, int fq) const {
        const int cb = u.pn * 256;
        pg8::for_each_piece(acc, u, wr, wc, fr, fq, [&](int row, int col, f32x4 v0, f32x4 v1) { const size_t idx = (size_t)row * D + cb + col;
            f32x4 g0, g1; pg8::unpack8(*(const u32x4*)(GB + idx), g0, g1);
            const f32x4 t0 = *(const f32x4*)(MRG + idx), t1 = *(const f32x4*)(MRG + idx + 4);
            *(u32x4*)(OUT + idx) = pg8::pack8(t0 + v0 * sig4(g0), t1 + v1 * sig4(g1)); }); } };
struct EpiOutF { float* Z; const bf16_t* H;
    __device__ __forceinline__ void operator()(const f32x4 (&acc)[2][2][4][2], const pg8::Unit& u, int wr, int wc, int fr, int fq) const {
        const int cb = u.pn * 256;
        pg8::for_each_piece(acc, u, wr, wc, fr, fq, [&](int row, int col, f32x4 v0, f32x4 v1) { const size_t idx = (size_t)row * D + cb + col;
            f32x4 h0, h1; pg8::unpack8(*(const u32x4*)(H + idx), h0, h1);
            *(f32x4*)(Z + idx) = v0 + h0 * DN_ALPHA; *(f32x4*)(Z + idx + 4) = v1 + h1 * DN_ALPHA; }); } };
struct SchedBr { const char* YM; const char* YA; const char* WM; const char* WA; int G, c; int K, lda, ldb;
    __device__ __forceinline__ bool next(int i, pg8::Unit& u) const { if (!pg8::decode_unit((long)(i >> 1) * G + c, 1, 64, 4, u)) return false; u.pm += 1; u.grp = i & 1; return true; }
    __device__ __forceinline__ const char* abase(const pg8::Unit& u) const { return (u.grp ? YA : YM) + (size_t)u.pm * 256 * D * 2; }
    __device__ __forceinline__ const char* bbase(const pg8::Unit& u) const { return (u.grp ? WA : WM) + (size_t)u.pn * 256 * D * 2; } };
__device__ __forceinline__ u32x4 ld16_agent(const bf16_t* ptr) {
    const unsigned long long a = __hip_atomic_load((const unsigned long long*)ptr, __ATOMIC_RELAXED, __HIP_MEMORY_SCOPE_AGENT), b = __hip_atomic_load((const unsigned long long*)ptr + 1, __ATOMIC_RELAXED, __HIP_MEMORY_SCOPE_AGENT);
    u32x4 r; r.x = (unsigned)a; r.y = (unsigned)(a >> 32); r.z = (unsigned)b; r.w = (unsigned)(b >> 32); return r; }
struct EpiBrF { unsigned char* ws;
    __device__ __forceinline__ void operator()(const f32x4 (&acc)[2][2][4][2], const pg8::Unit& u, int wr, int wc, int fr, int fq) const {
        const int cb = u.pn * 256; const bf16_t* G = (const bf16_t*)(ws + (u.grp ? B_GB : B_GA)); bf16_t* O = (bf16_t*)(ws + B_MRGB); const bool second = u.grp != 0;
        pg8::for_each_piece(acc, u, wr, wc, fr, fq, [&](int row, int col, f32x4 v0, f32x4 v1) { const size_t idx = (size_t)row * D + cb + col;
            f32x4 g0, g1; pg8::unpack8(*(const u32x4*)(G + idx), g0, g1);
            f32x4 r0 = v0 * sig4(g0), r1 = v1 * sig4(g1);
            if (second) { f32x4 t0, t1; pg8::unpack8(ld16_agent(O + idx), t0, t1); r0 += t0; r1 += t1; }
            *(u32x4*)(O + idx) = pg8::pack8(r0, r1); }); } };
struct EpiBrS { const bf16_t* G; bf16_t* O; bool second;
    __device__ __forceinline__ void operator()(int m, int n, f32x4 v) const { const u32x2 gg = *(const u32x2*)(G + (size_t)m * D + n);
        f32x4 o; o.x = v.x * sigmoidf_(bf2f(gg.x & 0xffffu)); o.y = v.y * sigmoidf_(bf2f(gg.x >> 16)); o.z = v.z * sigmoidf_(bf2f(gg.y & 0xffffu)); o.w = v.w * sigmoidf_(bf2f(gg.y >> 16));
        if (second) { const unsigned long long t = __hip_atomic_load((const unsigned long long*)(O + (size_t)m * D + n), __ATOMIC_RELAXED, __HIP_MEMORY_SCOPE_AGENT);
            o.x += bf2f((unsigned)t & 0xffffu); o.y += bf2f(((unsigned)t) >> 16); o.z += bf2f((unsigned)(t >> 32) & 0xffffu); o.w += bf2f((unsigned)(t >> 48)); }
        store4_bf16(O + (size_t)m * D + n, o); } };
__device__ __forceinline__ void phase_br_f(const Params& p, char* lds, int bid, int nb) {
    const bf16_t* YM = (const bf16_t*)(p.ws + B_YM); const bf16_t* YA = (const bf16_t*)(p.ws + B_YA);
    const bf16_t* WM = (const bf16_t*)(p.ws + W_BM_T); const bf16_t* WA = (const bf16_t*)(p.ws + W_BA_T); bf16_t* O = (bf16_t*)(p.ws + B_MRGB);
    for (int t = bid; t < 16; t += nb) {
        meta_gemm<1, 4>(RowsPlain{YM, D}, RowsPlain{WM, D}, D, VALID0, t * 64, EpiBrS{(const bf16_t*)(p.ws + B_GA), O, false}, lds);
        asm volatile("s_waitcnt vmcnt(0)" ::: "memory");
        meta_gemm<1, 4>(RowsPlain{YA, D}, RowsPlain{WA, D}, D, VALID0, t * 64, EpiBrS{(const bf16_t*)(p.ws + B_GB), O, true}, lds);
    }
    SchedBr S{(const char*)YM, (const char*)YA, (const char*)WM, (const char*)WA, nb, bid, D, D, D};
    pg8::gemm_phase((PG8_LAS unsigned char*)lds, S, EpiBrF{p.ws});
}
__device__ __forceinline__ void phase_out_f(const Params& p, char* lds, int bid, int nb) {
    const int gw = bid * NW + (TIDX >> 6), ngw = nb * NW;
    const bf16_t* A = (const bf16_t*)(p.ws + B_MRGB); const bf16_t* W = (const bf16_t*)(p.ws + W_OUT_T);
    for (int t = bid; t < 16; t += nb) meta_gemm<1, 4>(RowsPlain{A, D}, RowsPlain{W, D}, D, VALID0, t * 64, EpiOut{(float*)(p.ws + B_Z), (const bf16_t*)(p.ws + B_H)}, lds);
    SchedSq S{(const char*)A, (const char*)W, nb, bid, D, D, D};
    pg8::gemm_phase((PG8_LAS unsigned char*)lds, S, EpiOutF{(float*)(p.ws + B_Z), (const bf16_t*)(p.ws + B_H)});
}

__device__ __forceinline__ void phase_ln1(const Params& p, int l, char* lds, int bid, int nb) {
    const int tid = TIDX, wid = tid >> 6, lane = tid & 63, gw = bid * NW + wid, ngw = nb * NW;
    float* wr = (float*)lds;
    for (int i = tid; i < D * 16 / 4; i += NT) ((f32x4*)wr)[i] = ((const f32x4*)p.in[I_WR])[i];
    unsigned* lcnt = (unsigned*)(lds + 65536); unsigned* lbase = lcnt + 16; int* lrow = (int*)(lds + 65536 + 256) + wid * 64;
    if (tid < 16) lcnt[tid] = 0u;
    __syncthreads();
    const float* Z = (const float*)(p.ws + B_Z); bf16_t* H1 = (bf16_t*)(p.ws + B_H1);
    unsigned* cnt = (unsigned*)(p.ws + WS_CTL) + CW_CNT + l * 16; float* topk = (float*)(p.ws + TAB_TOPK);
    int nrow = 0;
    f32x4 vn[4];
    if (gw < P) {
#pragma unroll
        for (int j = 0; j < 4; ++j) vn[j] = *(const f32x4*)(Z + (size_t)gw * D + 4 * lane + 256 * j); }
    for (int r = gw; r < P; r += ngw) {
        f32x4 v[4];
#pragma unroll
        for (int j = 0; j < 4; ++j) v[j] = vn[j];
        if (r + ngw < P) {
#pragma unroll
            for (int j = 0; j < 4; ++j) vn[j] = *(const f32x4*)(Z + (size_t)(r + ngw) * D + 4 * lane + 256 * j); }
        if (r < VALID0) { store_row_zero(H1 + (size_t)r * D, lane); continue; }
        ln_normalize(v, p.in[I_LN1G] + (size_t)l * D, p.in[I_LN1B] + (size_t)l * D, lane);
        store_row_bf16(H1 + (size_t)r * D, v, lane);
        float lg[16];
#pragma unroll
        for (int e = 0; e < 16; ++e) lg[e] = 0.f;
#pragma unroll
        for (int j = 0; j < 4; ++j)
#pragma unroll
            for (int i = 0; i < 4; ++i) { const int k = 4 * lane + 256 * j + i; const float x = v[j][i];
#pragma unroll
                for (int q = 0; q < 4; ++q) { const f32x4 w = *(const f32x4*)(wr + k * 16 + 4 * q); lg[4 * q] += x * w.x; lg[4 * q + 1] += x * w.y; lg[4 * q + 2] += x * w.z; lg[4 * q + 3] += x * w.w; } }
#pragma unroll
        for (int e = 0; e < 16; ++e) lg[e] = wave_sum(lg[e]);
        if (lane == 0) {
            float mx = lg[0];
#pragma unroll
            for (int e = 1; e < 16; ++e) mx = fmaxf(mx, lg[e]);
            float pr[16], sum = 0.f;
#pragma unroll
            for (int e = 0; e < 16; ++e) { pr[e] = expf(lg[e] - mx); sum += pr[e]; }
            const float isum = 1.f / sum;
            float sel[16];
#pragma unroll
            for (int e = 0; e < 16; ++e) { pr[e] *= isum; sel[e] = pr[e] + p.in[I_RB][e]; }
            int tg = 0; float best = -INFINITY;
#pragma unroll
            for (int gI = 0; gI < 4; ++gI) { const float gs = fmaxf(fmaxf(sel[4 * gI], sel[4 * gI + 1]), fmaxf(sel[4 * gI + 2], sel[4 * gI + 3])); if (gs > best) { best = gs; tg = gI; } }
            int i0 = 0; float b0 = -INFINITY;
#pragma unroll
            for (int e = 0; e < 16; ++e) if ((e >> 2) == tg && sel[e] > b0) { b0 = sel[e]; i0 = e; }
            int i1 = 0; float b1 = -INFINITY;
#pragma unroll
            for (int e = 0; e < 16; ++e) if ((e >> 2) == tg && e != i0 && sel[e] > b1) { b1 = sel[e]; i1 = e; }
            float p0 = 0.f, p1 = 0.f;
#pragma unroll
            for (int e = 0; e < 16; ++e) { if (e == i0) p0 = pr[e]; if (e == i1) p1 = pr[e]; }
            const float inv = 1.f / (p0 + p1);
            const unsigned pos0 = atomicAdd(lcnt + i0, 1u), pos1 = atomicAdd(lcnt + i1, 1u);
            lrow[nrow * 4] = i0; lrow[nrow * 4 + 1] = i1; lrow[nrow * 4 + 2] = (int)pos0; lrow[nrow * 4 + 3] = (int)pos1;
            float* tk = topk + (size_t)r * 8;
            ((int*)tk)[0] = i0; ((int*)tk)[1] = i1; tk[4] = p0 * inv; tk[5] = p1 * inv;
        }
        ++nrow;
    }
    __syncthreads();
    if (tid < 16) lbase[tid] = atomicAdd(cnt + tid, lcnt[tid]);
    __syncthreads();
    if (lane == 0) { int k = 0;
        for (int r = gw; r < P; r += ngw) { if (r < VALID0) continue;
            int* tk = (int*)(topk + (size_t)r * 8); tk[2] = (int)lbase[lrow[k * 4]] + lrow[k * 4 + 2]; tk[3] = (int)lbase[lrow[k * 4 + 1]] + lrow[k * 4 + 3]; ++k; } }
}

__device__ __forceinline__ void expert_offsets(const unsigned* cnt, int* s_cnt, int* s_off, int* s_tiles) {
    int off = 0;
    if (TIDX == 0) { int tt = 0; for (int e = 0; e < 16; ++e) { const int c = (int)cnt[e]; const int tl = (c + 255) >> 8; s_cnt[e] = c; s_off[e] = off; s_tiles[e] = tt; off += tl * 256; tt += tl; } s_tiles[16] = tt; }
    __syncthreads();
}
__device__ __forceinline__ void phase_perm(const Params& p, int l, char* lds, int bid, int nb) {
    int* s_cnt = (int*)(lds + LDS_TAB_OFF); int* s_off = s_cnt + 16; int* s_tiles = s_off + 16;
    expert_offsets((const unsigned*)(p.ws + WS_CTL) + CW_CNT + l * 16, s_cnt, s_off, s_tiles);
    const int tid = TIDX, wid = tid >> 6, lane = tid & 63, gw = bid * NW + wid, ngw = nb * NW;
    const bf16_t* H1 = (const bf16_t*)(p.ws + B_H1); bf16_t* XP = (bf16_t*)(p.ws + B_XP); const float* topk = (const float*)(p.ws + TAB_TOPK);
    int r = VALID0 + gw;
    u32x4 a, b; u32x4 tk;
    if (r < P) { tk = *(const u32x4*)(topk + (size_t)r * 8); const u32x4* src = (const u32x4*)(H1 + (size_t)r * D) + lane * 2; a = src[0]; b = src[1]; }
    while (r < P) {
        const int rn = r + ngw; u32x4 an, bn, tkn;
        if (rn < P) { tkn = *(const u32x4*)(topk + (size_t)rn * 8); const u32x4* src = (const u32x4*)(H1 + (size_t)rn * D) + lane * 2; an = src[0]; bn = src[1]; }
        const int e0 = (int)tk.x, e1 = (int)tk.y, p0 = (int)tk.z, p1 = (int)tk.w;
        u32x4* d0 = (u32x4*)(XP + (size_t)(s_off[e0] + p0) * D) + lane * 2; u32x4* d1 = (u32x4*)(XP + (size_t)(s_off[e1] + p1) * D) + lane * 2;
        d0[0] = a; d0[1] = b; d1[0] = a; d1[1] = b;
        a = an; b = bn; tk = tkn; r = rn;
    }
}
struct SchedMoE { const char* A; const char* B; size_t estride; int nN; const int* s_off; const int* s_tiles; int G, c; int K, lda, ldb;
    __device__ __forceinline__ bool next(int i, pg8::Unit& u) const {
        const int nwg = s_tiles[16] * nN; const long L = (long)i * G + c; if (L >= nwg) return false;
        int wgid = (int)L; { const int q = nwg / 8, r = nwg % 8, xcd = wgid % 8, off = wgid / 8; wgid = (xcd < r ? xcd * (q + 1) : r * (q + 1) + (xcd - r) * q) + off; }
        const int rt = wgid / nN; int e = 0;
        while (e < 15 && rt >= s_tiles[e + 1]) ++e;
        u.grp = __builtin_amdgcn_readfirstlane(e); u.pm = __builtin_amdgcn_readfirstlane((s_off[e] >> 8) + rt - s_tiles[e]); u.pn = __builtin_amdgcn_readfirstlane(wgid % nN); return true; }
    __device__ __forceinline__ const char* abase(const pg8::Unit& u) const { return A + (size_t)u.pm * 256 * D * 2; }
    __device__ __forceinline__ const char* bbase(const pg8::Unit& u) const { return B + (size_t)u.grp * estride + (size_t)u.pn * 256 * D * 2; } };
struct EpiE1F { bf16_t* HID;
    __device__ __forceinline__ void operator()(const f32x4 (&acc)[2][2][4][2], const pg8::Unit& u, int wr, int wc, int fr, int fq) const {
        asm volatile("" : "+v"(fr), "+v"(fq));
        const int row0 = u.pm * 256 + wr * 64 + fr, col0 = u.pn * 128 + wc * 32 + 8 * fq;
#pragma unroll
        for (int ai = 0; ai < 2; ++ai)
#pragma unroll
            for (int m = 0; m < 4; ++m) { f32x4 h0, h1;
#pragma unroll
                for (int r = 0; r < 4; ++r) { h0[r] = siluf_(acc[ai][0][m][0][r]) * acc[ai][1][m][0][r]; h1[r] = siluf_(acc[ai][0][m][1][r]) * acc[ai][1][m][1][r]; }
                *(u32x4*)(HID + (size_t)(row0 + ai * 128 + m * 16) * D + col0) = pg8::pack8(h0, h1); } } };
struct EpiE2F { bf16_t* YB;
    __device__ __forceinline__ void operator()(const f32x4 (&acc)[2][2][4][2], const pg8::Unit& u, int wr, int wc, int fr, int fq) const {
        bf16_t* base = YB + u.pn * 256;
        pg8::for_each_piece(acc, u, wr, wc, fr, fq, [&](int row, int col, f32x4 v0, f32x4 v1) { *(u32x4*)(base + (size_t)row * D + col) = pg8::pack8(v0, v1); }); } };
__device__ __forceinline__ void phase_e1_f(const Params& p, int l, char* lds, int bid, int nb) {
    int* s_cnt = (int*)(lds + LDS_TAB_OFF); int* s_off = s_cnt + 16; int* s_tiles = s_off + 16;
    expert_offsets((const unsigned*)(p.ws + WS_CTL) + CW_CNT + l * 16, s_cnt, s_off, s_tiles);
    SchedMoE S{(const char*)(p.ws + B_XP), (const char*)(p.ws + W_G_T), (size_t)2048 * D * 2, 8, s_off, s_tiles, nb, bid, D, D, D};
    pg8::gemm_phase((PG8_LAS unsigned char*)lds, S, EpiE1F{(bf16_t*)(p.ws + B_HID)});
}
__device__ __forceinline__ void phase_e2_f(const Params& p, int l, char* lds, int bid, int nb) {
    int* s_cnt = (int*)(lds + LDS_TAB_OFF); int* s_off = s_cnt + 16; int* s_tiles = s_off + 16;
    expert_offsets((const unsigned*)(p.ws + WS_CTL) + CW_CNT + l * 16, s_cnt, s_off, s_tiles);
    SchedMoE S{(const char*)(p.ws + B_HID), (const char*)(p.ws + W_D_T), (size_t)D * D * 2, 4, s_off, s_tiles, nb, bid, D, D, D};
    pg8::gemm_phase((PG8_LAS unsigned char*)lds, S, EpiE2F{(bf16_t*)(p.ws + B_YB)});
}

__device__ __forceinline__ void phase_combine(const Params& p, int l, char* lds, int bid, int nb) {
    const int tid = TIDX, wid = tid >> 6, lane = tid & 63, gw = bid * NW + wid, ngw = nb * NW;
    const bool last = (l == DEPTH - 1);
    if (!last) { convert_weights(p, l + 1, lds, gw, ngw, wid, lane); __syncthreads(); }
    int* s_cnt = (int*)(lds + 65536); int* s_off = s_cnt + 16; int* s_tiles = s_off + 16;
    expert_offsets((const unsigned*)(p.ws + WS_CTL) + CW_CNT + l * 16, s_cnt, s_off, s_tiles);
    float* g8 = (float*)lds;
    if (!last) load_gate_w(p, l + 1, g8);
    const bf16_t* H1 = (const bf16_t*)(p.ws + B_H1); const bf16_t* YB = (const bf16_t*)(p.ws + B_YB); bf16_t* H = (bf16_t*)(p.ws + B_H);
    const float* topk = (const float*)(p.ws + TAB_TOPK);
    for (int r = gw; r < P; r += ngw) {
        if (r < VALID0) { if (!last) { store_row_zero(H + (size_t)r * D, lane); gates_row_pad(p, r, lane); } continue; }
        if (last && r < 256) continue;
        const float* tk = topk + (size_t)r * 8;
        const int e0 = ((const int*)tk)[0], e1 = ((const int*)tk)[1], p0 = ((const int*)tk)[2], p1 = ((const int*)tk)[3]; const float w0 = tk[4], w1 = tk[5];
        const bf16_t* y0 = YB + (size_t)(s_off[e0] + p0) * D; const bf16_t* y1 = YB + (size_t)(s_off[e1] + p1) * D; const bf16_t* hr = H1 + (size_t)r * D;
        f32x4 v[4];
#pragma unroll
        for (int j = 0; j < 4; ++j) { const int cc = 4 * lane + 256 * j; const u32x2 a = *(const u32x2*)(y0 + cc), b = *(const u32x2*)(y1 + cc), hh = *(const u32x2*)(hr + cc);
            v[j].x = DN_ALPHA * bf2f(hh.x & 0xffffu) + w0 * bf2f(a.x & 0xffffu) + w1 * bf2f(b.x & 0xffffu);
            v[j].y = DN_ALPHA * bf2f(hh.x >> 16) + w0 * bf2f(a.x >> 16) + w1 * bf2f(b.x >> 16);
            v[j].z = DN_ALPHA * bf2f(hh.y & 0xffffu) + w0 * bf2f(a.y & 0xffffu) + w1 * bf2f(b.y & 0xffffu);
            v[j].w = DN_ALPHA * bf2f(hh.y >> 16) + w0 * bf2f(a.y >> 16) + w1 * bf2f(b.y >> 16); }
        ln_normalize(v, p.in[I_LN2G] + (size_t)l * D, p.in[I_LN2B] + (size_t)l * D, lane);
        if (last) {
            float* o = p.out + (size_t)(r - 256) * D;
#pragma unroll
            for (int j = 0; j < 4; ++j) *(f32x4*)(o + 4 * lane + 256 * j) = v[j];
        } else { store_row_bf16(H + (size_t)r * D, v, lane); gates_row(p, l + 1, g8, v, r, lane); }
    }
}

#define XB_TMO      128
#define XB_XCNT(j)  (256  + 64 * (j))
#define XB_XSUB(j)  (1280 + 64 * (j))
#define XB_XGEN(j)  (2304 + 64 * (j))
#define XB_TOP      3328
#define XB_TOPGEN   3392
#define XCD_BAR_WORDS 3456
#define XB_SPIN_CAP (1u << 18)
#define LAS __attribute__((address_space(3)))

__device__ __forceinline__ unsigned xb_ld(unsigned* p)              { return __hip_atomic_load(p, __ATOMIC_RELAXED, __HIP_MEMORY_SCOPE_AGENT); }
__device__ __forceinline__ unsigned xb_add(unsigned* p, unsigned v) { return __hip_atomic_fetch_add(p, v, __ATOMIC_RELAXED, __HIP_MEMORY_SCOPE_AGENT); }
__device__ __forceinline__ unsigned xb_xcc_id() { return (unsigned)__builtin_amdgcn_s_getreg((3 << 11) | 20) & 0xFu; }
#define XB_SPIN(cond, bar) do { unsigned _sp = 0; while (cond) { __builtin_amdgcn_s_sleep(1); \
    if ((++_sp & 255u) == 0u) { if (xb_ld(&(bar)[XB_TMO])) break; if (_sp > XB_SPIN_CAP) { atomicAdd(&(bar)[XB_TMO], 1u); break; } } } } while (0)

struct XcdBarrier {
    unsigned* bar; unsigned x;
    volatile LAS unsigned* st;
};
__device__ __forceinline__ XcdBarrier xcd_barrier_post(unsigned* bar, volatile LAS unsigned* st) {
    XcdBarrier b; b.bar = bar; b.x = xb_xcc_id(); b.st = st;
    if (threadIdx.x == 0) (void)xb_add(&bar[XB_XCNT(b.x)], 1u);
    return b;
}
__device__ __forceinline__ void xcd_barrier_complete(unsigned* bar, unsigned x, unsigned& nloc, unsigned& nx) {
    const unsigned G = gridDim.x * gridDim.y * gridDim.z;
    unsigned sum, cnt, mine, sp = 0u;
    for (;;) {
        sum = 0u; cnt = 0u; mine = 0u;
#pragma unroll
        for (unsigned j = 0; j < 16; ++j) { const unsigned c = xb_ld(&bar[XB_XCNT(j)]); sum += c; cnt += (c > 0u) ? 1u : 0u; mine = (j == x) ? c : mine; }
        if (sum == G) break;
        __builtin_amdgcn_s_sleep(1);
        if ((++sp & 255u) == 0u) { if (xb_ld(&bar[XB_TMO])) break; if (sp > XB_SPIN_CAP) { atomicAdd(&bar[XB_TMO], 1u); break; } }
    }
    nloc = mine > 0u ? mine : 1u; nx = cnt > 0u ? cnt : 1u;
}
__device__ __forceinline__ void xcd_barrier(const XcdBarrier& b) {
    asm volatile("s_waitcnt vmcnt(0)" ::: "memory");
    __syncthreads();
    if (threadIdx.x == 0) {
        unsigned* bar = b.bar;
        __builtin_amdgcn_s_waitcnt(0);
        unsigned nloc = b.st[0], nx = b.st[1];
        if (nloc == 0u) { xcd_barrier_complete(bar, b.x, nloc, nx); b.st[0] = nloc; b.st[1] = nx; }
        const unsigned old = xb_add(&bar[XB_XSUB(b.x)], 1u);
        const unsigned gen = old / nloc;
        if (old + 1u == (gen + 1u) * nloc) {
            __builtin_amdgcn_fence(__ATOMIC_RELEASE, "agent");
            asm volatile("s_waitcnt vmcnt(0)" ::: "memory");
            const unsigned og = xb_add(&bar[XB_TOP], 1u);
            const unsigned tg = og / nx;
            if (og + 1u == (tg + 1u) * nx) xb_add(&bar[XB_TOPGEN], 1u);
            else XB_SPIN(xb_ld(&bar[XB_TOPGEN]) == tg, bar);
            __builtin_amdgcn_fence(__ATOMIC_ACQUIRE, "agent");
            xb_add(&bar[XB_XGEN(b.x)], 1u);
            asm volatile("s_waitcnt vmcnt(0)" ::: "memory");
        } else {
            XB_SPIN(xb_ld(&bar[XB_XGEN(b.x)]) == gen, bar);
            __builtin_amdgcn_fence(__ATOMIC_ACQUIRE, "agent");
            asm volatile("s_waitcnt vmcnt(0)" ::: "memory");
        }
    }
    __syncthreads();
}

constexpr int LDS_BYTES = 131072 + 12288;
constexpr int LDS_BAR_OFF = LDS_BYTES - 16;
constexpr int CW_BAR = 4096;
template <int L>
__device__ __forceinline__ void layer_body(const Params& p, char* lds, int bid, int nb, const XcdBarrier& bar) {
    phase_proj_f(p, lds, bid, nb); xcd_barrier(bar);
    phase_attn_f(p, L, lds, bid, nb); xcd_barrier(bar);
    phase_conv(p, L, lds, bid, nb); xcd_barrier(bar);
    phase_mqkv_f(p, lds, bid, nb); xcd_barrier(bar);
    phase_ms(p, lds, bid, nb); phase_sg(p, lds, bid, nb); xcd_barrier(bar);
    phase_m2(p, lds, bid, nb); xcd_barrier(bar);
    phase_o1(p, lds, bid, nb); xcd_barrier(bar);
    phase_o2(p, L, lds, bid, nb); xcd_barrier(bar);
    phase_br_f(p, lds, bid, nb); xcd_barrier(bar);
    phase_out_f(p, lds, bid, nb); xcd_barrier(bar);
    phase_ln1(p, L, lds, bid, nb); xcd_barrier(bar);
    phase_perm(p, L, lds, bid, nb); xcd_barrier(bar);
    phase_e1_f(p, L, lds, bid, nb); xcd_barrier(bar);
    phase_e2_f(p, L, lds, bid, nb); xcd_barrier(bar);
    phase_combine(p, L, lds, bid, nb); if (L + 1 < DEPTH) xcd_barrier(bar);
}
__global__ void __launch_bounds__(NT, 2) fwd_kernel(Params p) {
    extern __shared__ __attribute__((aligned(16))) char lds[];
    const int bid = blockIdx.x, nb = gridDim.x;
    if (threadIdx.x == 0) *(uint4*)(lds + LDS_BAR_OFF) = make_uint4(0u, 0u, 0u, 0u);
    __syncthreads();
    XcdBarrier bar = xcd_barrier_post((unsigned*)(p.ws + WS_CTL) + CW_BAR, (volatile LAS unsigned*)(lds + LDS_BAR_OFF));
    phase_prologue(p, lds, bid, nb); xcd_barrier(bar);
    layer_body<0>(p, lds, bid, nb, bar);
    layer_body<1>(p, lds, bid, nb, bar);
}

extern "C" void kernel_launch(void* const* d_in, const int* in_sizes, int n_in, void* d_out, int out_size, void* d_ws, size_t ws_size, hipStream_t stream) {
    if (n_in != 30 || ws_size < WS_END) { fprintf(stderr, "kernel_launch: unexpected n_in %d or ws_size %zu (< %zu)\n", n_in, ws_size, (size_t)WS_END); return; }
    static int grid = 0;
    if (grid == 0) {
        int dev = 0, cus = 0;
        if (hipGetDevice(&dev) != hipSuccess || hipDeviceGetAttribute(&cus, hipDeviceAttributeMultiprocessorCount, dev) != hipSuccess || cus <= 0) cus = 256;
        (void)hipFuncSetAttribute((const void*)fwd_kernel, hipFuncAttributeMaxDynamicSharedMemorySize, LDS_BYTES);
        grid = cus;
    }
    Params p{};
    for (int i = 0; i < 30; ++i) p.in[i] = (const float*)d_in[i];
    p.out = (float*)d_out; p.ws = (unsigned char*)d_ws;
    (void)hipMemsetAsync((char*)d_ws + WS_CTL, 0, CTL_BYTES, stream);
    hipLaunchKernelGGL(fwd_kernel, dim3(grid), dim3(NT), LDS_BYTES, stream, p);
}
```

```cpp
#include <hip/hip_runtime.h>
#include <cstdio>
#include <cstdint>

constexpr int D = 1024;
constexpr int SEQ = 16384;
constexpr int NMETA = 16;
constexpr int P = 16640;
constexpr int VALID0 = 240;
constexpr int DEPTH = 2;
constexpr int DIN = 7176;
constexpr int NSC = 65;
constexpr int NEXP = 16;
constexpr float LN_EPS = 1e-5f;
constexpr float DN_ALPHA = 1.4142135623730951f;
constexpr float NEGBIG = -1e30f;
constexpr int NT = 512;
constexpr int NW = 8;

typedef unsigned short bf16_t;
typedef short bf16x8 __attribute__((ext_vector_type(8)));
typedef float f32x4 __attribute__((ext_vector_type(4)));
typedef unsigned u32x4 __attribute__((ext_vector_type(4)));
typedef unsigned u32x2 __attribute__((ext_vector_type(2)));

constexpr size_t MiB = 1u << 20;
constexpr size_t RB = (size_t)P * D * 2;
constexpr size_t WS_CTL = 0;
constexpr size_t CTL_BYTES = 1 * MiB;
constexpr size_t WS_TAB = 1 * MiB;
constexpr size_t TAB_GLI = WS_TAB;
constexpr size_t TAB_GLF = TAB_GLI + 4 * P * 4;
constexpr size_t TAB_B   = TAB_GLF + 4 * P * 4;
constexpr size_t TAB_E   = TAB_B + 4 * P * 4;
constexpr size_t TAB_PM  = TAB_E + 4 * P * 4;
constexpr size_t TAB_W   = TAB_PM + 4 * P * 4;
constexpr size_t TAB_SCG = TAB_W + 4 * P * 4;
constexpr size_t TAB_SCM = TAB_SCG + 4096;
constexpr size_t TAB_MT  = TAB_SCM + 4096;
constexpr size_t TAB_NT  = TAB_MT + 4096;
constexpr size_t TAB_TOPK = TAB_NT + (size_t)NSC * 4 * 256 * 4;
constexpr size_t TAB_ELIST = TAB_TOPK + (size_t)P * 32;
constexpr size_t TAB_DENP = TAB_ELIST + (size_t)NEXP * P * 4;
constexpr size_t TAB_DENI = TAB_DENP + (size_t)P * 16 * 4;
constexpr size_t TAB_END = TAB_DENI + (size_t)P * 4 * 4;
static_assert(TAB_END <= 8 * MiB, "tables");
constexpr size_t WS_W = 8 * MiB;
constexpr size_t W_IN_T = WS_W;
constexpr size_t W_Q_T = W_IN_T + (size_t)7168 * 1024 * 2;
constexpr size_t W_K_T = W_Q_T + 4 * 65536 * 2;
constexpr size_t W_V_T = W_K_T + 4 * 65536 * 2;
constexpr size_t W_BM_T = W_V_T + 4 * 65536 * 2;
constexpr size_t W_BA_T = W_BM_T + (size_t)D * D * 2;
constexpr size_t W_OUT_T = W_BA_T + (size_t)D * D * 2;
constexpr size_t W_G_T = W_OUT_T + (size_t)D * D * 2;
constexpr size_t W_U_T = W_G_T + (size_t)NEXP * D * D * 2;
constexpr size_t W_D_T = W_U_T + (size_t)NEXP * D * D * 2;
constexpr size_t W_END = W_D_T + (size_t)NEXP * D * D * 2;
static_assert(W_END <= 128 * MiB, "weights");
constexpr size_t WS_SLOT = 128 * MiB;
constexpr size_t SLOT(int i) { return WS_SLOT + (size_t)i * RB; }
constexpr size_t WS_END = WS_SLOT + 12 * RB;
constexpr size_t B_H = SLOT(0);
constexpr size_t B_XM = SLOT(1), B_PM = SLOT(1);
constexpr size_t B_OP = SLOT(2), B_MRGB = SLOT(2);
constexpr size_t B_QA = SLOT(3), B_QM = SLOT(3), B_MRG = SLOT(3);
constexpr size_t B_KA = SLOT(4), B_XC = SLOT(4), B_CT = SLOT(4);
constexpr size_t B_KM = SLOT(5), B_OI = SLOT(5), B_H1 = SLOT(5);
constexpr size_t B_GA = SLOT(6);
constexpr size_t B_GB = SLOT(7);
constexpr size_t B_YA = SLOT(8);
constexpr size_t B_KMT = SLOT(9), B_YM = SLOT(9);
constexpr size_t B_VA = SLOT(10), B_VMT = SLOT(10);
constexpr size_t B_VWT = SLOT(11);
constexpr size_t B_Z = SLOT(10);
constexpr size_t B_HID = SLOT(6);
constexpr size_t B_XP = SLOT(1);
constexpr size_t B_YB = SLOT(9);
constexpr int HID_ROWS_MAX = (int)(3 * RB / (D * 2));
constexpr int CW_CNT = 64;

struct Params {
    const float* in[30];
    float* out;
    unsigned char* ws;
};
enum { I_X = 0, I_META, I_LNG, I_LNB, I_WIN, I_CONVW, I_CONVB, I_WQM, I_WKM, I_WVM, I_BI, I_BF, I_MNG, I_LQ1, I_LK1, I_LQ2, I_LK2, I_ANG,
       I_WBM, I_WBA, I_WOUT, I_LN1G, I_LN1B, I_LN2G, I_LN2B, I_WR, I_RB, I_WG, I_WU, I_WD };

__device__ __forceinline__ int tid_opaque() { int t = threadIdx.x; asm volatile("" : "+v"(t)); return t; }
#define TIDX tid_opaque()
__device__ __forceinline__ float bf2f(unsigned v) { return __uint_as_float(v << 16); }
__device__ __forceinline__ unsigned f2bf(float f) { unsigned u = __float_as_uint(f); return (u + 0x7fffu + ((u >> 16) & 1u)) >> 16; }
__device__ __forceinline__ unsigned pk2(float lo, float hi) { return f2bf(lo) | (f2bf(hi) << 16); }
template <int M> __device__ __forceinline__ float sx(float v) {
    static_assert(M == 1 || M == 2 || M == 4 || M == 8 || M == 16, "sx: xor mask within 32 lanes");
    return __int_as_float(__builtin_amdgcn_ds_swizzle(__float_as_int(v), 0x1f | (M << 10)));
}
__device__ __forceinline__ float sum32(float v) {
    auto rr = __builtin_amdgcn_permlane32_swap(__float_as_uint(v), __float_as_uint(v), false, false);
    return __uint_as_float(rr[0]) + __uint_as_float(rr[1]);
}
__device__ __forceinline__ float wave_sum(float v) {
    v += sx<1>(v); v += sx<2>(v); v += sx<4>(v); v += sx<8>(v); v += sx<16>(v); v = sum32(v);
    return v;
}
__device__ __forceinline__ float sigmoidf_(float x) { return 1.f / (1.f + __expf(-x)); }
__device__ __forceinline__ float siluf_(float x) { return x / (1.f + __expf(-x)); }
__device__ __forceinline__ float logsigmoidf_(float x) { return x >= 0.f ? -log1pf(__expf(-x)) : x - log1pf(__expf(x)); }
__device__ __forceinline__ f32x4 sig4(f32x4 v) { f32x4 o; o.x = sigmoidf_(v.x); o.y = sigmoidf_(v.y); o.z = sigmoidf_(v.z); o.w = sigmoidf_(v.w); return o; }
__device__ __forceinline__ f32x4 mfma16(bf16x8 a, bf16x8 b, f32x4 c) { return __builtin_amdgcn_mfma_f32_16x16x32_bf16(a, b, c, 0, 0, 0); }
__device__ __forceinline__ bf16x8 ld8(const bf16_t* p) { return *(const bf16x8*)p; }

__device__ __forceinline__ void transpose_item(const float* W, int K, size_t ldsrc, int k0, int n_src0, bf16_t* WT, int dst_row0, float* scr, int lane) {
#pragma unroll 8
    for (int i = 0; i < 32; ++i) { const int kk = 2 * i + (lane >> 5); scr[kk * 33 + (lane & 31)] = W[(size_t)(k0 + kk) * ldsrc + n_src0 + (lane & 31)]; }
    __builtin_amdgcn_wave_barrier();
    asm volatile("s_waitcnt lgkmcnt(0)" ::: "memory");
    const int c = lane & 7;
#pragma unroll
    for (int j = 0; j < 4; ++j) { const int n = (lane >> 3) + 8 * j; const float* s = scr + (8 * c) * 33 + n;
        u32x4 o; o.x = pk2(s[0 * 33], s[1 * 33]); o.y = pk2(s[2 * 33], s[3 * 33]); o.z = pk2(s[4 * 33], s[5 * 33]); o.w = pk2(s[6 * 33], s[7 * 33]);
        *(u32x4*)(WT + (size_t)(dst_row0 + n) * K + k0 + 8 * c) = o; }
    asm volatile("s_waitcnt lgkmcnt(0)" ::: "memory");
    __builtin_amdgcn_wave_barrier();
}
__device__ __forceinline__ void convert_weights(const Params& p, int l, char* lds, int gw, int ngw, int wid, int lane) {
    float* scr = (float*)lds + wid * (64 * 33);
    unsigned char* ws = p.ws;
    constexpr int I_IN = 16 * 224, I_QKV = 3 * 4 * 4 * 8, I_SQ = 16 * 32, I_EXP = 3 * 16 * 512;
    constexpr int TOTAL = I_IN + I_QKV + 3 * I_SQ + I_EXP;
    for (int it = gw; it < TOTAL; it += ngw) {
        int r = it;
        if (r < I_IN) { const int kb = r / 224, nb = r % 224, r0 = nb * 32, nsrc = r0 < 2048 ? r0 : r0 + 8;
            transpose_item(p.in[I_WIN] + (size_t)l * D * DIN, D, DIN, kb * 64, nsrc, (bf16_t*)(ws + W_IN_T), r0, scr, lane); continue; }
        r -= I_IN;
        if (r < I_QKV) { const int w = r / 128, rr = r % 128, h = rr / 32, t = rr % 32, kb = t / 8, nb = t % 8;
            const float* src = p.in[w == 0 ? I_WQM : (w == 1 ? I_WKM : I_WVM)] + ((size_t)l * 4 + h) * 65536;
            bf16_t* dst = (bf16_t*)(ws + (w == 0 ? W_Q_T : (w == 1 ? W_K_T : W_V_T))) + (size_t)h * 65536;
            transpose_item(src, 256, 256, kb * 64, nb * 32, dst, nb * 32, scr, lane); continue; }
        r -= I_QKV;
        if (r < 3 * I_SQ) { const int w = r / I_SQ, t = r % I_SQ, kb = t / 32, nb = t % 32;
            const float* src = p.in[w == 0 ? I_WBM : (w == 1 ? I_WBA : I_WOUT)] + (size_t)l * D * D;
            bf16_t* dst = (bf16_t*)(ws + (w == 0 ? W_BM_T : (w == 1 ? W_BA_T : W_OUT_T)));
            transpose_item(src, D, D, kb * 64, nb * 32, dst, nb * 32, scr, lane); continue; }
        r -= 3 * I_SQ;
        { const int w = r / (16 * 512), rr = r % (16 * 512), e = rr / 512, t = rr % 512, kb = t / 32, nb = t % 32;
            const float* src = p.in[w == 0 ? I_WG : (w == 1 ? I_WU : I_WD)] + ((size_t)l * NEXP + e) * D * D;
            if (w == 2) transpose_item(src, D, D, kb * 64, nb * 32, (bf16_t*)(ws + W_D_T) + (size_t)e * D * D, nb * 32, scr, lane);
            else { const int j0 = nb * 32; transpose_item(src, D, D, kb * 64, j0, (bf16_t*)(ws + W_G_T) + (size_t)e * 2048 * D, 256 * (j0 >> 7) + (j0 & 127) + (w == 1 ? 128 : 0), scr, lane); } }
    }
}

__device__ __forceinline__ void ln_normalize(f32x4 (&v)[4], const float* g, const float* b, int lane) {
    float s = 0.f;
#pragma unroll
    for (int j = 0; j < 4; ++j) s += (v[j].x + v[j].y) + (v[j].z + v[j].w);
    const float mean = wave_sum(s) * (1.f / D);
    float s2 = 0.f;
#pragma unroll
    for (int j = 0; j < 4; ++j) { v[j] = v[j] - mean; s2 += (v[j].x * v[j].x + v[j].y * v[j].y) + (v[j].z * v[j].z + v[j].w * v[j].w); }
    const float rstd = rsqrtf(wave_sum(s2) * (1.f / D) + LN_EPS);
#pragma unroll
    for (int j = 0; j < 4; ++j) { const f32x4 gg = *(const f32x4*)(g + 4 * lane + 256 * j), bb = *(const f32x4*)(b + 4 * lane + 256 * j); v[j] = v[j] * rstd * gg + bb; }
}
__device__ __forceinline__ void store_row_bf16(bf16_t* row, const f32x4 (&v)[4], int lane) {
#pragma unroll
    for (int j = 0; j < 4; ++j) { u32x2 o; o.x = pk2(v[j].x, v[j].y); o.y = pk2(v[j].z, v[j].w); *(u32x2*)(row + 4 * lane + 256 * j) = o; }
}
__device__ __forceinline__ void store_row_zero(bf16_t* row, int lane) {
#pragma unroll
    for (int j = 0; j < 4; ++j) { u32x2 o; o.x = 0u; o.y = 0u; *(u32x2*)(row + 4 * lane + 256 * j) = o; }
}
__device__ __forceinline__ void load_gate_w(const Params& p, int l, float* g8) {
    const float* w = p.in[I_WIN] + (size_t)l * D * DIN + 2048;
    for (int i = TIDX; i < D * 8; i += NT) { const int k = i >> 3, c = i & 7; g8[k * 8 + (k >> 2) * 4 + c] = w[(size_t)k * DIN + c]; }
    __syncthreads();
}
__device__ __forceinline__ void gates_row(const Params& p, int l, const float* g8, const f32x4 (&v)[4], int prow, int lane) {
    float acc[8];
#pragma unroll
    for (int c = 0; c < 8; ++c) acc[c] = 0.f;
#pragma unroll
    for (int j = 0; j < 4; ++j)
#pragma unroll
        for (int i = 0; i < 4; ++i) { const int k = 4 * lane + 256 * j + i; const float x = v[j][i];
            const f32x4 w0 = *(const f32x4*)(g8 + k * 8 + (k >> 2) * 4), w1 = *(const f32x4*)(g8 + k * 8 + (k >> 2) * 4 + 4);
            acc[0] += x * w0.x; acc[1] += x * w0.y; acc[2] += x * w0.z; acc[3] += x * w0.w; acc[4] += x * w1.x; acc[5] += x * w1.y; acc[6] += x * w1.z; acc[7] += x * w1.w; }
#pragma unroll
    for (int c = 0; c < 8; ++c) acc[c] = wave_sum(acc[c]);
    if (lane < 4) {
        float* gli = (float*)(p.ws + TAB_GLI); float* glf = (float*)(p.ws + TAB_GLF);
        const float bi = p.in[I_BI][l * 4 + lane], bfv = p.in[I_BF][l * 4 + lane];
        float ai = acc[0], af = acc[4];
        if (lane == 1) { ai = acc[1]; af = acc[5]; } else if (lane == 2) { ai = acc[2]; af = acc[6]; } else if (lane == 3) { ai = acc[3]; af = acc[7]; }
        gli[(size_t)lane * P + prow] = ai + bi;
        glf[(size_t)lane * P + prow] = logsigmoidf_(af + bfv);
    }
}
__device__ __forceinline__ void gates_row_pad(const Params& p, int prow, int lane) {
    if (lane < 4) { ((float*)(p.ws + TAB_GLI))[(size_t)lane * P + prow] = NEGBIG; ((float*)(p.ws + TAB_GLF))[(size_t)lane * P + prow] = 0.f; }
}

__device__ __forceinline__ void phase_prologue(const Params& p, char* lds, int bid, int nb) {
    const int tid = TIDX, wid = tid >> 6, lane = tid & 63, gw = bid * NW + wid, ngw = nb * NW;
    convert_weights(p, 0, lds, gw, ngw, wid, lane);
    __syncthreads();
    float* g8 = (float*)lds;
    load_gate_w(p, 0, g8);
    bf16_t* H = (bf16_t*)(p.ws + B_H);
    f32x4 vn[4];
#pragma unroll
    for (int j = 0; j < 4; ++j) vn[j] = (f32x4){0.f, 0.f, 0.f, 0.f};
#define PRO_SRC(r_) ((r_) < 256 ? p.in[I_META] + (size_t)((r_) - VALID0) * D : p.in[I_X] + (size_t)((r_) - 256) * D)
    if (gw >= VALID0 && gw < P) {
#pragma unroll
        for (int j = 0; j < 4; ++j) vn[j] = *(const f32x4*)(PRO_SRC(gw) + 4 * lane + 256 * j); }
    for (int r = gw; r < P; r += ngw) {
        f32x4 v[4];
#pragma unroll
        for (int j = 0; j < 4; ++j) v[j] = vn[j];
        { const int rn = r + ngw; if (rn >= VALID0 && rn < P) {
#pragma unroll
            for (int j = 0; j < 4; ++j) vn[j] = *(const f32x4*)(PRO_SRC(rn) + 4 * lane + 256 * j); } }
        if (r < VALID0) { store_row_zero(H + (size_t)r * D, lane); gates_row_pad(p, r, lane); continue; }
        ln_normalize(v, p.in[I_LNG], p.in[I_LNB], lane);
        store_row_bf16(H + (size_t)r * D, v, lane);
        gates_row(p, 0, g8, v, r, lane);
    }
}

struct RowsPlain { const bf16_t* base; size_t ld; __device__ __forceinline__ const bf16_t* row(int m) const { return base + (size_t)m * ld; } };
__device__ __forceinline__ void store4_bf16(bf16_t* dst, f32x4 v) { u32x2 o; o.x = pk2(v.x, v.y); o.y = pk2(v.z, v.w); *(u32x2*)dst = o; }

struct EpiProj { unsigned char* ws;
    __device__ __forceinline__ void operator()(int m, int n, f32x4 v) const {
        const int seg = n >> 10, cc = n & 1023;
        const size_t off = seg == 0 ? B_XM : seg == 1 ? B_OP : seg == 2 ? B_QA : seg == 3 ? B_KA : seg == 4 ? B_VA : seg == 5 ? B_GA : B_GB;
        store4_bf16((bf16_t*)(ws + off) + (size_t)m * D + cc, v); } };
struct EpiStore { bf16_t* C; size_t ldc; float scale;
    __device__ __forceinline__ void operator()(int m, int n, f32x4 v) const { store4_bf16(C + (size_t)m * ldc + n, v * scale); } };
namespace pg8 {
#define PG8_LAS __attribute__((address_space(3)))
constexpr int BM = 256, BK = 64, HALF = 128, HTB = HALF * BK * 2, STAGE_BYTES = 8 * HTB, NXCD = 8, WGM = 8;
__host__ __device__ __forceinline__ int lds_byte(int r, int c) { const int st = (r >> 4) * 2 + (c >> 5), rr = r & 15, cc = c & 31, ob = rr * 64 + cc * 2; return st * 1024 + (ob ^ (((ob >> 9) & 1) << 5)); }
__host__ __device__ __forceinline__ void stage_rc(int b, int& R, int& C) { const int st = b / 1024, sb = b % 1024, swz = sb ^ (((sb >> 9) & 1) << 5); R = (st >> 1) * 16 + swz / 64; C = (st & 1) * 32 + (swz % 64) / 2; }
__host__ __device__ __forceinline__ int perm32(int rho) { const int n = rho >> 4, i = rho & 15; return 8 * (i >> 2) + 4 * n + (i & 3); }
struct Unit { int pm, pn, grp; };
__device__ __forceinline__ bool decode_unit(long L, int nG, int nM, int nN, Unit& u) {
    const int nwg = nG * nM * nN; if (L >= nwg) return false;
    int wgid = (int)L; { const int q = nwg / NXCD, r = nwg % NXCD, xcd = wgid % NXCD, off = wgid / NXCD; wgid = (xcd < r ? xcd * (q + 1) : r * (q + 1) + (xcd - r) * q) + off; }
    const int per = nM * nN; u.grp = wgid / per; const int rem = wgid % per;
    const int nig = WGM * nN, gid = rem / nig, fm = gid * WGM, gsz = (nM - fm) < WGM ? (nM - fm) : WGM;
    u.pm = __builtin_amdgcn_readfirstlane(fm + ((rem % nig) % gsz)); u.pn = __builtin_amdgcn_readfirstlane((rem % nig) / gsz); u.grp = __builtin_amdgcn_readfirstlane(u.grp); return true;
}
__device__ __forceinline__ unsigned cvt_pk_bf16(float lo, float hi) { unsigned r; asm volatile("v_cvt_pk_bf16_f32 %0, %1, %2" : "=v"(r) : "v"(lo), "v"(hi)); return r; }

template <class Epi, class Sched, bool ALIGN_EPI = true>
__device__ __forceinline__ void gemm_phase(PG8_LAS unsigned char* lds, const Sched& S, const Epi& E) {
    const int tid = TIDX, wid = __builtin_amdgcn_readfirstlane(tid >> 6), lane = tid & 63, wr = wid >> 2, wc = wid & 3, fr = lane & 15, fq = lane >> 4;
    const int K = S.K, nt = K / BK;
    unsigned voffA[2], voffB[2];
#pragma unroll
    for (int i = 0; i < 2; ++i) { int R, C; stage_rc(tid * 16 + i * 8192, R, C); const int Rb = (R & ~31) + perm32(R & 31);
        voffA[i] = (unsigned)(R * S.lda + C) * 2u; voffB[i] = (unsigned)(Rb * S.ldb + C) * 2u; }
    const size_t kstep = (size_t)(BK * 2);
    const size_t hstepA = (size_t)HALF * S.lda * 2, hstepB = (size_t)HALF * S.ldb * 2;
    const unsigned ldsw = (unsigned)wid * 1024u;
    const int aoff = lds_byte(wr * 64 + fr, fq * 8), boff = lds_byte(wc * 32 + fr, fq * 8);
#define PG8_SA(b, h) (((b) * 2 + (h)) * HTB)
#define PG8_SB(b, h) ((4 + (b) * 2 + (h)) * HTB)
#define PG8_STAGE(bufoff, gbase, voff) do { _Pragma("unroll") for (int _i = 0; _i < 2; ++_i) \
        __builtin_amdgcn_global_load_lds((const unsigned*)((const char*)(gbase) + (voff)[_i]), (PG8_LAS unsigned*)(lds + (bufoff) + ldsw + _i * 8192), 16, 0, 0); } while (0)
#define PG8_LDA(dst, b, h) do { _Pragma("unroll") for (int m = 0; m < 4; ++m) _Pragma("unroll") for (int k = 0; k < 2; ++k) dst[m][k] = *(const PG8_LAS bf16x8*)(lds + PG8_SA(b, h) + aoff + m * 2048 + k * 1024); } while (0)
#define PG8_LDB(dst, b, h) do { _Pragma("unroll") for (int n = 0; n < 2; ++n) _Pragma("unroll") for (int k = 0; k < 2; ++k) dst[n][k] = *(const PG8_LAS bf16x8*)(lds + PG8_SB(b, h) + boff + n * 2048 + k * 1024); } while (0)
#define PG8_MMA(ai, bj, At, Bt) do { __builtin_amdgcn_s_setprio(1); _Pragma("unroll") for (int m = 0; m < 4; ++m) _Pragma("unroll") for (int n = 0; n < 2; ++n) _Pragma("unroll") for (int k = 0; k < 2; ++k) \
        acc[ai][bj][m][n] = __builtin_amdgcn_mfma_f32_16x16x32_bf16(Bt[n][k], At[m][k], acc[ai][bj][m][n], 0, 0, 0); __builtin_amdgcn_s_setprio(0); } while (0)
#define PG8_WAIT_V(n) asm volatile("s_waitcnt vmcnt(" #n ")" ::: "memory")
#define PG8_WAIT_L(n) asm volatile("s_waitcnt lgkmcnt(" #n ")" ::: "memory")
#define PG8_BAR __builtin_amdgcn_s_barrier()
#define PG8_SCHED __builtin_amdgcn_sched_barrier(0)
    Unit cur, nxt; int ui = 0;
    if (!S.next(0, cur)) return;
    f32x4 acc[2][2][4][2];
#pragma unroll
    for (int a = 0; a < 2; ++a)
#pragma unroll
        for (int b = 0; b < 2; ++b)
#pragma unroll
            for (int m = 0; m < 4; ++m)
#pragma unroll
                for (int n = 0; n < 2; ++n) acc[a][b][m][n] = (f32x4){0.f, 0.f, 0.f, 0.f};
    bf16x8 At[4][2], B0[2][2], B1[2][2];
    const char* cA = S.abase(cur); const char* cB = S.bbase(cur);
    PG8_STAGE(PG8_SB(0, 0), cB, voffB); PG8_STAGE(PG8_SB(0, 1), cB + hstepB, voffB); PG8_STAGE(PG8_SA(0, 0), cA, voffA); PG8_STAGE(PG8_SA(0, 1), cA + hstepA, voffA);
    if (wr == 1) PG8_BAR;
    PG8_WAIT_V(2); PG8_BAR;
    PG8_STAGE(PG8_SB(1, 0), cB + kstep, voffB); PG8_STAGE(PG8_SA(1, 0), cA + kstep, voffA); PG8_STAGE(PG8_SB(1, 1), cB + hstepB + kstep, voffB);
    PG8_WAIT_V(6); PG8_BAR;
    for (;;) {
        const bool has_next = S.next(ui + 1, nxt);
        const char* nA = has_next ? S.abase(nxt) : cA; const char* nB = has_next ? S.bbase(nxt) : cB;
        for (int t = 0; t < nt; t += 2) {
            const bool last = (t == nt - 2);
            const char* a1 = cA + (size_t)(t + 1) * kstep;
            const char* a2 = last ? nA : cA + (size_t)(t + 2) * kstep; const char* b2 = last ? nB : cB + (size_t)(t + 2) * kstep;
            const char* a3 = a2 + kstep; const char* b3 = b2 + kstep;
            PG8_LDB(B0, 0, 0); PG8_LDB(B1, 0, 1); PG8_SCHED; PG8_LDA(At, 0, 0); PG8_STAGE(PG8_SA(1, 1), a1 + hstepA, voffA);
            PG8_WAIT_V(8); PG8_WAIT_L(0); PG8_BAR; PG8_MMA(0, 0, At, B0); PG8_MMA(0, 1, At, B1); PG8_BAR; PG8_SCHED;
            PG8_LDA(At, 0, 1); PG8_STAGE(PG8_SB(0, 0), b2, voffB); PG8_STAGE(PG8_SB(0, 1), b2 + hstepB, voffB); PG8_STAGE(PG8_SA(0, 0), a2, voffA);
            PG8_WAIT_V(8); PG8_WAIT_L(0); PG8_BAR; PG8_MMA(1, 0, At, B0); PG8_MMA(1, 1, At, B1); PG8_BAR; PG8_SCHED;
            PG8_LDB(B0, 1, 0); PG8_LDB(B1, 1, 1); PG8_SCHED; PG8_LDA(At, 1, 0); PG8_STAGE(PG8_SA(0, 1), a2 + hstepA, voffA);
            PG8_WAIT_V(8); PG8_WAIT_L(0); PG8_BAR; PG8_MMA(0, 0, At, B0); PG8_MMA(0, 1, At, B1); PG8_BAR; PG8_SCHED;
            PG8_LDA(At, 1, 1); PG8_STAGE(PG8_SB(1, 0), b3, voffB); PG8_STAGE(PG8_SB(1, 1), b3 + hstepB, voffB); PG8_STAGE(PG8_SA(1, 0), a3, voffA);
            PG8_WAIT_V(8); PG8_WAIT_L(0); PG8_BAR; PG8_MMA(1, 0, At, B0); PG8_MMA(1, 1, At, B1); PG8_BAR; PG8_SCHED;
        }
        if constexpr (ALIGN_EPI) { if (wr == 0) PG8_BAR; }
        E(acc, cur, wr, wc, fr, fq);
        if (!has_next) break;
#pragma unroll
        for (int a = 0; a < 2; ++a)
#pragma unroll
            for (int b = 0; b < 2; ++b)
#pragma unroll
                for (int m = 0; m < 4; ++m)
#pragma unroll
                    for (int n = 0; n < 2; ++n) acc[a][b][m][n] = (f32x4){0.f, 0.f, 0.f, 0.f};
        cur = nxt; cA = nA; cB = nB; ++ui;
        if constexpr (ALIGN_EPI) { if (wr == 1) PG8_BAR; }
    }
    PG8_WAIT_V(0);
    if constexpr (!ALIGN_EPI) { if (wr == 0) PG8_BAR; }
    PG8_BAR;
#undef PG8_SA
#undef PG8_SB
#undef PG8_STAGE
#undef PG8_LDA
#undef PG8_LDB
#undef PG8_MMA
#undef PG8_WAIT_V
#undef PG8_WAIT_L
#undef PG8_BAR
#undef PG8_SCHED
}
__device__ __forceinline__ u32x4 pack8(f32x4 v0, f32x4 v1) { u32x4 w; w.x = cvt_pk_bf16(v0[0], v0[1]); w.y = cvt_pk_bf16(v0[2], v0[3]); w.z = cvt_pk_bf16(v1[0], v1[1]); w.w = cvt_pk_bf16(v1[2], v1[3]); return w; }
__device__ __forceinline__ void unpack8(u32x4 w, f32x4& v0, f32x4& v1) {
    v0[0] = __uint_as_float(w.x << 16); v0[1] = __uint_as_float(w.x & 0xffff0000u); v0[2] = __uint_as_float(w.y << 16); v0[3] = __uint_as_float(w.y & 0xffff0000u);
    v1[0] = __uint_as_float(w.z << 16); v1[1] = __uint_as_float(w.z & 0xffff0000u); v1[2] = __uint_as_float(w.w << 16); v1[3] = __uint_as_float(w.w & 0xffff0000u); }
template <class F> __device__ __forceinline__ void for_each_piece(const f32x4 (&acc)[2][2][4][2], const Unit& u, int wr, int wc, int fr, int fq, const F& f) {
    asm volatile("" : "+v"(fr), "+v"(fq));
    const int row0 = u.pm * BM + wr * 64 + fr, col0 = wc * 32 + 8 * fq;
#pragma unroll
    for (int ai = 0; ai < 2; ++ai)
#pragma unroll
        for (int m = 0; m < 4; ++m)
#pragma unroll
            for (int bj = 0; bj < 2; ++bj) f(row0 + ai * HALF + m * 16, col0 + bj * HALF, acc[ai][bj][m][0], acc[ai][bj][m][1]);
}
}

template <int MI, int NJ, class AR, class BR, class Epi>
__device__ __forceinline__ void sgemm_wave(const AR& ar, const BR& br, int K, int m0, int n0, const Epi& epi) {
    const int lane = TIDX & 63, c = lane & 15, g = lane >> 4;
    const bf16_t* ap[MI]; const bf16_t* bp[NJ];
#pragma unroll
    for (int i = 0; i < MI; ++i) ap[i] = ar.row(m0 + 16 * i + c) + 8 * g;
#pragma unroll
    for (int j = 0; j < NJ; ++j) bp[j] = br.row(n0 + 16 * j + c) + 8 * g;
    f32x4 acc[MI][NJ];
#pragma unroll
    for (int i = 0; i < MI; ++i)
#pragma unroll
        for (int j = 0; j < NJ; ++j) acc[i][j] = (f32x4){0.f, 0.f, 0.f, 0.f};
#pragma unroll 4
    for (int k0 = 0; k0 < K; k0 += 32) {
        bf16x8 a[MI], b[NJ];
#pragma unroll
        for (int i = 0; i < MI; ++i) a[i] = ld8(ap[i] + k0);
#pragma unroll
        for (int j = 0; j < NJ; ++j) b[j] = ld8(bp[j] + k0);
#pragma unroll
        for (int i = 0; i < MI; ++i)
#pragma unroll
            for (int j = 0; j < NJ; ++j) acc[i][j] = mfma16(b[j], a[i], acc[i][j]);
    }
#pragma unroll
    for (int i = 0; i < MI; ++i)
#pragma unroll
        for (int j = 0; j < NJ; ++j) epi(m0 + 16 * i + c, n0 + 16 * j + 4 * g, acc[i][j]);
}
template <int MI, int NJ, class AR, class BR, class Epi>
__device__ __forceinline__ void meta_gemm(const AR& ar, const BR& br, int K, int m0, int n0, const Epi& epi, char* lds) {
    const int tid = TIDX, wid = __builtin_amdgcn_readfirstlane(tid >> 6), lane = tid & 63, c = lane & 15, g = lane >> 4;
    const int kw = K >> 3, kb = wid * kw;
    f32x4 acc[MI][NJ];
#pragma unroll
    for (int i = 0; i < MI; ++i)
#pragma unroll
        for (int j = 0; j < NJ; ++j) acc[i][j] = (f32x4){0.f, 0.f, 0.f, 0.f};
    for (int k0 = kb; k0 < kb + kw; k0 += 32) {
        bf16x8 a[MI], b[NJ];
#pragma unroll
        for (int i = 0; i < MI; ++i) a[i] = ld8(ar.row(m0 + 16 * i + c) + 8 * g + k0);
#pragma unroll
        for (int j = 0; j < NJ; ++j) b[j] = ld8(br.row(n0 + 16 * j + c) + 8 * g + k0);
#pragma unroll
        for (int i = 0; i < MI; ++i)
#pragma unroll
            for (int j = 0; j < NJ; ++j) acc[i][j] = mfma16(b[j], a[i], acc[i][j]);
    }
    f32x4* part = (f32x4*)lds;
#pragma unroll
    for (int i = 0; i < MI; ++i)
#pragma unroll
        for (int j = 0; j < NJ; ++j) part[((wid * MI + i) * NJ + j) * 64 + lane] = acc[i][j];
    __syncthreads();
    if (wid == 0) {
#pragma unroll
        for (int i = 0; i < MI; ++i)
#pragma unroll
            for (int j = 0; j < NJ; ++j) { f32x4 s = acc[i][j];
#pragma unroll
                for (int w = 1; w < 8; ++w) s += part[((w * MI + i) * NJ + j) * 64 + lane];
                epi(m0 + 16 * i + c, n0 + 16 * j + 4 * g, s); }
    }
    __syncthreads();
}
__device__ __forceinline__ void zero_block(bf16_t* base, size_t ld, int nrows, int ncols, int gtid, int gthreads) {
    const int cpr = ncols / 8;
    for (int i = gtid; i < nrows * cpr; i += gthreads) { const int r = i / cpr, cc = (i % cpr) * 8; *(u32x4*)(base + (size_t)r * ld + cc) = (u32x4){0u, 0u, 0u, 0u}; }
}

struct SchedProj { const char* A; const char* B; int G, c; int K, lda, ldb;
    __device__ __forceinline__ bool next(int i, pg8::Unit& u) const { if (!pg8::decode_unit((long)i * G + c, 1, 64, 28, u)) return false; u.pm += 1; return true; }
    __device__ __forceinline__ const char* abase(const pg8::Unit& u) const { return A + (size_t)u.pm * 256 * D * 2; }
    __device__ __forceinline__ const char* bbase(const pg8::Unit& u) const { return B + (size_t)u.pn * 256 * D * 2; } };
struct EpiProjF { unsigned char* ws;
    __device__ __forceinline__ void operator()(const f32x4 (&acc)[2][2][4][2], const pg8::Unit& u, int wr, int wc, int fr, int fq) const {
        const int colt = u.pn * 256, seg = colt >> 10;
        const size_t off = seg == 0 ? B_XM : seg == 1 ? B_OP : seg == 2 ? B_QA : seg == 3 ? B_KA : seg == 4 ? B_VA : seg == 5 ? B_GA : B_GB;
        bf16_t* base = (bf16_t*)(ws + off) + (colt & 1023);
        pg8::for_each_piece(acc, u, wr, wc, fr, fq, [&](int row, int col, f32x4 v0, f32x4 v1) { *(u32x4*)(base + (size_t)row * D + col) = pg8::pack8(v0, v1); }); } };
struct SchedVAT { const char* A; const char* B; int G, c; int K, lda, ldb;
    __device__ __forceinline__ bool next(int i, pg8::Unit& u) const { if (!pg8::decode_unit((long)i * G + c, 1, 4, 64, u)) return false; u.pn += 1; return true; }
    __device__ __forceinline__ const char* abase(const pg8::Unit& u) const { return A + (size_t)u.pm * 256 * D * 2; }
    __device__ __forceinline__ const char* bbase(const pg8::Unit& u) const { return B + (size_t)u.pn * 256 * D * 2; } };
struct EpiStoreF { bf16_t* C; size_t ldc; float scale;
    __device__ __forceinline__ void operator()(const f32x4 (&acc)[2][2][4][2], const pg8::Unit& u, int wr, int wc, int fr, int fq) const {
        bf16_t* base = C + (size_t)u.pn * 256;
        pg8::for_each_piece(acc, u, wr, wc, fr, fq, [&](int row, int col, f32x4 v0, f32x4 v1) { *(u32x4*)(base + (size_t)row * ldc + col) = pg8::pack8(v0 * scale, v1 * scale); }); } };
__device__ __forceinline__ void phase_proj_f(const Params& p, char* lds, int bid, int nb) {
    const int tid = TIDX, wid = tid >> 6, gw = bid * NW + wid, ngw = nb * NW;
    const bf16_t* H = (const bf16_t*)(p.ws + B_H); const bf16_t* W = (const bf16_t*)(p.ws + W_IN_T);
    zero_block((bf16_t*)(p.ws + B_KA), D, VALID0, D, bid * NT + tid, nb * NT);
    zero_block((bf16_t*)(p.ws + B_VA), D, VALID0, D, bid * NT + tid, nb * NT);
    zero_block((bf16_t*)(p.ws + B_XM), D, VALID0, D, bid * NT + tid, nb * NT);
    for (int t = bid; t < 112; t += nb) meta_gemm<1, 4>(RowsPlain{H, D}, RowsPlain{W, D}, D, VALID0, t * 64, EpiProj{p.ws}, lds);
    { SchedProj S{(const char*)H, (const char*)W, nb, bid, D, D, D};
      pg8::gemm_phase(( PG8_LAS unsigned char*)lds, S, EpiProjF{p.ws}); }
}

namespace fa {
typedef short s16x4 __attribute__((ext_vector_type(4)));
typedef float f32x16 __attribute__((ext_vector_type(16)));
constexpr int KVBLK = 64, SHM_V = 64 * 128 * 2, SHM_K = 64 * 64 * 2, PITCH = 1024;
constexpr int LDS_NEED = 2 * SHM_V + 2 * SHM_K + NW * 64 * 4;
constexpr float SCALE = 0.125f, THR = 8.f;
#define FA_SBAR() __builtin_amdgcn_sched_barrier(0)
__device__ __forceinline__ int kswz(int row, int chunk) { return row * 128 + ((chunk ^ ((row >> 1) & 7)) << 4); }
__device__ __forceinline__ int v_st(int k, int c) { const int kk = (k & ~0xC) | ((k & 4) << 1) | ((k & 8) >> 1); return ((kk >> 3) * 4 + (c >> 5)) * 512 + ((kk & 7) * 32 + (c & 31)) * 2; }
__device__ __forceinline__ int v_rd_base(int lane) { return ((lane & 3) << 3) | (((lane >> 2) & 3) << 6) | (((lane >> 4) & 1) << 5) | (((lane >> 5) & 1) << 8); }
constexpr int v_rd_off(int d0, int ks, int half) { return d0 * 512 + ks * 4096 + half * 2048; }
__device__ __forceinline__ int crow(int r, int hi) { return (r & 3) + 8 * (r >> 2) + 4 * hi; }
__device__ __forceinline__ unsigned cvtpk(float lo, float hi) { unsigned r; asm volatile("v_cvt_pk_bf16_f32 %0, %1, %2" : "=v"(r) : "v"(lo), "v"(hi)); return r; }
__device__ __forceinline__ void mask_tile(f32x16& p0, f32x16& p1, int pos, int kbase, int hi, int lowkey) {
    const float NEG = -__builtin_inff();
#pragma unroll
    for (int r = 0; r < 16; ++r) {
        const int k0 = kbase + (r & 3) + 8 * (r >> 2) + 4 * hi;
        if (k0 > pos || k0 < lowkey) p0[r] = NEG;
        if (k0 + 32 > pos || k0 + 32 < lowkey) p1[r] = NEG;
    }
}
__device__ __forceinline__ void partialSM(f32x16& p0, f32x16& p1, float& m_reg, float& mn, float& alpha) {
    float pmax = p0[0];
#pragma unroll
    for (int r = 1; r < 16; ++r) pmax = fmaxf(pmax, p0[r]);
#pragma unroll
    for (int r = 0; r < 16; ++r) pmax = fmaxf(pmax, p1[r]);
    { auto rr = __builtin_amdgcn_permlane32_swap(__float_as_uint(pmax), __float_as_uint(pmax), false, false);
      pmax = fmaxf(__uint_as_float(rr[0]), __uint_as_float(rr[1])); }
    constexpr float C2 = 1.4426950408889634f * SCALE;
    if (__builtin_expect(__all((pmax - m_reg) * SCALE <= THR), 1)) { mn = m_reg; alpha = 1.f; }
    else { mn = fmaxf(m_reg, pmax); alpha = __builtin_amdgcn_exp2f((m_reg - mn) * C2); m_reg = mn; }
    const float mnL = -mn * C2;
#pragma unroll
    for (int r = 0; r < 16; ++r) p0[r] = fmaf(p0[r], C2, mnL);
#pragma unroll
    for (int r = 0; r < 16; ++r) p1[r] = fmaf(p1[r], C2, mnL);
#pragma unroll
    for (int r = 0; r < 16; ++r) p0[r] = __builtin_amdgcn_exp2f(p0[r]);
}
__device__ __forceinline__ void finishSM(f32x16& p0, f32x16& p1, float alpha, float& l_reg, bf16x8& pa0, bf16x8& pa1, bf16x8& pa2, bf16x8& pa3) {
#pragma unroll
    for (int r = 0; r < 16; ++r) p1[r] = __builtin_amdgcn_exp2f(p1[r]);
    float ps = 0;
#pragma unroll
    for (int r = 0; r < 16; ++r) ps += p0[r];
#pragma unroll
    for (int r = 0; r < 16; ++r) ps += p1[r];
    { auto rr = __builtin_amdgcn_permlane32_swap(__float_as_uint(ps), __float_as_uint(ps), false, false);
      ps = __uint_as_float(rr[0]) + __uint_as_float(rr[1]); }
    l_reg = l_reg * alpha + ps;
#define FA_PK4(Pv, B_, OUT) do { unsigned a0 = cvtpk(Pv[B_+0], Pv[B_+1]), a1 = cvtpk(Pv[B_+2], Pv[B_+3]);                          \
        unsigned b0 = cvtpk(Pv[B_+4], Pv[B_+5]), b1 = cvtpk(Pv[B_+6], Pv[B_+7]);                                             \
        auto r0 = __builtin_amdgcn_permlane32_swap(a0, b0, false, false); auto r1 = __builtin_amdgcn_permlane32_swap(a1, b1, false, false); \
        u32x4 w = {r0[0], r1[0], r0[1], r1[1]}; OUT = *reinterpret_cast<bf16x8*>(&w); } while (0)
    FA_PK4(p0, 0, pa0); FA_PK4(p0, 8, pa1); FA_PK4(p1, 0, pa2); FA_PK4(p1, 8, pa3);
#undef FA_PK4
}
template <int KB>
__device__ __forceinline__ void qkt(f32x16& p0, f32x16& p1, const char* K_lds, int r32, int hi, const bf16x8* qr) {
    p0 = f32x16{}; p1 = f32x16{};
#pragma unroll
    for (int d0 = 0; d0 < 4; ++d0) { const char* a = K_lds + KB * SHM_K + kswz(r32, 2 * d0 + hi);
        bf16x8 b0 = *reinterpret_cast<const bf16x8*>(a);
        bf16x8 b1 = *reinterpret_cast<const bf16x8*>(a + 32 * 128);
        p0 = __builtin_amdgcn_mfma_f32_32x32x16_bf16(b0, qr[d0], p0, 0, 0, 0);
        p1 = __builtin_amdgcn_mfma_f32_32x32x16_bf16(b1, qr[d0], p1, 0, 0, 0); }
}
template <int VB>
__device__ __forceinline__ void pv_tile(f32x16* o, int vb0, bf16x8 pa0, bf16x8 pa1, bf16x8 pa2, bf16x8 pa3) {
#define FA_TRRD(dst, off) asm volatile("ds_read_b64_tr_b16 %0, %1 offset:%2" : "=&v"(dst) : "v"(vb0), "i"(off) : "memory")
#define FA_PV_D0(d0) do { s16x4 l0, l1, l2, l3, h0, h1, h2, h3; constexpr int b_ = VB * SHM_V + v_rd_off(d0, 0, 0); \
        FA_TRRD(l0, b_); FA_TRRD(h0, b_ + 2048); FA_TRRD(l1, b_ + 4096); FA_TRRD(h1, b_ + 6144); FA_TRRD(l2, b_ + 8192); FA_TRRD(h2, b_ + 10240); FA_TRRD(l3, b_ + 12288); FA_TRRD(h3, b_ + 14336); \
        asm volatile("s_waitcnt lgkmcnt(0)" ::: "memory"); FA_SBAR();   \
        o[d0] = __builtin_amdgcn_mfma_f32_32x32x16_bf16(pa0, (bf16x8){l0[0], l0[1], l0[2], l0[3], h0[0], h0[1], h0[2], h0[3]}, o[d0], 0, 0, 0);   \
        o[d0] = __builtin_amdgcn_mfma_f32_32x32x16_bf16(pa1, (bf16x8){l1[0], l1[1], l1[2], l1[3], h1[0], h1[1], h1[2], h1[3]}, o[d0], 0, 0, 0);   \
        o[d0] = __builtin_amdgcn_mfma_f32_32x32x16_bf16(pa2, (bf16x8){l2[0], l2[1], l2[2], l2[3], h2[0], h2[1], h2[2], h2[3]}, o[d0], 0, 0, 0);   \
        o[d0] = __builtin_amdgcn_mfma_f32_32x32x16_bf16(pa3, (bf16x8){l3[0], l3[1], l3[2], l3[3], h3[0], h3[1], h3[2], h3[3]}, o[d0], 0, 0, 0); } while (0)
    FA_PV_D0(0); FA_PV_D0(1); FA_PV_D0(2); FA_PV_D0(3);
#undef FA_PV_D0
#undef FA_TRRD
}
__device__ __forceinline__ void attn_pass(const bf16_t* Qp, const bf16_t* Kp, const bf16_t* Vp, int P0, int NT, char* lds, f32x16 (&o)[4], float& l_out) {
    const int tid = TIDX, wid = __builtin_amdgcn_readfirstlane(tid >> 6), lane = tid & 63, r32 = lane & 31, hi = lane >> 5;
    char* V_lds = lds; char* K_lds = lds + 2 * SHM_V;
    float* wsl = (float*)(lds + 2 * SHM_V + 2 * SHM_K) + wid * 64; float* al_l = wsl + 32;
    const int qlo = P0 + wid * 32, pos = qlo + r32;
    float m_reg = -1e30f, l_reg = 0.f;
#pragma unroll
    for (int d = 0; d < 4; ++d) o[d] = f32x16{};
    const int ksr = tid >> 3, ksc = tid & 7, kws = kswz(ksr, ksc);
    const int sr = tid >> 4, sc = (tid & 15) * 8, vst0 = v_st(sr, sc), vst1 = v_st(32 + sr, sc);
    const int vb0 = (int)(uintptr_t)V_lds + v_rd_base(lane);
    bf16x8 qr[4];
#pragma unroll
    for (int d0 = 0; d0 < 4; ++d0) qr[d0] = ld8(Qp + (size_t)pos * PITCH + d0 * 16 + hi * 8);
    bf16x8 st_k, st_v0, st_v1;
#define FA_KBASE(t) ((3 + (t)) * KVBLK)
#define FA_SLOAD(t) do { const int kb_ = FA_KBASE(t); st_k = ld8(Kp + (size_t)(kb_ + ksr) * PITCH + ksc * 8); \
        st_v0 = ld8(Vp + (size_t)(kb_ + sr) * PITCH + sc); st_v1 = ld8(Vp + (size_t)(kb_ + 32 + sr) * PITCH + sc); } while (0)
#define FA_SWRITE_K(bf) do { *(bf16x8*)(K_lds + (bf) * SHM_K + kws) = st_k; } while (0)
#define FA_SWRITE_V(bf) do { *(bf16x8*)(V_lds + (bf) * SHM_V + vst0) = st_v0; *(bf16x8*)(V_lds + (bf) * SHM_V + vst1) = st_v1; } while (0)
#define FA_VMW() asm volatile("s_waitcnt vmcnt(0)" ::: "memory")
#define FA_RESC(a) do { if (__any((a) < 1.f)) { if (hi == 0) al_l[r32] = (a); asm volatile("s_waitcnt lgkmcnt(0)" ::: "memory");              \
                     for (int d_ = 0; d_ < 4; ++d_) for (int r = 0; r < 16; ++r) o[d_][r] *= al_l[crow(r, hi)]; } } while (0)
#define FA_MASKT(P0_, P1_, t) do { const int kb_ = FA_KBASE(t); if ((t) == 0 || kb_ + KVBLK - 1 > qlo) mask_tile(P0_, P1_, pos, kb_, hi, VALID0); } while (0)
    f32x16 pA0, pA1, pB0, pB1; float mnA, mnB, alA, alB; bf16x8 pa0, pa1, pa2, pa3;
    FA_SLOAD(0); FA_VMW(); FA_SWRITE_K(0); FA_SWRITE_V(0); FA_SBAR();
    if (NT > 1) FA_SLOAD(1);
    __syncthreads();
    FA_SBAR(); qkt<0>(pA0, pA1, K_lds, r32, hi, qr);
    FA_MASKT(pA0, pA1, 0); partialSM(pA0, pA1, m_reg, mnA, alA);
    if (NT > 1) { FA_VMW(); FA_SWRITE_K(1); FA_SWRITE_V(1); }
    __syncthreads();
#define FA_HALF_STEP(PX0, PX1, mnX, alX, PY0, PY1, alY, t, KB, VB, SB) do {                                                      \
        FA_SBAR(); qkt<KB>(PX0, PX1, K_lds, r32, hi, qr);                                             \
        finishSM(PY0, PY1, alY, l_reg, pa0, pa1, pa2, pa3); FA_SBAR();                                                           \
        if ((t) + 1 < NT) { FA_SLOAD((t) + 1); FA_SBAR(); }                                               \
        pv_tile<VB>(o, vb0, pa0, pa1, pa2, pa3); FA_MASKT(PX0, PX1, (t)); partialSM(PX0, PX1, m_reg, mnX, alX);                                        \
        __syncthreads();                                                                                                      \
        if ((t) + 1 < NT) { FA_VMW(); FA_SWRITE_K(SB); FA_SWRITE_V(SB); }                                                                          \
        FA_RESC(alX); __syncthreads(); } while (0)
    for (int t = 1; t + 1 < NT; t += 2) {
        FA_HALF_STEP(pB0, pB1, mnB, alB, pA0, pA1, alA, t, 1, 0, 0);
        FA_HALF_STEP(pA0, pA1, mnA, alA, pB0, pB1, alB, t + 1, 0, 1, 1);
    }
    const bool even = (NT & 1) == 0;
    if (even) { FA_SBAR(); qkt<1>(pB0, pB1, K_lds, r32, hi, qr); FA_SBAR(); }
    finishSM(pA0, pA1, alA, l_reg, pa0, pa1, pa2, pa3); FA_SBAR();
    pv_tile<0>(o, vb0, pa0, pa1, pa2, pa3);
    if (even) { FA_MASKT(pB0, pB1, NT - 1); partialSM(pB0, pB1, m_reg, mnB, alB); __syncthreads(); FA_RESC(alB);
        finishSM(pB0, pB1, alB, l_reg, pa0, pa1, pa2, pa3); FA_SBAR(); pv_tile<1>(o, vb0, pa0, pa1, pa2, pa3); }
    l_out = l_reg;
    __syncthreads();
#undef FA_KBASE
#undef FA_SLOAD
#undef FA_SWRITE_K
#undef FA_SWRITE_V
#undef FA_VMW
#undef FA_RESC
#undef FA_MASKT
#undef FA_HALF_STEP
}
__device__ __forceinline__ void attn_unit(const Params& p, int l, int hd, int j, float lam, float lam_init, char* lds) {
    const int tid = TIDX, wid = __builtin_amdgcn_readfirstlane(tid >> 6), lane = tid & 63, r32 = lane & 31, hi = lane >> 5;
    const bf16_t* QA = (const bf16_t*)(p.ws + B_QA) + hd * 128; const bf16_t* KA = (const bf16_t*)(p.ws + B_KA) + hd * 128; const bf16_t* VA = (const bf16_t*)(p.ws + B_VA) + hd * 128;
    bf16_t* YA = (bf16_t*)(p.ws + B_YA) + hd * 128;
    const int P0 = j * 256, NT = 4 * j + 1;
    float* li_l = (float*)(lds + 2 * SHM_V + 2 * SHM_K) + wid * 64;
    bf16_t* Yw = YA + (size_t)(P0 + wid * 32) * PITCH;
    f32x16 o[4]; float lr;
    attn_pass(QA, KA, VA, P0, NT, lds, o, lr);
    if (hi == 0) li_l[r32] = lr;
    asm volatile("s_waitcnt lgkmcnt(0)" ::: "memory");
#pragma unroll
    for (int r = 0; r < 16; ++r) { const int orow = crow(r, hi); const float rl = __builtin_amdgcn_rcpf(li_l[orow]);
#pragma unroll
        for (int d0 = 0; d0 < 4; ++d0) { const float v = o[d0][r] * rl; const float vn = sx<1>(v);
            if ((r32 & 1) == 0) *(unsigned*)(Yw + (size_t)orow * PITCH + d0 * 32 + r32) = cvtpk(v, vn); } }
    asm volatile("s_waitcnt vmcnt(0)" ::: "memory");
    __syncthreads();
    attn_pass(QA + 64, KA + 64, VA, P0, NT, lds, o, lr);
    if (hi == 0) li_l[r32] = lr;
    asm volatile("s_waitcnt lgkmcnt(0)" ::: "memory");
    const float scale_out = 1.f - lam_init;
#pragma unroll
    for (int r = 0; r < 16; ++r) { const int orow = crow(r, hi); const float rl = lam * __builtin_amdgcn_rcpf(li_l[orow]);
        float cv[4]; float ss = 0.f;
#pragma unroll
        for (int d0 = 0; d0 < 4; ++d0) { const float o1 = bf2f((unsigned)Yw[(size_t)orow * PITCH + d0 * 32 + r32]); cv[d0] = o1 - o[d0][r] * rl; ss += cv[d0] * cv[d0]; }
        ss += sx<1>(ss); ss += sx<2>(ss); ss += sx<4>(ss); ss += sx<8>(ss); ss += sx<16>(ss);
        const float rs = rsqrtf(ss * (1.f / 128.f) + LN_EPS) * scale_out;
#pragma unroll
        for (int d0 = 0; d0 < 4; ++d0) o[d0][r] = cv[d0] * rs * p.in[I_ANG][l * 128 + d0 * 32 + r32]; }
    asm volatile("s_waitcnt vmcnt(0)" ::: "memory");
    __syncthreads();
#pragma unroll
    for (int r = 0; r < 16; ++r) { const int orow = crow(r, hi);
#pragma unroll
        for (int d0 = 0; d0 < 4; ++d0) { const float v = o[d0][r]; const float vn = sx<1>(v);
            if ((r32 & 1) == 0) *(unsigned*)(Yw + (size_t)orow * PITCH + d0 * 32 + r32) = cvtpk(v, vn); } }
    __syncthreads();
}
}
__device__ __forceinline__ void phase_attn_f(const Params& p, int l, char* lds, int bid, int nb) {
    const int lane = TIDX & 63;
    const float lam_init = 0.8f - 0.6f * expf(-0.3f * (float)l);
    float lam;
    { const float a = wave_sum(p.in[I_LQ1][l * 64 + lane] * p.in[I_LK1][l * 64 + lane]), b = wave_sum(p.in[I_LQ2][l * 64 + lane] * p.in[I_LK2][l * 64 + lane]);
      lam = expf(a) - expf(b) + lam_init; }
    for (int u = bid; u < 256 + 8; u += nb) {
        if (u < 256) { const int hd = u & 7, jj = u >> 3;
            fa::attn_unit(p, l, hd, 64 - jj, lam, lam_init, lds);
            fa::attn_unit(p, l, hd, 1 + jj, lam, lam_init, lds);
        } else fa::attn_unit(p, l, u - 256, 0, lam, lam_init, lds);
    }
}

__device__ __forceinline__ void phase_conv(const Params& p, int l, char* lds, int bid, int nb) {
    const int tid = TIDX, wid = tid >> 6, lane = tid & 63, gw = bid * NW + wid, ngw = nb * NW;
    const bf16_t* XM = (const bf16_t*)(p.ws + B_XM); bf16_t* XC = (bf16_t*)(p.ws + B_XC);
    const float* cw = p.in[I_CONVW] + (size_t)l * 4 * D; const float* cb = p.in[I_CONVB] + (size_t)l * D;
    constexpr int RBLK = 16, NITEM = (P / RBLK) * (D / 8);
    for (int it = bid * NT + tid; it < NITEM; it += nb * NT) {
        const int rb = it >> 7, c0 = (it & 127) * 8, r0 = rb * RBLK;
        if (r0 + RBLK <= VALID0) {
#pragma unroll
            for (int i = 0; i < RBLK; ++i) *(u32x4*)(XC + (size_t)(r0 + i) * D + c0) = (u32x4){0u, 0u, 0u, 0u};
            continue; }
        u32x4 x[RBLK + 3];
#pragma unroll
        for (int i = 0; i < RBLK + 3; ++i) { const int rr = r0 - 3 + i; x[i] = rr >= VALID0 ? *(const u32x4*)(XM + (size_t)rr * D + c0) : (u32x4){0u, 0u, 0u, 0u}; }
        float w[4][8], bb[8];
#pragma unroll
        for (int j = 0; j < 4; ++j) { const f32x4 a = *(const f32x4*)(cw + j * D + c0), b = *(const f32x4*)(cw + j * D + c0 + 4);
            w[j][0] = a.x; w[j][1] = a.y; w[j][2] = a.z; w[j][3] = a.w; w[j][4] = b.x; w[j][5] = b.y; w[j][6] = b.z; w[j][7] = b.w; }
        { const f32x4 a = *(const f32x4*)(cb + c0), b = *(const f32x4*)(cb + c0 + 4); bb[0] = a.x; bb[1] = a.y; bb[2] = a.z; bb[3] = a.w; bb[4] = b.x; bb[5] = b.y; bb[6] = b.z; bb[7] = b.w; }
#pragma unroll
        for (int i = 0; i < RBLK; ++i) {
            float acc[8];
#pragma unroll
            for (int e = 0; e < 8; ++e) acc[e] = bb[e];
#pragma unroll
            for (int j = 0; j < 4; ++j) { const u32x4 v = x[i + j];
                acc[0] += w[j][0] * bf2f(v.x & 0xffffu); acc[1] += w[j][1] * bf2f(v.x >> 16); acc[2] += w[j][2] * bf2f(v.y & 0xffffu); acc[3] += w[j][3] * bf2f(v.y >> 16);
                acc[4] += w[j][4] * bf2f(v.z & 0xffffu); acc[5] += w[j][5] * bf2f(v.z >> 16); acc[6] += w[j][6] * bf2f(v.w & 0xffffu); acc[7] += w[j][7] * bf2f(v.w >> 16); }
            u32x4 o; o.x = pk2(siluf_(acc[0]), siluf_(acc[1])); o.y = pk2(siluf_(acc[2]), siluf_(acc[3])); o.z = pk2(siluf_(acc[4]), siluf_(acc[5])); o.w = pk2(siluf_(acc[6]), siluf_(acc[7]));
            if (r0 + i < VALID0) o = (u32x4){0u, 0u, 0u, 0u};
            *(u32x4*)(XC + (size_t)(r0 + i) * D + c0) = o;
        }
    }
    const float* gli = (const float*)(p.ws + TAB_GLI); const float* glf = (const float*)(p.ws + TAB_GLF);
    float* tb = (float*)(p.ws + TAB_B); float* te = (float*)(p.ws + TAB_E); float* tpm = (float*)(p.ws + TAB_PM); float* tw = (float*)(p.ws + TAB_W);
    float* scg = (float*)(p.ws + TAB_SCG); float* scm = (float*)(p.ws + TAB_SCM);
    for (int t = gw; t < NSC * 4; t += ngw) {
        const int sc = t >> 2, h = t & 3; const size_t base = (size_t)h * P + sc * 256 + 4 * lane;
        const f32x4 lf = *(const f32x4*)(glf + base), li = *(const f32x4*)(gli + base);
        float b[4]; b[0] = lf.x; b[1] = b[0] + lf.y; b[2] = b[1] + lf.z; b[3] = b[2] + lf.w;
        float incl = b[3];
#pragma unroll
        for (int o = 1; o < 64; o <<= 1) { const float n = __shfl_up(incl, o); if (lane >= o) incl += n; }
        const float excl = incl - b[3];
        float e[4], pm[4];
#pragma unroll
        for (int i = 0; i < 4; ++i) { b[i] += excl; e[i] = li[i] - b[i]; }
        pm[0] = e[0]; pm[1] = fmaxf(pm[0], e[1]); pm[2] = fmaxf(pm[1], e[2]); pm[3] = fmaxf(pm[2], e[3]);
        float mi = pm[3];
#pragma unroll
        for (int o = 1; o < 64; o <<= 1) { const float n = __shfl_up(mi, o); if (lane >= o) mi = fmaxf(mi, n); }
        float mex = __shfl_up(mi, 1); if (lane == 0) mex = -INFINITY;
#pragma unroll
        for (int i = 0; i < 4; ++i) pm[i] = fmaxf(pm[i], mex);
        const float gtot = __shfl(incl, 63), emax = __shfl(mi, 63), mloc = gtot + emax;
        f32x4 ww;
#pragma unroll
        for (int i = 0; i < 4; ++i) ww[i] = __expf(e[i] + gtot - mloc);
        *(f32x4*)(tb + base) = (f32x4){b[0], b[1], b[2], b[3]};
        *(f32x4*)(te + base) = (f32x4){e[0], e[1], e[2], e[3]};
        *(f32x4*)(tpm + base) = (f32x4){pm[0], pm[1], pm[2], pm[3]};
        *(f32x4*)(tw + base) = ww;
        if (lane == 0) { scg[sc * 4 + h] = gtot; scm[sc * 4 + h] = mloc; }
    }
}

__device__ __forceinline__ void phase_m1(const Params& p, char* lds, int bid, int nb, int nsc) {
    const int tid = TIDX, wid = __builtin_amdgcn_readfirstlane(tid >> 6), lane = tid & 63, c = lane & 15, g = lane >> 4, gw = bid * NW + wid, ngw = nb * NW;
    const bf16_t* KMT = (const bf16_t*)(p.ws + B_KMT); const bf16_t* VMT = (const bf16_t*)(p.ws + B_VMT);
    const float* tw = (const float*)(p.ws + TAB_W); bf16_t* CT = (bf16_t*)(p.ws + B_CT); float* NTv = (float*)(p.ws + TAB_NT);
    for (int u = bid; u < nsc * 4 * 2; u += nb) {
        const int dvb = (u & 1) * 8 + wid, h = (u >> 1) & 3, sc = u >> 3, s0 = sc * 256;
        f32x4 acc[16];
#pragma unroll
        for (int i = 0; i < 16; ++i) acc[i] = (f32x4){0.f, 0.f, 0.f, 0.f};
        float un[16];
#pragma unroll
        for (int i = 0; i < 16; ++i) un[i] = 0.f;
        for (int ks = (sc == 0 ? 7 : 0); ks < 8; ++ks) {
            const int sb = s0 + 32 * ks + 8 * g;
            const f32x4 w0 = *(const f32x4*)(tw + (size_t)h * P + sb), w1 = *(const f32x4*)(tw + (size_t)h * P + sb + 4);
            const u32x4 vv = *(const u32x4*)(VMT + (size_t)(h * 256 + 16 * dvb + c) * P + sb);
            u32x4 vw; vw.x = pk2(bf2f(vv.x & 0xffffu) * w0.x, bf2f(vv.x >> 16) * w0.y); vw.y = pk2(bf2f(vv.y & 0xffffu) * w0.z, bf2f(vv.y >> 16) * w0.w);
            vw.z = pk2(bf2f(vv.z & 0xffffu) * w1.x, bf2f(vv.z >> 16) * w1.y); vw.w = pk2(bf2f(vv.w & 0xffffu) * w1.z, bf2f(vv.w >> 16) * w1.w);
            const bf16x8 vf = *(bf16x8*)&vw;
#pragma unroll
            for (int dk = 0; dk < 16; ++dk) {
                const u32x4 kk = *(const u32x4*)(KMT + (size_t)(h * 256 + 16 * dk + c) * P + sb);
                acc[dk] = mfma16(*(const bf16x8*)&kk, vf, acc[dk]);
                if (dvb == 0) un[dk] += bf2f(kk.x & 0xffffu) * w0.x + bf2f(kk.x >> 16) * w0.y + bf2f(kk.y & 0xffffu) * w0.z + bf2f(kk.y >> 16) * w0.w
                                      + bf2f(kk.z & 0xffffu) * w1.x + bf2f(kk.z >> 16) * w1.y + bf2f(kk.w & 0xffffu) * w1.z + bf2f(kk.w >> 16) * w1.w;
            }
        }
        bf16_t* dst = CT + ((size_t)(sc * 4 + h) * 256 + 16 * dvb + c) * 256;
#pragma unroll
        for (int dk = 0; dk < 16; ++dk) store4_bf16(dst + 16 * dk + 4 * g, acc[dk]);
        if (dvb == 0) {
#pragma unroll
            for (int dk = 0; dk < 16; ++dk) { float v = un[dk]; v += sx<16>(v); v = sum32(v); if (g == 0) NTv[(size_t)(sc * 4 + h) * 256 + 16 * dk + c] = v; }
        }
    }
}

namespace pg8 {
template <class F> __device__ __forceinline__ void for_each_piece_local(const f32x4 (&acc)[2][2][4][2], int wr, int wc, int fr, int fq, const F& f) {
    asm volatile("" : "+v"(fr), "+v"(fq));
    const int row0 = wr * 64 + fr, col0 = wc * 32 + 8 * fq;
#pragma unroll
    for (int ai = 0; ai < 2; ++ai)
#pragma unroll
        for (int m = 0; m < 4; ++m)
#pragma unroll
            for (int bj = 0; bj < 2; ++bj) f(row0 + ai * HALF + m * 16, col0 + bj * HALF, acc[ai][bj][m][0], acc[ai][bj][m][1]);
}
}
struct SchedM1 { const char* VWT; const char* KMT; int G, c; int K, lda, ldb;
    __device__ __forceinline__ bool next(int i, pg8::Unit& u) const { return pg8::decode_unit((long)i * G + c, 4, 64, 1, u); }
    __device__ __forceinline__ const char* abase(const pg8::Unit& u) const { return VWT + ((size_t)u.grp * 256 * P + (size_t)(u.pm + 1) * 256) * 2; }
    __device__ __forceinline__ const char* bbase(const pg8::Unit& u) const { return KMT + ((size_t)u.grp * 256 * P + (size_t)(u.pm + 1) * 256) * 2; } };
struct EpiM1 { bf16_t* CT;
    __device__ __forceinline__ void operator()(const f32x4 (&acc)[2][2][4][2], const pg8::Unit& u, int wr, int wc, int fr, int fq) const {
        bf16_t* base = CT + (size_t)((u.pm + 1) * 4 + u.grp) * 65536;
        pg8::for_each_piece_local(acc, wr, wc, fr, fq, [&](int row, int col, f32x4 v0, f32x4 v1) { *(u32x4*)(base + (size_t)row * 256 + col) = pg8::pack8(v0, v1); }); } };
__device__ __forceinline__ void phase_ms(const Params& p, char* lds, int bid, int nb) {
    phase_m1(p, lds, bid, nb, 1);
    const int tid = TIDX, wid = __builtin_amdgcn_readfirstlane(tid >> 6), lane = tid & 63, c = lane & 15, g = lane >> 4, gw = bid * NW + wid, ngw = nb * NW;
    const bf16_t* KMT = (const bf16_t*)(p.ws + B_KMT); const float* tw = (const float*)(p.ws + TAB_W); float* NTv = (float*)(p.ws + TAB_NT);
    for (int t = gw; t < 64 * 4 * 16; t += ngw) {
        const int dkb = t & 15, h = (t >> 4) & 3, sc = 1 + (t >> 6);
        const bf16_t* kr = KMT + (size_t)(h * 256 + 16 * dkb + c) * P + sc * 256 + 64 * g; const float* wp = tw + (size_t)h * P + sc * 256 + 64 * g;
        float a = 0.f;
#pragma unroll
        for (int i = 0; i < 8; ++i) { const u32x4 kk = *(const u32x4*)(kr + 8 * i); const f32x4 w0 = *(const f32x4*)(wp + 8 * i), w1 = *(const f32x4*)(wp + 8 * i + 4);
            a += bf2f(kk.x & 0xffffu) * w0.x + bf2f(kk.x >> 16) * w0.y + bf2f(kk.y & 0xffffu) * w0.z + bf2f(kk.y >> 16) * w0.w
               + bf2f(kk.z & 0xffffu) * w1.x + bf2f(kk.z >> 16) * w1.y + bf2f(kk.w & 0xffffu) * w1.z + bf2f(kk.w >> 16) * w1.w; }
        a += sx<16>(a); a = sum32(a);
        if (g == 0) NTv[(size_t)(sc * 4 + h) * 256 + 16 * dkb + c] = a;
    }
    SchedM1 S{(const char*)(p.ws + B_VWT), (const char*)KMT, nb, bid, 256, P, P};
    pg8::gemm_phase((PG8_LAS unsigned char*)lds, S, EpiM1{(bf16_t*)(p.ws + B_CT)});
}

__device__ __forceinline__ void phase_m2(const Params& p, char* lds, int bid, int nb) {
    const float* scg = (const float*)(p.ws + TAB_SCG); const float* scm = (const float*)(p.ws + TAB_SCM);
    unsigned* CT = (unsigned*)(p.ws + B_CT); float* NTv = (float*)(p.ws + TAB_NT); float* mt = (float*)(p.ws + TAB_MT);
    const int gid = bid * NT + TIDX, nth = nb * NT;
    for (int i = gid; i < 4 * 32768 + 1024; i += nth) {
        if (i < 4 * 32768) {
            const int h = i >> 15, idx = i & 32767;
            unsigned* base = CT + (size_t)h * 32768 + idx;
            unsigned u[NSC];
#pragma unroll
            for (int sc = 0; sc < NSC; ++sc) u[sc] = base[(size_t)sc * 4 * 32768];
            float m = 0.f, c0 = 0.f, c1 = 0.f;
#pragma unroll
            for (int sc = 0; sc < NSC; ++sc) {
                const float gg = scg[sc * 4 + h], ml = scm[sc * 4 + h], mn = fmaxf(gg + m, ml), dec = __expf(gg + m - mn), cor = __expf(ml - mn);
                c0 = dec * c0 + cor * bf2f(u[sc] & 0xffffu); c1 = dec * c1 + cor * bf2f(u[sc] >> 16);
                base[(size_t)sc * 4 * 32768] = pk2(c0, c1); m = mn;
            }
        } else {
            const int j = i - 4 * 32768, h = j >> 8, d = j & 255;
            float* ptr0 = NTv + (size_t)h * 256 + d;
            float un[NSC];
#pragma unroll
            for (int sc = 0; sc < NSC; ++sc) un[sc] = ptr0[(size_t)sc * 1024];
            float m = 0.f, n = 0.f;
#pragma unroll
            for (int sc = 0; sc < NSC; ++sc) {
                const float gg = scg[sc * 4 + h], ml = scm[sc * 4 + h], mn = fmaxf(gg + m, ml), dec = __expf(gg + m - mn), cor = __expf(ml - mn);
                n = dec * n + cor * un[sc]; ptr0[(size_t)sc * 1024] = n; m = mn;
                if (d == 0) mt[sc * 4 + h] = mn;
            }
        }
    }
}

__device__ __forceinline__ void phase_m3(const Params& p, int l, char* lds, int bid, int nb, bool sc0_only) {
    const int tid = TIDX, wid = __builtin_amdgcn_readfirstlane(tid >> 6), lane = tid & 63, c = lane & 15, g = lane >> 4, gw = bid * NW + wid, ngw = nb * NW;
    const bf16_t* QM = (const bf16_t*)(p.ws + B_QM); const bf16_t* KM = (const bf16_t*)(p.ws + B_KM); const bf16_t* VMT = (const bf16_t*)(p.ws + B_VMT);
    const bf16_t* CT = (const bf16_t*)(p.ws + B_CT); const float* NTv = (const float*)(p.ws + TAB_NT); const float* mt = (const float*)(p.ws + TAB_MT);
    const float* tb = (const float*)(p.ws + TAB_B); const float* te = (const float*)(p.ws + TAB_E); const float* tpm = (const float*)(p.ws + TAB_PM);
    const bf16_t* OP = (const bf16_t*)(p.ws + B_OP); bf16_t* YM = (bf16_t*)(p.ws + B_YM);
    constexpr int NRG = P / 16, RG0 = VALID0 / 16;
    const int ntask = (NRG - RG0) * 4;
    for (int u = (sc0_only ? 256 : 0) + bid; u < (sc0_only ? 260 : NSC * 4 * 2); u += nb) {
        const int half = u < NSC * 4 ? 1 : 0, uu = u < NSC * 4 ? u : u - NSC * 4, sc = (NSC - 1) - (uu >> 2), h = uu & 3, rg = sc * 16 + half * 8 + wid;
        if (rg < RG0) continue;
        const int t0 = rg * 16, row = t0 + c, s_start = sc << 8;
        bf16x8 qf[8];
#pragma unroll
        for (int ks = 0; ks < 8; ++ks) qf[ks] = ld8(QM + (size_t)row * D + h * 256 + 32 * ks + 8 * g);
        const float b_t = tb[(size_t)h * P + row], pm_t = tpm[(size_t)h * P + row];
        const float m_prev = sc > 0 ? mt[(sc - 1) * 4 + h] : 0.f;
        const float m_t = b_t + fmaxf(m_prev, pm_t), scale_t = __expf(b_t + m_prev - m_t);
        f32x4 acc[16];
#pragma unroll
        for (int i = 0; i < 16; ++i) acc[i] = (f32x4){0.f, 0.f, 0.f, 0.f};
        float den = 0.f;
        if (sc > 0) {
            const bf16_t* Cb = CT + (size_t)((sc - 1) * 4 + h) * 65536; const float* nv = NTv + (size_t)((sc - 1) * 4 + h) * 256;
#pragma unroll 2
            for (int ks = 0; ks < 8; ++ks) {
#pragma unroll
                for (int dt = 0; dt < 16; ++dt) acc[dt] = mfma16(ld8(Cb + (size_t)(16 * dt + c) * 256 + 32 * ks + 8 * g), qf[ks], acc[dt]);
                const f32x4 n0 = *(const f32x4*)(nv + 32 * ks + 8 * g), n1 = *(const f32x4*)(nv + 32 * ks + 8 * g + 4);
                const u32x4 qq = *(const u32x4*)&qf[ks];
                den += bf2f(qq.x & 0xffffu) * n0.x + bf2f(qq.x >> 16) * n0.y + bf2f(qq.y & 0xffffu) * n0.z + bf2f(qq.y >> 16) * n0.w
                     + bf2f(qq.z & 0xffffu) * n1.x + bf2f(qq.z >> 16) * n1.y + bf2f(qq.w & 0xffffu) * n1.z + bf2f(qq.w >> 16) * n1.w;
            }
            den *= scale_t;
#pragma unroll
            for (int dt = 0; dt < 16; ++dt) acc[dt] = acc[dt] * scale_t;
        }
        for (int kb = (sc == 0 ? 224 : s_start); kb <= t0 + 15; kb += 32) {
            f32x4 s[2];
#pragma unroll
            for (int a = 0; a < 2; ++a) {
                s[a] = (f32x4){0.f, 0.f, 0.f, 0.f};
                const bf16_t* kr = KM + (size_t)(kb + 16 * a + c) * D + h * 256 + 8 * g;
#pragma unroll
                for (int ks = 0; ks < 8; ++ks) s[a] = mfma16(ld8(kr + 32 * ks), qf[ks], s[a]);
                const f32x4 ee = *(const f32x4*)(te + (size_t)h * P + kb + 16 * a + 4 * g);
#pragma unroll
                for (int r = 0; r < 4; ++r) { const int key = kb + 16 * a + 4 * g + r; const float arg = fminf(ee[r] + b_t - m_t, 0.f);
                    const float dd = key <= row ? __expf(arg) : 0.f; const float pv = s[a][r] * dd; s[a][r] = pv; den += pv; }
            }
            u32x4 w; w.x = pk2(s[0][0], s[0][1]); w.y = pk2(s[0][2], s[0][3]); w.z = pk2(s[1][0], s[1][1]); w.w = pk2(s[1][2], s[1][3]);
            const bf16x8 pf = *(bf16x8*)&w;
#pragma unroll
            for (int dt = 0; dt < 16; ++dt) {
                const bf16_t* vr = VMT + (size_t)(h * 256 + 16 * dt + c) * P + kb + 4 * g;
                const u32x2 v0 = *(const u32x2*)vr, v1 = *(const u32x2*)(vr + 16);
                u32x4 vv; vv.x = v0.x; vv.y = v0.y; vv.z = v1.x; vv.w = v1.y;
                acc[dt] = mfma16(*(bf16x8*)&vv, pf, acc[dt]);
            }
        }
        den += sx<16>(den); den = sum32(den);
        const float inv = 1.f / fmaxf(fabsf(den), __expf(-m_t));
        float s1 = 0.f;
#pragma unroll
        for (int dt = 0; dt < 16; ++dt) {
            const u32x2 og = *(const u32x2*)(OP + (size_t)row * D + h * 256 + 16 * dt + 4 * g);
            f32x4 v = acc[dt] * inv;
            v.x *= sigmoidf_(bf2f(og.x & 0xffffu)); v.y *= sigmoidf_(bf2f(og.x >> 16)); v.z *= sigmoidf_(bf2f(og.y & 0xffffu)); v.w *= sigmoidf_(bf2f(og.y >> 16));
            acc[dt] = v; s1 += (v.x + v.y) + (v.z + v.w);
        }
        s1 += sx<16>(s1); s1 = sum32(s1);
        const float mu = s1 * (1.f / 256.f);
        float s2 = 0.f;
#pragma unroll
        for (int dt = 0; dt < 16; ++dt) { acc[dt] = acc[dt] - mu; s2 += (acc[dt].x * acc[dt].x + acc[dt].y * acc[dt].y) + (acc[dt].z * acc[dt].z + acc[dt].w * acc[dt].w); }
        s2 += sx<16>(s2); s2 = sum32(s2);
        const float rstd = rsqrtf(s2 * (1.f / 256.f) + LN_EPS);
#pragma unroll
        for (int dt = 0; dt < 16; ++dt) { const f32x4 gg = *(const f32x4*)(p.in[I_MNG] + (size_t)l * D + h * 256 + 16 * dt + 4 * g);
            store4_bf16(YM + (size_t)row * D + h * 256 + 16 * dt + 4 * g, acc[dt] * rstd * gg); }
    }
}

struct EpiBr1 { float* MRG; const bf16_t* GA;
    __device__ __forceinline__ void operator()(int m, int n, f32x4 v) const { const u32x2 gg = *(const u32x2*)(GA + (size_t)m * D + n);
        f32x4 o; o.x = v.x * sigmoidf_(bf2f(gg.x & 0xffffu)); o.y = v.y * sigmoidf_(bf2f(gg.x >> 16)); o.z = v.z * sigmoidf_(bf2f(gg.y & 0xffffu)); o.w = v.w * sigmoidf_(bf2f(gg.y >> 16));
        *(f32x4*)(MRG + (size_t)m * D + n) = o; } };
struct EpiBr2 { const float* MRG; const bf16_t* GB; bf16_t* OUT;
    __device__ __forceinline__ void operator()(int m, int n, f32x4 v) const { const u32x2 gg = *(const u32x2*)(GB + (size_t)m * D + n); const f32x4 t = *(const f32x4*)(MRG + (size_t)m * D + n);
        f32x4 o; o.x = t.x + v.x * sigmoidf_(bf2f(gg.x & 0xffffu)); o.y = t.y + v.y * sigmoidf_(bf2f(gg.x >> 16)); o.z = t.z + v.z * sigmoidf_(bf2f(gg.y & 0xffffu)); o.w = t.w + v.w * sigmoidf_(bf2f(gg.y >> 16));
        store4_bf16(OUT + (size_t)m * D + n, o); } };
struct EpiOut { float* Z; const bf16_t* H;
    __device__ __forceinline__ void operator()(int m, int n, f32x4 v) const { const u32x2 hh = *(const u32x2*)(H + (size_t)m * D + n);
        f32x4 o; o.x = v.x + DN_ALPHA * bf2f(hh.x & 0xffffu); o.y = v.y + DN_ALPHA * bf2f(hh.x >> 16); o.z = v.z + DN_ALPHA * bf2f(hh.y & 0xffffu); o.w = v.w + DN_ALPHA * bf2f(hh.y >> 16);
        *(f32x4*)(Z + (size_t)m * D + n) = o; } };
constexpr int LDS_TAB_OFF = 131072;
constexpr int LDS_MT_OFF = LDS_TAB_OFF + 256;
constexpr int LDS_STAT_OFF = LDS_TAB_OFF + 2048;
__device__ __forceinline__ void compute_mtab_lds(const Params& p, char* lds) {
    float* mt = (float*)(lds + LDS_MT_OFF); float* tmp = (float*)(lds + LDS_STAT_OFF);
    const int t = TIDX;
    if (t < NSC * 4) { tmp[t] = ((const float*)(p.ws + TAB_SCG))[t]; tmp[NSC * 4 + t] = ((const float*)(p.ws + TAB_SCM))[t]; }
    __syncthreads();
    if (t < 4) { float m = 0.f;
        for (int sc = 0; sc < NSC; ++sc) { m = fmaxf(tmp[sc * 4 + t] + m, tmp[NSC * 4 + sc * 4 + t]); mt[sc * 4 + t] = m; } }
    __syncthreads();
}
struct SchedQK { const char* A; const char* B; int G, c; int K, lda, ldb;
    __device__ __forceinline__ bool next(int i, pg8::Unit& u) const { if (!pg8::decode_unit((long)i * G + c, 4, 64, 1, u)) return false; u.pm += 1; return true; }
    __device__ __forceinline__ const char* abase(const pg8::Unit& u) const { return A + ((size_t)u.pm * 256 * D + u.grp * 256) * 2; }
    __device__ __forceinline__ const char* bbase(const pg8::Unit& u) const { return B + ((size_t)u.pm * 256 * D + u.grp * 256) * 2; } };
struct EpiS { unsigned char* ws; const float* mt_lds;
    __device__ __forceinline__ void operator()(const f32x4 (&acc)[2][2][4][2], const pg8::Unit& u, int wr, int wc, int fr, int fq) const {
        asm volatile("" : "+v"(fr), "+v"(fq));
        const int h = u.grp, t0 = u.pm * 256; const float m_prev = mt_lds[(u.pm - 1) * 4 + h];
        const float* te = (const float*)(ws + TAB_E) + (size_t)h * P + t0; const float* tpm = (const float*)(ws + TAB_PM) + (size_t)h * P + t0;
        bf16_t* PMb = (bf16_t*)(ws + B_PM) + (size_t)t0 * D + h * 256; float* denp = (float*)(ws + TAB_DENP);
        const int c0 = wc * 32 + 8 * fq;
        f32x4 e[2][2];
#pragma unroll
        for (int bj = 0; bj < 2; ++bj) { e[bj][0] = *(const f32x4*)(te + c0 + bj * 128); e[bj][1] = *(const f32x4*)(te + c0 + bj * 128 + 4); }
#pragma unroll
        for (int ai = 0; ai < 2; ++ai)
#pragma unroll
            for (int m = 0; m < 4; ++m) { const int r = ai * 128 + wr * 64 + m * 16 + fr; const float pmx = fmaxf(m_prev, tpm[r]); float rs = 0.f;
#pragma unroll
                for (int bj = 0; bj < 2; ++bj) { f32x4 o0, o1;
#pragma unroll
                    for (int j = 0; j < 4; ++j) { const int s0 = c0 + bj * 128 + j, s1 = s0 + 4;
                        o0[j] = s0 <= r ? acc[ai][bj][m][0][j] * __expf(fminf(e[bj][0][j] - pmx, 0.f)) : 0.f;
                        o1[j] = s1 <= r ? acc[ai][bj][m][1][j] * __expf(fminf(e[bj][1][j] - pmx, 0.f)) : 0.f;
                        rs += o0[j] + o1[j]; }
                    *(u32x4*)(PMb + (size_t)r * D + c0 + bj * 128) = pg8::pack8(o0, o1); }
                rs += sx<16>(rs); rs = sum32(rs);
                if (fq == 0) denp[((size_t)(t0 + r) * 4 + h) * 4 + wc] = rs; } } };
struct SchedO1 { const char* A; const char* B; int G, c; int K, lda, ldb;
    __device__ __forceinline__ bool next(int i, pg8::Unit& u) const { if (!pg8::decode_unit((long)i * G + c, 4, 64, 1, u)) return false; u.pm += 1; return true; }
    __device__ __forceinline__ const char* abase(const pg8::Unit& u) const { return A + ((size_t)u.pm * 256 * D + u.grp * 256) * 2; }
    __device__ __forceinline__ const char* bbase(const pg8::Unit& u) const { return B + (size_t)((u.pm - 1) * 4 + u.grp) * 65536 * 2; } };
struct EpiO1 { unsigned char* ws;
    __device__ __forceinline__ void operator()(const f32x4 (&acc)[2][2][4][2], const pg8::Unit& u, int wr, int wc, int fr, int fq) const {
        asm volatile("" : "+v"(fr), "+v"(fq));
        const int h = u.grp, t0 = u.pm * 256; const float m_prev = ((const float*)(ws + TAB_MT))[(u.pm - 1) * 4 + h];
        const float* tpm = (const float*)(ws + TAB_PM) + (size_t)h * P + t0; bf16_t* OI = (bf16_t*)(ws + B_OI) + (size_t)t0 * D + h * 256;
        const int c0 = wc * 32 + 8 * fq;
#pragma unroll
        for (int ai = 0; ai < 2; ++ai)
#pragma unroll
            for (int m = 0; m < 4; ++m) { const int r = ai * 128 + wr * 64 + m * 16 + fr; const float sc = __expf(fminf(m_prev - tpm[r], 0.f));
#pragma unroll
                for (int bj = 0; bj < 2; ++bj) *(u32x4*)(OI + (size_t)r * D + c0 + bj * 128) = pg8::pack8(acc[ai][bj][m][0] * sc, acc[ai][bj][m][1] * sc); } } };
struct SchedO2 { const char* A; const char* B; int G, c; int K, lda, ldb;
    __device__ __forceinline__ bool next(int i, pg8::Unit& u) const { if (!pg8::decode_unit((long)i * G + c, 4, 64, 1, u)) return false; u.pm += 1; return true; }
    __device__ __forceinline__ const char* abase(const pg8::Unit& u) const { return A + ((size_t)u.pm * 256 * D + u.grp * 256) * 2; }
    __device__ __forceinline__ const char* bbase(const pg8::Unit& u) const { return B + ((size_t)u.grp * 256 * P + (size_t)u.pm * 256) * 2; } };
struct EpiO2 { unsigned char* ws; const float* mng; float* stat;
    __device__ __forceinline__ void operator()(f32x4 (&acc)[2][2][4][2], const pg8::Unit& u, int wr, int wc, int fr, int fq) const {
        asm volatile("" : "+v"(fr), "+v"(fq));
        const int h = u.grp, t0 = u.pm * 256; const float m_prev = ((const float*)(ws + TAB_MT))[(u.pm - 1) * 4 + h];
        const float* tpm = (const float*)(ws + TAB_PM) + (size_t)h * P + t0; const float* tb = (const float*)(ws + TAB_B) + (size_t)h * P + t0;
        const float* denp = (const float*)(ws + TAB_DENP); const float* deni = (const float*)(ws + TAB_DENI);
        const bf16_t* OI = (const bf16_t*)(ws + B_OI) + (size_t)t0 * D + h * 256; const bf16_t* OP = (const bf16_t*)(ws + B_OP) + (size_t)t0 * D + h * 256;
        bf16_t* YM = (bf16_t*)(ws + B_YM) + (size_t)t0 * D + h * 256;
        const int c0 = wc * 32 + 8 * fq;
#pragma unroll
        for (int ai = 0; ai < 2; ++ai)
#pragma unroll
            for (int m = 0; m < 4; ++m) { const int r = ai * 128 + wr * 64 + m * 16 + fr;
                const f32x4 dp = *(const f32x4*)(denp + ((size_t)(t0 + r) * 4 + h) * 4); const float den = (dp.x + dp.y) + (dp.z + dp.w) + deni[(size_t)(t0 + r) * 4 + h];
                const float m_t = tb[r] + fmaxf(m_prev, tpm[r]); const float inv = 1.f / fmaxf(fabsf(den), __expf(-m_t));
                float s1 = 0.f, s2 = 0.f;
#pragma unroll
                for (int bj = 0; bj < 2; ++bj) { f32x4 i0, i1, g0, g1; pg8::unpack8(*(const u32x4*)(OI + (size_t)r * D + c0 + bj * 128), i0, i1); pg8::unpack8(*(const u32x4*)(OP + (size_t)r * D + c0 + bj * 128), g0, g1);
                    f32x4 v0 = (acc[ai][bj][m][0] + i0) * inv * sig4(g0), v1 = (acc[ai][bj][m][1] + i1) * inv * sig4(g1);
                    acc[ai][bj][m][0] = v0; acc[ai][bj][m][1] = v1;
                    s1 += (v0.x + v0.y) + (v0.z + v0.w) + (v1.x + v1.y) + (v1.z + v1.w);
                    s2 += (v0.x * v0.x + v0.y * v0.y) + (v0.z * v0.z + v0.w * v0.w) + (v1.x * v1.x + v1.y * v1.y) + (v1.z * v1.z + v1.w * v1.w); }
                s1 += sx<16>(s1); s1 = sum32(s1); s2 += sx<16>(s2); s2 = sum32(s2);
                if (fq == 0) { stat[(r * 4 + wc) * 2] = s1; stat[(r * 4 + wc) * 2 + 1] = s2; } }
        asm volatile("s_waitcnt lgkmcnt(0)" ::: "memory"); __builtin_amdgcn_s_barrier(); asm volatile("" ::: "memory");
#pragma unroll
        for (int ai = 0; ai < 2; ++ai)
#pragma unroll
            for (int m = 0; m < 4; ++m) { const int r = ai * 128 + wr * 64 + m * 16 + fr;
                const f32x4 a = *(const f32x4*)(stat + r * 8), b = *(const f32x4*)(stat + r * 8 + 4);
                const float mu = ((a.x + a.z) + (b.x + b.z)) * (1.f / 256.f), ex2 = ((a.y + a.w) + (b.y + b.w)) * (1.f / 256.f);
                const float rstd = rsqrtf(fmaxf(ex2 - mu * mu, 0.f) + LN_EPS);
#pragma unroll
                for (int bj = 0; bj < 2; ++bj) { const f32x4 g0 = *(const f32x4*)(mng + h * 256 + c0 + bj * 128), g1 = *(const f32x4*)(mng + h * 256 + c0 + bj * 128 + 4);
                    *(u32x4*)(YM + (size_t)r * D + c0 + bj * 128) = pg8::pack8((acc[ai][bj][m][0] - mu) * rstd * g0, (acc[ai][bj][m][1] - mu) * rstd * g1); } } } };
__device__ __forceinline__ void phase_o1(const Params& p, char* lds, int bid, int nb) {
    const int tid = TIDX, wid = __builtin_amdgcn_readfirstlane(tid >> 6), lane = tid & 63, c = lane & 15, g = lane >> 4, gw = bid * NW + wid, ngw = nb * NW;
    const bf16_t* QM = (const bf16_t*)(p.ws + B_QM); const float* NTv = (const float*)(p.ws + TAB_NT); const float* mt = (const float*)(p.ws + TAB_MT);
    const float* tpm = (const float*)(p.ws + TAB_PM); float* deni = (float*)(p.ws + TAB_DENI);
#pragma unroll 2
    for (int it = gw; it < ((P - 256) / 16) * 4; it += ngw) {
        const int h = it & 3, t = 256 + (it >> 2) * 16 + c, sc = t >> 8;
        const bf16_t* qr = QM + (size_t)t * D + h * 256 + 64 * g; const float* nv = NTv + (size_t)((sc - 1) * 4 + h) * 256 + 64 * g;
        float a = 0.f;
#pragma unroll
        for (int i = 0; i < 8; ++i) { const u32x4 qq = *(const u32x4*)(qr + 8 * i); const f32x4 n0 = *(const f32x4*)(nv + 8 * i), n1 = *(const f32x4*)(nv + 8 * i + 4);
            a += bf2f(qq.x & 0xffffu) * n0.x + bf2f(qq.x >> 16) * n0.y + bf2f(qq.y & 0xffffu) * n0.z + bf2f(qq.y >> 16) * n0.w
               + bf2f(qq.z & 0xffffu) * n1.x + bf2f(qq.z >> 16) * n1.y + bf2f(qq.w & 0xffffu) * n1.z + bf2f(qq.w >> 16) * n1.w; }
        a += sx<16>(a); a = sum32(a);
        if (g == 0) deni[(size_t)t * 4 + h] = a * __expf(fminf(mt[(sc - 1) * 4 + h] - tpm[(size_t)h * P + t], 0.f));
    }
    SchedO1 S{(const char*)QM, (const char*)(p.ws + B_CT), nb, bid, 256, D, 256};
    pg8::gemm_phase((PG8_LAS unsigned char*)lds, S, EpiO1{p.ws});
}
__device__ __forceinline__ void phase_sg(const Params& p, char* lds, int bid, int nb) {
    compute_mtab_lds(p, lds);
    SchedQK S{(const char*)(p.ws + B_QM), (const char*)(p.ws + B_KM), nb, bid, 256, D, D};
    pg8::gemm_phase((PG8_LAS unsigned char*)lds, S, EpiS{p.ws, (const float*)(lds + LDS_MT_OFF)});
}
__device__ __forceinline__ void phase_o2(const Params& p, int l, char* lds, int bid, int nb) {
    phase_m3(p, l, lds, bid, nb, true);
    SchedO2 S{(const char*)(p.ws + B_PM), (const char*)(p.ws + B_VMT), nb, bid, 256, D, P};
    pg8::gemm_phase((PG8_LAS unsigned char*)lds, S, EpiO2{p.ws, p.in[I_MNG] + (size_t)l * D, (float*)(lds + LDS_STAT_OFF)});
}

struct SchedMqkvN { const char* XC; const char* WQ; const char* WK; int G, c; int K, lda, ldb;
    __device__ __forceinline__ bool next(int i, pg8::Unit& u) const { if (!pg8::decode_unit((long)i * G + c, 8, 64, 1, u)) return false; u.pm += 1; return true; }
    __device__ __forceinline__ const char* abase(const pg8::Unit& u) const { return XC + (size_t)(u.grp & 3) * 512 + (size_t)u.pm * 256 * D * 2; }
    __device__ __forceinline__ const char* bbase(const pg8::Unit& u) const { return ((u.grp >> 2) ? WK : WQ) + (size_t)(u.grp & 3) * 65536 * 2; } };
struct SchedMqkvT { const char* XC; const char* XM; const char* WK; const char* WV; int G, c; int K, lda, ldb;
    __device__ __forceinline__ bool next(int i, pg8::Unit& u) const { if (!pg8::decode_unit((long)i * G + c, 8, 1, 64, u)) return false; u.pn += 1; return true; }
    __device__ __forceinline__ const char* abase(const pg8::Unit& u) const { return ((u.grp >> 2) ? WV : WK) + (size_t)(u.grp & 3) * 65536 * 2; }
    __device__ __forceinline__ const char* bbase(const pg8::Unit& u) const { return ((u.grp >> 2) ? XM : XC) + (size_t)(u.grp & 3) * 512 + (size_t)u.pn * 256 * D * 2; } };
struct EpiGrpF { bf16_t* base0; bf16_t* base1; size_t hstride; size_t ldc; float s0, s1;
    __device__ __forceinline__ void operator()(const f32x4 (&acc)[2][2][4][2], const pg8::Unit& u, int wr, int wc, int fr, int fq) const {
        const int which = u.grp >> 2, h = u.grp & 3; const float sc = which ? s1 : s0;
        bf16_t* base = (which ? base1 : base0) + (size_t)h * hstride + (size_t)u.pn * 256;
        const size_t ld = ldc;
        pg8::for_each_piece(acc, u, wr, wc, fr, fq, [&](int row, int col, f32x4 v0, f32x4 v1) { *(u32x4*)(base + (size_t)row * ld + col) = pg8::pack8(v0 * sc, v1 * sc); }); } };
struct EpiMqkvT { unsigned char* ws;
    __device__ __forceinline__ void operator()(const f32x4 (&acc)[2][2][4][2], const pg8::Unit& u, int wr, int wc, int fr, int fq) const {
        bf16_t* KMT = (bf16_t*)(ws + B_KMT); bf16_t* VMT = (bf16_t*)(ws + B_VMT); bf16_t* VWT = (bf16_t*)(ws + B_VWT); const float* tw = (const float*)(ws + TAB_W);
        const int which = u.grp >> 2, h = u.grp & 3; const size_t cb = (size_t)u.pn * 256;
        if (which == 0) { bf16_t* base = KMT + (size_t)h * 256 * P + cb;
            pg8::for_each_piece(acc, u, wr, wc, fr, fq, [&](int row, int col, f32x4 v0, f32x4 v1) { *(u32x4*)(base + (size_t)row * P + col) = pg8::pack8(v0 * 0.0625f, v1 * 0.0625f); });
        } else { bf16_t* b0 = VMT + (size_t)h * 256 * P + cb; bf16_t* b1 = VWT + (size_t)h * 256 * P + cb; const float* w = tw + (size_t)h * P + cb;
            pg8::for_each_piece(acc, u, wr, wc, fr, fq, [&](int row, int col, f32x4 v0, f32x4 v1) { const f32x4 w0 = *(const f32x4*)(w + col), w1 = *(const f32x4*)(w + col + 4);
                *(u32x4*)(b0 + (size_t)row * P + col) = pg8::pack8(v0, v1); *(u32x4*)(b1 + (size_t)row * P + col) = pg8::pack8(v0 * w0, v1 * w1); }); } } };
struct EpiStoreW { bf16_t* C0; bf16_t* C1; size_t ldc; const float* w;
    __device__ __forceinline__ void operator()(int m, int n, f32x4 v) const { store4_bf16(C0 + (size_t)m * ldc + n, v); const f32x4 ww = *(const f32x4*)(w + n); store4_bf16(C1 + (size_t)m * ldc + n, v * ww); } };
__device__ __forceinline__ void phase_mqkv_f(const Params& p, char* lds, int bid, int nb) {
    const int tid = TIDX, wid = tid >> 6, gw = bid * NW + wid, ngw = nb * NW;
    const bf16_t* XC = (const bf16_t*)(p.ws + B_XC); const bf16_t* XM = (const bf16_t*)(p.ws + B_XM);
    const bf16_t* WQ = (const bf16_t*)(p.ws + W_Q_T); const bf16_t* WK = (const bf16_t*)(p.ws + W_K_T); const bf16_t* WV = (const bf16_t*)(p.ws + W_V_T);
    bf16_t* QM = (bf16_t*)(p.ws + B_QM); bf16_t* KM = (bf16_t*)(p.ws + B_KM); bf16_t* KMT = (bf16_t*)(p.ws + B_KMT); bf16_t* VMT = (bf16_t*)(p.ws + B_VMT); bf16_t* VWT = (bf16_t*)(p.ws + B_VWT);
    zero_block(KM, D, VALID0, D, bid * NT + tid, nb * NT);
    zero_block(VWT, P, D, VALID0, bid * NT + tid, nb * NT);
    zero_block(KMT, P, D, VALID0, bid * NT + tid, nb * NT);
    zero_block(VMT, P, D, VALID0, bid * NT + tid, nb * NT);
    for (int t = bid; t < 64; t += nb) {
        const int which = (t >> 4) & 1, h = (t >> 2) & 3, q = t & 3;
        if (t < 32) meta_gemm<1, 4>(RowsPlain{XC + h * 256, D}, RowsPlain{(which ? WK : WQ) + (size_t)h * 65536, 256}, 256, VALID0, q * 64, EpiStore{(which ? KM : QM) + h * 256, D, which ? 0.0625f : 1.f}, lds);
        else if (which == 0) meta_gemm<4, 1>(RowsPlain{WK + (size_t)h * 65536, 256}, RowsPlain{XC + h * 256, D}, 256, q * 64, VALID0, EpiStore{KMT + (size_t)h * 256 * P, P, 0.0625f}, lds);
        else meta_gemm<4, 1>(RowsPlain{WV + (size_t)h * 65536, 256}, RowsPlain{XM + h * 256, D}, 256, q * 64, VALID0, EpiStoreW{VMT + (size_t)h * 256 * P, VWT + (size_t)h * 256 * P, P, (const float*)(p.ws + TAB_W) + (size_t)h * P}, lds);
    }
    { SchedMqkvN S{(const char*)XC, (const char*)WQ, (const char*)WK, nb, bid, 256, D, 256};
      pg8::gemm_phase((PG8_LAS unsigned char*)lds, S, EpiGrpF{QM, KM, 256, D, 1.f, 0.0625f}); }
    { SchedMqkvT S{(const char*)XC, (const char*)XM, (const char*)WK, (const char*)WV, nb, bid, 256, 256, D};
      pg8::gemm_phase((PG8_LAS unsigned char*)lds, S, EpiMqkvT{p.ws}); }
}
struct SchedSq { const char* A; const char* B; int G, c; int K, lda, ldb;
    __device__ __forceinline__ bool next(int i, pg8::Unit& u) const { if (!pg8::decode_unit((long)i * G + c, 1, 64, 4, u)) return false; u.pm += 1; return true; }
    __device__ __forceinline__ const char* abase(const pg8::Unit& u) const { return A + (size_t)u.pm * 256 * D * 2; }
    __device__ __forceinline__ const char* bbase(const pg8::Unit& u) const { return B + (size_t)u.pn * 256 * D * 2; } };
struct EpiBr1F { float* MRG; const bf16_t* GA;
    __device__ __forceinline__ void operator()(const f32x4 (&acc)[2][2][4][2], const pg8::Unit& u, int wr, int wc, int fr, int fq) const {
        const int cb = u.pn * 256;
        pg8::for_each_piece(acc, u, wr, wc, fr, fq, [&](int row, int col, f32x4 v0, f32x4 v1) { const size_t idx = (size_t)row * D + cb + col;
            f32x4 g0, g1; pg8::unpack8(*(const u32x4*)(GA + idx), g0, g1);
            *(f32x4*)(MRG + idx) = v0 * sig4(g0); *(f32x4*)(MRG + idx + 4) = v1 * sig4(g1); }); } };
struct EpiBr2F { const float* MRG; const bf16_t* GB; bf16_t* OUT;
    __device__ __forceinline__ void operator()(const f32x4 (&acc)[2][2][4][2], const pg8::Unit& u, int wr, int wc, int fr, int fq) const {
        const int cb = u.pn * 256;
        pg8::for_each_piece(acc, u, wr, wc, fr, fq, [&](int row, int col, f32x4 v0, f32x4 v1) { const size_t idx = (size_t)row * D + cb + col;
            f32x4 g0, g1; pg8::unpack8(*(const u32x4*)(GB + idx), g0, g1);
            const f32x4 t0 = *(const f32x4*)(MRG + idx), t1 = *(const f32x4*)(MRG + idx + 4);
            *(u32x4*)(OUT + idx) = pg8::pack8(t0 + v0 * sig4(g0), t1 + v1 * sig4(g1)); }); } };
struct EpiOutF { float* Z; const bf16_t* H;
    __device__ __forceinline__ void operator()(const f32x4 (&acc)[2][2][4][2], const pg8::Unit& u, int wr, int wc, int fr, int fq) const {
        const int cb = u.pn * 256;
        pg8::for_each_piece(acc, u, wr, wc, fr, fq, [&](int row, int col, f32x4 v0, f32x4 v1) { const size_t idx = (size_t)row * D + cb + col;
            f32x4 h0, h1; pg8::unpack8(*(const u32x4*)(H + idx), h0, h1);
            *(f32x4*)(Z + idx) = v0 + h0 * DN_ALPHA; *(f32x4*)(Z + idx + 4) = v1 + h1 * DN_ALPHA; }); } };
struct SchedBr { const char* YM; const char* YA; const char* WM; const char* WA; int G, c; int K, lda, ldb;
    __device__ __forceinline__ bool next(int i, pg8::Unit& u) const { if (!pg8::decode_unit((long)(i >> 1) * G + c, 1, 64, 4, u)) return false; u.pm += 1; u.grp = i & 1; return true; }
    __device__ __forceinline__ const char* abase(const pg8::Unit& u) const { return (u.grp ? YA : YM) + (size_t)u.pm * 256 * D * 2; }
    __device__ __forceinline__ const char* bbase(const pg8::Unit& u) const { return (u.grp ? WA : WM) + (size_t)u.pn * 256 * D * 2; } };
__device__ __forceinline__ u32x4 ld16_agent(const bf16_t* ptr) {
    const unsigned long long a = __hip_atomic_load((const unsigned long long*)ptr, __ATOMIC_RELAXED, __HIP_MEMORY_SCOPE_AGENT), b = __hip_atomic_load((const unsigned long long*)ptr + 1, __ATOMIC_RELAXED, __HIP_MEMORY_SCOPE_AGENT);
    u32x4 r; r.x = (unsigned)a; r.y = (unsigned)(a >> 32); r.z = (unsigned)b; r.w = (unsigned)(b >> 32); return r; }
struct EpiBrF { unsigned char* ws;
    __device__ __forceinline__ void operator()(const f32x4 (&acc)[2][2][4][2], const pg8::Unit& u, int wr, int wc, int fr, int fq) const {
        const int cb = u.pn * 256; const bf16_t* G = (const bf16_t*)(ws + (u.grp ? B_GB : B_GA)); bf16_t* O = (bf16_t*)(ws + B_MRGB); const bool second = u.grp != 0;
        pg8::for_each_piece(acc, u, wr, wc, fr, fq, [&](int row, int col, f32x4 v0, f32x4 v1) { const size_t idx = (size_t)row * D + cb + col;
            f32x4 g0, g1; pg8::unpack8(*(const u32x4*)(G + idx), g0, g1);
            f32x4 r0 = v0 * sig4(g0), r1 = v1 * sig4(g1);
            if (second) { f32x4 t0, t1; pg8::unpack8(ld16_agent(O + idx), t0, t1); r0 += t0; r1 += t1; }
            *(u32x4*)(O + idx) = pg8::pack8(r0, r1); }); } };
struct EpiBrS { const bf16_t* G; bf16_t* O; bool second;
    __device__ __forceinline__ void operator()(int m, int n, f32x4 v) const { const u32x2 gg = *(const u32x2*)(G + (size_t)m * D + n);
        f32x4 o; o.x = v.x * sigmoidf_(bf2f(gg.x & 0xffffu)); o.y = v.y * sigmoidf_(bf2f(gg.x >> 16)); o.z = v.z * sigmoidf_(bf2f(gg.y & 0xffffu)); o.w = v.w * sigmoidf_(bf2f(gg.y >> 16));
        if (second) { const unsigned long long t = __hip_atomic_load((const unsigned long long*)(O + (size_t)m * D + n), __ATOMIC_RELAXED, __HIP_MEMORY_SCOPE_AGENT);
            o.x += bf2f((unsigned)t & 0xffffu); o.y += bf2f(((unsigned)t) >> 16); o.z += bf2f((unsigned)(t >> 32) & 0xffffu); o.w += bf2f((unsigned)(t >> 48)); }
        store4_bf16(O + (size_t)m * D + n, o); } };
__device__ __forceinline__ void phase_br_f(const Params& p, char* lds, int bid, int nb) {
    const bf16_t* YM = (const bf16_t*)(p.ws + B_YM); const bf16_t* YA = (const bf16_t*)(p.ws + B_YA);
    const bf16_t* WM = (const bf16_t*)(p.ws + W_BM_T); const bf16_t* WA = (const bf16_t*)(p.ws + W_BA_T); bf16_t* O = (bf16_t*)(p.ws + B_MRGB);
    for (int t = bid; t < 16; t += nb) {
        meta_gemm<1, 4>(RowsPlain{YM, D}, RowsPlain{WM, D}, D, VALID0, t * 64, EpiBrS{(const bf16_t*)(p.ws + B_GA), O, false}, lds);
        asm volatile("s_waitcnt vmcnt(0)" ::: "memory");
        meta_gemm<1, 4>(RowsPlain{YA, D}, RowsPlain{WA, D}, D, VALID0, t * 64, EpiBrS{(const bf16_t*)(p.ws + B_GB), O, true}, lds);
    }
    SchedBr S{(const char*)YM, (const char*)YA, (const char*)WM, (const char*)WA, nb, bid, D, D, D};
    pg8::gemm_phase((PG8_LAS unsigned char*)lds, S, EpiBrF{p.ws});
}
__device__ __forceinline__ void phase_out_f(const Params& p, char* lds, int bid, int nb) {
    const int gw = bid * NW + (TIDX >> 6), ngw = nb * NW;
    const bf16_t* A = (const bf16_t*)(p.ws + B_MRGB); const bf16_t* W = (const bf16_t*)(p.ws + W_OUT_T);
    for (int t = bid; t < 16; t += nb) meta_gemm<1, 4>(RowsPlain{A, D}, RowsPlain{W, D}, D, VALID0, t * 64, EpiOut{(float*)(p.ws + B_Z), (const bf16_t*)(p.ws + B_H)}, lds);
    SchedSq S{(const char*)A, (const char*)W, nb, bid, D, D, D};
    pg8::gemm_phase((PG8_LAS unsigned char*)lds, S, EpiOutF{(float*)(p.ws + B_Z), (const bf16_t*)(p.ws + B_H)});
}

__device__ __forceinline__ void phase_ln1(const Params& p, int l, char* lds, int bid, int nb) {
    const int tid = TIDX, wid = tid >> 6, lane = tid & 63, gw = bid * NW + wid, ngw = nb * NW;
    float* wr = (float*)lds;
    for (int i = tid; i < D * 16 / 4; i += NT) { const int k = i >> 2, q = i & 3; *(f32x4*)(wr + k * 16 + (k >> 2) * 4 + 4 * q) = ((const f32x4*)p.in[I_WR])[i]; }
    unsigned* lcnt = (unsigned*)(lds + 73728); unsigned* lbase = lcnt + 16; int* lrow = (int*)(lds + 73728 + 256) + wid * 64;
    if (tid < 16) lcnt[tid] = 0u;
    __syncthreads();
    const float* Z = (const float*)(p.ws + B_Z); bf16_t* H1 = (bf16_t*)(p.ws + B_H1);
    unsigned* cnt = (unsigned*)(p.ws + WS_CTL) + CW_CNT + l * 16; float* topk = (float*)(p.ws + TAB_TOPK);
    int nrow = 0;
    f32x4 vn[4];
    if (gw < P) {
#pragma unroll
        for (int j = 0; j < 4; ++j) vn[j] = *(const f32x4*)(Z + (size_t)gw * D + 4 * lane + 256 * j); }
    for (int r = gw; r < P; r += ngw) {
        f32x4 v[4];
#pragma unroll
        for (int j = 0; j < 4; ++j) v[j] = vn[j];
        if (r + ngw < P) {
#pragma unroll
            for (int j = 0; j < 4; ++j) vn[j] = *(const f32x4*)(Z + (size_t)(r + ngw) * D + 4 * lane + 256 * j); }
        if (r < VALID0) { store_row_zero(H1 + (size_t)r * D, lane); continue; }
        ln_normalize(v, p.in[I_LN1G] + (size_t)l * D, p.in[I_LN1B] + (size_t)l * D, lane);
        store_row_bf16(H1 + (size_t)r * D, v, lane);
        float lg[16];
#pragma unroll
        for (int e = 0; e < 16; ++e) lg[e] = 0.f;
#pragma unroll
        for (int j = 0; j < 4; ++j)
#pragma unroll
            for (int i = 0; i < 4; ++i) { const int k = 4 * lane + 256 * j + i; const float x = v[j][i];
#pragma unroll
                for (int q = 0; q < 4; ++q) { const f32x4 w = *(const f32x4*)(wr + k * 16 + (k >> 2) * 4 + 4 * q); lg[4 * q] += x * w.x; lg[4 * q + 1] += x * w.y; lg[4 * q + 2] += x * w.z; lg[4 * q + 3] += x * w.w; } }
#pragma unroll
        for (int e = 0; e < 16; ++e) lg[e] = wave_sum(lg[e]);
        if (lane == 0) {
            float mx = lg[0];
#pragma unroll
            for (int e = 1; e < 16; ++e) mx = fmaxf(mx, lg[e]);
            float pr[16], sum = 0.f;
#pragma unroll
            for (int e = 0; e < 16; ++e) { pr[e] = expf(lg[e] - mx); sum += pr[e]; }
            const float isum = 1.f / sum;
            float sel[16];
#pragma unroll
            for (int e = 0; e < 16; ++e) { pr[e] *= isum; sel[e] = pr[e] + p.in[I_RB][e]; }
            int tg = 0; float best = -INFINITY;
#pragma unroll
            for (int gI = 0; gI < 4; ++gI) { const float gs = fmaxf(fmaxf(sel[4 * gI], sel[4 * gI + 1]), fmaxf(sel[4 * gI + 2], sel[4 * gI + 3])); if (gs > best) { best = gs; tg = gI; } }
            int i0 = 0; float b0 = -INFINITY;
#pragma unroll
            for (int e = 0; e < 16; ++e) if ((e >> 2) == tg && sel[e] > b0) { b0 = sel[e]; i0 = e; }
            int i1 = 0; float b1 = -INFINITY;
#pragma unroll
            for (int e = 0; e < 16; ++e) if ((e >> 2) == tg && e != i0 && sel[e] > b1) { b1 = sel[e]; i1 = e; }
            float p0 = 0.f, p1 = 0.f;
#pragma unroll
            for (int e = 0; e < 16; ++e) { if (e == i0) p0 = pr[e]; if (e == i1) p1 = pr[e]; }
            const float inv = 1.f / (p0 + p1);
            const unsigned pos0 = atomicAdd(lcnt + i0, 1u), pos1 = atomicAdd(lcnt + i1, 1u);
            lrow[nrow * 4] = i0; lrow[nrow * 4 + 1] = i1; lrow[nrow * 4 + 2] = (int)pos0; lrow[nrow * 4 + 3] = (int)pos1;
            float* tk = topk + (size_t)r * 8;
            ((int*)tk)[0] = i0; ((int*)tk)[1] = i1; tk[4] = p0 * inv; tk[5] = p1 * inv;
        }
        ++nrow;
    }
    __syncthreads();
    if (tid < 16) lbase[tid] = atomicAdd(cnt + tid, lcnt[tid]);
    __syncthreads();
    if (lane == 0) { int k = 0;
        for (int r = gw; r < P; r += ngw) { if (r < VALID0) continue;
            int* tk = (int*)(topk + (size_t)r * 8); tk[2] = (int)lbase[lrow[k * 4]] + lrow[k * 4 + 2]; tk[3] = (int)lbase[lrow[k * 4 + 1]] + lrow[k * 4 + 3]; ++k; } }
}

__device__ __forceinline__ void expert_offsets(const unsigned* cnt, int* s_cnt, int* s_off, int* s_tiles) {
    int off = 0;
    if (TIDX == 0) { int tt = 0; for (int e = 0; e < 16; ++e) { const int c = (int)cnt[e]; const int tl = (c + 255) >> 8; s_cnt[e] = c; s_off[e] = off; s_tiles[e] = tt; off += tl * 256; tt += tl; } s_tiles[16] = tt; }
    __syncthreads();
}
__device__ __forceinline__ void phase_perm(const Params& p, int l, char* lds, int bid, int nb) {
    int* s_cnt = (int*)(lds + LDS_TAB_OFF); int* s_off = s_cnt + 16; int* s_tiles = s_off + 16;
    expert_offsets((const unsigned*)(p.ws + WS_CTL) + CW_CNT + l * 16, s_cnt, s_off, s_tiles);
    const int tid = TIDX, wid = tid >> 6, lane = tid & 63, gw = bid * NW + wid, ngw = nb * NW;
    const bf16_t* H1 = (const bf16_t*)(p.ws + B_H1); bf16_t* XP = (bf16_t*)(p.ws + B_XP); const float* topk = (const float*)(p.ws + TAB_TOPK);
    int r = VALID0 + gw;
    u32x4 a, b; u32x4 tk;
    if (r < P) { tk = *(const u32x4*)(topk + (size_t)r * 8); const u32x4* src = (const u32x4*)(H1 + (size_t)r * D) + lane * 2; a = src[0]; b = src[1]; }
    while (r < P) {
        const int rn = r + ngw; u32x4 an, bn, tkn;
        if (rn < P) { tkn = *(const u32x4*)(topk + (size_t)rn * 8); const u32x4* src = (const u32x4*)(H1 + (size_t)rn * D) + lane * 2; an = src[0]; bn = src[1]; }
        const int e0 = (int)tk.x, e1 = (int)tk.y, p0 = (int)tk.z, p1 = (int)tk.w;
        u32x4* d0 = (u32x4*)(XP + (size_t)(s_off[e0] + p0) * D) + lane * 2; u32x4* d1 = (u32x4*)(XP + (size_t)(s_off[e1] + p1) * D) + lane * 2;
        d0[0] = a; d0[1] = b; d1[0] = a; d1[1] = b;
        a = an; b = bn; tk = tkn; r = rn;
    }
}
struct SchedMoE { const char* A; const char* B; size_t estride; int nN; const int* s_off; const int* s_tiles; int G, c; int K, lda, ldb;
    __device__ __forceinline__ bool next(int i, pg8::Unit& u) const {
        const int nwg = s_tiles[16] * nN; const long L = (long)i * G + c; if (L >= nwg) return false;
        int wgid = (int)L; { const int q = nwg / 8, r = nwg % 8, xcd = wgid % 8, off = wgid / 8; wgid = (xcd < r ? xcd * (q + 1) : r * (q + 1) + (xcd - r) * q) + off; }
        const int rt = wgid / nN; int e = 0;
        while (e < 15 && rt >= s_tiles[e + 1]) ++e;
        u.grp = __builtin_amdgcn_readfirstlane(e); u.pm = __builtin_amdgcn_readfirstlane((s_off[e] >> 8) + rt - s_tiles[e]); u.pn = __builtin_amdgcn_readfirstlane(wgid % nN); return true; }
    __device__ __forceinline__ const char* abase(const pg8::Unit& u) const { return A + (size_t)u.pm * 256 * D * 2; }
    __device__ __forceinline__ const char* bbase(const pg8::Unit& u) const { return B + (size_t)u.grp * estride + (size_t)u.pn * 256 * D * 2; } };
struct EpiE1F { bf16_t* HID;
    __device__ __forceinline__ void operator()(const f32x4 (&acc)[2][2][4][2], const pg8::Unit& u, int wr, int wc, int fr, int fq) const {
        asm volatile("" : "+v"(fr), "+v"(fq));
        const int row0 = u.pm * 256 + wr * 64 + fr, col0 = u.pn * 128 + wc * 32 + 8 * fq;
#pragma unroll
        for (int ai = 0; ai < 2; ++ai)
#pragma unroll
            for (int m = 0; m < 4; ++m) { f32x4 h0, h1;
#pragma unroll
                for (int r = 0; r < 4; ++r) { h0[r] = siluf_(acc[ai][0][m][0][r]) * acc[ai][1][m][0][r]; h1[r] = siluf_(acc[ai][0][m][1][r]) * acc[ai][1][m][1][r]; }
                *(u32x4*)(HID + (size_t)(row0 + ai * 128 + m * 16) * D + col0) = pg8::pack8(h0, h1); } } };
struct EpiE2F { bf16_t* YB;
    __device__ __forceinline__ void operator()(const f32x4 (&acc)[2][2][4][2], const pg8::Unit& u, int wr, int wc, int fr, int fq) const {
        bf16_t* base = YB + u.pn * 256;
        pg8::for_each_piece(acc, u, wr, wc, fr, fq, [&](int row, int col, f32x4 v0, f32x4 v1) { *(u32x4*)(base + (size_t)row * D + col) = pg8::pack8(v0, v1); }); } };
__device__ __forceinline__ void phase_e1_f(const Params& p, int l, char* lds, int bid, int nb) {
    int* s_cnt = (int*)(lds + LDS_TAB_OFF); int* s_off = s_cnt + 16; int* s_tiles = s_off + 16;
    expert_offsets((const unsigned*)(p.ws + WS_CTL) + CW_CNT + l * 16, s_cnt, s_off, s_tiles);
    SchedMoE S{(const char*)(p.ws + B_XP), (const char*)(p.ws + W_G_T), (size_t)2048 * D * 2, 8, s_off, s_tiles, nb, bid, D, D, D};
    pg8::gemm_phase((PG8_LAS unsigned char*)lds, S, EpiE1F{(bf16_t*)(p.ws + B_HID)});
}
__device__ __forceinline__ void phase_e2_f(const Params& p, int l, char* lds, int bid, int nb) {
    int* s_cnt = (int*)(lds + LDS_TAB_OFF); int* s_off = s_cnt + 16; int* s_tiles = s_off + 16;
    expert_offsets((const unsigned*)(p.ws + WS_CTL) + CW_CNT + l * 16, s_cnt, s_off, s_tiles);
    SchedMoE S{(const char*)(p.ws + B_HID), (const char*)(p.ws + W_D_T), (size_t)D * D * 2, 4, s_off, s_tiles, nb, bid, D, D, D};
    pg8::gemm_phase((PG8_LAS unsigned char*)lds, S, EpiE2F{(bf16_t*)(p.ws + B_YB)});
}

__device__ __forceinline__ void phase_combine(const Params& p, int l, char* lds, int bid, int nb) {
    const int tid = TIDX, wid = tid >> 6, lane = tid & 63, gw = bid * NW + wid, ngw = nb * NW;
    const bool last = (l == DEPTH - 1);
    if (!last) { convert_weights(p, l + 1, lds, gw, ngw, wid, lane); __syncthreads(); }
    int* s_cnt = (int*)(lds + 65536); int* s_off = s_cnt + 16; int* s_tiles = s_off + 16;
    expert_offsets((const unsigned*)(p.ws + WS_CTL) + CW_CNT + l * 16, s_cnt, s_off, s_tiles);
    float* g8 = (float*)lds;
    if (!last) load_gate_w(p, l + 1, g8);
    const bf16_t* H1 = (const bf16_t*)(p.ws + B_H1); const bf16_t* YB = (const bf16_t*)(p.ws + B_YB); bf16_t* H = (bf16_t*)(p.ws + B_H);
    const float* topk = (const float*)(p.ws + TAB_TOPK);
    for (int r = gw; r < P; r += ngw) {
        if (r < VALID0) { if (!last) { store_row_zero(H + (size_t)r * D, lane); gates_row_pad(p, r, lane); } continue; }
        if (last && r < 256) continue;
        const float* tk = topk + (size_t)r * 8;
        const int e0 = ((const int*)tk)[0], e1 = ((const int*)tk)[1], p0 = ((const int*)tk)[2], p1 = ((const int*)tk)[3]; const float w0 = tk[4], w1 = tk[5];
        const bf16_t* y0 = YB + (size_t)(s_off[e0] + p0) * D; const bf16_t* y1 = YB + (size_t)(s_off[e1] + p1) * D; const bf16_t* hr = H1 + (size_t)r * D;
        f32x4 v[4];
#pragma unroll
        for (int j = 0; j < 4; ++j) { const int cc = 4 * lane + 256 * j; const u32x2 a = *(const u32x2*)(y0 + cc), b = *(const u32x2*)(y1 + cc), hh = *(const u32x2*)(hr + cc);
            v[j].x = DN_ALPHA * bf2f(hh.x & 0xffffu) + w0 * bf2f(a.x & 0xffffu) + w1 * bf2f(b.x & 0xffffu);
            v[j].y = DN_ALPHA * bf2f(hh.x >> 16) + w0 * bf2f(a.x >> 16) + w1 * bf2f(b.x >> 16);
            v[j].z = DN_ALPHA * bf2f(hh.y & 0xffffu) + w0 * bf2f(a.y & 0xffffu) + w1 * bf2f(b.y & 0xffffu);
            v[j].w = DN_ALPHA * bf2f(hh.y >> 16) + w0 * bf2f(a.y >> 16) + w1 * bf2f(b.y >> 16); }
        ln_normalize(v, p.in[I_LN2G] + (size_t)l * D, p.in[I_LN2B] + (size_t)l * D, lane);
        if (last) {
            float* o = p.out + (size_t)(r - 256) * D;
#pragma unroll
            for (int j = 0; j < 4; ++j) *(f32x4*)(o + 4 * lane + 256 * j) = v[j];
        } else { store_row_bf16(H + (size_t)r * D, v, lane); gates_row(p, l + 1, g8, v, r, lane); }
    }
}

#define XB_TMO      128
#define XB_XCNT(j)  (256  + 64 * (j))
#define XB_XSUB(j)  (1280 + 64 * (j))
#define XB_XGEN(j)  (2304 + 64 * (j))
#define XB_TOP      3328
#define XB_TOPGEN   3392
#define XCD_BAR_WORDS 3456
#define XB_SPIN_CAP (1u << 18)
#define LAS __attribute__((address_space(3)))

__device__ __forceinline__ unsigned xb_ld(unsigned* p)              { return __hip_atomic_load(p, __ATOMIC_RELAXED, __HIP_MEMORY_SCOPE_AGENT); }
__device__ __forceinline__ unsigned xb_add(unsigned* p, unsigned v) { return __hip_atomic_fetch_add(p, v, __ATOMIC_RELAXED, __HIP_MEMORY_SCOPE_AGENT); }
__device__ __forceinline__ unsigned xb_xcc_id() { return (unsigned)__builtin_amdgcn_s_getreg((3 << 11) | 20) & 0xFu; }
#define XB_SPIN(cond, bar) do { unsigned _sp = 0; while (cond) { __builtin_amdgcn_s_sleep(1); \
    if ((++_sp & 255u) == 0u) { if (xb_ld(&(bar)[XB_TMO])) break; if (_sp > XB_SPIN_CAP) { atomicAdd(&(bar)[XB_TMO], 1u); break; } } } } while (0)

struct XcdBarrier {
    unsigned* bar; unsigned x;
    volatile LAS unsigned* st;
};
__device__ __forceinline__ XcdBarrier xcd_barrier_post(unsigned* bar, volatile LAS unsigned* st) {
    XcdBarrier b; b.bar = bar; b.x = xb_xcc_id(); b.st = st;
    if (threadIdx.x == 0) (void)xb_add(&bar[XB_XCNT(b.x)], 1u);
    return b;
}
__device__ __forceinline__ void xcd_barrier_complete(unsigned* bar, unsigned x, unsigned& nloc, unsigned& nx) {
    const unsigned G = gridDim.x * gridDim.y * gridDim.z;
    unsigned sum, cnt, mine, sp = 0u;
    for (;;) {
        sum = 0u; cnt = 0u; mine = 0u;
#pragma unroll
        for (unsigned j = 0; j < 16; ++j) { const unsigned c = xb_ld(&bar[XB_XCNT(j)]); sum += c; cnt += (c > 0u) ? 1u : 0u; mine = (j == x) ? c : mine; }
        if (sum == G) break;
        __builtin_amdgcn_s_sleep(1);
        if ((++sp & 255u) == 0u) { if (xb_ld(&bar[XB_TMO])) break; if (sp > XB_SPIN_CAP) { atomicAdd(&bar[XB_TMO], 1u); break; } }
    }
    nloc = mine > 0u ? mine : 1u; nx = cnt > 0u ? cnt : 1u;
}
__device__ __forceinline__ void xcd_barrier(const XcdBarrier& b) {
    asm volatile("s_waitcnt vmcnt(0)" ::: "memory");
    __syncthreads();
    if (threadIdx.x == 0) {
        unsigned* bar = b.bar;
        __builtin_amdgcn_s_waitcnt(0);
        unsigned nloc = b.st[0], nx = b.st[1];
        if (nloc == 0u) { xcd_barrier_complete(bar, b.x, nloc, nx); b.st[0] = nloc; b.st[1] = nx; }
        const unsigned old = xb_add(&bar[XB_XSUB(b.x)], 1u);
        const unsigned gen = old / nloc;
        if (old + 1u == (gen + 1u) * nloc) {
            __builtin_amdgcn_fence(__ATOMIC_RELEASE, "agent");
            asm volatile("s_waitcnt vmcnt(0)" ::: "memory");
            const unsigned og = xb_add(&bar[XB_TOP], 1u);
            const unsigned tg = og / nx;
            if (og + 1u == (tg + 1u) * nx) xb_add(&bar[XB_TOPGEN], 1u);
            else XB_SPIN(xb_ld(&bar[XB_TOPGEN]) == tg, bar);
            __builtin_amdgcn_fence(__ATOMIC_ACQUIRE, "agent");
            xb_add(&bar[XB_XGEN(b.x)], 1u);
            asm volatile("s_waitcnt vmcnt(0)" ::: "memory");
        } else {
            XB_SPIN(xb_ld(&bar[XB_XGEN(b.x)]) == gen, bar);
            __builtin_amdgcn_fence(__ATOMIC_ACQUIRE, "agent");
            asm volatile("s_waitcnt vmcnt(0)" ::: "memory");
        }
    }
    __syncthreads();
}

constexpr int LDS_BYTES = 131072 + 12288;
constexpr int LDS_BAR_OFF = LDS_BYTES - 16;
constexpr int CW_BAR = 4096;
template <int L>
__device__ __forceinline__ void layer_body(const Params& p, char* lds, int bid, int nb, const XcdBarrier& bar) {
    phase_proj_f(p, lds, bid, nb); xcd_barrier(bar);
    phase_attn_f(p, L, lds, bid, nb); xcd_barrier(bar);
    phase_conv(p, L, lds, bid, nb); xcd_barrier(bar);
    phase_mqkv_f(p, lds, bid, nb); xcd_barrier(bar);
    phase_ms(p, lds, bid, nb); phase_sg(p, lds, bid, nb); xcd_barrier(bar);
    phase_m2(p, lds, bid, nb); xcd_barrier(bar);
    phase_o1(p, lds, bid, nb); xcd_barrier(bar);
    phase_o2(p, L, lds, bid, nb); xcd_barrier(bar);
    phase_br_f(p, lds, bid, nb); xcd_barrier(bar);
    phase_out_f(p, lds, bid, nb); xcd_barrier(bar);
    phase_ln1(p, L, lds, bid, nb); xcd_barrier(bar);
    phase_perm(p, L, lds, bid, nb); xcd_barrier(bar);
    phase_e1_f(p, L, lds, bid, nb); xcd_barrier(bar);
    phase_e2_f(p, L, lds, bid, nb); xcd_barrier(bar);
    phase_combine(p, L, lds, bid, nb); if (L + 1 < DEPTH) xcd_barrier(bar);
}
__global__ void __launch_bounds__(NT, 2) fwd_kernel(Params p) {
    extern __shared__ __attribute__((aligned(16))) char lds[];
    const int bid = blockIdx.x, nb = gridDim.x;
    if (threadIdx.x == 0) *(uint4*)(lds + LDS_BAR_OFF) = make_uint4(0u, 0u, 0u, 0u);
    __syncthreads();
    XcdBarrier bar = xcd_barrier_post((unsigned*)(p.ws + WS_CTL) + CW_BAR, (volatile LAS unsigned*)(lds + LDS_BAR_OFF));
    phase_prologue(p, lds, bid, nb); xcd_barrier(bar);
    layer_body<0>(p, lds, bid, nb, bar);
    layer_body<1>(p, lds, bid, nb, bar);
}

extern "C" void kernel_launch(void* const* d_in, const int* in_sizes, int n_in, void* d_out, int out_size, void* d_ws, size_t ws_size, hipStream_t stream) {
    if (n_in != 30 || ws_size < WS_END) { fprintf(stderr, "kernel_launch: unexpected n_in %d or ws_size %zu (< %zu)\n", n_in, ws_size, (size_t)WS_END); return; }
    static int grid = 0;
    if (grid == 0) {
        int dev = 0, cus = 0;
        if (hipGetDevice(&dev) != hipSuccess || hipDeviceGetAttribute(&cus, hipDeviceAttributeMultiprocessorCount, dev) != hipSuccess || cus <= 0) cus = 256;
        (void)hipFuncSetAttribute((const void*)fwd_kernel, hipFuncAttributeMaxDynamicSharedMemorySize, LDS_BYTES);
        grid = cus;
    }
    Params p{};
    for (int i = 0; i < 30; ++i) p.in[i] = (const float*)d_in[i];
    p.out = (float*)d_out; p.ws = (unsigned char*)d_ws;
    (void)hipMemsetAsync((char*)d_ws + WS_CTL, 0, CTL_BYTES, stream);
    hipLaunchKernelGGL(fwd_kernel, dim3(grid), dim3(NT), LDS_BYTES, stream, p);
}
```

```cpp
#include <hip/hip_runtime.h>
#include <cstdio>
#include <cstdint>

constexpr int D = 1024;
constexpr int SEQ = 16384;
constexpr int NMETA = 16;
constexpr int P = 16640;
constexpr int VALID0 = 240;
constexpr int DEPTH = 2;
constexpr int DIN = 7176;
constexpr int NSC = 65;
constexpr int NEXP = 16;
constexpr float LN_EPS = 1e-5f;
constexpr float DN_ALPHA = 1.4142135623730951f;
constexpr float NEGBIG = -1e30f;
constexpr float QA_PRESCALE = 0.18033688011112042f;
constexpr int NT = 512;
constexpr int NW = 8;

typedef unsigned short bf16_t;
typedef short bf16x8 __attribute__((ext_vector_type(8)));
typedef float f32x4 __attribute__((ext_vector_type(4)));
typedef unsigned u32x4 __attribute__((ext_vector_type(4)));
typedef unsigned u32x2 __attribute__((ext_vector_type(2)));

constexpr size_t MiB = 1u << 20;
constexpr size_t RB = (size_t)P * D * 2;
constexpr size_t WS_CTL = 0;
constexpr size_t CTL_BYTES = 1 * MiB;
constexpr size_t WS_TAB = 1 * MiB;
constexpr size_t TAB_GLI = WS_TAB;
constexpr size_t TAB_GLF = TAB_GLI + 4 * P * 4;
constexpr size_t TAB_B   = TAB_GLF + 4 * P * 4;
constexpr size_t TAB_E   = TAB_B + 4 * P * 4;
constexpr size_t TAB_PM  = TAB_E + 4 * P * 4;
constexpr size_t TAB_W   = TAB_PM + 4 * P * 4;
constexpr size_t TAB_SCG = TAB_W + 4 * P * 4;
constexpr size_t TAB_SCM = TAB_SCG + 4096;
constexpr size_t TAB_MT  = TAB_SCM + 4096;
constexpr size_t TAB_NT  = TAB_MT + 4096;
constexpr size_t TAB_TOPK = TAB_NT + (size_t)NSC * 4 * 256 * 4;
constexpr size_t TAB_ELIST = TAB_TOPK + (size_t)P * 32;
constexpr size_t TAB_DENP = TAB_ELIST + (size_t)NEXP * P * 4;
constexpr size_t TAB_DENI = TAB_DENP + (size_t)P * 16 * 4;
constexpr size_t TAB_END = TAB_DENI + (size_t)P * 4 * 4;
static_assert(TAB_END <= 8 * MiB, "tables");
constexpr size_t WS_W = 8 * MiB;
constexpr size_t W_IN_T = WS_W;
constexpr size_t W_Q_T = W_IN_T + (size_t)7168 * 1024 * 2;
constexpr size_t W_K_T = W_Q_T + 4 * 65536 * 2;
constexpr size_t W_V_T = W_K_T + 4 * 65536 * 2;
constexpr size_t W_BM_T = W_V_T + 4 * 65536 * 2;
constexpr size_t W_BA_T = W_BM_T + (size_t)D * D * 2;
constexpr size_t W_OUT_T = W_BA_T + (size_t)D * D * 2;
constexpr size_t W_G_T = W_OUT_T + (size_t)D * D * 2;
constexpr size_t W_U_T = W_G_T + (size_t)NEXP * D * D * 2;
constexpr size_t W_D_T = W_U_T + (size_t)NEXP * D * D * 2;
constexpr size_t W_END = W_D_T + (size_t)NEXP * D * D * 2;
static_assert(W_END <= 128 * MiB, "weights");
constexpr size_t WS_SLOT = 128 * MiB;
constexpr size_t SLOT(int i) { return WS_SLOT + (size_t)i * RB; }
constexpr size_t WS_END = WS_SLOT + 12 * RB;
constexpr size_t B_H = SLOT(0);
constexpr size_t B_XM = SLOT(1), B_PM = SLOT(1);
constexpr size_t B_OP = SLOT(2), B_MRGB = SLOT(2);
constexpr size_t B_QA = SLOT(3), B_QM = SLOT(3), B_MRG = SLOT(3);
constexpr size_t B_KA = SLOT(4), B_XC = SLOT(4), B_CT = SLOT(4);
constexpr size_t B_KM = SLOT(5), B_OI = SLOT(5), B_H1 = SLOT(5);
constexpr size_t B_GA = SLOT(6);
constexpr size_t B_GB = SLOT(7);
constexpr size_t B_YA = SLOT(8);
constexpr size_t B_KMT = SLOT(9), B_YM = SLOT(9);
constexpr size_t B_VA = SLOT(10), B_VMT = SLOT(10);
constexpr size_t B_VWT = SLOT(11);
constexpr size_t B_Z = SLOT(10);
constexpr size_t B_HID = SLOT(6);
constexpr size_t B_XP = SLOT(1);
constexpr size_t B_YB = SLOT(9);
constexpr int HID_ROWS_MAX = (int)(3 * RB / (D * 2));
constexpr int CW_CNT = 64;

struct Params {
    const float* in[30];
    float* out;
    unsigned char* ws;
};
enum { I_X = 0, I_META, I_LNG, I_LNB, I_WIN, I_CONVW, I_CONVB, I_WQM, I_WKM, I_WVM, I_BI, I_BF, I_MNG, I_LQ1, I_LK1, I_LQ2, I_LK2, I_ANG,
       I_WBM, I_WBA, I_WOUT, I_LN1G, I_LN1B, I_LN2G, I_LN2B, I_WR, I_RB, I_WG, I_WU, I_WD };

__device__ __forceinline__ int tid_opaque() { int t = threadIdx.x; asm volatile("" : "+v"(t)); return t; }
#define TIDX tid_opaque()
__device__ __forceinline__ float bf2f(unsigned v) { return __uint_as_float(v << 16); }
__device__ __forceinline__ unsigned f2bf(float f) { unsigned u = __float_as_uint(f); return (u + 0x7fffu + ((u >> 16) & 1u)) >> 16; }
__device__ __forceinline__ unsigned pk2(float lo, float hi) { return f2bf(lo) | (f2bf(hi) << 16); }
template <int M> __device__ __forceinline__ float sx(float v) {
    static_assert(M == 1 || M == 2 || M == 4 || M == 8 || M == 16, "sx: xor mask within 32 lanes");
    return __int_as_float(__builtin_amdgcn_ds_swizzle(__float_as_int(v), 0x1f | (M << 10)));
}
__device__ __forceinline__ float sum32(float v) {
    auto rr = __builtin_amdgcn_permlane32_swap(__float_as_uint(v), __float_as_uint(v), false, false);
    return __uint_as_float(rr[0]) + __uint_as_float(rr[1]);
}
__device__ __forceinline__ float wave_sum(float v) {
    v += sx<1>(v); v += sx<2>(v); v += sx<4>(v); v += sx<8>(v); v += sx<16>(v); v = sum32(v);
    return v;
}
__device__ __forceinline__ float sigmoidf_(float x) { return 1.f / (1.f + __expf(-x)); }
__device__ __forceinline__ float siluf_(float x) { return x / (1.f + __expf(-x)); }
__device__ __forceinline__ float logsigmoidf_(float x) { return x >= 0.f ? -log1pf(__expf(-x)) : x - log1pf(__expf(x)); }
__device__ __forceinline__ f32x4 sig4(f32x4 v) { f32x4 o; o.x = sigmoidf_(v.x); o.y = sigmoidf_(v.y); o.z = sigmoidf_(v.z); o.w = sigmoidf_(v.w); return o; }
__device__ __forceinline__ f32x4 mfma16(bf16x8 a, bf16x8 b, f32x4 c) { return __builtin_amdgcn_mfma_f32_16x16x32_bf16(a, b, c, 0, 0, 0); }
__device__ __forceinline__ bf16x8 ld8(const bf16_t* p) { return *(const bf16x8*)p; }

__device__ __forceinline__ void transpose_item(const float* W, int K, size_t ldsrc, int k0, int n_src0, bf16_t* WT, int dst_row0, float* scr, int lane) {
#pragma unroll 8
    for (int i = 0; i < 32; ++i) { const int kk = 2 * i + (lane >> 5); scr[kk * 33 + (lane & 31)] = W[(size_t)(k0 + kk) * ldsrc + n_src0 + (lane & 31)]; }
    __builtin_amdgcn_wave_barrier();
    asm volatile("s_waitcnt lgkmcnt(0)" ::: "memory");
    const int c = lane & 7;
#pragma unroll
    for (int j = 0; j < 4; ++j) { const int n = (lane >> 3) + 8 * j; const float* s = scr + (8 * c) * 33 + n;
        u32x4 o; o.x = pk2(s[0 * 33], s[1 * 33]); o.y = pk2(s[2 * 33], s[3 * 33]); o.z = pk2(s[4 * 33], s[5 * 33]); o.w = pk2(s[6 * 33], s[7 * 33]);
        *(u32x4*)(WT + (size_t)(dst_row0 + n) * K + k0 + 8 * c) = o; }
    asm volatile("s_waitcnt lgkmcnt(0)" ::: "memory");
    __builtin_amdgcn_wave_barrier();
}
__device__ __forceinline__ void convert_weights(const Params& p, int l, char* lds, int gw, int ngw, int wid, int lane) {
    float* scr = (float*)lds + wid * (64 * 33);
    unsigned char* ws = p.ws;
    constexpr int I_IN = 16 * 224, I_QKV = 3 * 4 * 4 * 8, I_SQ = 16 * 32, I_EXP = 3 * 16 * 512;
    constexpr int TOTAL = I_IN + I_QKV + 3 * I_SQ + I_EXP;
    for (int it = gw; it < TOTAL; it += ngw) {
        int r = it;
        if (r < I_IN) { const int kb = r / 224, nb = r % 224, r0 = nb * 32, nsrc = r0 < 2048 ? r0 : r0 + 8;
            transpose_item(p.in[I_WIN] + (size_t)l * D * DIN, D, DIN, kb * 64, nsrc, (bf16_t*)(ws + W_IN_T), r0, scr, lane); continue; }
        r -= I_IN;
        if (r < I_QKV) { const int w = r / 128, rr = r % 128, h = rr / 32, t = rr % 32, kb = t / 8, nb = t % 8;
            const float* src = p.in[w == 0 ? I_WQM : (w == 1 ? I_WKM : I_WVM)] + ((size_t)l * 4 + h) * 65536;
            bf16_t* dst = (bf16_t*)(ws + (w == 0 ? W_Q_T : (w == 1 ? W_K_T : W_V_T))) + (size_t)h * 65536;
            transpose_item(src, 256, 256, kb * 64, nb * 32, dst, nb * 32, scr, lane); continue; }
        r -= I_QKV;
        if (r < 3 * I_SQ) { const int w = r / I_SQ, t = r % I_SQ, kb = t / 32, nb = t % 32;
            const float* src = p.in[w == 0 ? I_WBM : (w == 1 ? I_WBA : I_WOUT)] + (size_t)l * D * D;
            bf16_t* dst = (bf16_t*)(ws + (w == 0 ? W_BM_T : (w == 1 ? W_BA_T : W_OUT_T)));
            transpose_item(src, D, D, kb * 64, nb * 32, dst, nb * 32, scr, lane); continue; }
        r -= 3 * I_SQ;
        { const int w = r / (16 * 512), rr = r % (16 * 512), e = rr / 512, t = rr % 512, kb = t / 32, nb = t % 32;
            const float* src = p.in[w == 0 ? I_WG : (w == 1 ? I_WU : I_WD)] + ((size_t)l * NEXP + e) * D * D;
            if (w == 2) transpose_item(src, D, D, kb * 64, nb * 32, (bf16_t*)(ws + W_D_T) + (size_t)e * D * D, nb * 32, scr, lane);
            else { const int j0 = nb * 32; transpose_item(src, D, D, kb * 64, j0, (bf16_t*)(ws + W_G_T) + (size_t)e * 2048 * D, 256 * (j0 >> 7) + (j0 & 127) + (w == 1 ? 128 : 0), scr, lane); } }
    }
}

__device__ __forceinline__ void ln_normalize(f32x4 (&v)[4], const float* g, const float* b, int lane) {
    float s = 0.f;
#pragma unroll
    for (int j = 0; j < 4; ++j) s += (v[j].x + v[j].y) + (v[j].z + v[j].w);
    const float mean = wave_sum(s) * (1.f / D);
    float s2 = 0.f;
#pragma unroll
    for (int j = 0; j < 4; ++j) { v[j] = v[j] - mean; s2 += (v[j].x * v[j].x + v[j].y * v[j].y) + (v[j].z * v[j].z + v[j].w * v[j].w); }
    const float rstd = rsqrtf(wave_sum(s2) * (1.f / D) + LN_EPS);
#pragma unroll
    for (int j = 0; j < 4; ++j) { const f32x4 gg = *(const f32x4*)(g + 4 * lane + 256 * j), bb = *(const f32x4*)(b + 4 * lane + 256 * j); v[j] = v[j] * rstd * gg + bb; }
}
__device__ __forceinline__ void store_row_bf16(bf16_t* row, const f32x4 (&v)[4], int lane) {
#pragma unroll
    for (int j = 0; j < 4; ++j) { u32x2 o; o.x = pk2(v[j].x, v[j].y); o.y = pk2(v[j].z, v[j].w); *(u32x2*)(row + 4 * lane + 256 * j) = o; }
}
__device__ __forceinline__ void store_row_zero(bf16_t* row, int lane) {
#pragma unroll
    for (int j = 0; j < 4; ++j) { u32x2 o; o.x = 0u; o.y = 0u; *(u32x2*)(row + 4 * lane + 256 * j) = o; }
}
__device__ __forceinline__ void load_gate_w(const Params& p, int l, float* g8) {
    const float* w = p.in[I_WIN] + (size_t)l * D * DIN + 2048;
    for (int i = TIDX; i < D * 8; i += NT) { const int k = i >> 3, c = i & 7; g8[k * 8 + (k >> 2) * 4 + c] = w[(size_t)k * DIN + c]; }
    __syncthreads();
}
__device__ __forceinline__ void gates_row(const Params& p, int l, const float* g8, const f32x4 (&v)[4], int prow, int lane) {
    float acc[8];
#pragma unroll
    for (int c = 0; c < 8; ++c) acc[c] = 0.f;
#pragma unroll
    for (int j = 0; j < 4; ++j)
#pragma unroll
        for (int i = 0; i < 4; ++i) { const int k = 4 * lane + 256 * j + i; const float x = v[j][i];
            const f32x4 w0 = *(const f32x4*)(g8 + k * 8 + (k >> 2) * 4), w1 = *(const f32x4*)(g8 + k * 8 + (k >> 2) * 4 + 4);
            acc[0] += x * w0.x; acc[1] += x * w0.y; acc[2] += x * w0.z; acc[3] += x * w0.w; acc[4] += x * w1.x; acc[5] += x * w1.y; acc[6] += x * w1.z; acc[7] += x * w1.w; }
#pragma unroll
    for (int c = 0; c < 8; ++c) acc[c] = wave_sum(acc[c]);
    if (lane < 4) {
        float* gli = (float*)(p.ws + TAB_GLI); float* glf = (float*)(p.ws + TAB_GLF);
        const float bi = p.in[I_BI][l * 4 + lane], bfv = p.in[I_BF][l * 4 + lane];
        float ai = acc[0], af = acc[4];
        if (lane == 1) { ai = acc[1]; af = acc[5]; } else if (lane == 2) { ai = acc[2]; af = acc[6]; } else if (lane == 3) { ai = acc[3]; af = acc[7]; }
        gli[(size_t)lane * P + prow] = ai + bi;
        glf[(size_t)lane * P + prow] = logsigmoidf_(af + bfv);
    }
}
__device__ __forceinline__ void gates_row_pad(const Params& p, int prow, int lane) {
    if (lane < 4) { ((float*)(p.ws + TAB_GLI))[(size_t)lane * P + prow] = NEGBIG; ((float*)(p.ws + TAB_GLF))[(size_t)lane * P + prow] = 0.f; }
}

__device__ __forceinline__ void phase_prologue(const Params& p, char* lds, int bid, int nb) {
    const int tid = TIDX, wid = tid >> 6, lane = tid & 63, gw = bid * NW + wid, ngw = nb * NW;
    convert_weights(p, 0, lds, gw, ngw, wid, lane);
    __syncthreads();
    float* g8 = (float*)lds;
    load_gate_w(p, 0, g8);
    bf16_t* H = (bf16_t*)(p.ws + B_H);
    f32x4 vn[4];
#pragma unroll
    for (int j = 0; j < 4; ++j) vn[j] = (f32x4){0.f, 0.f, 0.f, 0.f};
#define PRO_SRC(r_) ((r_) < 256 ? p.in[I_META] + (size_t)((r_) - VALID0) * D : p.in[I_X] + (size_t)((r_) - 256) * D)
    if (gw >= VALID0 && gw < P) {
#pragma unroll
        for (int j = 0; j < 4; ++j) vn[j] = *(const f32x4*)(PRO_SRC(gw) + 4 * lane + 256 * j); }
    for (int r = gw; r < P; r += ngw) {
        f32x4 v[4];
#pragma unroll
        for (int j = 0; j < 4; ++j) v[j] = vn[j];
        { const int rn = r + ngw; if (rn >= VALID0 && rn < P) {
#pragma unroll
            for (int j = 0; j < 4; ++j) vn[j] = *(const f32x4*)(PRO_SRC(rn) + 4 * lane + 256 * j); } }
        if (r < VALID0) { store_row_zero(H + (size_t)r * D, lane); gates_row_pad(p, r, lane); continue; }
        ln_normalize(v, p.in[I_LNG], p.in[I_LNB], lane);
        store_row_bf16(H + (size_t)r * D, v, lane);
        gates_row(p, 0, g8, v, r, lane);
    }
}

struct RowsPlain { const bf16_t* base; size_t ld; __device__ __forceinline__ const bf16_t* row(int m) const { return base + (size_t)m * ld; } };
__device__ __forceinline__ void store4_bf16(bf16_t* dst, f32x4 v) { u32x2 o; o.x = pk2(v.x, v.y); o.y = pk2(v.z, v.w); *(u32x2*)dst = o; }

struct EpiProj { unsigned char* ws;
    __device__ __forceinline__ void operator()(int m, int n, f32x4 v) const {
        const int seg = n >> 10, cc = n & 1023;
        const size_t off = seg == 0 ? B_XM : seg == 1 ? B_OP : seg == 2 ? B_QA : seg == 3 ? B_KA : seg == 4 ? B_VA : seg == 5 ? B_GA : B_GB;
        store4_bf16((bf16_t*)(ws + off) + (size_t)m * D + cc, seg == 2 ? v * QA_PRESCALE : v); } };
struct EpiStore { bf16_t* C; size_t ldc; float scale;
    __device__ __forceinline__ void operator()(int m, int n, f32x4 v) const { store4_bf16(C + (size_t)m * ldc + n, v * scale); } };
namespace pg8 {
#define PG8_LAS __attribute__((address_space(3)))
constexpr int BM = 256, BK = 64, HALF = 128, HTB = HALF * BK * 2, STAGE_BYTES = 8 * HTB, NXCD = 8, WGM = 8;
__host__ __device__ __forceinline__ int lds_byte(int r, int c) { const int st = (r >> 4) * 2 + (c >> 5), rr = r & 15, cc = c & 31, ob = rr * 64 + cc * 2; return st * 1024 + (ob ^ (((ob >> 9) & 1) << 5)); }
__host__ __device__ __forceinline__ void stage_rc(int b, int& R, int& C) { const int st = b / 1024, sb = b % 1024, swz = sb ^ (((sb >> 9) & 1) << 5); R = (st >> 1) * 16 + swz / 64; C = (st & 1) * 32 + (swz % 64) / 2; }
__host__ __device__ __forceinline__ int perm32(int rho) { const int n = rho >> 4, i = rho & 15; return 8 * (i >> 2) + 4 * n + (i & 3); }
struct Unit { int pm, pn, grp; };
__device__ __forceinline__ bool decode_unit(long L, int nG, int nM, int nN, Unit& u) {
    const int nwg = nG * nM * nN; if (L >= nwg) return false;
    int wgid = (int)L; { const int q = nwg / NXCD, r = nwg % NXCD, xcd = wgid % NXCD, off = wgid / NXCD; wgid = (xcd < r ? xcd * (q + 1) : r * (q + 1) + (xcd - r) * q) + off; }
    const int per = nM * nN; u.grp = wgid / per; const int rem = wgid % per;
    const int nig = WGM * nN, gid = rem / nig, fm = gid * WGM, gsz = (nM - fm) < WGM ? (nM - fm) : WGM;
    u.pm = __builtin_amdgcn_readfirstlane(fm + ((rem % nig) % gsz)); u.pn = __builtin_amdgcn_readfirstlane((rem % nig) / gsz); u.grp = __builtin_amdgcn_readfirstlane(u.grp); return true;
}
__device__ __forceinline__ unsigned cvt_pk_bf16(float lo, float hi) { unsigned r; asm volatile("v_cvt_pk_bf16_f32 %0, %1, %2" : "=v"(r) : "v"(lo), "v"(hi)); return r; }

template <class Epi, class Sched, bool ALIGN_EPI = true>
__device__ __forceinline__ void gemm_phase(PG8_LAS unsigned char* lds, const Sched& S, const Epi& E) {
    const int tid = TIDX, wid = __builtin_amdgcn_readfirstlane(tid >> 6), lane = tid & 63, wr = wid >> 2, wc = wid & 3, fr = lane & 15, fq = lane >> 4;
    const int K = S.K, nt = K / BK;
    unsigned voffA[2], voffB[2];
#pragma unroll
    for (int i = 0; i < 2; ++i) { int R, C; stage_rc(tid * 16 + i * 8192, R, C); const int Rb = (R & ~31) + perm32(R & 31);
        voffA[i] = (unsigned)(R * S.lda + C) * 2u; voffB[i] = (unsigned)(Rb * S.ldb + C) * 2u; }
    const size_t kstep = (size_t)(BK * 2);
    const size_t hstepA = (size_t)HALF * S.lda * 2, hstepB = (size_t)HALF * S.ldb * 2;
    const unsigned ldsw = (unsigned)wid * 1024u;
    const int aoff = lds_byte(wr * 64 + fr, fq * 8), boff = lds_byte(wc * 32 + fr, fq * 8);
#define PG8_SA(b, h) (((b) * 2 + (h)) * HTB)
#define PG8_SB(b, h) ((4 + (b) * 2 + (h)) * HTB)
#define PG8_STAGE(bufoff, gbase, voff) do { _Pragma("unroll") for (int _i = 0; _i < 2; ++_i) \
        __builtin_amdgcn_global_load_lds((const unsigned*)((const char*)(gbase) + (voff)[_i]), (PG8_LAS unsigned*)(lds + (bufoff) + ldsw + _i * 8192), 16, 0, 0); } while (0)
#define PG8_LDA(dst, b, h) do { _Pragma("unroll") for (int m = 0; m < 4; ++m) _Pragma("unroll") for (int k = 0; k < 2; ++k) dst[m][k] = *(const PG8_LAS bf16x8*)(lds + PG8_SA(b, h) + aoff + m * 2048 + k * 1024); } while (0)
#define PG8_LDB(dst, b, h) do { _Pragma("unroll") for (int n = 0; n < 2; ++n) _Pragma("unroll") for (int k = 0; k < 2; ++k) dst[n][k] = *(const PG8_LAS bf16x8*)(lds + PG8_SB(b, h) + boff + n * 2048 + k * 1024); } while (0)
#define PG8_MMA(ai, bj, At, Bt) do { __builtin_amdgcn_s_setprio(1); _Pragma("unroll") for (int m = 0; m < 4; ++m) _Pragma("unroll") for (int n = 0; n < 2; ++n) _Pragma("unroll") for (int k = 0; k < 2; ++k) \
        acc[ai][bj][m][n] = __builtin_amdgcn_mfma_f32_16x16x32_bf16(Bt[n][k], At[m][k], acc[ai][bj][m][n], 0, 0, 0); __builtin_amdgcn_s_setprio(0); } while (0)
#define PG8_WAIT_V(n) asm volatile("s_waitcnt vmcnt(" #n ")" ::: "memory")
#define PG8_WAIT_L(n) asm volatile("s_waitcnt lgkmcnt(" #n ")" ::: "memory")
#define PG8_BAR __builtin_amdgcn_s_barrier()
#define PG8_SCHED __builtin_amdgcn_sched_barrier(0)
    Unit cur, nxt; int ui = 0;
    if (!S.next(0, cur)) return;
    f32x4 acc[2][2][4][2];
#pragma unroll
    for (int a = 0; a < 2; ++a)
#pragma unroll
        for (int b = 0; b < 2; ++b)
#pragma unroll
            for (int m = 0; m < 4; ++m)
#pragma unroll
                for (int n = 0; n < 2; ++n) acc[a][b][m][n] = (f32x4){0.f, 0.f, 0.f, 0.f};
    bf16x8 At[4][2], B0[2][2], B1[2][2];
    const char* cA = S.abase(cur); const char* cB = S.bbase(cur);
    PG8_STAGE(PG8_SB(0, 0), cB, voffB); PG8_STAGE(PG8_SB(0, 1), cB + hstepB, voffB); PG8_STAGE(PG8_SA(0, 0), cA, voffA); PG8_STAGE(PG8_SA(0, 1), cA + hstepA, voffA);
    if (wr == 1) PG8_BAR;
    PG8_WAIT_V(2); PG8_BAR;
    PG8_STAGE(PG8_SB(1, 0), cB + kstep, voffB); PG8_STAGE(PG8_SA(1, 0), cA + kstep, voffA); PG8_STAGE(PG8_SB(1, 1), cB + hstepB + kstep, voffB);
    PG8_WAIT_V(6); PG8_BAR;
    for (;;) {
        const bool has_next = S.next(ui + 1, nxt);
        const char* nA = has_next ? S.abase(nxt) : cA; const char* nB = has_next ? S.bbase(nxt) : cB;
        for (int t = 0; t < nt; t += 2) {
            const bool last = (t == nt - 2);
            const char* a1 = cA + (size_t)(t + 1) * kstep;
            const char* a2 = last ? nA : cA + (size_t)(t + 2) * kstep; const char* b2 = last ? nB : cB + (size_t)(t + 2) * kstep;
            const char* a3 = a2 + kstep; const char* b3 = b2 + kstep;
            PG8_LDB(B0, 0, 0); PG8_LDB(B1, 0, 1); PG8_SCHED; PG8_LDA(At, 0, 0); PG8_STAGE(PG8_SA(1, 1), a1 + hstepA, voffA);
            PG8_WAIT_V(8); PG8_WAIT_L(0); PG8_BAR; PG8_MMA(0, 0, At, B0); PG8_MMA(0, 1, At, B1); PG8_BAR; PG8_SCHED;
            PG8_LDA(At, 0, 1); PG8_STAGE(PG8_SB(0, 0), b2, voffB); PG8_STAGE(PG8_SB(0, 1), b2 + hstepB, voffB); PG8_STAGE(PG8_SA(0, 0), a2, voffA);
            PG8_WAIT_V(8); PG8_WAIT_L(0); PG8_BAR; PG8_MMA(1, 0, At, B0); PG8_MMA(1, 1, At, B1); PG8_BAR; PG8_SCHED;
            PG8_LDB(B0, 1, 0); PG8_LDB(B1, 1, 1); PG8_SCHED; PG8_LDA(At, 1, 0); PG8_STAGE(PG8_SA(0, 1), a2 + hstepA, voffA);
            PG8_WAIT_V(8); PG8_WAIT_L(0); PG8_BAR; PG8_MMA(0, 0, At, B0); PG8_MMA(0, 1, At, B1); PG8_BAR; PG8_SCHED;
            PG8_LDA(At, 1, 1); PG8_STAGE(PG8_SB(1, 0), b3, voffB); PG8_STAGE(PG8_SB(1, 1), b3 + hstepB, voffB); PG8_STAGE(PG8_SA(1, 0), a3, voffA);
            PG8_WAIT_V(8); PG8_WAIT_L(0); PG8_BAR; PG8_MMA(1, 0, At, B0); PG8_MMA(1, 1, At, B1); PG8_BAR; PG8_SCHED;
        }
        if constexpr (ALIGN_EPI) { if (wr == 0) PG8_BAR; }
        E(acc, cur, wr, wc, fr, fq);
        if (!has_next) break;
#pragma unroll
        for (int a = 0; a < 2; ++a)
#pragma unroll
            for (int b = 0; b < 2; ++b)
#pragma unroll
                for (int m = 0; m < 4; ++m)
#pragma unroll
                    for (int n = 0; n < 2; ++n) acc[a][b][m][n] = (f32x4){0.f, 0.f, 0.f, 0.f};
        cur = nxt; cA = nA; cB = nB; ++ui;
        if constexpr (ALIGN_EPI) { if (wr == 1) PG8_BAR; }
    }
    PG8_WAIT_V(0);
    if constexpr (!ALIGN_EPI) { if (wr == 0) PG8_BAR; }
    PG8_BAR;
#undef PG8_SA
#undef PG8_SB
#undef PG8_STAGE
#undef PG8_LDA
#undef PG8_LDB
#undef PG8_MMA
#undef PG8_WAIT_V
#undef PG8_WAIT_L
#undef PG8_BAR
#undef PG8_SCHED
}
__device__ __forceinline__ u32x4 pack8(f32x4 v0, f32x4 v1) { u32x4 w; w.x = cvt_pk_bf16(v0[0], v0[1]); w.y = cvt_pk_bf16(v0[2], v0[3]); w.z = cvt_pk_bf16(v1[0], v1[1]); w.w = cvt_pk_bf16(v1[2], v1[3]); return w; }
__device__ __forceinline__ void unpack8(u32x4 w, f32x4& v0, f32x4& v1) {
    v0[0] = __uint_as_float(w.x << 16); v0[1] = __uint_as_float(w.x & 0xffff0000u); v0[2] = __uint_as_float(w.y << 16); v0[3] = __uint_as_float(w.y & 0xffff0000u);
    v1[0] = __uint_as_float(w.z << 16); v1[1] = __uint_as_float(w.z & 0xffff0000u); v1[2] = __uint_as_float(w.w << 16); v1[3] = __uint_as_float(w.w & 0xffff0000u); }
template <class F> __device__ __forceinline__ void for_each_piece(const f32x4 (&acc)[2][2][4][2], const Unit& u, int wr, int wc, int fr, int fq, const F& f) {
    asm volatile("" : "+v"(fr), "+v"(fq));
    const int row0 = u.pm * BM + wr * 64 + fr, col0 = wc * 32 + 8 * fq;
#pragma unroll
    for (int ai = 0; ai < 2; ++ai)
#pragma unroll
        for (int m = 0; m < 4; ++m)
#pragma unroll
            for (int bj = 0; bj < 2; ++bj) f(row0 + ai * HALF + m * 16, col0 + bj * HALF, acc[ai][bj][m][0], acc[ai][bj][m][1]);
}
template <class L, class F> __device__ __forceinline__ void for_each_piece_pf(const f32x4 (&acc)[2][2][4][2], const Unit& u, int wr, int wc, int fr, int fq, const L& ld, const F& f) {
    asm volatile("" : "+v"(fr), "+v"(fq));
    const int row0 = u.pm * BM + wr * 64 + fr, col0 = wc * 32 + 8 * fq;
#pragma unroll
    for (int ai = 0; ai < 2; ++ai) {
        decltype(ld(0, 0)) pre[4][2];
#pragma unroll
        for (int m = 0; m < 4; ++m)
#pragma unroll
            for (int bj = 0; bj < 2; ++bj) pre[m][bj] = ld(row0 + ai * HALF + m * 16, col0 + bj * HALF);
#pragma unroll
        for (int m = 0; m < 4; ++m)
#pragma unroll
            for (int bj = 0; bj < 2; ++bj) f(row0 + ai * HALF + m * 16, col0 + bj * HALF, acc[ai][bj][m][0], acc[ai][bj][m][1], pre[m][bj]);
    }
}
}

template <int MI, int NJ, class AR, class BR, class Epi>
__device__ __forceinline__ void sgemm_wave(const AR& ar, const BR& br, int K, int m0, int n0, const Epi& epi) {
    const int lane = TIDX & 63, c = lane & 15, g = lane >> 4;
    const bf16_t* ap[MI]; const bf16_t* bp[NJ];
#pragma unroll
    for (int i = 0; i < MI; ++i) ap[i] = ar.row(m0 + 16 * i + c) + 8 * g;
#pragma unroll
    for (int j = 0; j < NJ; ++j) bp[j] = br.row(n0 + 16 * j + c) + 8 * g;
    f32x4 acc[MI][NJ];
#pragma unroll
    for (int i = 0; i < MI; ++i)
#pragma unroll
        for (int j = 0; j < NJ; ++j) acc[i][j] = (f32x4){0.f, 0.f, 0.f, 0.f};
#pragma unroll 4
    for (int k0 = 0; k0 < K; k0 += 32) {
        bf16x8 a[MI], b[NJ];
#pragma unroll
        for (int i = 0; i < MI; ++i) a[i] = ld8(ap[i] + k0);
#pragma unroll
        for (int j = 0; j < NJ; ++j) b[j] = ld8(bp[j] + k0);
#pragma unroll
        for (int i = 0; i < MI; ++i)
#pragma unroll
            for (int j = 0; j < NJ; ++j) acc[i][j] = mfma16(b[j], a[i], acc[i][j]);
    }
#pragma unroll
    for (int i = 0; i < MI; ++i)
#pragma unroll
        for (int j = 0; j < NJ; ++j) epi(m0 + 16 * i + c, n0 + 16 * j + 4 * g, acc[i][j]);
}
template <int MI, int NJ, class AR, class BR, class Epi>
__device__ __forceinline__ void meta_gemm(const AR& ar, const BR& br, int K, int m0, int n0, const Epi& epi, char* lds) {
    const int tid = TIDX, wid = __builtin_amdgcn_readfirstlane(tid >> 6), lane = tid & 63, c = lane & 15, g = lane >> 4;
    const int kw = K >> 3, kb = wid * kw;
    f32x4 acc[MI][NJ];
#pragma unroll
    for (int i = 0; i < MI; ++i)
#pragma unroll
        for (int j = 0; j < NJ; ++j) acc[i][j] = (f32x4){0.f, 0.f, 0.f, 0.f};
    for (int k0 = kb; k0 < kb + kw; k0 += 32) {
        bf16x8 a[MI], b[NJ];
#pragma unroll
        for (int i = 0; i < MI; ++i) a[i] = ld8(ar.row(m0 + 16 * i + c) + 8 * g + k0);
#pragma unroll
        for (int j = 0; j < NJ; ++j) b[j] = ld8(br.row(n0 + 16 * j + c) + 8 * g + k0);
#pragma unroll
        for (int i = 0; i < MI; ++i)
#pragma unroll
            for (int j = 0; j < NJ; ++j) acc[i][j] = mfma16(b[j], a[i], acc[i][j]);
    }
    f32x4* part = (f32x4*)lds;
#pragma unroll
    for (int i = 0; i < MI; ++i)
#pragma unroll
        for (int j = 0; j < NJ; ++j) part[((wid * MI + i) * NJ + j) * 64 + lane] = acc[i][j];
    __syncthreads();
    if (wid == 0) {
#pragma unroll
        for (int i = 0; i < MI; ++i)
#pragma unroll
            for (int j = 0; j < NJ; ++j) { f32x4 s = acc[i][j];
#pragma unroll
                for (int w = 1; w < 8; ++w) s += part[((w * MI + i) * NJ + j) * 64 + lane];
                epi(m0 + 16 * i + c, n0 + 16 * j + 4 * g, s); }
    }
    __syncthreads();
}
__device__ __forceinline__ void zero_block(bf16_t* base, size_t ld, int nrows, int ncols, int gtid, int gthreads) {
    const int cpr = ncols / 8;
    for (int i = gtid; i < nrows * cpr; i += gthreads) { const int r = i / cpr, cc = (i % cpr) * 8; *(u32x4*)(base + (size_t)r * ld + cc) = (u32x4){0u, 0u, 0u, 0u}; }
}

struct SchedProj { const char* A; const char* B; int G, c; int K, lda, ldb;
    __device__ __forceinline__ bool next(int i, pg8::Unit& u) const { if (!pg8::decode_unit((long)i * G + c, 1, 64, 28, u)) return false; u.pm += 1; return true; }
    __device__ __forceinline__ const char* abase(const pg8::Unit& u) const { return A + (size_t)u.pm * 256 * D * 2; }
    __device__ __forceinline__ const char* bbase(const pg8::Unit& u) const { return B + (size_t)u.pn * 256 * D * 2; } };
struct EpiProjF { unsigned char* ws;
    __device__ __forceinline__ void operator()(const f32x4 (&acc)[2][2][4][2], const pg8::Unit& u, int wr, int wc, int fr, int fq) const {
        const int colt = u.pn * 256, seg = colt >> 10;
        const size_t off = seg == 0 ? B_XM : seg == 1 ? B_OP : seg == 2 ? B_QA : seg == 3 ? B_KA : seg == 4 ? B_VA : seg == 5 ? B_GA : B_GB;
        bf16_t* base = (bf16_t*)(ws + off) + (colt & 1023); const float qs = seg == 2 ? QA_PRESCALE : 1.f;
        pg8::for_each_piece(acc, u, wr, wc, fr, fq, [&](int row, int col, f32x4 v0, f32x4 v1) { *(u32x4*)(base + (size_t)row * D + col) = pg8::pack8(v0 * qs, v1 * qs); }); } };
struct SchedVAT { const char* A; const char* B; int G, c; int K, lda, ldb;
    __device__ __forceinline__ bool next(int i, pg8::Unit& u) const { if (!pg8::decode_unit((long)i * G + c, 1, 4, 64, u)) return false; u.pn += 1; return true; }
    __device__ __forceinline__ const char* abase(const pg8::Unit& u) const { return A + (size_t)u.pm * 256 * D * 2; }
    __device__ __forceinline__ const char* bbase(const pg8::Unit& u) const { return B + (size_t)u.pn * 256 * D * 2; } };
struct EpiStoreF { bf16_t* C; size_t ldc; float scale;
    __device__ __forceinline__ void operator()(const f32x4 (&acc)[2][2][4][2], const pg8::Unit& u, int wr, int wc, int fr, int fq) const {
        bf16_t* base = C + (size_t)u.pn * 256;
        pg8::for_each_piece(acc, u, wr, wc, fr, fq, [&](int row, int col, f32x4 v0, f32x4 v1) { *(u32x4*)(base + (size_t)row * ldc + col) = pg8::pack8(v0 * scale, v1 * scale); }); } };
__device__ __forceinline__ void phase_proj_f(const Params& p, char* lds, int bid, int nb) {
    const int tid = TIDX, wid = tid >> 6, gw = bid * NW + wid, ngw = nb * NW;
    const bf16_t* H = (const bf16_t*)(p.ws + B_H); const bf16_t* W = (const bf16_t*)(p.ws + W_IN_T);
    zero_block((bf16_t*)(p.ws + B_KA), D, VALID0, D, bid * NT + tid, nb * NT);
    zero_block((bf16_t*)(p.ws + B_VA), D, VALID0, D, bid * NT + tid, nb * NT);
    zero_block((bf16_t*)(p.ws + B_XM), D, VALID0, D, bid * NT + tid, nb * NT);
    for (int t = bid; t < 112; t += nb) meta_gemm<1, 4>(RowsPlain{H, D}, RowsPlain{W, D}, D, VALID0, t * 64, EpiProj{p.ws}, lds);
    { SchedProj S{(const char*)H, (const char*)W, nb, bid, D, D, D};
      pg8::gemm_phase(( PG8_LAS unsigned char*)lds, S, EpiProjF{p.ws}); }
}

namespace fc {
typedef short s16x4 __attribute__((ext_vector_type(4)));
typedef __attribute__((address_space(3))) unsigned LU;
constexpr int KVBLK = 64, SHM_V = 64 * 128 * 2, SHM_K = 64 * 64 * 2, PITCH = 1024, XCH = 17 * 1024;
constexpr float THR2 = 8.f * 1.4426950408889634f;
constexpr float TSUM = 16384.f;
#define FC_SBAR() __builtin_amdgcn_sched_barrier(0)
__device__ __forceinline__ unsigned cvtpk(float lo, float hi) { unsigned r; asm volatile("v_cvt_pk_bf16_f32 %0, %1, %2" : "=v"(r) : "v"(lo), "v"(hi)); return r; }
__device__ __forceinline__ float max_g(float v) {
    v = fmaxf(v, sx<16>(v));
    auto rr = __builtin_amdgcn_permlane32_swap(__float_as_uint(v), __float_as_uint(v), false, false);
    return fmaxf(__uint_as_float(rr[0]), __uint_as_float(rr[1]));
}
__device__ __forceinline__ float sum_g(float v) { v += sx<16>(v); return sum32(v); }
__device__ __forceinline__ int lane_id() { return (int)__builtin_amdgcn_mbcnt_hi(~0u, __builtin_amdgcn_mbcnt_lo(~0u, 0u)); }
__device__ __forceinline__ void attn_pass(const bf16_t* Qp, const bf16_t* Kp, const bf16_t* Vp, int P0, int NT, char* lds, f32x4 (&o)[4][8], float (&m2)[4], float (&lsum)[4]) {
    const int tid = TIDX, wid = __builtin_amdgcn_readfirstlane(tid >> 6), lane = tid & 63, c = lane & 15, g = lane >> 4;
    const int h = wid >> 2, qlo = P0 + (wid & 3) * 64;
    char* V_lds = lds; char* K_lds = lds + 2 * SHM_V;
#pragma unroll
    for (int qg = 0; qg < 4; ++qg) { m2[qg] = 0.f; lsum[qg] = 0.f;
#pragma unroll
        for (int dt = 0; dt < 8; ++dt) o[qg][dt] = (f32x4){0.f, 0.f, 0.f, 0.f}; }
    unsigned ksrc, vsrc0;
    { const int r = 8 * wid + (lane >> 3), cp = lane & 7, sw = (((r >> 3) & 3) << 1) | ((r >> 1) & 1); ksrc = (unsigned)(r * PITCH + ((cp ^ sw) << 3)) * 2u; }
    { const int pos = wid * 1024 + lane * 16, row = 8 * (pos >> 11) + ((pos >> 6) & 7), ch = 4 * ((pos >> 9) & 3) + (((pos >> 4) & 3) ^ ((row >> 2) & 3)); vsrc0 = (unsigned)(row * PITCH + ch * 8) * 2u; }
    const unsigned kdst = (unsigned)(2 * SHM_V) + (unsigned)wid * 1024u, vdst0 = (unsigned)wid * 1024u, vdst1 = (unsigned)(8 + wid) * 1024u;
    const int ksw = ((c >> 2) << 1) | ((c & 3) >> 1);
    const int krow = 4096 * h + 1024 * (c >> 2) + 128 * (c & 3);
    const int ka0 = krow + ((g ^ ksw) << 4), ka1 = krow + (((4 + g) ^ ksw) << 4);
    const int q4 = c >> 2, p4 = c & 3, ph = p4 >> 1;
    const int vbt0 = 8192 * h + 2048 * g + 64 * q4 + 16 * ph + 8 * (p4 & 1), vbt1 = 8192 * h + 2048 * g + 256 + 64 * q4 + 16 * (ph ^ 1) + 8 * (p4 & 1);
    const int vlds = (int)(uintptr_t)V_lds;
    const int vb_t0e = vlds + vbt0 + 32 * (g & 1), vb_t0o = vlds + vbt0 + 32 - 32 * (g & 1), vb_t1e = vlds + vbt1 + 32 * (g & 1), vb_t1o = vlds + vbt1 + 32 - 32 * (g & 1);
    bf16x8 qf[4][2];
#pragma unroll
    for (int qg = 0; qg < 4; ++qg)
#pragma unroll
        for (int ks = 0; ks < 2; ++ks) qf[qg][ks] = ld8(Qp + (size_t)(qlo + 16 * qg + c) * PITCH + 32 * ks + 8 * g);
#define FC_DMA(t, B) do { const size_t go_ = (size_t)(3 + (t)) * KVBLK * PITCH; const char* kt_ = (const char*)(Kp + go_); const char* vt_ = (const char*)(Vp + go_);  \
        __builtin_amdgcn_global_load_lds((const unsigned*)(kt_ + ksrc), (LU*)(lds + kdst + (B) * SHM_K), 16, 0, 0);                                             \
        __builtin_amdgcn_global_load_lds((const unsigned*)(vt_ + vsrc0), (LU*)(lds + vdst0 + (B) * SHM_V), 16, 0, 0);                                           \
        __builtin_amdgcn_global_load_lds((const unsigned*)(vt_ + 32 * PITCH * 2 + vsrc0), (LU*)(lds + vdst1 + (B) * SHM_V), 16, 0, 0); } while (0)
#define FC_WAITBAR() do { asm volatile("s_waitcnt vmcnt(0) lgkmcnt(0)" ::: "memory"); __builtin_amdgcn_s_barrier(); asm volatile("" ::: "memory"); } while (0)
#define FC_TRRD(dst, base, off) asm volatile("ds_read_b64_tr_b16 %0, %1 offset:%2" : "=&v"(dst) : "v"(base), "i"(off) : "memory")
#define FC_PV2(BUF, dt0) do { s16x4 a0, a1, b0, b1; constexpr int o_ = (BUF) * SHM_V + 512 * ((dt0) >> 1);                                                       \
        FC_TRRD(a0, vb_t0e, o_); FC_TRRD(a1, vb_t1e, o_); FC_TRRD(b0, vb_t0o, o_); FC_TRRD(b1, vb_t1o, o_);                                                     \
        asm volatile("s_waitcnt lgkmcnt(0)" ::: "memory"); FC_SBAR();                                                                                            \
        { const bf16x8 f0 = (bf16x8){a0[0], a0[1], a0[2], a0[3], a1[0], a1[1], a1[2], a1[3]}, f1 = (bf16x8){b0[0], b0[1], b0[2], b0[3], b1[0], b1[1], b1[2], b1[3]};      \
          _Pragma("unroll") for (int qg = 0; qg < 4; ++qg) o[qg][dt0] = mfma16(f0, pf[qg], o[qg][dt0]);                                                         \
          _Pragma("unroll") for (int qg = 0; qg < 4; ++qg) o[qg][(dt0) + 1] = mfma16(f1, pf[qg], o[qg][(dt0) + 1]); } } while (0)
#define FC_QK(BUF) do { _Pragma("unroll") for (int a = 0; a < 2; ++a) { const char* kp = K_lds + (BUF) * SHM_K + 512 * a;                                          \
              const bf16x8 k0 = *(const bf16x8*)(kp + ka0), k1 = *(const bf16x8*)(kp + ka1);                                                                    \
              _Pragma("unroll") for (int qp = 0; qp < 4; qp += 2) { float na = -m2[qp], nb = -m2[qp + 1]; asm volatile("" : "+v"(na), "+v"(nb));                 \
                  s[qp][a] = mfma16(k0, qf[qp][0], (f32x4){na, na, na, na}); s[qp + 1][a] = mfma16(k0, qf[qp + 1][0], (f32x4){nb, nb, nb, nb});                  \
                  s[qp][a] = mfma16(k1, qf[qp][1], s[qp][a]); s[qp + 1][a] = mfma16(k1, qf[qp + 1][1], s[qp + 1][a]); } } } while (0)
#define FC_MASK(t) do { if ((t) == 0 || kh + 31 > qlo) { const float NEG = -__builtin_inff(); const int ln_ = lane_id(), c_ = ln_ & 15, g_ = ln_ >> 4;                \
            _Pragma("unroll") for (int qg = 0; qg < 4; ++qg) { const int pos = qlo + 16 * qg + c_;                                                              \
                _Pragma("unroll") for (int a = 0; a < 2; ++a) _Pragma("unroll") for (int r = 0; r < 4; ++r) { const int key = kh + 8 * g_ + 4 * a + r;           \
                    if (key > pos || key < VALID0) s[qg][a][r] = NEG; } } } } while (0)
#define FC_EXPSUM() do { _Pragma("unroll") for (int qg = 0; qg < 4; ++qg) { float ps_ = 0.f;                                                                         \
            _Pragma("unroll") for (int a = 0; a < 2; ++a) _Pragma("unroll") for (int r = 0; r < 4; ++r) { const float e = __builtin_amdgcn_exp2f(s[qg][a][r]); s[qg][a][r] = e; ps_ += e; } \
            ps[qg] = ps_; } } while (0)
#define FC_TILE(t, BUF) do {                                                                                                                                     \
        if ((t) + 1 < NT) FC_DMA((t) + 1, (BUF) ^ 1);                                                                                                            \
        const int kh = (3 + (t)) * KVBLK + 32 * h;                                                                                                               \
        if (kh <= qlo + 63) {                                                                                                                                    \
        FC_SBAR();                                                                                                                                               \
        f32x4 s[4][2]; float ps[4];                                                                                                                              \
        const bool adopt = (t) == 0 || ((t) == 1 && h == 0);                              \
        bool exact = adopt;                                                                                                                                      \
        for (;;) {                                                                                \
            FC_QK(BUF); FC_MASK(t);                                                                                                                              \
            if (exact) {                                                                                                                                         \
                _Pragma("unroll") for (int qg = 0; qg < 4; ++qg) { float v = fmaxf(s[qg][0][0], s[qg][1][0]);                                                    \
                    _Pragma("unroll") for (int r = 1; r < 4; ++r) v = fmaxf(v, fmaxf(s[qg][0][r], s[qg][1][r]));                                                 \
                    const float pm = max_g(v);                                                                                                                   \
                    const float delta = adopt ? (pm > -1e30f ? pm : 0.f) : fmaxf(pm, 0.f);                                                                       \
                    m2[qg] += delta; s[qg][0] = s[qg][0] - delta; s[qg][1] = s[qg][1] - delta;                                                                   \
                    if (!adopt) { const float al_ = __builtin_amdgcn_exp2f(-delta); lsum[qg] *= al_;                                                             \
                        _Pragma("unroll") for (int dt = 0; dt < 8; ++dt) o[qg][dt] = o[qg][dt] * al_; } } }                                                      \
            FC_EXPSUM();                                                                                                                                         \
            if (exact || __all(fmaxf(fmaxf(ps[0], ps[1]), fmaxf(ps[2], ps[3])) <= TSUM)) break;                                                                  \
            exact = true; }                                                                                                                                      \
        bf16x8 pf[4];                                                                                                                                            \
        _Pragma("unroll") for (int qg = 0; qg < 4; ++qg) { lsum[qg] += ps[qg];                                                                                   \
            u32x4 w; w.x = cvtpk(s[qg][0][0], s[qg][0][1]); w.y = cvtpk(s[qg][0][2], s[qg][0][3]); w.z = cvtpk(s[qg][1][0], s[qg][1][1]); w.w = cvtpk(s[qg][1][2], s[qg][1][3]); \
            pf[qg] = *(bf16x8*)&w; }                                                                                                                             \
        FC_SBAR();                                                                                                                                               \
        FC_PV2(BUF, 0); FC_PV2(BUF, 2); FC_PV2(BUF, 4); FC_PV2(BUF, 6);                                                                                          \
        }                                                                                                                                                        \
        FC_WAITBAR(); } while (0)
    FC_DMA(0, 0); FC_WAITBAR();
    for (int t = 0; t < NT; t += 2) { FC_TILE(t, 0); if (t + 1 < NT) FC_TILE(t + 1, 1); }
#undef FC_TILE
#undef FC_QK
#undef FC_MASK
#undef FC_EXPSUM
#undef FC_PV2
#undef FC_TRRD
#undef FC_WAITBAR
#undef FC_DMA
}
__device__ __forceinline__ void merge_pair(f32x4 (&o)[4][8], float (&m2)[4], float (&ls)[4], float (&lr)[2], char* lds) {
    const int tid = TIDX, wid = __builtin_amdgcn_readfirstlane(tid >> 6), lane = tid & 63, h = wid >> 2;
    char* mine = lds + wid * XCH + lane * 16; const char* theirs = lds + (wid ^ 4) * XCH + lane * 16;
#define FC_SEND(QX) do { _Pragma("unroll") for (int i = 0; i < 2; ++i) _Pragma("unroll") for (int dt = 0; dt < 8; ++dt) *(f32x4*)(mine + (i * 8 + dt) * 1024) = o[(QX) + i][dt];  \
        *(f32x4*)(mine + 16 * 1024) = (f32x4){m2[(QX)], ls[(QX)], m2[(QX) + 1], ls[(QX) + 1]}; } while (0)
#define FC_RECV(QX) do { const f32x4 ml = *(const f32x4*)(theirs + 16 * 1024);                                                                                    \
        _Pragma("unroll") for (int i = 0; i < 2; ++i) { const float mr = i ? ml.z : ml.x, lrv = i ? ml.w : ml.y, m = fmaxf(m2[(QX) + i], mr);                       \
            const float fo = __builtin_amdgcn_exp2f(m2[(QX) + i] - m), fr = __builtin_amdgcn_exp2f(mr - m);                                                       \
            _Pragma("unroll") for (int dt = 0; dt < 8; ++dt) { const f32x4 v = *(const f32x4*)(theirs + (i * 8 + dt) * 1024); o[i][dt] = o[(QX) + i][dt] * fo + v * fr; } \
            lr[i] = sum_g(ls[(QX) + i] * fo + lrv * fr); } } while (0)
    if (h == 0) FC_SEND(2); else FC_SEND(0);
    __syncthreads();
    if (h == 0) FC_RECV(0); else FC_RECV(2);
    __syncthreads();
#undef FC_SEND
#undef FC_RECV
}
__device__ __forceinline__ void attn_unit(const Params& p, int l, int hd, int j, char* lds) {
    const int tid = TIDX, wid = __builtin_amdgcn_readfirstlane(tid >> 6), lane = tid & 63, c = lane & 15, g = lane >> 4;
    const bf16_t* QA = (const bf16_t*)(p.ws + B_QA) + hd * 128; const bf16_t* KA = (const bf16_t*)(p.ws + B_KA) + hd * 128; const bf16_t* VA = (const bf16_t*)(p.ws + B_VA) + hd * 128;
    bf16_t* YA = (bf16_t*)(p.ws + B_YA) + hd * 128;
    const int P0 = j * 256, NT = 4 * j + 1, row0 = P0 + (wid & 3) * 64 + (wid >> 2) * 32 + c;
    f32x4 o[4][8]; float m2[4], ls[4], lr[2];
    attn_pass(QA, KA, VA, P0, NT, lds, o, m2, ls);
    merge_pair(o, m2, ls, lr, lds);
#pragma unroll
    for (int i = 0; i < 2; ++i) { const float rl = __builtin_amdgcn_rcpf(lr[i]); bf16_t* yr = YA + (size_t)(row0 + 16 * i) * PITCH + 4 * g;
#pragma unroll
        for (int dt = 0; dt < 8; ++dt) { const f32x4 v = o[i][dt] * rl; u32x2 w; w.x = cvtpk(v.x, v.y); w.y = cvtpk(v.z, v.w); *(u32x2*)(yr + 16 * dt) = w; } }
    attn_pass(QA + 64, KA + 64, VA, P0, NT, lds, o, m2, ls);
    merge_pair(o, m2, ls, lr, lds);
    const float lam_init = 0.8f - 0.6f * expf(-0.3f * (float)l);
    float lam;
    { const float a = wave_sum(p.in[I_LQ1][l * 64 + lane] * p.in[I_LK1][l * 64 + lane]), b = wave_sum(p.in[I_LQ2][l * 64 + lane] * p.in[I_LK2][l * 64 + lane]);
      lam = expf(a) - expf(b) + lam_init; }
    const float scale_out = 1.f - lam_init;
#pragma unroll
    for (int i = 0; i < 2; ++i) { const float rl = lam * __builtin_amdgcn_rcpf(lr[i]); bf16_t* yr = YA + (size_t)(row0 + 16 * i) * PITCH + 4 * g;
        float ss = 0.f;
#pragma unroll
        for (int dt = 0; dt < 8; ++dt) { const unsigned long long w = __hip_atomic_load((const unsigned long long*)(yr + 16 * dt), __ATOMIC_RELAXED, __HIP_MEMORY_SCOPE_AGENT);
            f32x4 v; v.x = bf2f((unsigned)w & 0xffffu); v.y = bf2f(((unsigned)w) >> 16); v.z = bf2f((unsigned)(w >> 32) & 0xffffu); v.w = bf2f((unsigned)(w >> 48));
            v = v - o[i][dt] * rl; o[i][dt] = v; ss += (v.x * v.x + v.y * v.y) + (v.z * v.z + v.w * v.w); }
        ss = sum_g(ss);
        const float rs = rsqrtf(ss * (1.f / 128.f) + LN_EPS) * scale_out;
#pragma unroll
        for (int dt = 0; dt < 8; ++dt) { const f32x4 gg = *(const f32x4*)(p.in[I_ANG] + l * 128 + 16 * dt + 4 * g); const f32x4 v = o[i][dt] * rs * gg;
            u32x2 w; w.x = cvtpk(v.x, v.y); w.y = cvtpk(v.z, v.w); *(u32x2*)(yr + 16 * dt) = w; } }
}
}
__device__ __forceinline__ void phase_attn_f(const Params& p, int l, char* lds, int bid, int nb) {
    for (int u = bid; u < 256 + 8; u += nb) {
        if (u < 256) { const int hd = u & 7, jj = u >> 3;
            fc::attn_unit(p, l, hd, 64 - jj, lds);
            fc::attn_unit(p, l, hd, 1 + jj, lds);
        } else fc::attn_unit(p, l, u - 256, 0, lds);
    }
}

__device__ __forceinline__ void phase_conv(const Params& p, int l, char* lds, int bid, int nb) {
    const int tid = TIDX, wid = tid >> 6, lane = tid & 63, gw = bid * NW + wid, ngw = nb * NW;
    const bf16_t* XM = (const bf16_t*)(p.ws + B_XM); bf16_t* XC = (bf16_t*)(p.ws + B_XC);
    const float* cw = p.in[I_CONVW] + (size_t)l * 4 * D; const float* cb = p.in[I_CONVB] + (size_t)l * D;
    constexpr int RBLK = 16, NITEM = (P / RBLK) * (D / 8);
    for (int it = bid * NT + tid; it < NITEM; it += nb * NT) {
        const int rb = it >> 7, c0 = (it & 127) * 8, r0 = rb * RBLK;
        if (r0 + RBLK <= VALID0) {
#pragma unroll
            for (int i = 0; i < RBLK; ++i) *(u32x4*)(XC + (size_t)(r0 + i) * D + c0) = (u32x4){0u, 0u, 0u, 0u};
            continue; }
        u32x4 x[RBLK + 3];
#pragma unroll
        for (int i = 0; i < RBLK + 3; ++i) { const int rr = r0 - 3 + i; x[i] = rr >= VALID0 ? *(const u32x4*)(XM + (size_t)rr * D + c0) : (u32x4){0u, 0u, 0u, 0u}; }
        float w[4][8], bb[8];
#pragma unroll
        for (int j = 0; j < 4; ++j) { const f32x4 a = *(const f32x4*)(cw + j * D + c0), b = *(const f32x4*)(cw + j * D + c0 + 4);
            w[j][0] = a.x; w[j][1] = a.y; w[j][2] = a.z; w[j][3] = a.w; w[j][4] = b.x; w[j][5] = b.y; w[j][6] = b.z; w[j][7] = b.w; }
        { const f32x4 a = *(const f32x4*)(cb + c0), b = *(const f32x4*)(cb + c0 + 4); bb[0] = a.x; bb[1] = a.y; bb[2] = a.z; bb[3] = a.w; bb[4] = b.x; bb[5] = b.y; bb[6] = b.z; bb[7] = b.w; }
#pragma unroll
        for (int i = 0; i < RBLK; ++i) {
            float acc[8];
#pragma unroll
            for (int e = 0; e < 8; ++e) acc[e] = bb[e];
#pragma unroll
            for (int j = 0; j < 4; ++j) { const u32x4 v = x[i + j];
                acc[0] += w[j][0] * bf2f(v.x & 0xffffu); acc[1] += w[j][1] * bf2f(v.x >> 16); acc[2] += w[j][2] * bf2f(v.y & 0xffffu); acc[3] += w[j][3] * bf2f(v.y >> 16);
                acc[4] += w[j][4] * bf2f(v.z & 0xffffu); acc[5] += w[j][5] * bf2f(v.z >> 16); acc[6] += w[j][6] * bf2f(v.w & 0xffffu); acc[7] += w[j][7] * bf2f(v.w >> 16); }
            u32x4 o; o.x = pk2(siluf_(acc[0]), siluf_(acc[1])); o.y = pk2(siluf_(acc[2]), siluf_(acc[3])); o.z = pk2(siluf_(acc[4]), siluf_(acc[5])); o.w = pk2(siluf_(acc[6]), siluf_(acc[7]));
            if (r0 + i < VALID0) o = (u32x4){0u, 0u, 0u, 0u};
            *(u32x4*)(XC + (size_t)(r0 + i) * D + c0) = o;
        }
    }
    const float* gli = (const float*)(p.ws + TAB_GLI); const float* glf = (const float*)(p.ws + TAB_GLF);
    float* tb = (float*)(p.ws + TAB_B); float* te = (float*)(p.ws + TAB_E); float* tpm = (float*)(p.ws + TAB_PM); float* tw = (float*)(p.ws + TAB_W);
    float* scg = (float*)(p.ws + TAB_SCG); float* scm = (float*)(p.ws + TAB_SCM);
    for (int t = gw; t < NSC * 4; t += ngw) {
        const int sc = t >> 2, h = t & 3; const size_t base = (size_t)h * P + sc * 256 + 4 * lane;
        const f32x4 lf = *(const f32x4*)(glf + base), li = *(const f32x4*)(gli + base);
        float b[4]; b[0] = lf.x; b[1] = b[0] + lf.y; b[2] = b[1] + lf.z; b[3] = b[2] + lf.w;
        float incl = b[3];
#pragma unroll
        for (int o = 1; o < 64; o <<= 1) { const float n = __shfl_up(incl, o); if (lane >= o) incl += n; }
        const float excl = incl - b[3];
        float e[4], pm[4];
#pragma unroll
        for (int i = 0; i < 4; ++i) { b[i] += excl; e[i] = li[i] - b[i]; }
        pm[0] = e[0]; pm[1] = fmaxf(pm[0], e[1]); pm[2] = fmaxf(pm[1], e[2]); pm[3] = fmaxf(pm[2], e[3]);
        float mi = pm[3];
#pragma unroll
        for (int o = 1; o < 64; o <<= 1) { const float n = __shfl_up(mi, o); if (lane >= o) mi = fmaxf(mi, n); }
        float mex = __shfl_up(mi, 1); if (lane == 0) mex = -INFINITY;
#pragma unroll
        for (int i = 0; i < 4; ++i) pm[i] = fmaxf(pm[i], mex);
        const float gtot = __shfl(incl, 63), emax = __shfl(mi, 63), mloc = gtot + emax;
        f32x4 ww;
#pragma unroll
        for (int i = 0; i < 4; ++i) ww[i] = __expf(e[i] + gtot - mloc);
        *(f32x4*)(tb + base) = (f32x4){b[0], b[1], b[2], b[3]};
        *(f32x4*)(te + base) = (f32x4){e[0], e[1], e[2], e[3]};
        *(f32x4*)(tpm + base) = (f32x4){pm[0], pm[1], pm[2], pm[3]};
        *(f32x4*)(tw + base) = ww;
        if (lane == 0) { scg[sc * 4 + h] = gtot; scm[sc * 4 + h] = mloc; }
    }
}

__device__ __forceinline__ void phase_m1(const Params& p, char* lds, int bid, int nb, int nsc) {
    const int tid = TIDX, wid = __builtin_amdgcn_readfirstlane(tid >> 6), lane = tid & 63, c = lane & 15, g = lane >> 4, gw = bid * NW + wid, ngw = nb * NW;
    const bf16_t* KMT = (const bf16_t*)(p.ws + B_KMT); const bf16_t* VMT = (const bf16_t*)(p.ws + B_VMT);
    const float* tw = (const float*)(p.ws + TAB_W); bf16_t* CT = (bf16_t*)(p.ws + B_CT); float* NTv = (float*)(p.ws + TAB_NT);
    for (int u = bid; u < nsc * 4 * 2; u += nb) {
        const int dvb = (u & 1) * 8 + wid, h = (u >> 1) & 3, sc = u >> 3, s0 = sc * 256;
        f32x4 acc[16];
#pragma unroll
        for (int i = 0; i < 16; ++i) acc[i] = (f32x4){0.f, 0.f, 0.f, 0.f};
        float un[16];
#pragma unroll
        for (int i = 0; i < 16; ++i) un[i] = 0.f;
        for (int ks = (sc == 0 ? 7 : 0); ks < 8; ++ks) {
            const int sb = s0 + 32 * ks + 8 * g;
            const f32x4 w0 = *(const f32x4*)(tw + (size_t)h * P + sb), w1 = *(const f32x4*)(tw + (size_t)h * P + sb + 4);
            const u32x4 vv = *(const u32x4*)(VMT + (size_t)(h * 256 + 16 * dvb + c) * P + sb);
            u32x4 vw; vw.x = pk2(bf2f(vv.x & 0xffffu) * w0.x, bf2f(vv.x >> 16) * w0.y); vw.y = pk2(bf2f(vv.y & 0xffffu) * w0.z, bf2f(vv.y >> 16) * w0.w);
            vw.z = pk2(bf2f(vv.z & 0xffffu) * w1.x, bf2f(vv.z >> 16) * w1.y); vw.w = pk2(bf2f(vv.w & 0xffffu) * w1.z, bf2f(vv.w >> 16) * w1.w);
            const bf16x8 vf = *(bf16x8*)&vw;
#pragma unroll
            for (int dk = 0; dk < 16; ++dk) {
                const u32x4 kk = *(const u32x4*)(KMT + (size_t)(h * 256 + 16 * dk + c) * P + sb);
                acc[dk] = mfma16(*(const bf16x8*)&kk, vf, acc[dk]);
                if (dvb == 0) un[dk] += bf2f(kk.x & 0xffffu) * w0.x + bf2f(kk.x >> 16) * w0.y + bf2f(kk.y & 0xffffu) * w0.z + bf2f(kk.y >> 16) * w0.w
                                      + bf2f(kk.z & 0xffffu) * w1.x + bf2f(kk.z >> 16) * w1.y + bf2f(kk.w & 0xffffu) * w1.z + bf2f(kk.w >> 16) * w1.w;
            }
        }
        bf16_t* dst = CT + ((size_t)(sc * 4 + h) * 256 + 16 * dvb + c) * 256;
#pragma unroll
        for (int dk = 0; dk < 16; ++dk) store4_bf16(dst + 16 * dk + 4 * g, acc[dk]);
        if (dvb == 0) {
#pragma unroll
            for (int dk = 0; dk < 16; ++dk) { float v = un[dk]; v += sx<16>(v); v = sum32(v); if (g == 0) NTv[(size_t)(sc * 4 + h) * 256 + 16 * dk + c] = v; }
        }
    }
}

namespace pg8 {
template <class F> __device__ __forceinline__ void for_each_piece_local(const f32x4 (&acc)[2][2][4][2], int wr, int wc, int fr, int fq, const F& f) {
    asm volatile("" : "+v"(fr), "+v"(fq));
    const int row0 = wr * 64 + fr, col0 = wc * 32 + 8 * fq;
#pragma unroll
    for (int ai = 0; ai < 2; ++ai)
#pragma unroll
        for (int m = 0; m < 4; ++m)
#pragma unroll
            for (int bj = 0; bj < 2; ++bj) f(row0 + ai * HALF + m * 16, col0 + bj * HALF, acc[ai][bj][m][0], acc[ai][bj][m][1]);
}
}
struct SchedM1 { const char* VWT; const char* KMT; int G, c; int K, lda, ldb;
    __device__ __forceinline__ bool next(int i, pg8::Unit& u) const { return pg8::decode_unit((long)i * G + c, 4, 64, 1, u); }
    __device__ __forceinline__ const char* abase(const pg8::Unit& u) const { return VWT + ((size_t)u.grp * 256 * P + (size_t)(u.pm + 1) * 256) * 2; }
    __device__ __forceinline__ const char* bbase(const pg8::Unit& u) const { return KMT + ((size_t)u.grp * 256 * P + (size_t)(u.pm + 1) * 256) * 2; } };
struct EpiM1 { bf16_t* CT;
    __device__ __forceinline__ void operator()(const f32x4 (&acc)[2][2][4][2], const pg8::Unit& u, int wr, int wc, int fr, int fq) const {
        bf16_t* base = CT + (size_t)((u.pm + 1) * 4 + u.grp) * 65536;
        pg8::for_each_piece_local(acc, wr, wc, fr, fq, [&](int row, int col, f32x4 v0, f32x4 v1) { *(u32x4*)(base + (size_t)row * 256 + col) = pg8::pack8(v0, v1); }); } };
__device__ __forceinline__ void phase_ms(const Params& p, char* lds, int bid, int nb) {
    phase_m1(p, lds, bid, nb, 1);
    const int tid = TIDX, wid = __builtin_amdgcn_readfirstlane(tid >> 6), lane = tid & 63, c = lane & 15, g = lane >> 4, gw = bid * NW + wid, ngw = nb * NW;
    const bf16_t* KMT = (const bf16_t*)(p.ws + B_KMT); const float* tw = (const float*)(p.ws + TAB_W); float* NTv = (float*)(p.ws + TAB_NT);
    for (int t = gw; t < 64 * 4 * 16; t += ngw) {
        const int dkb = t & 15, h = (t >> 4) & 3, sc = 1 + (t >> 6);
        const bf16_t* kr = KMT + (size_t)(h * 256 + 16 * dkb + c) * P + sc * 256 + 64 * g; const float* wp = tw + (size_t)h * P + sc * 256 + 64 * g;
        float a = 0.f;
#pragma unroll
        for (int i = 0; i < 8; ++i) { const u32x4 kk = *(const u32x4*)(kr + 8 * i); const f32x4 w0 = *(const f32x4*)(wp + 8 * i), w1 = *(const f32x4*)(wp + 8 * i + 4);
            a += bf2f(kk.x & 0xffffu) * w0.x + bf2f(kk.x >> 16) * w0.y + bf2f(kk.y & 0xffffu) * w0.z + bf2f(kk.y >> 16) * w0.w
               + bf2f(kk.z & 0xffffu) * w1.x + bf2f(kk.z >> 16) * w1.y + bf2f(kk.w & 0xffffu) * w1.z + bf2f(kk.w >> 16) * w1.w; }
        a += sx<16>(a); a = sum32(a);
        if (g == 0) NTv[(size_t)(sc * 4 + h) * 256 + 16 * dkb + c] = a;
    }
    SchedM1 S{(const char*)(p.ws + B_VWT), (const char*)KMT, nb, bid, 256, P, P};
    pg8::gemm_phase((PG8_LAS unsigned char*)lds, S, EpiM1{(bf16_t*)(p.ws + B_CT)});
}

__device__ __forceinline__ void phase_m2(const Params& p, char* lds, int bid, int nb) {
    const float* scg = (const float*)(p.ws + TAB_SCG); const float* scm = (const float*)(p.ws + TAB_SCM);
    unsigned* CT = (unsigned*)(p.ws + B_CT); float* NTv = (float*)(p.ws + TAB_NT); float* mt = (float*)(p.ws + TAB_MT);
    const int tid = TIDX, gid = bid * NT + tid, nth = nb * NT;
    PG8_LAS float* cf = (PG8_LAS float*)lds;
    if (tid < 4) { const int h = tid; float m = 0.f; float gg[NSC], ml[NSC];
#pragma unroll
        for (int sc = 0; sc < NSC; ++sc) { gg[sc] = scg[sc * 4 + h]; ml[sc] = scm[sc * 4 + h]; }
#pragma unroll
        for (int sc = 0; sc < NSC; ++sc) { const float mn = fmaxf(gg[sc] + m, ml[sc]);
            cf[(sc * 4 + h) * 2] = __expf(gg[sc] + m - mn); cf[(sc * 4 + h) * 2 + 1] = __expf(ml[sc] - mn); cf[NSC * 8 + sc * 4 + h] = mn; m = mn; } }
    __syncthreads();
    for (int i = gid; i < 4 * 32768 + 1024; i += nth) {
        if (i < 4 * 32768) {
            const int h = i >> 15, idx = i & 32767;
            unsigned* base = CT + (size_t)h * 32768 + idx;
            unsigned u[NSC];
#pragma unroll
            for (int sc = 0; sc < NSC; ++sc) u[sc] = base[(size_t)sc * 4 * 32768];
            float c0 = 0.f, c1 = 0.f;
#pragma unroll
            for (int sc = 0; sc < NSC; ++sc) {
                const float dec = cf[(sc * 4 + h) * 2], cor = cf[(sc * 4 + h) * 2 + 1];
                c0 = dec * c0 + cor * bf2f(u[sc] & 0xffffu); c1 = dec * c1 + cor * bf2f(u[sc] >> 16);
                base[(size_t)sc * 4 * 32768] = pk2(c0, c1);
            }
        } else {
            const int j = i - 4 * 32768, h = j >> 8, d = j & 255;
            float* ptr0 = NTv + (size_t)h * 256 + d;
            float un[NSC];
#pragma unroll
            for (int sc = 0; sc < NSC; ++sc) un[sc] = ptr0[(size_t)sc * 1024];
            float n = 0.f;
#pragma unroll
            for (int sc = 0; sc < NSC; ++sc) {
                const float dec = cf[(sc * 4 + h) * 2], cor = cf[(sc * 4 + h) * 2 + 1];
                n = dec * n + cor * un[sc]; ptr0[(size_t)sc * 1024] = n;
                if (d == 0) mt[sc * 4 + h] = cf[NSC * 8 + sc * 4 + h];
            }
        }
    }
}

__device__ __forceinline__ void phase_m3(const Params& p, int l, char* lds, int bid, int nb, bool sc0_only) {
    const int tid = TIDX, wid = __builtin_amdgcn_readfirstlane(tid >> 6), lane = tid & 63, c = lane & 15, g = lane >> 4, gw = bid * NW + wid, ngw = nb * NW;
    const bf16_t* QM = (const bf16_t*)(p.ws + B_QM); const bf16_t* KM = (const bf16_t*)(p.ws + B_KM); const bf16_t* VMT = (const bf16_t*)(p.ws + B_VMT);
    const bf16_t* CT = (const bf16_t*)(p.ws + B_CT); const float* NTv = (const float*)(p.ws + TAB_NT); const float* mt = (const float*)(p.ws + TAB_MT);
    const float* tb = (const float*)(p.ws + TAB_B); const float* te = (const float*)(p.ws + TAB_E); const float* tpm = (const float*)(p.ws + TAB_PM);
    const bf16_t* OP = (const bf16_t*)(p.ws + B_OP); bf16_t* YM = (bf16_t*)(p.ws + B_YM);
    constexpr int NRG = P / 16, RG0 = VALID0 / 16;
    const int ntask = (NRG - RG0) * 4;
    for (int u = (sc0_only ? 256 : 0) + bid; u < (sc0_only ? 260 : NSC * 4 * 2); u += nb) {
        const int half = u < NSC * 4 ? 1 : 0, uu = u < NSC * 4 ? u : u - NSC * 4, sc = (NSC - 1) - (uu >> 2), h = uu & 3, rg = sc * 16 + half * 8 + wid;
        if (rg < RG0) continue;
        const int t0 = rg * 16, row = t0 + c, s_start = sc << 8;
        bf16x8 qf[8];
#pragma unroll
        for (int ks = 0; ks < 8; ++ks) qf[ks] = ld8(QM + (size_t)row * D + h * 256 + 32 * ks + 8 * g);
        const float b_t = tb[(size_t)h * P + row], pm_t = tpm[(size_t)h * P + row];
        const float m_prev = sc > 0 ? mt[(sc - 1) * 4 + h] : 0.f;
        const float m_t = b_t + fmaxf(m_prev, pm_t), scale_t = __expf(b_t + m_prev - m_t);
        f32x4 acc[16];
#pragma unroll
        for (int i = 0; i < 16; ++i) acc[i] = (f32x4){0.f, 0.f, 0.f, 0.f};
        float den = 0.f;
        if (sc > 0) {
            const bf16_t* Cb = CT + (size_t)((sc - 1) * 4 + h) * 65536; const float* nv = NTv + (size_t)((sc - 1) * 4 + h) * 256;
#pragma unroll 2
            for (int ks = 0; ks < 8; ++ks) {
#pragma unroll
                for (int dt = 0; dt < 16; ++dt) acc[dt] = mfma16(ld8(Cb + (size_t)(16 * dt + c) * 256 + 32 * ks + 8 * g), qf[ks], acc[dt]);
                const f32x4 n0 = *(const f32x4*)(nv + 32 * ks + 8 * g), n1 = *(const f32x4*)(nv + 32 * ks + 8 * g + 4);
                const u32x4 qq = *(const u32x4*)&qf[ks];
                den += bf2f(qq.x & 0xffffu) * n0.x + bf2f(qq.x >> 16) * n0.y + bf2f(qq.y & 0xffffu) * n0.z + bf2f(qq.y >> 16) * n0.w
                     + bf2f(qq.z & 0xffffu) * n1.x + bf2f(qq.z >> 16) * n1.y + bf2f(qq.w & 0xffffu) * n1.z + bf2f(qq.w >> 16) * n1.w;
            }
            den *= scale_t;
#pragma unroll
            for (int dt = 0; dt < 16; ++dt) acc[dt] = acc[dt] * scale_t;
        }
        for (int kb = (sc == 0 ? 224 : s_start); kb <= t0 + 15; kb += 32) {
            f32x4 s[2];
#pragma unroll
            for (int a = 0; a < 2; ++a) {
                s[a] = (f32x4){0.f, 0.f, 0.f, 0.f};
                const bf16_t* kr = KM + (size_t)(kb + 16 * a + c) * D + h * 256 + 8 * g;
#pragma unroll
                for (int ks = 0; ks < 8; ++ks) s[a] = mfma16(ld8(kr + 32 * ks), qf[ks], s[a]);
                const f32x4 ee = *(const f32x4*)(te + (size_t)h * P + kb + 16 * a + 4 * g);
#pragma unroll
                for (int r = 0; r < 4; ++r) { const int key = kb + 16 * a + 4 * g + r; const float arg = fminf(ee[r] + b_t - m_t, 0.f);
                    const float dd = key <= row ? __expf(arg) : 0.f; const float pv = s[a][r] * dd; s[a][r] = pv; den += pv; }
            }
            u32x4 w; w.x = pk2(s[0][0], s[0][1]); w.y = pk2(s[0][2], s[0][3]); w.z = pk2(s[1][0], s[1][1]); w.w = pk2(s[1][2], s[1][3]);
            const bf16x8 pf = *(bf16x8*)&w;
#pragma unroll
            for (int dt = 0; dt < 16; ++dt) {
                const bf16_t* vr = VMT + (size_t)(h * 256 + 16 * dt + c) * P + kb + 4 * g;
                const u32x2 v0 = *(const u32x2*)vr, v1 = *(const u32x2*)(vr + 16);
                u32x4 vv; vv.x = v0.x; vv.y = v0.y; vv.z = v1.x; vv.w = v1.y;
                acc[dt] = mfma16(*(bf16x8*)&vv, pf, acc[dt]);
            }
        }
        den += sx<16>(den); den = sum32(den);
        const float inv = 1.f / fmaxf(fabsf(den), __expf(-m_t));
        float s1 = 0.f;
#pragma unroll
        for (int dt = 0; dt < 16; ++dt) {
            const u32x2 og = *(const u32x2*)(OP + (size_t)row * D + h * 256 + 16 * dt + 4 * g);
            f32x4 v = acc[dt] * inv;
            v.x *= sigmoidf_(bf2f(og.x & 0xffffu)); v.y *= sigmoidf_(bf2f(og.x >> 16)); v.z *= sigmoidf_(bf2f(og.y & 0xffffu)); v.w *= sigmoidf_(bf2f(og.y >> 16));
            acc[dt] = v; s1 += (v.x + v.y) + (v.z + v.w);
        }
        s1 += sx<16>(s1); s1 = sum32(s1);
        const float mu = s1 * (1.f / 256.f);
        float s2 = 0.f;
#pragma unroll
        for (int dt = 0; dt < 16; ++dt) { acc[dt] = acc[dt] - mu; s2 += (acc[dt].x * acc[dt].x + acc[dt].y * acc[dt].y) + (acc[dt].z * acc[dt].z + acc[dt].w * acc[dt].w); }
        s2 += sx<16>(s2); s2 = sum32(s2);
        const float rstd = rsqrtf(s2 * (1.f / 256.f) + LN_EPS);
#pragma unroll
        for (int dt = 0; dt < 16; ++dt) { const f32x4 gg = *(const f32x4*)(p.in[I_MNG] + (size_t)l * D + h * 256 + 16 * dt + 4 * g);
            store4_bf16(YM + (size_t)row * D + h * 256 + 16 * dt + 4 * g, acc[dt] * rstd * gg); }
    }
}

struct EpiBr1 { float* MRG; const bf16_t* GA;
    __device__ __forceinline__ void operator()(int m, int n, f32x4 v) const { const u32x2 gg = *(const u32x2*)(GA + (size_t)m * D + n);
        f32x4 o; o.x = v.x * sigmoidf_(bf2f(gg.x & 0xffffu)); o.y = v.y * sigmoidf_(bf2f(gg.x >> 16)); o.z = v.z * sigmoidf_(bf2f(gg.y & 0xffffu)); o.w = v.w * sigmoidf_(bf2f(gg.y >> 16));
        *(f32x4*)(MRG + (size_t)m * D + n) = o; } };
struct EpiBr2 { const float* MRG; const bf16_t* GB; bf16_t* OUT;
    __device__ __forceinline__ void operator()(int m, int n, f32x4 v) const { const u32x2 gg = *(const u32x2*)(GB + (size_t)m * D + n); const f32x4 t = *(const f32x4*)(MRG + (size_t)m * D + n);
        f32x4 o; o.x = t.x + v.x * sigmoidf_(bf2f(gg.x & 0xffffu)); o.y = t.y + v.y * sigmoidf_(bf2f(gg.x >> 16)); o.z = t.z + v.z * sigmoidf_(bf2f(gg.y & 0xffffu)); o.w = t.w + v.w * sigmoidf_(bf2f(gg.y >> 16));
        store4_bf16(OUT + (size_t)m * D + n, o); } };
struct EpiOut { float* Z; const bf16_t* H;
    __device__ __forceinline__ void operator()(int m, int n, f32x4 v) const { const u32x2 hh = *(const u32x2*)(H + (size_t)m * D + n);
        f32x4 o; o.x = v.x + DN_ALPHA * bf2f(hh.x & 0xffffu); o.y = v.y + DN_ALPHA * bf2f(hh.x >> 16); o.z = v.z + DN_ALPHA * bf2f(hh.y & 0xffffu); o.w = v.w + DN_ALPHA * bf2f(hh.y >> 16);
        *(f32x4*)(Z + (size_t)m * D + n) = o; } };
constexpr int LDS_TAB_OFF = 131072;
constexpr int LDS_MT_OFF = LDS_TAB_OFF + 256;
constexpr int LDS_STAT_OFF = LDS_TAB_OFF + 2048;
__device__ __forceinline__ void compute_mtab_lds(const Params& p, char* lds) {
    float* mt = (float*)(lds + LDS_MT_OFF); float* tmp = (float*)(lds + LDS_STAT_OFF);
    const int t = TIDX;
    if (t < NSC * 4) { tmp[t] = ((const float*)(p.ws + TAB_SCG))[t]; tmp[NSC * 4 + t] = ((const float*)(p.ws + TAB_SCM))[t]; }
    __syncthreads();
    if (t < 4) { float m = 0.f;
        for (int sc = 0; sc < NSC; ++sc) { m = fmaxf(tmp[sc * 4 + t] + m, tmp[NSC * 4 + sc * 4 + t]); mt[sc * 4 + t] = m; } }
    __syncthreads();
}
struct SchedQK { const char* A; const char* B; int G, c; int K, lda, ldb;
    __device__ __forceinline__ bool next(int i, pg8::Unit& u) const { if (!pg8::decode_unit((long)i * G + c, 4, 64, 1, u)) return false; u.pm += 1; return true; }
    __device__ __forceinline__ const char* abase(const pg8::Unit& u) const { return A + ((size_t)u.pm * 256 * D + u.grp * 256) * 2; }
    __device__ __forceinline__ const char* bbase(const pg8::Unit& u) const { return B + ((size_t)u.pm * 256 * D + u.grp * 256) * 2; } };
struct EpiS { unsigned char* ws; const float* mt_lds;
    __device__ __forceinline__ void operator()(const f32x4 (&acc)[2][2][4][2], const pg8::Unit& u, int wr, int wc, int fr, int fq) const {
        asm volatile("" : "+v"(fr), "+v"(fq));
        const int h = u.grp, t0 = u.pm * 256; const float m_prev = mt_lds[(u.pm - 1) * 4 + h];
        const float* te = (const float*)(ws + TAB_E) + (size_t)h * P + t0; const float* tpm = (const float*)(ws + TAB_PM) + (size_t)h * P + t0;
        bf16_t* PMb = (bf16_t*)(ws + B_PM) + (size_t)t0 * D + h * 256; float* denp = (float*)(ws + TAB_DENP);
        const int c0 = wc * 32 + 8 * fq;
        f32x4 e[2][2];
#pragma unroll
        for (int bj = 0; bj < 2; ++bj) { e[bj][0] = *(const f32x4*)(te + c0 + bj * 128); e[bj][1] = *(const f32x4*)(te + c0 + bj * 128 + 4); }
        float tp[2][4];
#pragma unroll
        for (int ai = 0; ai < 2; ++ai)
#pragma unroll
            for (int m = 0; m < 4; ++m) tp[ai][m] = tpm[ai * 128 + wr * 64 + m * 16 + fr];
#pragma unroll
        for (int ai = 0; ai < 2; ++ai)
#pragma unroll
            for (int m = 0; m < 4; ++m) { const int r = ai * 128 + wr * 64 + m * 16 + fr; const float pmx = fmaxf(m_prev, tp[ai][m]); float rs = 0.f;
#pragma unroll
                for (int bj = 0; bj < 2; ++bj) { f32x4 o0, o1;
#pragma unroll
                    for (int j = 0; j < 4; ++j) { const int s0 = c0 + bj * 128 + j, s1 = s0 + 4;
                        o0[j] = s0 <= r ? acc[ai][bj][m][0][j] * __expf(fminf(e[bj][0][j] - pmx, 0.f)) : 0.f;
                        o1[j] = s1 <= r ? acc[ai][bj][m][1][j] * __expf(fminf(e[bj][1][j] - pmx, 0.f)) : 0.f;
                        rs += o0[j] + o1[j]; }
                    *(u32x4*)(PMb + (size_t)r * D + c0 + bj * 128) = pg8::pack8(o0, o1); }
                rs += sx<16>(rs); rs = sum32(rs);
                if (fq == 0) denp[((size_t)(t0 + r) * 4 + h) * 4 + wc] = rs; } } };
struct SchedO1 { const char* A; const char* B; int G, c; int K, lda, ldb;
    __device__ __forceinline__ bool next(int i, pg8::Unit& u) const { if (!pg8::decode_unit((long)i * G + c, 4, 64, 1, u)) return false; u.pm += 1; return true; }
    __device__ __forceinline__ const char* abase(const pg8::Unit& u) const { return A + ((size_t)u.pm * 256 * D + u.grp * 256) * 2; }
    __device__ __forceinline__ const char* bbase(const pg8::Unit& u) const { return B + (size_t)((u.pm - 1) * 4 + u.grp) * 65536 * 2; } };
struct EpiO1 { unsigned char* ws;
    __device__ __forceinline__ void operator()(const f32x4 (&acc)[2][2][4][2], const pg8::Unit& u, int wr, int wc, int fr, int fq) const {
        asm volatile("" : "+v"(fr), "+v"(fq));
        const int h = u.grp, t0 = u.pm * 256; const float m_prev = ((const float*)(ws + TAB_MT))[(u.pm - 1) * 4 + h];
        const float* tpm = (const float*)(ws + TAB_PM) + (size_t)h * P + t0; bf16_t* OI = (bf16_t*)(ws + B_OI) + (size_t)t0 * D + h * 256;
        const int c0 = wc * 32 + 8 * fq;
        float tp[2][4];
#pragma unroll
        for (int ai = 0; ai < 2; ++ai)
#pragma unroll
            for (int m = 0; m < 4; ++m) tp[ai][m] = tpm[ai * 128 + wr * 64 + m * 16 + fr];
#pragma unroll
        for (int ai = 0; ai < 2; ++ai)
#pragma unroll
            for (int m = 0; m < 4; ++m) { const int r = ai * 128 + wr * 64 + m * 16 + fr; const float sc = __expf(fminf(m_prev - tp[ai][m], 0.f));
#pragma unroll
                for (int bj = 0; bj < 2; ++bj) *(u32x4*)(OI + (size_t)r * D + c0 + bj * 128) = pg8::pack8(acc[ai][bj][m][0] * sc, acc[ai][bj][m][1] * sc); } } };
struct SchedO2 { const char* A; const char* B; int G, c; int K, lda, ldb;
    __device__ __forceinline__ bool next(int i, pg8::Unit& u) const { if (!pg8::decode_unit((long)i * G + c, 4, 64, 1, u)) return false; u.pm += 1; return true; }
    __device__ __forceinline__ const char* abase(const pg8::Unit& u) const { return A + ((size_t)u.pm * 256 * D + u.grp * 256) * 2; }
    __device__ __forceinline__ const char* bbase(const pg8::Unit& u) const { return B + ((size_t)u.grp * 256 * P + (size_t)u.pm * 256) * 2; } };
struct EpiO2 { unsigned char* ws; const float* mng; float* stat;
    __device__ __forceinline__ void operator()(f32x4 (&acc)[2][2][4][2], const pg8::Unit& u, int wr, int wc, int fr, int fq) const {
        asm volatile("" : "+v"(fr), "+v"(fq));
        const int h = u.grp, t0 = u.pm * 256; const float m_prev = ((const float*)(ws + TAB_MT))[(u.pm - 1) * 4 + h];
        const float* tpm = (const float*)(ws + TAB_PM) + (size_t)h * P + t0; const float* tb = (const float*)(ws + TAB_B) + (size_t)h * P + t0;
        const float* denp = (const float*)(ws + TAB_DENP); const float* deni = (const float*)(ws + TAB_DENI);
        const bf16_t* OI = (const bf16_t*)(ws + B_OI) + (size_t)t0 * D + h * 256; const bf16_t* OP = (const bf16_t*)(ws + B_OP) + (size_t)t0 * D + h * 256;
        bf16_t* YM = (bf16_t*)(ws + B_YM) + (size_t)t0 * D + h * 256;
        const int c0 = wc * 32 + 8 * fq;
#pragma unroll
        for (int ai = 0; ai < 2; ++ai)
#pragma unroll
            for (int m = 0; m < 4; ++m) { const int r = ai * 128 + wr * 64 + m * 16 + fr;
                const f32x4 dp = *(const f32x4*)(denp + ((size_t)(t0 + r) * 4 + h) * 4); const float den = (dp.x + dp.y) + (dp.z + dp.w) + deni[(size_t)(t0 + r) * 4 + h];
                const float m_t = tb[r] + fmaxf(m_prev, tpm[r]); const float inv = 1.f / fmaxf(fabsf(den), __expf(-m_t));
                float s1 = 0.f, s2 = 0.f;
#pragma unroll
                for (int bj = 0; bj < 2; ++bj) { f32x4 i0, i1, g0, g1; pg8::unpack8(*(const u32x4*)(OI + (size_t)r * D + c0 + bj * 128), i0, i1); pg8::unpack8(*(const u32x4*)(OP + (size_t)r * D + c0 + bj * 128), g0, g1);
                    f32x4 v0 = (acc[ai][bj][m][0] + i0) * inv * sig4(g0), v1 = (acc[ai][bj][m][1] + i1) * inv * sig4(g1);
                    acc[ai][bj][m][0] = v0; acc[ai][bj][m][1] = v1;
                    s1 += (v0.x + v0.y) + (v0.z + v0.w) + (v1.x + v1.y) + (v1.z + v1.w);
                    s2 += (v0.x * v0.x + v0.y * v0.y) + (v0.z * v0.z + v0.w * v0.w) + (v1.x * v1.x + v1.y * v1.y) + (v1.z * v1.z + v1.w * v1.w); }
                s1 += sx<16>(s1); s1 = sum32(s1); s2 += sx<16>(s2); s2 = sum32(s2);
                if (fq == 0) { stat[(r * 4 + wc) * 2] = s1; stat[(r * 4 + wc) * 2 + 1] = s2; } }
        asm volatile("s_waitcnt lgkmcnt(0)" ::: "memory"); __builtin_amdgcn_s_barrier(); asm volatile("" ::: "memory");
#pragma unroll
        for (int ai = 0; ai < 2; ++ai)
#pragma unroll
            for (int m = 0; m < 4; ++m) { const int r = ai * 128 + wr * 64 + m * 16 + fr;
                const f32x4 a = *(const f32x4*)(stat + r * 8), b = *(const f32x4*)(stat + r * 8 + 4);
                const float mu = ((a.x + a.z) + (b.x + b.z)) * (1.f / 256.f), ex2 = ((a.y + a.w) + (b.y + b.w)) * (1.f / 256.f);
                const float rstd = rsqrtf(fmaxf(ex2 - mu * mu, 0.f) + LN_EPS);
#pragma unroll
                for (int bj = 0; bj < 2; ++bj) { const f32x4 g0 = *(const f32x4*)(mng + h * 256 + c0 + bj * 128), g1 = *(const f32x4*)(mng + h * 256 + c0 + bj * 128 + 4);
                    *(u32x4*)(YM + (size_t)r * D + c0 + bj * 128) = pg8::pack8((acc[ai][bj][m][0] - mu) * rstd * g0, (acc[ai][bj][m][1] - mu) * rstd * g1); } } } };
__device__ __forceinline__ void phase_o1(const Params& p, char* lds, int bid, int nb) {
    const int tid = TIDX, wid = __builtin_amdgcn_readfirstlane(tid >> 6), lane = tid & 63, c = lane & 15, g = lane >> 4, gw = bid * NW + wid, ngw = nb * NW;
    const bf16_t* QM = (const bf16_t*)(p.ws + B_QM); const float* NTv = (const float*)(p.ws + TAB_NT); const float* mt = (const float*)(p.ws + TAB_MT);
    const float* tpm = (const float*)(p.ws + TAB_PM); float* deni = (float*)(p.ws + TAB_DENI);
#pragma unroll 2
    for (int it = gw; it < ((P - 256) / 16) * 4; it += ngw) {
        const int h = it & 3, t = 256 + (it >> 2) * 16 + c, sc = t >> 8;
        const bf16_t* qr = QM + (size_t)t * D + h * 256 + 64 * g; const float* nv = NTv + (size_t)((sc - 1) * 4 + h) * 256 + 64 * g;
        float a = 0.f;
#pragma unroll
        for (int i = 0; i < 8; ++i) { const u32x4 qq = *(const u32x4*)(qr + 8 * i); const f32x4 n0 = *(const f32x4*)(nv + 8 * i), n1 = *(const f32x4*)(nv + 8 * i + 4);
            a += bf2f(qq.x & 0xffffu) * n0.x + bf2f(qq.x >> 16) * n0.y + bf2f(qq.y & 0xffffu) * n0.z + bf2f(qq.y >> 16) * n0.w
               + bf2f(qq.z & 0xffffu) * n1.x + bf2f(qq.z >> 16) * n1.y + bf2f(qq.w & 0xffffu) * n1.z + bf2f(qq.w >> 16) * n1.w; }
        a += sx<16>(a); a = sum32(a);
        if (g == 0) deni[(size_t)t * 4 + h] = a * __expf(fminf(mt[(sc - 1) * 4 + h] - tpm[(size_t)h * P + t], 0.f));
    }
    SchedO1 S{(const char*)QM, (const char*)(p.ws + B_CT), nb, bid, 256, D, 256};
    pg8::gemm_phase((PG8_LAS unsigned char*)lds, S, EpiO1{p.ws});
}
__device__ __forceinline__ void phase_sg(const Params& p, char* lds, int bid, int nb) {
    compute_mtab_lds(p, lds);
    SchedQK S{(const char*)(p.ws + B_QM), (const char*)(p.ws + B_KM), nb, bid, 256, D, D};
    pg8::gemm_phase((PG8_LAS unsigned char*)lds, S, EpiS{p.ws, (const float*)(lds + LDS_MT_OFF)});
}
__device__ __forceinline__ void phase_o2(const Params& p, int l, char* lds, int bid, int nb) {
    phase_m3(p, l, lds, bid, nb, true);
    SchedO2 S{(const char*)(p.ws + B_PM), (const char*)(p.ws + B_VMT), nb, bid, 256, D, P};
    pg8::gemm_phase((PG8_LAS unsigned char*)lds, S, EpiO2{p.ws, p.in[I_MNG] + (size_t)l * D, (float*)(lds + LDS_STAT_OFF)});
}

struct SchedMqkvN { const char* XC; const char* WQ; const char* WK; int G, c; int K, lda, ldb;
    __device__ __forceinline__ bool next(int i, pg8::Unit& u) const { if (!pg8::decode_unit((long)i * G + c, 8, 64, 1, u)) return false; u.pm += 1; return true; }
    __device__ __forceinline__ const char* abase(const pg8::Unit& u) const { return XC + (size_t)(u.grp & 3) * 512 + (size_t)u.pm * 256 * D * 2; }
    __device__ __forceinline__ const char* bbase(const pg8::Unit& u) const { return ((u.grp >> 2) ? WK : WQ) + (size_t)(u.grp & 3) * 65536 * 2; } };
struct SchedMqkvT { const char* XC; const char* XM; const char* WK; const char* WV; int G, c; int K, lda, ldb;
    __device__ __forceinline__ bool next(int i, pg8::Unit& u) const { if (!pg8::decode_unit((long)i * G + c, 8, 1, 64, u)) return false; u.pn += 1; return true; }
    __device__ __forceinline__ const char* abase(const pg8::Unit& u) const { return ((u.grp >> 2) ? WV : WK) + (size_t)(u.grp & 3) * 65536 * 2; }
    __device__ __forceinline__ const char* bbase(const pg8::Unit& u) const { return ((u.grp >> 2) ? XM : XC) + (size_t)(u.grp & 3) * 512 + (size_t)u.pn * 256 * D * 2; } };
struct EpiGrpF { bf16_t* base0; bf16_t* base1; size_t hstride; size_t ldc; float s0, s1;
    __device__ __forceinline__ void operator()(const f32x4 (&acc)[2][2][4][2], const pg8::Unit& u, int wr, int wc, int fr, int fq) const {
        const int which = u.grp >> 2, h = u.grp & 3; const float sc = which ? s1 : s0;
        bf16_t* base = (which ? base1 : base0) + (size_t)h * hstride + (size_t)u.pn * 256;
        const size_t ld = ldc;
        pg8::for_each_piece(acc, u, wr, wc, fr, fq, [&](int row, int col, f32x4 v0, f32x4 v1) { *(u32x4*)(base + (size_t)row * ld + col) = pg8::pack8(v0 * sc, v1 * sc); }); } };
struct EpiMqkvT { unsigned char* ws;
    __device__ __forceinline__ void operator()(const f32x4 (&acc)[2][2][4][2], const pg8::Unit& u, int wr, int wc, int fr, int fq) const {
        bf16_t* KMT = (bf16_t*)(ws + B_KMT); bf16_t* VMT = (bf16_t*)(ws + B_VMT); bf16_t* VWT = (bf16_t*)(ws + B_VWT); const float* tw = (const float*)(ws + TAB_W);
        const int which = u.grp >> 2, h = u.grp & 3; const size_t cb = (size_t)u.pn * 256;
        if (which == 0) { bf16_t* base = KMT + (size_t)h * 256 * P + cb;
            pg8::for_each_piece(acc, u, wr, wc, fr, fq, [&](int row, int col, f32x4 v0, f32x4 v1) { *(u32x4*)(base + (size_t)row * P + col) = pg8::pack8(v0 * 0.0625f, v1 * 0.0625f); });
        } else { bf16_t* b0 = VMT + (size_t)h * 256 * P + cb; bf16_t* b1 = VWT + (size_t)h * 256 * P + cb; const float* w = tw + (size_t)h * P + cb;
            struct W2 { f32x4 w0, w1; };
            pg8::for_each_piece_pf(acc, u, wr, wc, fr, fq, [&](int row, int col) { W2 r; r.w0 = *(const f32x4*)(w + col); r.w1 = *(const f32x4*)(w + col + 4); return r; },
                [&](int row, int col, f32x4 v0, f32x4 v1, W2 ww) {
                *(u32x4*)(b0 + (size_t)row * P + col) = pg8::pack8(v0, v1); *(u32x4*)(b1 + (size_t)row * P + col) = pg8::pack8(v0 * ww.w0, v1 * ww.w1); }); } } };
struct EpiStoreW { bf16_t* C0; bf16_t* C1; size_t ldc; const float* w;
    __device__ __forceinline__ void operator()(int m, int n, f32x4 v) const { store4_bf16(C0 + (size_t)m * ldc + n, v); const f32x4 ww = *(const f32x4*)(w + n); store4_bf16(C1 + (size_t)m * ldc + n, v * ww); } };
__device__ __forceinline__ void phase_mqkv_f(const Params& p, char* lds, int bid, int nb) {
    const int tid = TIDX, wid = tid >> 6, gw = bid * NW + wid, ngw = nb * NW;
    const bf16_t* XC = (const bf16_t*)(p.ws + B_XC); const bf16_t* XM = (const bf16_t*)(p.ws + B_XM);
    const bf16_t* WQ = (const bf16_t*)(p.ws + W_Q_T); const bf16_t* WK = (const bf16_t*)(p.ws + W_K_T); const bf16_t* WV = (const bf16_t*)(p.ws + W_V_T);
    bf16_t* QM = (bf16_t*)(p.ws + B_QM); bf16_t* KM = (bf16_t*)(p.ws + B_KM); bf16_t* KMT = (bf16_t*)(p.ws + B_KMT); bf16_t* VMT = (bf16_t*)(p.ws + B_VMT); bf16_t* VWT = (bf16_t*)(p.ws + B_VWT);
    zero_block(KM, D, VALID0, D, bid * NT + tid, nb * NT);
    zero_block(VWT, P, D, VALID0, bid * NT + tid, nb * NT);
    zero_block(KMT, P, D, VALID0, bid * NT + tid, nb * NT);
    zero_block(VMT, P, D, VALID0, bid * NT + tid, nb * NT);
    for (int t = bid; t < 64; t += nb) {
        const int which = (t >> 4) & 1, h = (t >> 2) & 3, q = t & 3;
        if (t < 32) meta_gemm<1, 4>(RowsPlain{XC + h * 256, D}, RowsPlain{(which ? WK : WQ) + (size_t)h * 65536, 256}, 256, VALID0, q * 64, EpiStore{(which ? KM : QM) + h * 256, D, which ? 0.0625f : 1.f}, lds);
        else if (which == 0) meta_gemm<4, 1>(RowsPlain{WK + (size_t)h * 65536, 256}, RowsPlain{XC + h * 256, D}, 256, q * 64, VALID0, EpiStore{KMT + (size_t)h * 256 * P, P, 0.0625f}, lds);
        else meta_gemm<4, 1>(RowsPlain{WV + (size_t)h * 65536, 256}, RowsPlain{XM + h * 256, D}, 256, q * 64, VALID0, EpiStoreW{VMT + (size_t)h * 256 * P, VWT + (size_t)h * 256 * P, P, (const float*)(p.ws + TAB_W) + (size_t)h * P}, lds);
    }
    { SchedMqkvN S{(const char*)XC, (const char*)WQ, (const char*)WK, nb, bid, 256, D, 256};
      pg8::gemm_phase((PG8_LAS unsigned char*)lds, S, EpiGrpF{QM, KM, 256, D, 1.f, 0.0625f}); }
    { SchedMqkvT S{(const char*)XC, (const char*)XM, (const char*)WK, (const char*)WV, nb, bid, 256, 256, D};
      pg8::gemm_phase((PG8_LAS unsigned char*)lds, S, EpiMqkvT{p.ws}); }
}
struct SchedSq { const char* A; const char* B; int G, c; int K, lda, ldb;
    __device__ __forceinline__ bool next(int i, pg8::Unit& u) const { if (!pg8::decode_unit((long)i * G + c, 1, 64, 4, u)) return false; u.pm += 1; return true; }
    __device__ __forceinline__ const char* abase(const pg8::Unit& u) const { return A + (size_t)u.pm * 256 * D * 2; }
    __device__ __forceinline__ const char* bbase(const pg8::Unit& u) const { return B + (size_t)u.pn * 256 * D * 2; } };
struct EpiBr1F { float* MRG; const bf16_t* GA;
    __device__ __forceinline__ void operator()(const f32x4 (&acc)[2][2][4][2], const pg8::Unit& u, int wr, int wc, int fr, int fq) const {
        const int cb = u.pn * 256;
        pg8::for_each_piece(acc, u, wr, wc, fr, fq, [&](int row, int col, f32x4 v0, f32x4 v1) { const size_t idx = (size_t)row * D + cb + col;
            f32x4 g0, g1; pg8::unpack8(*(const u32x4*)(GA + idx), g0, g1);
            *(f32x4*)(MRG + idx) = v0 * sig4(g0); *(f32x4*)(MRG + idx + 4) = v1 * sig4(g1); }); } };
struct EpiBr2F { const float* MRG; const bf16_t* GB; bf16_t* OUT;
    __device__ __forceinline__ void operator()(const f32x4 (&acc)[2][2][4][2], const pg8::Unit& u, int wr, int wc, int fr, int fq) const {
        const int cb = u.pn * 256;
        pg8::for_each_piece(acc, u, wr, wc, fr, fq, [&](int row, int col, f32x4 v0, f32x4 v1) { const size_t idx = (size_t)row * D + cb + col;
            f32x4 g0, g1; pg8::unpack8(*(const u32x4*)(GB + idx), g0, g1);
            const f32x4 t0 = *(const f32x4*)(MRG + idx), t1 = *(const f32x4*)(MRG + idx + 4);
            *(u32x4*)(OUT + idx) = pg8::pack8(t0 + v0 * sig4(g0), t1 + v1 * sig4(g1)); }); } };
struct EpiOutF { float* Z; const bf16_t* H;
    __device__ __forceinline__ void operator()(const f32x4 (&acc)[2][2][4][2], const pg8::Unit& u, int wr, int wc, int fr, int fq) const {
        const int cb = u.pn * 256;
        pg8::for_each_piece_pf(acc, u, wr, wc, fr, fq, [&](int row, int col) { return *(const u32x4*)(H + (size_t)row * D + cb + col); },
            [&](int row, int col, f32x4 v0, f32x4 v1, u32x4 hh) { const size_t idx = (size_t)row * D + cb + col;
            f32x4 h0, h1; pg8::unpack8(hh, h0, h1);
            *(f32x4*)(Z + idx) = v0 + h0 * DN_ALPHA; *(f32x4*)(Z + idx + 4) = v1 + h1 * DN_ALPHA; }); } };
struct SchedBr { const char* YM; const char* YA; const char* WM; const char* WA; int G, c; int K, lda, ldb;
    __device__ __forceinline__ bool next(int i, pg8::Unit& u) const { if (!pg8::decode_unit((long)(i >> 1) * G + c, 1, 64, 4, u)) return false; u.pm += 1; u.grp = i & 1; return true; }
    __device__ __forceinline__ const char* abase(const pg8::Unit& u) const { return (u.grp ? YA : YM) + (size_t)u.pm * 256 * D * 2; }
    __device__ __forceinline__ const char* bbase(const pg8::Unit& u) const { return (u.grp ? WA : WM) + (size_t)u.pn * 256 * D * 2; } };
__device__ __forceinline__ u32x4 ld16_agent(const bf16_t* ptr) {
    const unsigned long long a = __hip_atomic_load((const unsigned long long*)ptr, __ATOMIC_RELAXED, __HIP_MEMORY_SCOPE_AGENT), b = __hip_atomic_load((const unsigned long long*)ptr + 1, __ATOMIC_RELAXED, __HIP_MEMORY_SCOPE_AGENT);
    u32x4 r; r.x = (unsigned)a; r.y = (unsigned)(a >> 32); r.z = (unsigned)b; r.w = (unsigned)(b >> 32); return r; }
struct EpiBrF { unsigned char* ws;
    __device__ __forceinline__ void operator()(const f32x4 (&acc)[2][2][4][2], const pg8::Unit& u, int wr, int wc, int fr, int fq) const {
        const int cb = u.pn * 256; const bf16_t* G = (const bf16_t*)(ws + (u.grp ? B_GB : B_GA)); bf16_t* O = (bf16_t*)(ws + B_MRGB); const bool second = u.grp != 0;
        struct GO { u32x4 g, o; };
        pg8::for_each_piece_pf(acc, u, wr, wc, fr, fq, [&](int row, int col) { const size_t idx = (size_t)row * D + cb + col; GO r; r.g = *(const u32x4*)(G + idx);
                r.o = second ? ld16_agent(O + idx) : (u32x4){0u, 0u, 0u, 0u}; return r; },
            [&](int row, int col, f32x4 v0, f32x4 v1, GO pre) { const size_t idx = (size_t)row * D + cb + col;
            f32x4 g0, g1; pg8::unpack8(pre.g, g0, g1);
            f32x4 r0 = v0 * sig4(g0), r1 = v1 * sig4(g1);
            if (second) { f32x4 t0, t1; pg8::unpack8(pre.o, t0, t1); r0 += t0; r1 += t1; }
            *(u32x4*)(O + idx) = pg8::pack8(r0, r1); }); } };
struct EpiBrS { const bf16_t* G; bf16_t* O; bool second;
    __device__ __forceinline__ void operator()(int m, int n, f32x4 v) const { const u32x2 gg = *(const u32x2*)(G + (size_t)m * D + n);
        f32x4 o; o.x = v.x * sigmoidf_(bf2f(gg.x & 0xffffu)); o.y = v.y * sigmoidf_(bf2f(gg.x >> 16)); o.z = v.z * sigmoidf_(bf2f(gg.y & 0xffffu)); o.w = v.w * sigmoidf_(bf2f(gg.y >> 16));
        if (second) { const unsigned long long t = __hip_atomic_load((const unsigned long long*)(O + (size_t)m * D + n), __ATOMIC_RELAXED, __HIP_MEMORY_SCOPE_AGENT);
            o.x += bf2f((unsigned)t & 0xffffu); o.y += bf2f(((unsigned)t) >> 16); o.z += bf2f((unsigned)(t >> 32) & 0xffffu); o.w += bf2f((unsigned)(t >> 48)); }
        store4_bf16(O + (size_t)m * D + n, o); } };
__device__ __forceinline__ void phase_br_f(const Params& p, char* lds, int bid, int nb) {
    const bf16_t* YM = (const bf16_t*)(p.ws + B_YM); const bf16_t* YA = (const bf16_t*)(p.ws + B_YA);
    const bf16_t* WM = (const bf16_t*)(p.ws + W_BM_T); const bf16_t* WA = (const bf16_t*)(p.ws + W_BA_T); bf16_t* O = (bf16_t*)(p.ws + B_MRGB);
    for (int t = bid; t < 16; t += nb) {
        meta_gemm<1, 4>(RowsPlain{YM, D}, RowsPlain{WM, D}, D, VALID0, t * 64, EpiBrS{(const bf16_t*)(p.ws + B_GA), O, false}, lds);
        asm volatile("s_waitcnt vmcnt(0)" ::: "memory");
        meta_gemm<1, 4>(RowsPlain{YA, D}, RowsPlain{WA, D}, D, VALID0, t * 64, EpiBrS{(const bf16_t*)(p.ws + B_GB), O, true}, lds);
    }
    SchedBr S{(const char*)YM, (const char*)YA, (const char*)WM, (const char*)WA, nb, bid, D, D, D};
    pg8::gemm_phase((PG8_LAS unsigned char*)lds, S, EpiBrF{p.ws});
}
__device__ __forceinline__ void phase_out_f(const Params& p, char* lds, int bid, int nb) {
    const int gw = bid * NW + (TIDX >> 6), ngw = nb * NW;
    const bf16_t* A = (const bf16_t*)(p.ws + B_MRGB); const bf16_t* W = (const bf16_t*)(p.ws + W_OUT_T);
    for (int t = bid; t < 16; t += nb) meta_gemm<1, 4>(RowsPlain{A, D}, RowsPlain{W, D}, D, VALID0, t * 64, EpiOut{(float*)(p.ws + B_Z), (const bf16_t*)(p.ws + B_H)}, lds);
    SchedSq S{(const char*)A, (const char*)W, nb, bid, D, D, D};
    pg8::gemm_phase((PG8_LAS unsigned char*)lds, S, EpiOutF{(float*)(p.ws + B_Z), (const bf16_t*)(p.ws + B_H)});
}

__device__ __forceinline__ void phase_ln1(const Params& p, int l, char* lds, int bid, int nb) {
    const int tid = TIDX, wid = tid >> 6, lane = tid & 63, gw = bid * NW + wid, ngw = nb * NW;
    float* wr = (float*)lds;
    for (int i = tid; i < D * 16 / 4; i += NT) { const int k = i >> 2, q = i & 3; *(f32x4*)(wr + k * 16 + (k >> 2) * 4 + 4 * q) = ((const f32x4*)p.in[I_WR])[i]; }
    unsigned* lcnt = (unsigned*)(lds + 73728); unsigned* lbase = lcnt + 16; int* lrow = (int*)(lds + 73728 + 256) + wid * 64;
    if (tid < 16) lcnt[tid] = 0u;
    __syncthreads();
    const float* Z = (const float*)(p.ws + B_Z); bf16_t* H1 = (bf16_t*)(p.ws + B_H1);
    unsigned* cnt = (unsigned*)(p.ws + WS_CTL) + CW_CNT + l * 16; float* topk = (float*)(p.ws + TAB_TOPK);
    int nrow = 0;
    f32x4 vn[4];
    if (gw < P) {
#pragma unroll
        for (int j = 0; j < 4; ++j) vn[j] = *(const f32x4*)(Z + (size_t)gw * D + 4 * lane + 256 * j); }
    for (int r = gw; r < P; r += ngw) {
        f32x4 v[4];
#pragma unroll
        for (int j = 0; j < 4; ++j) v[j] = vn[j];
        if (r + ngw < P) {
#pragma unroll
            for (int j = 0; j < 4; ++j) vn[j] = *(const f32x4*)(Z + (size_t)(r + ngw) * D + 4 * lane + 256 * j); }
        if (r < VALID0) { store_row_zero(H1 + (size_t)r * D, lane); continue; }
        ln_normalize(v, p.in[I_LN1G] + (size_t)l * D, p.in[I_LN1B] + (size_t)l * D, lane);
        store_row_bf16(H1 + (size_t)r * D, v, lane);
        float lg[16];
#pragma unroll
        for (int e = 0; e < 16; ++e) lg[e] = 0.f;
#pragma unroll
        for (int j = 0; j < 4; ++j)
#pragma unroll
            for (int i = 0; i < 4; ++i) { const int k = 4 * lane + 256 * j + i; const float x = v[j][i];
#pragma unroll
                for (int q = 0; q < 4; ++q) { const f32x4 w = *(const f32x4*)(wr + k * 16 + (k >> 2) * 4 + 4 * q); lg[4 * q] += x * w.x; lg[4 * q + 1] += x * w.y; lg[4 * q + 2] += x * w.z; lg[4 * q + 3] += x * w.w; } }
#pragma unroll
        for (int e = 0; e < 16; ++e) lg[e] = wave_sum(lg[e]);
        if (lane == 0) {
            float mx = lg[0];
#pragma unroll
            for (int e = 1; e < 16; ++e) mx = fmaxf(mx, lg[e]);
            float pr[16], sum = 0.f;
#pragma unroll
            for (int e = 0; e < 16; ++e) { pr[e] = expf(lg[e] - mx); sum += pr[e]; }
            const float isum = 1.f / sum;
            float sel[16];
#pragma unroll
            for (int e = 0; e < 16; ++e) { pr[e] *= isum; sel[e] = pr[e] + p.in[I_RB][e]; }
            int tg = 0; float best = -INFINITY;
#pragma unroll
            for (int gI = 0; gI < 4; ++gI) { const float gs = fmaxf(fmaxf(sel[4 * gI], sel[4 * gI + 1]), fmaxf(sel[4 * gI + 2], sel[4 * gI + 3])); if (gs > best) { best = gs; tg = gI; } }
            int i0 = 0; float b0 = -INFINITY;
#pragma unroll
            for (int e = 0; e < 16; ++e) if ((e >> 2) == tg && sel[e] > b0) { b0 = sel[e]; i0 = e; }
            int i1 = 0; float b1 = -INFINITY;
#pragma unroll
            for (int e = 0; e < 16; ++e) if ((e >> 2) == tg && e != i0 && sel[e] > b1) { b1 = sel[e]; i1 = e; }
            float p0 = 0.f, p1 = 0.f;
#pragma unroll
            for (int e = 0; e < 16; ++e) { if (e == i0) p0 = pr[e]; if (e == i1) p1 = pr[e]; }
            const float inv = 1.f / (p0 + p1);
            const unsigned pos0 = atomicAdd(lcnt + i0, 1u), pos1 = atomicAdd(lcnt + i1, 1u);
            lrow[nrow * 4] = i0; lrow[nrow * 4 + 1] = i1; lrow[nrow * 4 + 2] = (int)pos0; lrow[nrow * 4 + 3] = (int)pos1;
            float* tk = topk + (size_t)r * 8;
            ((int*)tk)[0] = i0; ((int*)tk)[1] = i1; tk[4] = p0 * inv; tk[5] = p1 * inv;
        }
        ++nrow;
    }
    __syncthreads();
    if (tid < 16) lbase[tid] = atomicAdd(cnt + tid, lcnt[tid]);
    __syncthreads();
    if (lane == 0) { int k = 0;
        for (int r = gw; r < P; r += ngw) { if (r < VALID0) continue;
            int* tk = (int*)(topk + (size_t)r * 8); tk[2] = (int)lbase[lrow[k * 4]] + lrow[k * 4 + 2]; tk[3] = (int)lbase[lrow[k * 4 + 1]] + lrow[k * 4 + 3]; ++k; } }
}

__device__ __forceinline__ void expert_offsets(const unsigned* cnt, int* s_cnt, int* s_off, int* s_tiles) {
    int off = 0;
    if (TIDX == 0) { int tt = 0; for (int e = 0; e < 16; ++e) { const int c = (int)cnt[e]; const int tl = (c + 255) >> 8; s_cnt[e] = c; s_off[e] = off; s_tiles[e] = tt; off += tl * 256; tt += tl; } s_tiles[16] = tt; }
    __syncthreads();
}
__device__ __forceinline__ void phase_perm(const Params& p, int l, char* lds, int bid, int nb) {
    int* s_cnt = (int*)(lds + LDS_TAB_OFF); int* s_off = s_cnt + 16; int* s_tiles = s_off + 16;
    expert_offsets((const unsigned*)(p.ws + WS_CTL) + CW_CNT + l * 16, s_cnt, s_off, s_tiles);
    const int tid = TIDX, wid = tid >> 6, lane = tid & 63, gw = bid * NW + wid, ngw = nb * NW;
    const bf16_t* H1 = (const bf16_t*)(p.ws + B_H1); bf16_t* XP = (bf16_t*)(p.ws + B_XP); const float* topk = (const float*)(p.ws + TAB_TOPK);
    int r = VALID0 + gw;
    u32x4 a, b; u32x4 tk;
    if (r < P) { tk = *(const u32x4*)(topk + (size_t)r * 8); const u32x4* src = (const u32x4*)(H1 + (size_t)r * D) + lane * 2; a = src[0]; b = src[1]; }
    while (r < P) {
        const int rn = r + ngw; u32x4 an, bn, tkn;
        if (rn < P) { tkn = *(const u32x4*)(topk + (size_t)rn * 8); const u32x4* src = (const u32x4*)(H1 + (size_t)rn * D) + lane * 2; an = src[0]; bn = src[1]; }
        const int e0 = (int)tk.x, e1 = (int)tk.y, p0 = (int)tk.z, p1 = (int)tk.w;
        u32x4* d0 = (u32x4*)(XP + (size_t)(s_off[e0] + p0) * D) + lane * 2; u32x4* d1 = (u32x4*)(XP + (size_t)(s_off[e1] + p1) * D) + lane * 2;
        d0[0] = a; d0[1] = b; d1[0] = a; d1[1] = b;
        a = an; b = bn; tk = tkn; r = rn;
    }
}
struct SchedMoE { const char* A; const char* B; size_t estride; int nN; const int* s_off; const int* s_tiles; int G, c; int K, lda, ldb;
    __device__ __forceinline__ bool next(int i, pg8::Unit& u) const {
        const int nwg = s_tiles[16] * nN; const long L = (long)i * G + c; if (L >= nwg) return false;
        int wgid = (int)L; { const int q = nwg / 8, r = nwg % 8, xcd = wgid % 8, off = wgid / 8; wgid = (xcd < r ? xcd * (q + 1) : r * (q + 1) + (xcd - r) * q) + off; }
        const int rt = wgid / nN; int e = 0;
        while (e < 15 && rt >= s_tiles[e + 1]) ++e;
        u.grp = __builtin_amdgcn_readfirstlane(e); u.pm = __builtin_amdgcn_readfirstlane((s_off[e] >> 8) + rt - s_tiles[e]); u.pn = __builtin_amdgcn_readfirstlane(wgid % nN); return true; }
    __device__ __forceinline__ const char* abase(const pg8::Unit& u) const { return A + (size_t)u.pm * 256 * D * 2; }
    __device__ __forceinline__ const char* bbase(const pg8::Unit& u) const { return B + (size_t)u.grp * estride + (size_t)u.pn * 256 * D * 2; } };
struct EpiE1F { bf16_t* HID;
    __device__ __forceinline__ void operator()(const f32x4 (&acc)[2][2][4][2], const pg8::Unit& u, int wr, int wc, int fr, int fq) const {
        asm volatile("" : "+v"(fr), "+v"(fq));
        const int row0 = u.pm * 256 + wr * 64 + fr, col0 = u.pn * 128 + wc * 32 + 8 * fq;
#pragma unroll
        for (int ai = 0; ai < 2; ++ai)
#pragma unroll
            for (int m = 0; m < 4; ++m) { f32x4 h0, h1;
#pragma unroll
                for (int r = 0; r < 4; ++r) { h0[r] = siluf_(acc[ai][0][m][0][r]) * acc[ai][1][m][0][r]; h1[r] = siluf_(acc[ai][0][m][1][r]) * acc[ai][1][m][1][r]; }
                *(u32x4*)(HID + (size_t)(row0 + ai * 128 + m * 16) * D + col0) = pg8::pack8(h0, h1); } } };
struct EpiE2F { bf16_t* YB;
    __device__ __forceinline__ void operator()(const f32x4 (&acc)[2][2][4][2], const pg8::Unit& u, int wr, int wc, int fr, int fq) const {
        bf16_t* base = YB + u.pn * 256;
        pg8::for_each_piece(acc, u, wr, wc, fr, fq, [&](int row, int col, f32x4 v0, f32x4 v1) { *(u32x4*)(base + (size_t)row * D + col) = pg8::pack8(v0, v1); }); } };
__device__ __forceinline__ void phase_e1_f(const Params& p, int l, char* lds, int bid, int nb) {
    int* s_cnt = (int*)(lds + LDS_TAB_OFF); int* s_off = s_cnt + 16; int* s_tiles = s_off + 16;
    expert_offsets((const unsigned*)(p.ws + WS_CTL) + CW_CNT + l * 16, s_cnt, s_off, s_tiles);
    SchedMoE S{(const char*)(p.ws + B_XP), (const char*)(p.ws + W_G_T), (size_t)2048 * D * 2, 8, s_off, s_tiles, nb, bid, D, D, D};
    pg8::gemm_phase((PG8_LAS unsigned char*)lds, S, EpiE1F{(bf16_t*)(p.ws + B_HID)});
}
__device__ __forceinline__ void phase_e2_f(const Params& p, int l, char* lds, int bid, int nb) {
    int* s_cnt = (int*)(lds + LDS_TAB_OFF); int* s_off = s_cnt + 16; int* s_tiles = s_off + 16;
    expert_offsets((const unsigned*)(p.ws + WS_CTL) + CW_CNT + l * 16, s_cnt, s_off, s_tiles);
    SchedMoE S{(const char*)(p.ws + B_HID), (const char*)(p.ws + W_D_T), (size_t)D * D * 2, 4, s_off, s_tiles, nb, bid, D, D, D};
    pg8::gemm_phase((PG8_LAS unsigned char*)lds, S, EpiE2F{(bf16_t*)(p.ws + B_YB)});
}

__device__ __forceinline__ void phase_combine(const Params& p, int l, char* lds, int bid, int nb) {
    const int tid = TIDX, wid = tid >> 6, lane = tid & 63, gw = bid * NW + wid, ngw = nb * NW;
    const bool last = (l == DEPTH - 1);
    if (!last) { convert_weights(p, l + 1, lds, gw, ngw, wid, lane); __syncthreads(); }
    int* s_cnt = (int*)(lds + 65536); int* s_off = s_cnt + 16; int* s_tiles = s_off + 16;
    expert_offsets((const unsigned*)(p.ws + WS_CTL) + CW_CNT + l * 16, s_cnt, s_off, s_tiles);
    float* g8 = (float*)lds;
    if (!last) load_gate_w(p, l + 1, g8);
    const bf16_t* H1 = (const bf16_t*)(p.ws + B_H1); const bf16_t* YB = (const bf16_t*)(p.ws + B_YB); bf16_t* H = (bf16_t*)(p.ws + B_H);
    const float* topk = (const float*)(p.ws + TAB_TOPK);
    for (int r = gw; r < P; r += ngw) {
        if (r < VALID0) { if (!last) { store_row_zero(H + (size_t)r * D, lane); gates_row_pad(p, r, lane); } continue; }
        if (last && r < 256) continue;
        const float* tk = topk + (size_t)r * 8;
        const int e0 = ((const int*)tk)[0], e1 = ((const int*)tk)[1], p0 = ((const int*)tk)[2], p1 = ((const int*)tk)[3]; const float w0 = tk[4], w1 = tk[5];
        const bf16_t* y0 = YB + (size_t)(s_off[e0] + p0) * D; const bf16_t* y1 = YB + (size_t)(s_off[e1] + p1) * D; const bf16_t* hr = H1 + (size_t)r * D;
        f32x4 v[4];
#pragma unroll
        for (int j = 0; j < 4; ++j) { const int cc = 4 * lane + 256 * j; const u32x2 a = *(const u32x2*)(y0 + cc), b = *(const u32x2*)(y1 + cc), hh = *(const u32x2*)(hr + cc);
            v[j].x = DN_ALPHA * bf2f(hh.x & 0xffffu) + w0 * bf2f(a.x & 0xffffu) + w1 * bf2f(b.x & 0xffffu);
            v[j].y = DN_ALPHA * bf2f(hh.x >> 16) + w0 * bf2f(a.x >> 16) + w1 * bf2f(b.x >> 16);
            v[j].z = DN_ALPHA * bf2f(hh.y & 0xffffu) + w0 * bf2f(a.y & 0xffffu) + w1 * bf2f(b.y & 0xffffu);
            v[j].w = DN_ALPHA * bf2f(hh.y >> 16) + w0 * bf2f(a.y >> 16) + w1 * bf2f(b.y >> 16); }
        ln_normalize(v, p.in[I_LN2G] + (size_t)l * D, p.in[I_LN2B] + (size_t)l * D, lane);
        if (last) {
            float* o = p.out + (size_t)(r - 256) * D;
#pragma unroll
            for (int j = 0; j < 4; ++j) *(f32x4*)(o + 4 * lane + 256 * j) = v[j];
        } else { store_row_bf16(H + (size_t)r * D, v, lane); gates_row(p, l + 1, g8, v, r, lane); }
    }
}

#define XB_TMO      128
#define XB_XCNT(j)  (256  + 64 * (j))
#define XB_XSUB(j)  (1280 + 64 * (j))
#define XB_XGEN(j)  (2304 + 64 * (j))
#define XB_TOP      3328
#define XB_TOPGEN   3392
#define XCD_BAR_WORDS 3456
#define XB_SPIN_CAP (1u << 18)
#define LAS __attribute__((address_space(3)))

__device__ __forceinline__ unsigned xb_ld(unsigned* p)              { return __hip_atomic_load(p, __ATOMIC_RELAXED, __HIP_MEMORY_SCOPE_AGENT); }
__device__ __forceinline__ unsigned xb_add(unsigned* p, unsigned v) { return __hip_atomic_fetch_add(p, v, __ATOMIC_RELAXED, __HIP_MEMORY_SCOPE_AGENT); }
__device__ __forceinline__ unsigned xb_xcc_id() { return (unsigned)__builtin_amdgcn_s_getreg((3 << 11) | 20) & 0xFu; }
#define XB_SPIN(cond, bar) do { unsigned _sp = 0; while (cond) { __builtin_amdgcn_s_sleep(1); \
    if ((++_sp & 255u) == 0u) { if (xb_ld(&(bar)[XB_TMO])) break; if (_sp > XB_SPIN_CAP) { atomicAdd(&(bar)[XB_TMO], 1u); break; } } } } while (0)

struct XcdBarrier {
    unsigned* bar; unsigned x;
    volatile LAS unsigned* st;
};
__device__ __forceinline__ XcdBarrier xcd_barrier_post(unsigned* bar, volatile LAS unsigned* st) {
    XcdBarrier b; b.bar = bar; b.x = xb_xcc_id(); b.st = st;
    if (threadIdx.x == 0) (void)xb_add(&bar[XB_XCNT(b.x)], 1u);
    return b;
}
__device__ __forceinline__ void xcd_barrier_complete(unsigned* bar, unsigned x, unsigned& nloc, unsigned& nx) {
    const unsigned G = gridDim.x * gridDim.y * gridDim.z;
    unsigned sum, cnt, mine, sp = 0u;
    for (;;) {
        sum = 0u; cnt = 0u; mine = 0u;
#pragma unroll
        for (unsigned j = 0; j < 16; ++j) { const unsigned c = xb_ld(&bar[XB_XCNT(j)]); sum += c; cnt += (c > 0u) ? 1u : 0u; mine = (j == x) ? c : mine; }
        if (sum == G) break;
        __builtin_amdgcn_s_sleep(1);
        if ((++sp & 255u) == 0u) { if (xb_ld(&bar[XB_TMO])) break; if (sp > XB_SPIN_CAP) { atomicAdd(&bar[XB_TMO], 1u); break; } }
    }
    nloc = mine > 0u ? mine : 1u; nx = cnt > 0u ? cnt : 1u;
}
__device__ __forceinline__ void xcd_barrier(const XcdBarrier& b) {
    asm volatile("s_waitcnt vmcnt(0)" ::: "memory");
    __syncthreads();
    if (threadIdx.x == 0) {
        unsigned* bar = b.bar;
        __builtin_amdgcn_s_waitcnt(0);
        unsigned nloc = b.st[0], nx = b.st[1];
        if (nloc == 0u) { xcd_barrier_complete(bar, b.x, nloc, nx); b.st[0] = nloc; b.st[1] = nx; }
        const unsigned old = xb_add(&bar[XB_XSUB(b.x)], 1u);
        const unsigned gen = old / nloc;
        if (old + 1u == (gen + 1u) * nloc) {
            __builtin_amdgcn_fence(__ATOMIC_RELEASE, "agent");
            asm volatile("s_waitcnt vmcnt(0)" ::: "memory");
            const unsigned og = xb_add(&bar[XB_TOP], 1u);
            const unsigned tg = og / nx;
            if (og + 1u == (tg + 1u) * nx) xb_add(&bar[XB_TOPGEN], 1u);
            else XB_SPIN(xb_ld(&bar[XB_TOPGEN]) == tg, bar);
            __builtin_amdgcn_fence(__ATOMIC_ACQUIRE, "agent");
            xb_add(&bar[XB_XGEN(b.x)], 1u);
            asm volatile("s_waitcnt vmcnt(0)" ::: "memory");
        } else {
            XB_SPIN(xb_ld(&bar[XB_XGEN(b.x)]) == gen, bar);
            __builtin_amdgcn_fence(__ATOMIC_ACQUIRE, "agent");
            asm volatile("s_waitcnt vmcnt(0)" ::: "memory");
        }
    }
    __syncthreads();
}

constexpr int LDS_BYTES = 131072 + 12288;
constexpr int LDS_BAR_OFF = LDS_BYTES - 16;
constexpr int CW_BAR = 4096;
template <int L>
__device__ __forceinline__ void layer_body(const Params& p, char* lds, int bid, int nb, const XcdBarrier& bar) {
    phase_proj_f(p, lds, bid, nb); xcd_barrier(bar);
    phase_attn_f(p, L, lds, bid, nb); xcd_barrier(bar);
    phase_conv(p, L, lds, bid, nb); xcd_barrier(bar);
    phase_mqkv_f(p, lds, bid, nb); xcd_barrier(bar);
    phase_ms(p, lds, bid, nb); phase_sg(p, lds, bid, nb); xcd_barrier(bar);
    phase_m2(p, lds, bid, nb); xcd_barrier(bar);
    phase_o1(p, lds, bid, nb); xcd_barrier(bar);
    phase_o2(p, L, lds, bid, nb); xcd_barrier(bar);
    phase_br_f(p, lds, bid, nb); xcd_barrier(bar);
    phase_out_f(p, lds, bid, nb); xcd_barrier(bar);
    phase_ln1(p, L, lds, bid, nb); xcd_barrier(bar);
    phase_perm(p, L, lds, bid, nb); xcd_barrier(bar);
    phase_e1_f(p, L, lds, bid, nb); xcd_barrier(bar);
    phase_e2_f(p, L, lds, bid, nb); xcd_barrier(bar);
    phase_combine(p, L, lds, bid, nb); if (L + 1 < DEPTH) xcd_barrier(bar);
}
__global__ void __launch_bounds__(NT, 2) fwd_kernel(Params p) {
    extern __shared__ __attribute__((aligned(16))) char lds[];
    const int bid = blockIdx.x, nb = gridDim.x;
    if (threadIdx.x == 0) *(uint4*)(lds + LDS_BAR_OFF) = make_uint4(0u, 0u, 0u, 0u);
    __syncthreads();
    XcdBarrier bar = xcd_barrier_post((unsigned*)(p.ws + WS_CTL) + CW_BAR, (volatile LAS unsigned*)(lds + LDS_BAR_OFF));
    phase_prologue(p, lds, bid, nb); xcd_barrier(bar);
    layer_body<0>(p, lds, bid, nb, bar);
    layer_body<1>(p, lds, bid, nb, bar);
}

extern "C" void kernel_launch(void* const* d_in, const int* in_sizes, int n_in, void* d_out, int out_size, void* d_ws, size_t ws_size, hipStream_t stream) {
    if (n_in != 30 || ws_size < WS_END) { fprintf(stderr, "kernel_launch: unexpected n_in %d or ws_size %zu (< %zu)\n", n_in, ws_size, (size_t)WS_END); return; }
    static int grid = 0;
    if (grid == 0) {
        int dev = 0, cus = 0;
        if (hipGetDevice(&dev) != hipSuccess || hipDeviceGetAttribute(&cus, hipDeviceAttributeMultiprocessorCount, dev) != hipSuccess || cus <= 0) cus = 256;
        (void)hipFuncSetAttribute((const void*)fwd_kernel, hipFuncAttributeMaxDynamicSharedMemorySize, LDS_BYTES);
        grid = cus;
    }
    Params p{};
    for (int i = 0; i < 30; ++i) p.in[i] = (const float*)d_in[i];
    p.out = (float*)d_out; p.ws = (unsigned char*)d_ws;
    (void)hipMemsetAsync((char*)d_ws + WS_CTL, 0, CTL_BYTES, stream);
    hipLaunchKernelGGL(fwd_kernel, dim3(grid), dim3(NT), LDS_BYTES, stream, p);
}
```

```cpp
#include <hip/hip_runtime.h>
#include <cstdio>
#include <cstdint>

constexpr int D = 1024;
constexpr int SEQ = 16384;
constexpr int NMETA = 16;
constexpr int P = 16640;
constexpr int VALID0 = 240;
constexpr int DEPTH = 2;
constexpr int DIN = 7176;
constexpr int NSC = 65;
constexpr int NEXP = 16;
constexpr float LN_EPS = 1e-5f;
constexpr float DN_ALPHA = 1.4142135623730951f;
constexpr float NEGBIG = -1e30f;
constexpr float QA_PRESCALE = 0.18033688011112042f;
constexpr int NT = 512;
constexpr int NW = 8;

typedef unsigned short bf16_t;
typedef short bf16x8 __attribute__((ext_vector_type(8)));
typedef float f32x4 __attribute__((ext_vector_type(4)));
typedef unsigned u32x4 __attribute__((ext_vector_type(4)));
typedef unsigned u32x2 __attribute__((ext_vector_type(2)));

constexpr size_t MiB = 1u << 20;
constexpr size_t RB = (size_t)P * D * 2;
constexpr size_t WS_CTL = 0;
constexpr size_t CTL_BYTES = 1 * MiB;
constexpr size_t WS_TAB = 1 * MiB;
constexpr size_t TAB_GLI = WS_TAB;
constexpr size_t TAB_GLF = TAB_GLI + 4 * P * 4;
constexpr size_t TAB_B   = TAB_GLF + 4 * P * 4;
constexpr size_t TAB_E   = TAB_B + 4 * P * 4;
constexpr size_t TAB_PM  = TAB_E + 4 * P * 4;
constexpr size_t TAB_W   = TAB_PM + 4 * P * 4;
constexpr size_t TAB_SCG = TAB_W + 4 * P * 4;
constexpr size_t TAB_SCM = TAB_SCG + 4096;
constexpr size_t TAB_MT  = TAB_SCM + 4096;
constexpr size_t TAB_NT  = TAB_MT + 4096;
constexpr size_t TAB_TOPK = TAB_NT + (size_t)NSC * 4 * 256 * 4;
constexpr size_t TAB_ELIST = TAB_TOPK + (size_t)P * 32;
constexpr size_t TAB_DENP = TAB_ELIST + (size_t)NEXP * P * 4;
constexpr size_t TAB_DENI = TAB_DENP + (size_t)P * 16 * 4;
constexpr size_t TAB_END = TAB_DENI + (size_t)P * 4 * 4;
static_assert(TAB_END <= 8 * MiB, "tables");
constexpr size_t WS_W = 8 * MiB;
constexpr size_t W_IN_T = WS_W;
constexpr size_t W_Q_T = W_IN_T + (size_t)7168 * 1024 * 2;
constexpr size_t W_K_T = W_Q_T + 4 * 65536 * 2;
constexpr size_t W_V_T = W_K_T + 4 * 65536 * 2;
constexpr size_t W_BM_T = W_V_T + 4 * 65536 * 2;
constexpr size_t W_BA_T = W_BM_T + (size_t)D * D * 2;
constexpr size_t W_OUT_T = W_BA_T + (size_t)D * D * 2;
constexpr size_t W_G_T = W_OUT_T + (size_t)D * D * 2;
constexpr size_t W_U_T = W_G_T + (size_t)NEXP * D * D * 2;
constexpr size_t W_D_T = W_U_T + (size_t)NEXP * D * D * 2;
constexpr size_t W_END = W_D_T + (size_t)NEXP * D * D * 2;
static_assert(W_END <= 128 * MiB, "weights");
constexpr size_t WS_SLOT = 128 * MiB;
constexpr size_t SLOT(int i) { return WS_SLOT + (size_t)i * RB; }
constexpr size_t WS_END = WS_SLOT + 12 * RB;
constexpr size_t B_H = SLOT(0);
constexpr size_t B_XM = SLOT(1), B_PM = SLOT(1);
constexpr size_t B_OP = SLOT(2), B_MRGB = SLOT(2);
constexpr size_t B_QA = SLOT(3), B_QM = SLOT(3), B_MRG = SLOT(3);
constexpr size_t B_KA = SLOT(4), B_XC = SLOT(4), B_CT = SLOT(4);
constexpr size_t B_KM = SLOT(5), B_OI = SLOT(5), B_H1 = SLOT(5);
constexpr size_t B_GA = SLOT(6);
constexpr size_t B_GB = SLOT(7);
constexpr size_t B_YA = SLOT(8);
constexpr size_t B_KMT = SLOT(9), B_YM = SLOT(9);
constexpr size_t B_VA = SLOT(10), B_VMT = SLOT(10);
constexpr size_t B_VWT = SLOT(11);
constexpr size_t B_Z = SLOT(10);
constexpr size_t B_HID = SLOT(6);
constexpr size_t B_XP = SLOT(1);
constexpr size_t B_YB = SLOT(9);
constexpr int HID_ROWS_MAX = (int)(3 * RB / (D * 2));
constexpr int CW_CNT = 64;

struct Params {
    const float* in[30];
    float* out;
    unsigned char* ws;
};
enum { I_X = 0, I_META, I_LNG, I_LNB, I_WIN, I_CONVW, I_CONVB, I_WQM, I_WKM, I_WVM, I_BI, I_BF, I_MNG, I_LQ1, I_LK1, I_LQ2, I_LK2, I_ANG,
       I_WBM, I_WBA, I_WOUT, I_LN1G, I_LN1B, I_LN2G, I_LN2B, I_WR, I_RB, I_WG, I_WU, I_WD };

__device__ __forceinline__ int tid_opaque() { int t = threadIdx.x; asm volatile("" : "+v"(t)); return t; }
#define TIDX tid_opaque()
__device__ __forceinline__ float bf2f(unsigned v) { return __uint_as_float(v << 16); }
__device__ __forceinline__ unsigned f2bf(float f) { unsigned u = __float_as_uint(f); return (u + 0x7fffu + ((u >> 16) & 1u)) >> 16; }
__device__ __forceinline__ unsigned pk2(float lo, float hi) { return f2bf(lo) | (f2bf(hi) << 16); }
template <int M> __device__ __forceinline__ float sx(float v) {
    static_assert(M == 1 || M == 2 || M == 4 || M == 8 || M == 16, "sx: xor mask within 32 lanes");
    return __int_as_float(__builtin_amdgcn_ds_swizzle(__float_as_int(v), 0x1f | (M << 10)));
}
__device__ __forceinline__ float sum32(float v) {
    auto rr = __builtin_amdgcn_permlane32_swap(__float_as_uint(v), __float_as_uint(v), false, false);
    return __uint_as_float(rr[0]) + __uint_as_float(rr[1]);
}
__device__ __forceinline__ float wave_sum(float v) {
    v += sx<1>(v); v += sx<2>(v); v += sx<4>(v); v += sx<8>(v); v += sx<16>(v); v = sum32(v);
    return v;
}
__device__ __forceinline__ float sigmoidf_(float x) { return 1.f / (1.f + __expf(-x)); }
__device__ __forceinline__ float siluf_(float x) { return x / (1.f + __expf(-x)); }
__device__ __forceinline__ float logsigmoidf_(float x) { return x >= 0.f ? -log1pf(__expf(-x)) : x - log1pf(__expf(x)); }
__device__ __forceinline__ f32x4 sig4(f32x4 v) { f32x4 o; o.x = sigmoidf_(v.x); o.y = sigmoidf_(v.y); o.z = sigmoidf_(v.z); o.w = sigmoidf_(v.w); return o; }
__device__ __forceinline__ f32x4 mfma16(bf16x8 a, bf16x8 b, f32x4 c) { return __builtin_amdgcn_mfma_f32_16x16x32_bf16(a, b, c, 0, 0, 0); }
__device__ __forceinline__ bf16x8 ld8(const bf16_t* p) { return *(const bf16x8*)p; }

__device__ __forceinline__ void transpose_item(const float* W, int K, size_t ldsrc, int k0, int n_src0, bf16_t* WT, int dst_row0, float* scr, int lane) {
#pragma unroll 8
    for (int i = 0; i < 32; ++i) { const int kk = 2 * i + (lane >> 5); scr[kk * 33 + (lane & 31)] = W[(size_t)(k0 + kk) * ldsrc + n_src0 + (lane & 31)]; }
    __builtin_amdgcn_wave_barrier();
    asm volatile("s_waitcnt lgkmcnt(0)" ::: "memory");
    const int c = lane & 7;
#pragma unroll
    for (int j = 0; j < 4; ++j) { const int n = (lane >> 3) + 8 * j; const float* s = scr + (8 * c) * 33 + n;
        u32x4 o; o.x = pk2(s[0 * 33], s[1 * 33]); o.y = pk2(s[2 * 33], s[3 * 33]); o.z = pk2(s[4 * 33], s[5 * 33]); o.w = pk2(s[6 * 33], s[7 * 33]);
        *(u32x4*)(WT + (size_t)(dst_row0 + n) * K + k0 + 8 * c) = o; }
    asm volatile("s_waitcnt lgkmcnt(0)" ::: "memory");
    __builtin_amdgcn_wave_barrier();
}
__device__ __forceinline__ void convert_weights(const Params& p, int l, char* lds, int gw, int ngw, int wid, int lane) {
    float* scr = (float*)lds + wid * (64 * 33);
    unsigned char* ws = p.ws;
    constexpr int I_IN = 16 * 224, I_QKV = 3 * 4 * 4 * 8, I_SQ = 16 * 32, I_EXP = 3 * 16 * 512;
    constexpr int TOTAL = I_IN + I_QKV + 3 * I_SQ + I_EXP;
    for (int it = gw; it < TOTAL; it += ngw) {
        int r = it;
        if (r < I_IN) { const int kb = r / 224, nb = r % 224, r0 = nb * 32, nsrc = r0 < 2048 ? r0 : r0 + 8;
            transpose_item(p.in[I_WIN] + (size_t)l * D * DIN, D, DIN, kb * 64, nsrc, (bf16_t*)(ws + W_IN_T), r0, scr, lane); continue; }
        r -= I_IN;
        if (r < I_QKV) { const int w = r / 128, rr = r % 128, h = rr / 32, t = rr % 32, kb = t / 8, nb = t % 8;
            const float* src = p.in[w == 0 ? I_WQM : (w == 1 ? I_WKM : I_WVM)] + ((size_t)l * 4 + h) * 65536;
            bf16_t* dst = (bf16_t*)(ws + (w == 0 ? W_Q_T : (w == 1 ? W_K_T : W_V_T))) + (size_t)h * 65536;
            transpose_item(src, 256, 256, kb * 64, nb * 32, dst, nb * 32, scr, lane); continue; }
        r -= I_QKV;
        if (r < 3 * I_SQ) { const int w = r / I_SQ, t = r % I_SQ, kb = t / 32, nb = t % 32;
            const float* src = p.in[w == 0 ? I_WBM : (w == 1 ? I_WBA : I_WOUT)] + (size_t)l * D * D;
            bf16_t* dst = (bf16_t*)(ws + (w == 0 ? W_BM_T : (w == 1 ? W_BA_T : W_OUT_T)));
            transpose_item(src, D, D, kb * 64, nb * 32, dst, nb * 32, scr, lane); continue; }
        r -= 3 * I_SQ;
        { const int w = r / (16 * 512), rr = r % (16 * 512), e = rr / 512, t = rr % 512, kb = t / 32, nb = t % 32;
            const float* src = p.in[w == 0 ? I_WG : (w == 1 ? I_WU : I_WD)] + ((size_t)l * NEXP + e) * D * D;
            if (w == 2) transpose_item(src, D, D, kb * 64, nb * 32, (bf16_t*)(ws + W_D_T) + (size_t)e * D * D, nb * 32, scr, lane);
            else { const int j0 = nb * 32; transpose_item(src, D, D, kb * 64, j0, (bf16_t*)(ws + W_G_T) + (size_t)e * 2048 * D, 256 * (j0 >> 7) + (j0 & 127) + (w == 1 ? 128 : 0), scr, lane); } }
    }
}

__device__ __forceinline__ void ln_normalize(f32x4 (&v)[4], const float* g, const float* b, int lane) {
    float s = 0.f;
#pragma unroll
    for (int j = 0; j < 4; ++j) s += (v[j].x + v[j].y) + (v[j].z + v[j].w);
    const float mean = wave_sum(s) * (1.f / D);
    float s2 = 0.f;
#pragma unroll
    for (int j = 0; j < 4; ++j) { v[j] = v[j] - mean; s2 += (v[j].x * v[j].x + v[j].y * v[j].y) + (v[j].z * v[j].z + v[j].w * v[j].w); }
    const float rstd = rsqrtf(wave_sum(s2) * (1.f / D) + LN_EPS);
#pragma unroll
    for (int j = 0; j < 4; ++j) { const f32x4 gg = *(const f32x4*)(g + 4 * lane + 256 * j), bb = *(const f32x4*)(b + 4 * lane + 256 * j); v[j] = v[j] * rstd * gg + bb; }
}
__device__ __forceinline__ void store_row_bf16(bf16_t* row, const f32x4 (&v)[4], int lane) {
#pragma unroll
    for (int j = 0; j < 4; ++j) { u32x2 o; o.x = pk2(v[j].x, v[j].y); o.y = pk2(v[j].z, v[j].w); *(u32x2*)(row + 4 * lane + 256 * j) = o; }
}
__device__ __forceinline__ void store_row_zero(bf16_t* row, int lane) {
#pragma unroll
    for (int j = 0; j < 4; ++j) { u32x2 o; o.x = 0u; o.y = 0u; *(u32x2*)(row + 4 * lane + 256 * j) = o; }
}
__device__ __forceinline__ void load_gate_w(const Params& p, int l, float* g8) {
    const float* w = p.in[I_WIN] + (size_t)l * D * DIN + 2048;
    for (int i = TIDX; i < D * 8; i += NT) { const int k = i >> 3, c = i & 7; g8[k * 8 + (k >> 2) * 4 + c] = w[(size_t)k * DIN + c]; }
    __syncthreads();
}
__device__ __forceinline__ void gates_row(const Params& p, int l, const float* g8, const f32x4 (&v)[4], int prow, int lane) {
    float acc[8];
#pragma unroll
    for (int c = 0; c < 8; ++c) acc[c] = 0.f;
#pragma unroll
    for (int j = 0; j < 4; ++j)
#pragma unroll
        for (int i = 0; i < 4; ++i) { const int k = 4 * lane + 256 * j + i; const float x = v[j][i];
            const f32x4 w0 = *(const f32x4*)(g8 + k * 8 + (k >> 2) * 4), w1 = *(const f32x4*)(g8 + k * 8 + (k >> 2) * 4 + 4);
            acc[0] += x * w0.x; acc[1] += x * w0.y; acc[2] += x * w0.z; acc[3] += x * w0.w; acc[4] += x * w1.x; acc[5] += x * w1.y; acc[6] += x * w1.z; acc[7] += x * w1.w; }
#pragma unroll
    for (int c = 0; c < 8; ++c) acc[c] = wave_sum(acc[c]);
    if (lane < 4) {
        float* gli = (float*)(p.ws + TAB_GLI); float* glf = (float*)(p.ws + TAB_GLF);
        const float bi = p.in[I_BI][l * 4 + lane], bfv = p.in[I_BF][l * 4 + lane];
        float ai = acc[0], af = acc[4];
        if (lane == 1) { ai = acc[1]; af = acc[5]; } else if (lane == 2) { ai = acc[2]; af = acc[6]; } else if (lane == 3) { ai = acc[3]; af = acc[7]; }
        gli[(size_t)lane * P + prow] = ai + bi;
        glf[(size_t)lane * P + prow] = logsigmoidf_(af + bfv);
    }
}
__device__ __forceinline__ void gates_row_pad(const Params& p, int prow, int lane) {
    if (lane < 4) { ((float*)(p.ws + TAB_GLI))[(size_t)lane * P + prow] = NEGBIG; ((float*)(p.ws + TAB_GLF))[(size_t)lane * P + prow] = 0.f; }
}

__device__ __forceinline__ void phase_prologue(const Params& p, char* lds, int bid, int nb) {
    const int tid = TIDX, wid = tid >> 6, lane = tid & 63, gw = bid * NW + wid, ngw = nb * NW;
    convert_weights(p, 0, lds, gw, ngw, wid, lane);
    __syncthreads();
    float* g8 = (float*)lds;
    load_gate_w(p, 0, g8);
    bf16_t* H = (bf16_t*)(p.ws + B_H);
    f32x4 vn[4];
#pragma unroll
    for (int j = 0; j < 4; ++j) vn[j] = (f32x4){0.f, 0.f, 0.f, 0.f};
#define PRO_SRC(r_) ((r_) < 256 ? p.in[I_META] + (size_t)((r_) - VALID0) * D : p.in[I_X] + (size_t)((r_) - 256) * D)
    if (gw >= VALID0 && gw < P) {
#pragma unroll
        for (int j = 0; j < 4; ++j) vn[j] = *(const f32x4*)(PRO_SRC(gw) + 4 * lane + 256 * j); }
    for (int r = gw; r < P; r += ngw) {
        f32x4 v[4];
#pragma unroll
        for (int j = 0; j < 4; ++j) v[j] = vn[j];
        { const int rn = r + ngw; if (rn >= VALID0 && rn < P) {
#pragma unroll
            for (int j = 0; j < 4; ++j) vn[j] = *(const f32x4*)(PRO_SRC(rn) + 4 * lane + 256 * j); } }
        if (r < VALID0) { store_row_zero(H + (size_t)r * D, lane); gates_row_pad(p, r, lane); continue; }
        ln_normalize(v, p.in[I_LNG], p.in[I_LNB], lane);
        store_row_bf16(H + (size_t)r * D, v, lane);
        gates_row(p, 0, g8, v, r, lane);
    }
}

struct RowsPlain { const bf16_t* base; size_t ld; __device__ __forceinline__ const bf16_t* row(int m) const { return base + (size_t)m * ld; } };
__device__ __forceinline__ void store4_bf16(bf16_t* dst, f32x4 v) { u32x2 o; o.x = pk2(v.x, v.y); o.y = pk2(v.z, v.w); *(u32x2*)dst = o; }

struct EpiProj { unsigned char* ws;
    __device__ __forceinline__ void operator()(int m, int n, f32x4 v) const {
        const int seg = n >> 10, cc = n & 1023;
        const size_t off = seg == 0 ? B_XM : seg == 1 ? B_OP : seg == 2 ? B_QA : seg == 3 ? B_KA : seg == 4 ? B_VA : seg == 5 ? B_GA : B_GB;
        store4_bf16((bf16_t*)(ws + off) + (size_t)m * D + cc, seg == 2 ? v * QA_PRESCALE : v); } };
struct EpiStore { bf16_t* C; size_t ldc; float scale;
    __device__ __forceinline__ void operator()(int m, int n, f32x4 v) const { store4_bf16(C + (size_t)m * ldc + n, v * scale); } };
namespace pg8 {
#define PG8_LAS __attribute__((address_space(3)))
constexpr int BM = 256, BK = 64, HALF = 128, HTB = HALF * BK * 2, STAGE_BYTES = 8 * HTB, NXCD = 8, WGM = 8;
__host__ __device__ __forceinline__ int lds_byte(int r, int c) { const int st = (r >> 4) * 2 + (c >> 5), rr = r & 15, cc = c & 31, ob = rr * 64 + cc * 2; return st * 1024 + (ob ^ (((ob >> 9) & 1) << 5)); }
__host__ __device__ __forceinline__ void stage_rc(int b, int& R, int& C) { const int st = b / 1024, sb = b % 1024, swz = sb ^ (((sb >> 9) & 1) << 5); R = (st >> 1) * 16 + swz / 64; C = (st & 1) * 32 + (swz % 64) / 2; }
__host__ __device__ __forceinline__ int perm32(int rho) { const int n = rho >> 4, i = rho & 15; return 8 * (i >> 2) + 4 * n + (i & 3); }
struct Unit { int pm, pn, grp; };
__device__ __forceinline__ bool decode_unit(long L, int nG, int nM, int nN, Unit& u) {
    const int nwg = nG * nM * nN; if (L >= nwg) return false;
    int wgid = (int)L; { const int q = nwg / NXCD, r = nwg % NXCD, xcd = wgid % NXCD, off = wgid / NXCD; wgid = (xcd < r ? xcd * (q + 1) : r * (q + 1) + (xcd - r) * q) + off; }
    const int per = nM * nN; u.grp = wgid / per; const int rem = wgid % per;
    const int nig = WGM * nN, gid = rem / nig, fm = gid * WGM, gsz = (nM - fm) < WGM ? (nM - fm) : WGM;
    u.pm = __builtin_amdgcn_readfirstlane(fm + ((rem % nig) % gsz)); u.pn = __builtin_amdgcn_readfirstlane((rem % nig) / gsz); u.grp = __builtin_amdgcn_readfirstlane(u.grp); return true;
}
__device__ __forceinline__ unsigned cvt_pk_bf16(float lo, float hi) { unsigned r; asm volatile("v_cvt_pk_bf16_f32 %0, %1, %2" : "=v"(r) : "v"(lo), "v"(hi)); return r; }

template <class Epi, class Sched, bool ALIGN_EPI = true>
__device__ __forceinline__ void gemm_phase(PG8_LAS unsigned char* lds, const Sched& S, const Epi& E) {
    const int tid = TIDX, wid = __builtin_amdgcn_readfirstlane(tid >> 6), lane = tid & 63, wr = wid >> 2, wc = wid & 3, fr = lane & 15, fq = lane >> 4;
    const int K = S.K, nt = K / BK;
    unsigned voffA[2], voffB[2];
#pragma unroll
    for (int i = 0; i < 2; ++i) { int R, C; stage_rc(tid * 16 + i * 8192, R, C); const int Rb = (R & ~31) + perm32(R & 31);
        voffA[i] = (unsigned)(R * S.lda + C) * 2u; voffB[i] = (unsigned)(Rb * S.ldb + C) * 2u; }
    const size_t kstep = (size_t)(BK * 2);
    const size_t hstepA = (size_t)HALF * S.lda * 2, hstepB = (size_t)HALF * S.ldb * 2;
    const unsigned ldsw = (unsigned)wid * 1024u;
    const int aoff = lds_byte(wr * 64 + fr, fq * 8), boff = lds_byte(wc * 32 + fr, fq * 8);
#define PG8_SA(b, h) (((b) * 2 + (h)) * HTB)
#define PG8_SB(b, h) ((4 + (b) * 2 + (h)) * HTB)
#define PG8_STAGE(bufoff, gbase, voff) do { _Pragma("unroll") for (int _i = 0; _i < 2; ++_i) \
        __builtin_amdgcn_global_load_lds((const unsigned*)((const char*)(gbase) + (voff)[_i]), (PG8_LAS unsigned*)(lds + (bufoff) + ldsw + _i * 8192), 16, 0, 0); } while (0)
#define PG8_LDA(dst, b, h) do { _Pragma("unroll") for (int m = 0; m < 4; ++m) _Pragma("unroll") for (int k = 0; k < 2; ++k) dst[m][k] = *(const PG8_LAS bf16x8*)(lds + PG8_SA(b, h) + aoff + m * 2048 + k * 1024); } while (0)
#define PG8_LDB(dst, b, h) do { _Pragma("unroll") for (int n = 0; n < 2; ++n) _Pragma("unroll") for (int k = 0; k < 2; ++k) dst[n][k] = *(const PG8_LAS bf16x8*)(lds + PG8_SB(b, h) + boff + n * 2048 + k * 1024); } while (0)
#define PG8_MMA(ai, bj, At, Bt) do { __builtin_amdgcn_s_setprio(1); _Pragma("unroll") for (int m = 0; m < 4; ++m) _Pragma("unroll") for (int n = 0; n < 2; ++n) _Pragma("unroll") for (int k = 0; k < 2; ++k) \
        acc[ai][bj][m][n] = __builtin_amdgcn_mfma_f32_16x16x32_bf16(Bt[n][k], At[m][k], acc[ai][bj][m][n], 0, 0, 0); __builtin_amdgcn_s_setprio(0); } while (0)
#define PG8_WAIT_V(n) asm volatile("s_waitcnt vmcnt(" #n ")" ::: "memory")
#define PG8_WAIT_L(n) asm volatile("s_waitcnt lgkmcnt(" #n ")" ::: "memory")
#define PG8_BAR __builtin_amdgcn_s_barrier()
#define PG8_SCHED __builtin_amdgcn_sched_barrier(0)
    Unit cur, nxt; int ui = 0;
    if (!S.next(0, cur)) return;
    f32x4 acc[2][2][4][2];
#pragma unroll
    for (int a = 0; a < 2; ++a)
#pragma unroll
        for (int b = 0; b < 2; ++b)
#pragma unroll
            for (int m = 0; m < 4; ++m)
#pragma unroll
                for (int n = 0; n < 2; ++n) acc[a][b][m][n] = (f32x4){0.f, 0.f, 0.f, 0.f};
    bf16x8 At[4][2], B0[2][2], B1[2][2];
    const char* cA = S.abase(cur); const char* cB = S.bbase(cur);
    PG8_STAGE(PG8_SB(0, 0), cB, voffB); PG8_STAGE(PG8_SB(0, 1), cB + hstepB, voffB); PG8_STAGE(PG8_SA(0, 0), cA, voffA); PG8_STAGE(PG8_SA(0, 1), cA + hstepA, voffA);
    if (wr == 1) PG8_BAR;
    PG8_WAIT_V(2); PG8_BAR;
    PG8_STAGE(PG8_SB(1, 0), cB + kstep, voffB); PG8_STAGE(PG8_SA(1, 0), cA + kstep, voffA); PG8_STAGE(PG8_SB(1, 1), cB + hstepB + kstep, voffB);
    PG8_WAIT_V(6); PG8_BAR;
    for (;;) {
        const bool has_next = S.next(ui + 1, nxt);
        const char* nA = has_next ? S.abase(nxt) : cA; const char* nB = has_next ? S.bbase(nxt) : cB;
        for (int t = 0; t < nt; t += 2) {
            const bool last = (t == nt - 2);
            const char* a1 = cA + (size_t)(t + 1) * kstep;
            const char* a2 = last ? nA : cA + (size_t)(t + 2) * kstep; const char* b2 = last ? nB : cB + (size_t)(t + 2) * kstep;
            const char* a3 = a2 + kstep; const char* b3 = b2 + kstep;
            PG8_LDB(B0, 0, 0); PG8_LDB(B1, 0, 1); PG8_SCHED; PG8_LDA(At, 0, 0); PG8_STAGE(PG8_SA(1, 1), a1 + hstepA, voffA);
            PG8_WAIT_V(8); PG8_WAIT_L(0); PG8_BAR; PG8_MMA(0, 0, At, B0); PG8_MMA(0, 1, At, B1); PG8_BAR; PG8_SCHED;
            PG8_LDA(At, 0, 1); PG8_STAGE(PG8_SB(0, 0), b2, voffB); PG8_STAGE(PG8_SB(0, 1), b2 + hstepB, voffB); PG8_STAGE(PG8_SA(0, 0), a2, voffA);
            PG8_WAIT_V(8); PG8_WAIT_L(0); PG8_BAR; PG8_MMA(1, 0, At, B0); PG8_MMA(1, 1, At, B1); PG8_BAR; PG8_SCHED;
            PG8_LDB(B0, 1, 0); PG8_LDB(B1, 1, 1); PG8_SCHED; PG8_LDA(At, 1, 0); PG8_STAGE(PG8_SA(0, 1), a2 + hstepA, voffA);
            PG8_WAIT_V(8); PG8_WAIT_L(0); PG8_BAR; PG8_MMA(0, 0, At, B0); PG8_MMA(0, 1, At, B1); PG8_BAR; PG8_SCHED;
            PG8_LDA(At, 1, 1); PG8_STAGE(PG8_SB(1, 0), b3, voffB); PG8_STAGE(PG8_SB(1, 1), b3 + hstepB, voffB); PG8_STAGE(PG8_SA(1, 0), a3, voffA);
            PG8_WAIT_V(8); PG8_WAIT_L(0); PG8_BAR; PG8_MMA(1, 0, At, B0); PG8_MMA(1, 1, At, B1); PG8_BAR; PG8_SCHED;
        }
        if constexpr (ALIGN_EPI) { if (wr == 0) PG8_BAR; }
        E(acc, cur, wr, wc, fr, fq);
        if (!has_next) break;
#pragma unroll
        for (int a = 0; a < 2; ++a)
#pragma unroll
            for (int b = 0; b < 2; ++b)
#pragma unroll
                for (int m = 0; m < 4; ++m)
#pragma unroll
                    for (int n = 0; n < 2; ++n) acc[a][b][m][n] = (f32x4){0.f, 0.f, 0.f, 0.f};
        cur = nxt; cA = nA; cB = nB; ++ui;
        if constexpr (ALIGN_EPI) { if (wr == 1) PG8_BAR; }
    }
    PG8_WAIT_V(0);
    if constexpr (!ALIGN_EPI) { if (wr == 0) PG8_BAR; }
    PG8_BAR;
#undef PG8_SA
#undef PG8_SB
#undef PG8_STAGE
#undef PG8_LDA
#undef PG8_LDB
#undef PG8_MMA
#undef PG8_WAIT_V
#undef PG8_WAIT_L
#undef PG8_BAR
#undef PG8_SCHED
}
__device__ __forceinline__ u32x4 pack8(f32x4 v0, f32x4 v1) { u32x4 w; w.x = cvt_pk_bf16(v0[0], v0[1]); w.y = cvt_pk_bf16(v0[2], v0[3]); w.z = cvt_pk_bf16(v1[0], v1[1]); w.w = cvt_pk_bf16(v1[2], v1[3]); return w; }
__device__ __forceinline__ void unpack8(u32x4 w, f32x4& v0, f32x4& v1) {
    v0[0] = __uint_as_float(w.x << 16); v0[1] = __uint_as_float(w.x & 0xffff0000u); v0[2] = __uint_as_float(w.y << 16); v0[3] = __uint_as_float(w.y & 0xffff0000u);
    v1[0] = __uint_as_float(w.z << 16); v1[1] = __uint_as_float(w.z & 0xffff0000u); v1[2] = __uint_as_float(w.w << 16); v1[3] = __uint_as_float(w.w & 0xffff0000u); }
template <class F> __device__ __forceinline__ void for_each_piece(const f32x4 (&acc)[2][2][4][2], const Unit& u, int wr, int wc, int fr, int fq, const F& f) {
    asm volatile("" : "+v"(fr), "+v"(fq));
    const int row0 = u.pm * BM + wr * 64 + fr, col0 = wc * 32 + 8 * fq;
#pragma unroll
    for (int ai = 0; ai < 2; ++ai)
#pragma unroll
        for (int m = 0; m < 4; ++m)
#pragma unroll
            for (int bj = 0; bj < 2; ++bj) f(row0 + ai * HALF + m * 16, col0 + bj * HALF, acc[ai][bj][m][0], acc[ai][bj][m][1]);
}
template <class L, class F> __device__ __forceinline__ void for_each_piece_pf(const f32x4 (&acc)[2][2][4][2], const Unit& u, int wr, int wc, int fr, int fq, const L& ld, const F& f) {
    asm volatile("" : "+v"(fr), "+v"(fq));
    const int row0 = u.pm * BM + wr * 64 + fr, col0 = wc * 32 + 8 * fq;
#pragma unroll
    for (int ai = 0; ai < 2; ++ai) {
        decltype(ld(0, 0)) pre[4][2];
#pragma unroll
        for (int m = 0; m < 4; ++m)
#pragma unroll
            for (int bj = 0; bj < 2; ++bj) pre[m][bj] = ld(row0 + ai * HALF + m * 16, col0 + bj * HALF);
#pragma unroll
        for (int m = 0; m < 4; ++m)
#pragma unroll
            for (int bj = 0; bj < 2; ++bj) f(row0 + ai * HALF + m * 16, col0 + bj * HALF, acc[ai][bj][m][0], acc[ai][bj][m][1], pre[m][bj]);
    }
}
}

template <int MI, int NJ, class AR, class BR, class Epi>
__device__ __forceinline__ void sgemm_wave(const AR& ar, const BR& br, int K, int m0, int n0, const Epi& epi) {
    const int lane = TIDX & 63, c = lane & 15, g = lane >> 4;
    const bf16_t* ap[MI]; const bf16_t* bp[NJ];
#pragma unroll
    for (int i = 0; i < MI; ++i) ap[i] = ar.row(m0 + 16 * i + c) + 8 * g;
#pragma unroll
    for (int j = 0; j < NJ; ++j) bp[j] = br.row(n0 + 16 * j + c) + 8 * g;
    f32x4 acc[MI][NJ];
#pragma unroll
    for (int i = 0; i < MI; ++i)
#pragma unroll
        for (int j = 0; j < NJ; ++j) acc[i][j] = (f32x4){0.f, 0.f, 0.f, 0.f};
#pragma unroll 4
    for (int k0 = 0; k0 < K; k0 += 32) {
        bf16x8 a[MI], b[NJ];
#pragma unroll
        for (int i = 0; i < MI; ++i) a[i] = ld8(ap[i] + k0);
#pragma unroll
        for (int j = 0; j < NJ; ++j) b[j] = ld8(bp[j] + k0);
#pragma unroll
        for (int i = 0; i < MI; ++i)
#pragma unroll
            for (int j = 0; j < NJ; ++j) acc[i][j] = mfma16(b[j], a[i], acc[i][j]);
    }
#pragma unroll
    for (int i = 0; i < MI; ++i)
#pragma unroll
        for (int j = 0; j < NJ; ++j) epi(m0 + 16 * i + c, n0 + 16 * j + 4 * g, acc[i][j]);
}
template <int MI, int NJ, class AR, class BR, class Epi>
__device__ __forceinline__ void meta_gemm(const AR& ar, const BR& br, int K, int m0, int n0, const Epi& epi, char* lds) {
    const int tid = TIDX, wid = __builtin_amdgcn_readfirstlane(tid >> 6), lane = tid & 63, c = lane & 15, g = lane >> 4;
    const int kw = K >> 3, kb = wid * kw;
    f32x4 acc[MI][NJ];
#pragma unroll
    for (int i = 0; i < MI; ++i)
#pragma unroll
        for (int j = 0; j < NJ; ++j) acc[i][j] = (f32x4){0.f, 0.f, 0.f, 0.f};
    for (int k0 = kb; k0 < kb + kw; k0 += 32) {
        bf16x8 a[MI], b[NJ];
#pragma unroll
        for (int i = 0; i < MI; ++i) a[i] = ld8(ar.row(m0 + 16 * i + c) + 8 * g + k0);
#pragma unroll
        for (int j = 0; j < NJ; ++j) b[j] = ld8(br.row(n0 + 16 * j + c) + 8 * g + k0);
#pragma unroll
        for (int i = 0; i < MI; ++i)
#pragma unroll
            for (int j = 0; j < NJ; ++j) acc[i][j] = mfma16(b[j], a[i], acc[i][j]);
    }
    f32x4* part = (f32x4*)lds;
#pragma unroll
    for (int i = 0; i < MI; ++i)
#pragma unroll
        for (int j = 0; j < NJ; ++j) part[((wid * MI + i) * NJ + j) * 64 + lane] = acc[i][j];
    __syncthreads();
    if (wid == 0) {
#pragma unroll
        for (int i = 0; i < MI; ++i)
#pragma unroll
            for (int j = 0; j < NJ; ++j) { f32x4 s = acc[i][j];
#pragma unroll
                for (int w = 1; w < 8; ++w) s += part[((w * MI + i) * NJ + j) * 64 + lane];
                epi(m0 + 16 * i + c, n0 + 16 * j + 4 * g, s); }
    }
    __syncthreads();
}
__device__ __forceinline__ void zero_block(bf16_t* base, size_t ld, int nrows, int ncols, int gtid, int gthreads) {
    const int cpr = ncols / 8;
    for (int i = gtid; i < nrows * cpr; i += gthreads) { const int r = i / cpr, cc = (i % cpr) * 8; *(u32x4*)(base + (size_t)r * ld + cc) = (u32x4){0u, 0u, 0u, 0u}; }
}

struct SchedProj { const char* A; const char* B; int G, c; int K, lda, ldb;
    __device__ __forceinline__ bool next(int i, pg8::Unit& u) const { if (!pg8::decode_unit((long)i * G + c, 1, 64, 28, u)) return false; u.pm += 1; return true; }
    __device__ __forceinline__ const char* abase(const pg8::Unit& u) const { return A + (size_t)u.pm * 256 * D * 2; }
    __device__ __forceinline__ const char* bbase(const pg8::Unit& u) const { return B + (size_t)u.pn * 256 * D * 2; } };
struct EpiProjF { unsigned char* ws;
    __device__ __forceinline__ void operator()(const f32x4 (&acc)[2][2][4][2], const pg8::Unit& u, int wr, int wc, int fr, int fq) const {
        const int colt = u.pn * 256, seg = colt >> 10;
        const size_t off = seg == 0 ? B_XM : seg == 1 ? B_OP : seg == 2 ? B_QA : seg == 3 ? B_KA : seg == 4 ? B_VA : seg == 5 ? B_GA : B_GB;
        bf16_t* base = (bf16_t*)(ws + off) + (colt & 1023); const float qs = seg == 2 ? QA_PRESCALE : 1.f;
        pg8::for_each_piece(acc, u, wr, wc, fr, fq, [&](int row, int col, f32x4 v0, f32x4 v1) { *(u32x4*)(base + (size_t)row * D + col) = pg8::pack8(v0 * qs, v1 * qs); }); } };
struct SchedVAT { const char* A; const char* B; int G, c; int K, lda, ldb;
    __device__ __forceinline__ bool next(int i, pg8::Unit& u) const { if (!pg8::decode_unit((long)i * G + c, 1, 4, 64, u)) return false; u.pn += 1; return true; }
    __device__ __forceinline__ const char* abase(const pg8::Unit& u) const { return A + (size_t)u.pm * 256 * D * 2; }
    __device__ __forceinline__ const char* bbase(const pg8::Unit& u) const { return B + (size_t)u.pn * 256 * D * 2; } };
struct EpiStoreF { bf16_t* C; size_t ldc; float scale;
    __device__ __forceinline__ void operator()(const f32x4 (&acc)[2][2][4][2], const pg8::Unit& u, int wr, int wc, int fr, int fq) const {
        bf16_t* base = C + (size_t)u.pn * 256;
        pg8::for_each_piece(acc, u, wr, wc, fr, fq, [&](int row, int col, f32x4 v0, f32x4 v1) { *(u32x4*)(base + (size_t)row * ldc + col) = pg8::pack8(v0 * scale, v1 * scale); }); } };
__device__ __forceinline__ void phase_proj_f(const Params& p, char* lds, int bid, int nb) {
    const int tid = TIDX, wid = tid >> 6, gw = bid * NW + wid, ngw = nb * NW;
    const bf16_t* H = (const bf16_t*)(p.ws + B_H); const bf16_t* W = (const bf16_t*)(p.ws + W_IN_T);
    zero_block((bf16_t*)(p.ws + B_KA), D, VALID0, D, bid * NT + tid, nb * NT);
    zero_block((bf16_t*)(p.ws + B_VA), D, VALID0, D, bid * NT + tid, nb * NT);
    zero_block((bf16_t*)(p.ws + B_XM), D, VALID0, D, bid * NT + tid, nb * NT);
    for (int t = bid; t < 112; t += nb) meta_gemm<1, 4>(RowsPlain{H, D}, RowsPlain{W, D}, D, VALID0, t * 64, EpiProj{p.ws}, lds);
    { SchedProj S{(const char*)H, (const char*)W, nb, bid, D, D, D};
      pg8::gemm_phase(( PG8_LAS unsigned char*)lds, S, EpiProjF{p.ws}); }
}

namespace fc {
typedef short s16x4 __attribute__((ext_vector_type(4)));
typedef __attribute__((address_space(3))) unsigned LU;
constexpr int KVBLK = 64, SHM_V = 64 * 128 * 2, SHM_K = 64 * 64 * 2, PITCH = 1024, XCH = 17 * 1024;
constexpr float THR2 = 8.f * 1.4426950408889634f;
constexpr float TSUM = 16384.f;
#define FC_SBAR() __builtin_amdgcn_sched_barrier(0)
__device__ __forceinline__ unsigned cvtpk(float lo, float hi) { unsigned r; asm volatile("v_cvt_pk_bf16_f32 %0, %1, %2" : "=v"(r) : "v"(lo), "v"(hi)); return r; }
__device__ __forceinline__ float max_g(float v) {
    v = fmaxf(v, sx<16>(v));
    auto rr = __builtin_amdgcn_permlane32_swap(__float_as_uint(v), __float_as_uint(v), false, false);
    return fmaxf(__uint_as_float(rr[0]), __uint_as_float(rr[1]));
}
__device__ __forceinline__ float sum_g(float v) { v += sx<16>(v); return sum32(v); }
__device__ __forceinline__ int lane_id() { return (int)__builtin_amdgcn_mbcnt_hi(~0u, __builtin_amdgcn_mbcnt_lo(~0u, 0u)); }
__device__ __forceinline__ void attn_pass(const bf16_t* Qp, const bf16_t* Kp, const bf16_t* Vp, int P0, int NT, char* lds, f32x4 (&o)[4][8], float (&m2)[4], float (&lsum)[4]) {
    const int tid = TIDX, wid = __builtin_amdgcn_readfirstlane(tid >> 6), lane = tid & 63, c = lane & 15, g = lane >> 4;
    const int h = wid >> 2, qlo = P0 + (wid & 3) * 64;
    char* V_lds = lds; char* K_lds = lds + 2 * SHM_V;
#pragma unroll
    for (int qg = 0; qg < 4; ++qg) { m2[qg] = 0.f; lsum[qg] = 0.f;
#pragma unroll
        for (int dt = 0; dt < 8; ++dt) o[qg][dt] = (f32x4){0.f, 0.f, 0.f, 0.f}; }
    unsigned ksrc, vsrc0;
    { const int r = 8 * wid + (lane >> 3), cp = lane & 7, sw = (((r >> 3) & 3) << 1) | ((r >> 1) & 1); ksrc = (unsigned)(r * PITCH + ((cp ^ sw) << 3)) * 2u; }
    { const int pos = wid * 1024 + lane * 16, row = 8 * (pos >> 11) + ((pos >> 6) & 7), ch = 4 * ((pos >> 9) & 3) + (((pos >> 4) & 3) ^ ((row >> 2) & 3)); vsrc0 = (unsigned)(row * PITCH + ch * 8) * 2u; }
    const unsigned kdst = (unsigned)(2 * SHM_V) + (unsigned)wid * 1024u, vdst0 = (unsigned)wid * 1024u, vdst1 = (unsigned)(8 + wid) * 1024u;
    const int ksw = ((c >> 2) << 1) | ((c & 3) >> 1);
    const int krow = 4096 * h + 1024 * (c >> 2) + 128 * (c & 3);
    const int ka0 = krow + ((g ^ ksw) << 4), ka1 = krow + (((4 + g) ^ ksw) << 4);
    const int q4 = c >> 2, p4 = c & 3, ph = p4 >> 1;
    const int vbt0 = 8192 * h + 2048 * g + 64 * q4 + 16 * ph + 8 * (p4 & 1), vbt1 = 8192 * h + 2048 * g + 256 + 64 * q4 + 16 * (ph ^ 1) + 8 * (p4 & 1);
    const int vlds = (int)(uintptr_t)V_lds;
    const int vb_t0e = vlds + vbt0 + 32 * (g & 1), vb_t0o = vlds + vbt0 + 32 - 32 * (g & 1), vb_t1e = vlds + vbt1 + 32 * (g & 1), vb_t1o = vlds + vbt1 + 32 - 32 * (g & 1);
    bf16x8 qf[4][2];
#pragma unroll
    for (int qg = 0; qg < 4; ++qg)
#pragma unroll
        for (int ks = 0; ks < 2; ++ks) qf[qg][ks] = ld8(Qp + (size_t)(qlo + 16 * qg + c) * PITCH + 32 * ks + 8 * g);
#define FC_DMA(t, B) do { const size_t go_ = (size_t)(3 + (t)) * KVBLK * PITCH; const char* kt_ = (const char*)(Kp + go_); const char* vt_ = (const char*)(Vp + go_);  \
        __builtin_amdgcn_global_load_lds((const unsigned*)(kt_ + ksrc), (LU*)(lds + kdst + (B) * SHM_K), 16, 0, 0);                                             \
        __builtin_amdgcn_global_load_lds((const unsigned*)(vt_ + vsrc0), (LU*)(lds + vdst0 + (B) * SHM_V), 16, 0, 0);                                           \
        __builtin_amdgcn_global_load_lds((const unsigned*)(vt_ + 32 * PITCH * 2 + vsrc0), (LU*)(lds + vdst1 + (B) * SHM_V), 16, 0, 0); } while (0)
#define FC_WAITBAR() do { asm volatile("s_waitcnt vmcnt(0) lgkmcnt(0)" ::: "memory"); __builtin_amdgcn_s_barrier(); asm volatile("" ::: "memory"); } while (0)
#define FC_TRRD(dst, base, off) asm volatile("ds_read_b64_tr_b16 %0, %1 offset:%2" : "=&v"(dst) : "v"(base), "i"(off) : "memory")
#define FC_PV2(BUF, dt0) do { s16x4 a0, a1, b0, b1; constexpr int o_ = (BUF) * SHM_V + 512 * ((dt0) >> 1);                                                       \
        FC_TRRD(a0, vb_t0e, o_); FC_TRRD(a1, vb_t1e, o_); FC_TRRD(b0, vb_t0o, o_); FC_TRRD(b1, vb_t1o, o_);                                                     \
        asm volatile("s_waitcnt lgkmcnt(0)" ::: "memory"); FC_SBAR();                                                                                            \
        { const bf16x8 f0 = (bf16x8){a0[0], a0[1], a0[2], a0[3], a1[0], a1[1], a1[2], a1[3]}, f1 = (bf16x8){b0[0], b0[1], b0[2], b0[3], b1[0], b1[1], b1[2], b1[3]};      \
          _Pragma("unroll") for (int qg = 0; qg < 4; ++qg) o[qg][dt0] = mfma16(f0, pf[qg], o[qg][dt0]);                                                         \
          _Pragma("unroll") for (int qg = 0; qg < 4; ++qg) o[qg][(dt0) + 1] = mfma16(f1, pf[qg], o[qg][(dt0) + 1]); } } while (0)
#define FC_QK(BUF) do { _Pragma("unroll") for (int a = 0; a < 2; ++a) { const char* kp = K_lds + (BUF) * SHM_K + 512 * a;                                          \
              const bf16x8 k0 = *(const bf16x8*)(kp + ka0), k1 = *(const bf16x8*)(kp + ka1);                                                                    \
              _Pragma("unroll") for (int qp = 0; qp < 4; qp += 2) {                                                                                              \
                  s[qp][a] = mfma16(k0, qf[qp][0], nv); s[qp + 1][a] = mfma16(k0, qf[qp + 1][0], nv);                                                            \
                  s[qp][a] = mfma16(k1, qf[qp][1], s[qp][a]); s[qp + 1][a] = mfma16(k1, qf[qp + 1][1], s[qp + 1][a]); } } } while (0)
#define FC_MASK(t) do { if ((t) == 0 || kh + 31 > qlo) { const float NEG = -__builtin_inff(); const int ln_ = lane_id(), c_ = ln_ & 15, g_ = ln_ >> 4;                \
            _Pragma("unroll") for (int qg = 0; qg < 4; ++qg) { const int pos = qlo + 16 * qg + c_;                                                              \
                _Pragma("unroll") for (int a = 0; a < 2; ++a) _Pragma("unroll") for (int r = 0; r < 4; ++r) { const int key = kh + 8 * g_ + 4 * a + r;           \
                    if (key > pos || key < VALID0) s[qg][a][r] = NEG; } } } } while (0)
#define FC_EXPSUM() do { _Pragma("unroll") for (int qg = 0; qg < 4; ++qg) { float ps_ = 0.f;                                                                         \
            _Pragma("unroll") for (int a = 0; a < 2; ++a) _Pragma("unroll") for (int r = 0; r < 4; ++r) { const float e = __builtin_amdgcn_exp2f(s[qg][a][r]); s[qg][a][r] = e; ps_ += e; } \
            ps[qg] = ps_; } } while (0)
#define FC_TILE(t, BUF) do {                                                                                                                                     \
        if ((t) + 1 < NT) FC_DMA((t) + 1, (BUF) ^ 1);                                                                                                            \
        const int kh = (3 + (t)) * KVBLK + 32 * h;                                                                                                               \
        if (kh <= qlo + 63) {                                                                                                                                    \
        FC_SBAR();                                                                                                                                               \
        f32x4 s[4][2]; float ps[4];                                                                                                                              \
        const bool adopt = (t) == 0 || ((t) == 1 && h == 0);                              \
        bool exact = adopt;                                                                                                                                      \
        for (;;) {                                                                                \
            FC_QK(BUF); FC_MASK(t);                                                                                                                              \
            if (exact) {                                                                                                                                         \
                float v = fmaxf(s[0][0][0], s[0][1][0]);                                                                                                         \
                _Pragma("unroll") for (int qg = 0; qg < 4; ++qg) _Pragma("unroll") for (int r = 0; r < 4; ++r) v = fmaxf(v, fmaxf(s[qg][0][r], s[qg][1][r]));           \
                const float pm = max_g(v);                                                                                                                       \
                const float delta = adopt ? (pm > -1e30f ? pm : 0.f) : fmaxf(pm, 0.f);                                                                           \
                m2s += delta; nv = (f32x4){-m2s, -m2s, -m2s, -m2s};                                                                                              \
                _Pragma("unroll") for (int qg = 0; qg < 4; ++qg) { s[qg][0] = s[qg][0] - delta; s[qg][1] = s[qg][1] - delta; }                                   \
                if (!adopt) { const float al_ = __builtin_amdgcn_exp2f(-delta);                                                                                  \
                    _Pragma("unroll") for (int qg = 0; qg < 4; ++qg) { lsum[qg] *= al_;                                                                          \
                        _Pragma("unroll") for (int dt = 0; dt < 8; ++dt) o[qg][dt] = o[qg][dt] * al_; } } }                                                      \
            FC_EXPSUM();                                                                                                                                         \
            if (exact || __all(fmaxf(fmaxf(ps[0], ps[1]), fmaxf(ps[2], ps[3])) <= TSUM)) break;                                                                  \
            exact = true; }                                                                                                                                      \
        bf16x8 pf[4];                                                                                                                                            \
        _Pragma("unroll") for (int qg = 0; qg < 4; ++qg) { lsum[qg] += ps[qg];                                                                                   \
            u32x4 w; w.x = cvtpk(s[qg][0][0], s[qg][0][1]); w.y = cvtpk(s[qg][0][2], s[qg][0][3]); w.z = cvtpk(s[qg][1][0], s[qg][1][1]); w.w = cvtpk(s[qg][1][2], s[qg][1][3]); \
            pf[qg] = *(bf16x8*)&w; }                                                                                                                             \
        FC_SBAR();                                                                                                                                               \
        FC_PV2(BUF, 0); FC_PV2(BUF, 2); FC_PV2(BUF, 4); FC_PV2(BUF, 6);                                                                                          \
        }                                                                                                                                                        \
        FC_WAITBAR(); } while (0)
    float m2s = 0.f; f32x4 nv = (f32x4){0.f, 0.f, 0.f, 0.f};
    FC_DMA(0, 0); FC_WAITBAR();
    for (int t = 0; t < NT; t += 2) { FC_TILE(t, 0); if (t + 1 < NT) FC_TILE(t + 1, 1); }
#pragma unroll
    for (int qg = 0; qg < 4; ++qg) m2[qg] = m2s;
#undef FC_TILE
#undef FC_QK
#undef FC_MASK
#undef FC_EXPSUM
#undef FC_PV2
#undef FC_TRRD
#undef FC_WAITBAR
#undef FC_DMA
}
__device__ __forceinline__ void merge_pair(f32x4 (&o)[4][8], float (&m2)[4], float (&ls)[4], float (&lr)[2], char* lds) {
    const int tid = TIDX, wid = __builtin_amdgcn_readfirstlane(tid >> 6), lane = tid & 63, h = wid >> 2;
    char* mine = lds + wid * XCH + lane * 16; const char* theirs = lds + (wid ^ 4) * XCH + lane * 16;
#define FC_SEND(QX) do { _Pragma("unroll") for (int i = 0; i < 2; ++i) _Pragma("unroll") for (int dt = 0; dt < 8; ++dt) *(f32x4*)(mine + (i * 8 + dt) * 1024) = o[(QX) + i][dt];  \
        *(f32x4*)(mine + 16 * 1024) = (f32x4){m2[(QX)], ls[(QX)], m2[(QX) + 1], ls[(QX) + 1]}; } while (0)
#define FC_RECV(QX) do { const f32x4 ml = *(const f32x4*)(theirs + 16 * 1024);                                                                                    \
        _Pragma("unroll") for (int i = 0; i < 2; ++i) { const float mr = i ? ml.z : ml.x, lrv = i ? ml.w : ml.y, m = fmaxf(m2[(QX) + i], mr);                       \
            const float fo = __builtin_amdgcn_exp2f(m2[(QX) + i] - m), fr = __builtin_amdgcn_exp2f(mr - m);                                                       \
            _Pragma("unroll") for (int dt = 0; dt < 8; ++dt) { const f32x4 v = *(const f32x4*)(theirs + (i * 8 + dt) * 1024); o[i][dt] = o[(QX) + i][dt] * fo + v * fr; } \
            lr[i] = sum_g(ls[(QX) + i] * fo + lrv * fr); } } while (0)
    if (h == 0) FC_SEND(2); else FC_SEND(0);
    __syncthreads();
    if (h == 0) FC_RECV(0); else FC_RECV(2);
    __syncthreads();
#undef FC_SEND
#undef FC_RECV
}
__device__ __forceinline__ void attn_unit(const Params& p, int l, int hd, int j, char* lds) {
    const int tid = TIDX, wid = __builtin_amdgcn_readfirstlane(tid >> 6), lane = tid & 63, c = lane & 15, g = lane >> 4;
    const bf16_t* QA = (const bf16_t*)(p.ws + B_QA) + hd * 128; const bf16_t* KA = (const bf16_t*)(p.ws + B_KA) + hd * 128; const bf16_t* VA = (const bf16_t*)(p.ws + B_VA) + hd * 128;
    bf16_t* YA = (bf16_t*)(p.ws + B_YA) + hd * 128;
    const int P0 = j * 256, NT = 4 * j + 1, row0 = P0 + (wid & 3) * 64 + (wid >> 2) * 32 + c;
    f32x4 o[4][8]; float m2[4], ls[4], lr[2];
    attn_pass(QA, KA, VA, P0, NT, lds, o, m2, ls);
    merge_pair(o, m2, ls, lr, lds);
#pragma unroll
    for (int i = 0; i < 2; ++i) { const float rl = __builtin_amdgcn_rcpf(lr[i]); bf16_t* yr = YA + (size_t)(row0 + 16 * i) * PITCH + 4 * g;
#pragma unroll
        for (int dt = 0; dt < 8; ++dt) { const f32x4 v = o[i][dt] * rl; u32x2 w; w.x = cvtpk(v.x, v.y); w.y = cvtpk(v.z, v.w); *(u32x2*)(yr + 16 * dt) = w; } }
    attn_pass(QA + 64, KA + 64, VA, P0, NT, lds, o, m2, ls);
    merge_pair(o, m2, ls, lr, lds);
    const float lam_init = 0.8f - 0.6f * expf(-0.3f * (float)l);
    float lam;
    { const float a = wave_sum(p.in[I_LQ1][l * 64 + lane] * p.in[I_LK1][l * 64 + lane]), b = wave_sum(p.in[I_LQ2][l * 64 + lane] * p.in[I_LK2][l * 64 + lane]);
      lam = expf(a) - expf(b) + lam_init; }
    const float scale_out = 1.f - lam_init;
#pragma unroll
    for (int i = 0; i < 2; ++i) { const float rl = lam * __builtin_amdgcn_rcpf(lr[i]); bf16_t* yr = YA + (size_t)(row0 + 16 * i) * PITCH + 4 * g;
        float ss = 0.f;
#pragma unroll
        for (int dt = 0; dt < 8; ++dt) { const unsigned long long w = __hip_atomic_load((const unsigned long long*)(yr + 16 * dt), __ATOMIC_RELAXED, __HIP_MEMORY_SCOPE_AGENT);
            f32x4 v; v.x = bf2f((unsigned)w & 0xffffu); v.y = bf2f(((unsigned)w) >> 16); v.z = bf2f((unsigned)(w >> 32) & 0xffffu); v.w = bf2f((unsigned)(w >> 48));
            v = v - o[i][dt] * rl; o[i][dt] = v; ss += (v.x * v.x + v.y * v.y) + (v.z * v.z + v.w * v.w); }
        ss = sum_g(ss);
        const float rs = rsqrtf(ss * (1.f / 128.f) + LN_EPS) * scale_out;
#pragma unroll
        for (int dt = 0; dt < 8; ++dt) { const f32x4 gg = *(const f32x4*)(p.in[I_ANG] + l * 128 + 16 * dt + 4 * g); const f32x4 v = o[i][dt] * rs * gg;
            u32x2 w; w.x = cvtpk(v.x, v.y); w.y = cvtpk(v.z, v.w); *(u32x2*)(yr + 16 * dt) = w; } }
}
}
__device__ __forceinline__ void phase_attn_f(const Params& p, int l, char* lds, int bid, int nb) {
    for (int u = bid; u < 256 + 8; u += nb) {
        if (u < 256) { const int hd = u & 7, jj = u >> 3;
            fc::attn_unit(p, l, hd, 64 - jj, lds);
            fc::attn_unit(p, l, hd, 1 + jj, lds);
        } else fc::attn_unit(p, l, u - 256, 0, lds);
    }
}

__device__ __forceinline__ void phase_conv(const Params& p, int l, char* lds, int bid, int nb) {
    const int tid = TIDX, wid = tid >> 6, lane = tid & 63, gw = bid * NW + wid, ngw = nb * NW;
    const bf16_t* XM = (const bf16_t*)(p.ws + B_XM); bf16_t* XC = (bf16_t*)(p.ws + B_XC);
    const float* cw = p.in[I_CONVW] + (size_t)l * 4 * D; const float* cb = p.in[I_CONVB] + (size_t)l * D;
    constexpr int RBLK = 16, NITEM = (P / RBLK) * (D / 8);
    for (int it = bid * NT + tid; it < NITEM; it += nb * NT) {
        const int rb = it >> 7, c0 = (it & 127) * 8, r0 = rb * RBLK;
        if (r0 + RBLK <= VALID0) {
#pragma unroll
            for (int i = 0; i < RBLK; ++i) *(u32x4*)(XC + (size_t)(r0 + i) * D + c0) = (u32x4){0u, 0u, 0u, 0u};
            continue; }
        u32x4 x[RBLK + 3];
#pragma unroll
        for (int i = 0; i < RBLK + 3; ++i) { const int rr = r0 - 3 + i; x[i] = rr >= VALID0 ? *(const u32x4*)(XM + (size_t)rr * D + c0) : (u32x4){0u, 0u, 0u, 0u}; }
        float w[4][8], bb[8];
#pragma unroll
        for (int j = 0; j < 4; ++j) { const f32x4 a = *(const f32x4*)(cw + j * D + c0), b = *(const f32x4*)(cw + j * D + c0 + 4);
            w[j][0] = a.x; w[j][1] = a.y; w[j][2] = a.z; w[j][3] = a.w; w[j][4] = b.x; w[j][5] = b.y; w[j][6] = b.z; w[j][7] = b.w; }
        { const f32x4 a = *(const f32x4*)(cb + c0), b = *(const f32x4*)(cb + c0 + 4); bb[0] = a.x; bb[1] = a.y; bb[2] = a.z; bb[3] = a.w; bb[4] = b.x; bb[5] = b.y; bb[6] = b.z; bb[7] = b.w; }
#pragma unroll
        for (int i = 0; i < RBLK; ++i) {
            float acc[8];
#pragma unroll
            for (int e = 0; e < 8; ++e) acc[e] = bb[e];
#pragma unroll
            for (int j = 0; j < 4; ++j) { const u32x4 v = x[i + j];
                acc[0] += w[j][0] * bf2f(v.x & 0xffffu); acc[1] += w[j][1] * bf2f(v.x >> 16); acc[2] += w[j][2] * bf2f(v.y & 0xffffu); acc[3] += w[j][3] * bf2f(v.y >> 16);
                acc[4] += w[j][4] * bf2f(v.z & 0xffffu); acc[5] += w[j][5] * bf2f(v.z >> 16); acc[6] += w[j][6] * bf2f(v.w & 0xffffu); acc[7] += w[j][7] * bf2f(v.w >> 16); }
            u32x4 o; o.x = pk2(siluf_(acc[0]), siluf_(acc[1])); o.y = pk2(siluf_(acc[2]), siluf_(acc[3])); o.z = pk2(siluf_(acc[4]), siluf_(acc[5])); o.w = pk2(siluf_(acc[6]), siluf_(acc[7]));
            if (r0 + i < VALID0) o = (u32x4){0u, 0u, 0u, 0u};
            *(u32x4*)(XC + (size_t)(r0 + i) * D + c0) = o;
        }
    }
    const float* gli = (const float*)(p.ws + TAB_GLI); const float* glf = (const float*)(p.ws + TAB_GLF);
    float* tb = (float*)(p.ws + TAB_B); float* te = (float*)(p.ws + TAB_E); float* tpm = (float*)(p.ws + TAB_PM); float* tw = (float*)(p.ws + TAB_W);
    float* scg = (float*)(p.ws + TAB_SCG); float* scm = (float*)(p.ws + TAB_SCM);
    for (int t = gw; t < NSC * 4; t += ngw) {
        const int sc = t >> 2, h = t & 3; const size_t base = (size_t)h * P + sc * 256 + 4 * lane;
        const f32x4 lf = *(const f32x4*)(glf + base), li = *(const f32x4*)(gli + base);
        float b[4]; b[0] = lf.x; b[1] = b[0] + lf.y; b[2] = b[1] + lf.z; b[3] = b[2] + lf.w;
        float incl = b[3];
#pragma unroll
        for (int o = 1; o < 64; o <<= 1) { const float n = __shfl_up(incl, o); if (lane >= o) incl += n; }
        const float excl = incl - b[3];
        float e[4], pm[4];
#pragma unroll
        for (int i = 0; i < 4; ++i) { b[i] += excl; e[i] = li[i] - b[i]; }
        pm[0] = e[0]; pm[1] = fmaxf(pm[0], e[1]); pm[2] = fmaxf(pm[1], e[2]); pm[3] = fmaxf(pm[2], e[3]);
        float mi = pm[3];
#pragma unroll
        for (int o = 1; o < 64; o <<= 1) { const float n = __shfl_up(mi, o); if (lane >= o) mi = fmaxf(mi, n); }
        float mex = __shfl_up(mi, 1); if (lane == 0) mex = -INFINITY;
#pragma unroll
        for (int i = 0; i < 4; ++i) pm[i] = fmaxf(pm[i], mex);
        const float gtot = __shfl(incl, 63), emax = __shfl(mi, 63), mloc = gtot + emax;
        f32x4 ww;
#pragma unroll
        for (int i = 0; i < 4; ++i) ww[i] = __expf(e[i] + gtot - mloc);
        *(f32x4*)(tb + base) = (f32x4){b[0], b[1], b[2], b[3]};
        *(f32x4*)(te + base) = (f32x4){e[0], e[1], e[2], e[3]};
        *(f32x4*)(tpm + base) = (f32x4){pm[0], pm[1], pm[2], pm[3]};
        *(f32x4*)(tw + base) = ww;
        if (lane == 0) { scg[sc * 4 + h] = gtot; scm[sc * 4 + h] = mloc; }
    }
}

__device__ __forceinline__ void phase_m1(const Params& p, char* lds, int bid, int nb, int nsc) {
    const int tid = TIDX, wid = __builtin_amdgcn_readfirstlane(tid >> 6), lane = tid & 63, c = lane & 15, g = lane >> 4, gw = bid * NW + wid, ngw = nb * NW;
    const bf16_t* KMT = (const bf16_t*)(p.ws + B_KMT); const bf16_t* VMT = (const bf16_t*)(p.ws + B_VMT);
    const float* tw = (const float*)(p.ws + TAB_W); bf16_t* CT = (bf16_t*)(p.ws + B_CT); float* NTv = (float*)(p.ws + TAB_NT);
    for (int u = bid; u < nsc * 4 * 2; u += nb) {
        const int dvb = (u & 1) * 8 + wid, h = (u >> 1) & 3, sc = u >> 3, s0 = sc * 256;
        f32x4 acc[16];
#pragma unroll
        for (int i = 0; i < 16; ++i) acc[i] = (f32x4){0.f, 0.f, 0.f, 0.f};
        float un[16];
#pragma unroll
        for (int i = 0; i < 16; ++i) un[i] = 0.f;
        for (int ks = (sc == 0 ? 7 : 0); ks < 8; ++ks) {
            const int sb = s0 + 32 * ks + 8 * g;
            const f32x4 w0 = *(const f32x4*)(tw + (size_t)h * P + sb), w1 = *(const f32x4*)(tw + (size_t)h * P + sb + 4);
            const u32x4 vv = *(const u32x4*)(VMT + (size_t)(h * 256 + 16 * dvb + c) * P + sb);
            u32x4 vw; vw.x = pk2(bf2f(vv.x & 0xffffu) * w0.x, bf2f(vv.x >> 16) * w0.y); vw.y = pk2(bf2f(vv.y & 0xffffu) * w0.z, bf2f(vv.y >> 16) * w0.w);
            vw.z = pk2(bf2f(vv.z & 0xffffu) * w1.x, bf2f(vv.z >> 16) * w1.y); vw.w = pk2(bf2f(vv.w & 0xffffu) * w1.z, bf2f(vv.w >> 16) * w1.w);
            const bf16x8 vf = *(bf16x8*)&vw;
#pragma unroll
            for (int dk = 0; dk < 16; ++dk) {
                const u32x4 kk = *(const u32x4*)(KMT + (size_t)(h * 256 + 16 * dk + c) * P + sb);
                acc[dk] = mfma16(*(const bf16x8*)&kk, vf, acc[dk]);
                if (dvb == 0) un[dk] += bf2f(kk.x & 0xffffu) * w0.x + bf2f(kk.x >> 16) * w0.y + bf2f(kk.y & 0xffffu) * w0.z + bf2f(kk.y >> 16) * w0.w
                                      + bf2f(kk.z & 0xffffu) * w1.x + bf2f(kk.z >> 16) * w1.y + bf2f(kk.w & 0xffffu) * w1.z + bf2f(kk.w >> 16) * w1.w;
            }
        }
        bf16_t* dst = CT + ((size_t)(sc * 4 + h) * 256 + 16 * dvb + c) * 256;
#pragma unroll
        for (int dk = 0; dk < 16; ++dk) store4_bf16(dst + 16 * dk + 4 * g, acc[dk]);
        if (dvb == 0) {
#pragma unroll
            for (int dk = 0; dk < 16; ++dk) { float v = un[dk]; v += sx<16>(v); v = sum32(v); if (g == 0) NTv[(size_t)(sc * 4 + h) * 256 + 16 * dk + c] = v; }
        }
    }
}

namespace pg8 {
template <class F> __device__ __forceinline__ void for_each_piece_local(const f32x4 (&acc)[2][2][4][2], int wr, int wc, int fr, int fq, const F& f) {
    asm volatile("" : "+v"(fr), "+v"(fq));
    const int row0 = wr * 64 + fr, col0 = wc * 32 + 8 * fq;
#pragma unroll
    for (int ai = 0; ai < 2; ++ai)
#pragma unroll
        for (int m = 0; m < 4; ++m)
#pragma unroll
            for (int bj = 0; bj < 2; ++bj) f(row0 + ai * HALF + m * 16, col0 + bj * HALF, acc[ai][bj][m][0], acc[ai][bj][m][1]);
}
}
struct SchedM1 { const char* VWT; const char* KMT; int G, c; int K, lda, ldb;
    __device__ __forceinline__ bool next(int i, pg8::Unit& u) const { return pg8::decode_unit((long)i * G + c, 4, 64, 1, u); }
    __device__ __forceinline__ const char* abase(const pg8::Unit& u) const { return VWT + ((size_t)u.grp * 256 * P + (size_t)(u.pm + 1) * 256) * 2; }
    __device__ __forceinline__ const char* bbase(const pg8::Unit& u) const { return KMT + ((size_t)u.grp * 256 * P + (size_t)(u.pm + 1) * 256) * 2; } };
struct EpiM1 { bf16_t* CT;
    __device__ __forceinline__ void operator()(const f32x4 (&acc)[2][2][4][2], const pg8::Unit& u, int wr, int wc, int fr, int fq) const {
        bf16_t* base = CT + (size_t)((u.pm + 1) * 4 + u.grp) * 65536;
        pg8::for_each_piece_local(acc, wr, wc, fr, fq, [&](int row, int col, f32x4 v0, f32x4 v1) { *(u32x4*)(base + (size_t)row * 256 + col) = pg8::pack8(v0, v1); }); } };
__device__ __forceinline__ void phase_ms(const Params& p, char* lds, int bid, int nb) {
    phase_m1(p, lds, bid, nb, 1);
    const int tid = TIDX, wid = __builtin_amdgcn_readfirstlane(tid >> 6), lane = tid & 63, c = lane & 15, g = lane >> 4, gw = bid * NW + wid, ngw = nb * NW;
    const bf16_t* KMT = (const bf16_t*)(p.ws + B_KMT); const float* tw = (const float*)(p.ws + TAB_W); float* NTv = (float*)(p.ws + TAB_NT);
    for (int t = gw; t < 64 * 4 * 16; t += ngw) {
        const int dkb = t & 15, h = (t >> 4) & 3, sc = 1 + (t >> 6);
        const bf16_t* kr = KMT + (size_t)(h * 256 + 16 * dkb + c) * P + sc * 256 + 64 * g; const float* wp = tw + (size_t)h * P + sc * 256 + 64 * g;
        float a = 0.f;
#pragma unroll
        for (int i = 0; i < 8; ++i) { const u32x4 kk = *(const u32x4*)(kr + 8 * i); const f32x4 w0 = *(const f32x4*)(wp + 8 * i), w1 = *(const f32x4*)(wp + 8 * i + 4);
            a += bf2f(kk.x & 0xffffu) * w0.x + bf2f(kk.x >> 16) * w0.y + bf2f(kk.y & 0xffffu) * w0.z + bf2f(kk.y >> 16) * w0.w
               + bf2f(kk.z & 0xffffu) * w1.x + bf2f(kk.z >> 16) * w1.y + bf2f(kk.w & 0xffffu) * w1.z + bf2f(kk.w >> 16) * w1.w; }
        a += sx<16>(a); a = sum32(a);
        if (g == 0) NTv[(size_t)(sc * 4 + h) * 256 + 16 * dkb + c] = a;
    }
    SchedM1 S{(const char*)(p.ws + B_VWT), (const char*)KMT, nb, bid, 256, P, P};
    pg8::gemm_phase((PG8_LAS unsigned char*)lds, S, EpiM1{(bf16_t*)(p.ws + B_CT)});
}

__device__ __forceinline__ void phase_m2(const Params& p, char* lds, int bid, int nb) {
    const float* scg = (const float*)(p.ws + TAB_SCG); const float* scm = (const float*)(p.ws + TAB_SCM);
    unsigned* CT = (unsigned*)(p.ws + B_CT); float* NTv = (float*)(p.ws + TAB_NT); float* mt = (float*)(p.ws + TAB_MT);
    const int gid = bid * NT + TIDX, nth = nb * NT;
    for (int i = gid; i < 4 * 32768 + 1024; i += nth) {
        if (i < 4 * 32768) {
            const int h = i >> 15, idx = i & 32767;
            unsigned* base = CT + (size_t)h * 32768 + idx;
            unsigned u[NSC];
#pragma unroll
            for (int sc = 0; sc < NSC; ++sc) u[sc] = base[(size_t)sc * 4 * 32768];
            float m = 0.f, c0 = 0.f, c1 = 0.f;
#pragma unroll
            for (int sc = 0; sc < NSC; ++sc) {
                const float gg = scg[sc * 4 + h], ml = scm[sc * 4 + h], mn = fmaxf(gg + m, ml), dec = __expf(gg + m - mn), cor = __expf(ml - mn);
                c0 = dec * c0 + cor * bf2f(u[sc] & 0xffffu); c1 = dec * c1 + cor * bf2f(u[sc] >> 16);
                base[(size_t)sc * 4 * 32768] = pk2(c0, c1); m = mn;
            }
        } else {
            const int j = i - 4 * 32768, h = j >> 8, d = j & 255;
            float* ptr0 = NTv + (size_t)h * 256 + d;
            float un[NSC];
#pragma unroll
            for (int sc = 0; sc < NSC; ++sc) un[sc] = ptr0[(size_t)sc * 1024];
            float m = 0.f, n = 0.f;
#pragma unroll
            for (int sc = 0; sc < NSC; ++sc) {
                const float gg = scg[sc * 4 + h], ml = scm[sc * 4 + h], mn = fmaxf(gg + m, ml), dec = __expf(gg + m - mn), cor = __expf(ml - mn);
                n = dec * n + cor * un[sc]; ptr0[(size_t)sc * 1024] = n; m = mn;
                if (d == 0) mt[sc * 4 + h] = mn;
            }
        }
    }
}

__device__ __forceinline__ void phase_m3(const Params& p, int l, char* lds, int bid, int nb, bool sc0_only) {
    const int tid = TIDX, wid = __builtin_amdgcn_readfirstlane(tid >> 6), lane = tid & 63, c = lane & 15, g = lane >> 4, gw = bid * NW + wid, ngw = nb * NW;
    const bf16_t* QM = (const bf16_t*)(p.ws + B_QM); const bf16_t* KM = (const bf16_t*)(p.ws + B_KM); const bf16_t* VMT = (const bf16_t*)(p.ws + B_VMT);
    const bf16_t* CT = (const bf16_t*)(p.ws + B_CT); const float* NTv = (const float*)(p.ws + TAB_NT); const float* mt = (const float*)(p.ws + TAB_MT);
    const float* tb = (const float*)(p.ws + TAB_B); const float* te = (const float*)(p.ws + TAB_E); const float* tpm = (const float*)(p.ws + TAB_PM);
    const bf16_t* OP = (const bf16_t*)(p.ws + B_OP); bf16_t* YM = (bf16_t*)(p.ws + B_YM);
    constexpr int NRG = P / 16, RG0 = VALID0 / 16;
    const int ntask = (NRG - RG0) * 4;
    for (int u = (sc0_only ? 256 : 0) + bid; u < (sc0_only ? 260 : NSC * 4 * 2); u += nb) {
        const int half = u < NSC * 4 ? 1 : 0, uu = u < NSC * 4 ? u : u - NSC * 4, sc = (NSC - 1) - (uu >> 2), h = uu & 3, rg = sc * 16 + half * 8 + wid;
        if (rg < RG0) continue;
        const int t0 = rg * 16, row = t0 + c, s_start = sc << 8;
        bf16x8 qf[8];
#pragma unroll
        for (int ks = 0; ks < 8; ++ks) qf[ks] = ld8(QM + (size_t)row * D + h * 256 + 32 * ks + 8 * g);
        const float b_t = tb[(size_t)h * P + row], pm_t = tpm[(size_t)h * P + row];
        const float m_prev = sc > 0 ? mt[(sc - 1) * 4 + h] : 0.f;
        const float m_t = b_t + fmaxf(m_prev, pm_t), scale_t = __expf(b_t + m_prev - m_t);
        f32x4 acc[16];
#pragma unroll
        for (int i = 0; i < 16; ++i) acc[i] = (f32x4){0.f, 0.f, 0.f, 0.f};
        float den = 0.f;
        if (sc > 0) {
            const bf16_t* Cb = CT + (size_t)((sc - 1) * 4 + h) * 65536; const float* nv = NTv + (size_t)((sc - 1) * 4 + h) * 256;
#pragma unroll 2
            for (int ks = 0; ks < 8; ++ks) {
#pragma unroll
                for (int dt = 0; dt < 16; ++dt) acc[dt] = mfma16(ld8(Cb + (size_t)(16 * dt + c) * 256 + 32 * ks + 8 * g), qf[ks], acc[dt]);
                const f32x4 n0 = *(const f32x4*)(nv + 32 * ks + 8 * g), n1 = *(const f32x4*)(nv + 32 * ks + 8 * g + 4);
                const u32x4 qq = *(const u32x4*)&qf[ks];
                den += bf2f(qq.x & 0xffffu) * n0.x + bf2f(qq.x >> 16) * n0.y + bf2f(qq.y & 0xffffu) * n0.z + bf2f(qq.y >> 16) * n0.w
                     + bf2f(qq.z & 0xffffu) * n1.x + bf2f(qq.z >> 16) * n1.y + bf2f(qq.w & 0xffffu) * n1.z + bf2f(qq.w >> 16) * n1.w;
            }
            den *= scale_t;
#pragma unroll
            for (int dt = 0; dt < 16; ++dt) acc[dt] = acc[dt] * scale_t;
        }
        for (int kb = (sc == 0 ? 224 : s_start); kb <= t0 + 15; kb += 32) {
            f32x4 s[2];
#pragma unroll
            for (int a = 0; a < 2; ++a) {
                s[a] = (f32x4){0.f, 0.f, 0.f, 0.f};
                const bf16_t* kr = KM + (size_t)(kb + 16 * a + c) * D + h * 256 + 8 * g;
#pragma unroll
                for (int ks = 0; ks < 8; ++ks) s[a] = mfma16(ld8(kr + 32 * ks), qf[ks], s[a]);
                const f32x4 ee = *(const f32x4*)(te + (size_t)h * P + kb + 16 * a + 4 * g);
#pragma unroll
                for (int r = 0; r < 4; ++r) { const int key = kb + 16 * a + 4 * g + r; const float arg = fminf(ee[r] + b_t - m_t, 0.f);
                    const float dd = key <= row ? __expf(arg) : 0.f; const float pv = s[a][r] * dd; s[a][r] = pv; den += pv; }
            }
            u32x4 w; w.x = pk2(s[0][0], s[0][1]); w.y = pk2(s[0][2], s[0][3]); w.z = pk2(s[1][0], s[1][1]); w.w = pk2(s[1][2], s[1][3]);
            const bf16x8 pf = *(bf16x8*)&w;
#pragma unroll
            for (int dt = 0; dt < 16; ++dt) {
                const bf16_t* vr = VMT + (size_t)(h * 256 + 16 * dt + c) * P + kb + 4 * g;
                const u32x2 v0 = *(const u32x2*)vr, v1 = *(const u32x2*)(vr + 16);
                u32x4 vv; vv.x = v0.x; vv.y = v0.y; vv.z = v1.x; vv.w = v1.y;
                acc[dt] = mfma16(*(bf16x8*)&vv, pf, acc[dt]);
            }
        }
        den += sx<16>(den); den = sum32(den);
        const float inv = 1.f / fmaxf(fabsf(den), __expf(-m_t));
        float s1 = 0.f;
#pragma unroll
        for (int dt = 0; dt < 16; ++dt) {
            const u32x2 og = *(const u32x2*)(OP + (size_t)row * D + h * 256 + 16 * dt + 4 * g);
            f32x4 v = acc[dt] * inv;
            v.x *= sigmoidf_(bf2f(og.x & 0xffffu)); v.y *= sigmoidf_(bf2f(og.x >> 16)); v.z *= sigmoidf_(bf2f(og.y & 0xffffu)); v.w *= sigmoidf_(bf2f(og.y >> 16));
            acc[dt] = v; s1 += (v.x + v.y) + (v.z + v.w);
        }
        s1 += sx<16>(s1); s1 = sum32(s1);
        const float mu = s1 * (1.f / 256.f);
        float s2 = 0.f;
#pragma unroll
        for (int dt = 0; dt < 16; ++dt) { acc[dt] = acc[dt] - mu; s2 += (acc[dt].x * acc[dt].x + acc[dt].y * acc[dt].y) + (acc[dt].z * acc[dt].z + acc[dt].w * acc[dt].w); }
        s2 += sx<16>(s2); s2 = sum32(s2);
        const float rstd = rsqrtf(s2 * (1.f / 256.f) + LN_EPS);
#pragma unroll
        for (int dt = 0; dt < 16; ++dt) { const f32x4 gg = *(const f32x4*)(p.in[I_MNG] + (size_t)l * D + h * 256 + 16 * dt + 4 * g);
            store4_bf16(YM + (size_t)row * D + h * 256 + 16 * dt + 4 * g, acc[dt] * rstd * gg); }
    }
}

struct EpiBr1 { float* MRG; const bf16_t* GA;
    __device__ __forceinline__ void operator()(int m, int n, f32x4 v) const { const u32x2 gg = *(const u32x2*)(GA + (size_t)m * D + n);
        f32x4 o; o.x = v.x * sigmoidf_(bf2f(gg.x & 0xffffu)); o.y = v.y * sigmoidf_(bf2f(gg.x >> 16)); o.z = v.z * sigmoidf_(bf2f(gg.y & 0xffffu)); o.w = v.w * sigmoidf_(bf2f(gg.y >> 16));
        *(f32x4*)(MRG + (size_t)m * D + n) = o; } };
struct EpiBr2 { const float* MRG; const bf16_t* GB; bf16_t* OUT;
    __device__ __forceinline__ void operator()(int m, int n, f32x4 v) const { const u32x2 gg = *(const u32x2*)(GB + (size_t)m * D + n); const f32x4 t = *(const f32x4*)(MRG + (size_t)m * D + n);
        f32x4 o; o.x = t.x + v.x * sigmoidf_(bf2f(gg.x & 0xffffu)); o.y = t.y + v.y * sigmoidf_(bf2f(gg.x >> 16)); o.z = t.z + v.z * sigmoidf_(bf2f(gg.y & 0xffffu)); o.w = t.w + v.w * sigmoidf_(bf2f(gg.y >> 16));
        store4_bf16(OUT + (size_t)m * D + n, o); } };
struct EpiOut { float* Z; const bf16_t* H;
    __device__ __forceinline__ void operator()(int m, int n, f32x4 v) const { const u32x2 hh = *(const u32x2*)(H + (size_t)m * D + n);
        f32x4 o; o.x = v.x + DN_ALPHA * bf2f(hh.x & 0xffffu); o.y = v.y + DN_ALPHA * bf2f(hh.x >> 16); o.z = v.z + DN_ALPHA * bf2f(hh.y & 0xffffu); o.w = v.w + DN_ALPHA * bf2f(hh.y >> 16);
        *(f32x4*)(Z + (size_t)m * D + n) = o; } };
constexpr int LDS_TAB_OFF = 131072;
constexpr int LDS_MT_OFF = LDS_TAB_OFF + 256;
constexpr int LDS_STAT_OFF = LDS_TAB_OFF + 2048;
__device__ __forceinline__ void compute_mtab_lds(const Params& p, char* lds) {
    float* mt = (float*)(lds + LDS_MT_OFF); float* tmp = (float*)(lds + LDS_STAT_OFF);
    const int t = TIDX;
    if (t < NSC * 4) { tmp[t] = ((const float*)(p.ws + TAB_SCG))[t]; tmp[NSC * 4 + t] = ((const float*)(p.ws + TAB_SCM))[t]; }
    __syncthreads();
    if (t < 4) { float m = 0.f;
        for (int sc = 0; sc < NSC; ++sc) { m = fmaxf(tmp[sc * 4 + t] + m, tmp[NSC * 4 + sc * 4 + t]); mt[sc * 4 + t] = m; } }
    __syncthreads();
}
struct SchedQK { const char* A; const char* B; int G, c; int K, lda, ldb;
    __device__ __forceinline__ bool next(int i, pg8::Unit& u) const { if (!pg8::decode_unit((long)i * G + c, 4, 64, 1, u)) return false; u.pm += 1; return true; }
    __device__ __forceinline__ const char* abase(const pg8::Unit& u) const { return A + ((size_t)u.pm * 256 * D + u.grp * 256) * 2; }
    __device__ __forceinline__ const char* bbase(const pg8::Unit& u) const { return B + ((size_t)u.pm * 256 * D + u.grp * 256) * 2; } };
struct EpiS { unsigned char* ws; const float* mt_lds;
    __device__ __forceinline__ void operator()(const f32x4 (&acc)[2][2][4][2], const pg8::Unit& u, int wr, int wc, int fr, int fq) const {
        asm volatile("" : "+v"(fr), "+v"(fq));
        const int h = u.grp, t0 = u.pm * 256; const float m_prev = mt_lds[(u.pm - 1) * 4 + h];
        const float* te = (const float*)(ws + TAB_E) + (size_t)h * P + t0; const float* tpm = (const float*)(ws + TAB_PM) + (size_t)h * P + t0;
        bf16_t* PMb = (bf16_t*)(ws + B_PM) + (size_t)t0 * D + h * 256; float* denp = (float*)(ws + TAB_DENP);
        const int c0 = wc * 32 + 8 * fq;
        f32x4 e[2][2];
#pragma unroll
        for (int bj = 0; bj < 2; ++bj) { e[bj][0] = *(const f32x4*)(te + c0 + bj * 128); e[bj][1] = *(const f32x4*)(te + c0 + bj * 128 + 4); }
        float tp[2][4];
#pragma unroll
        for (int ai = 0; ai < 2; ++ai)
#pragma unroll
            for (int m = 0; m < 4; ++m) tp[ai][m] = tpm[ai * 128 + wr * 64 + m * 16 + fr];
#pragma unroll
        for (int ai = 0; ai < 2; ++ai)
#pragma unroll
            for (int m = 0; m < 4; ++m) { const int r = ai * 128 + wr * 64 + m * 16 + fr; const float pmx = fmaxf(m_prev, tp[ai][m]); float rs = 0.f;
#pragma unroll
                for (int bj = 0; bj < 2; ++bj) { f32x4 o0, o1;
#pragma unroll
                    for (int j = 0; j < 4; ++j) { const int s0 = c0 + bj * 128 + j, s1 = s0 + 4;
                        o0[j] = s0 <= r ? acc[ai][bj][m][0][j] * __expf(fminf(e[bj][0][j] - pmx, 0.f)) : 0.f;
                        o1[j] = s1 <= r ? acc[ai][bj][m][1][j] * __expf(fminf(e[bj][1][j] - pmx, 0.f)) : 0.f;
                        rs += o0[j] + o1[j]; }
                    *(u32x4*)(PMb + (size_t)r * D + c0 + bj * 128) = pg8::pack8(o0, o1); }
                rs += sx<16>(rs); rs = sum32(rs);
                if (fq == 0) denp[((size_t)(t0 + r) * 4 + h) * 4 + wc] = rs; } } };
struct SchedO1 { const char* A; const char* B; int G, c; int K, lda, ldb;
    __device__ __forceinline__ bool next(int i, pg8::Unit& u) const { if (!pg8::decode_unit((long)i * G + c, 4, 64, 1, u)) return false; u.pm += 1; return true; }
    __device__ __forceinline__ const char* abase(const pg8::Unit& u) const { return A + ((size_t)u.pm * 256 * D + u.grp * 256) * 2; }
    __device__ __forceinline__ const char* bbase(const pg8::Unit& u) const { return B + (size_t)((u.pm - 1) * 4 + u.grp) * 65536 * 2; } };
struct EpiO1 { unsigned char* ws;
    __device__ __forceinline__ void operator()(const f32x4 (&acc)[2][2][4][2], const pg8::Unit& u, int wr, int wc, int fr, int fq) const {
        asm volatile("" : "+v"(fr), "+v"(fq));
        const int h = u.grp, t0 = u.pm * 256; const float m_prev = ((const float*)(ws + TAB_MT))[(u.pm - 1) * 4 + h];
        const float* tpm = (const float*)(ws + TAB_PM) + (size_t)h * P + t0; bf16_t* OI = (bf16_t*)(ws + B_OI) + (size_t)t0 * D + h * 256;
        const int c0 = wc * 32 + 8 * fq;
        float tp[2][4];
#pragma unroll
        for (int ai = 0; ai < 2; ++ai)
#pragma unroll
            for (int m = 0; m < 4; ++m) tp[ai][m] = tpm[ai * 128 + wr * 64 + m * 16 + fr];
#pragma unroll
        for (int ai = 0; ai < 2; ++ai)
#pragma unroll
            for (int m = 0; m < 4; ++m) { const int r = ai * 128 + wr * 64 + m * 16 + fr; const float sc = __expf(fminf(m_prev - tp[ai][m], 0.f));
#pragma unroll
                for (int bj = 0; bj < 2; ++bj) *(u32x4*)(OI + (size_t)r * D + c0 + bj * 128) = pg8::pack8(acc[ai][bj][m][0] * sc, acc[ai][bj][m][1] * sc); } } };
struct SchedO2 { const char* A; const char* B; int G, c; int K, lda, ldb;
    __device__ __forceinline__ bool next(int i, pg8::Unit& u) const { if (!pg8::decode_unit((long)i * G + c, 4, 64, 1, u)) return false; u.pm += 1; return true; }
    __device__ __forceinline__ const char* abase(const pg8::Unit& u) const { return A + ((size_t)u.pm * 256 * D + u.grp * 256) * 2; }
    __device__ __forceinline__ const char* bbase(const pg8::Unit& u) const { return B + ((size_t)u.grp * 256 * P + (size_t)u.pm * 256) * 2; } };
struct EpiO2 { unsigned char* ws; const float* mng; float* stat;
    __device__ __forceinline__ void operator()(f32x4 (&acc)[2][2][4][2], const pg8::Unit& u, int wr, int wc, int fr, int fq) const {
        asm volatile("" : "+v"(fr), "+v"(fq));
        const int h = u.grp, t0 = u.pm * 256; const float m_prev = ((const float*)(ws + TAB_MT))[(u.pm - 1) * 4 + h];
        const float* tpm = (const float*)(ws + TAB_PM) + (size_t)h * P + t0; const float* tb = (const float*)(ws + TAB_B) + (size_t)h * P + t0;
        const float* denp = (const float*)(ws + TAB_DENP); const float* deni = (const float*)(ws + TAB_DENI);
        const bf16_t* OI = (const bf16_t*)(ws + B_OI) + (size_t)t0 * D + h * 256; const bf16_t* OP = (const bf16_t*)(ws + B_OP) + (size_t)t0 * D + h * 256;
        bf16_t* YM = (bf16_t*)(ws + B_YM) + (size_t)t0 * D + h * 256;
        const int c0 = wc * 32 + 8 * fq;
#pragma unroll
        for (int ai = 0; ai < 2; ++ai)
#pragma unroll
            for (int m = 0; m < 4; ++m) { const int r = ai * 128 + wr * 64 + m * 16 + fr;
                const f32x4 dp = *(const f32x4*)(denp + ((size_t)(t0 + r) * 4 + h) * 4); const float den = (dp.x + dp.y) + (dp.z + dp.w) + deni[(size_t)(t0 + r) * 4 + h];
                const float m_t = tb[r] + fmaxf(m_prev, tpm[r]); const float inv = 1.f / fmaxf(fabsf(den), __expf(-m_t));
                float s1 = 0.f, s2 = 0.f;
#pragma unroll
                for (int bj = 0; bj < 2; ++bj) { f32x4 i0, i1, g0, g1; pg8::unpack8(*(const u32x4*)(OI + (size_t)r * D + c0 + bj * 128), i0, i1); pg8::unpack8(*(const u32x4*)(OP + (size_t)r * D + c0 + bj * 128), g0, g1);
                    f32x4 v0 = (acc[ai][bj][m][0] + i0) * inv * sig4(g0), v1 = (acc[ai][bj][m][1] + i1) * inv * sig4(g1);
                    acc[ai][bj][m][0] = v0; acc[ai][bj][m][1] = v1;
                    s1 += (v0.x + v0.y) + (v0.z + v0.w) + (v1.x + v1.y) + (v1.z + v1.w);
                    s2 += (v0.x * v0.x + v0.y * v0.y) + (v0.z * v0.z + v0.w * v0.w) + (v1.x * v1.x + v1.y * v1.y) + (v1.z * v1.z + v1.w * v1.w); }
                s1 += sx<16>(s1); s1 = sum32(s1); s2 += sx<16>(s2); s2 = sum32(s2);
                if (fq == 0) { stat[(r * 4 + wc) * 2] = s1; stat[(r * 4 + wc) * 2 + 1] = s2; } }
        asm volatile("s_waitcnt lgkmcnt(0)" ::: "memory"); __builtin_amdgcn_s_barrier(); asm volatile("" ::: "memory");
#pragma unroll
        for (int ai = 0; ai < 2; ++ai)
#pragma unroll
            for (int m = 0; m < 4; ++m) { const int r = ai * 128 + wr * 64 + m * 16 + fr;
                const f32x4 a = *(const f32x4*)(stat + r * 8), b = *(const f32x4*)(stat + r * 8 + 4);
                const float mu = ((a.x + a.z) + (b.x + b.z)) * (1.f / 256.f), ex2 = ((a.y + a.w) + (b.y + b.w)) * (1.f / 256.f);
                const float rstd = rsqrtf(fmaxf(ex2 - mu * mu, 0.f) + LN_EPS);
#pragma unroll
                for (int bj = 0; bj < 2; ++bj) { const f32x4 g0 = *(const f32x4*)(mng + h * 256 + c0 + bj * 128), g1 = *(const f32x4*)(mng + h * 256 + c0 + bj * 128 + 4);
                    *(u32x4*)(YM + (size_t)r * D + c0 + bj * 128) = pg8::pack8((acc[ai][bj][m][0] - mu) * rstd * g0, (acc[ai][bj][m][1] - mu) * rstd * g1); } } } };
__device__ __forceinline__ void phase_o1(const Params& p, char* lds, int bid, int nb) {
    const int tid = TIDX, wid = __builtin_amdgcn_readfirstlane(tid >> 6), lane = tid & 63, c = lane & 15, g = lane >> 4, gw = bid * NW + wid, ngw = nb * NW;
    const bf16_t* QM = (const bf16_t*)(p.ws + B_QM); const float* NTv = (const float*)(p.ws + TAB_NT); const float* mt = (const float*)(p.ws + TAB_MT);
    const float* tpm = (const float*)(p.ws + TAB_PM); float* deni = (float*)(p.ws + TAB_DENI);
#pragma unroll 2
    for (int it = gw; it < ((P - 256) / 16) * 4; it += ngw) {
        const int h = it & 3, t = 256 + (it >> 2) * 16 + c, sc = t >> 8;
        const bf16_t* qr = QM + (size_t)t * D + h * 256 + 64 * g; const float* nv = NTv + (size_t)((sc - 1) * 4 + h) * 256 + 64 * g;
        float a = 0.f;
#pragma unroll
        for (int i = 0; i < 8; ++i) { const u32x4 qq = *(const u32x4*)(qr + 8 * i); const f32x4 n0 = *(const f32x4*)(nv + 8 * i), n1 = *(const f32x4*)(nv + 8 * i + 4);
            a += bf2f(qq.x & 0xffffu) * n0.x + bf2f(qq.x >> 16) * n0.y + bf2f(qq.y & 0xffffu) * n0.z + bf2f(qq.y >> 16) * n0.w
               + bf2f(qq.z & 0xffffu) * n1.x + bf2f(qq.z >> 16) * n1.y + bf2f(qq.w & 0xffffu) * n1.z + bf2f(qq.w >> 16) * n1.w; }
        a += sx<16>(a); a = sum32(a);
        if (g == 0) deni[(size_t)t * 4 + h] = a * __expf(fminf(mt[(sc - 1) * 4 + h] - tpm[(size_t)h * P + t], 0.f));
    }
    SchedO1 S{(const char*)QM, (const char*)(p.ws + B_CT), nb, bid, 256, D, 256};
    pg8::gemm_phase((PG8_LAS unsigned char*)lds, S, EpiO1{p.ws});
}
__device__ __forceinline__ void phase_sg(const Params& p, char* lds, int bid, int nb) {
    compute_mtab_lds(p, lds);
    SchedQK S{(const char*)(p.ws + B_QM), (const char*)(p.ws + B_KM), nb, bid, 256, D, D};
    pg8::gemm_phase((PG8_LAS unsigned char*)lds, S, EpiS{p.ws, (const float*)(lds + LDS_MT_OFF)});
}
__device__ __forceinline__ void phase_o2(const Params& p, int l, char* lds, int bid, int nb) {
    phase_m3(p, l, lds, bid, nb, true);
    SchedO2 S{(const char*)(p.ws + B_PM), (const char*)(p.ws + B_VMT), nb, bid, 256, D, P};
    pg8::gemm_phase((PG8_LAS unsigned char*)lds, S, EpiO2{p.ws, p.in[I_MNG] + (size_t)l * D, (float*)(lds + LDS_STAT_OFF)});
}

struct SchedMqkvN { const char* XC; const char* WQ; const char* WK; int G, c; int K, lda, ldb;
    __device__ __forceinline__ bool next(int i, pg8::Unit& u) const { if (!pg8::decode_unit((long)i * G + c, 8, 64, 1, u)) return false; u.pm += 1; return true; }
    __device__ __forceinline__ const char* abase(const pg8::Unit& u) const { return XC + (size_t)(u.grp & 3) * 512 + (size_t)u.pm * 256 * D * 2; }
    __device__ __forceinline__ const char* bbase(const pg8::Unit& u) const { return ((u.grp >> 2) ? WK : WQ) + (size_t)(u.grp & 3) * 65536 * 2; } };
struct SchedMqkvT { const char* XC; const char* XM; const char* WK; const char* WV; int G, c; int K, lda, ldb;
    __device__ __forceinline__ bool next(int i, pg8::Unit& u) const { if (!pg8::decode_unit((long)i * G + c, 8, 1, 64, u)) return false; u.pn += 1; return true; }
    __device__ __forceinline__ const char* abase(const pg8::Unit& u) const { return ((u.grp >> 2) ? WV : WK) + (size_t)(u.grp & 3) * 65536 * 2; }
    __device__ __forceinline__ const char* bbase(const pg8::Unit& u) const { return ((u.grp >> 2) ? XM : XC) + (size_t)(u.grp & 3) * 512 + (size_t)u.pn * 256 * D * 2; } };
struct EpiGrpF { bf16_t* base0; bf16_t* base1; size_t hstride; size_t ldc; float s0, s1;
    __device__ __forceinline__ void operator()(const f32x4 (&acc)[2][2][4][2], const pg8::Unit& u, int wr, int wc, int fr, int fq) const {
        const int which = u.grp >> 2, h = u.grp & 3; const float sc = which ? s1 : s0;
        bf16_t* base = (which ? base1 : base0) + (size_t)h * hstride + (size_t)u.pn * 256;
        const size_t ld = ldc;
        pg8::for_each_piece(acc, u, wr, wc, fr, fq, [&](int row, int col, f32x4 v0, f32x4 v1) { *(u32x4*)(base + (size_t)row * ld + col) = pg8::pack8(v0 * sc, v1 * sc); }); } };
struct EpiMqkvT { unsigned char* ws;
    __device__ __forceinline__ void operator()(const f32x4 (&acc)[2][2][4][2], const pg8::Unit& u, int wr, int wc, int fr, int fq) const {
        bf16_t* KMT = (bf16_t*)(ws + B_KMT); bf16_t* VMT = (bf16_t*)(ws + B_VMT); bf16_t* VWT = (bf16_t*)(ws + B_VWT); const float* tw = (const float*)(ws + TAB_W);
        const int which = u.grp >> 2, h = u.grp & 3; const size_t cb = (size_t)u.pn * 256;
        if (which == 0) { bf16_t* base = KMT + (size_t)h * 256 * P + cb;
            pg8::for_each_piece(acc, u, wr, wc, fr, fq, [&](int row, int col, f32x4 v0, f32x4 v1) { *(u32x4*)(base + (size_t)row * P + col) = pg8::pack8(v0 * 0.0625f, v1 * 0.0625f); });
        } else { bf16_t* b0 = VMT + (size_t)h * 256 * P + cb; bf16_t* b1 = VWT + (size_t)h * 256 * P + cb; const float* w = tw + (size_t)h * P + cb;
            struct W2 { f32x4 w0, w1; };
            pg8::for_each_piece_pf(acc, u, wr, wc, fr, fq, [&](int row, int col) { W2 r; r.w0 = *(const f32x4*)(w + col); r.w1 = *(const f32x4*)(w + col + 4); return r; },
                [&](int row, int col, f32x4 v0, f32x4 v1, W2 ww) {
                *(u32x4*)(b0 + (size_t)row * P + col) = pg8::pack8(v0, v1); *(u32x4*)(b1 + (size_t)row * P + col) = pg8::pack8(v0 * ww.w0, v1 * ww.w1); }); } } };
struct EpiStoreW { bf16_t* C0; bf16_t* C1; size_t ldc; const float* w;
    __device__ __forceinline__ void operator()(int m, int n, f32x4 v) const { store4_bf16(C0 + (size_t)m * ldc + n, v); const f32x4 ww = *(const f32x4*)(w + n); store4_bf16(C1 + (size_t)m * ldc + n, v * ww); } };
__device__ __forceinline__ void phase_mqkv_f(const Params& p, char* lds, int bid, int nb) {
    const int tid = TIDX, wid = tid >> 6, gw = bid * NW + wid, ngw = nb * NW;
    const bf16_t* XC = (const bf16_t*)(p.ws + B_XC); const bf16_t* XM = (const bf16_t*)(p.ws + B_XM);
    const bf16_t* WQ = (const bf16_t*)(p.ws + W_Q_T); const bf16_t* WK = (const bf16_t*)(p.ws + W_K_T); const bf16_t* WV = (const bf16_t*)(p.ws + W_V_T);
    bf16_t* QM = (bf16_t*)(p.ws + B_QM); bf16_t* KM = (bf16_t*)(p.ws + B_KM); bf16_t* KMT = (bf16_t*)(p.ws + B_KMT); bf16_t* VMT = (bf16_t*)(p.ws + B_VMT); bf16_t* VWT = (bf16_t*)(p.ws + B_VWT);
    zero_block(KM, D, VALID0, D, bid * NT + tid, nb * NT);
    zero_block(VWT, P, D, VALID0, bid * NT + tid, nb * NT);
    zero_block(KMT, P, D, VALID0, bid * NT + tid, nb * NT);
    zero_block(VMT, P, D, VALID0, bid * NT + tid, nb * NT);
    for (int t = bid; t < 64; t += nb) {
        const int which = (t >> 4) & 1, h = (t >> 2) & 3, q = t & 3;
        if (t < 32) meta_gemm<1, 4>(RowsPlain{XC + h * 256, D}, RowsPlain{(which ? WK : WQ) + (size_t)h * 65536, 256}, 256, VALID0, q * 64, EpiStore{(which ? KM : QM) + h * 256, D, which ? 0.0625f : 1.f}, lds);
        else if (which == 0) meta_gemm<4, 1>(RowsPlain{WK + (size_t)h * 65536, 256}, RowsPlain{XC + h * 256, D}, 256, q * 64, VALID0, EpiStore{KMT + (size_t)h * 256 * P, P, 0.0625f}, lds);
        else meta_gemm<4, 1>(RowsPlain{WV + (size_t)h * 65536, 256}, RowsPlain{XM + h * 256, D}, 256, q * 64, VALID0, EpiStoreW{VMT + (size_t)h * 256 * P, VWT + (size_t)h * 256 * P, P, (const float*)(p.ws + TAB_W) + (size_t)h * P}, lds);
    }
    { SchedMqkvN S{(const char*)XC, (const char*)WQ, (const char*)WK, nb, bid, 256, D, 256};
      pg8::gemm_phase((PG8_LAS unsigned char*)lds, S, EpiGrpF{QM, KM, 256, D, 1.f, 0.0625f}); }
    { SchedMqkvT S{(const char*)XC, (const char*)XM, (const char*)WK, (const char*)WV, nb, bid, 256, 256, D};
      pg8::gemm_phase((PG8_LAS unsigned char*)lds, S, EpiMqkvT{p.ws}); }
}
struct SchedSq { const char* A; const char* B; int G, c; int K, lda, ldb;
    __device__ __forceinline__ bool next(int i, pg8::Unit& u) const { if (!pg8::decode_unit((long)i * G + c, 1, 64, 4, u)) return false; u.pm += 1; return true; }
    __device__ __forceinline__ const char* abase(const pg8::Unit& u) const { return A + (size_t)u.pm * 256 * D * 2; }
    __device__ __forceinline__ const char* bbase(const pg8::Unit& u) const { return B + (size_t)u.pn * 256 * D * 2; } };
struct EpiBr1F { float* MRG; const bf16_t* GA;
    __device__ __forceinline__ void operator()(const f32x4 (&acc)[2][2][4][2], const pg8::Unit& u, int wr, int wc, int fr, int fq) const {
        const int cb = u.pn * 256;
        pg8::for_each_piece(acc, u, wr, wc, fr, fq, [&](int row, int col, f32x4 v0, f32x4 v1) { const size_t idx = (size_t)row * D + cb + col;
            f32x4 g0, g1; pg8::unpack8(*(const u32x4*)(GA + idx), g0, g1);
            *(f32x4*)(MRG + idx) = v0 * sig4(g0); *(f32x4*)(MRG + idx + 4) = v1 * sig4(g1); }); } };
struct EpiBr2F { const float* MRG; const bf16_t* GB; bf16_t* OUT;
    __device__ __forceinline__ void operator()(const f32x4 (&acc)[2][2][4][2], const pg8::Unit& u, int wr, int wc, int fr, int fq) const {
        const int cb = u.pn * 256;
        pg8::for_each_piece(acc, u, wr, wc, fr, fq, [&](int row, int col, f32x4 v0, f32x4 v1) { const size_t idx = (size_t)row * D + cb + col;
            f32x4 g0, g1; pg8::unpack8(*(const u32x4*)(GB + idx), g0, g1);
            const f32x4 t0 = *(const f32x4*)(MRG + idx), t1 = *(const f32x4*)(MRG + idx + 4);
            *(u32x4*)(OUT + idx) = pg8::pack8(t0 + v0 * sig4(g0), t1 + v1 * sig4(g1)); }); } };
struct EpiOutF { float* Z; const bf16_t* H;
    __device__ __forceinline__ void operator()(const f32x4 (&acc)[2][2][4][2], const pg8::Unit& u, int wr, int wc, int fr, int fq) const {
        const int cb = u.pn * 256;
        pg8::for_each_piece_pf(acc, u, wr, wc, fr, fq, [&](int row, int col) { return *(const u32x4*)(H + (size_t)row * D + cb + col); },
            [&](int row, int col, f32x4 v0, f32x4 v1, u32x4 hh) { const size_t idx = (size_t)row * D + cb + col;
            f32x4 h0, h1; pg8::unpack8(hh, h0, h1);
            *(f32x4*)(Z + idx) = v0 + h0 * DN_ALPHA; *(f32x4*)(Z + idx + 4) = v1 + h1 * DN_ALPHA; }); } };
struct SchedBr { const char* YM; const char* YA; const char* WM; const char* WA; int G, c; int K, lda, ldb;
    __device__ __forceinline__ bool next(int i, pg8::Unit& u) const { if (!pg8::decode_unit((long)(i >> 1) * G + c, 1, 64, 4, u)) return false; u.pm += 1; u.grp = i & 1; return true; }
    __device__ __forceinline__ const char* abase(const pg8::Unit& u) const { return (u.grp ? YA : YM) + (size_t)u.pm * 256 * D * 2; }
    __device__ __forceinline__ const char* bbase(const pg8::Unit& u) const { return (u.grp ? WA : WM) + (size_t)u.pn * 256 * D * 2; } };
__device__ __forceinline__ u32x4 ld16_agent(const bf16_t* ptr) {
    const unsigned long long a = __hip_atomic_load((const unsigned long long*)ptr, __ATOMIC_RELAXED, __HIP_MEMORY_SCOPE_AGENT), b = __hip_atomic_load((const unsigned long long*)ptr + 1, __ATOMIC_RELAXED, __HIP_MEMORY_SCOPE_AGENT);
    u32x4 r; r.x = (unsigned)a; r.y = (unsigned)(a >> 32); r.z = (unsigned)b; r.w = (unsigned)(b >> 32); return r; }
struct EpiBrF { unsigned char* ws;
    __device__ __forceinline__ void operator()(const f32x4 (&acc)[2][2][4][2], const pg8::Unit& u, int wr, int wc, int fr, int fq) const {
        const int cb = u.pn * 256; const bf16_t* G = (const bf16_t*)(ws + (u.grp ? B_GB : B_GA)); bf16_t* O = (bf16_t*)(ws + B_MRGB); const bool second = u.grp != 0;
        struct GO { u32x4 g, o; };
        pg8::for_each_piece_pf(acc, u, wr, wc, fr, fq, [&](int row, int col) { const size_t idx = (size_t)row * D + cb + col; GO r; r.g = *(const u32x4*)(G + idx);
                r.o = second ? ld16_agent(O + idx) : (u32x4){0u, 0u, 0u, 0u}; return r; },
            [&](int row, int col, f32x4 v0, f32x4 v1, GO pre) { const size_t idx = (size_t)row * D + cb + col;
            f32x4 g0, g1; pg8::unpack8(pre.g, g0, g1);
            f32x4 r0 = v0 * sig4(g0), r1 = v1 * sig4(g1);
            if (second) { f32x4 t0, t1; pg8::unpack8(pre.o, t0, t1); r0 += t0; r1 += t1; }
            *(u32x4*)(O + idx) = pg8::pack8(r0, r1); }); } };
struct EpiBrS { const bf16_t* G; bf16_t* O; bool second;
    __device__ __forceinline__ void operator()(int m, int n, f32x4 v) const { const u32x2 gg = *(const u32x2*)(G + (size_t)m * D + n);
        f32x4 o; o.x = v.x * sigmoidf_(bf2f(gg.x & 0xffffu)); o.y = v.y * sigmoidf_(bf2f(gg.x >> 16)); o.z = v.z * sigmoidf_(bf2f(gg.y & 0xffffu)); o.w = v.w * sigmoidf_(bf2f(gg.y >> 16));
        if (second) { const unsigned long long t = __hip_atomic_load((const unsigned long long*)(O + (size_t)m * D + n), __ATOMIC_RELAXED, __HIP_MEMORY_SCOPE_AGENT);
            o.x += bf2f((unsigned)t & 0xffffu); o.y += bf2f(((unsigned)t) >> 16); o.z += bf2f((unsigned)(t >> 32) & 0xffffu); o.w += bf2f((unsigned)(t >> 48)); }
        store4_bf16(O + (size_t)m * D + n, o); } };
__device__ __forceinline__ void phase_br_f(const Params& p, char* lds, int bid, int nb) {
    const bf16_t* YM = (const bf16_t*)(p.ws + B_YM); const bf16_t* YA = (const bf16_t*)(p.ws + B_YA);
    const bf16_t* WM = (const bf16_t*)(p.ws + W_BM_T); const bf16_t* WA = (const bf16_t*)(p.ws + W_BA_T); bf16_t* O = (bf16_t*)(p.ws + B_MRGB);
    for (int t = bid; t < 16; t += nb) {
        meta_gemm<1, 4>(RowsPlain{YM, D}, RowsPlain{WM, D}, D, VALID0, t * 64, EpiBrS{(const bf16_t*)(p.ws + B_GA), O, false}, lds);
        asm volatile("s_waitcnt vmcnt(0)" ::: "memory");
        meta_gemm<1, 4>(RowsPlain{YA, D}, RowsPlain{WA, D}, D, VALID0, t * 64, EpiBrS{(const bf16_t*)(p.ws + B_GB), O, true}, lds);
    }
    SchedBr S{(const char*)YM, (const char*)YA, (const char*)WM, (const char*)WA, nb, bid, D, D, D};
    pg8::gemm_phase((PG8_LAS unsigned char*)lds, S, EpiBrF{p.ws});
}
__device__ __forceinline__ void phase_out_f(const Params& p, char* lds, int bid, int nb) {
    const int gw = bid * NW + (TIDX >> 6), ngw = nb * NW;
    const bf16_t* A = (const bf16_t*)(p.ws + B_MRGB); const bf16_t* W = (const bf16_t*)(p.ws + W_OUT_T);
    for (int t = bid; t < 16; t += nb) meta_gemm<1, 4>(RowsPlain{A, D}, RowsPlain{W, D}, D, VALID0, t * 64, EpiOut{(float*)(p.ws + B_Z), (const bf16_t*)(p.ws + B_H)}, lds);
    SchedSq S{(const char*)A, (const char*)W, nb, bid, D, D, D};
    pg8::gemm_phase((PG8_LAS unsigned char*)lds, S, EpiOutF{(float*)(p.ws + B_Z), (const bf16_t*)(p.ws + B_H)});
}

__device__ __forceinline__ void phase_ln1(const Params& p, int l, char* lds, int bid, int nb) {
    const int tid = TIDX, wid = tid >> 6, lane = tid & 63, gw = bid * NW + wid, ngw = nb * NW;
    float* wr = (float*)lds;
    for (int i = tid; i < D * 16 / 4; i += NT) { const int k = i >> 2, q = i & 3; *(f32x4*)(wr + k * 16 + (k >> 2) * 4 + 4 * q) = ((const f32x4*)p.in[I_WR])[i]; }
    unsigned* lcnt = (unsigned*)(lds + 73728); unsigned* lbase = lcnt + 16; int* lrow = (int*)(lds + 73728 + 256) + wid * 64;
    if (tid < 16) lcnt[tid] = 0u;
    __syncthreads();
    const float* Z = (const float*)(p.ws + B_Z); bf16_t* H1 = (bf16_t*)(p.ws + B_H1);
    unsigned* cnt = (unsigned*)(p.ws + WS_CTL) + CW_CNT + l * 16; float* topk = (float*)(p.ws + TAB_TOPK);
    int nrow = 0;
    f32x4 vn[4];
    if (gw < P) {
#pragma unroll
        for (int j = 0; j < 4; ++j) vn[j] = *(const f32x4*)(Z + (size_t)gw * D + 4 * lane + 256 * j); }
    for (int r = gw; r < P; r += ngw) {
        f32x4 v[4];
#pragma unroll
        for (int j = 0; j < 4; ++j) v[j] = vn[j];
        if (r + ngw < P) {
#pragma unroll
            for (int j = 0; j < 4; ++j) vn[j] = *(const f32x4*)(Z + (size_t)(r + ngw) * D + 4 * lane + 256 * j); }
        if (r < VALID0) { store_row_zero(H1 + (size_t)r * D, lane); continue; }
        ln_normalize(v, p.in[I_LN1G] + (size_t)l * D, p.in[I_LN1B] + (size_t)l * D, lane);
        store_row_bf16(H1 + (size_t)r * D, v, lane);
        float lg[16];
#pragma unroll
        for (int e = 0; e < 16; ++e) lg[e] = 0.f;
#pragma unroll
        for (int j = 0; j < 4; ++j)
#pragma unroll
            for (int i = 0; i < 4; ++i) { const int k = 4 * lane + 256 * j + i; const float x = v[j][i];
#pragma unroll
                for (int q = 0; q < 4; ++q) { const f32x4 w = *(const f32x4*)(wr + k * 16 + (k >> 2) * 4 + 4 * q); lg[4 * q] += x * w.x; lg[4 * q + 1] += x * w.y; lg[4 * q + 2] += x * w.z; lg[4 * q + 3] += x * w.w; } }
#pragma unroll
        for (int e = 0; e < 16; ++e) lg[e] = wave_sum(lg[e]);
        if (lane == 0) {
            float mx = lg[0];
#pragma unroll
            for (int e = 1; e < 16; ++e) mx = fmaxf(mx, lg[e]);
            float pr[16], sum = 0.f;
#pragma unroll
            for (int e = 0; e < 16; ++e) { pr[e] = expf(lg[e] - mx); sum += pr[e]; }
            const float isum = 1.f / sum;
            float sel[16];
#pragma unroll
            for (int e = 0; e < 16; ++e) { pr[e] *= isum; sel[e] = pr[e] + p.in[I_RB][e]; }
            int tg = 0; float best = -INFINITY;
#pragma unroll
            for (int gI = 0; gI < 4; ++gI) { const float gs = fmaxf(fmaxf(sel[4 * gI], sel[4 * gI + 1]), fmaxf(sel[4 * gI + 2], sel[4 * gI + 3])); if (gs > best) { best = gs; tg = gI; } }
            int i0 = 0; float b0 = -INFINITY;
#pragma unroll
            for (int e = 0; e < 16; ++e) if ((e >> 2) == tg && sel[e] > b0) { b0 = sel[e]; i0 = e; }
            int i1 = 0; float b1 = -INFINITY;
#pragma unroll
            for (int e = 0; e < 16; ++e) if ((e >> 2) == tg && e != i0 && sel[e] > b1) { b1 = sel[e]; i1 = e; }
            float p0 = 0.f, p1 = 0.f;
#pragma unroll
            for (int e = 0; e < 16; ++e) { if (e == i0) p0 = pr[e]; if (e == i1) p1 = pr[e]; }
            const float inv = 1.f / (p0 + p1);
            const unsigned pos0 = atomicAdd(lcnt + i0, 1u), pos1 = atomicAdd(lcnt + i1, 1u);
            lrow[nrow * 4] = i0; lrow[nrow * 4 + 1] = i1; lrow[nrow * 4 + 2] = (int)pos0; lrow[nrow * 4 + 3] = (int)pos1;
            float* tk = topk + (size_t)r * 8;
            ((int*)tk)[0] = i0; ((int*)tk)[1] = i1; tk[4] = p0 * inv; tk[5] = p1 * inv;
        }
        ++nrow;
    }
    __syncthreads();
    if (tid < 16) lbase[tid] = atomicAdd(cnt + tid, lcnt[tid]);
    __syncthreads();
    if (lane == 0) { int k = 0;
        for (int r = gw; r < P; r += ngw) { if (r < VALID0) continue;
            int* tk = (int*)(topk + (size_t)r * 8); tk[2] = (int)lbase[lrow[k * 4]] + lrow[k * 4 + 2]; tk[3] = (int)lbase[lrow[k * 4 + 1]] + lrow[k * 4 + 3]; ++k; } }
}

__device__ __forceinline__ void expert_offsets(const unsigned* cnt, int* s_cnt, int* s_off, int* s_tiles) {
    int off = 0;
    if (TIDX == 0) { int tt = 0; for (int e = 0; e < 16; ++e) { const int c = (int)cnt[e]; const int tl = (c + 255) >> 8; s_cnt[e] = c; s_off[e] = off; s_tiles[e] = tt; off += tl * 256; tt += tl; } s_tiles[16] = tt; }
    __syncthreads();
}
__device__ __forceinline__ void phase_perm(const Params& p, int l, char* lds, int bid, int nb) {
    int* s_cnt = (int*)(lds + LDS_TAB_OFF); int* s_off = s_cnt + 16; int* s_tiles = s_off + 16;
    expert_offsets((const unsigned*)(p.ws + WS_CTL) + CW_CNT + l * 16, s_cnt, s_off, s_tiles);
    const int tid = TIDX, wid = tid >> 6, lane = tid & 63, gw = bid * NW + wid, ngw = nb * NW;
    const bf16_t* H1 = (const bf16_t*)(p.ws + B_H1); bf16_t* XP = (bf16_t*)(p.ws + B_XP); const float* topk = (const float*)(p.ws + TAB_TOPK);
    int r = VALID0 + gw;
    u32x4 a, b; u32x4 tk;
    if (r < P) { tk = *(const u32x4*)(topk + (size_t)r * 8); const u32x4* src = (const u32x4*)(H1 + (size_t)r * D) + lane * 2; a = src[0]; b = src[1]; }
    while (r < P) {
        const int rn = r + ngw; u32x4 an, bn, tkn;
        if (rn < P) { tkn = *(const u32x4*)(topk + (size_t)rn * 8); const u32x4* src = (const u32x4*)(H1 + (size_t)rn * D) + lane * 2; an = src[0]; bn = src[1]; }
        const int e0 = (int)tk.x, e1 = (int)tk.y, p0 = (int)tk.z, p1 = (int)tk.w;
        u32x4* d0 = (u32x4*)(XP + (size_t)(s_off[e0] + p0) * D) + lane * 2; u32x4* d1 = (u32x4*)(XP + (size_t)(s_off[e1] + p1) * D) + lane * 2;
        d0[0] = a; d0[1] = b; d1[0] = a; d1[1] = b;
        a = an; b = bn; tk = tkn; r = rn;
    }
}
struct SchedMoE { const char* A; const char* B; size_t estride; int nN; const int* s_off; const int* s_tiles; int G, c; int K, lda, ldb;
    __device__ __forceinline__ bool next(int i, pg8::Unit& u) const {
        const int nwg = s_tiles[16] * nN; const long L = (long)i * G + c; if (L >= nwg) return false;
        int wgid = (int)L; { const int q = nwg / 8, r = nwg % 8, xcd = wgid % 8, off = wgid / 8; wgid = (xcd < r ? xcd * (q + 1) : r * (q + 1) + (xcd - r) * q) + off; }
        const int rt = wgid / nN; int e = 0;
        while (e < 15 && rt >= s_tiles[e + 1]) ++e;
        u.grp = __builtin_amdgcn_readfirstlane(e); u.pm = __builtin_amdgcn_readfirstlane((s_off[e] >> 8) + rt - s_tiles[e]); u.pn = __builtin_amdgcn_readfirstlane(wgid % nN); return true; }
    __device__ __forceinline__ const char* abase(const pg8::Unit& u) const { return A + (size_t)u.pm * 256 * D * 2; }
    __device__ __forceinline__ const char* bbase(const pg8::Unit& u) const { return B + (size_t)u.grp * estride + (size_t)u.pn * 256 * D * 2; } };
struct EpiE1F { bf16_t* HID;
    __device__ __forceinline__ void operator()(const f32x4 (&acc)[2][2][4][2], const pg8::Unit& u, int wr, int wc, int fr, int fq) const {
        asm volatile("" : "+v"(fr), "+v"(fq));
        const int row0 = u.pm * 256 + wr * 64 + fr, col0 = u.pn * 128 + wc * 32 + 8 * fq;
#pragma unroll
        for (int ai = 0; ai < 2; ++ai)
#pragma unroll
            for (int m = 0; m < 4; ++m) { f32x4 h0, h1;
#pragma unroll
                for (int r = 0; r < 4; ++r) { h0[r] = siluf_(acc[ai][0][m][0][r]) * acc[ai][1][m][0][r]; h1[r] = siluf_(acc[ai][0][m][1][r]) * acc[ai][1][m][1][r]; }
                *(u32x4*)(HID + (size_t)(row0 + ai * 128 + m * 16) * D + col0) = pg8::pack8(h0, h1); } } };
struct EpiE2F { bf16_t* YB;
    __device__ __forceinline__ void operator()(const f32x4 (&acc)[2][2][4][2], const pg8::Unit& u, int wr, int wc, int fr, int fq) const {
        bf16_t* base = YB + u.pn * 256;
        pg8::for_each_piece(acc, u, wr, wc, fr, fq, [&](int row, int col, f32x4 v0, f32x4 v1) { *(u32x4*)(base + (size_t)row * D + col) = pg8::pack8(v0, v1); }); } };
__device__ __forceinline__ void phase_e1_f(const Params& p, int l, char* lds, int bid, int nb) {
    int* s_cnt = (int*)(lds + LDS_TAB_OFF); int* s_off = s_cnt + 16; int* s_tiles = s_off + 16;
    expert_offsets((const unsigned*)(p.ws + WS_CTL) + CW_CNT + l * 16, s_cnt, s_off, s_tiles);
    SchedMoE S{(const char*)(p.ws + B_XP), (const char*)(p.ws + W_G_T), (size_t)2048 * D * 2, 8, s_off, s_tiles, nb, bid, D, D, D};
    pg8::gemm_phase((PG8_LAS unsigned char*)lds, S, EpiE1F{(bf16_t*)(p.ws + B_HID)});
}
__device__ __forceinline__ void phase_e2_f(const Params& p, int l, char* lds, int bid, int nb) {
    int* s_cnt = (int*)(lds + LDS_TAB_OFF); int* s_off = s_cnt + 16; int* s_tiles = s_off + 16;
    expert_offsets((const unsigned*)(p.ws + WS_CTL) + CW_CNT + l * 16, s_cnt, s_off, s_tiles);
    SchedMoE S{(const char*)(p.ws + B_HID), (const char*)(p.ws + W_D_T), (size_t)D * D * 2, 4, s_off, s_tiles, nb, bid, D, D, D};
    pg8::gemm_phase((PG8_LAS unsigned char*)lds, S, EpiE2F{(bf16_t*)(p.ws + B_YB)});
}

__device__ __forceinline__ void phase_combine(const Params& p, int l, char* lds, int bid, int nb) {
    const int tid = TIDX, wid = tid >> 6, lane = tid & 63, gw = bid * NW + wid, ngw = nb * NW;
    const bool last = (l == DEPTH - 1);
    if (!last) { convert_weights(p, l + 1, lds, gw, ngw, wid, lane); __syncthreads(); }
    int* s_cnt = (int*)(lds + 65536); int* s_off = s_cnt + 16; int* s_tiles = s_off + 16;
    expert_offsets((const unsigned*)(p.ws + WS_CTL) + CW_CNT + l * 16, s_cnt, s_off, s_tiles);
    float* g8 = (float*)lds;
    if (!last) load_gate_w(p, l + 1, g8);
    const bf16_t* H1 = (const bf16_t*)(p.ws + B_H1); const bf16_t* YB = (const bf16_t*)(p.ws + B_YB); bf16_t* H = (bf16_t*)(p.ws + B_H);
    const float* topk = (const float*)(p.ws + TAB_TOPK);
    for (int r = gw; r < P; r += ngw) {
        if (r < VALID0) { if (!last) { store_row_zero(H + (size_t)r * D, lane); gates_row_pad(p, r, lane); } continue; }
        if (last && r < 256) continue;
        const float* tk = topk + (size_t)r * 8;
        const int e0 = ((const int*)tk)[0], e1 = ((const int*)tk)[1], p0 = ((const int*)tk)[2], p1 = ((const int*)tk)[3]; const float w0 = tk[4], w1 = tk[5];
        const bf16_t* y0 = YB + (size_t)(s_off[e0] + p0) * D; const bf16_t* y1 = YB + (size_t)(s_off[e1] + p1) * D; const bf16_t* hr = H1 + (size_t)r * D;
        f32x4 v[4];
#pragma unroll
        for (int j = 0; j < 4; ++j) { const int cc = 4 * lane + 256 * j; const u32x2 a = *(const u32x2*)(y0 + cc), b = *(const u32x2*)(y1 + cc), hh = *(const u32x2*)(hr + cc);
            v[j].x = DN_ALPHA * bf2f(hh.x & 0xffffu) + w0 * bf2f(a.x & 0xffffu) + w1 * bf2f(b.x & 0xffffu);
            v[j].y = DN_ALPHA * bf2f(hh.x >> 16) + w0 * bf2f(a.x >> 16) + w1 * bf2f(b.x >> 16);
            v[j].z = DN_ALPHA * bf2f(hh.y & 0xffffu) + w0 * bf2f(a.y & 0xffffu) + w1 * bf2f(b.y & 0xffffu);
            v[j].w = DN_ALPHA * bf2f(hh.y >> 16) + w0 * bf2f(a.y >> 16) + w1 * bf2f(b.y >> 16); }
        ln_normalize(v, p.in[I_LN2G] + (size_t)l * D, p.in[I_LN2B] + (size_t)l * D, lane);
        if (last) {
            float* o = p.out + (size_t)(r - 256) * D;
#pragma unroll
            for (int j = 0; j < 4; ++j) *(f32x4*)(o + 4 * lane + 256 * j) = v[j];
        } else { store_row_bf16(H + (size_t)r * D, v, lane); gates_row(p, l + 1, g8, v, r, lane); }
    }
}

#define XB_TMO      128
#define XB_XCNT(j)  (256  + 64 * (j))
#define XB_XSUB(j)  (1280 + 64 * (j))
#define XB_XGEN(j)  (2304 + 64 * (j))
#define XB_TOP      3328
#define XB_TOPGEN   3392
#define XCD_BAR_WORDS 3456
#define XB_SPIN_CAP (1u << 18)
#define LAS __attribute__((address_space(3)))

__device__ __forceinline__ unsigned xb_ld(unsigned* p)              { return __hip_atomic_load(p, __ATOMIC_RELAXED, __HIP_MEMORY_SCOPE_AGENT); }
__device__ __forceinline__ unsigned xb_add(unsigned* p, unsigned v) { return __hip_atomic_fetch_add(p, v, __ATOMIC_RELAXED, __HIP_MEMORY_SCOPE_AGENT); }
__device__ __forceinline__ unsigned xb_xcc_id() { return (unsigned)__builtin_amdgcn_s_getreg((3 << 11) | 20) & 0xFu; }
#define XB_SPIN(cond, bar) do { unsigned _sp = 0; while (cond) { __builtin_amdgcn_s_sleep(1); \
    if ((++_sp & 255u) == 0u) { if (xb_ld(&(bar)[XB_TMO])) break; if (_sp > XB_SPIN_CAP) { atomicAdd(&(bar)[XB_TMO], 1u); break; } } } } while (0)

struct XcdBarrier {
    unsigned* bar; unsigned x;
    volatile LAS unsigned* st;
};
__device__ __forceinline__ XcdBarrier xcd_barrier_post(unsigned* bar, volatile LAS unsigned* st) {
    XcdBarrier b; b.bar = bar; b.x = xb_xcc_id(); b.st = st;
    if (threadIdx.x == 0) (void)xb_add(&bar[XB_XCNT(b.x)], 1u);
    return b;
}
__device__ __forceinline__ void xcd_barrier_complete(unsigned* bar, unsigned x, unsigned& nloc, unsigned& nx) {
    const unsigned G = gridDim.x * gridDim.y * gridDim.z;
    unsigned sum, cnt, mine, sp = 0u;
    for (;;) {
        sum = 0u; cnt = 0u; mine = 0u;
#pragma unroll
        for (unsigned j = 0; j < 16; ++j) { const unsigned c = xb_ld(&bar[XB_XCNT(j)]); sum += c; cnt += (c > 0u) ? 1u : 0u; mine = (j == x) ? c : mine; }
        if (sum == G) break;
        __builtin_amdgcn_s_sleep(1);
        if ((++sp & 255u) == 0u) { if (xb_ld(&bar[XB_TMO])) break; if (sp > XB_SPIN_CAP) { atomicAdd(&bar[XB_TMO], 1u); break; } }
    }
    nloc = mine > 0u ? mine : 1u; nx = cnt > 0u ? cnt : 1u;
}
__device__ __forceinline__ void xcd_barrier(const XcdBarrier& b) {
    asm volatile("s_waitcnt vmcnt(0)" ::: "memory");
    __syncthreads();
    if (threadIdx.x == 0) {
        unsigned* bar = b.bar;
        __builtin_amdgcn_s_waitcnt(0);
        unsigned nloc = b.st[0], nx = b.st[1];
        if (nloc == 0u) { xcd_barrier_complete(bar, b.x, nloc, nx); b.st[0] = nloc; b.st[1] = nx; }
        const unsigned old = xb_add(&bar[XB_XSUB(b.x)], 1u);
        const unsigned gen = old / nloc;
        if (old + 1u == (gen + 1u) * nloc) {
            __builtin_amdgcn_fence(__ATOMIC_RELEASE, "agent");
            asm volatile("s_waitcnt vmcnt(0)" ::: "memory");
            const unsigned og = xb_add(&bar[XB_TOP], 1u);
            const unsigned tg = og / nx;
            if (og + 1u == (tg + 1u) * nx) xb_add(&bar[XB_TOPGEN], 1u);
            else XB_SPIN(xb_ld(&bar[XB_TOPGEN]) == tg, bar);
            __builtin_amdgcn_fence(__ATOMIC_ACQUIRE, "agent");
            xb_add(&bar[XB_XGEN(b.x)], 1u);
            asm volatile("s_waitcnt vmcnt(0)" ::: "memory");
        } else {
            XB_SPIN(xb_ld(&bar[XB_XGEN(b.x)]) == gen, bar);
            __builtin_amdgcn_fence(__ATOMIC_ACQUIRE, "agent");
            asm volatile("s_waitcnt vmcnt(0)" ::: "memory");
        }
    }
    __syncthreads();
}

constexpr int LDS_BYTES = 131072 + 12288;
constexpr int LDS_BAR_OFF = LDS_BYTES - 16;
constexpr int CW_BAR = 4096;
template <int L>
__device__ __forceinline__ void layer_body(const Params& p, char* lds, int bid, int nb, const XcdBarrier& bar) {
    phase_proj_f(p, lds, bid, nb); xcd_barrier(bar);
    phase_attn_f(p, L, lds, bid, nb); xcd_barrier(bar);
    phase_conv(p, L, lds, bid, nb); xcd_barrier(bar);
    phase_mqkv_f(p, lds, bid, nb); xcd_barrier(bar);
    phase_ms(p, lds, bid, nb); phase_sg(p, lds, bid, nb); xcd_barrier(bar);
    phase_m2(p, lds, bid, nb); xcd_barrier(bar);
    phase_o1(p, lds, bid, nb); xcd_barrier(bar);
    phase_o2(p, L, lds, bid, nb); xcd_barrier(bar);
    phase_br_f(p, lds, bid, nb); xcd_barrier(bar);
    phase_out_f(p, lds, bid, nb); xcd_barrier(bar);
    phase_ln1(p, L, lds, bid, nb); xcd_barrier(bar);
    phase_perm(p, L, lds, bid, nb); xcd_barrier(bar);
    phase_e1_f(p, L, lds, bid, nb); xcd_barrier(bar);
    phase_e2_f(p, L, lds, bid, nb); xcd_barrier(bar);
    phase_combine(p, L, lds, bid, nb); if (L + 1 < DEPTH) xcd_barrier(bar);
}
__global__ void __launch_bounds__(NT, 2) fwd_kernel(Params p) {
    extern __shared__ __attribute__((aligned(16))) char lds[];
    const int bid = blockIdx.x, nb = gridDim.x;
    if (threadIdx.x == 0) *(uint4*)(lds + LDS_BAR_OFF) = make_uint4(0u, 0u, 0u, 0u);
    __syncthreads();
    XcdBarrier bar = xcd_barrier_post((unsigned*)(p.ws + WS_CTL) + CW_BAR, (volatile LAS unsigned*)(lds + LDS_BAR_OFF));
    phase_prologue(p, lds, bid, nb); xcd_barrier(bar);
    layer_body<0>(p, lds, bid, nb, bar);
    layer_body<1>(p, lds, bid, nb, bar);
}

extern "C" void kernel_launch(void* const* d_in, const int* in_sizes, int n_in, void* d_out, int out_size, void* d_ws, size_t ws_size, hipStream_t stream) {
    if (n_in != 30 || ws_size < WS_END) { fprintf(stderr, "kernel_launch: unexpected n_in %d or ws_size %zu (< %zu)\n", n_in, ws_size, (size_t)WS_END); return; }
    static int grid = 0;
    if (grid == 0) {
        int dev = 0, cus = 0;
        if (hipGetDevice(&dev) != hipSuccess || hipDeviceGetAttribute(&cus, hipDeviceAttributeMultiprocessorCount, dev) != hipSuccess || cus <= 0) cus = 256;
        (void)hipFuncSetAttribute((const void*)fwd_kernel, hipFuncAttributeMaxDynamicSharedMemorySize, LDS_BYTES);
        grid = cus;
    }
    Params p{};
    for (int i = 0; i < 30; ++i) p.in[i] = (const float*)d_in[i];
    p.out = (float*)d_out; p.ws = (unsigned char*)d_ws;
    (void)hipMemsetAsync((char*)d_ws + WS_CTL, 0, CTL_BYTES, stream);
    hipLaunchKernelGGL(fwd_kernel, dim3(grid), dim3(NT), LDS_BYTES, stream, p);
}
```

```cpp
#include <hip/hip_runtime.h>
#include <cstdio>
#include <cstdint>

constexpr int D = 1024;
constexpr int SEQ = 16384;
constexpr int NMETA = 16;
constexpr int P = 16640;
constexpr int VALID0 = 240;
constexpr int DEPTH = 2;
constexpr int DIN = 7176;
constexpr int NSC = 65;
constexpr int NEXP = 16;
constexpr float LN_EPS = 1e-5f;
constexpr float DN_ALPHA = 1.4142135623730951f;
constexpr float NEGBIG = -1e30f;
constexpr float QA_PRESCALE = 0.18033688011112042f;
constexpr int NT = 512;
constexpr int NW = 8;

typedef unsigned short bf16_t;
typedef short bf16x8 __attribute__((ext_vector_type(8)));
typedef float f32x4 __attribute__((ext_vector_type(4)));
typedef unsigned u32x4 __attribute__((ext_vector_type(4)));
typedef unsigned u32x2 __attribute__((ext_vector_type(2)));

constexpr size_t MiB = 1u << 20;
constexpr size_t RB = (size_t)P * D * 2;
constexpr size_t WS_CTL = 0;
constexpr size_t CTL_BYTES = 1 * MiB;
constexpr size_t WS_TAB = 1 * MiB;
constexpr size_t TAB_GLI = WS_TAB;
constexpr size_t TAB_GLF = TAB_GLI + 4 * P * 4;
constexpr size_t TAB_B   = TAB_GLF + 4 * P * 4;
constexpr size_t TAB_E   = TAB_B + 4 * P * 4;
constexpr size_t TAB_PM  = TAB_E + 4 * P * 4;
constexpr size_t TAB_W   = TAB_PM + 4 * P * 4;
constexpr size_t TAB_SCG = TAB_W + 4 * P * 4;
constexpr size_t TAB_SCM = TAB_SCG + 4096;
constexpr size_t TAB_MT  = TAB_SCM + 4096;
constexpr size_t TAB_NT  = TAB_MT + 4096;
constexpr size_t TAB_TOPK = TAB_NT + (size_t)NSC * 4 * 256 * 4;
constexpr size_t TAB_ELIST = TAB_TOPK + (size_t)P * 32;
constexpr size_t TAB_DENP = TAB_ELIST + (size_t)NEXP * P * 4;
constexpr size_t TAB_DENI = TAB_DENP + (size_t)P * 16 * 4;
constexpr size_t TAB_END = TAB_DENI + (size_t)P * 4 * 4;
static_assert(TAB_END <= 8 * MiB, "tables");
constexpr size_t WS_W = 8 * MiB;
constexpr size_t W_IN_T = WS_W;
constexpr size_t W_Q_T = W_IN_T + (size_t)7168 * 1024 * 2;
constexpr size_t W_K_T = W_Q_T + 4 * 65536 * 2;
constexpr size_t W_V_T = W_K_T + 4 * 65536 * 2;
constexpr size_t W_BM_T = W_V_T + 4 * 65536 * 2;
constexpr size_t W_BA_T = W_BM_T + (size_t)D * D * 2;
constexpr size_t W_OUT_T = W_BA_T + (size_t)D * D * 2;
constexpr size_t W_G_T = W_OUT_T + (size_t)D * D * 2;
constexpr size_t W_U_T = W_G_T + (size_t)NEXP * D * D * 2;
constexpr size_t W_D_T = W_U_T + (size_t)NEXP * D * D * 2;
constexpr size_t W_END = W_D_T + (size_t)NEXP * D * D * 2;
static_assert(W_END <= 128 * MiB, "weights");
constexpr size_t WS_SLOT = 128 * MiB;
constexpr size_t SLOT(int i) { return WS_SLOT + (size_t)i * RB; }
constexpr size_t WS_END = WS_SLOT + 12 * RB;
constexpr size_t B_H = SLOT(0);
constexpr size_t B_XM = SLOT(1), B_PM = SLOT(1);
constexpr size_t B_OP = SLOT(2), B_MRGB = SLOT(2);
constexpr size_t B_QA = SLOT(3), B_QM = SLOT(3), B_MRG = SLOT(3);
constexpr size_t B_KA = SLOT(4), B_XC = SLOT(4), B_CT = SLOT(4);
constexpr size_t B_KM = SLOT(5), B_OI = SLOT(5), B_H1 = SLOT(5);
constexpr size_t B_GA = SLOT(6);
constexpr size_t B_GB = SLOT(7);
constexpr size_t B_YA = SLOT(8);
constexpr size_t B_KMT = SLOT(9), B_YM = SLOT(9);
constexpr size_t B_VA = SLOT(10), B_VMT = SLOT(10);
constexpr size_t B_VWT = SLOT(11);
constexpr size_t B_Z = SLOT(10);
constexpr size_t B_HID = SLOT(6);
constexpr size_t B_XP = SLOT(1);
constexpr size_t B_YB = SLOT(9);
constexpr int HID_ROWS_MAX = (int)(3 * RB / (D * 2));
constexpr int CW_CNT = 64;

struct Params {
    const float* in[30];
    float* out;
    unsigned char* ws;
};
enum { I_X = 0, I_META, I_LNG, I_LNB, I_WIN, I_CONVW, I_CONVB, I_WQM, I_WKM, I_WVM, I_BI, I_BF, I_MNG, I_LQ1, I_LK1, I_LQ2, I_LK2, I_ANG,
       I_WBM, I_WBA, I_WOUT, I_LN1G, I_LN1B, I_LN2G, I_LN2B, I_WR, I_RB, I_WG, I_WU, I_WD };

__device__ __forceinline__ int tid_opaque() { int t = threadIdx.x; asm volatile("" : "+v"(t)); return t; }
#define TIDX tid_opaque()
__device__ __forceinline__ float bf2f(unsigned v) { return __uint_as_float(v << 16); }
__device__ __forceinline__ unsigned f2bf(float f) { unsigned u = __float_as_uint(f); return (u + 0x7fffu + ((u >> 16) & 1u)) >> 16; }
__device__ __forceinline__ unsigned pk2(float lo, float hi) { return f2bf(lo) | (f2bf(hi) << 16); }
template <int M> __device__ __forceinline__ float sx(float v) {
    static_assert(M == 1 || M == 2 || M == 4 || M == 8 || M == 16, "sx: xor mask within 32 lanes");
    return __int_as_float(__builtin_amdgcn_ds_swizzle(__float_as_int(v), 0x1f | (M << 10)));
}
__device__ __forceinline__ float sum32(float v) {
    auto rr = __builtin_amdgcn_permlane32_swap(__float_as_uint(v), __float_as_uint(v), false, false);
    return __uint_as_float(rr[0]) + __uint_as_float(rr[1]);
}
__device__ __forceinline__ float wave_sum(float v) {
    v += sx<1>(v); v += sx<2>(v); v += sx<4>(v); v += sx<8>(v); v += sx<16>(v); v = sum32(v);
    return v;
}
__device__ __forceinline__ float sigmoidf_(float x) { return 1.f / (1.f + __expf(-x)); }
__device__ __forceinline__ float siluf_(float x) { return x / (1.f + __expf(-x)); }
__device__ __forceinline__ float logsigmoidf_(float x) { return x >= 0.f ? -log1pf(__expf(-x)) : x - log1pf(__expf(x)); }
__device__ __forceinline__ f32x4 sig4(f32x4 v) { f32x4 o; o.x = sigmoidf_(v.x); o.y = sigmoidf_(v.y); o.z = sigmoidf_(v.z); o.w = sigmoidf_(v.w); return o; }
__device__ __forceinline__ f32x4 mfma16(bf16x8 a, bf16x8 b, f32x4 c) { return __builtin_amdgcn_mfma_f32_16x16x32_bf16(a, b, c, 0, 0, 0); }
__device__ __forceinline__ bf16x8 ld8(const bf16_t* p) { return *(const bf16x8*)p; }

__device__ __forceinline__ void transpose_item(const float* W, int K, size_t ldsrc, int k0, int n_src0, bf16_t* WT, int dst_row0, float* scr, int lane) {
#pragma unroll 8
    for (int i = 0; i < 32; ++i) { const int kk = 2 * i + (lane >> 5); scr[kk * 33 + (lane & 31)] = W[(size_t)(k0 + kk) * ldsrc + n_src0 + (lane & 31)]; }
    __builtin_amdgcn_wave_barrier();
    asm volatile("s_waitcnt lgkmcnt(0)" ::: "memory");
    const int c = lane & 7;
#pragma unroll
    for (int j = 0; j < 4; ++j) { const int n = (lane >> 3) + 8 * j; const float* s = scr + (8 * c) * 33 + n;
        u32x4 o; o.x = pk2(s[0 * 33], s[1 * 33]); o.y = pk2(s[2 * 33], s[3 * 33]); o.z = pk2(s[4 * 33], s[5 * 33]); o.w = pk2(s[6 * 33], s[7 * 33]);
        *(u32x4*)(WT + (size_t)(dst_row0 + n) * K + k0 + 8 * c) = o; }
    asm volatile("s_waitcnt lgkmcnt(0)" ::: "memory");
    __builtin_amdgcn_wave_barrier();
}
__device__ __forceinline__ void convert_weights(const Params& p, int l, char* lds, int gw, int ngw, int wid, int lane) {
    float* scr = (float*)lds + wid * (64 * 33);
    unsigned char* ws = p.ws;
    constexpr int I_IN = 16 * 224, I_QKV = 3 * 4 * 4 * 8, I_SQ = 16 * 32, I_EXP = 3 * 16 * 512;
    constexpr int TOTAL = I_IN + I_QKV + 3 * I_SQ + I_EXP;
    for (int it = gw; it < TOTAL; it += ngw) {
        int r = it;
        if (r < I_IN) { const int kb = r / 224, nb = r % 224, r0 = nb * 32, nsrc = r0 < 2048 ? r0 : r0 + 8;
            transpose_item(p.in[I_WIN] + (size_t)l * D * DIN, D, DIN, kb * 64, nsrc, (bf16_t*)(ws + W_IN_T), r0, scr, lane); continue; }
        r -= I_IN;
        if (r < I_QKV) { const int w = r / 128, rr = r % 128, h = rr / 32, t = rr % 32, kb = t / 8, nb = t % 8;
            const float* src = p.in[w == 0 ? I_WQM : (w == 1 ? I_WKM : I_WVM)] + ((size_t)l * 4 + h) * 65536;
            bf16_t* dst = (bf16_t*)(ws + (w == 0 ? W_Q_T : (w == 1 ? W_K_T : W_V_T))) + (size_t)h * 65536;
            transpose_item(src, 256, 256, kb * 64, nb * 32, dst, nb * 32, scr, lane); continue; }
        r -= I_QKV;
        if (r < 3 * I_SQ) { const int w = r / I_SQ, t = r % I_SQ, kb = t / 32, nb = t % 32;
            const float* src = p.in[w == 0 ? I_WBM : (w == 1 ? I_WBA : I_WOUT)] + (size_t)l * D * D;
            bf16_t* dst = (bf16_t*)(ws + (w == 0 ? W_BM_T : (w == 1 ? W_BA_T : W_OUT_T)));
            transpose_item(src, D, D, kb * 64, nb * 32, dst, nb * 32, scr, lane); continue; }
        r -= 3 * I_SQ;
        { const int w = r / (16 * 512), rr = r % (16 * 512), e = rr / 512, t = rr % 512, kb = t / 32, nb = t % 32;
            const float* src = p.in[w == 0 ? I_WG : (w == 1 ? I_WU : I_WD)] + ((size_t)l * NEXP + e) * D * D;
            if (w == 2) transpose_item(src, D, D, kb * 64, nb * 32, (bf16_t*)(ws + W_D_T) + (size_t)e * D * D, nb * 32, scr, lane);
            else { const int j0 = nb * 32; transpose_item(src, D, D, kb * 64, j0, (bf16_t*)(ws + W_G_T) + (size_t)e * 2048 * D, 256 * (j0 >> 7) + (j0 & 127) + (w == 1 ? 128 : 0), scr, lane); } }
    }
}

__device__ __forceinline__ void ln_normalize(f32x4 (&v)[4], const float* g, const float* b, int lane) {
    float s = 0.f;
#pragma unroll
    for (int j = 0; j < 4; ++j) s += (v[j].x + v[j].y) + (v[j].z + v[j].w);
    const float mean = wave_sum(s) * (1.f / D);
    float s2 = 0.f;
#pragma unroll
    for (int j = 0; j < 4; ++j) { v[j] = v[j] - mean; s2 += (v[j].x * v[j].x + v[j].y * v[j].y) + (v[j].z * v[j].z + v[j].w * v[j].w); }
    const float rstd = rsqrtf(wave_sum(s2) * (1.f / D) + LN_EPS);
#pragma unroll
    for (int j = 0; j < 4; ++j) { const f32x4 gg = *(const f32x4*)(g + 4 * lane + 256 * j), bb = *(const f32x4*)(b + 4 * lane + 256 * j); v[j] = v[j] * rstd * gg + bb; }
}
__device__ __forceinline__ void store_row_bf16(bf16_t* row, const f32x4 (&v)[4], int lane) {
#pragma unroll
    for (int j = 0; j < 4; ++j) { u32x2 o; o.x = pk2(v[j].x, v[j].y); o.y = pk2(v[j].z, v[j].w); *(u32x2*)(row + 4 * lane + 256 * j) = o; }
}
__device__ __forceinline__ void store_row_zero(bf16_t* row, int lane) {
#pragma unroll
    for (int j = 0; j < 4; ++j) { u32x2 o; o.x = 0u; o.y = 0u; *(u32x2*)(row + 4 * lane + 256 * j) = o; }
}
__device__ __forceinline__ void load_gate_w(const Params& p, int l, float* g8) {
    const float* w = p.in[I_WIN] + (size_t)l * D * DIN + 2048;
    for (int i = TIDX; i < D * 8; i += NT) { const int k = i >> 3, c = i & 7; g8[k * 8 + (k >> 2) * 4 + c] = w[(size_t)k * DIN + c]; }
    __syncthreads();
}
__device__ __forceinline__ void gates_row(const Params& p, int l, const float* g8, const f32x4 (&v)[4], int prow, int lane) {
    float acc[8];
#pragma unroll
    for (int c = 0; c < 8; ++c) acc[c] = 0.f;
#pragma unroll
    for (int j = 0; j < 4; ++j)
#pragma unroll
        for (int i = 0; i < 4; ++i) { const int k = 4 * lane + 256 * j + i; const float x = v[j][i];
            const f32x4 w0 = *(const f32x4*)(g8 + k * 8 + (k >> 2) * 4), w1 = *(const f32x4*)(g8 + k * 8 + (k >> 2) * 4 + 4);
            acc[0] += x * w0.x; acc[1] += x * w0.y; acc[2] += x * w0.z; acc[3] += x * w0.w; acc[4] += x * w1.x; acc[5] += x * w1.y; acc[6] += x * w1.z; acc[7] += x * w1.w; }
#pragma unroll
    for (int c = 0; c < 8; ++c) acc[c] = wave_sum(acc[c]);
    if (lane < 4) {
        float* gli = (float*)(p.ws + TAB_GLI); float* glf = (float*)(p.ws + TAB_GLF);
        const float bi = p.in[I_BI][l * 4 + lane], bfv = p.in[I_BF][l * 4 + lane];
        float ai = acc[0], af = acc[4];
        if (lane == 1) { ai = acc[1]; af = acc[5]; } else if (lane == 2) { ai = acc[2]; af = acc[6]; } else if (lane == 3) { ai = acc[3]; af = acc[7]; }
        gli[(size_t)lane * P + prow] = ai + bi;
        glf[(size_t)lane * P + prow] = logsigmoidf_(af + bfv);
    }
}
__device__ __forceinline__ void gates_row_pad(const Params& p, int prow, int lane) {
    if (lane < 4) { ((float*)(p.ws + TAB_GLI))[(size_t)lane * P + prow] = NEGBIG; ((float*)(p.ws + TAB_GLF))[(size_t)lane * P + prow] = 0.f; }
}

__device__ __forceinline__ void phase_prologue(const Params& p, char* lds, int bid, int nb) {
    const int tid = TIDX, wid = tid >> 6, lane = tid & 63, gw = bid * NW + wid, ngw = nb * NW;
    convert_weights(p, 0, lds, gw, ngw, wid, lane);
    __syncthreads();
    float* g8 = (float*)lds;
    load_gate_w(p, 0, g8);
    bf16_t* H = (bf16_t*)(p.ws + B_H);
    f32x4 vn[4];
#pragma unroll
    for (int j = 0; j < 4; ++j) vn[j] = (f32x4){0.f, 0.f, 0.f, 0.f};
#define PRO_SRC(r_) ((r_) < 256 ? p.in[I_META] + (size_t)((r_) - VALID0) * D : p.in[I_X] + (size_t)((r_) - 256) * D)
    if (gw >= VALID0 && gw < P) {
#pragma unroll
        for (int j = 0; j < 4; ++j) vn[j] = *(const f32x4*)(PRO_SRC(gw) + 4 * lane + 256 * j); }
    for (int r = gw; r < P; r += ngw) {
        f32x4 v[4];
#pragma unroll
        for (int j = 0; j < 4; ++j) v[j] = vn[j];
        { const int rn = r + ngw; if (rn >= VALID0 && rn < P) {
#pragma unroll
            for (int j = 0; j < 4; ++j) vn[j] = *(const f32x4*)(PRO_SRC(rn) + 4 * lane + 256 * j); } }
        if (r < VALID0) { store_row_zero(H + (size_t)r * D, lane); gates_row_pad(p, r, lane); continue; }
        ln_normalize(v, p.in[I_LNG], p.in[I_LNB], lane);
        store_row_bf16(H + (size_t)r * D, v, lane);
        gates_row(p, 0, g8, v, r, lane);
    }
}

struct RowsPlain { const bf16_t* base; size_t ld; __device__ __forceinline__ const bf16_t* row(int m) const { return base + (size_t)m * ld; } };
__device__ __forceinline__ void store4_bf16(bf16_t* dst, f32x4 v) { u32x2 o; o.x = pk2(v.x, v.y); o.y = pk2(v.z, v.w); *(u32x2*)dst = o; }

struct EpiProj { unsigned char* ws;
    __device__ __forceinline__ void operator()(int m, int n, f32x4 v) const {
        const int seg = n >> 10, cc = n & 1023;
        const size_t off = seg == 0 ? B_XM : seg == 1 ? B_OP : seg == 2 ? B_QA : seg == 3 ? B_KA : seg == 4 ? B_VA : seg == 5 ? B_GA : B_GB;
        store4_bf16((bf16_t*)(ws + off) + (size_t)m * D + cc, seg == 2 ? v * QA_PRESCALE : v); } };
struct EpiStore { bf16_t* C; size_t ldc; float scale;
    __device__ __forceinline__ void operator()(int m, int n, f32x4 v) const { store4_bf16(C + (size_t)m * ldc + n, v * scale); } };
namespace pg8 {
#define PG8_LAS __attribute__((address_space(3)))
constexpr int BM = 256, BK = 64, HALF = 128, HTB = HALF * BK * 2, STAGE_BYTES = 8 * HTB, NXCD = 8, WGM = 8;
__host__ __device__ __forceinline__ int lds_byte(int r, int c) { const int st = (r >> 4) * 2 + (c >> 5), rr = r & 15, cc = c & 31, ob = rr * 64 + cc * 2; return st * 1024 + (ob ^ (((ob >> 9) & 1) << 5)); }
__host__ __device__ __forceinline__ void stage_rc(int b, int& R, int& C) { const int st = b / 1024, sb = b % 1024, swz = sb ^ (((sb >> 9) & 1) << 5); R = (st >> 1) * 16 + swz / 64; C = (st & 1) * 32 + (swz % 64) / 2; }
__host__ __device__ __forceinline__ int perm32(int rho) { const int n = rho >> 4, i = rho & 15; return 8 * (i >> 2) + 4 * n + (i & 3); }
struct Unit { int pm, pn, grp; };
__device__ __forceinline__ bool decode_unit(long L, int nG, int nM, int nN, Unit& u) {
    const int nwg = nG * nM * nN; if (L >= nwg) return false;
    int wgid = (int)L; { const int q = nwg / NXCD, r = nwg % NXCD, xcd = wgid % NXCD, off = wgid / NXCD; wgid = (xcd < r ? xcd * (q + 1) : r * (q + 1) + (xcd - r) * q) + off; }
    const int per = nM * nN; u.grp = wgid / per; const int rem = wgid % per;
    const int nig = WGM * nN, gid = rem / nig, fm = gid * WGM, gsz = (nM - fm) < WGM ? (nM - fm) : WGM;
    u.pm = __builtin_amdgcn_readfirstlane(fm + ((rem % nig) % gsz)); u.pn = __builtin_amdgcn_readfirstlane((rem % nig) / gsz); u.grp = __builtin_amdgcn_readfirstlane(u.grp); return true;
}
__device__ __forceinline__ unsigned cvt_pk_bf16(float lo, float hi) { unsigned r; asm volatile("v_cvt_pk_bf16_f32 %0, %1, %2" : "=v"(r) : "v"(lo), "v"(hi)); return r; }

template <class Epi, class Sched, bool ALIGN_EPI = true>
__device__ __forceinline__ void gemm_phase(PG8_LAS unsigned char* lds, const Sched& S, const Epi& E) {
    const int tid = TIDX, wid = __builtin_amdgcn_readfirstlane(tid >> 6), lane = tid & 63, wr = wid >> 2, wc = wid & 3, fr = lane & 15, fq = lane >> 4;
    const int K = S.K, nt = K / BK;
    unsigned voffA[2], voffB[2];
#pragma unroll
    for (int i = 0; i < 2; ++i) { int R, C; stage_rc(tid * 16 + i * 8192, R, C); const int Rb = (R & ~31) + perm32(R & 31);
        voffA[i] = (unsigned)(R * S.lda + C) * 2u; voffB[i] = (unsigned)(Rb * S.ldb + C) * 2u; }
    const size_t kstep = (size_t)(BK * 2);
    const size_t hstepA = (size_t)HALF * S.lda * 2, hstepB = (size_t)HALF * S.ldb * 2;
    const unsigned ldsw = (unsigned)wid * 1024u;
    const int aoff = lds_byte(wr * 64 + fr, fq * 8), boff = lds_byte(wc * 32 + fr, fq * 8);
#define PG8_SA(b, h) (((b) * 2 + (h)) * HTB)
#define PG8_SB(b, h) ((4 + (b) * 2 + (h)) * HTB)
#define PG8_STAGE(bufoff, gbase, voff) do { _Pragma("unroll") for (int _i = 0; _i < 2; ++_i) \
        __builtin_amdgcn_global_load_lds((const unsigned*)((const char*)(gbase) + (voff)[_i]), (PG8_LAS unsigned*)(lds + (bufoff) + ldsw + _i * 8192), 16, 0, 0); } while (0)
#define PG8_LDA(dst, b, h) do { _Pragma("unroll") for (int m = 0; m < 4; ++m) _Pragma("unroll") for (int k = 0; k < 2; ++k) dst[m][k] = *(const PG8_LAS bf16x8*)(lds + PG8_SA(b, h) + aoff + m * 2048 + k * 1024); } while (0)
#define PG8_LDB(dst, b, h) do { _Pragma("unroll") for (int n = 0; n < 2; ++n) _Pragma("unroll") for (int k = 0; k < 2; ++k) dst[n][k] = *(const PG8_LAS bf16x8*)(lds + PG8_SB(b, h) + boff + n * 2048 + k * 1024); } while (0)
#define PG8_MMA(ai, bj, At, Bt) do { __builtin_amdgcn_s_setprio(1); _Pragma("unroll") for (int m = 0; m < 4; ++m) _Pragma("unroll") for (int n = 0; n < 2; ++n) _Pragma("unroll") for (int k = 0; k < 2; ++k) \
        acc[ai][bj][m][n] = __builtin_amdgcn_mfma_f32_16x16x32_bf16(Bt[n][k], At[m][k], acc[ai][bj][m][n], 0, 0, 0); __builtin_amdgcn_s_setprio(0); } while (0)
#define PG8_WAIT_V(n) asm volatile("s_waitcnt vmcnt(" #n ")" ::: "memory")
#define PG8_WAIT_L(n) asm volatile("s_waitcnt lgkmcnt(" #n ")" ::: "memory")
#define PG8_BAR __builtin_amdgcn_s_barrier()
#define PG8_SCHED __builtin_amdgcn_sched_barrier(0)
    Unit cur, nxt; int ui = 0;
    if (!S.next(0, cur)) return;
    f32x4 acc[2][2][4][2];
#pragma unroll
    for (int a = 0; a < 2; ++a)
#pragma unroll
        for (int b = 0; b < 2; ++b)
#pragma unroll
            for (int m = 0; m < 4; ++m)
#pragma unroll
                for (int n = 0; n < 2; ++n) acc[a][b][m][n] = (f32x4){0.f, 0.f, 0.f, 0.f};
    bf16x8 At[4][2], B0[2][2], B1[2][2];
    const char* cA = S.abase(cur); const char* cB = S.bbase(cur);
    PG8_STAGE(PG8_SB(0, 0), cB, voffB); PG8_STAGE(PG8_SB(0, 1), cB + hstepB, voffB); PG8_STAGE(PG8_SA(0, 0), cA, voffA); PG8_STAGE(PG8_SA(0, 1), cA + hstepA, voffA);
    if (wr == 1) PG8_BAR;
    PG8_WAIT_V(2); PG8_BAR;
    PG8_STAGE(PG8_SB(1, 0), cB + kstep, voffB); PG8_STAGE(PG8_SA(1, 0), cA + kstep, voffA); PG8_STAGE(PG8_SB(1, 1), cB + hstepB + kstep, voffB);
    PG8_WAIT_V(6); PG8_BAR;
    for (;;) {
        const bool has_next = S.next(ui + 1, nxt);
        const char* nA = has_next ? S.abase(nxt) : cA; const char* nB = has_next ? S.bbase(nxt) : cB;
        for (int t = 0; t < nt; t += 2) {
            const bool last = (t == nt - 2);
            const char* a1 = cA + (size_t)(t + 1) * kstep;
            const char* a2 = last ? nA : cA + (size_t)(t + 2) * kstep; const char* b2 = last ? nB : cB + (size_t)(t + 2) * kstep;
            const char* a3 = a2 + kstep; const char* b3 = b2 + kstep;
            PG8_LDB(B0, 0, 0); PG8_LDB(B1, 0, 1); PG8_SCHED; PG8_LDA(At, 0, 0); PG8_STAGE(PG8_SA(1, 1), a1 + hstepA, voffA);
            PG8_WAIT_V(8); PG8_WAIT_L(0); PG8_BAR; PG8_MMA(0, 0, At, B0); PG8_MMA(0, 1, At, B1); PG8_BAR; PG8_SCHED;
            PG8_LDA(At, 0, 1); PG8_STAGE(PG8_SB(0, 0), b2, voffB); PG8_STAGE(PG8_SB(0, 1), b2 + hstepB, voffB); PG8_STAGE(PG8_SA(0, 0), a2, voffA);
            PG8_WAIT_V(8); PG8_WAIT_L(0); PG8_BAR; PG8_MMA(1, 0, At, B0); PG8_MMA(1, 1, At, B1); PG8_BAR; PG8_SCHED;
            PG8_LDB(B0, 1, 0); PG8_LDB(B1, 1, 1); PG8_SCHED; PG8_LDA(At, 1, 0); PG8_STAGE(PG8_SA(0, 1), a2 + hstepA, voffA);
            PG8_WAIT_V(8); PG8_WAIT_L(0); PG8_BAR; PG8_MMA(0, 0, At, B0); PG8_MMA(0, 1, At, B1); PG8_BAR; PG8_SCHED;
            PG8_LDA(At, 1, 1); PG8_STAGE(PG8_SB(1, 0), b3, voffB); PG8_STAGE(PG8_SB(1, 1), b3 + hstepB, voffB); PG8_STAGE(PG8_SA(1, 0), a3, voffA);
            PG8_WAIT_V(8); PG8_WAIT_L(0); PG8_BAR; PG8_MMA(1, 0, At, B0); PG8_MMA(1, 1, At, B1); PG8_BAR; PG8_SCHED;
        }
        if constexpr (ALIGN_EPI) { if (wr == 0) PG8_BAR; }
        E(acc, cur, wr, wc, fr, fq);
        if (!has_next) break;
#pragma unroll
        for (int a = 0; a < 2; ++a)
#pragma unroll
            for (int b = 0; b < 2; ++b)
#pragma unroll
                for (int m = 0; m < 4; ++m)
#pragma unroll
                    for (int n = 0; n < 2; ++n) acc[a][b][m][n] = (f32x4){0.f, 0.f, 0.f, 0.f};
        cur = nxt; cA = nA; cB = nB; ++ui;
        if constexpr (ALIGN_EPI) { if (wr == 1) PG8_BAR; }
    }
    PG8_WAIT_V(0);
    if constexpr (!ALIGN_EPI) { if (wr == 0) PG8_BAR; }
    PG8_BAR;
#undef PG8_SA
#undef PG8_SB
#undef PG8_STAGE
#undef PG8_LDA
#undef PG8_LDB
#undef PG8_MMA
#undef PG8_WAIT_V
#undef PG8_WAIT_L
#undef PG8_BAR
#undef PG8_SCHED
}
__device__ __forceinline__ u32x4 pack8(f32x4 v0, f32x4 v1) { u32x4 w; w.x = cvt_pk_bf16(v0[0], v0[1]); w.y = cvt_pk_bf16(v0[2], v0[3]); w.z = cvt_pk_bf16(v1[0], v1[1]); w.w = cvt_pk_bf16(v1[2], v1[3]); return w; }
__device__ __forceinline__ void unpack8(u32x4 w, f32x4& v0, f32x4& v1) {
    v0[0] = __uint_as_float(w.x << 16); v0[1] = __uint_as_float(w.x & 0xffff0000u); v0[2] = __uint_as_float(w.y << 16); v0[3] = __uint_as_float(w.y & 0xffff0000u);
    v1[0] = __uint_as_float(w.z << 16); v1[1] = __uint_as_float(w.z & 0xffff0000u); v1[2] = __uint_as_float(w.w << 16); v1[3] = __uint_as_float(w.w & 0xffff0000u); }
template <class F> __device__ __forceinline__ void for_each_piece(const f32x4 (&acc)[2][2][4][2], const Unit& u, int wr, int wc, int fr, int fq, const F& f) {
    asm volatile("" : "+v"(fr), "+v"(fq));
    const int row0 = u.pm * BM + wr * 64 + fr, col0 = wc * 32 + 8 * fq;
#pragma unroll
    for (int ai = 0; ai < 2; ++ai)
#pragma unroll
        for (int m = 0; m < 4; ++m)
#pragma unroll
            for (int bj = 0; bj < 2; ++bj) f(row0 + ai * HALF + m * 16, col0 + bj * HALF, acc[ai][bj][m][0], acc[ai][bj][m][1]);
}
template <class L, class F> __device__ __forceinline__ void for_each_piece_pf(const f32x4 (&acc)[2][2][4][2], const Unit& u, int wr, int wc, int fr, int fq, const L& ld, const F& f) {
    asm volatile("" : "+v"(fr), "+v"(fq));
    const int row0 = u.pm * BM + wr * 64 + fr, col0 = wc * 32 + 8 * fq;
#pragma unroll
    for (int ai = 0; ai < 2; ++ai) {
        decltype(ld(0, 0)) pre[4][2];
#pragma unroll
        for (int m = 0; m < 4; ++m)
#pragma unroll
            for (int bj = 0; bj < 2; ++bj) pre[m][bj] = ld(row0 + ai * HALF + m * 16, col0 + bj * HALF);
#pragma unroll
        for (int m = 0; m < 4; ++m)
#pragma unroll
            for (int bj = 0; bj < 2; ++bj) f(row0 + ai * HALF + m * 16, col0 + bj * HALF, acc[ai][bj][m][0], acc[ai][bj][m][1], pre[m][bj]);
    }
}
}

template <int MI, int NJ, class AR, class BR, class Epi>
__device__ __forceinline__ void sgemm_wave(const AR& ar, const BR& br, int K, int m0, int n0, const Epi& epi) {
    const int lane = TIDX & 63, c = lane & 15, g = lane >> 4;
    const bf16_t* ap[MI]; const bf16_t* bp[NJ];
#pragma unroll
    for (int i = 0; i < MI; ++i) ap[i] = ar.row(m0 + 16 * i + c) + 8 * g;
#pragma unroll
    for (int j = 0; j < NJ; ++j) bp[j] = br.row(n0 + 16 * j + c) + 8 * g;
    f32x4 acc[MI][NJ];
#pragma unroll
    for (int i = 0; i < MI; ++i)
#pragma unroll
        for (int j = 0; j < NJ; ++j) acc[i][j] = (f32x4){0.f, 0.f, 0.f, 0.f};
#pragma unroll 4
    for (int k0 = 0; k0 < K; k0 += 32) {
        bf16x8 a[MI], b[NJ];
#pragma unroll
        for (int i = 0; i < MI; ++i) a[i] = ld8(ap[i] + k0);
#pragma unroll
        for (int j = 0; j < NJ; ++j) b[j] = ld8(bp[j] + k0);
#pragma unroll
        for (int i = 0; i < MI; ++i)
#pragma unroll
            for (int j = 0; j < NJ; ++j) acc[i][j] = mfma16(b[j], a[i], acc[i][j]);
    }
#pragma unroll
    for (int i = 0; i < MI; ++i)
#pragma unroll
        for (int j = 0; j < NJ; ++j) epi(m0 + 16 * i + c, n0 + 16 * j + 4 * g, acc[i][j]);
}
template <int MI, int NJ, class AR, class BR, class Epi>
__device__ __forceinline__ void meta_gemm(const AR& ar, const BR& br, int K, int m0, int n0, const Epi& epi, char* lds) {
    const int tid = TIDX, wid = __builtin_amdgcn_readfirstlane(tid >> 6), lane = tid & 63, c = lane & 15, g = lane >> 4;
    const int kw = K >> 3, kb = wid * kw;
    f32x4 acc[MI][NJ];
#pragma unroll
    for (int i = 0; i < MI; ++i)
#pragma unroll
        for (int j = 0; j < NJ; ++j) acc[i][j] = (f32x4){0.f, 0.f, 0.f, 0.f};
    for (int k0 = kb; k0 < kb + kw; k0 += 32) {
        bf16x8 a[MI], b[NJ];
#pragma unroll
        for (int i = 0; i < MI; ++i) a[i] = ld8(ar.row(m0 + 16 * i + c) + 8 * g + k0);
#pragma unroll
        for (int j = 0; j < NJ; ++j) b[j] = ld8(br.row(n0 + 16 * j + c) + 8 * g + k0);
#pragma unroll
        for (int i = 0; i < MI; ++i)
#pragma unroll
            for (int j = 0; j < NJ; ++j) acc[i][j] = mfma16(b[j], a[i], acc[i][j]);
    }
    f32x4* part = (f32x4*)lds;
#pragma unroll
    for (int i = 0; i < MI; ++i)
#pragma unroll
        for (int j = 0; j < NJ; ++j) part[((wid * MI + i) * NJ + j) * 64 + lane] = acc[i][j];
    __syncthreads();
    if (wid == 0) {
#pragma unroll
        for (int i = 0; i < MI; ++i)
#pragma unroll
            for (int j = 0; j < NJ; ++j) { f32x4 s = acc[i][j];
#pragma unroll
                for (int w = 1; w < 8; ++w) s += part[((w * MI + i) * NJ + j) * 64 + lane];
                epi(m0 + 16 * i + c, n0 + 16 * j + 4 * g, s); }
    }
    __syncthreads();
}
__device__ __forceinline__ void zero_block(bf16_t* base, size_t ld, int nrows, int ncols, int gtid, int gthreads) {
    const int cpr = ncols / 8;
    for (int i = gtid; i < nrows * cpr; i += gthreads) { const int r = i / cpr, cc = (i % cpr) * 8; *(u32x4*)(base + (size_t)r * ld + cc) = (u32x4){0u, 0u, 0u, 0u}; }
}

struct SchedProj { const char* A; const char* B; int G, c; int K, lda, ldb;
    __device__ __forceinline__ bool next(int i, pg8::Unit& u) const { if (!pg8::decode_unit((long)i * G + c, 1, 64, 28, u)) return false; u.pm += 1; return true; }
    __device__ __forceinline__ const char* abase(const pg8::Unit& u) const { return A + (size_t)u.pm * 256 * D * 2; }
    __device__ __forceinline__ const char* bbase(const pg8::Unit& u) const { return B + (size_t)u.pn * 256 * D * 2; } };
struct EpiProjF { unsigned char* ws;
    __device__ __forceinline__ void operator()(const f32x4 (&acc)[2][2][4][2], const pg8::Unit& u, int wr, int wc, int fr, int fq) const {
        const int colt = u.pn * 256, seg = colt >> 10;
        const size_t off = seg == 0 ? B_XM : seg == 1 ? B_OP : seg == 2 ? B_QA : seg == 3 ? B_KA : seg == 4 ? B_VA : seg == 5 ? B_GA : B_GB;
        bf16_t* base = (bf16_t*)(ws + off) + (colt & 1023); const float qs = seg == 2 ? QA_PRESCALE : 1.f;
        pg8::for_each_piece(acc, u, wr, wc, fr, fq, [&](int row, int col, f32x4 v0, f32x4 v1) { *(u32x4*)(base + (size_t)row * D + col) = pg8::pack8(v0 * qs, v1 * qs); }); } };
struct SchedVAT { const char* A; const char* B; int G, c; int K, lda, ldb;
    __device__ __forceinline__ bool next(int i, pg8::Unit& u) const { if (!pg8::decode_unit((long)i * G + c, 1, 4, 64, u)) return false; u.pn += 1; return true; }
    __device__ __forceinline__ const char* abase(const pg8::Unit& u) const { return A + (size_t)u.pm * 256 * D * 2; }
    __device__ __forceinline__ const char* bbase(const pg8::Unit& u) const { return B + (size_t)u.pn * 256 * D * 2; } };
struct EpiStoreF { bf16_t* C; size_t ldc; float scale;
    __device__ __forceinline__ void operator()(const f32x4 (&acc)[2][2][4][2], const pg8::Unit& u, int wr, int wc, int fr, int fq) const {
        bf16_t* base = C + (size_t)u.pn * 256;
        pg8::for_each_piece(acc, u, wr, wc, fr, fq, [&](int row, int col, f32x4 v0, f32x4 v1) { *(u32x4*)(base + (size_t)row * ldc + col) = pg8::pack8(v0 * scale, v1 * scale); }); } };
__device__ __forceinline__ void phase_proj_f(const Params& p, char* lds, int bid, int nb) {
    const int tid = TIDX, wid = tid >> 6, gw = bid * NW + wid, ngw = nb * NW;
    const bf16_t* H = (const bf16_t*)(p.ws + B_H); const bf16_t* W = (const bf16_t*)(p.ws + W_IN_T);
    zero_block((bf16_t*)(p.ws + B_KA), D, VALID0, D, bid * NT + tid, nb * NT);
    zero_block((bf16_t*)(p.ws + B_VA), D, VALID0, D, bid * NT + tid, nb * NT);
    zero_block((bf16_t*)(p.ws + B_XM), D, VALID0, D, bid * NT + tid, nb * NT);
    for (int t = bid; t < 112; t += nb) meta_gemm<1, 4>(RowsPlain{H, D}, RowsPlain{W, D}, D, VALID0, t * 64, EpiProj{p.ws}, lds);
    { SchedProj S{(const char*)H, (const char*)W, nb, bid, D, D, D};
      pg8::gemm_phase(( PG8_LAS unsigned char*)lds, S, EpiProjF{p.ws}); }
}

namespace fd {
typedef short s16x4 __attribute__((ext_vector_type(4)));
typedef __attribute__((address_space(3))) unsigned LU;
constexpr int KVBLK = 64, SHM_V = 64 * 128 * 2, SHM_K = 64 * 64 * 2, PITCH = 1024, XCH = 16 * 1024;
constexpr float THR2 = 8.f * 1.4426950408889634f;
constexpr float TSUM = 16384.f;
#define FC_SBAR() __builtin_amdgcn_sched_barrier(0)
__device__ __forceinline__ unsigned cvtpk(float lo, float hi) { unsigned r; asm volatile("v_cvt_pk_bf16_f32 %0, %1, %2" : "=v"(r) : "v"(lo), "v"(hi)); return r; }
__device__ __forceinline__ float max_g(float v) {
    v = fmaxf(v, sx<16>(v));
    auto rr = __builtin_amdgcn_permlane32_swap(__float_as_uint(v), __float_as_uint(v), false, false);
    return fmaxf(__uint_as_float(rr[0]), __uint_as_float(rr[1]));
}
__device__ __forceinline__ float sum_g(float v) { v += sx<16>(v); return sum32(v); }
__device__ __forceinline__ int lane_id() { return (int)__builtin_amdgcn_mbcnt_hi(~0u, __builtin_amdgcn_mbcnt_lo(~0u, 0u)); }
__device__ __forceinline__ void attn_pass(const bf16_t* Qp, const bf16_t* Kp, const bf16_t* Vp, int P0, int NT, char* lds, f32x4 (&o)[4][8], float (&lsum)[4]) {
    const int tid = TIDX, wid = __builtin_amdgcn_readfirstlane(tid >> 6), lane = tid & 63, c = lane & 15, g = lane >> 4;
    const int h = wid >> 2, qlo = P0 + (wid & 3) * 64;
    char* V_lds = lds; char* K_lds = lds + 2 * SHM_V;
#pragma unroll
    for (int qg = 0; qg < 4; ++qg) { lsum[qg] = 0.f;
#pragma unroll
        for (int dt = 0; dt < 8; ++dt) o[qg][dt] = (f32x4){0.f, 0.f, 0.f, 0.f}; }
    unsigned ksrc, vsrc0;
    { const int r = 8 * wid + (lane >> 3), cp = lane & 7, sw = (((r >> 3) & 3) << 1) | ((r >> 1) & 1); ksrc = (unsigned)(r * PITCH + ((cp ^ sw) << 3)) * 2u; }
    { const int pos = wid * 1024 + lane * 16, row = 8 * (pos >> 11) + ((pos >> 6) & 7), ch = 4 * ((pos >> 9) & 3) + (((pos >> 4) & 3) ^ ((row >> 2) & 3)); vsrc0 = (unsigned)(row * PITCH + ch * 8) * 2u; }
    const unsigned kdst = (unsigned)(2 * SHM_V) + (unsigned)wid * 1024u, vdst0 = (unsigned)wid * 1024u, vdst1 = (unsigned)(8 + wid) * 1024u;
    const int ksw = ((c >> 2) << 1) | ((c & 3) >> 1);
    const int krow = SHM_K * h + 1024 * (c >> 2) + 128 * (c & 3);
    const int ka0 = krow + ((g ^ ksw) << 4), ka1 = krow + (((4 + g) ^ ksw) << 4);
    const int q4 = c >> 2, p4 = c & 3, ph = p4 >> 1;
    const int vbt0 = 2048 * g + 64 * q4 + 16 * ph + 8 * (p4 & 1), vbt1 = 2048 * g + 256 + 64 * q4 + 16 * (ph ^ 1) + 8 * (p4 & 1);
    const int vlds = (int)(uintptr_t)V_lds;
    const int vb_t0e = vlds + vbt0 + 32 * (g & 1), vb_t0o = vlds + vbt0 + 32 - 32 * (g & 1), vb_t1e = vlds + vbt1 + 32 * (g & 1), vb_t1o = vlds + vbt1 + 32 - 32 * (g & 1);
    bf16x8 qf[4][2];
#pragma unroll
    for (int qg = 0; qg < 4; ++qg)
#pragma unroll
        for (int ks = 0; ks < 2; ++ks) qf[qg][ks] = ld8(Qp + (size_t)(qlo + 16 * qg + c) * PITCH + 64 * h + 32 * ks + 8 * g);
#define FC_DMA(t, B) do { const size_t go_ = (size_t)(3 + (t)) * KVBLK * PITCH; const char* kt_ = (const char*)(Kp + go_); const char* vt_ = (const char*)(Vp + go_);  \
        __builtin_amdgcn_global_load_lds((const unsigned*)(kt_ + ksrc), (LU*)(lds + kdst + (B) * 2 * SHM_K), 16, 0, 0);                                         \
        __builtin_amdgcn_global_load_lds((const unsigned*)(kt_ + 128 + ksrc), (LU*)(lds + kdst + (B) * 2 * SHM_K + SHM_K), 16, 0, 0);                           \
        __builtin_amdgcn_global_load_lds((const unsigned*)(vt_ + vsrc0), (LU*)(lds + vdst0 + (B) * SHM_V), 16, 0, 0);                                           \
        __builtin_amdgcn_global_load_lds((const unsigned*)(vt_ + 32 * PITCH * 2 + vsrc0), (LU*)(lds + vdst1 + (B) * SHM_V), 16, 0, 0); } while (0)
#define FC_WAITBAR() do { asm volatile("s_waitcnt vmcnt(0) lgkmcnt(0)" ::: "memory"); __builtin_amdgcn_s_barrier(); asm volatile("" ::: "memory"); } while (0)
#define FC_TRRD(dst, base, off) asm volatile("ds_read_b64_tr_b16 %0, %1 offset:%2" : "=&v"(dst) : "v"(base), "i"(off) : "memory")
#define FC_PV2(BUF, KK, dt0) do { s16x4 a0, a1, b0, b1; constexpr int o_ = (BUF) * SHM_V + 8192 * (KK) + 512 * ((dt0) >> 1);                                              \
        FC_TRRD(a0, vb_t0e, o_); FC_TRRD(a1, vb_t1e, o_); FC_TRRD(b0, vb_t0o, o_); FC_TRRD(b1, vb_t1o, o_);                                                     \
        asm volatile("s_waitcnt lgkmcnt(0)" ::: "memory"); FC_SBAR();                                                                                            \
        { const bf16x8 f0 = (bf16x8){a0[0], a0[1], a0[2], a0[3], a1[0], a1[1], a1[2], a1[3]}, f1 = (bf16x8){b0[0], b0[1], b0[2], b0[3], b1[0], b1[1], b1[2], b1[3]};      \
          _Pragma("unroll") for (int qg = 0; qg < 4; ++qg) o[qg][dt0] = mfma16(f0, pf[qg], o[qg][dt0]);                                                         \
          _Pragma("unroll") for (int qg = 0; qg < 4; ++qg) o[qg][(dt0) + 1] = mfma16(f1, pf[qg], o[qg][(dt0) + 1]); } } while (0)
#define FC_QK(BUF, KK) do { _Pragma("unroll") for (int a = 0; a < 2; ++a) { const char* kp = K_lds + (BUF) * 2 * SHM_K + 4096 * (KK) + 512 * a;                      \
              const bf16x8 k0 = *(const bf16x8*)(kp + ka0), k1 = *(const bf16x8*)(kp + ka1);                                                                    \
              _Pragma("unroll") for (int qp = 0; qp < 4; qp += 2) {                                                                                              \
                  s[qp][a] = mfma16(k0, qf[qp][0], nv); s[qp + 1][a] = mfma16(k0, qf[qp + 1][0], nv);                                                            \
                  s[qp][a] = mfma16(k1, qf[qp][1], s[qp][a]); s[qp + 1][a] = mfma16(k1, qf[qp + 1][1], s[qp + 1][a]); } } } while (0)
#define FC_MASK(t) do { if ((t) == 0 || kh + 31 > qlo) { const float NEG = -__builtin_inff(); const int ln_ = lane_id(), c_ = ln_ & 15, g_ = ln_ >> 4;                \
            _Pragma("unroll") for (int qg = 0; qg < 4; ++qg) { const int pos = qlo + 16 * qg + c_;                                                              \
                _Pragma("unroll") for (int a = 0; a < 2; ++a) _Pragma("unroll") for (int r = 0; r < 4; ++r) { const int key = kh + 8 * g_ + 4 * a + r;           \
                    if (key > pos || key < VALID0) s[qg][a][r] = NEG; } } } } while (0)
#define FC_EXPSUM() do { _Pragma("unroll") for (int qg = 0; qg < 4; ++qg) { float ps_ = 0.f;                                                                         \
            _Pragma("unroll") for (int a = 0; a < 2; ++a) _Pragma("unroll") for (int r = 0; r < 4; ++r) { const float e = __builtin_amdgcn_exp2f(s[qg][a][r]); s[qg][a][r] = e; ps_ += e; } \
            ps[qg] = ps_; } } while (0)
#define FC_HALF(t, BUF, KK) do {                                                                                                                             \
        const int kh = (3 + (t)) * KVBLK + 32 * (KK);                                                                                                            \
        if (kh <= qlo + 63 && !((t) == 0 && (KK) == 0)) {                                                                      \
        FC_SBAR();                                                                                                                                               \
        f32x4 s[4][2]; float ps[4];                                                                                                                              \
        const bool adopt = (t) == 0 && (KK) == 1;                                                  \
        bool exact = adopt;                                                                                                                                      \
        for (;;) {                                                                                \
            FC_QK(BUF, KK); FC_MASK(t);                                                                                                                          \
            if (exact) {                                                                                                                                         \
                float v = fmaxf(s[0][0][0], s[0][1][0]);                                                                                                         \
                _Pragma("unroll") for (int qg = 0; qg < 4; ++qg) _Pragma("unroll") for (int r = 0; r < 4; ++r) v = fmaxf(v, fmaxf(s[qg][0][r], s[qg][1][r]));           \
                const float pm = max_g(v);                                                                                                                       \
                const float delta = adopt ? (pm > -1e30f ? pm : 0.f) : fmaxf(pm, 0.f);                                                                           \
                m2s += delta; nv = (f32x4){-m2s, -m2s, -m2s, -m2s};                                                                                              \
                _Pragma("unroll") for (int qg = 0; qg < 4; ++qg) { s[qg][0] = s[qg][0] - delta; s[qg][1] = s[qg][1] - delta; }                                   \
                if (!adopt) { const float al_ = __builtin_amdgcn_exp2f(-delta);                                                                                  \
                    _Pragma("unroll") for (int qg = 0; qg < 4; ++qg) { lsum[qg] *= al_;                                                                          \
                        _Pragma("unroll") for (int dt = 0; dt < 8; ++dt) o[qg][dt] = o[qg][dt] * al_; } } }                                                      \
            FC_EXPSUM();                                                                                                                                         \
            if (exact || __all(fmaxf(fmaxf(ps[0], ps[1]), fmaxf(ps[2], ps[3])) <= TSUM)) break;                                                                  \
            exact = true; }                                                                                                                                      \
        bf16x8 pf[4];                                                                                                                                            \
        _Pragma("unroll") for (int qg = 0; qg < 4; ++qg) { lsum[qg] += ps[qg];                                                                                   \
            u32x4 w; w.x = cvtpk(s[qg][0][0], s[qg][0][1]); w.y = cvtpk(s[qg][0][2], s[qg][0][3]); w.z = cvtpk(s[qg][1][0], s[qg][1][1]); w.w = cvtpk(s[qg][1][2], s[qg][1][3]); \
            pf[qg] = *(bf16x8*)&w; }                                                                                                                             \
        FC_SBAR();                                                                                                                                               \
        FC_PV2(BUF, KK, 0); FC_PV2(BUF, KK, 2); FC_PV2(BUF, KK, 4); FC_PV2(BUF, KK, 6);                                                                          \
        } } while (0)
#define FC_TILE(t, BUF) do {                                                                                                                                     \
        if ((t) + 1 < NT) FC_DMA((t) + 1, (BUF) ^ 1);                                                                                                            \
        FC_HALF(t, BUF, 0); FC_HALF(t, BUF, 1);                                                                                                                  \
        FC_WAITBAR(); } while (0)
    float m2s = 0.f; f32x4 nv = (f32x4){0.f, 0.f, 0.f, 0.f};
    FC_DMA(0, 0); FC_WAITBAR();
    for (int t = 0; t < NT; t += 2) { FC_TILE(t, 0); if (t + 1 < NT) FC_TILE(t + 1, 1); }
#undef FC_TILE
#undef FC_HALF
#undef FC_QK
#undef FC_MASK
#undef FC_EXPSUM
#undef FC_PV2
#undef FC_TRRD
#undef FC_WAITBAR
#undef FC_DMA
}
__device__ __forceinline__ void combine_pair(f32x4 (&o)[4][8], float (&ls)[4], float lam, char* lds) {
    const int tid = TIDX, wid = __builtin_amdgcn_readfirstlane(tid >> 6), lane = tid & 63, h = wid >> 2;
    char* mine = lds + wid * XCH + lane * 16; const char* theirs = lds + (wid ^ 4) * XCH + lane * 16;
    float rl[4];
#pragma unroll
    for (int qg = 0; qg < 4; ++qg) rl[qg] = __builtin_amdgcn_rcpf(sum_g(ls[qg])) * (h ? lam : 1.f);
#define FC_SEND(QX) do { _Pragma("unroll") for (int i = 0; i < 2; ++i) _Pragma("unroll") for (int dt = 0; dt < 8; ++dt) *(f32x4*)(mine + (i * 8 + dt) * 1024) = o[(QX) + i][dt] * rl[(QX) + i]; } while (0)
    if (h == 0) FC_SEND(2); else FC_SEND(0);
    __syncthreads();
    if (h == 0) {
#pragma unroll
        for (int i = 0; i < 2; ++i)
#pragma unroll
            for (int dt = 0; dt < 8; ++dt) { const f32x4 v = *(const f32x4*)(theirs + (i * 8 + dt) * 1024); o[i][dt] = o[i][dt] * rl[i] - v; }
    } else {
#pragma unroll
        for (int i = 0; i < 2; ++i)
#pragma unroll
            for (int dt = 0; dt < 8; ++dt) { const f32x4 v = *(const f32x4*)(theirs + (i * 8 + dt) * 1024); o[i][dt] = v - o[2 + i][dt] * rl[2 + i]; }
    }
    __syncthreads();
#undef FC_SEND
}
__device__ __forceinline__ void attn_unit(const Params& p, int l, int hd, int j, char* lds) {
    const int tid = TIDX, wid = __builtin_amdgcn_readfirstlane(tid >> 6), lane = tid & 63, c = lane & 15, g = lane >> 4;
    const bf16_t* QA = (const bf16_t*)(p.ws + B_QA) + hd * 128; const bf16_t* KA = (const bf16_t*)(p.ws + B_KA) + hd * 128; const bf16_t* VA = (const bf16_t*)(p.ws + B_VA) + hd * 128;
    bf16_t* YA = (bf16_t*)(p.ws + B_YA) + hd * 128;
    const int P0 = j * 256, NT = 4 * j + 1, row0 = P0 + (wid & 3) * 64 + (wid >> 2) * 32 + c;
    f32x4 o[4][8]; float ls[4];
    attn_pass(QA, KA, VA, P0, NT, lds, o, ls);
    const float lam_init = 0.8f - 0.6f * expf(-0.3f * (float)l);
    float lam;
    { const float a = wave_sum(p.in[I_LQ1][l * 64 + lane] * p.in[I_LK1][l * 64 + lane]), b = wave_sum(p.in[I_LQ2][l * 64 + lane] * p.in[I_LK2][l * 64 + lane]);
      lam = expf(a) - expf(b) + lam_init; }
    combine_pair(o, ls, lam, lds);
    const float scale_out = 1.f - lam_init;
#pragma unroll
    for (int i = 0; i < 2; ++i) { bf16_t* yr = YA + (size_t)(row0 + 16 * i) * PITCH + 4 * g;
        float ss = 0.f;
#pragma unroll
        for (int dt = 0; dt < 8; ++dt) { const f32x4 v = o[i][dt]; ss += (v.x * v.x + v.y * v.y) + (v.z * v.z + v.w * v.w); }
        ss = sum_g(ss);
        const float rs = rsqrtf(ss * (1.f / 128.f) + LN_EPS) * scale_out;
#pragma unroll
        for (int dt = 0; dt < 8; ++dt) { const f32x4 gg = *(const f32x4*)(p.in[I_ANG] + l * 128 + 16 * dt + 4 * g); const f32x4 v = o[i][dt] * rs * gg;
            u32x2 w; w.x = cvtpk(v.x, v.y); w.y = cvtpk(v.z, v.w); *(u32x2*)(yr + 16 * dt) = w; } }
}
}

__device__ __forceinline__ void phase_attn_f(const Params& p, int l, char* lds, int bid, int nb) {
    for (int u = bid; u < 256 + 8; u += nb) {
        if (u < 256) { const int hd = u & 7, jj = u >> 3;
            fd::attn_unit(p, l, hd, 64 - jj, lds);
            fd::attn_unit(p, l, hd, 1 + jj, lds);
        } else fd::attn_unit(p, l, u - 256, 0, lds);
    }
}

__device__ __forceinline__ void phase_conv(const Params& p, int l, char* lds, int bid, int nb) {
    const int tid = TIDX, wid = tid >> 6, lane = tid & 63, gw = bid * NW + wid, ngw = nb * NW;
    const bf16_t* XM = (const bf16_t*)(p.ws + B_XM); bf16_t* XC = (bf16_t*)(p.ws + B_XC);
    const float* cw = p.in[I_CONVW] + (size_t)l * 4 * D; const float* cb = p.in[I_CONVB] + (size_t)l * D;
    constexpr int RBLK = 16, NITEM = (P / RBLK) * (D / 8);
    for (int it = bid * NT + tid; it < NITEM; it += nb * NT) {
        const int rb = it >> 7, c0 = (it & 127) * 8, r0 = rb * RBLK;
        if (r0 + RBLK <= VALID0) {
#pragma unroll
            for (int i = 0; i < RBLK; ++i) *(u32x4*)(XC + (size_t)(r0 + i) * D + c0) = (u32x4){0u, 0u, 0u, 0u};
            continue; }
        u32x4 x[RBLK + 3];
#pragma unroll
        for (int i = 0; i < RBLK + 3; ++i) { const int rr = r0 - 3 + i; x[i] = rr >= VALID0 ? *(const u32x4*)(XM + (size_t)rr * D + c0) : (u32x4){0u, 0u, 0u, 0u}; }
        float w[4][8], bb[8];
#pragma unroll
        for (int j = 0; j < 4; ++j) { const f32x4 a = *(const f32x4*)(cw + j * D + c0), b = *(const f32x4*)(cw + j * D + c0 + 4);
            w[j][0] = a.x; w[j][1] = a.y; w[j][2] = a.z; w[j][3] = a.w; w[j][4] = b.x; w[j][5] = b.y; w[j][6] = b.z; w[j][7] = b.w; }
        { const f32x4 a = *(const f32x4*)(cb + c0), b = *(const f32x4*)(cb + c0 + 4); bb[0] = a.x; bb[1] = a.y; bb[2] = a.z; bb[3] = a.w; bb[4] = b.x; bb[5] = b.y; bb[6] = b.z; bb[7] = b.w; }
#pragma unroll
        for (int i = 0; i < RBLK; ++i) {
            float acc[8];
#pragma unroll
            for (int e = 0; e < 8; ++e) acc[e] = bb[e];
#pragma unroll
            for (int j = 0; j < 4; ++j) { const u32x4 v = x[i + j];
                acc[0] += w[j][0] * bf2f(v.x & 0xffffu); acc[1] += w[j][1] * bf2f(v.x >> 16); acc[2] += w[j][2] * bf2f(v.y & 0xffffu); acc[3] += w[j][3] * bf2f(v.y >> 16);
                acc[4] += w[j][4] * bf2f(v.z & 0xffffu); acc[5] += w[j][5] * bf2f(v.z >> 16); acc[6] += w[j][6] * bf2f(v.w & 0xffffu); acc[7] += w[j][7] * bf2f(v.w >> 16); }
            u32x4 o; o.x = pk2(siluf_(acc[0]), siluf_(acc[1])); o.y = pk2(siluf_(acc[2]), siluf_(acc[3])); o.z = pk2(siluf_(acc[4]), siluf_(acc[5])); o.w = pk2(siluf_(acc[6]), siluf_(acc[7]));
            if (r0 + i < VALID0) o = (u32x4){0u, 0u, 0u, 0u};
            *(u32x4*)(XC + (size_t)(r0 + i) * D + c0) = o;
        }
    }
    const float* gli = (const float*)(p.ws + TAB_GLI); const float* glf = (const float*)(p.ws + TAB_GLF);
    float* tb = (float*)(p.ws + TAB_B); float* te = (float*)(p.ws + TAB_E); float* tpm = (float*)(p.ws + TAB_PM); float* tw = (float*)(p.ws + TAB_W);
    float* scg = (float*)(p.ws + TAB_SCG); float* scm = (float*)(p.ws + TAB_SCM);
    for (int t = gw; t < NSC * 4; t += ngw) {
        const int sc = t >> 2, h = t & 3; const size_t base = (size_t)h * P + sc * 256 + 4 * lane;
        const f32x4 lf = *(const f32x4*)(glf + base), li = *(const f32x4*)(gli + base);
        float b[4]; b[0] = lf.x; b[1] = b[0] + lf.y; b[2] = b[1] + lf.z; b[3] = b[2] + lf.w;
        float incl = b[3];
#pragma unroll
        for (int o = 1; o < 64; o <<= 1) { const float n = __shfl_up(incl, o); if (lane >= o) incl += n; }
        const float excl = incl - b[3];
        float e[4], pm[4];
#pragma unroll
        for (int i = 0; i < 4; ++i) { b[i] += excl; e[i] = li[i] - b[i]; }
        pm[0] = e[0]; pm[1] = fmaxf(pm[0], e[1]); pm[2] = fmaxf(pm[1], e[2]); pm[3] = fmaxf(pm[2], e[3]);
        float mi = pm[3];
#pragma unroll
        for (int o = 1; o < 64; o <<= 1) { const float n = __shfl_up(mi, o); if (lane >= o) mi = fmaxf(mi, n); }
        float mex = __shfl_up(mi, 1); if (lane == 0) mex = -INFINITY;
#pragma unroll
        for (int i = 0; i < 4; ++i) pm[i] = fmaxf(pm[i], mex);
        const float gtot = __shfl(incl, 63), emax = __shfl(mi, 63), mloc = gtot + emax;
        f32x4 ww;
#pragma unroll
        for (int i = 0; i < 4; ++i) ww[i] = __expf(e[i] + gtot - mloc);
        *(f32x4*)(tb + base) = (f32x4){b[0], b[1], b[2], b[3]};
        *(f32x4*)(te + base) = (f32x4){e[0], e[1], e[2], e[3]};
        *(f32x4*)(tpm + base) = (f32x4){pm[0], pm[1], pm[2], pm[3]};
        *(f32x4*)(tw + base) = ww;
        if (lane == 0) { scg[sc * 4 + h] = gtot; scm[sc * 4 + h] = mloc; }
    }
}

__device__ __forceinline__ void phase_m1(const Params& p, char* lds, int bid, int nb, int nsc) {
    const int tid = TIDX, wid = __builtin_amdgcn_readfirstlane(tid >> 6), lane = tid & 63, c = lane & 15, g = lane >> 4, gw = bid * NW + wid, ngw = nb * NW;
    const bf16_t* KMT = (const bf16_t*)(p.ws + B_KMT); const bf16_t* VMT = (const bf16_t*)(p.ws + B_VMT);
    const float* tw = (const float*)(p.ws + TAB_W); bf16_t* CT = (bf16_t*)(p.ws + B_CT); float* NTv = (float*)(p.ws + TAB_NT);
    for (int u = bid; u < nsc * 4 * 2; u += nb) {
        const int dvb = (u & 1) * 8 + wid, h = (u >> 1) & 3, sc = u >> 3, s0 = sc * 256;
        f32x4 acc[16];
#pragma unroll
        for (int i = 0; i < 16; ++i) acc[i] = (f32x4){0.f, 0.f, 0.f, 0.f};
        float un[16];
#pragma unroll
        for (int i = 0; i < 16; ++i) un[i] = 0.f;
        for (int ks = (sc == 0 ? 7 : 0); ks < 8; ++ks) {
            const int sb = s0 + 32 * ks + 8 * g;
            const f32x4 w0 = *(const f32x4*)(tw + (size_t)h * P + sb), w1 = *(const f32x4*)(tw + (size_t)h * P + sb + 4);
            const u32x4 vv = *(const u32x4*)(VMT + (size_t)(h * 256 + 16 * dvb + c) * P + sb);
            u32x4 vw; vw.x = pk2(bf2f(vv.x & 0xffffu) * w0.x, bf2f(vv.x >> 16) * w0.y); vw.y = pk2(bf2f(vv.y & 0xffffu) * w0.z, bf2f(vv.y >> 16) * w0.w);
            vw.z = pk2(bf2f(vv.z & 0xffffu) * w1.x, bf2f(vv.z >> 16) * w1.y); vw.w = pk2(bf2f(vv.w & 0xffffu) * w1.z, bf2f(vv.w >> 16) * w1.w);
            const bf16x8 vf = *(bf16x8*)&vw;
#pragma unroll
            for (int dk = 0; dk < 16; ++dk) {
                const u32x4 kk = *(const u32x4*)(KMT + (size_t)(h * 256 + 16 * dk + c) * P + sb);
                acc[dk] = mfma16(*(const bf16x8*)&kk, vf, acc[dk]);
                if (dvb == 0) un[dk] += bf2f(kk.x & 0xffffu) * w0.x + bf2f(kk.x >> 16) * w0.y + bf2f(kk.y & 0xffffu) * w0.z + bf2f(kk.y >> 16) * w0.w
                                      + bf2f(kk.z & 0xffffu) * w1.x + bf2f(kk.z >> 16) * w1.y + bf2f(kk.w & 0xffffu) * w1.z + bf2f(kk.w >> 16) * w1.w;
            }
        }
        bf16_t* dst = CT + ((size_t)(sc * 4 + h) * 256 + 16 * dvb + c) * 256;
#pragma unroll
        for (int dk = 0; dk < 16; ++dk) store4_bf16(dst + 16 * dk + 4 * g, acc[dk]);
        if (dvb == 0) {
#pragma unroll
            for (int dk = 0; dk < 16; ++dk) { float v = un[dk]; v += sx<16>(v); v = sum32(v); if (g == 0) NTv[(size_t)(sc * 4 + h) * 256 + 16 * dk + c] = v; }
        }
    }
}

namespace pg8 {
template <class F> __device__ __forceinline__ void for_each_piece_local(const f32x4 (&acc)[2][2][4][2], int wr, int wc, int fr, int fq, const F& f) {
    asm volatile("" : "+v"(fr), "+v"(fq));
    const int row0 = wr * 64 + fr, col0 = wc * 32 + 8 * fq;
#pragma unroll
    for (int ai = 0; ai < 2; ++ai)
#pragma unroll
        for (int m = 0; m < 4; ++m)
#pragma unroll
            for (int bj = 0; bj < 2; ++bj) f(row0 + ai * HALF + m * 16, col0 + bj * HALF, acc[ai][bj][m][0], acc[ai][bj][m][1]);
}
}
struct SchedM1 { const char* VWT; const char* KMT; int G, c; int K, lda, ldb;
    __device__ __forceinline__ bool next(int i, pg8::Unit& u) const { return pg8::decode_unit((long)i * G + c, 4, 64, 1, u); }
    __device__ __forceinline__ const char* abase(const pg8::Unit& u) const { return VWT + ((size_t)u.grp * 256 * P + (size_t)(u.pm + 1) * 256) * 2; }
    __device__ __forceinline__ const char* bbase(const pg8::Unit& u) const { return KMT + ((size_t)u.grp * 256 * P + (size_t)(u.pm + 1) * 256) * 2; } };
struct EpiM1 { bf16_t* CT;
    __device__ __forceinline__ void operator()(const f32x4 (&acc)[2][2][4][2], const pg8::Unit& u, int wr, int wc, int fr, int fq) const {
        bf16_t* base = CT + (size_t)((u.pm + 1) * 4 + u.grp) * 65536;
        pg8::for_each_piece_local(acc, wr, wc, fr, fq, [&](int row, int col, f32x4 v0, f32x4 v1) { *(u32x4*)(base + (size_t)row * 256 + col) = pg8::pack8(v0, v1); }); } };
__device__ __forceinline__ void phase_ms(const Params& p, char* lds, int bid, int nb) {
    phase_m1(p, lds, bid, nb, 1);
    const int tid = TIDX, wid = __builtin_amdgcn_readfirstlane(tid >> 6), lane = tid & 63, c = lane & 15, g = lane >> 4, gw = bid * NW + wid, ngw = nb * NW;
    const bf16_t* KMT = (const bf16_t*)(p.ws + B_KMT); const float* tw = (const float*)(p.ws + TAB_W); float* NTv = (float*)(p.ws + TAB_NT);
    for (int t = gw; t < 64 * 4 * 16; t += ngw) {
        const int dkb = t & 15, h = (t >> 4) & 3, sc = 1 + (t >> 6);
        const bf16_t* kr = KMT + (size_t)(h * 256 + 16 * dkb + c) * P + sc * 256 + 64 * g; const float* wp = tw + (size_t)h * P + sc * 256 + 64 * g;
        float a = 0.f;
#pragma unroll
        for (int i = 0; i < 8; ++i) { const u32x4 kk = *(const u32x4*)(kr + 8 * i); const f32x4 w0 = *(const f32x4*)(wp + 8 * i), w1 = *(const f32x4*)(wp + 8 * i + 4);
            a += bf2f(kk.x & 0xffffu) * w0.x + bf2f(kk.x >> 16) * w0.y + bf2f(kk.y & 0xffffu) * w0.z + bf2f(kk.y >> 16) * w0.w
               + bf2f(kk.z & 0xffffu) * w1.x + bf2f(kk.z >> 16) * w1.y + bf2f(kk.w & 0xffffu) * w1.z + bf2f(kk.w >> 16) * w1.w; }
        a += sx<16>(a); a = sum32(a);
        if (g == 0) NTv[(size_t)(sc * 4 + h) * 256 + 16 * dkb + c] = a;
    }
    SchedM1 S{(const char*)(p.ws + B_VWT), (const char*)KMT, nb, bid, 256, P, P};
    pg8::gemm_phase((PG8_LAS unsigned char*)lds, S, EpiM1{(bf16_t*)(p.ws + B_CT)});
}

__device__ __forceinline__ void phase_m2(const Params& p, char* lds, int bid, int nb) {
    const float* scg = (const float*)(p.ws + TAB_SCG); const float* scm = (const float*)(p.ws + TAB_SCM);
    unsigned* CT = (unsigned*)(p.ws + B_CT); float* NTv = (float*)(p.ws + TAB_NT); float* mt = (float*)(p.ws + TAB_MT);
    const int gid = bid * NT + TIDX, nth = nb * NT;
    for (int i = gid; i < 4 * 32768 + 1024; i += nth) {
        if (i < 4 * 32768) {
            const int h = i >> 15, idx = i & 32767;
            unsigned* base = CT + (size_t)h * 32768 + idx;
            unsigned u[NSC];
#pragma unroll
            for (int sc = 0; sc < NSC; ++sc) u[sc] = base[(size_t)sc * 4 * 32768];
            float m = 0.f, c0 = 0.f, c1 = 0.f;
#pragma unroll
            for (int sc = 0; sc < NSC; ++sc) {
                const float gg = scg[sc * 4 + h], ml = scm[sc * 4 + h], mn = fmaxf(gg + m, ml), dec = __expf(gg + m - mn), cor = __expf(ml - mn);
                c0 = dec * c0 + cor * bf2f(u[sc] & 0xffffu); c1 = dec * c1 + cor * bf2f(u[sc] >> 16);
                base[(size_t)sc * 4 * 32768] = pk2(c0, c1); m = mn;
            }
        } else {
            const int j = i - 4 * 32768, h = j >> 8, d = j & 255;
            float* ptr0 = NTv + (size_t)h * 256 + d;
            float un[NSC];
#pragma unroll
            for (int sc = 0; sc < NSC; ++sc) un[sc] = ptr0[(size_t)sc * 1024];
            float m = 0.f, n = 0.f;
#pragma unroll
            for (int sc = 0; sc < NSC; ++sc) {
                const float gg = scg[sc * 4 + h], ml = scm[sc * 4 + h], mn = fmaxf(gg + m, ml), dec = __expf(gg + m - mn), cor = __expf(ml - mn);
                n = dec * n + cor * un[sc]; ptr0[(size_t)sc * 1024] = n; m = mn;
                if (d == 0) mt[sc * 4 + h] = mn;
            }
        }
    }
}

__device__ __forceinline__ void phase_m3(const Params& p, int l, char* lds, int bid, int nb, bool sc0_only) {
    const int tid = TIDX, wid = __builtin_amdgcn_readfirstlane(tid >> 6), lane = tid & 63, c = lane & 15, g = lane >> 4, gw = bid * NW + wid, ngw = nb * NW;
    const bf16_t* QM = (const bf16_t*)(p.ws + B_QM); const bf16_t* KM = (const bf16_t*)(p.ws + B_KM); const bf16_t* VMT = (const bf16_t*)(p.ws + B_VMT);
    const bf16_t* CT = (const bf16_t*)(p.ws + B_CT); const float* NTv = (const float*)(p.ws + TAB_NT); const float* mt = (const float*)(p.ws + TAB_MT);
    const float* tb = (const float*)(p.ws + TAB_B); const float* te = (const float*)(p.ws + TAB_E); const float* tpm = (const float*)(p.ws + TAB_PM);
    const bf16_t* OP = (const bf16_t*)(p.ws + B_OP); bf16_t* YM = (bf16_t*)(p.ws + B_YM);
    constexpr int NRG = P / 16, RG0 = VALID0 / 16;
    const int ntask = (NRG - RG0) * 4;
    for (int u = (sc0_only ? 256 : 0) + bid; u < (sc0_only ? 260 : NSC * 4 * 2); u += nb) {
        const int half = u < NSC * 4 ? 1 : 0, uu = u < NSC * 4 ? u : u - NSC * 4, sc = (NSC - 1) - (uu >> 2), h = uu & 3, rg = sc * 16 + half * 8 + wid;
        if (rg < RG0) continue;
        const int t0 = rg * 16, row = t0 + c, s_start = sc << 8;
        bf16x8 qf[8];
#pragma unroll
        for (int ks = 0; ks < 8; ++ks) qf[ks] = ld8(QM + (size_t)row * D + h * 256 + 32 * ks + 8 * g);
        const float b_t = tb[(size_t)h * P + row], pm_t = tpm[(size_t)h * P + row];
        const float m_prev = sc > 0 ? mt[(sc - 1) * 4 + h] : 0.f;
        const float m_t = b_t + fmaxf(m_prev, pm_t), scale_t = __expf(b_t + m_prev - m_t);
        f32x4 acc[16];
#pragma unroll
        for (int i = 0; i < 16; ++i) acc[i] = (f32x4){0.f, 0.f, 0.f, 0.f};
        float den = 0.f;
        if (sc > 0) {
            const bf16_t* Cb = CT + (size_t)((sc - 1) * 4 + h) * 65536; const float* nv = NTv + (size_t)((sc - 1) * 4 + h) * 256;
#pragma unroll 2
            for (int ks = 0; ks < 8; ++ks) {
#pragma unroll
                for (int dt = 0; dt < 16; ++dt) acc[dt] = mfma16(ld8(Cb + (size_t)(16 * dt + c) * 256 + 32 * ks + 8 * g), qf[ks], acc[dt]);
                const f32x4 n0 = *(const f32x4*)(nv + 32 * ks + 8 * g), n1 = *(const f32x4*)(nv + 32 * ks + 8 * g + 4);
                const u32x4 qq = *(const u32x4*)&qf[ks];
                den += bf2f(qq.x & 0xffffu) * n0.x + bf2f(qq.x >> 16) * n0.y + bf2f(qq.y & 0xffffu) * n0.z + bf2f(qq.y >> 16) * n0.w
                     + bf2f(qq.z & 0xffffu) * n1.x + bf2f(qq.z >> 16) * n1.y + bf2f(qq.w & 0xffffu) * n1.z + bf2f(qq.w >> 16) * n1.w;
            }
            den *= scale_t;
#pragma unroll
            for (int dt = 0; dt < 16; ++dt) acc[dt] = acc[dt] * scale_t;
        }
        for (int kb = (sc == 0 ? 224 : s_start); kb <= t0 + 15; kb += 32) {
            f32x4 s[2];
#pragma unroll
            for (int a = 0; a < 2; ++a) {
                s[a] = (f32x4){0.f, 0.f, 0.f, 0.f};
                const bf16_t* kr = KM + (size_t)(kb + 16 * a + c) * D + h * 256 + 8 * g;
#pragma unroll
                for (int ks = 0; ks < 8; ++ks) s[a] = mfma16(ld8(kr + 32 * ks), qf[ks], s[a]);
                const f32x4 ee = *(const f32x4*)(te + (size_t)h * P + kb + 16 * a + 4 * g);
#pragma unroll
                for (int r = 0; r < 4; ++r) { const int key = kb + 16 * a + 4 * g + r; const float arg = fminf(ee[r] + b_t - m_t, 0.f);
                    const float dd = key <= row ? __expf(arg) : 0.f; const float pv = s[a][r] * dd; s[a][r] = pv; den += pv; }
            }
            u32x4 w; w.x = pk2(s[0][0], s[0][1]); w.y = pk2(s[0][2], s[0][3]); w.z = pk2(s[1][0], s[1][1]); w.w = pk2(s[1][2], s[1][3]);
            const bf16x8 pf = *(bf16x8*)&w;
#pragma unroll
            for (int dt = 0; dt < 16; ++dt) {
                const bf16_t* vr = VMT + (size_t)(h * 256 + 16 * dt + c) * P + kb + 4 * g;
                const u32x2 v0 = *(const u32x2*)vr, v1 = *(const u32x2*)(vr + 16);
                u32x4 vv; vv.x = v0.x; vv.y = v0.y; vv.z = v1.x; vv.w = v1.y;
                acc[dt] = mfma16(*(bf16x8*)&vv, pf, acc[dt]);
            }
        }
        den += sx<16>(den); den = sum32(den);
        const float inv = 1.f / fmaxf(fabsf(den), __expf(-m_t));
        float s1 = 0.f;
#pragma unroll
        for (int dt = 0; dt < 16; ++dt) {
            const u32x2 og = *(const u32x2*)(OP + (size_t)row * D + h * 256 + 16 * dt + 4 * g);
            f32x4 v = acc[dt] * inv;
            v.x *= sigmoidf_(bf2f(og.x & 0xffffu)); v.y *= sigmoidf_(bf2f(og.x >> 16)); v.z *= sigmoidf_(bf2f(og.y & 0xffffu)); v.w *= sigmoidf_(bf2f(og.y >> 16));
            acc[dt] = v; s1 += (v.x + v.y) + (v.z + v.w);
        }
        s1 += sx<16>(s1); s1 = sum32(s1);
        const float mu = s1 * (1.f / 256.f);
        float s2 = 0.f;
#pragma unroll
        for (int dt = 0; dt < 16; ++dt) { acc[dt] = acc[dt] - mu; s2 += (acc[dt].x * acc[dt].x + acc[dt].y * acc[dt].y) + (acc[dt].z * acc[dt].z + acc[dt].w * acc[dt].w); }
        s2 += sx<16>(s2); s2 = sum32(s2);
        const float rstd = rsqrtf(s2 * (1.f / 256.f) + LN_EPS);
#pragma unroll
        for (int dt = 0; dt < 16; ++dt) { const f32x4 gg = *(const f32x4*)(p.in[I_MNG] + (size_t)l * D + h * 256 + 16 * dt + 4 * g);
            store4_bf16(YM + (size_t)row * D + h * 256 + 16 * dt + 4 * g, acc[dt] * rstd * gg); }
    }
}

struct EpiBr1 { float* MRG; const bf16_t* GA;
    __device__ __forceinline__ void operator()(int m, int n, f32x4 v) const { const u32x2 gg = *(const u32x2*)(GA + (size_t)m * D + n);
        f32x4 o; o.x = v.x * sigmoidf_(bf2f(gg.x & 0xffffu)); o.y = v.y * sigmoidf_(bf2f(gg.x >> 16)); o.z = v.z * sigmoidf_(bf2f(gg.y & 0xffffu)); o.w = v.w * sigmoidf_(bf2f(gg.y >> 16));
        *(f32x4*)(MRG + (size_t)m * D + n) = o; } };
struct EpiBr2 { const float* MRG; const bf16_t* GB; bf16_t* OUT;
    __device__ __forceinline__ void operator()(int m, int n, f32x4 v) const { const u32x2 gg = *(const u32x2*)(GB + (size_t)m * D + n); const f32x4 t = *(const f32x4*)(MRG + (size_t)m * D + n);
        f32x4 o; o.x = t.x + v.x * sigmoidf_(bf2f(gg.x & 0xffffu)); o.y = t.y + v.y * sigmoidf_(bf2f(gg.x >> 16)); o.z = t.z + v.z * sigmoidf_(bf2f(gg.y & 0xffffu)); o.w = t.w + v.w * sigmoidf_(bf2f(gg.y >> 16));
        store4_bf16(OUT + (size_t)m * D + n, o); } };
struct EpiOut { float* Z; const bf16_t* H;
    __device__ __forceinline__ void operator()(int m, int n, f32x4 v) const { const u32x2 hh = *(const u32x2*)(H + (size_t)m * D + n);
        f32x4 o; o.x = v.x + DN_ALPHA * bf2f(hh.x & 0xffffu); o.y = v.y + DN_ALPHA * bf2f(hh.x >> 16); o.z = v.z + DN_ALPHA * bf2f(hh.y & 0xffffu); o.w = v.w + DN_ALPHA * bf2f(hh.y >> 16);
        *(f32x4*)(Z + (size_t)m * D + n) = o; } };
constexpr int LDS_TAB_OFF = 131072;
constexpr int LDS_MT_OFF = LDS_TAB_OFF + 256;
constexpr int LDS_STAT_OFF = LDS_TAB_OFF + 2048;
__device__ __forceinline__ void compute_mtab_lds(const Params& p, char* lds) {
    float* mt = (float*)(lds + LDS_MT_OFF); float* tmp = (float*)(lds + LDS_STAT_OFF);
    const int t = TIDX;
    if (t < NSC * 4) { tmp[t] = ((const float*)(p.ws + TAB_SCG))[t]; tmp[NSC * 4 + t] = ((const float*)(p.ws + TAB_SCM))[t]; }
    __syncthreads();
    if (t < 4) { float m = 0.f;
        for (int sc = 0; sc < NSC; ++sc) { m = fmaxf(tmp[sc * 4 + t] + m, tmp[NSC * 4 + sc * 4 + t]); mt[sc * 4 + t] = m; } }
    __syncthreads();
}
struct SchedQK { const char* A; const char* B; int G, c; int K, lda, ldb;
    __device__ __forceinline__ bool next(int i, pg8::Unit& u) const { if (!pg8::decode_unit((long)i * G + c, 4, 64, 1, u)) return false; u.pm += 1; return true; }
    __device__ __forceinline__ const char* abase(const pg8::Unit& u) const { return A + ((size_t)u.pm * 256 * D + u.grp * 256) * 2; }
    __device__ __forceinline__ const char* bbase(const pg8::Unit& u) const { return B + ((size_t)u.pm * 256 * D + u.grp * 256) * 2; } };
struct EpiS { unsigned char* ws; const float* mt_lds;
    __device__ __forceinline__ void operator()(const f32x4 (&acc)[2][2][4][2], const pg8::Unit& u, int wr, int wc, int fr, int fq) const {
        asm volatile("" : "+v"(fr), "+v"(fq));
        const int h = u.grp, t0 = u.pm * 256; const float m_prev = mt_lds[(u.pm - 1) * 4 + h];
        const float* te = (const float*)(ws + TAB_E) + (size_t)h * P + t0; const float* tpm = (const float*)(ws + TAB_PM) + (size_t)h * P + t0;
        bf16_t* PMb = (bf16_t*)(ws + B_PM) + (size_t)t0 * D + h * 256; float* denp = (float*)(ws + TAB_DENP);
        const int c0 = wc * 32 + 8 * fq;
        f32x4 e[2][2];
#pragma unroll
        for (int bj = 0; bj < 2; ++bj) { e[bj][0] = *(const f32x4*)(te + c0 + bj * 128); e[bj][1] = *(const f32x4*)(te + c0 + bj * 128 + 4); }
        float tp[2][4];
#pragma unroll
        for (int ai = 0; ai < 2; ++ai)
#pragma unroll
            for (int m = 0; m < 4; ++m) tp[ai][m] = tpm[ai * 128 + wr * 64 + m * 16 + fr];
#pragma unroll
        for (int ai = 0; ai < 2; ++ai)
#pragma unroll
            for (int m = 0; m < 4; ++m) { const int r = ai * 128 + wr * 64 + m * 16 + fr; const float pmx = fmaxf(m_prev, tp[ai][m]); float rs = 0.f;
#pragma unroll
                for (int bj = 0; bj < 2; ++bj) { f32x4 o0, o1;
#pragma unroll
                    for (int j = 0; j < 4; ++j) { const int s0 = c0 + bj * 128 + j, s1 = s0 + 4;
                        o0[j] = s0 <= r ? acc[ai][bj][m][0][j] * __expf(fminf(e[bj][0][j] - pmx, 0.f)) : 0.f;
                        o1[j] = s1 <= r ? acc[ai][bj][m][1][j] * __expf(fminf(e[bj][1][j] - pmx, 0.f)) : 0.f;
                        rs += o0[j] + o1[j]; }
                    *(u32x4*)(PMb + (size_t)r * D + c0 + bj * 128) = pg8::pack8(o0, o1); }
                rs += sx<16>(rs); rs = sum32(rs);
                if (fq == 0) denp[((size_t)(t0 + r) * 4 + h) * 4 + wc] = rs; } } };
struct SchedO1 { const char* A; const char* B; int G, c; int K, lda, ldb;
    __device__ __forceinline__ bool next(int i, pg8::Unit& u) const { if (!pg8::decode_unit((long)i * G + c, 4, 64, 1, u)) return false; u.pm += 1; return true; }
    __device__ __forceinline__ const char* abase(const pg8::Unit& u) const { return A + ((size_t)u.pm * 256 * D + u.grp * 256) * 2; }
    __device__ __forceinline__ const char* bbase(const pg8::Unit& u) const { return B + (size_t)((u.pm - 1) * 4 + u.grp) * 65536 * 2; } };
struct EpiO1 { unsigned char* ws;
    __device__ __forceinline__ void operator()(const f32x4 (&acc)[2][2][4][2], const pg8::Unit& u, int wr, int wc, int fr, int fq) const {
        asm volatile("" : "+v"(fr), "+v"(fq));
        const int h = u.grp, t0 = u.pm * 256; const float m_prev = ((const float*)(ws + TAB_MT))[(u.pm - 1) * 4 + h];
        const float* tpm = (const float*)(ws + TAB_PM) + (size_t)h * P + t0; bf16_t* OI = (bf16_t*)(ws + B_OI) + (size_t)t0 * D + h * 256;
        const int c0 = wc * 32 + 8 * fq;
        float tp[2][4];
#pragma unroll
        for (int ai = 0; ai < 2; ++ai)
#pragma unroll
            for (int m = 0; m < 4; ++m) tp[ai][m] = tpm[ai * 128 + wr * 64 + m * 16 + fr];
#pragma unroll
        for (int ai = 0; ai < 2; ++ai)
#pragma unroll
            for (int m = 0; m < 4; ++m) { const int r = ai * 128 + wr * 64 + m * 16 + fr; const float sc = __expf(fminf(m_prev - tp[ai][m], 0.f));
#pragma unroll
                for (int bj = 0; bj < 2; ++bj) *(u32x4*)(OI + (size_t)r * D + c0 + bj * 128) = pg8::pack8(acc[ai][bj][m][0] * sc, acc[ai][bj][m][1] * sc); } } };
struct SchedO2 { const char* A; const char* B; int G, c; int K, lda, ldb;
    __device__ __forceinline__ bool next(int i, pg8::Unit& u) const { if (!pg8::decode_unit((long)i * G + c, 4, 64, 1, u)) return false; u.pm += 1; return true; }
    __device__ __forceinline__ const char* abase(const pg8::Unit& u) const { return A + ((size_t)u.pm * 256 * D + u.grp * 256) * 2; }
    __device__ __forceinline__ const char* bbase(const pg8::Unit& u) const { return B + ((size_t)u.grp * 256 * P + (size_t)u.pm * 256) * 2; } };
struct EpiO2 { unsigned char* ws; const float* mng; float* stat;
    __device__ __forceinline__ void operator()(f32x4 (&acc)[2][2][4][2], const pg8::Unit& u, int wr, int wc, int fr, int fq) const {
        asm volatile("" : "+v"(fr), "+v"(fq));
        const int h = u.grp, t0 = u.pm * 256; const float m_prev = ((const float*)(ws + TAB_MT))[(u.pm - 1) * 4 + h];
        const float* tpm = (const float*)(ws + TAB_PM) + (size_t)h * P + t0; const float* tb = (const float*)(ws + TAB_B) + (size_t)h * P + t0;
        const float* denp = (const float*)(ws + TAB_DENP); const float* deni = (const float*)(ws + TAB_DENI);
        const bf16_t* OI = (const bf16_t*)(ws + B_OI) + (size_t)t0 * D + h * 256; const bf16_t* OP = (const bf16_t*)(ws + B_OP) + (size_t)t0 * D + h * 256;
        bf16_t* YM = (bf16_t*)(ws + B_YM) + (size_t)t0 * D + h * 256;
        const int c0 = wc * 32 + 8 * fq;
#pragma unroll
        for (int ai = 0; ai < 2; ++ai)
#pragma unroll
            for (int m = 0; m < 4; ++m) { const int r = ai * 128 + wr * 64 + m * 16 + fr;
                const f32x4 dp = *(const f32x4*)(denp + ((size_t)(t0 + r) * 4 + h) * 4); const float den = (dp.x + dp.y) + (dp.z + dp.w) + deni[(size_t)(t0 + r) * 4 + h];
                const float m_t = tb[r] + fmaxf(m_prev, tpm[r]); const float inv = 1.f / fmaxf(fabsf(den), __expf(-m_t));
                float s1 = 0.f, s2 = 0.f;
#pragma unroll
                for (int bj = 0; bj < 2; ++bj) { f32x4 i0, i1, g0, g1; pg8::unpack8(*(const u32x4*)(OI + (size_t)r * D + c0 + bj * 128), i0, i1); pg8::unpack8(*(const u32x4*)(OP + (size_t)r * D + c0 + bj * 128), g0, g1);
                    f32x4 v0 = (acc[ai][bj][m][0] + i0) * inv * sig4(g0), v1 = (acc[ai][bj][m][1] + i1) * inv * sig4(g1);
                    acc[ai][bj][m][0] = v0; acc[ai][bj][m][1] = v1;
                    s1 += (v0.x + v0.y) + (v0.z + v0.w) + (v1.x + v1.y) + (v1.z + v1.w);
                    s2 += (v0.x * v0.x + v0.y * v0.y) + (v0.z * v0.z + v0.w * v0.w) + (v1.x * v1.x + v1.y * v1.y) + (v1.z * v1.z + v1.w * v1.w); }
                s1 += sx<16>(s1); s1 = sum32(s1); s2 += sx<16>(s2); s2 = sum32(s2);
                if (fq == 0) { stat[(r * 4 + wc) * 2] = s1; stat[(r * 4 + wc) * 2 + 1] = s2; } }
        asm volatile("s_waitcnt lgkmcnt(0)" ::: "memory"); __builtin_amdgcn_s_barrier(); asm volatile("" ::: "memory");
#pragma unroll
        for (int ai = 0; ai < 2; ++ai)
#pragma unroll
            for (int m = 0; m < 4; ++m) { const int r = ai * 128 + wr * 64 + m * 16 + fr;
                const f32x4 a = *(const f32x4*)(stat + r * 8), b = *(const f32x4*)(stat + r * 8 + 4);
                const float mu = ((a.x + a.z) + (b.x + b.z)) * (1.f / 256.f), ex2 = ((a.y + a.w) + (b.y + b.w)) * (1.f / 256.f);
                const float rstd = rsqrtf(fmaxf(ex2 - mu * mu, 0.f) + LN_EPS);
#pragma unroll
                for (int bj = 0; bj < 2; ++bj) { const f32x4 g0 = *(const f32x4*)(mng + h * 256 + c0 + bj * 128), g1 = *(const f32x4*)(mng + h * 256 + c0 + bj * 128 + 4);
                    *(u32x4*)(YM + (size_t)r * D + c0 + bj * 128) = pg8::pack8((acc[ai][bj][m][0] - mu) * rstd * g0, (acc[ai][bj][m][1] - mu) * rstd * g1); } } } };
__device__ __forceinline__ void phase_o1(const Params& p, char* lds, int bid, int nb) {
    const int tid = TIDX, wid = __builtin_amdgcn_readfirstlane(tid >> 6), lane = tid & 63, c = lane & 15, g = lane >> 4, gw = bid * NW + wid, ngw = nb * NW;
    const bf16_t* QM = (const bf16_t*)(p.ws + B_QM); const float* NTv = (const float*)(p.ws + TAB_NT); const float* mt = (const float*)(p.ws + TAB_MT);
    const float* tpm = (const float*)(p.ws + TAB_PM); float* deni = (float*)(p.ws + TAB_DENI);
#pragma unroll 2
    for (int it = gw; it < ((P - 256) / 16) * 4; it += ngw) {
        const int h = it & 3, t = 256 + (it >> 2) * 16 + c, sc = t >> 8;
        const bf16_t* qr = QM + (size_t)t * D + h * 256 + 64 * g; const float* nv = NTv + (size_t)((sc - 1) * 4 + h) * 256 + 64 * g;
        float a = 0.f;
#pragma unroll
        for (int i = 0; i < 8; ++i) { const u32x4 qq = *(const u32x4*)(qr + 8 * i); const f32x4 n0 = *(const f32x4*)(nv + 8 * i), n1 = *(const f32x4*)(nv + 8 * i + 4);
            a += bf2f(qq.x & 0xffffu) * n0.x + bf2f(qq.x >> 16) * n0.y + bf2f(qq.y & 0xffffu) * n0.z + bf2f(qq.y >> 16) * n0.w
               + bf2f(qq.z & 0xffffu) * n1.x + bf2f(qq.z >> 16) * n1.y + bf2f(qq.w & 0xffffu) * n1.z + bf2f(qq.w >> 16) * n1.w; }
        a += sx<16>(a); a = sum32(a);
        if (g == 0) deni[(size_t)t * 4 + h] = a * __expf(fminf(mt[(sc - 1) * 4 + h] - tpm[(size_t)h * P + t], 0.f));
    }
    SchedO1 S{(const char*)QM, (const char*)(p.ws + B_CT), nb, bid, 256, D, 256};
    pg8::gemm_phase((PG8_LAS unsigned char*)lds, S, EpiO1{p.ws});
}
__device__ __forceinline__ void phase_sg(const Params& p, char* lds, int bid, int nb) {
    compute_mtab_lds(p, lds);
    SchedQK S{(const char*)(p.ws + B_QM), (const char*)(p.ws + B_KM), nb, bid, 256, D, D};
    pg8::gemm_phase((PG8_LAS unsigned char*)lds, S, EpiS{p.ws, (const float*)(lds + LDS_MT_OFF)});
}
__device__ __forceinline__ void phase_o2(const Params& p, int l, char* lds, int bid, int nb) {
    phase_m3(p, l, lds, bid, nb, true);
    SchedO2 S{(const char*)(p.ws + B_PM), (const char*)(p.ws + B_VMT), nb, bid, 256, D, P};
    pg8::gemm_phase((PG8_LAS unsigned char*)lds, S, EpiO2{p.ws, p.in[I_MNG] + (size_t)l * D, (float*)(lds + LDS_STAT_OFF)});
}

struct SchedMqkvN { const char* XC; const char* WQ; const char* WK; int G, c; int K, lda, ldb;
    __device__ __forceinline__ bool next(int i, pg8::Unit& u) const { if (!pg8::decode_unit((long)i * G + c, 8, 64, 1, u)) return false; u.pm += 1; return true; }
    __device__ __forceinline__ const char* abase(const pg8::Unit& u) const { return XC + (size_t)(u.grp & 3) * 512 + (size_t)u.pm * 256 * D * 2; }
    __device__ __forceinline__ const char* bbase(const pg8::Unit& u) const { return ((u.grp >> 2) ? WK : WQ) + (size_t)(u.grp & 3) * 65536 * 2; } };
struct SchedMqkvT { const char* XC; const char* XM; const char* WK; const char* WV; int G, c; int K, lda, ldb;
    __device__ __forceinline__ bool next(int i, pg8::Unit& u) const { if (!pg8::decode_unit((long)i * G + c, 8, 1, 64, u)) return false; u.pn += 1; return true; }
    __device__ __forceinline__ const char* abase(const pg8::Unit& u) const { return ((u.grp >> 2) ? WV : WK) + (size_t)(u.grp & 3) * 65536 * 2; }
    __device__ __forceinline__ const char* bbase(const pg8::Unit& u) const { return ((u.grp >> 2) ? XM : XC) + (size_t)(u.grp & 3) * 512 + (size_t)u.pn * 256 * D * 2; } };
struct EpiGrpF { bf16_t* base0; bf16_t* base1; size_t hstride; size_t ldc; float s0, s1;
    __device__ __forceinline__ void operator()(const f32x4 (&acc)[2][2][4][2], const pg8::Unit& u, int wr, int wc, int fr, int fq) const {
        const int which = u.grp >> 2, h = u.grp & 3; const float sc = which ? s1 : s0;
        bf16_t* base = (which ? base1 : base0) + (size_t)h * hstride + (size_t)u.pn * 256;
        const size_t ld = ldc;
        pg8::for_each_piece(acc, u, wr, wc, fr, fq, [&](int row, int col, f32x4 v0, f32x4 v1) { *(u32x4*)(base + (size_t)row * ld + col) = pg8::pack8(v0 * sc, v1 * sc); }); } };
struct EpiMqkvT { unsigned char* ws;
    __device__ __forceinline__ void operator()(const f32x4 (&acc)[2][2][4][2], const pg8::Unit& u, int wr, int wc, int fr, int fq) const {
        bf16_t* KMT = (bf16_t*)(ws + B_KMT); bf16_t* VMT = (bf16_t*)(ws + B_VMT); bf16_t* VWT = (bf16_t*)(ws + B_VWT); const float* tw = (const float*)(ws + TAB_W);
        const int which = u.grp >> 2, h = u.grp & 3; const size_t cb = (size_t)u.pn * 256;
        if (which == 0) { bf16_t* base = KMT + (size_t)h * 256 * P + cb;
            pg8::for_each_piece(acc, u, wr, wc, fr, fq, [&](int row, int col, f32x4 v0, f32x4 v1) { *(u32x4*)(base + (size_t)row * P + col) = pg8::pack8(v0 * 0.0625f, v1 * 0.0625f); });
        } else { bf16_t* b0 = VMT + (size_t)h * 256 * P + cb; bf16_t* b1 = VWT + (size_t)h * 256 * P + cb; const float* w = tw + (size_t)h * P + cb;
            struct W2 { f32x4 w0, w1; };
            pg8::for_each_piece_pf(acc, u, wr, wc, fr, fq, [&](int row, int col) { W2 r; r.w0 = *(const f32x4*)(w + col); r.w1 = *(const f32x4*)(w + col + 4); return r; },
                [&](int row, int col, f32x4 v0, f32x4 v1, W2 ww) {
                *(u32x4*)(b0 + (size_t)row * P + col) = pg8::pack8(v0, v1); *(u32x4*)(b1 + (size_t)row * P + col) = pg8::pack8(v0 * ww.w0, v1 * ww.w1); }); } } };
struct EpiStoreW { bf16_t* C0; bf16_t* C1; size_t ldc; const float* w;
    __device__ __forceinline__ void operator()(int m, int n, f32x4 v) const { store4_bf16(C0 + (size_t)m * ldc + n, v); const f32x4 ww = *(const f32x4*)(w + n); store4_bf16(C1 + (size_t)m * ldc + n, v * ww); } };
__device__ __forceinline__ void phase_mqkv_f(const Params& p, char* lds, int bid, int nb) {
    const int tid = TIDX, wid = tid >> 6, gw = bid * NW + wid, ngw = nb * NW;
    const bf16_t* XC = (const bf16_t*)(p.ws + B_XC); const bf16_t* XM = (const bf16_t*)(p.ws + B_XM);
    const bf16_t* WQ = (const bf16_t*)(p.ws + W_Q_T); const bf16_t* WK = (const bf16_t*)(p.ws + W_K_T); const bf16_t* WV = (const bf16_t*)(p.ws + W_V_T);
    bf16_t* QM = (bf16_t*)(p.ws + B_QM); bf16_t* KM = (bf16_t*)(p.ws + B_KM); bf16_t* KMT = (bf16_t*)(p.ws + B_KMT); bf16_t* VMT = (bf16_t*)(p.ws + B_VMT); bf16_t* VWT = (bf16_t*)(p.ws + B_VWT);
    zero_block(KM, D, VALID0, D, bid * NT + tid, nb * NT);
    zero_block(VWT, P, D, VALID0, bid * NT + tid, nb * NT);
    zero_block(KMT, P, D, VALID0, bid * NT + tid, nb * NT);
    zero_block(VMT, P, D, VALID0, bid * NT + tid, nb * NT);
    for (int t = bid; t < 64; t += nb) {
        const int which = (t >> 4) & 1, h = (t >> 2) & 3, q = t & 3;
        if (t < 32) meta_gemm<1, 4>(RowsPlain{XC + h * 256, D}, RowsPlain{(which ? WK : WQ) + (size_t)h * 65536, 256}, 256, VALID0, q * 64, EpiStore{(which ? KM : QM) + h * 256, D, which ? 0.0625f : 1.f}, lds);
        else if (which == 0) meta_gemm<4, 1>(RowsPlain{WK + (size_t)h * 65536, 256}, RowsPlain{XC + h * 256, D}, 256, q * 64, VALID0, EpiStore{KMT + (size_t)h * 256 * P, P, 0.0625f}, lds);
        else meta_gemm<4, 1>(RowsPlain{WV + (size_t)h * 65536, 256}, RowsPlain{XM + h * 256, D}, 256, q * 64, VALID0, EpiStoreW{VMT + (size_t)h * 256 * P, VWT + (size_t)h * 256 * P, P, (const float*)(p.ws + TAB_W) + (size_t)h * P}, lds);
    }
    { SchedMqkvN S{(const char*)XC, (const char*)WQ, (const char*)WK, nb, bid, 256, D, 256};
      pg8::gemm_phase((PG8_LAS unsigned char*)lds, S, EpiGrpF{QM, KM, 256, D, 1.f, 0.0625f}); }
    { SchedMqkvT S{(const char*)XC, (const char*)XM, (const char*)WK, (const char*)WV, nb, bid, 256, 256, D};
      pg8::gemm_phase((PG8_LAS unsigned char*)lds, S, EpiMqkvT{p.ws}); }
}
struct SchedSq { const char* A; const char* B; int G, c; int K, lda, ldb;
    __device__ __forceinline__ bool next(int i, pg8::Unit& u) const { if (!pg8::decode_unit((long)i * G + c, 1, 64, 4, u)) return false; u.pm += 1; return true; }
    __device__ __forceinline__ const char* abase(const pg8::Unit& u) const { return A + (size_t)u.pm * 256 * D * 2; }
    __device__ __forceinline__ const char* bbase(const pg8::Unit& u) const { return B + (size_t)u.pn * 256 * D * 2; } };
struct EpiBr1F { float* MRG; const bf16_t* GA;
    __device__ __forceinline__ void operator()(const f32x4 (&acc)[2][2][4][2], const pg8::Unit& u, int wr, int wc, int fr, int fq) const {
        const int cb = u.pn * 256;
        pg8::for_each_piece(acc, u, wr, wc, fr, fq, [&](int row, int col, f32x4 v0, f32x4 v1) { const size_t idx = (size_t)row * D + cb + col;
            f32x4 g0, g1; pg8::unpack8(*(const u32x4*)(GA + idx), g0, g1);
            *(f32x4*)(MRG + idx) = v0 * sig4(g0); *(f32x4*)(MRG + idx + 4) = v1 * sig4(g1); }); } };
struct EpiBr2F { const float* MRG; const bf16_t* GB; bf16_t* OUT;
    __device__ __forceinline__ void operator()(const f32x4 (&acc)[2][2][4][2], const pg8::Unit& u, int wr, int wc, int fr, int fq) const {
        const int cb = u.pn * 256;
        pg8::for_each_piece(acc, u, wr, wc, fr, fq, [&](int row, int col, f32x4 v0, f32x4 v1) { const size_t idx = (size_t)row * D + cb + col;
            f32x4 g0, g1; pg8::unpack8(*(const u32x4*)(GB + idx), g0, g1);
            const f32x4 t0 = *(const f32x4*)(MRG + idx), t1 = *(const f32x4*)(MRG + idx + 4);
            *(u32x4*)(OUT + idx) = pg8::pack8(t0 + v0 * sig4(g0), t1 + v1 * sig4(g1)); }); } };
struct EpiOutF { float* Z; const bf16_t* H;
    __device__ __forceinline__ void operator()(const f32x4 (&acc)[2][2][4][2], const pg8::Unit& u, int wr, int wc, int fr, int fq) const {
        const int cb = u.pn * 256;
        pg8::for_each_piece_pf(acc, u, wr, wc, fr, fq, [&](int row, int col) { return *(const u32x4*)(H + (size_t)row * D + cb + col); },
            [&](int row, int col, f32x4 v0, f32x4 v1, u32x4 hh) { const size_t idx = (size_t)row * D + cb + col;
            f32x4 h0, h1; pg8::unpack8(hh, h0, h1);
            *(f32x4*)(Z + idx) = v0 + h0 * DN_ALPHA; *(f32x4*)(Z + idx + 4) = v1 + h1 * DN_ALPHA; }); } };
struct SchedBr { const char* YM; const char* YA; const char* WM; const char* WA; int G, c; int K, lda, ldb;
    __device__ __forceinline__ bool next(int i, pg8::Unit& u) const { if (!pg8::decode_unit((long)(i >> 1) * G + c, 1, 64, 4, u)) return false; u.pm += 1; u.grp = i & 1; return true; }
    __device__ __forceinline__ const char* abase(const pg8::Unit& u) const { return (u.grp ? YA : YM) + (size_t)u.pm * 256 * D * 2; }
    __device__ __forceinline__ const char* bbase(const pg8::Unit& u) const { return (u.grp ? WA : WM) + (size_t)u.pn * 256 * D * 2; } };
__device__ __forceinline__ u32x4 ld16_agent(const bf16_t* ptr) {
    const unsigned long long a = __hip_atomic_load((const unsigned long long*)ptr, __ATOMIC_RELAXED, __HIP_MEMORY_SCOPE_AGENT), b = __hip_atomic_load((const unsigned long long*)ptr + 1, __ATOMIC_RELAXED, __HIP_MEMORY_SCOPE_AGENT);
    u32x4 r; r.x = (unsigned)a; r.y = (unsigned)(a >> 32); r.z = (unsigned)b; r.w = (unsigned)(b >> 32); return r; }
struct EpiBrF { unsigned char* ws;
    __device__ __forceinline__ void operator()(const f32x4 (&acc)[2][2][4][2], const pg8::Unit& u, int wr, int wc, int fr, int fq) const {
        const int cb = u.pn * 256; const bf16_t* G = (const bf16_t*)(ws + (u.grp ? B_GB : B_GA)); bf16_t* O = (bf16_t*)(ws + B_MRGB); const bool second = u.grp != 0;
        struct GO { u32x4 g, o; };
        pg8::for_each_piece_pf(acc, u, wr, wc, fr, fq, [&](int row, int col) { const size_t idx = (size_t)row * D + cb + col; GO r; r.g = *(const u32x4*)(G + idx);
                r.o = second ? ld16_agent(O + idx) : (u32x4){0u, 0u, 0u, 0u}; return r; },
            [&](int row, int col, f32x4 v0, f32x4 v1, GO pre) { const size_t idx = (size_t)row * D + cb + col;
            f32x4 g0, g1; pg8::unpack8(pre.g, g0, g1);
            f32x4 r0 = v0 * sig4(g0), r1 = v1 * sig4(g1);
            if (second) { f32x4 t0, t1; pg8::unpack8(pre.o, t0, t1); r0 += t0; r1 += t1; }
            *(u32x4*)(O + idx) = pg8::pack8(r0, r1); }); } };
struct EpiBrS { const bf16_t* G; bf16_t* O; bool second;
    __device__ __forceinline__ void operator()(int m, int n, f32x4 v) const { const u32x2 gg = *(const u32x2*)(G + (size_t)m * D + n);
        f32x4 o; o.x = v.x * sigmoidf_(bf2f(gg.x & 0xffffu)); o.y = v.y * sigmoidf_(bf2f(gg.x >> 16)); o.z = v.z * sigmoidf_(bf2f(gg.y & 0xffffu)); o.w = v.w * sigmoidf_(bf2f(gg.y >> 16));
        if (second) { const unsigned long long t = __hip_atomic_load((const unsigned long long*)(O + (size_t)m * D + n), __ATOMIC_RELAXED, __HIP_MEMORY_SCOPE_AGENT);
            o.x += bf2f((unsigned)t & 0xffffu); o.y += bf2f(((unsigned)t) >> 16); o.z += bf2f((unsigned)(t >> 32) & 0xffffu); o.w += bf2f((unsigned)(t >> 48)); }
        store4_bf16(O + (size_t)m * D + n, o); } };
__device__ __forceinline__ void phase_br_f(const Params& p, char* lds, int bid, int nb) {
    const bf16_t* YM = (const bf16_t*)(p.ws + B_YM); const bf16_t* YA = (const bf16_t*)(p.ws + B_YA);
    const bf16_t* WM = (const bf16_t*)(p.ws + W_BM_T); const bf16_t* WA = (const bf16_t*)(p.ws + W_BA_T); bf16_t* O = (bf16_t*)(p.ws + B_MRGB);
    for (int t = bid; t < 16; t += nb) {
        meta_gemm<1, 4>(RowsPlain{YM, D}, RowsPlain{WM, D}, D, VALID0, t * 64, EpiBrS{(const bf16_t*)(p.ws + B_GA), O, false}, lds);
        asm volatile("s_waitcnt vmcnt(0)" ::: "memory");
        meta_gemm<1, 4>(RowsPlain{YA, D}, RowsPlain{WA, D}, D, VALID0, t * 64, EpiBrS{(const bf16_t*)(p.ws + B_GB), O, true}, lds);
    }
    SchedBr S{(const char*)YM, (const char*)YA, (const char*)WM, (const char*)WA, nb, bid, D, D, D};
    pg8::gemm_phase((PG8_LAS unsigned char*)lds, S, EpiBrF{p.ws});
}
__device__ __forceinline__ void phase_out_f(const Params& p, char* lds, int bid, int nb) {
    const int gw = bid * NW + (TIDX >> 6), ngw = nb * NW;
    const bf16_t* A = (const bf16_t*)(p.ws + B_MRGB); const bf16_t* W = (const bf16_t*)(p.ws + W_OUT_T);
    for (int t = bid; t < 16; t += nb) meta_gemm<1, 4>(RowsPlain{A, D}, RowsPlain{W, D}, D, VALID0, t * 64, EpiOut{(float*)(p.ws + B_Z), (const bf16_t*)(p.ws + B_H)}, lds);
    SchedSq S{(const char*)A, (const char*)W, nb, bid, D, D, D};
    pg8::gemm_phase((PG8_LAS unsigned char*)lds, S, EpiOutF{(float*)(p.ws + B_Z), (const bf16_t*)(p.ws + B_H)});
}

__device__ __forceinline__ void phase_ln1(const Params& p, int l, char* lds, int bid, int nb) {
    const int tid = TIDX, wid = tid >> 6, lane = tid & 63, gw = bid * NW + wid, ngw = nb * NW;
    float* wr = (float*)lds;
    for (int i = tid; i < D * 16 / 4; i += NT) { const int k = i >> 2, q = i & 3; *(f32x4*)(wr + k * 16 + (k >> 2) * 4 + 4 * q) = ((const f32x4*)p.in[I_WR])[i]; }
    unsigned* lcnt = (unsigned*)(lds + 73728); unsigned* lbase = lcnt + 16; int* lrow = (int*)(lds + 73728 + 256) + wid * 64;
    if (tid < 16) lcnt[tid] = 0u;
    __syncthreads();
    const float* Z = (const float*)(p.ws + B_Z); bf16_t* H1 = (bf16_t*)(p.ws + B_H1);
    unsigned* cnt = (unsigned*)(p.ws + WS_CTL) + CW_CNT + l * 16; float* topk = (float*)(p.ws + TAB_TOPK);
    int nrow = 0;
    f32x4 vn[4];
    if (gw < P) {
#pragma unroll
        for (int j = 0; j < 4; ++j) vn[j] = *(const f32x4*)(Z + (size_t)gw * D + 4 * lane + 256 * j); }
    for (int r = gw; r < P; r += ngw) {
        f32x4 v[4];
#pragma unroll
        for (int j = 0; j < 4; ++j) v[j] = vn[j];
        if (r + ngw < P) {
#pragma unroll
            for (int j = 0; j < 4; ++j) vn[j] = *(const f32x4*)(Z + (size_t)(r + ngw) * D + 4 * lane + 256 * j); }
        if (r < VALID0) { store_row_zero(H1 + (size_t)r * D, lane); continue; }
        ln_normalize(v, p.in[I_LN1G] + (size_t)l * D, p.in[I_LN1B] + (size_t)l * D, lane);
        store_row_bf16(H1 + (size_t)r * D, v, lane);
        float lg[16];
#pragma unroll
        for (int e = 0; e < 16; ++e) lg[e] = 0.f;
#pragma unroll
        for (int j = 0; j < 4; ++j)
#pragma unroll
            for (int i = 0; i < 4; ++i) { const int k = 4 * lane + 256 * j + i; const float x = v[j][i];
#pragma unroll
                for (int q = 0; q < 4; ++q) { const f32x4 w = *(const f32x4*)(wr + k * 16 + (k >> 2) * 4 + 4 * q); lg[4 * q] += x * w.x; lg[4 * q + 1] += x * w.y; lg[4 * q + 2] += x * w.z; lg[4 * q + 3] += x * w.w; } }
#pragma unroll
        for (int e = 0; e < 16; ++e) lg[e] = wave_sum(lg[e]);
        if (lane == 0) {
            float mx = lg[0];
#pragma unroll
            for (int e = 1; e < 16; ++e) mx = fmaxf(mx, lg[e]);
            float pr[16], sum = 0.f;
#pragma unroll
            for (int e = 0; e < 16; ++e) { pr[e] = expf(lg[e] - mx); sum += pr[e]; }
            const float isum = 1.f / sum;
            float sel[16];
#pragma unroll
            for (int e = 0; e < 16; ++e) { pr[e] *= isum; sel[e] = pr[e] + p.in[I_RB][e]; }
            int tg = 0; float best = -INFINITY;
#pragma unroll
            for (int gI = 0; gI < 4; ++gI) { const float gs = fmaxf(fmaxf(sel[4 * gI], sel[4 * gI + 1]), fmaxf(sel[4 * gI + 2], sel[4 * gI + 3])); if (gs > best) { best = gs; tg = gI; } }
            int i0 = 0; float b0 = -INFINITY;
#pragma unroll
            for (int e = 0; e < 16; ++e) if ((e >> 2) == tg && sel[e] > b0) { b0 = sel[e]; i0 = e; }
            int i1 = 0; float b1 = -INFINITY;
#pragma unroll
            for (int e = 0; e < 16; ++e) if ((e >> 2) == tg && e != i0 && sel[e] > b1) { b1 = sel[e]; i1 = e; }
            float p0 = 0.f, p1 = 0.f;
#pragma unroll
            for (int e = 0; e < 16; ++e) { if (e == i0) p0 = pr[e]; if (e == i1) p1 = pr[e]; }
            const float inv = 1.f / (p0 + p1);
            const unsigned pos0 = atomicAdd(lcnt + i0, 1u), pos1 = atomicAdd(lcnt + i1, 1u);
            lrow[nrow * 4] = i0; lrow[nrow * 4 + 1] = i1; lrow[nrow * 4 + 2] = (int)pos0; lrow[nrow * 4 + 3] = (int)pos1;
            float* tk = topk + (size_t)r * 8;
            ((int*)tk)[0] = i0; ((int*)tk)[1] = i1; tk[4] = p0 * inv; tk[5] = p1 * inv;
        }
        ++nrow;
    }
    __syncthreads();
    if (tid < 16) lbase[tid] = atomicAdd(cnt + tid, lcnt[tid]);
    __syncthreads();
    if (lane == 0) { int k = 0;
        for (int r = gw; r < P; r += ngw) { if (r < VALID0) continue;
            int* tk = (int*)(topk + (size_t)r * 8); tk[2] = (int)lbase[lrow[k * 4]] + lrow[k * 4 + 2]; tk[3] = (int)lbase[lrow[k * 4 + 1]] + lrow[k * 4 + 3]; ++k; } }
}

__device__ __forceinline__ void expert_offsets(const unsigned* cnt, int* s_cnt, int* s_off, int* s_tiles) {
    int off = 0;
    if (TIDX == 0) { int tt = 0; for (int e = 0; e < 16; ++e) { const int c = (int)cnt[e]; const int tl = (c + 255) >> 8; s_cnt[e] = c; s_off[e] = off; s_tiles[e] = tt; off += tl * 256; tt += tl; } s_tiles[16] = tt; }
    __syncthreads();
}
__device__ __forceinline__ void phase_perm(const Params& p, int l, char* lds, int bid, int nb) {
    int* s_cnt = (int*)(lds + LDS_TAB_OFF); int* s_off = s_cnt + 16; int* s_tiles = s_off + 16;
    expert_offsets((const unsigned*)(p.ws + WS_CTL) + CW_CNT + l * 16, s_cnt, s_off, s_tiles);
    const int tid = TIDX, wid = tid >> 6, lane = tid & 63, gw = bid * NW + wid, ngw = nb * NW;
    const bf16_t* H1 = (const bf16_t*)(p.ws + B_H1); bf16_t* XP = (bf16_t*)(p.ws + B_XP); const float* topk = (const float*)(p.ws + TAB_TOPK);
    int r = VALID0 + gw;
    u32x4 a, b; u32x4 tk;
    if (r < P) { tk = *(const u32x4*)(topk + (size_t)r * 8); const u32x4* src = (const u32x4*)(H1 + (size_t)r * D) + lane * 2; a = src[0]; b = src[1]; }
    while (r < P) {
        const int rn = r + ngw; u32x4 an, bn, tkn;
        if (rn < P) { tkn = *(const u32x4*)(topk + (size_t)rn * 8); const u32x4* src = (const u32x4*)(H1 + (size_t)rn * D) + lane * 2; an = src[0]; bn = src[1]; }
        const int e0 = (int)tk.x, e1 = (int)tk.y, p0 = (int)tk.z, p1 = (int)tk.w;
        u32x4* d0 = (u32x4*)(XP + (size_t)(s_off[e0] + p0) * D) + lane * 2; u32x4* d1 = (u32x4*)(XP + (size_t)(s_off[e1] + p1) * D) + lane * 2;
        d0[0] = a; d0[1] = b; d1[0] = a; d1[1] = b;
        a = an; b = bn; tk = tkn; r = rn;
    }
}
struct SchedMoE { const char* A; const char* B; size_t estride; int nN; const int* s_off; const int* s_tiles; int G, c; int K, lda, ldb;
    __device__ __forceinline__ bool next(int i, pg8::Unit& u) const {
        const int nwg = s_tiles[16] * nN; const long L = (long)i * G + c; if (L >= nwg) return false;
        int wgid = (int)L; { const int q = nwg / 8, r = nwg % 8, xcd = wgid % 8, off = wgid / 8; wgid = (xcd < r ? xcd * (q + 1) : r * (q + 1) + (xcd - r) * q) + off; }
        const int rt = wgid / nN; int e = 0;
        while (e < 15 && rt >= s_tiles[e + 1]) ++e;
        u.grp = __builtin_amdgcn_readfirstlane(e); u.pm = __builtin_amdgcn_readfirstlane((s_off[e] >> 8) + rt - s_tiles[e]); u.pn = __builtin_amdgcn_readfirstlane(wgid % nN); return true; }
    __device__ __forceinline__ const char* abase(const pg8::Unit& u) const { return A + (size_t)u.pm * 256 * D * 2; }
    __device__ __forceinline__ const char* bbase(const pg8::Unit& u) const { return B + (size_t)u.grp * estride + (size_t)u.pn * 256 * D * 2; } };
struct EpiE1F { bf16_t* HID;
    __device__ __forceinline__ void operator()(const f32x4 (&acc)[2][2][4][2], const pg8::Unit& u, int wr, int wc, int fr, int fq) const {
        asm volatile("" : "+v"(fr), "+v"(fq));
        const int row0 = u.pm * 256 + wr * 64 + fr, col0 = u.pn * 128 + wc * 32 + 8 * fq;
#pragma unroll
        for (int ai = 0; ai < 2; ++ai)
#pragma unroll
            for (int m = 0; m < 4; ++m) { f32x4 h0, h1;
#pragma unroll
                for (int r = 0; r < 4; ++r) { h0[r] = siluf_(acc[ai][0][m][0][r]) * acc[ai][1][m][0][r]; h1[r] = siluf_(acc[ai][0][m][1][r]) * acc[ai][1][m][1][r]; }
                *(u32x4*)(HID + (size_t)(row0 + ai * 128 + m * 16) * D + col0) = pg8::pack8(h0, h1); } } };
struct EpiE2F { bf16_t* YB;
    __device__ __forceinline__ void operator()(const f32x4 (&acc)[2][2][4][2], const pg8::Unit& u, int wr, int wc, int fr, int fq) const {
        bf16_t* base = YB + u.pn * 256;
        pg8::for_each_piece(acc, u, wr, wc, fr, fq, [&](int row, int col, f32x4 v0, f32x4 v1) { *(u32x4*)(base + (size_t)row * D + col) = pg8::pack8(v0, v1); }); } };
__device__ __forceinline__ void phase_e1_f(const Params& p, int l, char* lds, int bid, int nb) {
    int* s_cnt = (int*)(lds + LDS_TAB_OFF); int* s_off = s_cnt + 16; int* s_tiles = s_off + 16;
    expert_offsets((const unsigned*)(p.ws + WS_CTL) + CW_CNT + l * 16, s_cnt, s_off, s_tiles);
    SchedMoE S{(const char*)(p.ws + B_XP), (const char*)(p.ws + W_G_T), (size_t)2048 * D * 2, 8, s_off, s_tiles, nb, bid, D, D, D};
    pg8::gemm_phase((PG8_LAS unsigned char*)lds, S, EpiE1F{(bf16_t*)(p.ws + B_HID)});
}
__device__ __forceinline__ void phase_e2_f(const Params& p, int l, char* lds, int bid, int nb) {
    int* s_cnt = (int*)(lds + LDS_TAB_OFF); int* s_off = s_cnt + 16; int* s_tiles = s_off + 16;
    expert_offsets((const unsigned*)(p.ws + WS_CTL) + CW_CNT + l * 16, s_cnt, s_off, s_tiles);
    SchedMoE S{(const char*)(p.ws + B_HID), (const char*)(p.ws + W_D_T), (size_t)D * D * 2, 4, s_off, s_tiles, nb, bid, D, D, D};
    pg8::gemm_phase((PG8_LAS unsigned char*)lds, S, EpiE2F{(bf16_t*)(p.ws + B_YB)});
}

__device__ __forceinline__ void phase_combine(const Params& p, int l, char* lds, int bid, int nb) {
    const int tid = TIDX, wid = tid >> 6, lane = tid & 63, gw = bid * NW + wid, ngw = nb * NW;
    const bool last = (l == DEPTH - 1);
    if (!last) { convert_weights(p, l + 1, lds, gw, ngw, wid, lane); __syncthreads(); }
    int* s_cnt = (int*)(lds + 65536); int* s_off = s_cnt + 16; int* s_tiles = s_off + 16;
    expert_offsets((const unsigned*)(p.ws + WS_CTL) + CW_CNT + l * 16, s_cnt, s_off, s_tiles);
    float* g8 = (float*)lds;
    if (!last) load_gate_w(p, l + 1, g8);
    const bf16_t* H1 = (const bf16_t*)(p.ws + B_H1); const bf16_t* YB = (const bf16_t*)(p.ws + B_YB); bf16_t* H = (bf16_t*)(p.ws + B_H);
    const float* topk = (const float*)(p.ws + TAB_TOPK);
    for (int r = gw; r < P; r += ngw) {
        if (r < VALID0) { if (!last) { store_row_zero(H + (size_t)r * D, lane); gates_row_pad(p, r, lane); } continue; }
        if (last && r < 256) continue;
        const float* tk = topk + (size_t)r * 8;
        const int e0 = ((const int*)tk)[0], e1 = ((const int*)tk)[1], p0 = ((const int*)tk)[2], p1 = ((const int*)tk)[3]; const float w0 = tk[4], w1 = tk[5];
        const bf16_t* y0 = YB + (size_t)(s_off[e0] + p0) * D; const bf16_t* y1 = YB + (size_t)(s_off[e1] + p1) * D; const bf16_t* hr = H1 + (size_t)r * D;
        f32x4 v[4];
#pragma unroll
        for (int j = 0; j < 4; ++j) { const int cc = 4 * lane + 256 * j; const u32x2 a = *(const u32x2*)(y0 + cc), b = *(const u32x2*)(y1 + cc), hh = *(const u32x2*)(hr + cc);
            v[j].x = DN_ALPHA * bf2f(hh.x & 0xffffu) + w0 * bf2f(a.x & 0xffffu) + w1 * bf2f(b.x & 0xffffu);
            v[j].y = DN_ALPHA * bf2f(hh.x >> 16) + w0 * bf2f(a.x >> 16) + w1 * bf2f(b.x >> 16);
            v[j].z = DN_ALPHA * bf2f(hh.y & 0xffffu) + w0 * bf2f(a.y & 0xffffu) + w1 * bf2f(b.y & 0xffffu);
            v[j].w = DN_ALPHA * bf2f(hh.y >> 16) + w0 * bf2f(a.y >> 16) + w1 * bf2f(b.y >> 16); }
        ln_normalize(v, p.in[I_LN2G] + (size_t)l * D, p.in[I_LN2B] + (size_t)l * D, lane);
        if (last) {
            float* o = p.out + (size_t)(r - 256) * D;
#pragma unroll
            for (int j = 0; j < 4; ++j) *(f32x4*)(o + 4 * lane + 256 * j) = v[j];
        } else { store_row_bf16(H + (size_t)r * D, v, lane); gates_row(p, l + 1, g8, v, r, lane); }
    }
}

#define XB_TMO      128
#define XB_XCNT(j)  (256  + 64 * (j))
#define XB_XSUB(j)  (1280 + 64 * (j))
#define XB_XGEN(j)  (2304 + 64 * (j))
#define XB_TOP      3328
#define XB_TOPGEN   3392
#define XCD_BAR_WORDS 3456
#define XB_SPIN_CAP (1u << 18)
#define LAS __attribute__((address_space(3)))

__device__ __forceinline__ unsigned xb_ld(unsigned* p)              { return __hip_atomic_load(p, __ATOMIC_RELAXED, __HIP_MEMORY_SCOPE_AGENT); }
__device__ __forceinline__ unsigned xb_add(unsigned* p, unsigned v) { return __hip_atomic_fetch_add(p, v, __ATOMIC_RELAXED, __HIP_MEMORY_SCOPE_AGENT); }
__device__ __forceinline__ unsigned xb_xcc_id() { return (unsigned)__builtin_amdgcn_s_getreg((3 << 11) | 20) & 0xFu; }
#define XB_SPIN(cond, bar) do { unsigned _sp = 0; while (cond) { __builtin_amdgcn_s_sleep(1); \
    if ((++_sp & 255u) == 0u) { if (xb_ld(&(bar)[XB_TMO])) break; if (_sp > XB_SPIN_CAP) { atomicAdd(&(bar)[XB_TMO], 1u); break; } } } } while (0)

struct XcdBarrier {
    unsigned* bar; unsigned x;
    volatile LAS unsigned* st;
};
__device__ __forceinline__ XcdBarrier xcd_barrier_post(unsigned* bar, volatile LAS unsigned* st) {
    XcdBarrier b; b.bar = bar; b.x = xb_xcc_id(); b.st = st;
    if (threadIdx.x == 0) (void)xb_add(&bar[XB_XCNT(b.x)], 1u);
    return b;
}
__device__ __forceinline__ void xcd_barrier_complete(unsigned* bar, unsigned x, unsigned& nloc, unsigned& nx) {
    const unsigned G = gridDim.x * gridDim.y * gridDim.z;
    unsigned sum, cnt, mine, sp = 0u;
    for (;;) {
        sum = 0u; cnt = 0u; mine = 0u;
#pragma unroll
        for (unsigned j = 0; j < 16; ++j) { const unsigned c = xb_ld(&bar[XB_XCNT(j)]); sum += c; cnt += (c > 0u) ? 1u : 0u; mine = (j == x) ? c : mine; }
        if (sum == G) break;
        __builtin_amdgcn_s_sleep(1);
        if ((++sp & 255u) == 0u) { if (xb_ld(&bar[XB_TMO])) break; if (sp > XB_SPIN_CAP) { atomicAdd(&bar[XB_TMO], 1u); break; } }
    }
    nloc = mine > 0u ? mine : 1u; nx = cnt > 0u ? cnt : 1u;
}
__device__ __forceinline__ void xcd_barrier(const XcdBarrier& b) {
    asm volatile("s_waitcnt vmcnt(0)" ::: "memory");
    __syncthreads();
    if (threadIdx.x == 0) {
        unsigned* bar = b.bar;
        __builtin_amdgcn_s_waitcnt(0);
        unsigned nloc = b.st[0], nx = b.st[1];
        if (nloc == 0u) { xcd_barrier_complete(bar, b.x, nloc, nx); b.st[0] = nloc; b.st[1] = nx; }
        const unsigned old = xb_add(&bar[XB_XSUB(b.x)], 1u);
        const unsigned gen = old / nloc;
        if (old + 1u == (gen + 1u) * nloc) {
            __builtin_amdgcn_fence(__ATOMIC_RELEASE, "agent");
            asm volatile("s_waitcnt vmcnt(0)" ::: "memory");
            const unsigned og = xb_add(&bar[XB_TOP], 1u);
            const unsigned tg = og / nx;
            if (og + 1u == (tg + 1u) * nx) xb_add(&bar[XB_TOPGEN], 1u);
            else XB_SPIN(xb_ld(&bar[XB_TOPGEN]) == tg, bar);
            __builtin_amdgcn_fence(__ATOMIC_ACQUIRE, "agent");
            xb_add(&bar[XB_XGEN(b.x)], 1u);
            asm volatile("s_waitcnt vmcnt(0)" ::: "memory");
        } else {
            XB_SPIN(xb_ld(&bar[XB_XGEN(b.x)]) == gen, bar);
            __builtin_amdgcn_fence(__ATOMIC_ACQUIRE, "agent");
            asm volatile("s_waitcnt vmcnt(0)" ::: "memory");
        }
    }
    __syncthreads();
}

constexpr int LDS_BYTES = 131072 + 12288;
constexpr int LDS_BAR_OFF = LDS_BYTES - 16;
constexpr int CW_BAR = 4096;
template <int L>
__device__ __forceinline__ void layer_body(const Params& p, char* lds, int bid, int nb, const XcdBarrier& bar) {
    phase_proj_f(p, lds, bid, nb); xcd_barrier(bar);
    phase_attn_f(p, L, lds, bid, nb); xcd_barrier(bar);
    phase_conv(p, L, lds, bid, nb); xcd_barrier(bar);
    phase_mqkv_f(p, lds, bid, nb); xcd_barrier(bar);
    phase_ms(p, lds, bid, nb); phase_sg(p, lds, bid, nb); xcd_barrier(bar);
    phase_m2(p, lds, bid, nb); xcd_barrier(bar);
    phase_o1(p, lds, bid, nb); xcd_barrier(bar);
    phase_o2(p, L, lds, bid, nb); xcd_barrier(bar);
    phase_br_f(p, lds, bid, nb); xcd_barrier(bar);
    phase_out_f(p, lds, bid, nb); xcd_barrier(bar);
    phase_ln1(p, L, lds, bid, nb); xcd_barrier(bar);
    phase_perm(p, L, lds, bid, nb); xcd_barrier(bar);
    phase_e1_f(p, L, lds, bid, nb); xcd_barrier(bar);
    phase_e2_f(p, L, lds, bid, nb); xcd_barrier(bar);
    phase_combine(p, L, lds, bid, nb); if (L + 1 < DEPTH) xcd_barrier(bar);
}
__global__ void __launch_bounds__(NT, 2) fwd_kernel(Params p) {
    extern __shared__ __attribute__((aligned(16))) char lds[];
    const int bid = blockIdx.x, nb = gridDim.x;
    if (threadIdx.x == 0) *(uint4*)(lds + LDS_BAR_OFF) = make_uint4(0u, 0u, 0u, 0u);
    __syncthreads();
    XcdBarrier bar = xcd_barrier_post((unsigned*)(p.ws + WS_CTL) + CW_BAR, (volatile LAS unsigned*)(lds + LDS_BAR_OFF));
    phase_prologue(p, lds, bid, nb); xcd_barrier(bar);
    layer_body<0>(p, lds, bid, nb, bar);
    layer_body<1>(p, lds, bid, nb, bar);
}

extern "C" void kernel_launch(void* const* d_in, const int* in_sizes, int n_in, void* d_out, int out_size, void* d_ws, size_t ws_size, hipStream_t stream) {
    if (n_in != 30 || ws_size < WS_END) { fprintf(stderr, "kernel_launch: unexpected n_in %d or ws_size %zu (< %zu)\n", n_in, ws_size, (size_t)WS_END); return; }
    static int grid = 0;
    if (grid == 0) {
        int dev = 0, cus = 0;
        if (hipGetDevice(&dev) != hipSuccess || hipDeviceGetAttribute(&cus, hipDeviceAttributeMultiprocessorCount, dev) != hipSuccess || cus <= 0) cus = 256;
        (void)hipFuncSetAttribute((const void*)fwd_kernel, hipFuncAttributeMaxDynamicSharedMemorySize, LDS_BYTES);
        grid = cus;
    }
    Params p{};
    for (int i = 0; i < 30; ++i) p.in[i] = (const float*)d_in[i];
    p.out = (float*)d_out; p.ws = (unsigned char*)d_ws;
    (void)hipMemsetAsync((char*)d_ws + WS_CTL, 0, CTL_BYTES, stream);
    hipLaunchKernelGGL(fwd_kernel, dim3(grid), dim3(NT), LDS_BYTES, stream, p);
}
```
